# Optimizing an MI355X kernel written in HIP

```python
import math
import jax, jax.numpy as jnp
from jax import lax
import numpy as np


D_MODEL = 1024
BATCH = 2
SEQ = 8192
DEPTH = 1

MEM_LEN = 256
RMS_EPS = 1e-6
RW_HEADS = 8
RW_HEAD_DIM = 64
RW_WIDTH = RW_HEADS * RW_HEAD_DIM
DECAY_LORA = 64
AAA_LORA = 64
LNX_EPS = 64e-5
L2_EPS = 1e-12
SW_HEADS = 8
SW_KV_HEADS = 2
SW_GROUP = SW_HEADS // SW_KV_HEADS
SW_HEAD_DIM = 64
SW_WIDTH = SW_HEADS * SW_HEAD_DIM
SW_KV_WIDTH = SW_KV_HEADS * SW_HEAD_DIM
WINDOW = 128
BLOCK = 128
ROPE_THETA = 10000.0
NEG_INF = -1e30
X_HEADS = 4
X_HEAD_DIM = 128
X_WIDTH = X_HEADS * X_HEAD_DIM
N_BRANCHES = 3

IN_SPLITS = (RW_WIDTH, RW_WIDTH, RW_WIDTH, DECAY_LORA, AAA_LORA, RW_WIDTH,
             SW_WIDTH, SW_KV_WIDTH, SW_KV_WIDTH, SW_WIDTH,
             X_WIDTH, X_WIDTH,
             N_BRANCHES * D_MODEL)
IN_WIDTH = sum(IN_SPLITS)

kernel_name = 'hybrid_rwkv7_swa_sink_memxattn_gated'


def rms_norm(x, g):
    xf = x.astype(jnp.float32)
    y = xf * lax.rsqrt(jnp.mean(xf * xf, axis=-1, keepdims=True) + RMS_EPS)
    return (y * g.astype(jnp.float32)).astype(x.dtype)


def token_shift_mix(u, mu):
    prev = jnp.pad(u, ((0, 0), (1, 0), (0, 0)))[:, :-1]
    return u + (prev - u) * mu


def rope(x, pos):
    d = x.shape[-1]
    half = d // 2
    inv = ROPE_THETA ** (-jnp.arange(half, dtype=jnp.float32) / half)
    ang = pos.astype(jnp.float32)[..., None] * inv
    cos = jnp.cos(ang)[:, :, None, :]
    sin = jnp.sin(ang)[:, :, None, :]
    xf = x.astype(jnp.float32)
    x1, x2 = xf[..., :half], xf[..., half:]
    return jnp.concatenate([x1 * cos - x2 * sin, x2 * cos + x1 * sin], axis=-1).astype(x.dtype)


def rwkv7_scan(r, w, k, v, a, b):
    def step(S, inp):
        r_t, w_t, k_t, v_t, a_t, b_t = inp
        sa = jnp.einsum('bhvk,bhk->bhv', S, a_t)
        S = S * w_t[:, :, None, :] + sa[..., None] * b_t[:, :, None, :] + v_t[..., None] * k_t[:, :, None, :]
        y = jnp.einsum('bhvk,bhk->bhv', S, r_t)
        return S, y
    bsz, _, h, n = r.shape
    xs = tuple(jnp.moveaxis(t, 1, 0) for t in (r, w, k, v, a, b))
    s0 = jnp.zeros((bsz, h, n, n), jnp.float32)
    _, y = lax.scan(step, s0, xs)
    return jnp.moveaxis(y, 0, 1)


def rwkv7_mix(p_r, p_k, p_v, p_w, p_a, mu_rkv, mu_wa, w0, w2, a0, a2, k_k, k_a, r_k, lnx_g, lnx_b):
    f32 = jnp.float32
    bsz, t, _ = p_r.shape
    r = token_shift_mix(p_r, mu_rkv[0]).astype(f32)
    k = token_shift_mix(p_k, mu_rkv[1]).astype(f32)
    v = token_shift_mix(p_v, mu_rkv[2]).astype(f32)
    lw = token_shift_mix(p_w, mu_wa[0]).astype(f32)
    la = token_shift_mix(p_a, mu_wa[1]).astype(f32)
    w_log = -jax.nn.softplus(-(w0.astype(f32) + jnp.tanh(lw) @ w2.astype(f32))) - 0.5
    decay = jnp.exp(-jnp.exp(w_log))
    a = jax.nn.sigmoid(a0.astype(f32) + la @ a2.astype(f32))
    heads = lambda u: u.reshape(bsz, t, RW_HEADS, RW_HEAD_DIM)
    kk = heads(k * k_k.astype(f32))
    kk = kk / jnp.maximum(jnp.linalg.norm(kk, axis=-1, keepdims=True), L2_EPS)
    k = k * (1.0 + (a - 1.0) * k_a.astype(f32))
    rh, kh, vh, ah = heads(r), heads(k), heads(v), heads(a)
    y = rwkv7_scan(rh, heads(decay), kh, vh, -kk, kk * ah)
    mean = jnp.mean(y, axis=-1, keepdims=True)
    var = jnp.mean(jnp.square(y - mean), axis=-1, keepdims=True)
    y = ((y - mean) * lax.rsqrt(var + LNX_EPS)).reshape(bsz, t, RW_WIDTH) * lnx_g.astype(f32) + lnx_b.astype(f32)
    bonus = jnp.sum(rh * kh * r_k.astype(f32), axis=-1, keepdims=True) * vh
    return y + bonus.reshape(bsz, t, RW_WIDTH)


def sliding_window_sink_attn(q, k, v, pos, q_g, k_g, sinks):
    bsz, t, _ = q.shape
    nb = t // BLOCK
    q = rope(rms_norm(q.reshape(bsz, t, SW_HEADS, SW_HEAD_DIM), q_g), pos)
    k = rope(rms_norm(k.reshape(bsz, t, SW_KV_HEADS, SW_HEAD_DIM), k_g), pos)
    v = v.reshape(bsz, t, SW_KV_HEADS, SW_HEAD_DIM)
    qb = q.reshape(bsz, nb, BLOCK, SW_KV_HEADS, SW_GROUP, SW_HEAD_DIM)
    def band(u):
        ub = u.reshape(bsz, nb, BLOCK, SW_KV_HEADS, SW_HEAD_DIM)
        prev = jnp.pad(ub, ((0, 0), (1, 0), (0, 0), (0, 0), (0, 0)))[:, :-1]
        return jnp.concatenate([prev, ub], axis=2)
    kband, vband = band(k), band(v)
    scale = SW_HEAD_DIM ** -0.5
    s = jnp.einsum('bnqhgd,bnkhd->bnhgqk', qb, kband).astype(jnp.float32) * scale
    qi = jnp.arange(BLOCK)[:, None]
    kj = jnp.arange(2 * BLOCK)[None, :]
    rel = qi - kj + BLOCK
    allowed = (rel >= 0) & (rel < WINDOW)
    not_pad = (jnp.arange(nb)[:, None, None] > 0) | (kj >= BLOCK)[None]
    mask = allowed[None] & not_pad
    s = jnp.where(mask[None, :, None, None], s, NEG_INF)
    sink = jnp.broadcast_to(sinks.astype(jnp.float32).reshape(SW_KV_HEADS, SW_GROUP)[None, None, :, :, None, None],
                            s.shape[:-1] + (1,))
    p = jax.nn.softmax(jnp.concatenate([s, sink], axis=-1), axis=-1)[..., :-1]
    o = jnp.einsum('bnhgqk,bnkhd->bnqhgd', p.astype(v.dtype), vband)
    return o.reshape(bsz, t, SW_WIDTH)


def memory_cross_attn(q, mem, mem_norm_g, w_mem_kv, xq_g, xk_g):
    bsz, t, _ = q.shape
    m = mem.shape[1]
    q = rms_norm(q.reshape(bsz, t, X_HEADS, X_HEAD_DIM), xq_g)
    kv = rms_norm(mem, mem_norm_g) @ w_mem_kv
    km, vm = kv[..., :X_WIDTH], kv[..., X_WIDTH:]
    km = rms_norm(km.reshape(bsz, m, X_HEADS, X_HEAD_DIM), xk_g)
    vm = vm.reshape(bsz, m, X_HEADS, X_HEAD_DIM)
    s = jnp.einsum('bthd,bmhd->bhtm', q, km).astype(jnp.float32) * (X_HEAD_DIM ** -0.5)
    p = jax.nn.softmax(s, axis=-1)
    o = jnp.einsum('bhtm,bmhd->bthd', p.astype(vm.dtype), vm)
    return o.reshape(bsz, t, X_WIDTH)


def setup_inputs(seed: int = 0) -> dict:
    key = jax.random.key(seed)
    ks = iter(jax.random.split(key, 40))
    f32 = jnp.float32
    def nrm(shape, scale):
        return jax.random.normal(next(ks), shape, f32) * scale
    L = DEPTH
    x = jax.random.normal(next(ks), (BATCH, SEQ, D_MODEL), f32)
    mem = jax.random.normal(next(ks), (BATCH, MEM_LEN, D_MODEL), f32)
    offset = jax.random.randint(next(ks), (BATCH, 1), 0, 4096, dtype=jnp.int32)
    positions = jnp.arange(SEQ, dtype=jnp.int32)[None, :] + offset
    return {
        'x': x,
        'mem': mem,
        'positions': positions,
        'norm_g': 1.0 + nrm((L, D_MODEL), 0.05),
        'mem_norm_g': 1.0 + nrm((L, D_MODEL), 0.05),
        'w_in': nrm((L, D_MODEL, IN_WIDTH), D_MODEL ** -0.5),
        'mu_rkv': jax.random.uniform(next(ks), (L, 3, RW_WIDTH), f32),
        'mu_wa': jax.random.uniform(next(ks), (L, 2, DECAY_LORA), f32),
        'w0': jnp.linspace(-6.0, -1.0, RW_WIDTH, dtype=f32)[None, :] + nrm((L, RW_WIDTH), 0.1),
        'w2': nrm((L, DECAY_LORA, RW_WIDTH), 0.5 * DECAY_LORA ** -0.5),
        'a0': nrm((L, RW_WIDTH), 0.1),
        'a2': nrm((L, AAA_LORA, RW_WIDTH), 0.5 * AAA_LORA ** -0.5),
        'k_k': 0.85 + nrm((L, RW_WIDTH), 0.05),
        'k_a': 1.0 + nrm((L, RW_WIDTH), 0.05),
        'r_k': nrm((L, RW_HEADS, RW_HEAD_DIM), 0.1),
        'lnx_g': 1.0 + nrm((L, RW_WIDTH), 0.05),
        'lnx_b': nrm((L, RW_WIDTH), 0.01),
        'q_norm_g': 1.0 + nrm((L, SW_HEAD_DIM), 0.05),
        'k_norm_g': 1.0 + nrm((L, SW_HEAD_DIM), 0.05),
        'sinks': nrm((L, SW_HEADS), 1.0),
        'xq_norm_g': 1.0 + nrm((L, X_HEAD_DIM), 0.05),
        'xk_norm_g': 1.0 + nrm((L, X_HEAD_DIM), 0.05),
        'w_mem_kv': nrm((L, D_MODEL, 2 * X_WIDTH), D_MODEL ** -0.5),
        'w_proj_a': nrm((L, RW_WIDTH, D_MODEL), RW_WIDTH ** -0.5),
        'w_proj_b': nrm((L, SW_WIDTH, D_MODEL), SW_WIDTH ** -0.5),
        'w_proj_c': nrm((L, X_WIDTH, D_MODEL), X_WIDTH ** -0.5),
        'w_out': nrm((L, D_MODEL, D_MODEL), D_MODEL ** -0.5),
    }


def reference(x, mem, positions, norm_g, mem_norm_g, w_in, mu_rkv, mu_wa, w0, w2, a0, a2, k_k, k_a, r_k,
              lnx_g, lnx_b, q_norm_g, k_norm_g, sinks, xq_norm_g, xk_norm_g, w_mem_kv,
              w_proj_a, w_proj_b, w_proj_c, w_out):
    bsz, t, _ = x.shape
    split_points = [int(i) for i in np.cumsum(IN_SPLITS)[:-1]]
    for l in range(DEPTH):
        h = rms_norm(x, norm_g[l])
        p = h @ w_in[l]
        (p_r, p_k, p_v, p_w, p_a, z_a,
         p_q, p_sk, p_sv, z_b,
         p_xq, z_c, p_gate) = jnp.split(p, split_points, axis=-1)
        y_a = rwkv7_mix(p_r, p_k, p_v, p_w, p_a, mu_rkv[l], mu_wa[l], w0[l], w2[l], a0[l], a2[l],
                        k_k[l], k_a[l], r_k[l], lnx_g[l], lnx_b[l]).astype(x.dtype) * jax.nn.silu(z_a)
        y_b = sliding_window_sink_attn(p_q, p_sk, p_sv, positions, q_norm_g[l], k_norm_g[l],
                                       sinks[l]) * jax.nn.silu(z_b)
        y_c = memory_cross_attn(p_xq, mem, mem_norm_g[l], w_mem_kv[l], xq_norm_g[l],
                                xk_norm_g[l]) * jax.nn.silu(z_c)
        gates = jax.nn.sigmoid(p_gate.astype(jnp.float32)).reshape(bsz, t, N_BRANCHES, D_MODEL)
        merged = (gates[:, :, 0] * (y_a @ w_proj_a[l]) + gates[:, :, 1] * (y_b @ w_proj_b[l])
                  + gates[:, :, 2] * (y_c @ w_proj_c[l]))
        x = x + (merged.astype(x.dtype) @ w_out[l]).astype(x.dtype)
    return x
```

```cpp
#include <hip/hip_runtime.h>
#include <stdint.h>
#include <stdio.h>

#define DI __device__ __forceinline__
typedef unsigned short bf16_t;
typedef short bf16x8 __attribute__((ext_vector_type(8)));
typedef float f32x4 __attribute__((ext_vector_type(4)));

constexpr int BATCH = 2, T = 8192, M = BATCH * T, D = 1024, NIN = 7552, NP = 4608  ;
constexpr int MEMLEN = 256, MM = BATCH * MEMLEN;
constexpr int C_R = 0, C_K = 512, C_V = 1024, C_W = 1536, C_A = 1600, C_ZA = 1664, C_Q = 2176, C_SK = 2688, C_SV = 2816, C_ZB = 2944, C_XQ = 3456, C_ZC = 3968, C_G = 4480;
constexpr int NTHREADS = 512, NWAVES = 8;
constexpr int LDS_BYTES = 147456;

constexpr size_t OFF_CTL = 0;
constexpr size_t OFF_WIN = 65536;
constexpr size_t OFF_WKV = OFF_WIN + (size_t)7680 * 1024 * 2;
constexpr size_t OFF_WPA = OFF_WKV + (size_t)1024 * 1024 * 2;
constexpr size_t OFF_WPB = OFF_WPA + (size_t)1024 * 512 * 2;
constexpr size_t OFF_WPC = OFF_WPB + (size_t)1024 * 512 * 2;
constexpr size_t OFF_WO  = OFF_WPC + (size_t)1024 * 512 * 2;
constexpr size_t OFF_H   = OFF_WO + (size_t)1024 * 1024 * 2;
constexpr size_t OFF_HM  = OFF_H + (size_t)M * 1024 * 2;
constexpr size_t OFF_KVM = OFF_HM + (size_t)MM * 1024 * 2;
constexpr size_t OFF_ROPE = OFF_KVM + (size_t)MM * 1024 * 2;
constexpr size_t OFF_P   = OFF_ROPE + (size_t)M * 32 * 8;
constexpr size_t OFF_YA  = OFF_P + (size_t)M * NP * 2;
constexpr size_t OFF_YB  = OFF_YA + (size_t)M * 512 * 2;
constexpr size_t OFF_YC  = OFF_YB + (size_t)M * 512 * 2;
constexpr size_t WS_END  = OFF_YC + (size_t)M * 512 * 2;
constexpr size_t OFF_SG  = OFF_P;
constexpr size_t OFF_MG  = OFF_P + (size_t)M * 3072 * 2;
static_assert(WS_END <= (size_t)256 * 1024 * 1024, "workspace");
static_assert(OFF_MG + (size_t)M * 1024 * 2 <= OFF_YA, "overlay");

struct Params {
    const float* x; const float* mem; const int* pos; const float* norm_g; const float* mem_norm_g; const float* w_in;
    const float* mu_rkv; const float* mu_wa; const float* w0; const float* w2; const float* a0; const float* a2;
    const float* k_k; const float* k_a; const float* r_k; const float* lnx_g; const float* lnx_b;
    const float* q_norm_g; const float* k_norm_g; const float* sinks; const float* xq_norm_g; const float* xk_norm_g;
    const float* w_mem_kv; const float* w_proj_a; const float* w_proj_b; const float* w_proj_c; const float* w_out;
    float* out; unsigned char* ws;
};

DI bf16_t f2bf(float x) { unsigned u = __float_as_uint(x); u += 0x7fffu + ((u >> 16) & 1u); return (bf16_t)(u >> 16); }
DI float bf2f(bf16_t h) { return __uint_as_float(((unsigned)h) << 16); }
DI float wave_sum(float v) {
#pragma unroll
    for (int o = 32; o > 0; o >>= 1) v += __shfl_xor(v, o, 64);
    return v;
}
DI float wave_max(float v) {
#pragma unroll
    for (int o = 32; o > 0; o >>= 1) v = fmaxf(v, __shfl_xor(v, o, 64));
    return v;
}
DI float sigmoidf_(float x) { return 1.f / (1.f + __expf(-x)); }
DI float siluf_(float x) { return x / (1.f + __expf(-x)); }

DI void transpose_convert(const float* W, int K, int N, bf16_t* Wt, int item, float* tile  ) {
    const int tn = N / 64, kt = item / tn, nt = item % tn, tid = threadIdx.x;
    __syncthreads();
    for (int e = tid; e < 4096; e += NTHREADS) { const int r = e >> 6, c = e & 63; tile[r * 65 + c] = W[(size_t)(kt * 64 + r) * N + nt * 64 + c]; }
    __syncthreads();
    for (int e = tid; e < 4096; e += NTHREADS) { const int n = e >> 6, k = e & 63; Wt[(size_t)(nt * 64 + n) * K + kt * 64 + k] = f2bf(tile[k * 65 + n]); }
}

DI void phase_prologue(const Params& p, unsigned char* lds) {
    float* tile = (float*)lds;
    unsigned char* ws = p.ws;
    const int n_in = (1024 / 64) * (NIN / 64), n_kv = 16 * 16, n_pr = (512 / 64) * 16, n_o = 16 * 16;
    const int total = n_in + n_kv + 3 * n_pr + n_o;
    for (int it = blockIdx.x; it < total; it += gridDim.x) {
        int i = it;
        if (i < n_in) { transpose_convert(p.w_in, 1024, NIN, (bf16_t*)(ws + OFF_WIN), i, tile); continue; } i -= n_in;
        if (i < n_kv) { transpose_convert(p.w_mem_kv, 1024, 1024, (bf16_t*)(ws + OFF_WKV), i, tile); continue; } i -= n_kv;
        if (i < n_pr) { transpose_convert(p.w_proj_a, 512, 1024, (bf16_t*)(ws + OFF_WPA), i, tile); continue; } i -= n_pr;
        if (i < n_pr) { transpose_convert(p.w_proj_b, 512, 1024, (bf16_t*)(ws + OFF_WPB), i, tile); continue; } i -= n_pr;
        if (i < n_pr) { transpose_convert(p.w_proj_c, 512, 1024, (bf16_t*)(ws + OFF_WPC), i, tile); continue; } i -= n_pr;
        transpose_convert(p.w_out, 1024, 1024, (bf16_t*)(ws + OFF_WO), i, tile);
    }
    {
        unsigned* z = (unsigned*)(ws + OFF_WIN + (size_t)NIN * 1024 * 2);
        const int nz = (7680 - NIN) * 1024 / 2;
        for (int i = blockIdx.x * NTHREADS + threadIdx.x; i < nz; i += gridDim.x * NTHREADS) z[i] = 0u;
    }
    const int lane = threadIdx.x & 63, wid = threadIdx.x >> 6;
    for (int row = blockIdx.x * NWAVES + wid; row < M + MM; row += gridDim.x * NWAVES) {
        const float* src = row < M ? p.x + (size_t)row * D : p.mem + (size_t)(row - M) * D;
        const float* g = row < M ? p.norm_g : p.mem_norm_g;
        bf16_t* dst = row < M ? (bf16_t*)(ws + OFF_H) + (size_t)row * D : (bf16_t*)(ws + OFF_HM) + (size_t)(row - M) * D;
        f32x4 v[4]; float ss = 0.f;
#pragma unroll
        for (int i = 0; i < 4; ++i) { v[i] = *(const f32x4*)(src + i * 256 + lane * 4); ss += v[i][0] * v[i][0] + v[i][1] * v[i][1] + v[i][2] * v[i][2] + v[i][3] * v[i][3]; }
        ss = wave_sum(ss);
        const float rs = rsqrtf(ss * (1.f / 1024.f) + 1e-6f);
#pragma unroll
        for (int i = 0; i < 4; ++i) {
            const f32x4 gg = *(const f32x4*)(g + i * 256 + lane * 4);
            ushort4 o; o.x = f2bf(v[i][0] * rs * gg[0]); o.y = f2bf(v[i][1] * rs * gg[1]); o.z = f2bf(v[i][2] * rs * gg[2]); o.w = f2bf(v[i][3] * rs * gg[3]);
            *(ushort4*)(dst + i * 256 + lane * 4) = o;
        }
    }
    float2* rope = (float2*)(ws + OFF_ROPE);
    for (int i = blockIdx.x * NTHREADS + threadIdx.x; i < M * 32; i += gridDim.x * NTHREADS) {
        const int row = i >> 5, f = i & 31;
        const double inv = pow(10000.0, -(double)f / 32.0);
        const double ang = (double)p.pos[row] * inv;
        double s, c; sincos(ang, &s, &c);
        rope[i] = make_float2((float)c, (float)s);
    }
}

struct GemmTile { f32x4 acc[2][4]; };
DI void gemm_tile_k(GemmTile& g, const bf16_t* A, int lda, const bf16_t* Bt, int ldb, int m0, int n0, int K, unsigned char* lds) {
    bf16_t* sA = (bf16_t*)lds;
    bf16_t* sB = sA + 128 * 40;
    const int tid = threadIdx.x, lane = tid & 63, wid = tid >> 6, wm = wid & 3, wn = wid >> 2;
    const int srow = tid >> 2, sch = tid & 3;
    const bf16_t* ga = A + (size_t)(m0 + srow) * lda + sch * 8;
    const bf16_t* gb = Bt + (size_t)(n0 + srow) * ldb + sch * 8;
    const int fr = lane & 15, fq = lane >> 4;
    uint4 ra = *(const uint4*)ga, rb = *(const uint4*)gb;
    for (int k0 = 0; k0 < K; k0 += 32) {
        __syncthreads();
        *(uint4*)(sA + srow * 40 + sch * 8) = ra;
        *(uint4*)(sB + srow * 40 + sch * 8) = rb;
        __syncthreads();
        if (k0 + 32 < K) { ra = *(const uint4*)(ga + k0 + 32); rb = *(const uint4*)(gb + k0 + 32); }
        bf16x8 af[2], bfr[4];
#pragma unroll
        for (int mi = 0; mi < 2; ++mi) af[mi] = *(const bf16x8*)(sA + (wm * 32 + mi * 16 + fr) * 40 + fq * 8);
#pragma unroll
        for (int ni = 0; ni < 4; ++ni) bfr[ni] = *(const bf16x8*)(sB + (wn * 64 + ni * 16 + fr) * 40 + fq * 8);
#pragma unroll
        for (int mi = 0; mi < 2; ++mi)
#pragma unroll
            for (int ni = 0; ni < 4; ++ni) g.acc[mi][ni] = __builtin_amdgcn_mfma_f32_16x16x32_bf16(af[mi], bfr[ni], g.acc[mi][ni], 0, 0, 0);
    }
}
DI void gemm_zero(GemmTile& g) {
#pragma unroll
    for (int mi = 0; mi < 2; ++mi)
#pragma unroll
        for (int ni = 0; ni < 4; ++ni) g.acc[mi][ni] = (f32x4){0.f, 0.f, 0.f, 0.f};
}
#define GEMM_FOREACH(body) do { const int lane_ = threadIdx.x & 63, wid_ = threadIdx.x >> 6, wm_ = wid_ & 3, wn_ = wid_ >> 2, fr_ = lane_ & 15, fq_ = lane_ >> 4; \
    _Pragma("unroll") for (int mi = 0; mi < 2; ++mi) _Pragma("unroll") for (int ni = 0; ni < 4; ++ni) _Pragma("unroll") for (int r = 0; r < 4; ++r) { \
        const int row = m0 + wm_ * 32 + mi * 16 + fq_ * 4 + r, col = n0 + wn_ * 64 + ni * 16 + fr_; body } } while (0)

DI void phase_gemm_in(const Params& p, unsigned char* lds) {
    unsigned char* ws = p.ws;
    const bf16_t* H = (const bf16_t*)(ws + OFF_H); const bf16_t* Wt = (const bf16_t*)(ws + OFF_WIN);
    bf16_t* P = (bf16_t*)(ws + OFF_P);
    const int tn = NP / 128, nt1 = (M / 128) * tn;
    const int tn2 = 1024 / 128, nt2 = (MM / 128) * tn2;
    for (int it = blockIdx.x; it < nt1 + nt2; it += gridDim.x) {
        GemmTile g; gemm_zero(g);
        if (it < nt1) {
            const int m0 = (it / tn) * 128, n0 = (it % tn) * 128;
            gemm_tile_k(g, H, 1024, Wt, 1024, m0, n0, 1024, lds);
            GEMM_FOREACH(P[(size_t)row * NP + col] = f2bf(g.acc[mi][ni][r]););
        } else {
            const int i2 = it - nt1; const int m0 = (i2 / tn2) * 128, n0 = (i2 % tn2) * 128;
            gemm_tile_k(g, (const bf16_t*)(ws + OFF_HM), 1024, (const bf16_t*)(ws + OFF_WKV), 1024, m0, n0, 1024, lds);
            bf16_t* KVM = (bf16_t*)(ws + OFF_KVM);
            GEMM_FOREACH(KVM[(size_t)row * 1024 + col] = f2bf(g.acc[mi][ni][r]););
        }
    }
}

DI void phase_attn_prep(const Params& p, unsigned char* lds) {
    unsigned char* ws = p.ws; bf16_t* P = (bf16_t*)(ws + OFF_P); bf16_t* KVM = (bf16_t*)(ws + OFF_KVM);
    const float2* rope = (const float2*)(ws + OFF_ROPE);
    const int lane = threadIdx.x & 63, wid = threadIdx.x >> 6;
    const long n1 = (long)M * 14, n2 = (long)MM * 4;
    for (long it = (long)blockIdx.x * NWAVES + wid; it < n1 + n2; it += (long)gridDim.x * NWAVES) {
        if (it < n1) {
            const int row = (int)(it / 14), j = (int)(it % 14);
            if (j < 10) {
                bf16_t* ptr = P + (size_t)row * NP + (j < 8 ? C_Q + j * 64 : C_SK + (j - 8) * 64);
                const float g = j < 8 ? p.q_norm_g[lane] : p.k_norm_g[lane];
                const float xv = bf2f(ptr[lane]);
                const float ss = wave_sum(xv * xv);
                const float y = xv * rsqrtf(ss * (1.f / 64.f) + 1e-6f) * g;
                const float yp = __shfl_xor(y, 32, 64);
                const float2 cs = rope[(size_t)row * 32 + (lane & 31)];
                const float o = lane < 32 ? y * cs.x - yp * cs.y : y * cs.x + yp * cs.y;
                ptr[lane] = f2bf(o);
            } else {
                bf16_t* ptr = P + (size_t)row * NP + C_XQ + (j - 10) * 128;
                const float x0 = bf2f(ptr[lane]), x1 = bf2f(ptr[lane + 64]);
                const float ss = wave_sum(x0 * x0 + x1 * x1);
                const float rs = rsqrtf(ss * (1.f / 128.f) + 1e-6f);
                ptr[lane] = f2bf(x0 * rs * p.xq_norm_g[lane]); ptr[lane + 64] = f2bf(x1 * rs * p.xq_norm_g[lane + 64]);
            }
        } else {
            const long i2 = it - n1; const int row = (int)(i2 / 4), j = (int)(i2 % 4);
            bf16_t* ptr = KVM + (size_t)row * 1024 + j * 128;
            const float x0 = bf2f(ptr[lane]), x1 = bf2f(ptr[lane + 64]);
            const float ss = wave_sum(x0 * x0 + x1 * x1);
            const float rs = rsqrtf(ss * (1.f / 128.f) + 1e-6f);
            ptr[lane] = f2bf(x0 * rs * p.xk_norm_g[lane]); ptr[lane + 64] = f2bf(x1 * rs * p.xk_norm_g[lane + 64]);
        }
    }
}

DI void rwkv_stage(const Params& p, int b, int h, int t0, int ntok, float* ck, float* scratch  ) {
    const bf16_t* P = (const bf16_t*)(p.ws + OFF_P);
    const int lane = threadIdx.x & 63, wid = threadIdx.x >> 6, ch = h * 64 + lane;
    const float mu_r = p.mu_rkv[ch], mu_k = p.mu_rkv[512 + ch], mu_v = p.mu_rkv[1024 + ch], mu_w = p.mu_wa[lane], mu_a = p.mu_wa[64 + lane];
    const float w0c = p.w0[ch], a0c = p.a0[ch], kkc = p.k_k[ch], kac = p.k_a[ch];
    float* sc = scratch + wid * 128;
    for (int i = wid; i < ntok; i += NWAVES) {
        const int t = t0 + i; const bf16_t* pr = P + (size_t)(b * T + t) * NP; const bf16_t* pp = pr - NP; const bool hp = t > 0;
        const float rc = bf2f(pr[C_R + ch]), rp = hp ? bf2f(pp[C_R + ch]) : 0.f;
        const float kc = bf2f(pr[C_K + ch]), kp = hp ? bf2f(pp[C_K + ch]) : 0.f;
        const float vc = bf2f(pr[C_V + ch]), vp = hp ? bf2f(pp[C_V + ch]) : 0.f;
        const float wc = bf2f(pr[C_W + lane]), wp = hp ? bf2f(pp[C_W + lane]) : 0.f;
        const float ac = bf2f(pr[C_A + lane]), ap = hp ? bf2f(pp[C_A + lane]) : 0.f;
        const float r = rc + (rp - rc) * mu_r, k = kc + (kp - kc) * mu_k, v = vc + (vp - vc) * mu_v;
        const float lw = wc + (wp - wc) * mu_w, la = ac + (ap - ac) * mu_a;
        sc[lane] = tanhf(lw); sc[64 + lane] = la;
        float accw = 0.f, acca = 0.f;
#pragma unroll 8
        for (int j = 0; j < 64; ++j) { accw += sc[j] * p.w2[j * 512 + ch]; acca += sc[64 + j] * p.a2[j * 512 + ch]; }
        const float xw = -(w0c + accw);
        const float sp = xw > 20.f ? xw : log1pf(expf(xw));
        const float wlog = -sp - 0.5f;
        const float decay = expf(-expf(wlog));
        const float alpha = 1.f / (1.f + expf(-(a0c + acca)));
        const float kk0 = k * kkc;
        const float n2 = wave_sum(kk0 * kk0);
        const float kk = kk0 / fmaxf(sqrtf(n2), 1e-12f);
        const float k2 = k * (1.f + (alpha - 1.f) * kac);
        float* o = ck + i * 384;
        o[lane] = r; o[64 + lane] = decay; o[128 + lane] = k2; o[192 + lane] = v; o[256 + lane] = -kk; o[320 + lane] = kk * alpha;
    }
}

DI void phase_rwkv_direct(const Params& p, unsigned char* lds) {
    float* ck = (float*)lds; float* scratch = ck + 64 * 384;
    const int lane = threadIdx.x & 63, wid = threadIdx.x >> 6;
    const bf16_t* P = (const bf16_t*)(p.ws + OFF_P); bf16_t* YA = (bf16_t*)(p.ws + OFF_YA);
    for (int bh = blockIdx.x; bh < BATCH * 8; bh += gridDim.x) {
        const int b = bh >> 3, h = bh & 7, ch = h * 64 + lane;
        float S[64];
#pragma unroll
        for (int k = 0; k < 64; ++k) S[k] = 0.f;
        const float rk = p.r_k[ch], lg = p.lnx_g[ch], lb = p.lnx_b[ch];
        for (int c = 0; c < T / 64; ++c) {
            __syncthreads();
            rwkv_stage(p, b, h, c * 64, 64, ck, scratch);
            __syncthreads();
            if (wid == 0) {
                for (int i = 0; i < 64; ++i) {
                    const float* cc = ck + i * 384;
                    float sa = 0.f;
#pragma unroll
                    for (int k = 0; k < 64; ++k) sa += S[k] * cc[256 + k];
                    const float vv = cc[192 + lane];
#pragma unroll
                    for (int k = 0; k < 64; ++k) S[k] = S[k] * cc[64 + k] + sa * cc[320 + k] + vv * cc[128 + k];
                    float y = 0.f;
#pragma unroll
                    for (int k = 0; k < 64; ++k) y += S[k] * cc[k];
                    const float mean = wave_sum(y) * (1.f / 64.f);
                    const float dy = y - mean;
                    const float var = wave_sum(dy * dy) * (1.f / 64.f);
                    const float yn = dy * rsqrtf(var + 64e-5f) * lg + lb;
                    const float bonus = wave_sum(cc[lane] * cc[128 + lane] * rk) * vv;
                    const int t = c * 64 + i; const size_t row = (size_t)(b * T + t);
                    const float z = bf2f(P[row * NP + C_ZA + ch]);
                    YA[row * 512 + ch] = f2bf((yn + bonus) * siluf_(z));
                }
            }
        }
    }
}

DI void phase_swa_simple(const Params& p, unsigned char* lds) {
    const bf16_t* P = (const bf16_t*)(p.ws + OFF_P); bf16_t* YB = (bf16_t*)(p.ws + OFF_YB);
    const long total = (long)BATCH * 8 * T;
    for (long it = (long)blockIdx.x * NTHREADS + threadIdx.x; it < total; it += (long)gridDim.x * NTHREADS) {
        const int t = (int)(it % T), qh = (int)((it / T) % 8), b = (int)(it / ((long)T * 8)), kvh = qh >> 2;
        const size_t row = (size_t)(b * T + t);
        float q[64], acc[64];
        {
            const uint4* qp = (const uint4*)(P + row * NP + C_Q + qh * 64);
#pragma unroll
            for (int i = 0; i < 8; ++i) { const uint4 u = qp[i]; const unsigned w[4] = {u.x, u.y, u.z, u.w};
#pragma unroll
                for (int j = 0; j < 4; ++j) { q[i * 8 + j * 2] = __uint_as_float(w[j] << 16); q[i * 8 + j * 2 + 1] = __uint_as_float(w[j] & 0xffff0000u); } }
        }
#pragma unroll
        for (int d = 0; d < 64; ++d) acc[d] = 0.f;
        float m = p.sinks[qh], l = 1.f;
        for (int j = 0; j < 128; ++j) {
            const int s = t - 127 + j;
            if (s < 0) continue;
            const size_t krow = (size_t)(b * T + s) * NP;
            const uint4* kp = (const uint4*)(P + krow + C_SK + kvh * 64);
            float dot = 0.f;
#pragma unroll
            for (int i = 0; i < 8; ++i) { const uint4 u = kp[i]; const unsigned w[4] = {u.x, u.y, u.z, u.w};
#pragma unroll
                for (int jj = 0; jj < 4; ++jj) { dot += q[i * 8 + jj * 2] * __uint_as_float(w[jj] << 16) + q[i * 8 + jj * 2 + 1] * __uint_as_float(w[jj] & 0xffff0000u); } }
            const float sc = dot * 0.125f;
            const float mn = fmaxf(m, sc), corr = __expf(m - mn), pe = __expf(sc - mn);
            l = l * corr + pe; m = mn;
            const uint4* vp = (const uint4*)(P + krow + C_SV + kvh * 64);
#pragma unroll
            for (int i = 0; i < 8; ++i) { const uint4 u = vp[i]; const unsigned w[4] = {u.x, u.y, u.z, u.w};
#pragma unroll
                for (int jj = 0; jj < 4; ++jj) { acc[i * 8 + jj * 2] = acc[i * 8 + jj * 2] * corr + pe * __uint_as_float(w[jj] << 16);
                                                 acc[i * 8 + jj * 2 + 1] = acc[i * 8 + jj * 2 + 1] * corr + pe * __uint_as_float(w[jj] & 0xffff0000u); } }
        }
        const float inv = 1.f / l;
        const bf16_t* zp = P + row * NP + C_ZB + qh * 64; bf16_t* op = YB + row * 512 + qh * 64;
#pragma unroll
        for (int d = 0; d < 64; ++d) op[d] = f2bf(acc[d] * inv * siluf_(bf2f(zp[d])));
    }
}

DI void phase_xattn_simple(const Params& p, unsigned char* lds) {
    const bf16_t* P = (const bf16_t*)(p.ws + OFF_P); const bf16_t* KVM = (const bf16_t*)(p.ws + OFF_KVM); bf16_t* YC = (bf16_t*)(p.ws + OFF_YC);
    const int lane = threadIdx.x & 63, wid = threadIdx.x >> 6;
    const long total = (long)M * 4;
    const float scale = 0.08838834764831845f;
    for (long it = (long)blockIdx.x * NWAVES + wid; it < total; it += (long)gridDim.x * NWAVES) {
        const int row = (int)(it >> 2), hd = (int)(it & 3), b = row / T;
        const bf16_t* qp = P + (size_t)row * NP + C_XQ + hd * 128;
        const bf16_t* kb = KVM + (size_t)(b * MEMLEN) * 1024 + hd * 128;
        float s[4] = {0.f, 0.f, 0.f, 0.f};
        for (int c = 0; c < 16; ++c) {
            const uint4 qu = *(const uint4*)(qp + c * 8); const unsigned qw[4] = {qu.x, qu.y, qu.z, qu.w};
#pragma unroll
            for (int i = 0; i < 4; ++i) {
                const uint4 ku = *(const uint4*)(kb + (size_t)(lane + 64 * i) * 1024 + c * 8); const unsigned kw[4] = {ku.x, ku.y, ku.z, ku.w};
#pragma unroll
                for (int j = 0; j < 4; ++j) s[i] += __uint_as_float(qw[j] << 16) * __uint_as_float(kw[j] << 16) + __uint_as_float(qw[j] & 0xffff0000u) * __uint_as_float(kw[j] & 0xffff0000u);
            }
        }
        float mx = -1e30f;
#pragma unroll
        for (int i = 0; i < 4; ++i) { s[i] *= scale; mx = fmaxf(mx, s[i]); }
        mx = wave_max(mx);
        float pe[4], sum = 0.f;
#pragma unroll
        for (int i = 0; i < 4; ++i) { pe[i] = __expf(s[i] - mx); sum += pe[i]; }
        sum = wave_sum(sum);
        const float inv = 1.f / sum;
        float o0 = 0.f, o1 = 0.f;
        const bf16_t* vb = kb + 512;
#pragma unroll
        for (int i = 0; i < 4; ++i)
            for (int mm = 0; mm < 64; ++mm) {
                const float pv = __shfl(pe[i], mm, 64);
                const bf16_t* vr = vb + (size_t)(mm + 64 * i) * 1024;
                o0 += pv * bf2f(vr[lane]); o1 += pv * bf2f(vr[lane + 64]);
            }
        const bf16_t* zp = P + (size_t)row * NP + C_ZC + hd * 128; bf16_t* op = YC + (size_t)row * 512 + hd * 128;
        op[lane] = f2bf(o0 * inv * siluf_(bf2f(zp[lane]))); op[lane + 64] = f2bf(o1 * inv * siluf_(bf2f(zp[lane + 64])));
    }
}

DI void phase_gemm_gate(const Params& p, unsigned char* lds) {
    unsigned char* ws = p.ws;
    const bf16_t* H = (const bf16_t*)(ws + OFF_H); const bf16_t* Wt = (const bf16_t*)(ws + OFF_WIN) + (size_t)C_G * 1024;
    bf16_t* SG = (bf16_t*)(ws + OFF_SG);
    const int tn = 3072 / 128, nt = (M / 128) * tn;
    for (int it = blockIdx.x; it < nt; it += gridDim.x) {
        GemmTile g; gemm_zero(g);
        const int m0 = (it / tn) * 128, n0 = (it % tn) * 128;
        gemm_tile_k(g, H, 1024, Wt, 1024, m0, n0, 1024, lds);
        GEMM_FOREACH(SG[(size_t)row * 3072 + col] = f2bf(sigmoidf_(g.acc[mi][ni][r])););
    }
}
DI void phase_gemm_proj(const Params& p, unsigned char* lds) {
    unsigned char* ws = p.ws;
    const bf16_t* SG = (const bf16_t*)(ws + OFF_SG); bf16_t* MG = (bf16_t*)(ws + OFF_MG);
    const int tn = 1024 / 128, nt = (M / 128) * tn;
    for (int it = blockIdx.x; it < nt; it += gridDim.x) {
        const int m0 = (it / tn) * 128, n0 = (it % tn) * 128;
        GemmTile mg; gemm_zero(mg);
#pragma unroll 1
        for (int br = 0; br < 3; ++br) {
            GemmTile g; gemm_zero(g);
            const bf16_t* Y = (const bf16_t*)(ws + (br == 0 ? OFF_YA : br == 1 ? OFF_YB : OFF_YC));
            const bf16_t* W = (const bf16_t*)(ws + (br == 0 ? OFF_WPA : br == 1 ? OFF_WPB : OFF_WPC));
            gemm_tile_k(g, Y, 512, W, 512, m0, n0, 512, lds);
            GEMM_FOREACH(mg.acc[mi][ni][r] += bf2f(SG[(size_t)row * 3072 + br * 1024 + col]) * g.acc[mi][ni][r];);
        }
        GEMM_FOREACH(MG[(size_t)row * 1024 + col] = f2bf(mg.acc[mi][ni][r]););
    }
}
DI void phase_gemm_out(const Params& p, unsigned char* lds) {
    unsigned char* ws = p.ws;
    const bf16_t* MG = (const bf16_t*)(ws + OFF_MG); const bf16_t* W = (const bf16_t*)(ws + OFF_WO);
    const int tn = 1024 / 128, nt = (M / 128) * tn;
    for (int it = blockIdx.x; it < nt; it += gridDim.x) {
        GemmTile g; gemm_zero(g);
        const int m0 = (it / tn) * 128, n0 = (it % tn) * 128;
        gemm_tile_k(g, MG, 1024, W, 1024, m0, n0, 1024, lds);
        GEMM_FOREACH(p.out[(size_t)row * 1024 + col] = p.x[(size_t)row * 1024 + col] + g.acc[mi][ni][r];);
    }
}

template <int PH> __global__ void __launch_bounds__(NTHREADS, 2) k_phase(Params p) {
    extern __shared__ __attribute__((aligned(16))) unsigned char lds[];
    if (PH == 0) phase_prologue(p, lds);
    if (PH == 1) phase_gemm_in(p, lds);
    if (PH == 2) phase_attn_prep(p, lds);
    if (PH == 3) phase_rwkv_direct(p, lds);
    if (PH == 4) phase_swa_simple(p, lds);
    if (PH == 5) phase_xattn_simple(p, lds);
    if (PH == 6) phase_gemm_gate(p, lds);
    if (PH == 7) phase_gemm_proj(p, lds);
    if (PH == 8) phase_gemm_out(p, lds);
}

template <int PH> static void launch_phase(const Params& p, int grid, hipStream_t stream) {
    static bool attr = false;
    if (!attr) { (void)hipFuncSetAttribute((const void*)k_phase<PH>, hipFuncAttributeMaxDynamicSharedMemorySize, LDS_BYTES); attr = true; }
    hipLaunchKernelGGL(k_phase<PH>, dim3(grid), dim3(NTHREADS), LDS_BYTES, stream, p);
}

extern "C" void kernel_launch(void* const* d_in, const int* in_sizes, int n_in, void* d_out, int out_size, void* d_ws, size_t ws_size, hipStream_t stream) {
    if (n_in != 27 || ws_size < WS_END) { fprintf(stderr, "kernel_launch: unexpected inputs (n_in %d, ws %zu)\n", n_in, ws_size); return; }
    Params p{};
    p.x = (const float*)d_in[0]; p.mem = (const float*)d_in[1]; p.pos = (const int*)d_in[2]; p.norm_g = (const float*)d_in[3]; p.mem_norm_g = (const float*)d_in[4];
    p.w_in = (const float*)d_in[5]; p.mu_rkv = (const float*)d_in[6]; p.mu_wa = (const float*)d_in[7]; p.w0 = (const float*)d_in[8]; p.w2 = (const float*)d_in[9];
    p.a0 = (const float*)d_in[10]; p.a2 = (const float*)d_in[11]; p.k_k = (const float*)d_in[12]; p.k_a = (const float*)d_in[13]; p.r_k = (const float*)d_in[14];
    p.lnx_g = (const float*)d_in[15]; p.lnx_b = (const float*)d_in[16]; p.q_norm_g = (const float*)d_in[17]; p.k_norm_g = (const float*)d_in[18]; p.sinks = (const float*)d_in[19];
    p.xq_norm_g = (const float*)d_in[20]; p.xk_norm_g = (const float*)d_in[21]; p.w_mem_kv = (const float*)d_in[22]; p.w_proj_a = (const float*)d_in[23];
    p.w_proj_b = (const float*)d_in[24]; p.w_proj_c = (const float*)d_in[25]; p.w_out = (const float*)d_in[26];
    p.out = (float*)d_out; p.ws = (unsigned char*)d_ws;
    const int G = 256;
    launch_phase<0>(p, G, stream);
    launch_phase<1>(p, G, stream);
    launch_phase<2>(p, G, stream);
    launch_phase<3>(p, 16, stream);
    launch_phase<4>(p, G, stream);
    launch_phase<5>(p, G, stream);
    launch_phase<6>(p, G, stream);
    launch_phase<7>(p, G, stream);
    launch_phase<8>(p, G, stream);
}
```

```cpp
#include <hip/hip_runtime.h>
#include <stdint.h>
#include <stdio.h>

#define DI __device__ __forceinline__
typedef unsigned short bf16_t;
typedef short bf16x8 __attribute__((ext_vector_type(8)));
typedef float f32x4 __attribute__((ext_vector_type(4)));

constexpr int BATCH = 2, T = 8192, M = BATCH * T, D = 1024, NIN = 7552, NP = 4608  ;
constexpr int MEMLEN = 256, MM = BATCH * MEMLEN;
constexpr int C_R = 0, C_K = 512, C_V = 1024, C_W = 1536, C_A = 1600, C_ZA = 1664, C_Q = 2176, C_SK = 2688, C_SV = 2816, C_ZB = 2944, C_XQ = 3456, C_ZC = 3968, C_G = 4480;
constexpr int NTHREADS = 512, NWAVES = 8;
constexpr int LDS_BYTES = 147456;

constexpr size_t OFF_CTL = 0;
constexpr size_t OFF_WIN = 65536;
constexpr size_t OFF_WKV = OFF_WIN + (size_t)7680 * 1024 * 2;
constexpr size_t OFF_WPA = OFF_WKV + (size_t)1024 * 1024 * 2;
constexpr size_t OFF_WPB = OFF_WPA + (size_t)1024 * 512 * 2;
constexpr size_t OFF_WPC = OFF_WPB + (size_t)1024 * 512 * 2;
constexpr size_t OFF_WO  = OFF_WPC + (size_t)1024 * 512 * 2;
constexpr size_t OFF_H   = OFF_WO + (size_t)1024 * 1024 * 2;
constexpr size_t OFF_HM  = OFF_H + (size_t)M * 1024 * 2;
constexpr size_t OFF_KVM = OFF_HM + (size_t)MM * 1024 * 2;
constexpr size_t OFF_ROPE = OFF_KVM + (size_t)MM * 1024 * 2;
constexpr size_t OFF_P   = OFF_ROPE + (size_t)M * 32 * 8;
constexpr size_t OFF_YA  = OFF_P + (size_t)M * NP * 2;
constexpr size_t OFF_YB  = OFF_YA + (size_t)M * 512 * 2;
constexpr size_t OFF_YC  = OFF_YB + (size_t)M * 512 * 2;
constexpr size_t WS_END  = OFF_YC + (size_t)M * 512 * 2;
constexpr size_t OFF_SG  = OFF_P;
constexpr size_t OFF_MG  = OFF_P + (size_t)M * 3072 * 2;
static_assert(WS_END <= (size_t)256 * 1024 * 1024, "workspace");
static_assert(OFF_MG + (size_t)M * 1024 * 2 <= OFF_YA, "overlay");

struct Params {
    const float* x; const float* mem; const int* pos; const float* norm_g; const float* mem_norm_g; const float* w_in;
    const float* mu_rkv; const float* mu_wa; const float* w0; const float* w2; const float* a0; const float* a2;
    const float* k_k; const float* k_a; const float* r_k; const float* lnx_g; const float* lnx_b;
    const float* q_norm_g; const float* k_norm_g; const float* sinks; const float* xq_norm_g; const float* xk_norm_g;
    const float* w_mem_kv; const float* w_proj_a; const float* w_proj_b; const float* w_proj_c; const float* w_out;
    float* out; unsigned char* ws;
};

DI bf16_t f2bf(float x) { unsigned u = __float_as_uint(x); u += 0x7fffu + ((u >> 16) & 1u); return (bf16_t)(u >> 16); }
DI float bf2f(bf16_t h) { return __uint_as_float(((unsigned)h) << 16); }
DI float wave_sum(float v) {
#pragma unroll
    for (int o = 32; o > 0; o >>= 1) v += __shfl_xor(v, o, 64);
    return v;
}
DI float wave_max(float v) {
#pragma unroll
    for (int o = 32; o > 0; o >>= 1) v = fmaxf(v, __shfl_xor(v, o, 64));
    return v;
}
DI float sigmoidf_(float x) { return 1.f / (1.f + __expf(-x)); }
DI float siluf_(float x) { return x / (1.f + __expf(-x)); }

DI void transpose_convert(const float* W, int K, int N, bf16_t* Wt, int item, float* tile  ) {
    const int tn = N / 64, kt = item / tn, nt = item % tn, tid = threadIdx.x;
    __syncthreads();
    for (int e = tid; e < 4096; e += NTHREADS) { const int r = e >> 6, c = e & 63; tile[r * 65 + c] = W[(size_t)(kt * 64 + r) * N + nt * 64 + c]; }
    __syncthreads();
    for (int e = tid; e < 4096; e += NTHREADS) { const int n = e >> 6, k = e & 63; Wt[(size_t)(nt * 64 + n) * K + kt * 64 + k] = f2bf(tile[k * 65 + n]); }
}

DI void phase_prologue(const Params& p, unsigned char* lds, const int bid, const int nb) {
    float* tile = (float*)lds;
    unsigned char* ws = p.ws;
    const int n_in = (1024 / 64) * (NIN / 64), n_kv = 16 * 16, n_pr = (512 / 64) * 16, n_o = 16 * 16;
    const int total = n_in + n_kv + 3 * n_pr + n_o;
    for (int it = bid; it < total; it += nb) {
        int i = it;
        if (i < n_in) { transpose_convert(p.w_in, 1024, NIN, (bf16_t*)(ws + OFF_WIN), i, tile); continue; } i -= n_in;
        if (i < n_kv) { transpose_convert(p.w_mem_kv, 1024, 1024, (bf16_t*)(ws + OFF_WKV), i, tile); continue; } i -= n_kv;
        if (i < n_pr) { transpose_convert(p.w_proj_a, 512, 1024, (bf16_t*)(ws + OFF_WPA), i, tile); continue; } i -= n_pr;
        if (i < n_pr) { transpose_convert(p.w_proj_b, 512, 1024, (bf16_t*)(ws + OFF_WPB), i, tile); continue; } i -= n_pr;
        if (i < n_pr) { transpose_convert(p.w_proj_c, 512, 1024, (bf16_t*)(ws + OFF_WPC), i, tile); continue; } i -= n_pr;
        transpose_convert(p.w_out, 1024, 1024, (bf16_t*)(ws + OFF_WO), i, tile);
    }
    {
        unsigned* z = (unsigned*)(ws + OFF_WIN + (size_t)NIN * 1024 * 2);
        const int nz = (7680 - NIN) * 1024 / 2;
        for (int i = bid * NTHREADS + threadIdx.x; i < nz; i += nb * NTHREADS) z[i] = 0u;
    }
    const int lane = threadIdx.x & 63, wid = threadIdx.x >> 6;
    for (int row = bid * NWAVES + wid; row < M + MM; row += nb * NWAVES) {
        const float* src = row < M ? p.x + (size_t)row * D : p.mem + (size_t)(row - M) * D;
        const float* g = row < M ? p.norm_g : p.mem_norm_g;
        bf16_t* dst = row < M ? (bf16_t*)(ws + OFF_H) + (size_t)row * D : (bf16_t*)(ws + OFF_HM) + (size_t)(row - M) * D;
        f32x4 v[4]; float ss = 0.f;
#pragma unroll
        for (int i = 0; i < 4; ++i) { v[i] = *(const f32x4*)(src + i * 256 + lane * 4); ss += v[i][0] * v[i][0] + v[i][1] * v[i][1] + v[i][2] * v[i][2] + v[i][3] * v[i][3]; }
        ss = wave_sum(ss);
        const float rs = rsqrtf(ss * (1.f / 1024.f) + 1e-6f);
#pragma unroll
        for (int i = 0; i < 4; ++i) {
            const f32x4 gg = *(const f32x4*)(g + i * 256 + lane * 4);
            ushort4 o; o.x = f2bf(v[i][0] * rs * gg[0]); o.y = f2bf(v[i][1] * rs * gg[1]); o.z = f2bf(v[i][2] * rs * gg[2]); o.w = f2bf(v[i][3] * rs * gg[3]);
            *(ushort4*)(dst + i * 256 + lane * 4) = o;
        }
    }
    float2* rope = (float2*)(ws + OFF_ROPE);
    for (int i = bid * NTHREADS + threadIdx.x; i < M * 32; i += nb * NTHREADS) {
        const int row = i >> 5, f = i & 31;
        const double inv = pow(10000.0, -(double)f / 32.0);
        const double ang = (double)p.pos[row] * inv;
        double s, c; sincos(ang, &s, &c);
        rope[i] = make_float2((float)c, (float)s);
    }
}

struct GemmTile { f32x4 acc[2][4]; };
DI void gemm_tile_k(GemmTile& g, const bf16_t* A, int lda, const bf16_t* Bt, int ldb, int m0, int n0, int K, unsigned char* lds) {
    bf16_t* sA = (bf16_t*)lds;
    bf16_t* sB = sA + 128 * 40;
    const int tid = threadIdx.x, lane = tid & 63, wid = tid >> 6, wm = wid & 3, wn = wid >> 2;
    const int srow = tid >> 2, sch = tid & 3;
    const bf16_t* ga = A + (size_t)(m0 + srow) * lda + sch * 8;
    const bf16_t* gb = Bt + (size_t)(n0 + srow) * ldb + sch * 8;
    const int fr = lane & 15, fq = lane >> 4;
    uint4 ra = *(const uint4*)ga, rb = *(const uint4*)gb;
    for (int k0 = 0; k0 < K; k0 += 32) {
        __syncthreads();
        *(uint4*)(sA + srow * 40 + sch * 8) = ra;
        *(uint4*)(sB + srow * 40 + sch * 8) = rb;
        __syncthreads();
        if (k0 + 32 < K) { ra = *(const uint4*)(ga + k0 + 32); rb = *(const uint4*)(gb + k0 + 32); }
        bf16x8 af[2], bfr[4];
#pragma unroll
        for (int mi = 0; mi < 2; ++mi) af[mi] = *(const bf16x8*)(sA + (wm * 32 + mi * 16 + fr) * 40 + fq * 8);
#pragma unroll
        for (int ni = 0; ni < 4; ++ni) bfr[ni] = *(const bf16x8*)(sB + (wn * 64 + ni * 16 + fr) * 40 + fq * 8);
#pragma unroll
        for (int mi = 0; mi < 2; ++mi)
#pragma unroll
            for (int ni = 0; ni < 4; ++ni) g.acc[mi][ni] = __builtin_amdgcn_mfma_f32_16x16x32_bf16(af[mi], bfr[ni], g.acc[mi][ni], 0, 0, 0);
    }
}
DI void gemm_zero(GemmTile& g) {
#pragma unroll
    for (int mi = 0; mi < 2; ++mi)
#pragma unroll
        for (int ni = 0; ni < 4; ++ni) g.acc[mi][ni] = (f32x4){0.f, 0.f, 0.f, 0.f};
}
#define GEMM_FOREACH(body) do { const int lane_ = threadIdx.x & 63, wid_ = threadIdx.x >> 6, wm_ = wid_ & 3, wn_ = wid_ >> 2, fr_ = lane_ & 15, fq_ = lane_ >> 4; \
    _Pragma("unroll") for (int mi = 0; mi < 2; ++mi) _Pragma("unroll") for (int ni = 0; ni < 4; ++ni) _Pragma("unroll") for (int r = 0; r < 4; ++r) { \
        const int row = m0 + wm_ * 32 + mi * 16 + fq_ * 4 + r, col = n0 + wn_ * 64 + ni * 16 + fr_; body } } while (0)

DI void phase_gemm_in(const Params& p, unsigned char* lds, const int bid, const int nb) {
    unsigned char* ws = p.ws;
    const bf16_t* H = (const bf16_t*)(ws + OFF_H); const bf16_t* Wt = (const bf16_t*)(ws + OFF_WIN);
    bf16_t* P = (bf16_t*)(ws + OFF_P);
    const int tn = NP / 128, nt1 = (M / 128) * tn;
    const int tn2 = 1024 / 128, nt2 = (MM / 128) * tn2;
    for (int it = bid; it < nt1 + nt2; it += nb) {
        GemmTile g; gemm_zero(g);
        if (it < nt1) {
            const int m0 = (it / tn) * 128, n0 = (it % tn) * 128;
            gemm_tile_k(g, H, 1024, Wt, 1024, m0, n0, 1024, lds);
            GEMM_FOREACH(P[(size_t)row * NP + col] = f2bf(g.acc[mi][ni][r]););
        } else {
            const int i2 = it - nt1; const int m0 = (i2 / tn2) * 128, n0 = (i2 % tn2) * 128;
            gemm_tile_k(g, (const bf16_t*)(ws + OFF_HM), 1024, (const bf16_t*)(ws + OFF_WKV), 1024, m0, n0, 1024, lds);
            bf16_t* KVM = (bf16_t*)(ws + OFF_KVM);
            GEMM_FOREACH(KVM[(size_t)row * 1024 + col] = f2bf(g.acc[mi][ni][r]););
        }
    }
}

DI void phase_attn_prep(const Params& p, unsigned char* lds, const int bid, const int nb) {
    unsigned char* ws = p.ws; bf16_t* P = (bf16_t*)(ws + OFF_P); bf16_t* KVM = (bf16_t*)(ws + OFF_KVM);
    const float2* rope = (const float2*)(ws + OFF_ROPE);
    const int lane = threadIdx.x & 63, wid = threadIdx.x >> 6;
    const long n1 = (long)M * 14, n2 = (long)MM * 4;
    for (long it = (long)bid * NWAVES + wid; it < n1 + n2; it += (long)nb * NWAVES) {
        if (it < n1) {
            const int row = (int)(it / 14), j = (int)(it % 14);
            if (j < 10) {
                bf16_t* ptr = P + (size_t)row * NP + (j < 8 ? C_Q + j * 64 : C_SK + (j - 8) * 64);
                const float g = j < 8 ? p.q_norm_g[lane] : p.k_norm_g[lane];
                const float xv = bf2f(ptr[lane]);
                const float ss = wave_sum(xv * xv);
                const float y = xv * rsqrtf(ss * (1.f / 64.f) + 1e-6f) * g;
                const float yp = __shfl_xor(y, 32, 64);
                const float2 cs = rope[(size_t)row * 32 + (lane & 31)];
                const float o = lane < 32 ? y * cs.x - yp * cs.y : y * cs.x + yp * cs.y;
                ptr[lane] = f2bf(o);
            } else {
                bf16_t* ptr = P + (size_t)row * NP + C_XQ + (j - 10) * 128;
                const float x0 = bf2f(ptr[lane]), x1 = bf2f(ptr[lane + 64]);
                const float ss = wave_sum(x0 * x0 + x1 * x1);
                const float rs = rsqrtf(ss * (1.f / 128.f) + 1e-6f);
                ptr[lane] = f2bf(x0 * rs * p.xq_norm_g[lane]); ptr[lane + 64] = f2bf(x1 * rs * p.xq_norm_g[lane + 64]);
            }
        } else {
            const long i2 = it - n1; const int row = (int)(i2 / 4), j = (int)(i2 % 4);
            bf16_t* ptr = KVM + (size_t)row * 1024 + j * 128;
            const float x0 = bf2f(ptr[lane]), x1 = bf2f(ptr[lane + 64]);
            const float ss = wave_sum(x0 * x0 + x1 * x1);
            const float rs = rsqrtf(ss * (1.f / 128.f) + 1e-6f);
            ptr[lane] = f2bf(x0 * rs * p.xk_norm_g[lane]); ptr[lane + 64] = f2bf(x1 * rs * p.xk_norm_g[lane + 64]);
        }
    }
}

DI void rwkv_stage(const Params& p, int b, int h, int t0, int ntok, float* ck, float* scratch  ) {
    const bf16_t* P = (const bf16_t*)(p.ws + OFF_P);
    const int lane = threadIdx.x & 63, wid = threadIdx.x >> 6, ch = h * 64 + lane;
    const float mu_r = p.mu_rkv[ch], mu_k = p.mu_rkv[512 + ch], mu_v = p.mu_rkv[1024 + ch], mu_w = p.mu_wa[lane], mu_a = p.mu_wa[64 + lane];
    const float w0c = p.w0[ch], a0c = p.a0[ch], kkc = p.k_k[ch], kac = p.k_a[ch];
    float* sc = scratch + wid * 128;
    for (int i = wid; i < ntok; i += NWAVES) {
        const int t = t0 + i; const bf16_t* pr = P + (size_t)(b * T + t) * NP; const bf16_t* pp = pr - NP; const bool hp = t > 0;
        const float rc = bf2f(pr[C_R + ch]), rp = hp ? bf2f(pp[C_R + ch]) : 0.f;
        const float kc = bf2f(pr[C_K + ch]), kp = hp ? bf2f(pp[C_K + ch]) : 0.f;
        const float vc = bf2f(pr[C_V + ch]), vp = hp ? bf2f(pp[C_V + ch]) : 0.f;
        const float wc = bf2f(pr[C_W + lane]), wp = hp ? bf2f(pp[C_W + lane]) : 0.f;
        const float ac = bf2f(pr[C_A + lane]), ap = hp ? bf2f(pp[C_A + lane]) : 0.f;
        const float r = rc + (rp - rc) * mu_r, k = kc + (kp - kc) * mu_k, v = vc + (vp - vc) * mu_v;
        const float lw = wc + (wp - wc) * mu_w, la = ac + (ap - ac) * mu_a;
        sc[lane] = tanhf(lw); sc[64 + lane] = la;
        float accw = 0.f, acca = 0.f;
#pragma unroll 8
        for (int j = 0; j < 64; ++j) { accw += sc[j] * p.w2[j * 512 + ch]; acca += sc[64 + j] * p.a2[j * 512 + ch]; }
        const float xw = -(w0c + accw);
        const float sp = xw > 20.f ? xw : log1pf(expf(xw));
        const float wlog = -sp - 0.5f;
        const float decay = expf(-expf(wlog));
        const float alpha = 1.f / (1.f + expf(-(a0c + acca)));
        const float kk0 = k * kkc;
        const float n2 = wave_sum(kk0 * kk0);
        const float kk = kk0 / fmaxf(sqrtf(n2), 1e-12f);
        const float k2 = k * (1.f + (alpha - 1.f) * kac);
        float* o = ck + i * 384;
        o[lane] = r; o[64 + lane] = decay; o[128 + lane] = k2; o[192 + lane] = v; o[256 + lane] = -kk; o[320 + lane] = kk * alpha;
    }
}

DI void phase_rwkv_direct(const Params& p, unsigned char* lds, const int bid, const int nb) {
    float* ck = (float*)lds; float* scratch = ck + 64 * 384;
    const int lane = threadIdx.x & 63, wid = threadIdx.x >> 6;
    const bf16_t* P = (const bf16_t*)(p.ws + OFF_P); bf16_t* YA = (bf16_t*)(p.ws + OFF_YA);
    for (int bh = bid; bh < BATCH * 8; bh += nb) {
        const int b = bh >> 3, h = bh & 7, ch = h * 64 + lane;
        float S[64];
#pragma unroll
        for (int k = 0; k < 64; ++k) S[k] = 0.f;
        const float rk = p.r_k[ch], lg = p.lnx_g[ch], lb = p.lnx_b[ch];
        for (int c = 0; c < T / 64; ++c) {
            __syncthreads();
            rwkv_stage(p, b, h, c * 64, 64, ck, scratch);
            __syncthreads();
            if (wid == 0) {
                for (int i = 0; i < 64; ++i) {
                    const float* cc = ck + i * 384;
                    float sa = 0.f;
#pragma unroll
                    for (int k = 0; k < 64; ++k) sa += S[k] * cc[256 + k];
                    const float vv = cc[192 + lane];
#pragma unroll
                    for (int k = 0; k < 64; ++k) S[k] = S[k] * cc[64 + k] + sa * cc[320 + k] + vv * cc[128 + k];
                    float y = 0.f;
#pragma unroll
                    for (int k = 0; k < 64; ++k) y += S[k] * cc[k];
                    const float mean = wave_sum(y) * (1.f / 64.f);
                    const float dy = y - mean;
                    const float var = wave_sum(dy * dy) * (1.f / 64.f);
                    const float yn = dy * rsqrtf(var + 64e-5f) * lg + lb;
                    const float bonus = wave_sum(cc[lane] * cc[128 + lane] * rk) * vv;
                    const int t = c * 64 + i; const size_t row = (size_t)(b * T + t);
                    const float z = bf2f(P[row * NP + C_ZA + ch]);
                    YA[row * 512 + ch] = f2bf((yn + bonus) * siluf_(z));
                }
            }
        }
    }
}

DI void phase_swa_simple(const Params& p, unsigned char* lds, const int bid, const int nb) {
    const bf16_t* P = (const bf16_t*)(p.ws + OFF_P); bf16_t* YB = (bf16_t*)(p.ws + OFF_YB);
    const long total = (long)BATCH * 8 * T;
    for (long it = (long)bid * NTHREADS + threadIdx.x; it < total; it += (long)nb * NTHREADS) {
        const int t = (int)(it % T), qh = (int)((it / T) % 8), b = (int)(it / ((long)T * 8)), kvh = qh >> 2;
        const size_t row = (size_t)(b * T + t);
        float q[64], acc[64];
        {
            const uint4* qp = (const uint4*)(P + row * NP + C_Q + qh * 64);
#pragma unroll
            for (int i = 0; i < 8; ++i) { const uint4 u = qp[i]; const unsigned w[4] = {u.x, u.y, u.z, u.w};
#pragma unroll
                for (int j = 0; j < 4; ++j) { q[i * 8 + j * 2] = __uint_as_float(w[j] << 16); q[i * 8 + j * 2 + 1] = __uint_as_float(w[j] & 0xffff0000u); } }
        }
#pragma unroll
        for (int d = 0; d < 64; ++d) acc[d] = 0.f;
        float m = p.sinks[qh], l = 1.f;
        for (int j = 0; j < 128; ++j) {
            const int s = t - 127 + j;
            if (s < 0) continue;
            const size_t krow = (size_t)(b * T + s) * NP;
            const uint4* kp = (const uint4*)(P + krow + C_SK + kvh * 64);
            float dot = 0.f;
#pragma unroll
            for (int i = 0; i < 8; ++i) { const uint4 u = kp[i]; const unsigned w[4] = {u.x, u.y, u.z, u.w};
#pragma unroll
                for (int jj = 0; jj < 4; ++jj) { dot += q[i * 8 + jj * 2] * __uint_as_float(w[jj] << 16) + q[i * 8 + jj * 2 + 1] * __uint_as_float(w[jj] & 0xffff0000u); } }
            const float sc = dot * 0.125f;
            const float mn = fmaxf(m, sc), corr = __expf(m - mn), pe = __expf(sc - mn);
            l = l * corr + pe; m = mn;
            const uint4* vp = (const uint4*)(P + krow + C_SV + kvh * 64);
#pragma unroll
            for (int i = 0; i < 8; ++i) { const uint4 u = vp[i]; const unsigned w[4] = {u.x, u.y, u.z, u.w};
#pragma unroll
                for (int jj = 0; jj < 4; ++jj) { acc[i * 8 + jj * 2] = acc[i * 8 + jj * 2] * corr + pe * __uint_as_float(w[jj] << 16);
                                                 acc[i * 8 + jj * 2 + 1] = acc[i * 8 + jj * 2 + 1] * corr + pe * __uint_as_float(w[jj] & 0xffff0000u); } }
        }
        const float inv = 1.f / l;
        const bf16_t* zp = P + row * NP + C_ZB + qh * 64; bf16_t* op = YB + row * 512 + qh * 64;
#pragma unroll
        for (int d = 0; d < 64; ++d) op[d] = f2bf(acc[d] * inv * siluf_(bf2f(zp[d])));
    }
}

DI void phase_xattn_simple(const Params& p, unsigned char* lds, const int bid, const int nb) {
    const bf16_t* P = (const bf16_t*)(p.ws + OFF_P); const bf16_t* KVM = (const bf16_t*)(p.ws + OFF_KVM); bf16_t* YC = (bf16_t*)(p.ws + OFF_YC);
    const int lane = threadIdx.x & 63, wid = threadIdx.x >> 6;
    const long total = (long)M * 4;
    const float scale = 0.08838834764831845f;
    for (long it = (long)bid * NWAVES + wid; it < total; it += (long)nb * NWAVES) {
        const int row = (int)(it >> 2), hd = (int)(it & 3), b = row / T;
        const bf16_t* qp = P + (size_t)row * NP + C_XQ + hd * 128;
        const bf16_t* kb = KVM + (size_t)(b * MEMLEN) * 1024 + hd * 128;
        float s[4] = {0.f, 0.f, 0.f, 0.f};
        for (int c = 0; c < 16; ++c) {
            const uint4 qu = *(const uint4*)(qp + c * 8); const unsigned qw[4] = {qu.x, qu.y, qu.z, qu.w};
#pragma unroll
            for (int i = 0; i < 4; ++i) {
                const uint4 ku = *(const uint4*)(kb + (size_t)(lane + 64 * i) * 1024 + c * 8); const unsigned kw[4] = {ku.x, ku.y, ku.z, ku.w};
#pragma unroll
                for (int j = 0; j < 4; ++j) s[i] += __uint_as_float(qw[j] << 16) * __uint_as_float(kw[j] << 16) + __uint_as_float(qw[j] & 0xffff0000u) * __uint_as_float(kw[j] & 0xffff0000u);
            }
        }
        float mx = -1e30f;
#pragma unroll
        for (int i = 0; i < 4; ++i) { s[i] *= scale; mx = fmaxf(mx, s[i]); }
        mx = wave_max(mx);
        float pe[4], sum = 0.f;
#pragma unroll
        for (int i = 0; i < 4; ++i) { pe[i] = __expf(s[i] - mx); sum += pe[i]; }
        sum = wave_sum(sum);
        const float inv = 1.f / sum;
        float o0 = 0.f, o1 = 0.f;
        const bf16_t* vb = kb + 512;
#pragma unroll
        for (int i = 0; i < 4; ++i)
            for (int mm = 0; mm < 64; ++mm) {
                const float pv = __shfl(pe[i], mm, 64);
                const bf16_t* vr = vb + (size_t)(mm + 64 * i) * 1024;
                o0 += pv * bf2f(vr[lane]); o1 += pv * bf2f(vr[lane + 64]);
            }
        const bf16_t* zp = P + (size_t)row * NP + C_ZC + hd * 128; bf16_t* op = YC + (size_t)row * 512 + hd * 128;
        op[lane] = f2bf(o0 * inv * siluf_(bf2f(zp[lane]))); op[lane + 64] = f2bf(o1 * inv * siluf_(bf2f(zp[lane + 64])));
    }
}

DI void phase_gemm_gate(const Params& p, unsigned char* lds, const int bid, const int nb) {
    unsigned char* ws = p.ws;
    const bf16_t* H = (const bf16_t*)(ws + OFF_H); const bf16_t* Wt = (const bf16_t*)(ws + OFF_WIN) + (size_t)C_G * 1024;
    bf16_t* SG = (bf16_t*)(ws + OFF_SG);
    const int tn = 3072 / 128, nt = (M / 128) * tn;
    for (int it = bid; it < nt; it += nb) {
        GemmTile g; gemm_zero(g);
        const int m0 = (it / tn) * 128, n0 = (it % tn) * 128;
        gemm_tile_k(g, H, 1024, Wt, 1024, m0, n0, 1024, lds);
        GEMM_FOREACH(SG[(size_t)row * 3072 + col] = f2bf(sigmoidf_(g.acc[mi][ni][r])););
    }
}
DI void phase_gemm_proj(const Params& p, unsigned char* lds, const int bid, const int nb) {
    unsigned char* ws = p.ws;
    const bf16_t* SG = (const bf16_t*)(ws + OFF_SG); bf16_t* MG = (bf16_t*)(ws + OFF_MG);
    const int tn = 1024 / 128, nt = (M / 128) * tn;
    for (int it = bid; it < nt; it += nb) {
        const int m0 = (it / tn) * 128, n0 = (it % tn) * 128;
        GemmTile mg; gemm_zero(mg);
#pragma unroll 1
        for (int br = 0; br < 3; ++br) {
            GemmTile g; gemm_zero(g);
            const bf16_t* Y = (const bf16_t*)(ws + (br == 0 ? OFF_YA : br == 1 ? OFF_YB : OFF_YC));
            const bf16_t* W = (const bf16_t*)(ws + (br == 0 ? OFF_WPA : br == 1 ? OFF_WPB : OFF_WPC));
            gemm_tile_k(g, Y, 512, W, 512, m0, n0, 512, lds);
            GEMM_FOREACH(mg.acc[mi][ni][r] += bf2f(SG[(size_t)row * 3072 + br * 1024 + col]) * g.acc[mi][ni][r];);
        }
        GEMM_FOREACH(MG[(size_t)row * 1024 + col] = f2bf(mg.acc[mi][ni][r]););
    }
}
DI void phase_gemm_out(const Params& p, unsigned char* lds, const int bid, const int nb) {
    unsigned char* ws = p.ws;
    const bf16_t* MG = (const bf16_t*)(ws + OFF_MG); const bf16_t* W = (const bf16_t*)(ws + OFF_WO);
    const int tn = 1024 / 128, nt = (M / 128) * tn;
    for (int it = bid; it < nt; it += nb) {
        GemmTile g; gemm_zero(g);
        const int m0 = (it / tn) * 128, n0 = (it % tn) * 128;
        gemm_tile_k(g, MG, 1024, W, 1024, m0, n0, 1024, lds);
        GEMM_FOREACH(p.out[(size_t)row * 1024 + col] = p.x[(size_t)row * 1024 + col] + g.acc[mi][ni][r];);
    }
}

#define XB_TMO      128
#define XB_XCNT(j)  (256  + 64 * (j))
#define XB_XSUB(j)  (1280 + 64 * (j))
#define XB_XGEN(j)  (2304 + 64 * (j))
#define XB_TOP      3328
#define XB_TOPGEN   3392
#define XCD_BAR_WORDS 3456
#define XB_SPIN_CAP (1u << 22)
#define LAS __attribute__((address_space(3)))
DI unsigned xb_ld(unsigned* p)              { return __hip_atomic_load(p, __ATOMIC_RELAXED, __HIP_MEMORY_SCOPE_AGENT); }
DI unsigned xb_add(unsigned* p, unsigned v) { return __hip_atomic_fetch_add(p, v, __ATOMIC_RELAXED, __HIP_MEMORY_SCOPE_AGENT); }
DI unsigned xb_xcc_id() { return (unsigned)__builtin_amdgcn_s_getreg((3 << 11) | 20) & 0xFu; }
#define XB_SPIN(cond, bar) do { unsigned _sp = 0; while (cond) { __builtin_amdgcn_s_sleep(1); \
    if ((++_sp & 255u) == 0u) { if (xb_ld(&(bar)[XB_TMO])) break; if (_sp > XB_SPIN_CAP) { atomicAdd(&(bar)[XB_TMO], 1u); break; } } } } while (0)
struct XcdBarrier { unsigned* bar; unsigned x; volatile LAS unsigned* st; };
DI XcdBarrier xcd_barrier_post(unsigned* bar, volatile LAS unsigned* st) {
    XcdBarrier b; b.bar = bar; b.x = xb_xcc_id(); b.st = st;
    if (threadIdx.x == 0) (void)xb_add(&bar[XB_XCNT(b.x)], 1u);
    return b;
}
DI void xcd_barrier_complete(unsigned* bar, unsigned x, unsigned& nloc, unsigned& nx) {
    const unsigned G = gridDim.x * gridDim.y * gridDim.z;
    unsigned sum, cnt, mine, sp = 0u;
    for (;;) {
        sum = 0u; cnt = 0u; mine = 0u;
#pragma unroll
        for (unsigned j = 0; j < 16; ++j) { const unsigned c = xb_ld(&bar[XB_XCNT(j)]); sum += c; cnt += (c > 0u) ? 1u : 0u; mine = (j == x) ? c : mine; }
        if (sum == G) break;
        __builtin_amdgcn_s_sleep(1);
        if ((++sp & 255u) == 0u) { if (xb_ld(&bar[XB_TMO])) break; if (sp > XB_SPIN_CAP) { atomicAdd(&bar[XB_TMO], 1u); break; } }
    }
    nloc = mine > 0u ? mine : 1u; nx = cnt > 0u ? cnt : 1u;
}
DI void xcd_barrier(const XcdBarrier& b) {
    asm volatile("s_waitcnt vmcnt(0)" ::: "memory");
    __syncthreads();
    if (threadIdx.x == 0) {
        unsigned* bar = b.bar;
        __builtin_amdgcn_s_waitcnt(0);
        unsigned nloc = b.st[0], nx = b.st[1];
        if (nloc == 0u) { xcd_barrier_complete(bar, b.x, nloc, nx); b.st[0] = nloc; b.st[1] = nx; }
        const unsigned old = xb_add(&bar[XB_XSUB(b.x)], 1u);
        const unsigned gen = old / nloc;
        if (old + 1u == (gen + 1u) * nloc) {
            __builtin_amdgcn_fence(__ATOMIC_RELEASE, "agent");
            asm volatile("s_waitcnt vmcnt(0)" ::: "memory");
            const unsigned og = xb_add(&bar[XB_TOP], 1u);
            const unsigned tg = og / nx;
            if (og + 1u == (tg + 1u) * nx) xb_add(&bar[XB_TOPGEN], 1u);
            else XB_SPIN(xb_ld(&bar[XB_TOPGEN]) == tg, bar);
            __builtin_amdgcn_fence(__ATOMIC_ACQUIRE, "agent");
            xb_add(&bar[XB_XGEN(b.x)], 1u);
            asm volatile("s_waitcnt vmcnt(0)" ::: "memory");
        } else {
            XB_SPIN(xb_ld(&bar[XB_XGEN(b.x)]) == gen, bar);
            __builtin_amdgcn_fence(__ATOMIC_ACQUIRE, "agent");
            asm volatile("s_waitcnt vmcnt(0)" ::: "memory");
        }
    }
    __syncthreads();
}

constexpr int LDS_CTL_OFF = LDS_BYTES - 256;
__global__ void __launch_bounds__(NTHREADS, 2) k_mega(Params p) {
    extern __shared__ __attribute__((aligned(16))) unsigned char lds[];
    volatile LAS unsigned* st = (volatile LAS unsigned*)(lds + LDS_CTL_OFF);
    if (threadIdx.x == 0) { st[0] = 0u; st[1] = 0u; st[2] = 0u; st[3] = 0u; }
    __syncthreads();
    XcdBarrier bar = xcd_barrier_post((unsigned*)(p.ws + OFF_CTL), st);
    const int bid = blockIdx.x, nb = gridDim.x;
    phase_prologue(p, lds, bid, nb);
    xcd_barrier(bar);
    phase_gemm_in(p, lds, bid, nb);
    xcd_barrier(bar);
    phase_attn_prep(p, lds, bid, nb);
    xcd_barrier(bar);
    if (bid < 16) phase_rwkv_direct(p, lds, bid, 16);
    else { phase_swa_simple(p, lds, bid - 16, nb - 16); phase_xattn_simple(p, lds, bid - 16, nb - 16); }
    xcd_barrier(bar);
    phase_gemm_gate(p, lds, bid, nb);
    xcd_barrier(bar);
    phase_gemm_proj(p, lds, bid, nb);
    xcd_barrier(bar);
    phase_gemm_out(p, lds, bid, nb);
}

extern "C" void kernel_launch(void* const* d_in, const int* in_sizes, int n_in, void* d_out, int out_size, void* d_ws, size_t ws_size, hipStream_t stream) {
    static int grid = 0;
    if (grid == 0) {
        if (n_in != 27 || ws_size < WS_END) { fprintf(stderr, "kernel_launch: unexpected inputs (n_in %d, ws %zu)\n", n_in, ws_size); grid = -1; return; }
        int dev = 0, cus = 0, per_cu = 0;
        if (hipGetDevice(&dev) != hipSuccess || hipDeviceGetAttribute(&cus, hipDeviceAttributeMultiprocessorCount, dev) != hipSuccess) { grid = -1; return; }
        if (hipFuncSetAttribute((const void*)k_mega, hipFuncAttributeMaxDynamicSharedMemorySize, LDS_BYTES) != hipSuccess) { fprintf(stderr, "kernel_launch: hipFuncSetAttribute failed\n"); grid = -1; return; }
        if (hipOccupancyMaxActiveBlocksPerMultiprocessor(&per_cu, (const void*)k_mega, NTHREADS, LDS_BYTES) != hipSuccess || per_cu < 1)
            fprintf(stderr, "kernel_launch: occupancy query reports %d workgroups per CU\n", per_cu);
        (void)hipGetLastError();
        grid = cus;
        if (grid < 32) { fprintf(stderr, "kernel_launch: too few CUs (%d)\n", grid); grid = -1; return; }
    }
    if (grid < 0) return;
    if (hipMemsetAsync((char*)d_ws + OFF_CTL, 0, 65536, stream) != hipSuccess) { fprintf(stderr, "kernel_launch: memset failed\n"); return; }
    Params p{};
    p.x = (const float*)d_in[0]; p.mem = (const float*)d_in[1]; p.pos = (const int*)d_in[2]; p.norm_g = (const float*)d_in[3]; p.mem_norm_g = (const float*)d_in[4];
    p.w_in = (const float*)d_in[5]; p.mu_rkv = (const float*)d_in[6]; p.mu_wa = (const float*)d_in[7]; p.w0 = (const float*)d_in[8]; p.w2 = (const float*)d_in[9];
    p.a0 = (const float*)d_in[10]; p.a2 = (const float*)d_in[11]; p.k_k = (const float*)d_in[12]; p.k_a = (const float*)d_in[13]; p.r_k = (const float*)d_in[14];
    p.lnx_g = (const float*)d_in[15]; p.lnx_b = (const float*)d_in[16]; p.q_norm_g = (const float*)d_in[17]; p.k_norm_g = (const float*)d_in[18]; p.sinks = (const float*)d_in[19];
    p.xq_norm_g = (const float*)d_in[20]; p.xk_norm_g = (const float*)d_in[21]; p.w_mem_kv = (const float*)d_in[22]; p.w_proj_a = (const float*)d_in[23];
    p.w_proj_b = (const float*)d_in[24]; p.w_proj_c = (const float*)d_in[25]; p.w_out = (const float*)d_in[26];
    p.out = (float*)d_out; p.ws = (unsigned char*)d_ws;
    hipLaunchKernelGGL(k_mega, dim3(grid), dim3(NTHREADS), LDS_BYTES, stream, p);
}
```

```cpp
#include <hip/hip_runtime.h>
#include <stdint.h>
#include <stdio.h>

#define DI __device__ __forceinline__
typedef unsigned short bf16_t;
typedef short bf16x8 __attribute__((ext_vector_type(8)));
typedef float f32x4 __attribute__((ext_vector_type(4)));

constexpr int BATCH = 2, T = 8192, M = BATCH * T, D = 1024, NIN = 7552, NP = 4608  ;
constexpr int MEMLEN = 256, MM = BATCH * MEMLEN;
constexpr int C_R = 0, C_K = 512, C_V = 1024, C_W = 1536, C_A = 1600, C_ZA = 1664, C_Q = 2176, C_SK = 2688, C_SV = 2816, C_ZB = 2944, C_XQ = 3456, C_ZC = 3968, C_G = 4480;
constexpr int NTHREADS = 512, NWAVES = 8;
constexpr int LDS_BYTES = 147456;

constexpr size_t OFF_CTL = 0;
constexpr size_t OFF_WIN = 65536;
constexpr size_t OFF_WKV = OFF_WIN + (size_t)7680 * 1024 * 2;
constexpr size_t OFF_WPA = OFF_WKV + (size_t)1024 * 1024 * 2;
constexpr size_t OFF_WPB = OFF_WPA + (size_t)1024 * 512 * 2;
constexpr size_t OFF_WPC = OFF_WPB + (size_t)1024 * 512 * 2;
constexpr size_t OFF_WO  = OFF_WPC + (size_t)1024 * 512 * 2;
constexpr size_t OFF_H   = OFF_WO + (size_t)1024 * 1024 * 2;
constexpr size_t OFF_HM  = OFF_H + (size_t)M * 1024 * 2;
constexpr size_t OFF_KVM = OFF_HM + (size_t)MM * 1024 * 2;
constexpr size_t OFF_ROPE = OFF_KVM + (size_t)MM * 1024 * 2;
constexpr size_t OFF_P   = OFF_ROPE + (size_t)M * 32 * 8;
constexpr size_t OFF_YA  = OFF_P + (size_t)M * NP * 2;
constexpr size_t OFF_YB  = OFF_YA + (size_t)M * 512 * 2;
constexpr size_t OFF_YC  = OFF_YB + (size_t)M * 512 * 2;
constexpr size_t WS_END  = OFF_YC + (size_t)M * 512 * 2;
constexpr size_t OFF_SG  = OFF_P;
constexpr size_t OFF_MG  = OFF_P + (size_t)M * 3072 * 2;
static_assert(WS_END <= (size_t)256 * 1024 * 1024, "workspace");
static_assert(OFF_MG + (size_t)M * 1024 * 2 <= OFF_YA, "overlay");

struct Params {
    const float* x; const float* mem; const int* pos; const float* norm_g; const float* mem_norm_g; const float* w_in;
    const float* mu_rkv; const float* mu_wa; const float* w0; const float* w2; const float* a0; const float* a2;
    const float* k_k; const float* k_a; const float* r_k; const float* lnx_g; const float* lnx_b;
    const float* q_norm_g; const float* k_norm_g; const float* sinks; const float* xq_norm_g; const float* xk_norm_g;
    const float* w_mem_kv; const float* w_proj_a; const float* w_proj_b; const float* w_proj_c; const float* w_out;
    float* out; unsigned char* ws;
};

DI bf16_t f2bf(float x) { return __builtin_bit_cast(unsigned short, (__bf16)x); }
DI float bf2f(bf16_t h) { return __uint_as_float(((unsigned)h) << 16); }
DI float wave_sum(float v) {
#pragma unroll
    for (int o = 32; o > 0; o >>= 1) v += __shfl_xor(v, o, 64);
    return v;
}
DI float wave_max(float v) {
#pragma unroll
    for (int o = 32; o > 0; o >>= 1) v = fmaxf(v, __shfl_xor(v, o, 64));
    return v;
}
DI float sigmoidf_(float x) { return 1.f / (1.f + __expf(-x)); }
DI float siluf_(float x) { return x / (1.f + __expf(-x)); }

DI void transpose_convert(const float* W, int K, int N, bf16_t* Wt, int item, float* tile  ) {
    const int tn = N / 64, kt = item / tn, nt = item % tn, tid = threadIdx.x;
    __syncthreads();
    for (int e = tid; e < 4096; e += NTHREADS) { const int r = e >> 6, c = e & 63; tile[r * 65 + c] = W[(size_t)(kt * 64 + r) * N + nt * 64 + c]; }
    __syncthreads();
    for (int e = tid; e < 4096; e += NTHREADS) { const int n = e >> 6, k = e & 63; Wt[(size_t)(nt * 64 + n) * K + kt * 64 + k] = f2bf(tile[k * 65 + n]); }
}

DI void phase_prologue(const Params& p, unsigned char* lds, const int bid, const int nb) {
    float* tile = (float*)lds;
    unsigned char* ws = p.ws;
    const int n_in = (1024 / 64) * (NIN / 64), n_kv = 16 * 16, n_pr = (512 / 64) * 16, n_o = 16 * 16;
    const int total = n_in + n_kv + 3 * n_pr + n_o;
    for (int it = bid; it < total; it += nb) {
        int i = it;
        if (i < n_in) { transpose_convert(p.w_in, 1024, NIN, (bf16_t*)(ws + OFF_WIN), i, tile); continue; } i -= n_in;
        if (i < n_kv) { transpose_convert(p.w_mem_kv, 1024, 1024, (bf16_t*)(ws + OFF_WKV), i, tile); continue; } i -= n_kv;
        if (i < n_pr) { transpose_convert(p.w_proj_a, 512, 1024, (bf16_t*)(ws + OFF_WPA), i, tile); continue; } i -= n_pr;
        if (i < n_pr) { transpose_convert(p.w_proj_b, 512, 1024, (bf16_t*)(ws + OFF_WPB), i, tile); continue; } i -= n_pr;
        if (i < n_pr) { transpose_convert(p.w_proj_c, 512, 1024, (bf16_t*)(ws + OFF_WPC), i, tile); continue; } i -= n_pr;
        transpose_convert(p.w_out, 1024, 1024, (bf16_t*)(ws + OFF_WO), i, tile);
    }
    {
        unsigned* z = (unsigned*)(ws + OFF_WIN + (size_t)NIN * 1024 * 2);
        const int nz = (7680 - NIN) * 1024 / 2;
        for (int i = bid * NTHREADS + threadIdx.x; i < nz; i += nb * NTHREADS) z[i] = 0u;
    }
    const int lane = threadIdx.x & 63, wid = threadIdx.x >> 6;
    for (int row = bid * NWAVES + wid; row < M + MM; row += nb * NWAVES) {
        const float* src = row < M ? p.x + (size_t)row * D : p.mem + (size_t)(row - M) * D;
        const float* g = row < M ? p.norm_g : p.mem_norm_g;
        bf16_t* dst = row < M ? (bf16_t*)(ws + OFF_H) + (size_t)row * D : (bf16_t*)(ws + OFF_HM) + (size_t)(row - M) * D;
        f32x4 v[4]; float ss = 0.f;
#pragma unroll
        for (int i = 0; i < 4; ++i) { v[i] = *(const f32x4*)(src + i * 256 + lane * 4); ss += v[i][0] * v[i][0] + v[i][1] * v[i][1] + v[i][2] * v[i][2] + v[i][3] * v[i][3]; }
        ss = wave_sum(ss);
        const float rs = rsqrtf(ss * (1.f / 1024.f) + 1e-6f);
#pragma unroll
        for (int i = 0; i < 4; ++i) {
            const f32x4 gg = *(const f32x4*)(g + i * 256 + lane * 4);
            ushort4 o; o.x = f2bf(v[i][0] * rs * gg[0]); o.y = f2bf(v[i][1] * rs * gg[1]); o.z = f2bf(v[i][2] * rs * gg[2]); o.w = f2bf(v[i][3] * rs * gg[3]);
            *(ushort4*)(dst + i * 256 + lane * 4) = o;
        }
    }
    float2* rope = (float2*)(ws + OFF_ROPE);
    for (int i = bid * NTHREADS + threadIdx.x; i < M * 32; i += nb * NTHREADS) {
        const int row = i >> 5, f = i & 31;
        const double inv = pow(10000.0, -(double)f / 32.0);
        const double ang = (double)p.pos[row] * inv;
        double s, c; sincos(ang, &s, &c);
        rope[i] = make_float2((float)c, (float)s);
    }
}

struct GemmTile { f32x4 acc[2][4]; };
DI void gemm_tile_k(GemmTile& g, const bf16_t* A, int lda, const bf16_t* Bt, int ldb, int m0, int n0, int K, unsigned char* lds) {
    bf16_t* sA = (bf16_t*)lds;
    bf16_t* sB = sA + 128 * 40;
    const int tid = threadIdx.x, lane = tid & 63, wid = tid >> 6, wm = wid & 3, wn = wid >> 2;
    const int srow = tid >> 2, sch = tid & 3;
    const bf16_t* ga = A + (size_t)(m0 + srow) * lda + sch * 8;
    const bf16_t* gb = Bt + (size_t)(n0 + srow) * ldb + sch * 8;
    const int fr = lane & 15, fq = lane >> 4;
    uint4 ra = *(const uint4*)ga, rb = *(const uint4*)gb;
    for (int k0 = 0; k0 < K; k0 += 32) {
        __syncthreads();
        *(uint4*)(sA + srow * 40 + sch * 8) = ra;
        *(uint4*)(sB + srow * 40 + sch * 8) = rb;
        __syncthreads();
        if (k0 + 32 < K) { ra = *(const uint4*)(ga + k0 + 32); rb = *(const uint4*)(gb + k0 + 32); }
        bf16x8 af[2], bfr[4];
#pragma unroll
        for (int mi = 0; mi < 2; ++mi) af[mi] = *(const bf16x8*)(sA + (wm * 32 + mi * 16 + fr) * 40 + fq * 8);
#pragma unroll
        for (int ni = 0; ni < 4; ++ni) bfr[ni] = *(const bf16x8*)(sB + (wn * 64 + ni * 16 + fr) * 40 + fq * 8);
#pragma unroll
        for (int mi = 0; mi < 2; ++mi)
#pragma unroll
            for (int ni = 0; ni < 4; ++ni) g.acc[mi][ni] = __builtin_amdgcn_mfma_f32_16x16x32_bf16(af[mi], bfr[ni], g.acc[mi][ni], 0, 0, 0);
    }
}
DI void gemm_zero(GemmTile& g) {
#pragma unroll
    for (int mi = 0; mi < 2; ++mi)
#pragma unroll
        for (int ni = 0; ni < 4; ++ni) g.acc[mi][ni] = (f32x4){0.f, 0.f, 0.f, 0.f};
}
#define GEMM_FOREACH(body) do { const int lane_ = threadIdx.x & 63, wid_ = threadIdx.x >> 6, wm_ = wid_ & 3, wn_ = wid_ >> 2, fr_ = lane_ & 15, fq_ = lane_ >> 4; \
    _Pragma("unroll") for (int mi = 0; mi < 2; ++mi) _Pragma("unroll") for (int ni = 0; ni < 4; ++ni) _Pragma("unroll") for (int r = 0; r < 4; ++r) { \
        const int row = m0 + wm_ * 32 + mi * 16 + fq_ * 4 + r, col = n0 + wn_ * 64 + ni * 16 + fr_; body } } while (0)

DI void phase_gemm_in(const Params& p, unsigned char* lds, const int bid, const int nb) {
    unsigned char* ws = p.ws;
    const bf16_t* H = (const bf16_t*)(ws + OFF_H); const bf16_t* Wt = (const bf16_t*)(ws + OFF_WIN);
    bf16_t* P = (bf16_t*)(ws + OFF_P);
    const int tn = NP / 128, nt1 = (M / 128) * tn;
    const int tn2 = 1024 / 128, nt2 = (MM / 128) * tn2;
    for (int it = bid; it < nt1 + nt2; it += nb) {
        GemmTile g; gemm_zero(g);
        if (it < nt1) {
            const int m0 = (it / tn) * 128, n0 = (it % tn) * 128;
            gemm_tile_k(g, H, 1024, Wt, 1024, m0, n0, 1024, lds);
            GEMM_FOREACH(P[(size_t)row * NP + col] = f2bf(g.acc[mi][ni][r]););
        } else {
            const int i2 = it - nt1; const int m0 = (i2 / tn2) * 128, n0 = (i2 % tn2) * 128;
            gemm_tile_k(g, (const bf16_t*)(ws + OFF_HM), 1024, (const bf16_t*)(ws + OFF_WKV), 1024, m0, n0, 1024, lds);
            bf16_t* KVM = (bf16_t*)(ws + OFF_KVM);
            GEMM_FOREACH(KVM[(size_t)row * 1024 + col] = f2bf(g.acc[mi][ni][r]););
        }
    }
}

DI void phase_attn_prep(const Params& p, unsigned char* lds, const int bid, const int nb) {
    unsigned char* ws = p.ws; bf16_t* P = (bf16_t*)(ws + OFF_P); bf16_t* KVM = (bf16_t*)(ws + OFF_KVM);
    const float2* rope = (const float2*)(ws + OFF_ROPE);
    const int lane = threadIdx.x & 63, wid = threadIdx.x >> 6;
    const long n1 = (long)M * 14, n2 = (long)MM * 4;
    for (long it = (long)bid * NWAVES + wid; it < n1 + n2; it += (long)nb * NWAVES) {
        if (it < n1) {
            const int row = (int)(it / 14), j = (int)(it % 14);
            if (j < 10) {
                bf16_t* ptr = P + (size_t)row * NP + (j < 8 ? C_Q + j * 64 : C_SK + (j - 8) * 64);
                const float g = j < 8 ? p.q_norm_g[lane] : p.k_norm_g[lane];
                const float xv = bf2f(ptr[lane]);
                const float ss = wave_sum(xv * xv);
                const float y = xv * rsqrtf(ss * (1.f / 64.f) + 1e-6f) * g;
                const float yp = __shfl_xor(y, 32, 64);
                const float2 cs = rope[(size_t)row * 32 + (lane & 31)];
                const float o = lane < 32 ? y * cs.x - yp * cs.y : y * cs.x + yp * cs.y;
                ptr[lane] = f2bf(o);
            } else {
                bf16_t* ptr = P + (size_t)row * NP + C_XQ + (j - 10) * 128;
                const float x0 = bf2f(ptr[lane]), x1 = bf2f(ptr[lane + 64]);
                const float ss = wave_sum(x0 * x0 + x1 * x1);
                const float rs = rsqrtf(ss * (1.f / 128.f) + 1e-6f);
                ptr[lane] = f2bf(x0 * rs * p.xq_norm_g[lane]); ptr[lane + 64] = f2bf(x1 * rs * p.xq_norm_g[lane + 64]);
            }
        } else {
            const long i2 = it - n1; const int row = (int)(i2 / 4), j = (int)(i2 % 4);
            bf16_t* ptr = KVM + (size_t)row * 1024 + j * 128;
            const float x0 = bf2f(ptr[lane]), x1 = bf2f(ptr[lane + 64]);
            const float ss = wave_sum(x0 * x0 + x1 * x1);
            const float rs = rsqrtf(ss * (1.f / 128.f) + 1e-6f);
            ptr[lane] = f2bf(x0 * rs * p.xk_norm_g[lane]); ptr[lane + 64] = f2bf(x1 * rs * p.xk_norm_g[lane + 64]);
        }
    }
}

DI void rwkv_stage(const Params& p, int b, int h, int t0, int ntok, float* ck, float* scratch  ) {
    const bf16_t* P = (const bf16_t*)(p.ws + OFF_P);
    const int lane = threadIdx.x & 63, wid = threadIdx.x >> 6, ch = h * 64 + lane;
    const float mu_r = p.mu_rkv[ch], mu_k = p.mu_rkv[512 + ch], mu_v = p.mu_rkv[1024 + ch], mu_w = p.mu_wa[lane], mu_a = p.mu_wa[64 + lane];
    const float w0c = p.w0[ch], a0c = p.a0[ch], kkc = p.k_k[ch], kac = p.k_a[ch];
    float* sc = scratch + wid * 128;
    for (int i = wid; i < ntok; i += NWAVES) {
        const int t = t0 + i; const bf16_t* pr = P + (size_t)(b * T + t) * NP; const bf16_t* pp = pr - NP; const bool hp = t > 0;
        const float rc = bf2f(pr[C_R + ch]), rp = hp ? bf2f(pp[C_R + ch]) : 0.f;
        const float kc = bf2f(pr[C_K + ch]), kp = hp ? bf2f(pp[C_K + ch]) : 0.f;
        const float vc = bf2f(pr[C_V + ch]), vp = hp ? bf2f(pp[C_V + ch]) : 0.f;
        const float wc = bf2f(pr[C_W + lane]), wp = hp ? bf2f(pp[C_W + lane]) : 0.f;
        const float ac = bf2f(pr[C_A + lane]), ap = hp ? bf2f(pp[C_A + lane]) : 0.f;
        const float r = rc + (rp - rc) * mu_r, k = kc + (kp - kc) * mu_k, v = vc + (vp - vc) * mu_v;
        const float lw = wc + (wp - wc) * mu_w, la = ac + (ap - ac) * mu_a;
        sc[lane] = tanhf(lw); sc[64 + lane] = la;
        float accw = 0.f, acca = 0.f;
#pragma unroll 8
        for (int j = 0; j < 64; ++j) { accw += sc[j] * p.w2[j * 512 + ch]; acca += sc[64 + j] * p.a2[j * 512 + ch]; }
        const float xw = -(w0c + accw);
        const float sp = xw > 20.f ? xw : log1pf(expf(xw));
        const float wlog = -sp - 0.5f;
        const float decay = expf(-expf(wlog));
        const float alpha = 1.f / (1.f + expf(-(a0c + acca)));
        const float kk0 = k * kkc;
        const float n2 = wave_sum(kk0 * kk0);
        const float kk = kk0 / fmaxf(sqrtf(n2), 1e-12f);
        const float k2 = k * (1.f + (alpha - 1.f) * kac);
        float* o = ck + i * 384;
        o[lane] = r; o[64 + lane] = decay; o[128 + lane] = k2; o[192 + lane] = v; o[256 + lane] = -kk; o[320 + lane] = kk * alpha;
    }
}

DI void phase_rwkv_direct(const Params& p, unsigned char* lds, const int bid, const int nb) {
    float* ck = (float*)lds; float* scratch = ck + 64 * 384;
    const int lane = threadIdx.x & 63, wid = threadIdx.x >> 6;
    const bf16_t* P = (const bf16_t*)(p.ws + OFF_P); bf16_t* YA = (bf16_t*)(p.ws + OFF_YA);
    for (int bh = bid; bh < BATCH * 8; bh += nb) {
        const int b = bh >> 3, h = bh & 7, ch = h * 64 + lane;
        float S[64];
#pragma unroll
        for (int k = 0; k < 64; ++k) S[k] = 0.f;
        const float rk = p.r_k[ch], lg = p.lnx_g[ch], lb = p.lnx_b[ch];
        for (int c = 0; c < T / 64; ++c) {
            __syncthreads();
            rwkv_stage(p, b, h, c * 64, 64, ck, scratch);
            __syncthreads();
            if (wid == 0) {
                for (int i = 0; i < 64; ++i) {
                    const float* cc = ck + i * 384;
                    float sa = 0.f;
#pragma unroll
                    for (int k = 0; k < 64; ++k) sa += S[k] * cc[256 + k];
                    const float vv = cc[192 + lane];
#pragma unroll
                    for (int k = 0; k < 64; ++k) S[k] = S[k] * cc[64 + k] + sa * cc[320 + k] + vv * cc[128 + k];
                    float y = 0.f;
#pragma unroll
                    for (int k = 0; k < 64; ++k) y += S[k] * cc[k];
                    const float mean = wave_sum(y) * (1.f / 64.f);
                    const float dy = y - mean;
                    const float var = wave_sum(dy * dy) * (1.f / 64.f);
                    const float yn = dy * rsqrtf(var + 64e-5f) * lg + lb;
                    const float bonus = wave_sum(cc[lane] * cc[128 + lane] * rk) * vv;
                    const int t = c * 64 + i; const size_t row = (size_t)(b * T + t);
                    const float z = bf2f(P[row * NP + C_ZA + ch]);
                    YA[row * 512 + ch] = f2bf((yn + bonus) * siluf_(z));
                }
            }
        }
    }
}

constexpr size_t AF_BYTES = 16384, NF_BYTES = 16384, NCHUNK = 128;
constexpr size_t OFF_AF = 0, OFF_NF = (size_t)16 * NCHUNK * AF_BYTES;
typedef float f32x16 __attribute__((ext_vector_type(16)));
typedef float f32x2 __attribute__((ext_vector_type(2)));

DI float quad_sum(float s) {
    s += __int_as_float(__builtin_amdgcn_update_dpp(0, __float_as_int(s), 0xB1, 0xF, 0xF, true));
    s += __int_as_float(__builtin_amdgcn_update_dpp(0, __float_as_int(s), 0x4E, 0xF, 0xF, true));
    return s;
}

DI float rwkv_stage_tok(const Params& p, const bf16_t* P, int b, int h, int t, float* o, float* sc, float mu_r, float mu_k, float mu_v, float mu_w, float mu_a,
                        float w0c, float a0c, float kkc, float kac, float rkc) {
    const int lane = threadIdx.x & 63, ch = h * 64 + lane;
    const bf16_t* pr = P + (size_t)(b * T + t) * NP; const bf16_t* pp = pr - NP; const bool hp = t > 0;
    const float rc = bf2f(pr[C_R + ch]), rp = hp ? bf2f(pp[C_R + ch]) : 0.f;
    const float kc = bf2f(pr[C_K + ch]), kp = hp ? bf2f(pp[C_K + ch]) : 0.f;
    const float vc = bf2f(pr[C_V + ch]), vp = hp ? bf2f(pp[C_V + ch]) : 0.f;
    const float wc = bf2f(pr[C_W + lane]), wp = hp ? bf2f(pp[C_W + lane]) : 0.f;
    const float ac = bf2f(pr[C_A + lane]), ap = hp ? bf2f(pp[C_A + lane]) : 0.f;
    const float r = rc + (rp - rc) * mu_r, k = kc + (kp - kc) * mu_k, v = vc + (vp - vc) * mu_v;
    const float lw = wc + (wp - wc) * mu_w, la = ac + (ap - ac) * mu_a;
    sc[lane] = tanhf(lw); sc[64 + lane] = la;
    float accw = 0.f, acca = 0.f;
    const float* w2p = p.w2; const float* a2p = p.a2;
    asm volatile("" : "+s"(w2p), "+s"(a2p));
#pragma unroll 8
    for (int j = 0; j < 64; ++j) { accw += sc[j] * w2p[j * 512 + ch]; acca += sc[64 + j] * a2p[j * 512 + ch]; }
    const float xw = -(w0c + accw);
    const float sp = xw > 20.f ? xw : log1pf(expf(xw));
    const float decay = expf(-expf(-sp - 0.5f));
    const float alpha = 1.f / (1.f + expf(-(a0c + acca)));
    const float kk0 = k * kkc;
    const float n2 = wave_sum(kk0 * kk0);
    const float kk = kk0 / fmaxf(sqrtf(n2), 1e-12f);
    const float k2 = k * (1.f + (alpha - 1.f) * kac);
    o[lane] = r; o[64 + lane] = decay; o[128 + lane] = k2; o[192 + lane] = v; o[256 + lane] = -kk; o[320 + lane] = kk * alpha;
    return wave_sum(r * k2 * rkc);
}

template <int MODE> DI void rwkv_step(float (&z)[4][16], const float* cc, int q, int g, float (&sa)[4]) {
    f32x4 av[4], wv[4], bv[4], kv[4];
#pragma unroll
    for (int u = 0; u < 4; ++u) { av[u] = *(const f32x4*)(cc + 256 + 16 * q + 4 * u); wv[u] = *(const f32x4*)(cc + 64 + 16 * q + 4 * u); bv[u] = *(const f32x4*)(cc + 320 + 16 * q + 4 * u);
        if (MODE == 1) kv[u] = *(const f32x4*)(cc + 128 + 16 * q + 4 * u); }
    f32x4 vr = (f32x4){0.f, 0.f, 0.f, 0.f};
    if (MODE == 1) vr = *(const f32x4*)(cc + 192 + 4 * g);
#pragma unroll
    for (int rr = 0; rr < 4; ++rr) {
        float s0 = 0.f, s1 = 0.f;
#pragma unroll
        for (int u = 0; u < 4; ++u) { s0 += z[rr][4 * u] * av[u][0] + z[rr][4 * u + 2] * av[u][2]; s1 += z[rr][4 * u + 1] * av[u][1] + z[rr][4 * u + 3] * av[u][3]; }
        sa[rr] = quad_sum(s0 + s1);
    }
#pragma unroll
    for (int rr = 0; rr < 4; ++rr)
#pragma unroll
        for (int u = 0; u < 4; ++u)
#pragma unroll
            for (int e = 0; e < 4; ++e) {
                float t = sa[rr] * bv[u][e];
                if (MODE == 1) t += vr[rr] * kv[u][e];
                z[rr][4 * u + e] = z[rr][4 * u + e] * wv[u][e] + t;
            }
}

DI void phase_rwkv_prep(const Params& p, unsigned char* lds, const int bid, const int nb) {
    float* ck = (float*)lds; float* scratch = ck + 64 * 384; float* mat = (float*)lds;
    const bf16_t* P = (const bf16_t*)(p.ws + OFF_P);
    unsigned char* fr = (unsigned char*)p.out;
    const int tid = threadIdx.x, lane = tid & 63, wid = tid >> 6, q = lane & 3, g = lane >> 2, cl = wid >> 1, role = wid & 1;
    for (int item = bid; item < 512; item += nb) {
        const int bh = item >> 5, cq = item & 31, b = bh >> 3, h = bh & 7, ch = h * 64 + lane;
        const float mu_r = p.mu_rkv[ch], mu_k = p.mu_rkv[512 + ch], mu_v = p.mu_rkv[1024 + ch], mu_w = p.mu_wa[lane], mu_a = p.mu_wa[64 + lane];
        const float w0c = p.w0[ch], a0c = p.a0[ch], kkc = p.k_k[ch], kac = p.k_a[ch], rkc = p.r_k[ch];
        float z[4][16];
#pragma unroll
        for (int rr = 0; rr < 4; ++rr)
#pragma unroll
            for (int c = 0; c < 16; ++c) z[rr][c] = (role == 0 && (4 * g + rr) == (16 * q + c)) ? 1.f : 0.f;
        for (int sl = 0; sl < 4; ++sl) {
            __syncthreads();
#pragma unroll 1
            for (int sidx = wid; sidx < 64; sidx += NWAVES) {
                const int clx = sidx >> 4, i = sidx & 15, t = (cq * 4 + clx) * 64 + sl * 16 + i;
                (void)rwkv_stage_tok(p, P, b, h, t, ck + sidx * 384, scratch + wid * 128, mu_r, mu_k, mu_v, mu_w, mu_a, w0c, a0c, kkc, kac, rkc);
            }
            __syncthreads();
            float sa[4];
            if (role == 0) {
#pragma unroll 1
                for (int i = 0; i < 16; ++i) rwkv_step<0>(z, ck + (cl * 16 + i) * 384, q, g, sa); }
            else {
#pragma unroll 1
                for (int i = 0; i < 16; ++i) rwkv_step<1>(z, ck + (cl * 16 + i) * 384, q, g, sa); }
        }
        for (int pass = 0; pass < 2; ++pass) {
            __syncthreads();
            if (role == pass) {
#pragma unroll
                for (int rr = 0; rr < 4; ++rr)
#pragma unroll
                    for (int u = 0; u < 4; ++u) *(f32x4*)(mat + (cl * 64 + 4 * g + rr) * 68 + 16 * q + 4 * u) = (f32x4){z[rr][4 * u], z[rr][4 * u + 1], z[rr][4 * u + 2], z[rr][4 * u + 3]};
            }
            __syncthreads();
            if (pass == 0) {
                for (int it = tid; it < 4 * 8 * 64; it += NTHREADS) {
                    const int clx = it >> 9, f = (it >> 6) & 7, l = it & 63, r = l & 31, hh = l >> 5, fi = f >> 2, fj = (f >> 1) & 1, fs = f & 1;
                    const size_t chunk = (size_t)bh * NCHUNK + cq * 4 + clx;
                    unsigned hi[4], lo[4];
#pragma unroll
                    for (int e2 = 0; e2 < 4; ++e2) {
                        unsigned short hs[2], ls[2];
#pragma unroll
                        for (int d = 0; d < 2; ++d) { const int e = 2 * e2 + d, kin = 32 * fj + 16 * fs + 8 * (e >> 2) + 4 * hh + (e & 3), kout = 32 * fi + r;
                            const float val = mat[(clx * 64 + kin) * 68 + kout]; hs[d] = f2bf(val); ls[d] = f2bf(val - bf2f(hs[d])); }
                        hi[e2] = (unsigned)hs[0] | ((unsigned)hs[1] << 16); lo[e2] = (unsigned)ls[0] | ((unsigned)ls[1] << 16);
                    }
                    unsigned char* dst = fr + OFF_AF + chunk * AF_BYTES + (size_t)((f * 2) * 64 + l) * 16;
                    *(uint4*)dst = make_uint4(hi[0], hi[1], hi[2], hi[3]);
                    *(uint4*)(dst + 64 * 16) = make_uint4(lo[0], lo[1], lo[2], lo[3]);
                }
            } else {
                for (int it = tid; it < 4 * 2 * 2 * 64 * 4; it += NTHREADS) {
                    const int gq = it & 3, l = (it >> 2) & 63, fi = (it >> 8) & 1, w2 = (it >> 9) & 1, clx = it >> 10, hh = l >> 5;
                    const size_t chunk = (size_t)bh * NCHUNK + cq * 4 + clx;
                    const f32x4 v4 = *(const f32x4*)(mat + (clx * 64 + 32 * w2 + (l & 31)) * 68 + 32 * fi + 8 * gq + 4 * hh);
                    *(f32x4*)(fr + OFF_NF + chunk * NF_BYTES + (size_t)(((w2 * 2 + fi) * 64 + l) * 16 + 4 * gq) * 4) = v4;
                }
            }
        }
    }
}

DI void split8(const f32x16& x, int s, bf16x8& hi, bf16x8& lo) {
#pragma unroll
    for (int e = 0; e < 8; ++e) { const float v = x[8 * s + e]; const bf16_t hb = f2bf(v); hi[e] = (short)hb; lo[e] = (short)f2bf(v - bf2f(hb)); }
}
DI void phase_rwkv_scan(const Params& p, unsigned char* lds, const int bh) {
    unsigned char* fr = (unsigned char*)p.out;
    const int tid = threadIdx.x, lane = tid & 63, wid = tid >> 6;
    const unsigned char* gA = fr + OFF_AF + (size_t)bh * NCHUNK * AF_BYTES;
    unsigned char* gN = fr + OFF_NF + (size_t)bh * NCHUNK * NF_BYTES;
    __syncthreads();
    for (int c = 0; c < 3; ++c)
        for (int e = tid; e < 2048; e += NTHREADS) {
            const uint4 v = e < 1024 ? *(const uint4*)(gA + (size_t)c * AF_BYTES + e * 16) : *(const uint4*)(gN + (size_t)c * NF_BYTES + (e - 1024) * 16);
            *(uint4*)(lds + c * 32768 + e * 16) = v;
        }
    const int ltid = tid - 128;
    const bool loader = (wid >= 2 && wid < 6);
    uint4 la0, la1, la2, la3, ln0, ln1, ln2, ln3;
#define SCAN_LOAD(cc_) do { const unsigned char* a_ = gA + (size_t)(cc_) * AF_BYTES + ltid * 16; const unsigned char* n_ = gN + (size_t)(cc_) * NF_BYTES + ltid * 16; \
        la0 = *(const uint4*)a_; la1 = *(const uint4*)(a_ + 4096); la2 = *(const uint4*)(a_ + 8192); la3 = *(const uint4*)(a_ + 12288); \
        ln0 = *(const uint4*)n_; ln1 = *(const uint4*)(n_ + 4096); ln2 = *(const uint4*)(n_ + 8192); ln3 = *(const uint4*)(n_ + 12288); } while (0)
#define SCAN_WRITE(slot_) do { unsigned char* d_ = lds + (slot_) * 32768 + ltid * 16; \
        *(uint4*)d_ = la0; *(uint4*)(d_ + 4096) = la1; *(uint4*)(d_ + 8192) = la2; *(uint4*)(d_ + 12288) = la3; \
        *(uint4*)(d_ + 16384) = ln0; *(uint4*)(d_ + 20480) = ln1; *(uint4*)(d_ + 24576) = ln2; *(uint4*)(d_ + 28672) = ln3; } while (0)
    if (loader) SCAN_LOAD(3);
    f32x16 X0, X1;
#pragma unroll
    for (int i = 0; i < 16; ++i) { X0[i] = 0.f; X1[i] = 0.f; }
    for (int c = 0; c < (int)NCHUNK; ++c) {
        __syncthreads();
        if (wid >= 2) {
            if (loader) {
                if (c + 3 < (int)NCHUNK) SCAN_WRITE((c + 3) & 3);
                if (c + 4 < (int)NCHUNK) SCAN_LOAD(c + 4);
            }
        } else {
            const int w2 = wid;
            const unsigned char* slot = lds + (c & 3) * 32768;
            float* gs = (float*)(gN + (size_t)c * NF_BYTES) + ((w2 * 2) * 64 + lane) * 16;
#pragma unroll
            for (int gq = 0; gq < 4; ++gq) { *(f32x4*)(gs + 4 * gq) = (f32x4){X0[4 * gq], X0[4 * gq + 1], X0[4 * gq + 2], X0[4 * gq + 3]};
                                             *(f32x4*)(gs + 64 * 16 + 4 * gq) = (f32x4){X1[4 * gq], X1[4 * gq + 1], X1[4 * gq + 2], X1[4 * gq + 3]}; }
            bf16x8 bhi[2][2], blo[2][2];
            split8(X0, 0, bhi[0][0], blo[0][0]); split8(X0, 1, bhi[0][1], blo[0][1]); split8(X1, 0, bhi[1][0], blo[1][0]); split8(X1, 1, bhi[1][1], blo[1][1]);
            f32x16 Dn[2];
#pragma unroll
            for (int i = 0; i < 2; ++i) {
                const float* np = (const float*)(slot + 16384) + ((w2 * 2 + i) * 64 + lane) * 16;
#pragma unroll
                for (int gq = 0; gq < 4; ++gq) { const f32x4 v4 = *(const f32x4*)(np + 4 * gq); Dn[i][4 * gq] = v4[0]; Dn[i][4 * gq + 1] = v4[1]; Dn[i][4 * gq + 2] = v4[2]; Dn[i][4 * gq + 3] = v4[3]; }
#pragma unroll
                for (int j = 0; j < 2; ++j)
#pragma unroll
                    for (int s = 0; s < 2; ++s) {
                        const int f = (i * 2 + j) * 2 + s;
                        const bf16x8 ah = *(const bf16x8*)(slot + ((f * 2) * 64 + lane) * 16), al = *(const bf16x8*)(slot + ((f * 2 + 1) * 64 + lane) * 16);
                        Dn[i] = __builtin_amdgcn_mfma_f32_32x32x16_bf16(ah, bhi[j][s], Dn[i], 0, 0, 0);
                        Dn[i] = __builtin_amdgcn_mfma_f32_32x32x16_bf16(ah, blo[j][s], Dn[i], 0, 0, 0);
                        Dn[i] = __builtin_amdgcn_mfma_f32_32x32x16_bf16(al, bhi[j][s], Dn[i], 0, 0, 0);
                    }
            }
            X0 = Dn[0]; X1 = Dn[1];
        }
    }
}

constexpr int RS3 = 464;
DI void phase_rwkv_out(const Params& p, unsigned char* lds, const int bid, const int nb) {
    const bf16_t* P = (const bf16_t*)(p.ws + OFF_P); bf16_t* YA = (bf16_t*)(p.ws + OFF_YA);
    const unsigned char* fr = (const unsigned char*)p.out;
    const int tid = threadIdx.x, lane = tid & 63, wid = tid >> 6, q = lane & 3, g = lane >> 2;
    float* ck = (float*)lds + wid * (8 * RS3); float* sc = (float*)lds + 8 * 8 * RS3 + wid * 128;
    for (int item = bid; item < 256; item += nb) {
        const int bh = item >> 4, co = item & 15, b = bh >> 3, h = bh & 7, ch = h * 64 + lane, c = co * 8 + wid;
        const float mu_r = p.mu_rkv[ch], mu_k = p.mu_rkv[512 + ch], mu_v = p.mu_rkv[1024 + ch], mu_w = p.mu_wa[lane], mu_a = p.mu_wa[64 + lane];
        const float w0c = p.w0[ch], a0c = p.a0[ch], kkc = p.k_k[ch], kac = p.k_a[ch], rkc = p.r_k[ch];
        const int vo = 4 * g + q;
        const float lg = p.lnx_g[h * 64 + vo], lb = p.lnx_b[h * 64 + vo];
        float z[4][16];
        {
            const float* sf = (const float*)(fr + OFF_NF + ((size_t)bh * NCHUNK + c) * NF_BYTES);
#pragma unroll
            for (int rr = 0; rr < 4; ++rr) { const int v = 4 * g + rr, w2 = v >> 5, vl = v & 31, fi = q >> 1;
#pragma unroll
                for (int u = 0; u < 4; ++u) { const int hh = u & 1, r0 = 4 * (2 * (q & 1) + (u >> 1));
                    const f32x4 v4 = *(const f32x4*)(sf + ((w2 * 2 + fi) * 64 + vl + 32 * hh) * 16 + r0);
                    z[rr][4 * u] = v4[0]; z[rr][4 * u + 1] = v4[1]; z[rr][4 * u + 2] = v4[2]; z[rr][4 * u + 3] = v4[3]; } }
        }
#pragma unroll 1
        for (int sl = 0; sl < 8; ++sl) {
#pragma unroll 1
            for (int i = 0; i < 8; ++i) {
                const int t = c * 64 + sl * 8 + i; float* o = ck + i * RS3;
                const float bon = rwkv_stage_tok(p, P, b, h, t, o, sc, mu_r, mu_k, mu_v, mu_w, mu_a, w0c, a0c, kkc, kac, rkc);
                o[384 + lane] = bf2f(P[(size_t)(b * T + t) * NP + C_ZA + ch]);
                if (lane == 0) o[448] = bon;
            }
#pragma unroll 1
            for (int i = 0; i < 8; ++i) {
                const float* cc = ck + i * RS3; float sa[4];
                rwkv_step<1>(z, cc, q, g, sa);
                f32x4 rv[4];
#pragma unroll
                for (int u = 0; u < 4; ++u) rv[u] = *(const f32x4*)(cc + 16 * q + 4 * u);
                float y[4];
#pragma unroll
                for (int rr = 0; rr < 4; ++rr) { float s0 = 0.f;
#pragma unroll
                    for (int u = 0; u < 4; ++u) s0 += z[rr][4 * u] * rv[u][0] + z[rr][4 * u + 1] * rv[u][1] + z[rr][4 * u + 2] * rv[u][2] + z[rr][4 * u + 3] * rv[u][3];
                    y[rr] = quad_sum(s0); }
                float tot = (y[0] + y[1]) + (y[2] + y[3]);
#pragma unroll
                for (int o2 = 4; o2 < 64; o2 <<= 1) tot += __shfl_xor(tot, o2, 64);
                const float mean = tot * (1.f / 64.f);
                float d0 = y[0] - mean, d1 = y[1] - mean, d2 = y[2] - mean, d3 = y[3] - mean;
                float vs = (d0 * d0 + d1 * d1) + (d2 * d2 + d3 * d3);
#pragma unroll
                for (int o2 = 4; o2 < 64; o2 <<= 1) vs += __shfl_xor(vs, o2, 64);
                const float rstd = rsqrtf(vs * (1.f / 64.f) + 64e-5f);
                const float dv = q == 0 ? d0 : q == 1 ? d1 : q == 2 ? d2 : d3;
                const float yn = dv * rstd * lg + lb;
                const float outv = (yn + cc[448] * cc[192 + vo]) * siluf_(cc[384 + vo]);
                const int t = c * 64 + sl * 8 + i;
                YA[(size_t)(b * T + t) * 512 + h * 64 + vo] = f2bf(outv);
            }
        }
    }
}

DI void phase_swa_simple(const Params& p, unsigned char* lds, const int bid, const int nb) {
    const bf16_t* P = (const bf16_t*)(p.ws + OFF_P); bf16_t* YB = (bf16_t*)(p.ws + OFF_YB);
    const long total = (long)BATCH * 8 * T;
    for (long it = (long)bid * NTHREADS + threadIdx.x; it < total; it += (long)nb * NTHREADS) {
        const int t = (int)(it % T), qh = (int)((it / T) % 8), b = (int)(it / ((long)T * 8)), kvh = qh >> 2;
        const size_t row = (size_t)(b * T + t);
        float q[64], acc[64];
        {
            const uint4* qp = (const uint4*)(P + row * NP + C_Q + qh * 64);
#pragma unroll
            for (int i = 0; i < 8; ++i) { const uint4 u = qp[i]; const unsigned w[4] = {u.x, u.y, u.z, u.w};
#pragma unroll
                for (int j = 0; j < 4; ++j) { q[i * 8 + j * 2] = __uint_as_float(w[j] << 16); q[i * 8 + j * 2 + 1] = __uint_as_float(w[j] & 0xffff0000u); } }
        }
#pragma unroll
        for (int d = 0; d < 64; ++d) acc[d] = 0.f;
        float m = p.sinks[qh], l = 1.f;
        for (int j = 0; j < 128; ++j) {
            const int s = t - 127 + j;
            if (s < 0) continue;
            const size_t krow = (size_t)(b * T + s) * NP;
            const uint4* kp = (const uint4*)(P + krow + C_SK + kvh * 64);
            float dot = 0.f;
#pragma unroll
            for (int i = 0; i < 8; ++i) { const uint4 u = kp[i]; const unsigned w[4] = {u.x, u.y, u.z, u.w};
#pragma unroll
                for (int jj = 0; jj < 4; ++jj) { dot += q[i * 8 + jj * 2] * __uint_as_float(w[jj] << 16) + q[i * 8 + jj * 2 + 1] * __uint_as_float(w[jj] & 0xffff0000u); } }
            const float sc = dot * 0.125f;
            const float mn = fmaxf(m, sc), corr = __expf(m - mn), pe = __expf(sc - mn);
            l = l * corr + pe; m = mn;
            const uint4* vp = (const uint4*)(P + krow + C_SV + kvh * 64);
#pragma unroll
            for (int i = 0; i < 8; ++i) { const uint4 u = vp[i]; const unsigned w[4] = {u.x, u.y, u.z, u.w};
#pragma unroll
                for (int jj = 0; jj < 4; ++jj) { acc[i * 8 + jj * 2] = acc[i * 8 + jj * 2] * corr + pe * __uint_as_float(w[jj] << 16);
                                                 acc[i * 8 + jj * 2 + 1] = acc[i * 8 + jj * 2 + 1] * corr + pe * __uint_as_float(w[jj] & 0xffff0000u); } }
        }
        const float inv = 1.f / l;
        const bf16_t* zp = P + row * NP + C_ZB + qh * 64; bf16_t* op = YB + row * 512 + qh * 64;
#pragma unroll
        for (int d = 0; d < 64; ++d) op[d] = f2bf(acc[d] * inv * siluf_(bf2f(zp[d])));
    }
}

DI void phase_xattn_simple(const Params& p, unsigned char* lds, const int bid, const int nb) {
    const bf16_t* P = (const bf16_t*)(p.ws + OFF_P); const bf16_t* KVM = (const bf16_t*)(p.ws + OFF_KVM); bf16_t* YC = (bf16_t*)(p.ws + OFF_YC);
    const int lane = threadIdx.x & 63, wid = threadIdx.x >> 6;
    const long total = (long)M * 4;
    const float scale = 0.08838834764831845f;
    for (long it = (long)bid * NWAVES + wid; it < total; it += (long)nb * NWAVES) {
        const int row = (int)(it >> 2), hd = (int)(it & 3), b = row / T;
        const bf16_t* qp = P + (size_t)row * NP + C_XQ + hd * 128;
        const bf16_t* kb = KVM + (size_t)(b * MEMLEN) * 1024 + hd * 128;
        float s[4] = {0.f, 0.f, 0.f, 0.f};
        for (int c = 0; c < 16; ++c) {
            const uint4 qu = *(const uint4*)(qp + c * 8); const unsigned qw[4] = {qu.x, qu.y, qu.z, qu.w};
#pragma unroll
            for (int i = 0; i < 4; ++i) {
                const uint4 ku = *(const uint4*)(kb + (size_t)(lane + 64 * i) * 1024 + c * 8); const unsigned kw[4] = {ku.x, ku.y, ku.z, ku.w};
#pragma unroll
                for (int j = 0; j < 4; ++j) s[i] += __uint_as_float(qw[j] << 16) * __uint_as_float(kw[j] << 16) + __uint_as_float(qw[j] & 0xffff0000u) * __uint_as_float(kw[j] & 0xffff0000u);
            }
        }
        float mx = -1e30f;
#pragma unroll
        for (int i = 0; i < 4; ++i) { s[i] *= scale; mx = fmaxf(mx, s[i]); }
        mx = wave_max(mx);
        float pe[4], sum = 0.f;
#pragma unroll
        for (int i = 0; i < 4; ++i) { pe[i] = __expf(s[i] - mx); sum += pe[i]; }
        sum = wave_sum(sum);
        const float inv = 1.f / sum;
        float o0 = 0.f, o1 = 0.f;
        const bf16_t* vb = kb + 512;
#pragma unroll
        for (int i = 0; i < 4; ++i)
            for (int mm = 0; mm < 64; ++mm) {
                const float pv = __shfl(pe[i], mm, 64);
                const bf16_t* vr = vb + (size_t)(mm + 64 * i) * 1024;
                o0 += pv * bf2f(vr[lane]); o1 += pv * bf2f(vr[lane + 64]);
            }
        const bf16_t* zp = P + (size_t)row * NP + C_ZC + hd * 128; bf16_t* op = YC + (size_t)row * 512 + hd * 128;
        op[lane] = f2bf(o0 * inv * siluf_(bf2f(zp[lane]))); op[lane + 64] = f2bf(o1 * inv * siluf_(bf2f(zp[lane + 64])));
    }
}

DI void phase_gemm_gate(const Params& p, unsigned char* lds, const int bid, const int nb) {
    unsigned char* ws = p.ws;
    const bf16_t* H = (const bf16_t*)(ws + OFF_H); const bf16_t* Wt = (const bf16_t*)(ws + OFF_WIN) + (size_t)C_G * 1024;
    bf16_t* SG = (bf16_t*)(ws + OFF_SG);
    const int tn = 3072 / 128, nt = (M / 128) * tn;
    for (int it = bid; it < nt; it += nb) {
        GemmTile g; gemm_zero(g);
        const int m0 = (it / tn) * 128, n0 = (it % tn) * 128;
        gemm_tile_k(g, H, 1024, Wt, 1024, m0, n0, 1024, lds);
        GEMM_FOREACH(SG[(size_t)row * 3072 + col] = f2bf(sigmoidf_(g.acc[mi][ni][r])););
    }
}
DI void phase_gemm_proj(const Params& p, unsigned char* lds, const int bid, const int nb) {
    unsigned char* ws = p.ws;
    const bf16_t* SG = (const bf16_t*)(ws + OFF_SG); bf16_t* MG = (bf16_t*)(ws + OFF_MG);
    const int tn = 1024 / 128, nt = (M / 128) * tn;
    for (int it = bid; it < nt; it += nb) {
        const int m0 = (it / tn) * 128, n0 = (it % tn) * 128;
        GemmTile mg; gemm_zero(mg);
#pragma unroll 1
        for (int br = 0; br < 3; ++br) {
            GemmTile g; gemm_zero(g);
            const bf16_t* Y = (const bf16_t*)(ws + (br == 0 ? OFF_YA : br == 1 ? OFF_YB : OFF_YC));
            const bf16_t* W = (const bf16_t*)(ws + (br == 0 ? OFF_WPA : br == 1 ? OFF_WPB : OFF_WPC));
            gemm_tile_k(g, Y, 512, W, 512, m0, n0, 512, lds);
            GEMM_FOREACH(mg.acc[mi][ni][r] += bf2f(SG[(size_t)row * 3072 + br * 1024 + col]) * g.acc[mi][ni][r];);
        }
        GEMM_FOREACH(MG[(size_t)row * 1024 + col] = f2bf(mg.acc[mi][ni][r]););
    }
}
DI void phase_gemm_out(const Params& p, unsigned char* lds, const int bid, const int nb) {
    unsigned char* ws = p.ws;
    const bf16_t* MG = (const bf16_t*)(ws + OFF_MG); const bf16_t* W = (const bf16_t*)(ws + OFF_WO);
    const int tn = 1024 / 128, nt = (M / 128) * tn;
    for (int it = bid; it < nt; it += nb) {
        GemmTile g; gemm_zero(g);
        const int m0 = (it / tn) * 128, n0 = (it % tn) * 128;
        gemm_tile_k(g, MG, 1024, W, 1024, m0, n0, 1024, lds);
        GEMM_FOREACH(p.out[(size_t)row * 1024 + col] = p.x[(size_t)row * 1024 + col] + g.acc[mi][ni][r];);
    }
}

#define XB_TMO      128
#define XB_XCNT(j)  (256  + 64 * (j))
#define XB_XSUB(j)  (1280 + 64 * (j))
#define XB_XGEN(j)  (2304 + 64 * (j))
#define XB_TOP      3328
#define XB_TOPGEN   3392
#define XCD_BAR_WORDS 3456
#define XB_SPIN_CAP (1u << 22)
#define LAS __attribute__((address_space(3)))
DI unsigned xb_ld(unsigned* p)              { return __hip_atomic_load(p, __ATOMIC_RELAXED, __HIP_MEMORY_SCOPE_AGENT); }
DI unsigned xb_add(unsigned* p, unsigned v) { return __hip_atomic_fetch_add(p, v, __ATOMIC_RELAXED, __HIP_MEMORY_SCOPE_AGENT); }
DI unsigned xb_xcc_id() { return (unsigned)__builtin_amdgcn_s_getreg((3 << 11) | 20) & 0xFu; }
#define XB_SPIN(cond, bar) do { unsigned _sp = 0; while (cond) { __builtin_amdgcn_s_sleep(1); \
    if ((++_sp & 255u) == 0u) { if (xb_ld(&(bar)[XB_TMO])) break; if (_sp > XB_SPIN_CAP) { atomicAdd(&(bar)[XB_TMO], 1u); break; } } } } while (0)
struct XcdBarrier { unsigned* bar; unsigned x; volatile LAS unsigned* st; };
DI XcdBarrier xcd_barrier_post(unsigned* bar, volatile LAS unsigned* st) {
    XcdBarrier b; b.bar = bar; b.x = xb_xcc_id(); b.st = st;
    if (threadIdx.x == 0) (void)xb_add(&bar[XB_XCNT(b.x)], 1u);
    return b;
}
DI void xcd_barrier_complete(unsigned* bar, unsigned x, unsigned& nloc, unsigned& nx) {
    const unsigned G = gridDim.x * gridDim.y * gridDim.z;
    unsigned sum, cnt, mine, sp = 0u;
    for (;;) {
        sum = 0u; cnt = 0u; mine = 0u;
#pragma unroll
        for (unsigned j = 0; j < 16; ++j) { const unsigned c = xb_ld(&bar[XB_XCNT(j)]); sum += c; cnt += (c > 0u) ? 1u : 0u; mine = (j == x) ? c : mine; }
        if (sum == G) break;
        __builtin_amdgcn_s_sleep(1);
        if ((++sp & 255u) == 0u) { if (xb_ld(&bar[XB_TMO])) break; if (sp > XB_SPIN_CAP) { atomicAdd(&bar[XB_TMO], 1u); break; } }
    }
    nloc = mine > 0u ? mine : 1u; nx = cnt > 0u ? cnt : 1u;
}
DI void xcd_barrier(const XcdBarrier& b) {
    asm volatile("s_waitcnt vmcnt(0)" ::: "memory");
    __syncthreads();
    if (threadIdx.x == 0) {
        unsigned* bar = b.bar;
        __builtin_amdgcn_s_waitcnt(0);
        unsigned nloc = b.st[0], nx = b.st[1];
        if (nloc == 0u) { xcd_barrier_complete(bar, b.x, nloc, nx); b.st[0] = nloc; b.st[1] = nx; }
        const unsigned old = xb_add(&bar[XB_XSUB(b.x)], 1u);
        const unsigned gen = old / nloc;
        if (old + 1u == (gen + 1u) * nloc) {
            __builtin_amdgcn_fence(__ATOMIC_RELEASE, "agent");
            asm volatile("s_waitcnt vmcnt(0)" ::: "memory");
            const unsigned og = xb_add(&bar[XB_TOP], 1u);
            const unsigned tg = og / nx;
            if (og + 1u == (tg + 1u) * nx) xb_add(&bar[XB_TOPGEN], 1u);
            else XB_SPIN(xb_ld(&bar[XB_TOPGEN]) == tg, bar);
            __builtin_amdgcn_fence(__ATOMIC_ACQUIRE, "agent");
            xb_add(&bar[XB_XGEN(b.x)], 1u);
            asm volatile("s_waitcnt vmcnt(0)" ::: "memory");
        } else {
            XB_SPIN(xb_ld(&bar[XB_XGEN(b.x)]) == gen, bar);
            __builtin_amdgcn_fence(__ATOMIC_ACQUIRE, "agent");
            asm volatile("s_waitcnt vmcnt(0)" ::: "memory");
        }
    }
    __syncthreads();
}

constexpr int LDS_CTL_OFF = LDS_BYTES - 256;
__global__ void __launch_bounds__(NTHREADS, 2) k_mega(Params p) {
    extern __shared__ __attribute__((aligned(16))) unsigned char lds[];
    volatile LAS unsigned* st = (volatile LAS unsigned*)(lds + LDS_CTL_OFF);
    if (threadIdx.x == 0) { st[0] = 0u; st[1] = 0u; st[2] = 0u; st[3] = 0u; }
    __syncthreads();
    (void)xcd_barrier_post((unsigned*)(p.ws + OFF_CTL), st);
#define GRID_BAR() do { XcdBarrier b_; b_.bar = (unsigned*)(p.ws + OFF_CTL); b_.x = xb_xcc_id(); b_.st = (volatile LAS unsigned*)(lds + LDS_CTL_OFF); xcd_barrier(b_); } while (0)
    const int bid = blockIdx.x, nb = gridDim.x;
    phase_prologue(p, lds, bid, nb);
    GRID_BAR();
    phase_gemm_in(p, lds, bid, nb);
    GRID_BAR();
    phase_attn_prep(p, lds, bid, nb);
    GRID_BAR();
    phase_rwkv_prep(p, lds, bid, nb);
    GRID_BAR();
    if (bid < 16) phase_rwkv_scan(p, lds, bid);
    else { phase_swa_simple(p, lds, bid - 16, nb - 16); phase_xattn_simple(p, lds, bid - 16, nb - 16); }
    GRID_BAR();
    phase_rwkv_out(p, lds, bid, nb);
    GRID_BAR();
    phase_gemm_gate(p, lds, bid, nb);
    GRID_BAR();
    phase_gemm_proj(p, lds, bid, nb);
    GRID_BAR();
    phase_gemm_out(p, lds, bid, nb);
}

extern "C" void kernel_launch(void* const* d_in, const int* in_sizes, int n_in, void* d_out, int out_size, void* d_ws, size_t ws_size, hipStream_t stream) {
    static int grid = 0;
    if (grid == 0) {
        if (n_in != 27 || ws_size < WS_END) { fprintf(stderr, "kernel_launch: unexpected inputs (n_in %d, ws %zu)\n", n_in, ws_size); grid = -1; return; }
        int dev = 0, cus = 0, per_cu = 0;
        if (hipGetDevice(&dev) != hipSuccess || hipDeviceGetAttribute(&cus, hipDeviceAttributeMultiprocessorCount, dev) != hipSuccess) { grid = -1; return; }
        if (hipFuncSetAttribute((const void*)k_mega, hipFuncAttributeMaxDynamicSharedMemorySize, LDS_BYTES) != hipSuccess) { fprintf(stderr, "kernel_launch: hipFuncSetAttribute failed\n"); grid = -1; return; }
        if (hipOccupancyMaxActiveBlocksPerMultiprocessor(&per_cu, (const void*)k_mega, NTHREADS, LDS_BYTES) != hipSuccess || per_cu < 1)
            fprintf(stderr, "kernel_launch: occupancy query reports %d workgroups per CU\n", per_cu);
        (void)hipGetLastError();
        grid = cus;
        if (grid < 32) { fprintf(stderr, "kernel_launch: too few CUs (%d)\n", grid); grid = -1; return; }
    }
    if (grid < 0) return;
    if (hipMemsetAsync((char*)d_ws + OFF_CTL, 0, 65536, stream) != hipSuccess) { fprintf(stderr, "kernel_launch: memset failed\n"); return; }
    Params p{};
    p.x = (const float*)d_in[0]; p.mem = (const float*)d_in[1]; p.pos = (const int*)d_in[2]; p.norm_g = (const float*)d_in[3]; p.mem_norm_g = (const float*)d_in[4];
    p.w_in = (const float*)d_in[5]; p.mu_rkv = (const float*)d_in[6]; p.mu_wa = (const float*)d_in[7]; p.w0 = (const float*)d_in[8]; p.w2 = (const float*)d_in[9];
    p.a0 = (const float*)d_in[10]; p.a2 = (const float*)d_in[11]; p.k_k = (const float*)d_in[12]; p.k_a = (const float*)d_in[13]; p.r_k = (const float*)d_in[14];
    p.lnx_g = (const float*)d_in[15]; p.lnx_b = (const float*)d_in[16]; p.q_norm_g = (const float*)d_in[17]; p.k_norm_g = (const float*)d_in[18]; p.sinks = (const float*)d_in[19];
    p.xq_norm_g = (const float*)d_in[20]; p.xk_norm_g = (const float*)d_in[21]; p.w_mem_kv = (const float*)d_in[22]; p.w_proj_a = (const float*)d_in[23];
    p.w_proj_b = (const float*)d_in[24]; p.w_proj_c = (const float*)d_in[25]; p.w_out = (const float*)d_in[26];
    p.out = (float*)d_out; p.ws = (unsigned char*)d_ws;
    hipLaunchKernelGGL(k_mega, dim3(grid), dim3(NTHREADS), LDS_BYTES, stream, p);
}
```

```cpp
#include <hip/hip_runtime.h>
#include <stdint.h>
#include <stdio.h>

#define DI __device__ __forceinline__
typedef unsigned short bf16_t;
typedef short bf16x8 __attribute__((ext_vector_type(8)));
typedef float f32x4 __attribute__((ext_vector_type(4)));

constexpr int BATCH = 2, T = 8192, M = BATCH * T, D = 1024, NIN = 7552, NP = 4608  ;
constexpr int MEMLEN = 256, MM = BATCH * MEMLEN;
constexpr int C_R = 0, C_K = 512, C_V = 1024, C_W = 1536, C_A = 1600, C_ZA = 1664, C_Q = 2176, C_SK = 2688, C_SV = 2816, C_ZB = 2944, C_XQ = 3456, C_ZC = 3968, C_G = 4480;
constexpr int NTHREADS = 512, NWAVES = 8;
constexpr int LDS_BYTES = 147456;

constexpr size_t OFF_CTL = 0;
constexpr size_t OFF_WIN = 65536;
constexpr size_t OFF_WKV = OFF_WIN + (size_t)7680 * 1024 * 2;
constexpr size_t OFF_WPA = OFF_WKV + (size_t)1024 * 1024 * 2;
constexpr size_t OFF_WPB = OFF_WPA + (size_t)1024 * 512 * 2;
constexpr size_t OFF_WPC = OFF_WPB + (size_t)1024 * 512 * 2;
constexpr size_t OFF_WO  = OFF_WPC + (size_t)1024 * 512 * 2;
constexpr size_t OFF_H   = OFF_WO + (size_t)1024 * 1024 * 2;
constexpr size_t OFF_HM  = OFF_H + (size_t)M * 1024 * 2;
constexpr size_t OFF_KVM = OFF_HM + (size_t)MM * 1024 * 2;
constexpr size_t OFF_ROPE = OFF_KVM + (size_t)MM * 1024 * 2;
constexpr size_t OFF_P   = OFF_ROPE + (size_t)M * 32 * 8;
constexpr size_t OFF_YA  = OFF_P + (size_t)M * NP * 2;
constexpr size_t OFF_YB  = OFF_YA + (size_t)M * 512 * 2;
constexpr size_t OFF_YC  = OFF_YB + (size_t)M * 512 * 2;
constexpr size_t WS_END  = OFF_YC + (size_t)M * 512 * 2;
constexpr size_t OFF_SG  = OFF_P;
constexpr size_t OFF_MG  = OFF_P + (size_t)M * 3072 * 2;
static_assert(WS_END <= (size_t)256 * 1024 * 1024, "workspace");
static_assert(OFF_MG + (size_t)M * 1024 * 2 <= OFF_YA, "overlay");

struct Params {
    const float* x; const float* mem; const int* pos; const float* norm_g; const float* mem_norm_g; const float* w_in;
    const float* mu_rkv; const float* mu_wa; const float* w0; const float* w2; const float* a0; const float* a2;
    const float* k_k; const float* k_a; const float* r_k; const float* lnx_g; const float* lnx_b;
    const float* q_norm_g; const float* k_norm_g; const float* sinks; const float* xq_norm_g; const float* xk_norm_g;
    const float* w_mem_kv; const float* w_proj_a; const float* w_proj_b; const float* w_proj_c; const float* w_out;
    float* out; unsigned char* ws;
};

DI bf16_t f2bf(float x) { return __builtin_bit_cast(unsigned short, (__bf16)x); }
DI float bf2f(bf16_t h) { return __uint_as_float(((unsigned)h) << 16); }
DI float wave_sum(float v) {
#pragma unroll
    for (int o = 32; o > 0; o >>= 1) v += __shfl_xor(v, o, 64);
    return v;
}
DI float wave_max(float v) {
#pragma unroll
    for (int o = 32; o > 0; o >>= 1) v = fmaxf(v, __shfl_xor(v, o, 64));
    return v;
}
DI float sigmoidf_(float x) { return 1.f / (1.f + __expf(-x)); }
DI float siluf_(float x) { return x / (1.f + __expf(-x)); }

DI void transpose_convert(const float* W, int K, int N, bf16_t* Wt, int item, float* tile  ) {
    const int tn = N / 64, kt = item / tn, nt = item % tn, tid = threadIdx.x;
    __syncthreads();
    for (int e = tid; e < 4096; e += NTHREADS) { const int r = e >> 6, c = e & 63; tile[r * 65 + c] = W[(size_t)(kt * 64 + r) * N + nt * 64 + c]; }
    __syncthreads();
    for (int e = tid; e < 4096; e += NTHREADS) { const int n = e >> 6, k = e & 63; Wt[(size_t)(nt * 64 + n) * K + kt * 64 + k] = f2bf(tile[k * 65 + n]); }
}

DI void phase_prologue(const Params& p, unsigned char* lds, const int bid, const int nb) {
    float* tile = (float*)lds;
    unsigned char* ws = p.ws;
    const int n_in = (1024 / 64) * (NIN / 64), n_kv = 16 * 16, n_pr = (512 / 64) * 16, n_o = 16 * 16;
    const int total = n_in + n_kv + 3 * n_pr + n_o;
    for (int it = bid; it < total; it += nb) {
        int i = it;
        if (i < n_in) { transpose_convert(p.w_in, 1024, NIN, (bf16_t*)(ws + OFF_WIN), i, tile); continue; } i -= n_in;
        if (i < n_kv) { transpose_convert(p.w_mem_kv, 1024, 1024, (bf16_t*)(ws + OFF_WKV), i, tile); continue; } i -= n_kv;
        if (i < n_pr) { transpose_convert(p.w_proj_a, 512, 1024, (bf16_t*)(ws + OFF_WPA), i, tile); continue; } i -= n_pr;
        if (i < n_pr) { transpose_convert(p.w_proj_b, 512, 1024, (bf16_t*)(ws + OFF_WPB), i, tile); continue; } i -= n_pr;
        if (i < n_pr) { transpose_convert(p.w_proj_c, 512, 1024, (bf16_t*)(ws + OFF_WPC), i, tile); continue; } i -= n_pr;
        transpose_convert(p.w_out, 1024, 1024, (bf16_t*)(ws + OFF_WO), i, tile);
    }
    {
        unsigned* z = (unsigned*)(ws + OFF_WIN + (size_t)NIN * 1024 * 2);
        const int nz = (7680 - NIN) * 1024 / 2;
        for (int i = bid * NTHREADS + threadIdx.x; i < nz; i += nb * NTHREADS) z[i] = 0u;
    }
    const int lane = threadIdx.x & 63, wid = threadIdx.x >> 6;
    for (int row = bid * NWAVES + wid; row < M + MM; row += nb * NWAVES) {
        const float* src = row < M ? p.x + (size_t)row * D : p.mem + (size_t)(row - M) * D;
        const float* g = row < M ? p.norm_g : p.mem_norm_g;
        bf16_t* dst = row < M ? (bf16_t*)(ws + OFF_H) + (size_t)row * D : (bf16_t*)(ws + OFF_HM) + (size_t)(row - M) * D;
        f32x4 v[4]; float ss = 0.f;
#pragma unroll
        for (int i = 0; i < 4; ++i) { v[i] = *(const f32x4*)(src + i * 256 + lane * 4); ss += v[i][0] * v[i][0] + v[i][1] * v[i][1] + v[i][2] * v[i][2] + v[i][3] * v[i][3]; }
        ss = wave_sum(ss);
        const float rs = rsqrtf(ss * (1.f / 1024.f) + 1e-6f);
#pragma unroll
        for (int i = 0; i < 4; ++i) {
            const f32x4 gg = *(const f32x4*)(g + i * 256 + lane * 4);
            ushort4 o; o.x = f2bf(v[i][0] * rs * gg[0]); o.y = f2bf(v[i][1] * rs * gg[1]); o.z = f2bf(v[i][2] * rs * gg[2]); o.w = f2bf(v[i][3] * rs * gg[3]);
            *(ushort4*)(dst + i * 256 + lane * 4) = o;
        }
    }
    float2* rope = (float2*)(ws + OFF_ROPE);
    for (int i = bid * NTHREADS + threadIdx.x; i < M * 32; i += nb * NTHREADS) {
        const int row = i >> 5, f = i & 31;
        const double inv = pow(10000.0, -(double)f / 32.0);
        const double ang = (double)p.pos[row] * inv;
        double s, c; sincos(ang, &s, &c);
        rope[i] = make_float2((float)c, (float)s);
    }
}

struct GemmTile { f32x4 acc[2][4]; };
DI void gemm_tile_k(GemmTile& g, const bf16_t* A, int lda, const bf16_t* Bt, int ldb, int m0, int n0, int K, unsigned char* lds) {
    bf16_t* sA = (bf16_t*)lds;
    bf16_t* sB = sA + 128 * 40;
    const int tid = threadIdx.x, lane = tid & 63, wid = tid >> 6, wm = wid & 3, wn = wid >> 2;
    const int srow = tid >> 2, sch = tid & 3;
    const bf16_t* ga = A + (size_t)(m0 + srow) * lda + sch * 8;
    const bf16_t* gb = Bt + (size_t)(n0 + srow) * ldb + sch * 8;
    const int fr = lane & 15, fq = lane >> 4;
    uint4 ra = *(const uint4*)ga, rb = *(const uint4*)gb;
    for (int k0 = 0; k0 < K; k0 += 32) {
        __syncthreads();
        *(uint4*)(sA + srow * 40 + sch * 8) = ra;
        *(uint4*)(sB + srow * 40 + sch * 8) = rb;
        __syncthreads();
        if (k0 + 32 < K) { ra = *(const uint4*)(ga + k0 + 32); rb = *(const uint4*)(gb + k0 + 32); }
        bf16x8 af[2], bfr[4];
#pragma unroll
        for (int mi = 0; mi < 2; ++mi) af[mi] = *(const bf16x8*)(sA + (wm * 32 + mi * 16 + fr) * 40 + fq * 8);
#pragma unroll
        for (int ni = 0; ni < 4; ++ni) bfr[ni] = *(const bf16x8*)(sB + (wn * 64 + ni * 16 + fr) * 40 + fq * 8);
#pragma unroll
        for (int mi = 0; mi < 2; ++mi)
#pragma unroll
            for (int ni = 0; ni < 4; ++ni) g.acc[mi][ni] = __builtin_amdgcn_mfma_f32_16x16x32_bf16(af[mi], bfr[ni], g.acc[mi][ni], 0, 0, 0);
    }
}
DI void gemm_zero(GemmTile& g) {
#pragma unroll
    for (int mi = 0; mi < 2; ++mi)
#pragma unroll
        for (int ni = 0; ni < 4; ++ni) g.acc[mi][ni] = (f32x4){0.f, 0.f, 0.f, 0.f};
}
#define GEMM_FOREACH(body) do { const int lane_ = threadIdx.x & 63, wid_ = threadIdx.x >> 6, wm_ = wid_ & 3, wn_ = wid_ >> 2, fr_ = lane_ & 15, fq_ = lane_ >> 4; \
    _Pragma("unroll") for (int mi = 0; mi < 2; ++mi) _Pragma("unroll") for (int ni = 0; ni < 4; ++ni) _Pragma("unroll") for (int r = 0; r < 4; ++r) { \
        const int row = m0 + wm_ * 32 + mi * 16 + fq_ * 4 + r, col = n0 + wn_ * 64 + ni * 16 + fr_; body } } while (0)

DI void phase_gemm_in(const Params& p, unsigned char* lds, const int bid, const int nb) {
    unsigned char* ws = p.ws;
    const bf16_t* H = (const bf16_t*)(ws + OFF_H); const bf16_t* Wt = (const bf16_t*)(ws + OFF_WIN);
    bf16_t* P = (bf16_t*)(ws + OFF_P);
    const int tn = NP / 128, nt1 = (M / 128) * tn;
    const int tn2 = 1024 / 128, nt2 = (MM / 128) * tn2;
    for (int it = bid; it < nt1 + nt2; it += nb) {
        GemmTile g; gemm_zero(g);
        if (it < nt1) {
            const int m0 = (it / tn) * 128, n0 = (it % tn) * 128;
            gemm_tile_k(g, H, 1024, Wt, 1024, m0, n0, 1024, lds);
            GEMM_FOREACH(P[(size_t)row * NP + col] = f2bf(g.acc[mi][ni][r]););
        } else {
            const int i2 = it - nt1; const int m0 = (i2 / tn2) * 128, n0 = (i2 % tn2) * 128;
            gemm_tile_k(g, (const bf16_t*)(ws + OFF_HM), 1024, (const bf16_t*)(ws + OFF_WKV), 1024, m0, n0, 1024, lds);
            bf16_t* KVM = (bf16_t*)(ws + OFF_KVM);
            GEMM_FOREACH(KVM[(size_t)row * 1024 + col] = f2bf(g.acc[mi][ni][r]););
        }
    }
}

DI void phase_attn_prep(const Params& p, unsigned char* lds, const int bid, const int nb) {
    unsigned char* ws = p.ws; bf16_t* P = (bf16_t*)(ws + OFF_P); bf16_t* KVM = (bf16_t*)(ws + OFF_KVM);
    const float2* rope = (const float2*)(ws + OFF_ROPE);
    const int lane = threadIdx.x & 63, wid = threadIdx.x >> 6;
    const long n1 = (long)M * 14, n2 = (long)MM * 4;
    for (long it = (long)bid * NWAVES + wid; it < n1 + n2; it += (long)nb * NWAVES) {
        if (it < n1) {
            const int row = (int)(it / 14), j = (int)(it % 14);
            if (j < 10) {
                bf16_t* ptr = P + (size_t)row * NP + (j < 8 ? C_Q + j * 64 : C_SK + (j - 8) * 64);
                const float g = j < 8 ? p.q_norm_g[lane] : p.k_norm_g[lane];
                const float xv = bf2f(ptr[lane]);
                const float ss = wave_sum(xv * xv);
                const float y = xv * rsqrtf(ss * (1.f / 64.f) + 1e-6f) * g;
                const float yp = __shfl_xor(y, 32, 64);
                const float2 cs = rope[(size_t)row * 32 + (lane & 31)];
                const float o = lane < 32 ? y * cs.x - yp * cs.y : y * cs.x + yp * cs.y;
                ptr[lane] = f2bf(o);
            } else {
                bf16_t* ptr = P + (size_t)row * NP + C_XQ + (j - 10) * 128;
                const float x0 = bf2f(ptr[lane]), x1 = bf2f(ptr[lane + 64]);
                const float ss = wave_sum(x0 * x0 + x1 * x1);
                const float rs = rsqrtf(ss * (1.f / 128.f) + 1e-6f);
                ptr[lane] = f2bf(x0 * rs * p.xq_norm_g[lane]); ptr[lane + 64] = f2bf(x1 * rs * p.xq_norm_g[lane + 64]);
            }
        } else {
            const long i2 = it - n1; const int row = (int)(i2 / 4), j = (int)(i2 % 4);
            bf16_t* ptr = KVM + (size_t)row * 1024 + j * 128;
            const float x0 = bf2f(ptr[lane]), x1 = bf2f(ptr[lane + 64]);
            const float ss = wave_sum(x0 * x0 + x1 * x1);
            const float rs = rsqrtf(ss * (1.f / 128.f) + 1e-6f);
            ptr[lane] = f2bf(x0 * rs * p.xk_norm_g[lane]); ptr[lane + 64] = f2bf(x1 * rs * p.xk_norm_g[lane + 64]);
        }
    }
}

DI void rwkv_stage(const Params& p, int b, int h, int t0, int ntok, float* ck, float* scratch  ) {
    const bf16_t* P = (const bf16_t*)(p.ws + OFF_P);
    const int lane = threadIdx.x & 63, wid = threadIdx.x >> 6, ch = h * 64 + lane;
    const float mu_r = p.mu_rkv[ch], mu_k = p.mu_rkv[512 + ch], mu_v = p.mu_rkv[1024 + ch], mu_w = p.mu_wa[lane], mu_a = p.mu_wa[64 + lane];
    const float w0c = p.w0[ch], a0c = p.a0[ch], kkc = p.k_k[ch], kac = p.k_a[ch];
    float* sc = scratch + wid * 128;
    for (int i = wid; i < ntok; i += NWAVES) {
        const int t = t0 + i; const bf16_t* pr = P + (size_t)(b * T + t) * NP; const bf16_t* pp = pr - NP; const bool hp = t > 0;
        const float rc = bf2f(pr[C_R + ch]), rp = hp ? bf2f(pp[C_R + ch]) : 0.f;
        const float kc = bf2f(pr[C_K + ch]), kp = hp ? bf2f(pp[C_K + ch]) : 0.f;
        const float vc = bf2f(pr[C_V + ch]), vp = hp ? bf2f(pp[C_V + ch]) : 0.f;
        const float wc = bf2f(pr[C_W + lane]), wp = hp ? bf2f(pp[C_W + lane]) : 0.f;
        const float ac = bf2f(pr[C_A + lane]), ap = hp ? bf2f(pp[C_A + lane]) : 0.f;
        const float r = rc + (rp - rc) * mu_r, k = kc + (kp - kc) * mu_k, v = vc + (vp - vc) * mu_v;
        const float lw = wc + (wp - wc) * mu_w, la = ac + (ap - ac) * mu_a;
        sc[lane] = tanhf(lw); sc[64 + lane] = la;
        float accw = 0.f, acca = 0.f;
#pragma unroll 8
        for (int j = 0; j < 64; ++j) { accw += sc[j] * p.w2[j * 512 + ch]; acca += sc[64 + j] * p.a2[j * 512 + ch]; }
        const float xw = -(w0c + accw);
        const float sp = xw > 20.f ? xw : log1pf(expf(xw));
        const float wlog = -sp - 0.5f;
        const float decay = expf(-expf(wlog));
        const float alpha = 1.f / (1.f + expf(-(a0c + acca)));
        const float kk0 = k * kkc;
        const float n2 = wave_sum(kk0 * kk0);
        const float kk = kk0 / fmaxf(sqrtf(n2), 1e-12f);
        const float k2 = k * (1.f + (alpha - 1.f) * kac);
        float* o = ck + i * 384;
        o[lane] = r; o[64 + lane] = decay; o[128 + lane] = k2; o[192 + lane] = v; o[256 + lane] = -kk; o[320 + lane] = kk * alpha;
    }
}

DI void phase_rwkv_direct(const Params& p, unsigned char* lds, const int bid, const int nb) {
    float* ck = (float*)lds; float* scratch = ck + 64 * 384;
    const int lane = threadIdx.x & 63, wid = threadIdx.x >> 6;
    const bf16_t* P = (const bf16_t*)(p.ws + OFF_P); bf16_t* YA = (bf16_t*)(p.ws + OFF_YA);
    for (int bh = bid; bh < BATCH * 8; bh += nb) {
        const int b = bh >> 3, h = bh & 7, ch = h * 64 + lane;
        float S[64];
#pragma unroll
        for (int k = 0; k < 64; ++k) S[k] = 0.f;
        const float rk = p.r_k[ch], lg = p.lnx_g[ch], lb = p.lnx_b[ch];
        for (int c = 0; c < T / 64; ++c) {
            __syncthreads();
            rwkv_stage(p, b, h, c * 64, 64, ck, scratch);
            __syncthreads();
            if (wid == 0) {
                for (int i = 0; i < 64; ++i) {
                    const float* cc = ck + i * 384;
                    float sa = 0.f;
#pragma unroll
                    for (int k = 0; k < 64; ++k) sa += S[k] * cc[256 + k];
                    const float vv = cc[192 + lane];
#pragma unroll
                    for (int k = 0; k < 64; ++k) S[k] = S[k] * cc[64 + k] + sa * cc[320 + k] + vv * cc[128 + k];
                    float y = 0.f;
#pragma unroll
                    for (int k = 0; k < 64; ++k) y += S[k] * cc[k];
                    const float mean = wave_sum(y) * (1.f / 64.f);
                    const float dy = y - mean;
                    const float var = wave_sum(dy * dy) * (1.f / 64.f);
                    const float yn = dy * rsqrtf(var + 64e-5f) * lg + lb;
                    const float bonus = wave_sum(cc[lane] * cc[128 + lane] * rk) * vv;
                    const int t = c * 64 + i; const size_t row = (size_t)(b * T + t);
                    const float z = bf2f(P[row * NP + C_ZA + ch]);
                    YA[row * 512 + ch] = f2bf((yn + bonus) * siluf_(z));
                }
            }
        }
    }
}

constexpr size_t AF_BYTES = 16384, NF_BYTES = 16384, NCHUNK = 128;
constexpr size_t OFF_AF = 0, OFF_NF = (size_t)16 * NCHUNK * AF_BYTES;
typedef float f32x16 __attribute__((ext_vector_type(16)));
typedef float f32x2 __attribute__((ext_vector_type(2)));

DI float quad_sum(float s) {
    s += __int_as_float(__builtin_amdgcn_update_dpp(0, __float_as_int(s), 0xB1, 0xF, 0xF, true));
    s += __int_as_float(__builtin_amdgcn_update_dpp(0, __float_as_int(s), 0x4E, 0xF, 0xF, true));
    return s;
}

DI float rwkv_stage_tok(const Params& p, const bf16_t* P, int b, int h, int t, float* o, float* sc, float mu_r, float mu_k, float mu_v, float mu_w, float mu_a,
                        float w0c, float a0c, float kkc, float kac, float rkc) {
    const int lane = threadIdx.x & 63, ch = h * 64 + lane;
    const bf16_t* pr = P + (size_t)(b * T + t) * NP; const bf16_t* pp = pr - NP; const bool hp = t > 0;
    const float rc = bf2f(pr[C_R + ch]), rp = hp ? bf2f(pp[C_R + ch]) : 0.f;
    const float kc = bf2f(pr[C_K + ch]), kp = hp ? bf2f(pp[C_K + ch]) : 0.f;
    const float vc = bf2f(pr[C_V + ch]), vp = hp ? bf2f(pp[C_V + ch]) : 0.f;
    const float wc = bf2f(pr[C_W + lane]), wp = hp ? bf2f(pp[C_W + lane]) : 0.f;
    const float ac = bf2f(pr[C_A + lane]), ap = hp ? bf2f(pp[C_A + lane]) : 0.f;
    const float r = rc + (rp - rc) * mu_r, k = kc + (kp - kc) * mu_k, v = vc + (vp - vc) * mu_v;
    const float lw = wc + (wp - wc) * mu_w, la = ac + (ap - ac) * mu_a;
    sc[lane] = tanhf(lw); sc[64 + lane] = la;
    float accw = 0.f, acca = 0.f;
    const float* w2p = p.w2; const float* a2p = p.a2;
    asm volatile("" : "+s"(w2p), "+s"(a2p));
#pragma unroll 8
    for (int j = 0; j < 64; ++j) { accw += sc[j] * w2p[j * 512 + ch]; acca += sc[64 + j] * a2p[j * 512 + ch]; }
    const float xw = -(w0c + accw);
    const float sp = xw > 20.f ? xw : log1pf(expf(xw));
    const float decay = expf(-expf(-sp - 0.5f));
    const float alpha = 1.f / (1.f + expf(-(a0c + acca)));
    const float kk0 = k * kkc;
    const float n2 = wave_sum(kk0 * kk0);
    const float kk = kk0 / fmaxf(sqrtf(n2), 1e-12f);
    const float k2 = k * (1.f + (alpha - 1.f) * kac);
    o[lane] = r; o[64 + lane] = decay; o[128 + lane] = k2; o[192 + lane] = v; o[256 + lane] = -kk; o[320 + lane] = kk * alpha;
    return wave_sum(r * k2 * rkc);
}

template <int MODE> DI void rwkv_step(float (&z)[4][16], const float* cc, int q, int g, float (&sa)[4]) {
    f32x4 av[4], wv[4], bv[4], kv[4];
#pragma unroll
    for (int u = 0; u < 4; ++u) { av[u] = *(const f32x4*)(cc + 256 + 16 * q + 4 * u); wv[u] = *(const f32x4*)(cc + 64 + 16 * q + 4 * u); bv[u] = *(const f32x4*)(cc + 320 + 16 * q + 4 * u);
        if (MODE == 1) kv[u] = *(const f32x4*)(cc + 128 + 16 * q + 4 * u); }
    f32x4 vr = (f32x4){0.f, 0.f, 0.f, 0.f};
    if (MODE == 1) vr = *(const f32x4*)(cc + 192 + 4 * g);
#pragma unroll
    for (int rr = 0; rr < 4; ++rr) {
        float s0 = 0.f, s1 = 0.f;
#pragma unroll
        for (int u = 0; u < 4; ++u) { s0 += z[rr][4 * u] * av[u][0] + z[rr][4 * u + 2] * av[u][2]; s1 += z[rr][4 * u + 1] * av[u][1] + z[rr][4 * u + 3] * av[u][3]; }
        sa[rr] = quad_sum(s0 + s1);
    }
#pragma unroll
    for (int rr = 0; rr < 4; ++rr)
#pragma unroll
        for (int u = 0; u < 4; ++u)
#pragma unroll
            for (int e = 0; e < 4; ++e) {
                float t = sa[rr] * bv[u][e];
                if (MODE == 1) t += vr[rr] * kv[u][e];
                z[rr][4 * u + e] = z[rr][4 * u + e] * wv[u][e] + t;
            }
}

DI void phase_rwkv_prep(const Params& p, unsigned char* lds, const int bid, const int nb) {
    float* ck = (float*)lds; float* scratch = ck + 64 * 384; float* mat = (float*)lds;
    const bf16_t* P = (const bf16_t*)(p.ws + OFF_P);
    unsigned char* fr = (unsigned char*)p.out;
    const int tid = threadIdx.x, lane = tid & 63, wid = tid >> 6, q = lane & 3, g = lane >> 2, cl = wid >> 1, role = wid & 1;
    for (int item = bid; item < 512; item += nb) {
        const int bh = item >> 5, cq = item & 31, b = bh >> 3, h = bh & 7, ch = h * 64 + lane;
        const float mu_r = p.mu_rkv[ch], mu_k = p.mu_rkv[512 + ch], mu_v = p.mu_rkv[1024 + ch], mu_w = p.mu_wa[lane], mu_a = p.mu_wa[64 + lane];
        const float w0c = p.w0[ch], a0c = p.a0[ch], kkc = p.k_k[ch], kac = p.k_a[ch], rkc = p.r_k[ch];
        float z[4][16];
#pragma unroll
        for (int rr = 0; rr < 4; ++rr)
#pragma unroll
            for (int c = 0; c < 16; ++c) z[rr][c] = (role == 0 && (4 * g + rr) == (16 * q + c)) ? 1.f : 0.f;
        for (int sl = 0; sl < 4; ++sl) {
            __syncthreads();
#pragma unroll 1
            for (int sidx = wid; sidx < 64; sidx += NWAVES) {
                const int clx = sidx >> 4, i = sidx & 15, t = (cq * 4 + clx) * 64 + sl * 16 + i;
                (void)rwkv_stage_tok(p, P, b, h, t, ck + sidx * 384, scratch + wid * 128, mu_r, mu_k, mu_v, mu_w, mu_a, w0c, a0c, kkc, kac, rkc);
            }
            __syncthreads();
            float sa[4];
            if (role == 0) {
#pragma unroll 1
                for (int i = 0; i < 16; ++i) rwkv_step<0>(z, ck + (cl * 16 + i) * 384, q, g, sa); }
            else {
#pragma unroll 1
                for (int i = 0; i < 16; ++i) rwkv_step<1>(z, ck + (cl * 16 + i) * 384, q, g, sa); }
        }
        for (int pass = 0; pass < 2; ++pass) {
            __syncthreads();
            if (role == pass) {
#pragma unroll
                for (int rr = 0; rr < 4; ++rr)
#pragma unroll
                    for (int u = 0; u < 4; ++u) *(f32x4*)(mat + (cl * 64 + 4 * g + rr) * 68 + 16 * q + 4 * u) = (f32x4){z[rr][4 * u], z[rr][4 * u + 1], z[rr][4 * u + 2], z[rr][4 * u + 3]};
            }
            __syncthreads();
            if (pass == 0) {
                for (int it = tid; it < 4 * 8 * 64; it += NTHREADS) {
                    const int clx = it >> 9, f = (it >> 6) & 7, l = it & 63, r = l & 31, hh = l >> 5, fi = f >> 2, fj = (f >> 1) & 1, fs = f & 1;
                    const size_t chunk = (size_t)bh * NCHUNK + cq * 4 + clx;
                    unsigned hi[4], lo[4];
#pragma unroll
                    for (int e2 = 0; e2 < 4; ++e2) {
                        unsigned short hs[2], ls[2];
#pragma unroll
                        for (int d = 0; d < 2; ++d) { const int e = 2 * e2 + d, kin = 32 * fj + 16 * fs + 8 * (e >> 2) + 4 * hh + (e & 3), kout = 32 * fi + r;
                            const float val = mat[(clx * 64 + kin) * 68 + kout]; hs[d] = f2bf(val); ls[d] = f2bf(val - bf2f(hs[d])); }
                        hi[e2] = (unsigned)hs[0] | ((unsigned)hs[1] << 16); lo[e2] = (unsigned)ls[0] | ((unsigned)ls[1] << 16);
                    }
                    unsigned char* dst = fr + OFF_AF + chunk * AF_BYTES + (size_t)((f * 2) * 64 + l) * 16;
                    *(uint4*)dst = make_uint4(hi[0], hi[1], hi[2], hi[3]);
                    *(uint4*)(dst + 64 * 16) = make_uint4(lo[0], lo[1], lo[2], lo[3]);
                }
            } else {
                for (int it = tid; it < 4 * 2 * 2 * 64 * 4; it += NTHREADS) {
                    const int gq = it & 3, l = (it >> 2) & 63, fi = (it >> 8) & 1, w2 = (it >> 9) & 1, clx = it >> 10, hh = l >> 5;
                    const size_t chunk = (size_t)bh * NCHUNK + cq * 4 + clx;
                    const f32x4 v4 = *(const f32x4*)(mat + (clx * 64 + 32 * w2 + (l & 31)) * 68 + 32 * fi + 8 * gq + 4 * hh);
                    *(f32x4*)(fr + OFF_NF + chunk * NF_BYTES + (size_t)(((w2 * 2 + fi) * 64 + l) * 16 + 4 * gq) * 4) = v4;
                }
            }
        }
    }
}

DI void split8(const f32x16& x, int s, bf16x8& hi, bf16x8& lo) {
#pragma unroll
    for (int e = 0; e < 8; ++e) { const float v = x[8 * s + e]; const bf16_t hb = f2bf(v); hi[e] = (short)hb; lo[e] = (short)f2bf(v - bf2f(hb)); }
}
DI void phase_rwkv_scan(const Params& p, unsigned char* lds, const int bh) {
    unsigned char* fr = (unsigned char*)p.out;
    const int tid = threadIdx.x, lane = tid & 63, wid = tid >> 6;
    const unsigned char* gA = fr + OFF_AF + (size_t)bh * NCHUNK * AF_BYTES;
    unsigned char* gN = fr + OFF_NF + (size_t)bh * NCHUNK * NF_BYTES;
    __syncthreads();
    for (int c = 0; c < 3; ++c)
        for (int e = tid; e < 2048; e += NTHREADS) {
            const uint4 v = e < 1024 ? *(const uint4*)(gA + (size_t)c * AF_BYTES + e * 16) : *(const uint4*)(gN + (size_t)c * NF_BYTES + (e - 1024) * 16);
            *(uint4*)(lds + c * 32768 + e * 16) = v;
        }
    const int ltid = tid - 128;
    const bool loader = (wid >= 2 && wid < 6);
    uint4 la0, la1, la2, la3, ln0, ln1, ln2, ln3;
#define SCAN_LOAD(cc_) do { const unsigned char* a_ = gA + (size_t)(cc_) * AF_BYTES + ltid * 16; const unsigned char* n_ = gN + (size_t)(cc_) * NF_BYTES + ltid * 16; \
        la0 = *(const uint4*)a_; la1 = *(const uint4*)(a_ + 4096); la2 = *(const uint4*)(a_ + 8192); la3 = *(const uint4*)(a_ + 12288); \
        ln0 = *(const uint4*)n_; ln1 = *(const uint4*)(n_ + 4096); ln2 = *(const uint4*)(n_ + 8192); ln3 = *(const uint4*)(n_ + 12288); } while (0)
#define SCAN_WRITE(slot_) do { unsigned char* d_ = lds + (slot_) * 32768 + ltid * 16; \
        *(uint4*)d_ = la0; *(uint4*)(d_ + 4096) = la1; *(uint4*)(d_ + 8192) = la2; *(uint4*)(d_ + 12288) = la3; \
        *(uint4*)(d_ + 16384) = ln0; *(uint4*)(d_ + 20480) = ln1; *(uint4*)(d_ + 24576) = ln2; *(uint4*)(d_ + 28672) = ln3; } while (0)
    if (loader) SCAN_LOAD(3);
    f32x16 X0, X1;
#pragma unroll
    for (int i = 0; i < 16; ++i) { X0[i] = 0.f; X1[i] = 0.f; }
    for (int c = 0; c < (int)NCHUNK; ++c) {
        __syncthreads();
        if (wid >= 2) {
            if (loader) {
                if (c + 3 < (int)NCHUNK) SCAN_WRITE((c + 3) & 3);
                if (c + 4 < (int)NCHUNK) SCAN_LOAD(c + 4);
            }
        } else {
            const int w2 = wid;
            const unsigned char* slot = lds + (c & 3) * 32768;
            float* gs = (float*)(gN + (size_t)c * NF_BYTES) + ((w2 * 2) * 64 + lane) * 16;
#pragma unroll
            for (int gq = 0; gq < 4; ++gq) { *(f32x4*)(gs + 4 * gq) = (f32x4){X0[4 * gq], X0[4 * gq + 1], X0[4 * gq + 2], X0[4 * gq + 3]};
                                             *(f32x4*)(gs + 64 * 16 + 4 * gq) = (f32x4){X1[4 * gq], X1[4 * gq + 1], X1[4 * gq + 2], X1[4 * gq + 3]}; }
            bf16x8 bhi[2][2], blo[2][2];
            split8(X0, 0, bhi[0][0], blo[0][0]); split8(X0, 1, bhi[0][1], blo[0][1]); split8(X1, 0, bhi[1][0], blo[1][0]); split8(X1, 1, bhi[1][1], blo[1][1]);
            f32x16 Dn[2];
#pragma unroll
            for (int i = 0; i < 2; ++i) {
                const float* np = (const float*)(slot + 16384) + ((w2 * 2 + i) * 64 + lane) * 16;
#pragma unroll
                for (int gq = 0; gq < 4; ++gq) { const f32x4 v4 = *(const f32x4*)(np + 4 * gq); Dn[i][4 * gq] = v4[0]; Dn[i][4 * gq + 1] = v4[1]; Dn[i][4 * gq + 2] = v4[2]; Dn[i][4 * gq + 3] = v4[3]; }
#pragma unroll
                for (int j = 0; j < 2; ++j)
#pragma unroll
                    for (int s = 0; s < 2; ++s) {
                        const int f = (i * 2 + j) * 2 + s;
                        const bf16x8 ah = *(const bf16x8*)(slot + ((f * 2) * 64 + lane) * 16), al = *(const bf16x8*)(slot + ((f * 2 + 1) * 64 + lane) * 16);
                        Dn[i] = __builtin_amdgcn_mfma_f32_32x32x16_bf16(ah, bhi[j][s], Dn[i], 0, 0, 0);
                        Dn[i] = __builtin_amdgcn_mfma_f32_32x32x16_bf16(ah, blo[j][s], Dn[i], 0, 0, 0);
                        Dn[i] = __builtin_amdgcn_mfma_f32_32x32x16_bf16(al, bhi[j][s], Dn[i], 0, 0, 0);
                    }
            }
            X0 = Dn[0]; X1 = Dn[1];
        }
    }
}

constexpr int RS3 = 464;
DI void phase_rwkv_out(const Params& p, unsigned char* lds, const int bid, const int nb) {
    const bf16_t* P = (const bf16_t*)(p.ws + OFF_P); bf16_t* YA = (bf16_t*)(p.ws + OFF_YA);
    const unsigned char* fr = (const unsigned char*)p.out;
    const int tid = threadIdx.x, lane = tid & 63, wid = tid >> 6, q = lane & 3, g = lane >> 2;
    float* ck = (float*)lds + wid * (8 * RS3); float* sc = (float*)lds + 8 * 8 * RS3 + wid * 128;
    for (int item = bid; item < 256; item += nb) {
        const int bh = item >> 4, co = item & 15, b = bh >> 3, h = bh & 7, ch = h * 64 + lane, c = co * 8 + wid;
        const float mu_r = p.mu_rkv[ch], mu_k = p.mu_rkv[512 + ch], mu_v = p.mu_rkv[1024 + ch], mu_w = p.mu_wa[lane], mu_a = p.mu_wa[64 + lane];
        const float w0c = p.w0[ch], a0c = p.a0[ch], kkc = p.k_k[ch], kac = p.k_a[ch], rkc = p.r_k[ch];
        const int vo = 4 * g + q;
        const float lg = p.lnx_g[h * 64 + vo], lb = p.lnx_b[h * 64 + vo];
        float z[4][16];
        {
            const float* sf = (const float*)(fr + OFF_NF + ((size_t)bh * NCHUNK + c) * NF_BYTES);
#pragma unroll
            for (int rr = 0; rr < 4; ++rr) { const int v = 4 * g + rr, w2 = v >> 5, vl = v & 31, fi = q >> 1;
#pragma unroll
                for (int u = 0; u < 4; ++u) { const int hh = u & 1, r0 = 4 * (2 * (q & 1) + (u >> 1));
                    const f32x4 v4 = *(const f32x4*)(sf + ((w2 * 2 + fi) * 64 + vl + 32 * hh) * 16 + r0);
                    z[rr][4 * u] = v4[0]; z[rr][4 * u + 1] = v4[1]; z[rr][4 * u + 2] = v4[2]; z[rr][4 * u + 3] = v4[3]; } }
        }
#pragma unroll 1
        for (int sl = 0; sl < 8; ++sl) {
#pragma unroll 1
            for (int i = 0; i < 8; ++i) {
                const int t = c * 64 + sl * 8 + i; float* o = ck + i * RS3;
                const float bon = rwkv_stage_tok(p, P, b, h, t, o, sc, mu_r, mu_k, mu_v, mu_w, mu_a, w0c, a0c, kkc, kac, rkc);
                o[384 + lane] = bf2f(P[(size_t)(b * T + t) * NP + C_ZA + ch]);
                if (lane == 0) o[448] = bon;
            }
#pragma unroll 1
            for (int i = 0; i < 8; ++i) {
                const float* cc = ck + i * RS3; float sa[4];
                rwkv_step<1>(z, cc, q, g, sa);
                f32x4 rv[4];
#pragma unroll
                for (int u = 0; u < 4; ++u) rv[u] = *(const f32x4*)(cc + 16 * q + 4 * u);
                float y[4];
#pragma unroll
                for (int rr = 0; rr < 4; ++rr) { float s0 = 0.f;
#pragma unroll
                    for (int u = 0; u < 4; ++u) s0 += z[rr][4 * u] * rv[u][0] + z[rr][4 * u + 1] * rv[u][1] + z[rr][4 * u + 2] * rv[u][2] + z[rr][4 * u + 3] * rv[u][3];
                    y[rr] = quad_sum(s0); }
                float tot = (y[0] + y[1]) + (y[2] + y[3]);
#pragma unroll
                for (int o2 = 4; o2 < 64; o2 <<= 1) tot += __shfl_xor(tot, o2, 64);
                const float mean = tot * (1.f / 64.f);
                float d0 = y[0] - mean, d1 = y[1] - mean, d2 = y[2] - mean, d3 = y[3] - mean;
                float vs = (d0 * d0 + d1 * d1) + (d2 * d2 + d3 * d3);
#pragma unroll
                for (int o2 = 4; o2 < 64; o2 <<= 1) vs += __shfl_xor(vs, o2, 64);
                const float rstd = rsqrtf(vs * (1.f / 64.f) + 64e-5f);
                const float dv = q == 0 ? d0 : q == 1 ? d1 : q == 2 ? d2 : d3;
                const float yn = dv * rstd * lg + lb;
                const float outv = (yn + cc[448] * cc[192 + vo]) * siluf_(cc[384 + vo]);
                const int t = c * 64 + sl * 8 + i;
                YA[(size_t)(b * T + t) * 512 + h * 64 + vo] = f2bf(outv);
            }
        }
    }
}

DI void phase_swa_simple(const Params& p, unsigned char* lds, const int bid, const int nb) {
    const bf16_t* P = (const bf16_t*)(p.ws + OFF_P); bf16_t* YB = (bf16_t*)(p.ws + OFF_YB);
    const long total = (long)BATCH * 8 * T;
    for (long it = (long)bid * NTHREADS + threadIdx.x; it < total; it += (long)nb * NTHREADS) {
        const int t = (int)(it % T), qh = (int)((it / T) % 8), b = (int)(it / ((long)T * 8)), kvh = qh >> 2;
        const size_t row = (size_t)(b * T + t);
        float q[64], acc[64];
        {
            const uint4* qp = (const uint4*)(P + row * NP + C_Q + qh * 64);
#pragma unroll
            for (int i = 0; i < 8; ++i) { const uint4 u = qp[i]; const unsigned w[4] = {u.x, u.y, u.z, u.w};
#pragma unroll
                for (int j = 0; j < 4; ++j) { q[i * 8 + j * 2] = __uint_as_float(w[j] << 16); q[i * 8 + j * 2 + 1] = __uint_as_float(w[j] & 0xffff0000u); } }
        }
#pragma unroll
        for (int d = 0; d < 64; ++d) acc[d] = 0.f;
        float m = p.sinks[qh], l = 1.f;
        for (int j = 0; j < 128; ++j) {
            const int s = t - 127 + j;
            if (s < 0) continue;
            const size_t krow = (size_t)(b * T + s) * NP;
            const uint4* kp = (const uint4*)(P + krow + C_SK + kvh * 64);
            float dot = 0.f;
#pragma unroll
            for (int i = 0; i < 8; ++i) { const uint4 u = kp[i]; const unsigned w[4] = {u.x, u.y, u.z, u.w};
#pragma unroll
                for (int jj = 0; jj < 4; ++jj) { dot += q[i * 8 + jj * 2] * __uint_as_float(w[jj] << 16) + q[i * 8 + jj * 2 + 1] * __uint_as_float(w[jj] & 0xffff0000u); } }
            const float sc = dot * 0.125f;
            const float mn = fmaxf(m, sc), corr = __expf(m - mn), pe = __expf(sc - mn);
            l = l * corr + pe; m = mn;
            const uint4* vp = (const uint4*)(P + krow + C_SV + kvh * 64);
#pragma unroll
            for (int i = 0; i < 8; ++i) { const uint4 u = vp[i]; const unsigned w[4] = {u.x, u.y, u.z, u.w};
#pragma unroll
                for (int jj = 0; jj < 4; ++jj) { acc[i * 8 + jj * 2] = acc[i * 8 + jj * 2] * corr + pe * __uint_as_float(w[jj] << 16);
                                                 acc[i * 8 + jj * 2 + 1] = acc[i * 8 + jj * 2 + 1] * corr + pe * __uint_as_float(w[jj] & 0xffff0000u); } }
        }
        const float inv = 1.f / l;
        const bf16_t* zp = P + row * NP + C_ZB + qh * 64; bf16_t* op = YB + row * 512 + qh * 64;
#pragma unroll
        for (int d = 0; d < 64; ++d) op[d] = f2bf(acc[d] * inv * siluf_(bf2f(zp[d])));
    }
}

DI void phase_xattn_simple(const Params& p, unsigned char* lds, const int bid, const int nb) {
    const bf16_t* P = (const bf16_t*)(p.ws + OFF_P); const bf16_t* KVM = (const bf16_t*)(p.ws + OFF_KVM); bf16_t* YC = (bf16_t*)(p.ws + OFF_YC);
    const int lane = threadIdx.x & 63, wid = threadIdx.x >> 6;
    const long total = (long)M * 4;
    const float scale = 0.08838834764831845f;
    for (long it = (long)bid * NWAVES + wid; it < total; it += (long)nb * NWAVES) {
        const int row = (int)(it >> 2), hd = (int)(it & 3), b = row / T;
        const bf16_t* qp = P + (size_t)row * NP + C_XQ + hd * 128;
        const bf16_t* kb = KVM + (size_t)(b * MEMLEN) * 1024 + hd * 128;
        float s[4] = {0.f, 0.f, 0.f, 0.f};
        for (int c = 0; c < 16; ++c) {
            const uint4 qu = *(const uint4*)(qp + c * 8); const unsigned qw[4] = {qu.x, qu.y, qu.z, qu.w};
#pragma unroll
            for (int i = 0; i < 4; ++i) {
                const uint4 ku = *(const uint4*)(kb + (size_t)(lane + 64 * i) * 1024 + c * 8); const unsigned kw[4] = {ku.x, ku.y, ku.z, ku.w};
#pragma unroll
                for (int j = 0; j < 4; ++j) s[i] += __uint_as_float(qw[j] << 16) * __uint_as_float(kw[j] << 16) + __uint_as_float(qw[j] & 0xffff0000u) * __uint_as_float(kw[j] & 0xffff0000u);
            }
        }
        float mx = -1e30f;
#pragma unroll
        for (int i = 0; i < 4; ++i) { s[i] *= scale; mx = fmaxf(mx, s[i]); }
        mx = wave_max(mx);
        float pe[4], sum = 0.f;
#pragma unroll
        for (int i = 0; i < 4; ++i) { pe[i] = __expf(s[i] - mx); sum += pe[i]; }
        sum = wave_sum(sum);
        const float inv = 1.f / sum;
        float o0 = 0.f, o1 = 0.f;
        const bf16_t* vb = kb + 512;
#pragma unroll
        for (int i = 0; i < 4; ++i)
            for (int mm = 0; mm < 64; ++mm) {
                const float pv = __shfl(pe[i], mm, 64);
                const bf16_t* vr = vb + (size_t)(mm + 64 * i) * 1024;
                o0 += pv * bf2f(vr[lane]); o1 += pv * bf2f(vr[lane + 64]);
            }
        const bf16_t* zp = P + (size_t)row * NP + C_ZC + hd * 128; bf16_t* op = YC + (size_t)row * 512 + hd * 128;
        op[lane] = f2bf(o0 * inv * siluf_(bf2f(zp[lane]))); op[lane + 64] = f2bf(o1 * inv * siluf_(bf2f(zp[lane + 64])));
    }
}

#define MFMA32(a, b, c) __builtin_amdgcn_mfma_f32_32x32x16_bf16((a), (b), (c), 0, 0, 0)
typedef short s16x4 __attribute__((ext_vector_type(4)));
DI int crow(int reg, int hh) { return (reg & 3) + 8 * (reg >> 2) + 4 * hh; }
template <int Dh> DI unsigned k_off(int row, int chunk) { return (unsigned)(row * (Dh * 2) + ((chunk ^ (row & (Dh / 8 - 1))) << 4)); }
DI bf16x8 pack8(const f32x16& x, int s) {
    bf16x8 r;
#pragma unroll
    for (int e = 0; e < 8; ++e) r[e] = (short)f2bf(x[8 * s + e]);
    return r;
}
constexpr int VS = 528;

DI void swa_unit(const Params& p, unsigned char* lds, int unit) {
    const bf16_t* P = (const bf16_t*)(p.ws + OFF_P); bf16_t* YB = (bf16_t*)(p.ws + OFF_YB);
    int tid = threadIdx.x; asm volatile("" : "+v"(tid));
    const int lane = tid & 63, wid = __builtin_amdgcn_readfirstlane(tid >> 6), c = lane & 31, hh = lane >> 5;
    const int n = unit & 63, kvh = (unit >> 6) & 1, b = unit >> 7;
    unsigned char* Kl = lds; unsigned char* Vt = lds + 32768;
    __syncthreads();
#pragma unroll
    for (int u = 0; u < 4; ++u) {
        const int idx = tid + 512 * u;
        { const int row = idx >> 3, chunk = idx & 7, t = n * 128 - 128 + row;
          uint4 v = make_uint4(0u, 0u, 0u, 0u);
          if (t >= 0) v = *(const uint4*)(P + (size_t)(b * T + t) * NP + C_SK + kvh * 64 + chunk * 8);
          *(uint4*)(Kl + k_off<64>(row, chunk)) = v; }
        { const int key = idx & 255, dch = idx >> 8, t = n * 128 - 128 + key;
          uint4 v = make_uint4(0u, 0u, 0u, 0u);
          if (t >= 0) v = *(const uint4*)(P + (size_t)(b * T + t) * NP + C_SV + kvh * 64 + dch * 8);
          const unsigned w[4] = {v.x, v.y, v.z, v.w};
#pragma unroll
          for (int e = 0; e < 8; ++e) *(bf16_t*)(Vt + (dch * 8 + e) * VS + key * 2) = (bf16_t)(e & 1 ? w[e >> 1] >> 16 : w[e >> 1] & 0xffffu); }
    }
    __syncthreads();
    const int qh = kvh * 4 + (wid >> 1), rh = wid & 1;
    const float sink = p.sinks[qh];
#pragma unroll 1
    for (int rt = 0; rt < 2; ++rt) {
        const int base = 64 * rh + 32 * rt;
        const size_t qrow = (size_t)(b * T + n * 128 + base + c);
        bf16x8 qf[4];
#pragma unroll
        for (int ds = 0; ds < 4; ++ds) qf[ds] = *(const bf16x8*)(P + qrow * NP + C_Q + qh * 64 + 16 * ds + 8 * hh);
        f32x16 st[5];
#pragma unroll
        for (int kt = 0; kt < 5; ++kt) {
#pragma unroll
            for (int i = 0; i < 16; ++i) st[kt][i] = 0.f;
#pragma unroll
            for (int ds = 0; ds < 4; ++ds) { const bf16x8 a = *(const bf16x8*)(Kl + k_off<64>(base + 32 * kt + c, 2 * ds + hh)); st[kt] = MFMA32(a, qf[ds], st[kt]); }
        }
        float mx = sink;
#pragma unroll
        for (int kt = 0; kt < 5; ++kt)
#pragma unroll
            for (int i = 0; i < 16; ++i) {
                const int cr = crow(i, hh);
                bool ok = true;
                if (kt == 0) ok = cr > c;
                if (kt == 4) ok = cr <= c;
                if (n == 0) ok = ok && (base + 32 * kt + cr >= 128);
                const float s = ok ? st[kt][i] * 0.125f : -1e30f;
                st[kt][i] = s; mx = fmaxf(mx, s);
            }
        mx = fmaxf(mx, __shfl_xor(mx, 32, 64));
        float ls = 0.f;
#pragma unroll
        for (int kt = 0; kt < 5; ++kt)
#pragma unroll
            for (int i = 0; i < 16; ++i) { const float pe = __expf(st[kt][i] - mx); st[kt][i] = pe; ls += pe; }
        ls += __shfl_xor(ls, 32, 64);
        const float inv = 1.f / (ls + __expf(sink - mx));
        f32x16 ot[2];
#pragma unroll
        for (int dt = 0; dt < 2; ++dt)
#pragma unroll
            for (int i = 0; i < 16; ++i) ot[dt][i] = 0.f;
#pragma unroll
        for (int kt = 0; kt < 5; ++kt)
#pragma unroll
            for (int s = 0; s < 2; ++s) {
                const bf16x8 pf = pack8(st[kt], s);
#pragma unroll
                for (int dt = 0; dt < 2; ++dt) {
                    const unsigned char* vp = Vt + (32 * dt + c) * VS + (base + 32 * kt + 16 * s + 4 * hh) * 2;
                    const s16x4 lo = *(const s16x4*)vp, hi = *(const s16x4*)(vp + 16);
                    const bf16x8 vf = __builtin_shufflevector(lo, hi, 0, 1, 2, 3, 4, 5, 6, 7);
                    ot[dt] = MFMA32(vf, pf, ot[dt]);
                }
            }
        const bf16_t* zp = P + qrow * NP + C_ZB + qh * 64; bf16_t* op = YB + qrow * 512 + qh * 64;
#pragma unroll
        for (int dt = 0; dt < 2; ++dt)
#pragma unroll
            for (int gq = 0; gq < 4; ++gq) {
                const int d0 = 32 * dt + 8 * gq + 4 * hh;
                const uint2 zz = *(const uint2*)(zp + d0);
                const float z0 = __uint_as_float(zz.x << 16), z1 = __uint_as_float(zz.x & 0xffff0000u), z2 = __uint_as_float(zz.y << 16), z3 = __uint_as_float(zz.y & 0xffff0000u);
                const unsigned o0 = (unsigned)f2bf(ot[dt][4 * gq] * inv * siluf_(z0)) | ((unsigned)f2bf(ot[dt][4 * gq + 1] * inv * siluf_(z1)) << 16);
                const unsigned o1 = (unsigned)f2bf(ot[dt][4 * gq + 2] * inv * siluf_(z2)) | ((unsigned)f2bf(ot[dt][4 * gq + 3] * inv * siluf_(z3)) << 16);
                *(uint2*)(op + d0) = make_uint2(o0, o1);
            }
    }
}

DI void xattn_unit(const Params& p, unsigned char* lds, int unit) {
    const bf16_t* P = (const bf16_t*)(p.ws + OFF_P); const bf16_t* KVM = (const bf16_t*)(p.ws + OFF_KVM); bf16_t* YC = (bf16_t*)(p.ws + OFF_YC);
    int tid = threadIdx.x; asm volatile("" : "+v"(tid));
    const int lane = tid & 63, wid = __builtin_amdgcn_readfirstlane(tid >> 6), c = lane & 31, hh = lane >> 5;
    const int qb = unit & 31, hd = (unit >> 5) & 3, b = unit >> 7;
    unsigned char* Kl = lds; unsigned char* Vt = lds + 65536;
    const bf16_t* kb = KVM + (size_t)(b * MEMLEN) * 1024 + hd * 128;
    __syncthreads();
#pragma unroll
    for (int u = 0; u < 8; ++u) {
        const int idx = tid + 512 * u;
        { const int row = idx >> 4, chunk = idx & 15;
          *(uint4*)(Kl + k_off<128>(row, chunk)) = *(const uint4*)(kb + (size_t)row * 1024 + chunk * 8); }
        { const int key = idx & 255, dch = idx >> 8;
          const uint4 v = *(const uint4*)(kb + (size_t)key * 1024 + 512 + dch * 8);
          const unsigned w[4] = {v.x, v.y, v.z, v.w};
#pragma unroll
          for (int e = 0; e < 8; ++e) *(bf16_t*)(Vt + (dch * 8 + e) * VS + key * 2) = (bf16_t)(e & 1 ? w[e >> 1] >> 16 : w[e >> 1] & 0xffffu); }
    }
    __syncthreads();
    const size_t qrow = (size_t)(b * T + qb * 256 + wid * 32 + c);
    const float scale = 0.08838834764831845f;
    bf16x8 qf[8];
#pragma unroll
    for (int ds = 0; ds < 8; ++ds) qf[ds] = *(const bf16x8*)(P + qrow * NP + C_XQ + hd * 128 + 16 * ds + 8 * hh);
    f32x16 ot[4];
#pragma unroll
    for (int dt = 0; dt < 4; ++dt)
#pragma unroll
        for (int i = 0; i < 16; ++i) ot[dt][i] = 0.f;
    float mrun = -1e30f, lrun = 0.f;
#pragma unroll 1
    for (int half = 0; half < 2; ++half) {
        f32x16 st[4];
#pragma unroll
        for (int kt = 0; kt < 4; ++kt) {
#pragma unroll
            for (int i = 0; i < 16; ++i) st[kt][i] = 0.f;
#pragma unroll
            for (int ds = 0; ds < 8; ++ds) { const bf16x8 a = *(const bf16x8*)(Kl + k_off<128>(128 * half + 32 * kt + c, 2 * ds + hh)); st[kt] = MFMA32(a, qf[ds], st[kt]); }
        }
        float mx = mrun;
#pragma unroll
        for (int kt = 0; kt < 4; ++kt)
#pragma unroll
            for (int i = 0; i < 16; ++i) { st[kt][i] *= scale; mx = fmaxf(mx, st[kt][i]); }
        mx = fmaxf(mx, __shfl_xor(mx, 32, 64));
        const float corr = __expf(mrun - mx);
        float ls = 0.f;
#pragma unroll
        for (int kt = 0; kt < 4; ++kt)
#pragma unroll
            for (int i = 0; i < 16; ++i) { const float pe = __expf(st[kt][i] - mx); st[kt][i] = pe; ls += pe; }
        ls += __shfl_xor(ls, 32, 64);
        lrun = lrun * corr + ls; mrun = mx;
#pragma unroll
        for (int dt = 0; dt < 4; ++dt)
#pragma unroll
            for (int i = 0; i < 16; ++i) ot[dt][i] *= corr;
#pragma unroll
        for (int kt = 0; kt < 4; ++kt)
#pragma unroll
            for (int s = 0; s < 2; ++s) {
                const bf16x8 pf = pack8(st[kt], s);
#pragma unroll
                for (int dt = 0; dt < 4; ++dt) {
                    const unsigned char* vp = Vt + (32 * dt + c) * VS + (128 * half + 32 * kt + 16 * s + 4 * hh) * 2;
                    const s16x4 lo = *(const s16x4*)vp, hi = *(const s16x4*)(vp + 16);
                    const bf16x8 vf = __builtin_shufflevector(lo, hi, 0, 1, 2, 3, 4, 5, 6, 7);
                    ot[dt] = MFMA32(vf, pf, ot[dt]);
                }
            }
    }
    const float inv = 1.f / lrun;
    const bf16_t* zp = P + qrow * NP + C_ZC + hd * 128; bf16_t* op = YC + qrow * 512 + hd * 128;
#pragma unroll
    for (int dt = 0; dt < 4; ++dt)
#pragma unroll
        for (int gq = 0; gq < 4; ++gq) {
            const int d0 = 32 * dt + 8 * gq + 4 * hh;
            const uint2 zz = *(const uint2*)(zp + d0);
            const float z0 = __uint_as_float(zz.x << 16), z1 = __uint_as_float(zz.x & 0xffff0000u), z2 = __uint_as_float(zz.y << 16), z3 = __uint_as_float(zz.y & 0xffff0000u);
            const unsigned o0 = (unsigned)f2bf(ot[dt][4 * gq] * inv * siluf_(z0)) | ((unsigned)f2bf(ot[dt][4 * gq + 1] * inv * siluf_(z1)) << 16);
            const unsigned o1 = (unsigned)f2bf(ot[dt][4 * gq + 2] * inv * siluf_(z2)) | ((unsigned)f2bf(ot[dt][4 * gq + 3] * inv * siluf_(z3)) << 16);
            *(uint2*)(op + d0) = make_uint2(o0, o1);
        }
}
DI void phase_attn(const Params& p, unsigned char* lds, const int bid, const int nb) {
    for (int u = bid; u < 512; u += nb) { if (u < 256) swa_unit(p, lds, u); else xattn_unit(p, lds, u - 256); }
}

DI void phase_gemm_gate(const Params& p, unsigned char* lds, const int bid, const int nb) {
    unsigned char* ws = p.ws;
    const bf16_t* H = (const bf16_t*)(ws + OFF_H); const bf16_t* Wt = (const bf16_t*)(ws + OFF_WIN) + (size_t)C_G * 1024;
    bf16_t* SG = (bf16_t*)(ws + OFF_SG);
    const int tn = 3072 / 128, nt = (M / 128) * tn;
    for (int it = bid; it < nt; it += nb) {
        GemmTile g; gemm_zero(g);
        const int m0 = (it / tn) * 128, n0 = (it % tn) * 128;
        gemm_tile_k(g, H, 1024, Wt, 1024, m0, n0, 1024, lds);
        GEMM_FOREACH(SG[(size_t)row * 3072 + col] = f2bf(sigmoidf_(g.acc[mi][ni][r])););
    }
}
DI void phase_gemm_proj(const Params& p, unsigned char* lds, const int bid, const int nb) {
    unsigned char* ws = p.ws;
    const bf16_t* SG = (const bf16_t*)(ws + OFF_SG); bf16_t* MG = (bf16_t*)(ws + OFF_MG);
    const int tn = 1024 / 128, nt = (M / 128) * tn;
    for (int it = bid; it < nt; it += nb) {
        const int m0 = (it / tn) * 128, n0 = (it % tn) * 128;
        GemmTile mg; gemm_zero(mg);
#pragma unroll 1
        for (int br = 0; br < 3; ++br) {
            GemmTile g; gemm_zero(g);
            const bf16_t* Y = (const bf16_t*)(ws + (br == 0 ? OFF_YA : br == 1 ? OFF_YB : OFF_YC));
            const bf16_t* W = (const bf16_t*)(ws + (br == 0 ? OFF_WPA : br == 1 ? OFF_WPB : OFF_WPC));
            gemm_tile_k(g, Y, 512, W, 512, m0, n0, 512, lds);
            GEMM_FOREACH(mg.acc[mi][ni][r] += bf2f(SG[(size_t)row * 3072 + br * 1024 + col]) * g.acc[mi][ni][r];);
        }
        GEMM_FOREACH(MG[(size_t)row * 1024 + col] = f2bf(mg.acc[mi][ni][r]););
    }
}
DI void phase_gemm_out(const Params& p, unsigned char* lds, const int bid, const int nb) {
    unsigned char* ws = p.ws;
    const bf16_t* MG = (const bf16_t*)(ws + OFF_MG); const bf16_t* W = (const bf16_t*)(ws + OFF_WO);
    const int tn = 1024 / 128, nt = (M / 128) * tn;
    for (int it = bid; it < nt; it += nb) {
        GemmTile g; gemm_zero(g);
        const int m0 = (it / tn) * 128, n0 = (it % tn) * 128;
        gemm_tile_k(g, MG, 1024, W, 1024, m0, n0, 1024, lds);
        GEMM_FOREACH(p.out[(size_t)row * 1024 + col] = p.x[(size_t)row * 1024 + col] + g.acc[mi][ni][r];);
    }
}

#define XB_TMO      128
#define XB_XCNT(j)  (256  + 64 * (j))
#define XB_XSUB(j)  (1280 + 64 * (j))
#define XB_XGEN(j)  (2304 + 64 * (j))
#define XB_TOP      3328
#define XB_TOPGEN   3392
#define XCD_BAR_WORDS 3456
#define XB_SPIN_CAP (1u << 22)
#define LAS __attribute__((address_space(3)))
DI unsigned xb_ld(unsigned* p)              { return __hip_atomic_load(p, __ATOMIC_RELAXED, __HIP_MEMORY_SCOPE_AGENT); }
DI unsigned xb_add(unsigned* p, unsigned v) { return __hip_atomic_fetch_add(p, v, __ATOMIC_RELAXED, __HIP_MEMORY_SCOPE_AGENT); }
DI unsigned xb_xcc_id() { return (unsigned)__builtin_amdgcn_s_getreg((3 << 11) | 20) & 0xFu; }
#define XB_SPIN(cond, bar) do { unsigned _sp = 0; while (cond) { __builtin_amdgcn_s_sleep(1); \
    if ((++_sp & 255u) == 0u) { if (xb_ld(&(bar)[XB_TMO])) break; if (_sp > XB_SPIN_CAP) { atomicAdd(&(bar)[XB_TMO], 1u); break; } } } } while (0)
struct XcdBarrier { unsigned* bar; unsigned x; volatile LAS unsigned* st; };
DI XcdBarrier xcd_barrier_post(unsigned* bar, volatile LAS unsigned* st) {
    XcdBarrier b; b.bar = bar; b.x = xb_xcc_id(); b.st = st;
    if (threadIdx.x == 0) (void)xb_add(&bar[XB_XCNT(b.x)], 1u);
    return b;
}
DI void xcd_barrier_complete(unsigned* bar, unsigned x, unsigned& nloc, unsigned& nx) {
    const unsigned G = gridDim.x * gridDim.y * gridDim.z;
    unsigned sum, cnt, mine, sp = 0u;
    for (;;) {
        sum = 0u; cnt = 0u; mine = 0u;
#pragma unroll
        for (unsigned j = 0; j < 16; ++j) { const unsigned c = xb_ld(&bar[XB_XCNT(j)]); sum += c; cnt += (c > 0u) ? 1u : 0u; mine = (j == x) ? c : mine; }
        if (sum == G) break;
        __builtin_amdgcn_s_sleep(1);
        if ((++sp & 255u) == 0u) { if (xb_ld(&bar[XB_TMO])) break; if (sp > XB_SPIN_CAP) { atomicAdd(&bar[XB_TMO], 1u); break; } }
    }
    nloc = mine > 0u ? mine : 1u; nx = cnt > 0u ? cnt : 1u;
}
DI void xcd_barrier(const XcdBarrier& b) {
    asm volatile("s_waitcnt vmcnt(0)" ::: "memory");
    __syncthreads();
    if (threadIdx.x == 0) {
        unsigned* bar = b.bar;
        __builtin_amdgcn_s_waitcnt(0);
        unsigned nloc = b.st[0], nx = b.st[1];
        if (nloc == 0u) { xcd_barrier_complete(bar, b.x, nloc, nx); b.st[0] = nloc; b.st[1] = nx; }
        const unsigned old = xb_add(&bar[XB_XSUB(b.x)], 1u);
        const unsigned gen = old / nloc;
        if (old + 1u == (gen + 1u) * nloc) {
            __builtin_amdgcn_fence(__ATOMIC_RELEASE, "agent");
            asm volatile("s_waitcnt vmcnt(0)" ::: "memory");
            const unsigned og = xb_add(&bar[XB_TOP], 1u);
            const unsigned tg = og / nx;
            if (og + 1u == (tg + 1u) * nx) xb_add(&bar[XB_TOPGEN], 1u);
            else XB_SPIN(xb_ld(&bar[XB_TOPGEN]) == tg, bar);
            __builtin_amdgcn_fence(__ATOMIC_ACQUIRE, "agent");
            xb_add(&bar[XB_XGEN(b.x)], 1u);
            asm volatile("s_waitcnt vmcnt(0)" ::: "memory");
        } else {
            XB_SPIN(xb_ld(&bar[XB_XGEN(b.x)]) == gen, bar);
            __builtin_amdgcn_fence(__ATOMIC_ACQUIRE, "agent");
            asm volatile("s_waitcnt vmcnt(0)" ::: "memory");
        }
    }
    __syncthreads();
}

constexpr int LDS_CTL_OFF = LDS_BYTES - 256;
__global__ void __launch_bounds__(NTHREADS, 2) k_mega(Params p) {
    extern __shared__ __attribute__((aligned(16))) unsigned char lds[];
    volatile LAS unsigned* st = (volatile LAS unsigned*)(lds + LDS_CTL_OFF);
    if (threadIdx.x == 0) { st[0] = 0u; st[1] = 0u; st[2] = 0u; st[3] = 0u; }
    __syncthreads();
    (void)xcd_barrier_post((unsigned*)(p.ws + OFF_CTL), st);
#define GRID_BAR() do { XcdBarrier b_; b_.bar = (unsigned*)(p.ws + OFF_CTL); b_.x = xb_xcc_id(); b_.st = (volatile LAS unsigned*)(lds + LDS_CTL_OFF); xcd_barrier(b_); } while (0)
    const int bid = blockIdx.x, nb = gridDim.x;
    phase_prologue(p, lds, bid, nb);
    GRID_BAR();
    phase_gemm_in(p, lds, bid, nb);
    GRID_BAR();
    phase_attn_prep(p, lds, bid, nb);
    GRID_BAR();
    phase_rwkv_prep(p, lds, bid, nb);
    GRID_BAR();
    if (bid < 16) phase_rwkv_scan(p, lds, bid);
    else phase_attn(p, lds, bid - 16, nb - 16);
    GRID_BAR();
    phase_rwkv_out(p, lds, bid, nb);
    GRID_BAR();
    phase_gemm_gate(p, lds, bid, nb);
    GRID_BAR();
    phase_gemm_proj(p, lds, bid, nb);
    GRID_BAR();
    phase_gemm_out(p, lds, bid, nb);
}

extern "C" void kernel_launch(void* const* d_in, const int* in_sizes, int n_in, void* d_out, int out_size, void* d_ws, size_t ws_size, hipStream_t stream) {
    static int grid = 0;
    if (grid == 0) {
        if (n_in != 27 || ws_size < WS_END) { fprintf(stderr, "kernel_launch: unexpected inputs (n_in %d, ws %zu)\n", n_in, ws_size); grid = -1; return; }
        int dev = 0, cus = 0, per_cu = 0;
        if (hipGetDevice(&dev) != hipSuccess || hipDeviceGetAttribute(&cus, hipDeviceAttributeMultiprocessorCount, dev) != hipSuccess) { grid = -1; return; }
        if (hipFuncSetAttribute((const void*)k_mega, hipFuncAttributeMaxDynamicSharedMemorySize, LDS_BYTES) != hipSuccess) { fprintf(stderr, "kernel_launch: hipFuncSetAttribute failed\n"); grid = -1; return; }
        if (hipOccupancyMaxActiveBlocksPerMultiprocessor(&per_cu, (const void*)k_mega, NTHREADS, LDS_BYTES) != hipSuccess || per_cu < 1)
            fprintf(stderr, "kernel_launch: occupancy query reports %d workgroups per CU\n", per_cu);
        (void)hipGetLastError();
        grid = cus;
        if (grid < 32) { fprintf(stderr, "kernel_launch: too few CUs (%d)\n", grid); grid = -1; return; }
    }
    if (grid < 0) return;
    if (hipMemsetAsync((char*)d_ws + OFF_CTL, 0, 65536, stream) != hipSuccess) { fprintf(stderr, "kernel_launch: memset failed\n"); return; }
    Params p{};
    p.x = (const float*)d_in[0]; p.mem = (const float*)d_in[1]; p.pos = (const int*)d_in[2]; p.norm_g = (const float*)d_in[3]; p.mem_norm_g = (const float*)d_in[4];
    p.w_in = (const float*)d_in[5]; p.mu_rkv = (const float*)d_in[6]; p.mu_wa = (const float*)d_in[7]; p.w0 = (const float*)d_in[8]; p.w2 = (const float*)d_in[9];
    p.a0 = (const float*)d_in[10]; p.a2 = (const float*)d_in[11]; p.k_k = (const float*)d_in[12]; p.k_a = (const float*)d_in[13]; p.r_k = (const float*)d_in[14];
    p.lnx_g = (const float*)d_in[15]; p.lnx_b = (const float*)d_in[16]; p.q_norm_g = (const float*)d_in[17]; p.k_norm_g = (const float*)d_in[18]; p.sinks = (const float*)d_in[19];
    p.xq_norm_g = (const float*)d_in[20]; p.xk_norm_g = (const float*)d_in[21]; p.w_mem_kv = (const float*)d_in[22]; p.w_proj_a = (const float*)d_in[23];
    p.w_proj_b = (const float*)d_in[24]; p.w_proj_c = (const float*)d_in[25]; p.w_out = (const float*)d_in[26];
    p.out = (float*)d_out; p.ws = (unsigned char*)d_ws;
    hipLaunchKernelGGL(k_mega, dim3(grid), dim3(NTHREADS), LDS_BYTES, stream, p);
}
```

```cpp
#include <hip/hip_runtime.h>
#include <stdint.h>
#include <stdio.h>

#define DI __device__ __forceinline__
typedef unsigned short bf16_t;
typedef short bf16x8 __attribute__((ext_vector_type(8)));
typedef float f32x4 __attribute__((ext_vector_type(4)));

constexpr int BATCH = 2, T = 8192, M = BATCH * T, D = 1024, NIN = 7552, NP = 4608  ;
constexpr int MEMLEN = 256, MM = BATCH * MEMLEN;
constexpr int C_R = 0, C_K = 512, C_V = 1024, C_W = 1536, C_A = 1600, C_ZA = 1664, C_Q = 2176, C_SK = 2688, C_SV = 2816, C_ZB = 2944, C_XQ = 3456, C_ZC = 3968, C_G = 4480;
constexpr int NTHREADS = 512, NWAVES = 8;
constexpr int LDS_BYTES = 147456;

constexpr size_t OFF_CTL = 0;
constexpr size_t OFF_WIN = 65536;
constexpr size_t OFF_WKV = OFF_WIN + (size_t)7680 * 1024 * 2;
constexpr size_t OFF_WPA = OFF_WKV + (size_t)1024 * 1024 * 2;
constexpr size_t OFF_WPB = OFF_WPA + (size_t)1024 * 512 * 2;
constexpr size_t OFF_WPC = OFF_WPB + (size_t)1024 * 512 * 2;
constexpr size_t OFF_WO  = OFF_WPC + (size_t)1024 * 512 * 2;
constexpr size_t OFF_H   = OFF_WO + (size_t)1024 * 1024 * 2;
constexpr size_t OFF_HM  = OFF_H + (size_t)M * 1024 * 2;
constexpr size_t OFF_KVM = OFF_HM + (size_t)MM * 1024 * 2;
constexpr size_t OFF_ROPE = OFF_KVM + (size_t)MM * 1024 * 2;
constexpr size_t OFF_P   = OFF_ROPE + (size_t)M * 32 * 8;
constexpr size_t OFF_YA  = OFF_P + (size_t)M * NP * 2;
constexpr size_t OFF_YB  = OFF_YA + (size_t)M * 512 * 2;
constexpr size_t OFF_YC  = OFF_YB + (size_t)M * 512 * 2;
constexpr size_t WS_END  = OFF_YC + (size_t)M * 512 * 2;
constexpr size_t OFF_SG  = OFF_P;
constexpr size_t OFF_MG  = OFF_P + (size_t)M * 3072 * 2;
static_assert(WS_END <= (size_t)256 * 1024 * 1024, "workspace");
static_assert(OFF_MG + (size_t)M * 1024 * 2 <= OFF_YA, "overlay");

struct Params {
    const float* x; const float* mem; const int* pos; const float* norm_g; const float* mem_norm_g; const float* w_in;
    const float* mu_rkv; const float* mu_wa; const float* w0; const float* w2; const float* a0; const float* a2;
    const float* k_k; const float* k_a; const float* r_k; const float* lnx_g; const float* lnx_b;
    const float* q_norm_g; const float* k_norm_g; const float* sinks; const float* xq_norm_g; const float* xk_norm_g;
    const float* w_mem_kv; const float* w_proj_a; const float* w_proj_b; const float* w_proj_c; const float* w_out;
    float* out; unsigned char* ws;
};

DI bf16_t f2bf(float x) { return __builtin_bit_cast(unsigned short, (__bf16)x); }
DI float bf2f(bf16_t h) { return __uint_as_float(((unsigned)h) << 16); }
DI float wave_sum(float v) {
#pragma unroll
    for (int o = 32; o > 0; o >>= 1) v += __shfl_xor(v, o, 64);
    return v;
}
DI float wave_max(float v) {
#pragma unroll
    for (int o = 32; o > 0; o >>= 1) v = fmaxf(v, __shfl_xor(v, o, 64));
    return v;
}
DI float sigmoidf_(float x) { return 1.f / (1.f + __expf(-x)); }
DI float siluf_(float x) { return x / (1.f + __expf(-x)); }

DI void transpose_convert(const float* W, int K, int N, bf16_t* Wt, int item, float* tile  ) {
    const int tn = N / 64, kt = item / tn, nt = item % tn, tid = threadIdx.x;
    __syncthreads();
    for (int e = tid; e < 4096; e += NTHREADS) { const int r = e >> 6, c = e & 63; tile[r * 65 + c] = W[(size_t)(kt * 64 + r) * N + nt * 64 + c]; }
    __syncthreads();
    for (int e = tid; e < 4096; e += NTHREADS) { const int n = e >> 6, k = e & 63; Wt[(size_t)(nt * 64 + n) * K + kt * 64 + k] = f2bf(tile[k * 65 + n]); }
}

DI void phase_prologue(const Params& p, unsigned char* lds, const int bid, const int nb) {
    float* tile = (float*)lds;
    unsigned char* ws = p.ws;
    const int n_in = (1024 / 64) * (NIN / 64), n_kv = 16 * 16, n_pr = (512 / 64) * 16, n_o = 16 * 16;
    const int total = n_in + n_kv + 3 * n_pr + n_o;
    for (int it = bid; it < total; it += nb) {
        int i = it;
        if (i < n_in) { transpose_convert(p.w_in, 1024, NIN, (bf16_t*)(ws + OFF_WIN), i, tile); continue; } i -= n_in;
        if (i < n_kv) { transpose_convert(p.w_mem_kv, 1024, 1024, (bf16_t*)(ws + OFF_WKV), i, tile); continue; } i -= n_kv;
        if (i < n_pr) { transpose_convert(p.w_proj_a, 512, 1024, (bf16_t*)(ws + OFF_WPA), i, tile); continue; } i -= n_pr;
        if (i < n_pr) { transpose_convert(p.w_proj_b, 512, 1024, (bf16_t*)(ws + OFF_WPB), i, tile); continue; } i -= n_pr;
        if (i < n_pr) { transpose_convert(p.w_proj_c, 512, 1024, (bf16_t*)(ws + OFF_WPC), i, tile); continue; } i -= n_pr;
        transpose_convert(p.w_out, 1024, 1024, (bf16_t*)(ws + OFF_WO), i, tile);
    }
    {
        unsigned* z = (unsigned*)(ws + OFF_WIN + (size_t)NIN * 1024 * 2);
        const int nz = (7680 - NIN) * 1024 / 2;
        for (int i = bid * NTHREADS + threadIdx.x; i < nz; i += nb * NTHREADS) z[i] = 0u;
    }
    const int lane = threadIdx.x & 63, wid = threadIdx.x >> 6;
    for (int row = bid * NWAVES + wid; row < M + MM; row += nb * NWAVES) {
        const float* src = row < M ? p.x + (size_t)row * D : p.mem + (size_t)(row - M) * D;
        const float* g = row < M ? p.norm_g : p.mem_norm_g;
        bf16_t* dst = row < M ? (bf16_t*)(ws + OFF_H) + (size_t)row * D : (bf16_t*)(ws + OFF_HM) + (size_t)(row - M) * D;
        f32x4 v[4]; float ss = 0.f;
#pragma unroll
        for (int i = 0; i < 4; ++i) { v[i] = *(const f32x4*)(src + i * 256 + lane * 4); ss += v[i][0] * v[i][0] + v[i][1] * v[i][1] + v[i][2] * v[i][2] + v[i][3] * v[i][3]; }
        ss = wave_sum(ss);
        const float rs = rsqrtf(ss * (1.f / 1024.f) + 1e-6f);
#pragma unroll
        for (int i = 0; i < 4; ++i) {
            const f32x4 gg = *(const f32x4*)(g + i * 256 + lane * 4);
            ushort4 o; o.x = f2bf(v[i][0] * rs * gg[0]); o.y = f2bf(v[i][1] * rs * gg[1]); o.z = f2bf(v[i][2] * rs * gg[2]); o.w = f2bf(v[i][3] * rs * gg[3]);
            *(ushort4*)(dst + i * 256 + lane * 4) = o;
        }
    }
    float2* rope = (float2*)(ws + OFF_ROPE);
    for (int i = bid * NTHREADS + threadIdx.x; i < M * 32; i += nb * NTHREADS) {
        const int row = i >> 5, f = i & 31;
        const double inv = pow(10000.0, -(double)f / 32.0);
        const double ang = (double)p.pos[row] * inv;
        double s, c; sincos(ang, &s, &c);
        rope[i] = make_float2((float)c, (float)s);
    }
}

struct GemmTile { f32x4 acc[2][4]; };
DI void gemm_tile_k(GemmTile& g, const bf16_t* A, int lda, const bf16_t* Bt, int ldb, int m0, int n0, int K, unsigned char* lds) {
    bf16_t* sA = (bf16_t*)lds;
    bf16_t* sB = sA + 128 * 40;
    const int tid = threadIdx.x, lane = tid & 63, wid = tid >> 6, wm = wid & 3, wn = wid >> 2;
    const int srow = tid >> 2, sch = tid & 3;
    const bf16_t* ga = A + (size_t)(m0 + srow) * lda + sch * 8;
    const bf16_t* gb = Bt + (size_t)(n0 + srow) * ldb + sch * 8;
    const int fr = lane & 15, fq = lane >> 4;
    uint4 ra = *(const uint4*)ga, rb = *(const uint4*)gb;
    for (int k0 = 0; k0 < K; k0 += 32) {
        __syncthreads();
        *(uint4*)(sA + srow * 40 + sch * 8) = ra;
        *(uint4*)(sB + srow * 40 + sch * 8) = rb;
        __syncthreads();
        if (k0 + 32 < K) { ra = *(const uint4*)(ga + k0 + 32); rb = *(const uint4*)(gb + k0 + 32); }
        bf16x8 af[2], bfr[4];
#pragma unroll
        for (int mi = 0; mi < 2; ++mi) af[mi] = *(const bf16x8*)(sA + (wm * 32 + mi * 16 + fr) * 40 + fq * 8);
#pragma unroll
        for (int ni = 0; ni < 4; ++ni) bfr[ni] = *(const bf16x8*)(sB + (wn * 64 + ni * 16 + fr) * 40 + fq * 8);
#pragma unroll
        for (int mi = 0; mi < 2; ++mi)
#pragma unroll
            for (int ni = 0; ni < 4; ++ni) g.acc[mi][ni] = __builtin_amdgcn_mfma_f32_16x16x32_bf16(af[mi], bfr[ni], g.acc[mi][ni], 0, 0, 0);
    }
}
DI void gemm_zero(GemmTile& g) {
#pragma unroll
    for (int mi = 0; mi < 2; ++mi)
#pragma unroll
        for (int ni = 0; ni < 4; ++ni) g.acc[mi][ni] = (f32x4){0.f, 0.f, 0.f, 0.f};
}
#define GEMM_FOREACH(body) do { const int lane_ = threadIdx.x & 63, wid_ = threadIdx.x >> 6, wm_ = wid_ & 3, wn_ = wid_ >> 2, fr_ = lane_ & 15, fq_ = lane_ >> 4; \
    _Pragma("unroll") for (int mi = 0; mi < 2; ++mi) _Pragma("unroll") for (int ni = 0; ni < 4; ++ni) _Pragma("unroll") for (int r = 0; r < 4; ++r) { \
        const int row = m0 + wm_ * 32 + mi * 16 + fq_ * 4 + r, col = n0 + wn_ * 64 + ni * 16 + fr_; body } } while (0)

DI void phase_gemm_in(const Params& p, unsigned char* lds, const int bid, const int nb) {
    unsigned char* ws = p.ws;
    const bf16_t* H = (const bf16_t*)(ws + OFF_H); const bf16_t* Wt = (const bf16_t*)(ws + OFF_WIN);
    bf16_t* P = (bf16_t*)(ws + OFF_P);
    const int tn = NP / 128, nt1 = (M / 128) * tn;
    const int tn2 = 1024 / 128, nt2 = (MM / 128) * tn2;
    for (int it = bid; it < nt1 + nt2; it += nb) {
        GemmTile g; gemm_zero(g);
        if (it < nt1) {
            const int m0 = (it / tn) * 128, n0 = (it % tn) * 128;
            gemm_tile_k(g, H, 1024, Wt, 1024, m0, n0, 1024, lds);
            GEMM_FOREACH(P[(size_t)row * NP + col] = f2bf(g.acc[mi][ni][r]););
        } else {
            const int i2 = it - nt1; const int m0 = (i2 / tn2) * 128, n0 = (i2 % tn2) * 128;
            gemm_tile_k(g, (const bf16_t*)(ws + OFF_HM), 1024, (const bf16_t*)(ws + OFF_WKV), 1024, m0, n0, 1024, lds);
            bf16_t* KVM = (bf16_t*)(ws + OFF_KVM);
            GEMM_FOREACH(KVM[(size_t)row * 1024 + col] = f2bf(g.acc[mi][ni][r]););
        }
    }
}

DI void phase_attn_prep(const Params& p, unsigned char* lds, const int bid, const int nb) {
    unsigned char* ws = p.ws; bf16_t* P = (bf16_t*)(ws + OFF_P); bf16_t* KVM = (bf16_t*)(ws + OFF_KVM);
    const float2* rope = (const float2*)(ws + OFF_ROPE);
    const int lane = threadIdx.x & 63, wid = threadIdx.x >> 6;
    const long n1 = (long)M * 14, n2 = (long)MM * 4;
    for (long it = (long)bid * NWAVES + wid; it < n1 + n2; it += (long)nb * NWAVES) {
        if (it < n1) {
            const int row = (int)(it / 14), j = (int)(it % 14);
            if (j < 10) {
                bf16_t* ptr = P + (size_t)row * NP + (j < 8 ? C_Q + j * 64 : C_SK + (j - 8) * 64);
                const float g = j < 8 ? p.q_norm_g[lane] : p.k_norm_g[lane];
                const float xv = bf2f(ptr[lane]);
                const float ss = wave_sum(xv * xv);
                const float y = xv * rsqrtf(ss * (1.f / 64.f) + 1e-6f) * g;
                const float yp = __shfl_xor(y, 32, 64);
                const float2 cs = rope[(size_t)row * 32 + (lane & 31)];
                const float o = lane < 32 ? y * cs.x - yp * cs.y : y * cs.x + yp * cs.y;
                ptr[lane] = f2bf(o);
            } else {
                bf16_t* ptr = P + (size_t)row * NP + C_XQ + (j - 10) * 128;
                const float x0 = bf2f(ptr[lane]), x1 = bf2f(ptr[lane + 64]);
                const float ss = wave_sum(x0 * x0 + x1 * x1);
                const float rs = rsqrtf(ss * (1.f / 128.f) + 1e-6f);
                ptr[lane] = f2bf(x0 * rs * p.xq_norm_g[lane]); ptr[lane + 64] = f2bf(x1 * rs * p.xq_norm_g[lane + 64]);
            }
        } else {
            const long i2 = it - n1; const int row = (int)(i2 / 4), j = (int)(i2 % 4);
            bf16_t* ptr = KVM + (size_t)row * 1024 + j * 128;
            const float x0 = bf2f(ptr[lane]), x1 = bf2f(ptr[lane + 64]);
            const float ss = wave_sum(x0 * x0 + x1 * x1);
            const float rs = rsqrtf(ss * (1.f / 128.f) + 1e-6f);
            ptr[lane] = f2bf(x0 * rs * p.xk_norm_g[lane]); ptr[lane + 64] = f2bf(x1 * rs * p.xk_norm_g[lane + 64]);
        }
    }
}

DI void rwkv_stage(const Params& p, int b, int h, int t0, int ntok, float* ck, float* scratch  ) {
    const bf16_t* P = (const bf16_t*)(p.ws + OFF_P);
    const int lane = threadIdx.x & 63, wid = threadIdx.x >> 6, ch = h * 64 + lane;
    const float mu_r = p.mu_rkv[ch], mu_k = p.mu_rkv[512 + ch], mu_v = p.mu_rkv[1024 + ch], mu_w = p.mu_wa[lane], mu_a = p.mu_wa[64 + lane];
    const float w0c = p.w0[ch], a0c = p.a0[ch], kkc = p.k_k[ch], kac = p.k_a[ch];
    float* sc = scratch + wid * 128;
    for (int i = wid; i < ntok; i += NWAVES) {
        const int t = t0 + i; const bf16_t* pr = P + (size_t)(b * T + t) * NP; const bf16_t* pp = pr - NP; const bool hp = t > 0;
        const float rc = bf2f(pr[C_R + ch]), rp = hp ? bf2f(pp[C_R + ch]) : 0.f;
        const float kc = bf2f(pr[C_K + ch]), kp = hp ? bf2f(pp[C_K + ch]) : 0.f;
        const float vc = bf2f(pr[C_V + ch]), vp = hp ? bf2f(pp[C_V + ch]) : 0.f;
        const float wc = bf2f(pr[C_W + lane]), wp = hp ? bf2f(pp[C_W + lane]) : 0.f;
        const float ac = bf2f(pr[C_A + lane]), ap = hp ? bf2f(pp[C_A + lane]) : 0.f;
        const float r = rc + (rp - rc) * mu_r, k = kc + (kp - kc) * mu_k, v = vc + (vp - vc) * mu_v;
        const float lw = wc + (wp - wc) * mu_w, la = ac + (ap - ac) * mu_a;
        sc[lane] = tanhf(lw); sc[64 + lane] = la;
        float accw = 0.f, acca = 0.f;
#pragma unroll 8
        for (int j = 0; j < 64; ++j) { accw += sc[j] * p.w2[j * 512 + ch]; acca += sc[64 + j] * p.a2[j * 512 + ch]; }
        const float xw = -(w0c + accw);
        const float sp = xw > 20.f ? xw : log1pf(expf(xw));
        const float wlog = -sp - 0.5f;
        const float decay = expf(-expf(wlog));
        const float alpha = 1.f / (1.f + expf(-(a0c + acca)));
        const float kk0 = k * kkc;
        const float n2 = wave_sum(kk0 * kk0);
        const float kk = kk0 / fmaxf(sqrtf(n2), 1e-12f);
        const float k2 = k * (1.f + (alpha - 1.f) * kac);
        float* o = ck + i * 384;
        o[lane] = r; o[64 + lane] = decay; o[128 + lane] = k2; o[192 + lane] = v; o[256 + lane] = -kk; o[320 + lane] = kk * alpha;
    }
}

DI void phase_rwkv_direct(const Params& p, unsigned char* lds, const int bid, const int nb) {
    float* ck = (float*)lds; float* scratch = ck + 64 * 384;
    const int lane = threadIdx.x & 63, wid = threadIdx.x >> 6;
    const bf16_t* P = (const bf16_t*)(p.ws + OFF_P); bf16_t* YA = (bf16_t*)(p.ws + OFF_YA);
    for (int bh = bid; bh < BATCH * 8; bh += nb) {
        const int b = bh >> 3, h = bh & 7, ch = h * 64 + lane;
        float S[64];
#pragma unroll
        for (int k = 0; k < 64; ++k) S[k] = 0.f;
        const float rk = p.r_k[ch], lg = p.lnx_g[ch], lb = p.lnx_b[ch];
        for (int c = 0; c < T / 64; ++c) {
            __syncthreads();
            rwkv_stage(p, b, h, c * 64, 64, ck, scratch);
            __syncthreads();
            if (wid == 0) {
                for (int i = 0; i < 64; ++i) {
                    const float* cc = ck + i * 384;
                    float sa = 0.f;
#pragma unroll
                    for (int k = 0; k < 64; ++k) sa += S[k] * cc[256 + k];
                    const float vv = cc[192 + lane];
#pragma unroll
                    for (int k = 0; k < 64; ++k) S[k] = S[k] * cc[64 + k] + sa * cc[320 + k] + vv * cc[128 + k];
                    float y = 0.f;
#pragma unroll
                    for (int k = 0; k < 64; ++k) y += S[k] * cc[k];
                    const float mean = wave_sum(y) * (1.f / 64.f);
                    const float dy = y - mean;
                    const float var = wave_sum(dy * dy) * (1.f / 64.f);
                    const float yn = dy * rsqrtf(var + 64e-5f) * lg + lb;
                    const float bonus = wave_sum(cc[lane] * cc[128 + lane] * rk) * vv;
                    const int t = c * 64 + i; const size_t row = (size_t)(b * T + t);
                    const float z = bf2f(P[row * NP + C_ZA + ch]);
                    YA[row * 512 + ch] = f2bf((yn + bonus) * siluf_(z));
                }
            }
        }
    }
}

constexpr size_t AF_BYTES = 16384, NF_BYTES = 16384, NCHUNK = 128;
constexpr size_t OFF_AF = 0, OFF_NF = (size_t)16 * NCHUNK * AF_BYTES;
typedef float f32x16 __attribute__((ext_vector_type(16)));
typedef float f32x2 __attribute__((ext_vector_type(2)));

DI float quad_sum(float s) {
    s += __int_as_float(__builtin_amdgcn_update_dpp(0, __float_as_int(s), 0xB1, 0xF, 0xF, true));
    s += __int_as_float(__builtin_amdgcn_update_dpp(0, __float_as_int(s), 0x4E, 0xF, 0xF, true));
    return s;
}

DI float rwkv_stage_tok(const Params& p, const bf16_t* P, int b, int h, int t, float* o, float* sc, float mu_r, float mu_k, float mu_v, float mu_w, float mu_a,
                        float w0c, float a0c, float kkc, float kac, float rkc) {
    const int lane = threadIdx.x & 63, ch = h * 64 + lane;
    const bf16_t* pr = P + (size_t)(b * T + t) * NP; const bf16_t* pp = pr - NP; const bool hp = t > 0;
    const float rc = bf2f(pr[C_R + ch]), rp = hp ? bf2f(pp[C_R + ch]) : 0.f;
    const float kc = bf2f(pr[C_K + ch]), kp = hp ? bf2f(pp[C_K + ch]) : 0.f;
    const float vc = bf2f(pr[C_V + ch]), vp = hp ? bf2f(pp[C_V + ch]) : 0.f;
    const float wc = bf2f(pr[C_W + lane]), wp = hp ? bf2f(pp[C_W + lane]) : 0.f;
    const float ac = bf2f(pr[C_A + lane]), ap = hp ? bf2f(pp[C_A + lane]) : 0.f;
    const float r = rc + (rp - rc) * mu_r, k = kc + (kp - kc) * mu_k, v = vc + (vp - vc) * mu_v;
    const float lw = wc + (wp - wc) * mu_w, la = ac + (ap - ac) * mu_a;
    sc[lane] = tanhf(lw); sc[64 + lane] = la;
    float accw = 0.f, acca = 0.f;
    const float* w2p = p.w2; const float* a2p = p.a2;
    asm volatile("" : "+s"(w2p), "+s"(a2p));
#pragma unroll 8
    for (int j = 0; j < 64; ++j) { accw += sc[j] * w2p[j * 512 + ch]; acca += sc[64 + j] * a2p[j * 512 + ch]; }
    const float xw = -(w0c + accw);
    const float sp = xw > 20.f ? xw : log1pf(expf(xw));
    const float decay = expf(-expf(-sp - 0.5f));
    const float alpha = 1.f / (1.f + expf(-(a0c + acca)));
    const float kk0 = k * kkc;
    const float n2 = wave_sum(kk0 * kk0);
    const float kk = kk0 / fmaxf(sqrtf(n2), 1e-12f);
    const float k2 = k * (1.f + (alpha - 1.f) * kac);
    o[lane] = r; o[64 + lane] = decay; o[128 + lane] = k2; o[192 + lane] = v; o[256 + lane] = -kk; o[320 + lane] = kk * alpha;
    return wave_sum(r * k2 * rkc);
}

template <int MODE> DI void rwkv_step(float (&z)[4][16], const float* cc, int q, int g, float (&sa)[4]) {
    f32x4 av[4], wv[4], bv[4], kv[4];
#pragma unroll
    for (int u = 0; u < 4; ++u) { av[u] = *(const f32x4*)(cc + 256 + 16 * q + 4 * u); wv[u] = *(const f32x4*)(cc + 64 + 16 * q + 4 * u); bv[u] = *(const f32x4*)(cc + 320 + 16 * q + 4 * u);
        if (MODE == 1) kv[u] = *(const f32x4*)(cc + 128 + 16 * q + 4 * u); }
    f32x4 vr = (f32x4){0.f, 0.f, 0.f, 0.f};
    if (MODE == 1) vr = *(const f32x4*)(cc + 192 + 4 * g);
#pragma unroll
    for (int rr = 0; rr < 4; ++rr) {
        float s0 = 0.f, s1 = 0.f;
#pragma unroll
        for (int u = 0; u < 4; ++u) { s0 += z[rr][4 * u] * av[u][0] + z[rr][4 * u + 2] * av[u][2]; s1 += z[rr][4 * u + 1] * av[u][1] + z[rr][4 * u + 3] * av[u][3]; }
        sa[rr] = quad_sum(s0 + s1);
    }
#pragma unroll
    for (int rr = 0; rr < 4; ++rr)
#pragma unroll
        for (int u = 0; u < 4; ++u)
#pragma unroll
            for (int e = 0; e < 4; ++e) {
                float t = sa[rr] * bv[u][e];
                if (MODE == 1) t += vr[rr] * kv[u][e];
                z[rr][4 * u + e] = z[rr][4 * u + e] * wv[u][e] + t;
            }
}

DI void phase_rwkv_prep(const Params& p, unsigned char* lds, const int bid, const int nb) {
    float* ck = (float*)lds; float* scratch = ck + 64 * 384; float* mat = (float*)lds;
    const bf16_t* P = (const bf16_t*)(p.ws + OFF_P);
    unsigned char* fr = (unsigned char*)p.out;
    const int tid = threadIdx.x, lane = tid & 63, wid = tid >> 6, q = lane & 3, g = lane >> 2, cl = wid >> 1, role = wid & 1;
    for (int item = bid; item < 512; item += nb) {
        const int bh = item >> 5, cq = item & 31, b = bh >> 3, h = bh & 7, ch = h * 64 + lane;
        const float mu_r = p.mu_rkv[ch], mu_k = p.mu_rkv[512 + ch], mu_v = p.mu_rkv[1024 + ch], mu_w = p.mu_wa[lane], mu_a = p.mu_wa[64 + lane];
        const float w0c = p.w0[ch], a0c = p.a0[ch], kkc = p.k_k[ch], kac = p.k_a[ch], rkc = p.r_k[ch];
        float z[4][16];
#pragma unroll
        for (int rr = 0; rr < 4; ++rr)
#pragma unroll
            for (int c = 0; c < 16; ++c) z[rr][c] = (role == 0 && (4 * g + rr) == (16 * q + c)) ? 1.f : 0.f;
        for (int sl = 0; sl < 4; ++sl) {
            __syncthreads();
#pragma unroll 1
            for (int sidx = wid; sidx < 64; sidx += NWAVES) {
                const int clx = sidx >> 4, i = sidx & 15, t = (cq * 4 + clx) * 64 + sl * 16 + i;
                (void)rwkv_stage_tok(p, P, b, h, t, ck + sidx * 384, scratch + wid * 128, mu_r, mu_k, mu_v, mu_w, mu_a, w0c, a0c, kkc, kac, rkc);
            }
            __syncthreads();
            float sa[4];
            if (role == 0) {
#pragma unroll 1
                for (int i = 0; i < 16; ++i) rwkv_step<0>(z, ck + (cl * 16 + i) * 384, q, g, sa); }
            else {
#pragma unroll 1
                for (int i = 0; i < 16; ++i) rwkv_step<1>(z, ck + (cl * 16 + i) * 384, q, g, sa); }
        }
        for (int pass = 0; pass < 2; ++pass) {
            __syncthreads();
            if (role == pass) {
#pragma unroll
                for (int rr = 0; rr < 4; ++rr)
#pragma unroll
                    for (int u = 0; u < 4; ++u) *(f32x4*)(mat + (cl * 64 + 4 * g + rr) * 68 + 16 * q + 4 * u) = (f32x4){z[rr][4 * u], z[rr][4 * u + 1], z[rr][4 * u + 2], z[rr][4 * u + 3]};
            }
            __syncthreads();
            if (pass == 0) {
                for (int it = tid; it < 4 * 8 * 64; it += NTHREADS) {
                    const int clx = it >> 9, f = (it >> 6) & 7, l = it & 63, r = l & 31, hh = l >> 5, fi = f >> 2, fj = (f >> 1) & 1, fs = f & 1;
                    const size_t chunk = (size_t)bh * NCHUNK + cq * 4 + clx;
                    unsigned hi[4], lo[4];
#pragma unroll
                    for (int e2 = 0; e2 < 4; ++e2) {
                        unsigned short hs[2], ls[2];
#pragma unroll
                        for (int d = 0; d < 2; ++d) { const int e = 2 * e2 + d, kin = 32 * fj + 16 * fs + 8 * (e >> 2) + 4 * hh + (e & 3), kout = 32 * fi + r;
                            const float val = mat[(clx * 64 + kin) * 68 + kout]; hs[d] = f2bf(val); ls[d] = f2bf(val - bf2f(hs[d])); }
                        hi[e2] = (unsigned)hs[0] | ((unsigned)hs[1] << 16); lo[e2] = (unsigned)ls[0] | ((unsigned)ls[1] << 16);
                    }
                    unsigned char* dst = fr + OFF_AF + chunk * AF_BYTES + (size_t)((f * 2) * 64 + l) * 16;
                    *(uint4*)dst = make_uint4(hi[0], hi[1], hi[2], hi[3]);
                    *(uint4*)(dst + 64 * 16) = make_uint4(lo[0], lo[1], lo[2], lo[3]);
                }
            } else {
                for (int it = tid; it < 4 * 2 * 2 * 64 * 4; it += NTHREADS) {
                    const int gq = it & 3, l = (it >> 2) & 63, fi = (it >> 8) & 1, w2 = (it >> 9) & 1, clx = it >> 10, hh = l >> 5;
                    const size_t chunk = (size_t)bh * NCHUNK + cq * 4 + clx;
                    const f32x4 v4 = *(const f32x4*)(mat + (clx * 64 + 32 * w2 + (l & 31)) * 68 + 32 * fi + 8 * gq + 4 * hh);
                    *(f32x4*)(fr + OFF_NF + chunk * NF_BYTES + (size_t)(((w2 * 2 + fi) * 64 + l) * 16 + 4 * gq) * 4) = v4;
                }
            }
        }
    }
}

DI void split8(const f32x16& x, int s, bf16x8& hi, bf16x8& lo) {
#pragma unroll
    for (int e = 0; e < 8; ++e) { const float v = x[8 * s + e]; const bf16_t hb = f2bf(v); hi[e] = (short)hb; lo[e] = (short)f2bf(v - bf2f(hb)); }
}
DI void phase_rwkv_scan(const Params& p, unsigned char* lds, const int bh) {
    unsigned char* fr = (unsigned char*)p.out;
    const int tid = threadIdx.x, lane = tid & 63, wid = tid >> 6;
    const unsigned char* gA = fr + OFF_AF + (size_t)bh * NCHUNK * AF_BYTES;
    unsigned char* gN = fr + OFF_NF + (size_t)bh * NCHUNK * NF_BYTES;
    __syncthreads();
    for (int c = 0; c < 3; ++c)
        for (int e = tid; e < 2048; e += NTHREADS) {
            const uint4 v = e < 1024 ? *(const uint4*)(gA + (size_t)c * AF_BYTES + e * 16) : *(const uint4*)(gN + (size_t)c * NF_BYTES + (e - 1024) * 16);
            *(uint4*)(lds + c * 32768 + e * 16) = v;
        }
    const int ltid = tid - 128;
    const bool loader = (wid >= 2 && wid < 6);
    uint4 la0, la1, la2, la3, ln0, ln1, ln2, ln3;
#define SCAN_LOAD(cc_) do { const unsigned char* a_ = gA + (size_t)(cc_) * AF_BYTES + ltid * 16; const unsigned char* n_ = gN + (size_t)(cc_) * NF_BYTES + ltid * 16; \
        la0 = *(const uint4*)a_; la1 = *(const uint4*)(a_ + 4096); la2 = *(const uint4*)(a_ + 8192); la3 = *(const uint4*)(a_ + 12288); \
        ln0 = *(const uint4*)n_; ln1 = *(const uint4*)(n_ + 4096); ln2 = *(const uint4*)(n_ + 8192); ln3 = *(const uint4*)(n_ + 12288); } while (0)
#define SCAN_WRITE(slot_) do { unsigned char* d_ = lds + (slot_) * 32768 + ltid * 16; \
        *(uint4*)d_ = la0; *(uint4*)(d_ + 4096) = la1; *(uint4*)(d_ + 8192) = la2; *(uint4*)(d_ + 12288) = la3; \
        *(uint4*)(d_ + 16384) = ln0; *(uint4*)(d_ + 20480) = ln1; *(uint4*)(d_ + 24576) = ln2; *(uint4*)(d_ + 28672) = ln3; } while (0)
    if (loader) SCAN_LOAD(3);
    f32x16 X0, X1;
#pragma unroll
    for (int i = 0; i < 16; ++i) { X0[i] = 0.f; X1[i] = 0.f; }
    for (int c = 0; c < (int)NCHUNK; ++c) {
        __syncthreads();
        if (wid >= 2) {
            if (loader) {
                if (c + 3 < (int)NCHUNK) SCAN_WRITE((c + 3) & 3);
                if (c + 4 < (int)NCHUNK) SCAN_LOAD(c + 4);
            }
        } else {
            const int w2 = wid;
            const unsigned char* slot = lds + (c & 3) * 32768;
            float* gs = (float*)(gN + (size_t)c * NF_BYTES) + ((w2 * 2) * 64 + lane) * 16;
#pragma unroll
            for (int gq = 0; gq < 4; ++gq) { *(f32x4*)(gs + 4 * gq) = (f32x4){X0[4 * gq], X0[4 * gq + 1], X0[4 * gq + 2], X0[4 * gq + 3]};
                                             *(f32x4*)(gs + 64 * 16 + 4 * gq) = (f32x4){X1[4 * gq], X1[4 * gq + 1], X1[4 * gq + 2], X1[4 * gq + 3]}; }
            bf16x8 bhi[2][2], blo[2][2];
            split8(X0, 0, bhi[0][0], blo[0][0]); split8(X0, 1, bhi[0][1], blo[0][1]); split8(X1, 0, bhi[1][0], blo[1][0]); split8(X1, 1, bhi[1][1], blo[1][1]);
            f32x16 Dn[2];
#pragma unroll
            for (int i = 0; i < 2; ++i) {
                const float* np = (const float*)(slot + 16384) + ((w2 * 2 + i) * 64 + lane) * 16;
#pragma unroll
                for (int gq = 0; gq < 4; ++gq) { const f32x4 v4 = *(const f32x4*)(np + 4 * gq); Dn[i][4 * gq] = v4[0]; Dn[i][4 * gq + 1] = v4[1]; Dn[i][4 * gq + 2] = v4[2]; Dn[i][4 * gq + 3] = v4[3]; }
#pragma unroll
                for (int j = 0; j < 2; ++j)
#pragma unroll
                    for (int s = 0; s < 2; ++s) {
                        const int f = (i * 2 + j) * 2 + s;
                        const bf16x8 ah = *(const bf16x8*)(slot + ((f * 2) * 64 + lane) * 16), al = *(const bf16x8*)(slot + ((f * 2 + 1) * 64 + lane) * 16);
                        Dn[i] = __builtin_amdgcn_mfma_f32_32x32x16_bf16(ah, bhi[j][s], Dn[i], 0, 0, 0);
                        Dn[i] = __builtin_amdgcn_mfma_f32_32x32x16_bf16(ah, blo[j][s], Dn[i], 0, 0, 0);
                        Dn[i] = __builtin_amdgcn_mfma_f32_32x32x16_bf16(al, bhi[j][s], Dn[i], 0, 0, 0);
                    }
            }
            X0 = Dn[0]; X1 = Dn[1];
        }
    }
}

constexpr int RS3 = 464;
DI void phase_rwkv_out(const Params& p, unsigned char* lds, const int bid, const int nb) {
    const bf16_t* P = (const bf16_t*)(p.ws + OFF_P); bf16_t* YA = (bf16_t*)(p.ws + OFF_YA);
    const unsigned char* fr = (const unsigned char*)p.out;
    const int tid = threadIdx.x, lane = tid & 63, wid = tid >> 6, q = lane & 3, g = lane >> 2;
    float* ck = (float*)lds + wid * (8 * RS3); float* sc = (float*)lds + 8 * 8 * RS3 + wid * 128;
    for (int item = bid; item < 256; item += nb) {
        const int bh = item >> 4, co = item & 15, b = bh >> 3, h = bh & 7, ch = h * 64 + lane, c = co * 8 + wid;
        const float mu_r = p.mu_rkv[ch], mu_k = p.mu_rkv[512 + ch], mu_v = p.mu_rkv[1024 + ch], mu_w = p.mu_wa[lane], mu_a = p.mu_wa[64 + lane];
        const float w0c = p.w0[ch], a0c = p.a0[ch], kkc = p.k_k[ch], kac = p.k_a[ch], rkc = p.r_k[ch];
        const int vo = 4 * g + q;
        const float lg = p.lnx_g[h * 64 + vo], lb = p.lnx_b[h * 64 + vo];
        float z[4][16];
        {
            const float* sf = (const float*)(fr + OFF_NF + ((size_t)bh * NCHUNK + c) * NF_BYTES);
#pragma unroll
            for (int rr = 0; rr < 4; ++rr) { const int v = 4 * g + rr, w2 = v >> 5, vl = v & 31, fi = q >> 1;
#pragma unroll
                for (int u = 0; u < 4; ++u) { const int hh = u & 1, r0 = 4 * (2 * (q & 1) + (u >> 1));
                    const f32x4 v4 = *(const f32x4*)(sf + ((w2 * 2 + fi) * 64 + vl + 32 * hh) * 16 + r0);
                    z[rr][4 * u] = v4[0]; z[rr][4 * u + 1] = v4[1]; z[rr][4 * u + 2] = v4[2]; z[rr][4 * u + 3] = v4[3]; } }
        }
#pragma unroll 1
        for (int sl = 0; sl < 8; ++sl) {
#pragma unroll 1
            for (int i = 0; i < 8; ++i) {
                const int t = c * 64 + sl * 8 + i; float* o = ck + i * RS3;
                const float bon = rwkv_stage_tok(p, P, b, h, t, o, sc, mu_r, mu_k, mu_v, mu_w, mu_a, w0c, a0c, kkc, kac, rkc);
                o[384 + lane] = bf2f(P[(size_t)(b * T + t) * NP + C_ZA + ch]);
                if (lane == 0) o[448] = bon;
            }
#pragma unroll 1
            for (int i = 0; i < 8; ++i) {
                const float* cc = ck + i * RS3; float sa[4];
                rwkv_step<1>(z, cc, q, g, sa);
                f32x4 rv[4];
#pragma unroll
                for (int u = 0; u < 4; ++u) rv[u] = *(const f32x4*)(cc + 16 * q + 4 * u);
                float y[4];
#pragma unroll
                for (int rr = 0; rr < 4; ++rr) { float s0 = 0.f;
#pragma unroll
                    for (int u = 0; u < 4; ++u) s0 += z[rr][4 * u] * rv[u][0] + z[rr][4 * u + 1] * rv[u][1] + z[rr][4 * u + 2] * rv[u][2] + z[rr][4 * u + 3] * rv[u][3];
                    y[rr] = quad_sum(s0); }
                float tot = (y[0] + y[1]) + (y[2] + y[3]);
#pragma unroll
                for (int o2 = 4; o2 < 64; o2 <<= 1) tot += __shfl_xor(tot, o2, 64);
                const float mean = tot * (1.f / 64.f);
                float d0 = y[0] - mean, d1 = y[1] - mean, d2 = y[2] - mean, d3 = y[3] - mean;
                float vs = (d0 * d0 + d1 * d1) + (d2 * d2 + d3 * d3);
#pragma unroll
                for (int o2 = 4; o2 < 64; o2 <<= 1) vs += __shfl_xor(vs, o2, 64);
                const float rstd = rsqrtf(vs * (1.f / 64.f) + 64e-5f);
                const float dv = q == 0 ? d0 : q == 1 ? d1 : q == 2 ? d2 : d3;
                const float yn = dv * rstd * lg + lb;
                const float outv = (yn + cc[448] * cc[192 + vo]) * siluf_(cc[384 + vo]);
                const int t = c * 64 + sl * 8 + i;
                YA[(size_t)(b * T + t) * 512 + h * 64 + vo] = f2bf(outv);
            }
        }
    }
}

DI void phase_swa_simple(const Params& p, unsigned char* lds, const int bid, const int nb) {
    const bf16_t* P = (const bf16_t*)(p.ws + OFF_P); bf16_t* YB = (bf16_t*)(p.ws + OFF_YB);
    const long total = (long)BATCH * 8 * T;
    for (long it = (long)bid * NTHREADS + threadIdx.x; it < total; it += (long)nb * NTHREADS) {
        const int t = (int)(it % T), qh = (int)((it / T) % 8), b = (int)(it / ((long)T * 8)), kvh = qh >> 2;
        const size_t row = (size_t)(b * T + t);
        float q[64], acc[64];
        {
            const uint4* qp = (const uint4*)(P + row * NP + C_Q + qh * 64);
#pragma unroll
            for (int i = 0; i < 8; ++i) { const uint4 u = qp[i]; const unsigned w[4] = {u.x, u.y, u.z, u.w};
#pragma unroll
                for (int j = 0; j < 4; ++j) { q[i * 8 + j * 2] = __uint_as_float(w[j] << 16); q[i * 8 + j * 2 + 1] = __uint_as_float(w[j] & 0xffff0000u); } }
        }
#pragma unroll
        for (int d = 0; d < 64; ++d) acc[d] = 0.f;
        float m = p.sinks[qh], l = 1.f;
        for (int j = 0; j < 128; ++j) {
            const int s = t - 127 + j;
            if (s < 0) continue;
            const size_t krow = (size_t)(b * T + s) * NP;
            const uint4* kp = (const uint4*)(P + krow + C_SK + kvh * 64);
            float dot = 0.f;
#pragma unroll
            for (int i = 0; i < 8; ++i) { const uint4 u = kp[i]; const unsigned w[4] = {u.x, u.y, u.z, u.w};
#pragma unroll
                for (int jj = 0; jj < 4; ++jj) { dot += q[i * 8 + jj * 2] * __uint_as_float(w[jj] << 16) + q[i * 8 + jj * 2 + 1] * __uint_as_float(w[jj] & 0xffff0000u); } }
            const float sc = dot * 0.125f;
            const float mn = fmaxf(m, sc), corr = __expf(m - mn), pe = __expf(sc - mn);
            l = l * corr + pe; m = mn;
            const uint4* vp = (const uint4*)(P + krow + C_SV + kvh * 64);
#pragma unroll
            for (int i = 0; i < 8; ++i) { const uint4 u = vp[i]; const unsigned w[4] = {u.x, u.y, u.z, u.w};
#pragma unroll
                for (int jj = 0; jj < 4; ++jj) { acc[i * 8 + jj * 2] = acc[i * 8 + jj * 2] * corr + pe * __uint_as_float(w[jj] << 16);
                                                 acc[i * 8 + jj * 2 + 1] = acc[i * 8 + jj * 2 + 1] * corr + pe * __uint_as_float(w[jj] & 0xffff0000u); } }
        }
        const float inv = 1.f / l;
        const bf16_t* zp = P + row * NP + C_ZB + qh * 64; bf16_t* op = YB + row * 512 + qh * 64;
#pragma unroll
        for (int d = 0; d < 64; ++d) op[d] = f2bf(acc[d] * inv * siluf_(bf2f(zp[d])));
    }
}

DI void phase_xattn_simple(const Params& p, unsigned char* lds, const int bid, const int nb) {
    const bf16_t* P = (const bf16_t*)(p.ws + OFF_P); const bf16_t* KVM = (const bf16_t*)(p.ws + OFF_KVM); bf16_t* YC = (bf16_t*)(p.ws + OFF_YC);
    const int lane = threadIdx.x & 63, wid = threadIdx.x >> 6;
    const long total = (long)M * 4;
    const float scale = 0.08838834764831845f;
    for (long it = (long)bid * NWAVES + wid; it < total; it += (long)nb * NWAVES) {
        const int row = (int)(it >> 2), hd = (int)(it & 3), b = row / T;
        const bf16_t* qp = P + (size_t)row * NP + C_XQ + hd * 128;
        const bf16_t* kb = KVM + (size_t)(b * MEMLEN) * 1024 + hd * 128;
        float s[4] = {0.f, 0.f, 0.f, 0.f};
        for (int c = 0; c < 16; ++c) {
            const uint4 qu = *(const uint4*)(qp + c * 8); const unsigned qw[4] = {qu.x, qu.y, qu.z, qu.w};
#pragma unroll
            for (int i = 0; i < 4; ++i) {
                const uint4 ku = *(const uint4*)(kb + (size_t)(lane + 64 * i) * 1024 + c * 8); const unsigned kw[4] = {ku.x, ku.y, ku.z, ku.w};
#pragma unroll
                for (int j = 0; j < 4; ++j) s[i] += __uint_as_float(qw[j] << 16) * __uint_as_float(kw[j] << 16) + __uint_as_float(qw[j] & 0xffff0000u) * __uint_as_float(kw[j] & 0xffff0000u);
            }
        }
        float mx = -1e30f;
#pragma unroll
        for (int i = 0; i < 4; ++i) { s[i] *= scale; mx = fmaxf(mx, s[i]); }
        mx = wave_max(mx);
        float pe[4], sum = 0.f;
#pragma unroll
        for (int i = 0; i < 4; ++i) { pe[i] = __expf(s[i] - mx); sum += pe[i]; }
        sum = wave_sum(sum);
        const float inv = 1.f / sum;
        float o0 = 0.f, o1 = 0.f;
        const bf16_t* vb = kb + 512;
#pragma unroll
        for (int i = 0; i < 4; ++i)
            for (int mm = 0; mm < 64; ++mm) {
                const float pv = __shfl(pe[i], mm, 64);
                const bf16_t* vr = vb + (size_t)(mm + 64 * i) * 1024;
                o0 += pv * bf2f(vr[lane]); o1 += pv * bf2f(vr[lane + 64]);
            }
        const bf16_t* zp = P + (size_t)row * NP + C_ZC + hd * 128; bf16_t* op = YC + (size_t)row * 512 + hd * 128;
        op[lane] = f2bf(o0 * inv * siluf_(bf2f(zp[lane]))); op[lane + 64] = f2bf(o1 * inv * siluf_(bf2f(zp[lane + 64])));
    }
}

#define MFMA32(a, b, c) __builtin_amdgcn_mfma_f32_32x32x16_bf16((a), (b), (c), 0, 0, 0)
typedef short s16x4 __attribute__((ext_vector_type(4)));
DI int crow(int reg, int hh) { return (reg & 3) + 8 * (reg >> 2) + 4 * hh; }
template <int Dh> DI unsigned k_off(int row, int chunk) { return (unsigned)(row * (Dh * 2) + ((chunk ^ (row & (Dh / 8 - 1))) << 4)); }
DI bf16x8 pack8(const f32x16& x, int s) {
    bf16x8 r;
#pragma unroll
    for (int e = 0; e < 8; ++e) r[e] = (short)f2bf(x[8 * s + e]);
    return r;
}
constexpr int VS = 528;

DI void swa_unit(const Params& p, unsigned char* lds, int unit) {
    const bf16_t* P = (const bf16_t*)(p.ws + OFF_P); bf16_t* YB = (bf16_t*)(p.ws + OFF_YB);
    int tid = threadIdx.x; asm volatile("" : "+v"(tid));
    const int lane = tid & 63, wid = __builtin_amdgcn_readfirstlane(tid >> 6), c = lane & 31, hh = lane >> 5;
    const int n = unit & 63, kvh = (unit >> 6) & 1, b = unit >> 7;
    unsigned char* Kl = lds; unsigned char* Vt = lds + 32768;
    __syncthreads();
#pragma unroll
    for (int u = 0; u < 4; ++u) {
        const int idx = tid + 512 * u;
        { const int row = idx >> 3, chunk = idx & 7, t = n * 128 - 128 + row;
          uint4 v = make_uint4(0u, 0u, 0u, 0u);
          if (t >= 0) v = *(const uint4*)(P + (size_t)(b * T + t) * NP + C_SK + kvh * 64 + chunk * 8);
          *(uint4*)(Kl + k_off<64>(row, chunk)) = v; }
        { const int key = idx & 255, dch = idx >> 8, t = n * 128 - 128 + key;
          uint4 v = make_uint4(0u, 0u, 0u, 0u);
          if (t >= 0) v = *(const uint4*)(P + (size_t)(b * T + t) * NP + C_SV + kvh * 64 + dch * 8);
          const unsigned w[4] = {v.x, v.y, v.z, v.w};
#pragma unroll
          for (int e = 0; e < 8; ++e) *(bf16_t*)(Vt + (dch * 8 + e) * VS + key * 2) = (bf16_t)(e & 1 ? w[e >> 1] >> 16 : w[e >> 1] & 0xffffu); }
    }
    __syncthreads();
    const int qh = kvh * 4 + (wid >> 1), rh = wid & 1;
    const float sink = p.sinks[qh];
#pragma unroll 1
    for (int rt = 0; rt < 2; ++rt) {
        const int base = 64 * rh + 32 * rt;
        const size_t qrow = (size_t)(b * T + n * 128 + base + c);
        bf16x8 qf[4];
#pragma unroll
        for (int ds = 0; ds < 4; ++ds) qf[ds] = *(const bf16x8*)(P + qrow * NP + C_Q + qh * 64 + 16 * ds + 8 * hh);
        f32x16 st[5];
#pragma unroll
        for (int kt = 0; kt < 5; ++kt) {
#pragma unroll
            for (int i = 0; i < 16; ++i) st[kt][i] = 0.f;
#pragma unroll
            for (int ds = 0; ds < 4; ++ds) { const bf16x8 a = *(const bf16x8*)(Kl + k_off<64>(base + 32 * kt + c, 2 * ds + hh)); st[kt] = MFMA32(a, qf[ds], st[kt]); }
        }
        float mx = sink;
#pragma unroll
        for (int kt = 0; kt < 5; ++kt)
#pragma unroll
            for (int i = 0; i < 16; ++i) {
                const int cr = crow(i, hh);
                bool ok = true;
                if (kt == 0) ok = cr > c;
                if (kt == 4) ok = cr <= c;
                if (n == 0) ok = ok && (base + 32 * kt + cr >= 128);
                const float s = ok ? st[kt][i] * 0.125f : -1e30f;
                st[kt][i] = s; mx = fmaxf(mx, s);
            }
        mx = fmaxf(mx, __shfl_xor(mx, 32, 64));
        float ls = 0.f;
#pragma unroll
        for (int kt = 0; kt < 5; ++kt)
#pragma unroll
            for (int i = 0; i < 16; ++i) { const float pe = __expf(st[kt][i] - mx); st[kt][i] = pe; ls += pe; }
        ls += __shfl_xor(ls, 32, 64);
        const float inv = 1.f / (ls + __expf(sink - mx));
        f32x16 ot[2];
#pragma unroll
        for (int dt = 0; dt < 2; ++dt)
#pragma unroll
            for (int i = 0; i < 16; ++i) ot[dt][i] = 0.f;
#pragma unroll
        for (int kt = 0; kt < 5; ++kt)
#pragma unroll
            for (int s = 0; s < 2; ++s) {
                const bf16x8 pf = pack8(st[kt], s);
#pragma unroll
                for (int dt = 0; dt < 2; ++dt) {
                    const unsigned char* vp = Vt + (32 * dt + c) * VS + (base + 32 * kt + 16 * s + 4 * hh) * 2;
                    const s16x4 lo = *(const s16x4*)vp, hi = *(const s16x4*)(vp + 16);
                    const bf16x8 vf = __builtin_shufflevector(lo, hi, 0, 1, 2, 3, 4, 5, 6, 7);
                    ot[dt] = MFMA32(vf, pf, ot[dt]);
                }
            }
        const bf16_t* zp = P + qrow * NP + C_ZB + qh * 64; bf16_t* op = YB + qrow * 512 + qh * 64;
#pragma unroll
        for (int dt = 0; dt < 2; ++dt)
#pragma unroll
            for (int gq = 0; gq < 4; ++gq) {
                const int d0 = 32 * dt + 8 * gq + 4 * hh;
                const uint2 zz = *(const uint2*)(zp + d0);
                const float z0 = __uint_as_float(zz.x << 16), z1 = __uint_as_float(zz.x & 0xffff0000u), z2 = __uint_as_float(zz.y << 16), z3 = __uint_as_float(zz.y & 0xffff0000u);
                const unsigned o0 = (unsigned)f2bf(ot[dt][4 * gq] * inv * siluf_(z0)) | ((unsigned)f2bf(ot[dt][4 * gq + 1] * inv * siluf_(z1)) << 16);
                const unsigned o1 = (unsigned)f2bf(ot[dt][4 * gq + 2] * inv * siluf_(z2)) | ((unsigned)f2bf(ot[dt][4 * gq + 3] * inv * siluf_(z3)) << 16);
                *(uint2*)(op + d0) = make_uint2(o0, o1);
            }
    }
}

DI void xattn_unit(const Params& p, unsigned char* lds, int unit) {
    const bf16_t* P = (const bf16_t*)(p.ws + OFF_P); const bf16_t* KVM = (const bf16_t*)(p.ws + OFF_KVM); bf16_t* YC = (bf16_t*)(p.ws + OFF_YC);
    int tid = threadIdx.x; asm volatile("" : "+v"(tid));
    const int lane = tid & 63, wid = __builtin_amdgcn_readfirstlane(tid >> 6), c = lane & 31, hh = lane >> 5;
    const int qb = unit & 31, hd = (unit >> 5) & 3, b = unit >> 7;
    unsigned char* Kl = lds; unsigned char* Vt = lds + 65536;
    const bf16_t* kb = KVM + (size_t)(b * MEMLEN) * 1024 + hd * 128;
    __syncthreads();
#pragma unroll
    for (int u = 0; u < 8; ++u) {
        const int idx = tid + 512 * u;
        { const int row = idx >> 4, chunk = idx & 15;
          *(uint4*)(Kl + k_off<128>(row, chunk)) = *(const uint4*)(kb + (size_t)row * 1024 + chunk * 8); }
        { const int key = idx & 255, dch = idx >> 8;
          const uint4 v = *(const uint4*)(kb + (size_t)key * 1024 + 512 + dch * 8);
          const unsigned w[4] = {v.x, v.y, v.z, v.w};
#pragma unroll
          for (int e = 0; e < 8; ++e) *(bf16_t*)(Vt + (dch * 8 + e) * VS + key * 2) = (bf16_t)(e & 1 ? w[e >> 1] >> 16 : w[e >> 1] & 0xffffu); }
    }
    __syncthreads();
    const size_t qrow = (size_t)(b * T + qb * 256 + wid * 32 + c);
    const float scale = 0.08838834764831845f;
    bf16x8 qf[8];
#pragma unroll
    for (int ds = 0; ds < 8; ++ds) qf[ds] = *(const bf16x8*)(P + qrow * NP + C_XQ + hd * 128 + 16 * ds + 8 * hh);
    f32x16 ot[4];
#pragma unroll
    for (int dt = 0; dt < 4; ++dt)
#pragma unroll
        for (int i = 0; i < 16; ++i) ot[dt][i] = 0.f;
    float mrun = -1e30f, lrun = 0.f;
#pragma unroll 1
    for (int half = 0; half < 2; ++half) {
        f32x16 st[4];
#pragma unroll
        for (int kt = 0; kt < 4; ++kt) {
#pragma unroll
            for (int i = 0; i < 16; ++i) st[kt][i] = 0.f;
#pragma unroll
            for (int ds = 0; ds < 8; ++ds) { const bf16x8 a = *(const bf16x8*)(Kl + k_off<128>(128 * half + 32 * kt + c, 2 * ds + hh)); st[kt] = MFMA32(a, qf[ds], st[kt]); }
        }
        float mx = mrun;
#pragma unroll
        for (int kt = 0; kt < 4; ++kt)
#pragma unroll
            for (int i = 0; i < 16; ++i) { st[kt][i] *= scale; mx = fmaxf(mx, st[kt][i]); }
        mx = fmaxf(mx, __shfl_xor(mx, 32, 64));
        const float corr = __expf(mrun - mx);
        float ls = 0.f;
#pragma unroll
        for (int kt = 0; kt < 4; ++kt)
#pragma unroll
            for (int i = 0; i < 16; ++i) { const float pe = __expf(st[kt][i] - mx); st[kt][i] = pe; ls += pe; }
        ls += __shfl_xor(ls, 32, 64);
        lrun = lrun * corr + ls; mrun = mx;
#pragma unroll
        for (int dt = 0; dt < 4; ++dt)
#pragma unroll
            for (int i = 0; i < 16; ++i) ot[dt][i] *= corr;
#pragma unroll
        for (int kt = 0; kt < 4; ++kt)
#pragma unroll
            for (int s = 0; s < 2; ++s) {
                const bf16x8 pf = pack8(st[kt], s);
#pragma unroll
                for (int dt = 0; dt < 4; ++dt) {
                    const unsigned char* vp = Vt + (32 * dt + c) * VS + (128 * half + 32 * kt + 16 * s + 4 * hh) * 2;
                    const s16x4 lo = *(const s16x4*)vp, hi = *(const s16x4*)(vp + 16);
                    const bf16x8 vf = __builtin_shufflevector(lo, hi, 0, 1, 2, 3, 4, 5, 6, 7);
                    ot[dt] = MFMA32(vf, pf, ot[dt]);
                }
            }
    }
    const float inv = 1.f / lrun;
    const bf16_t* zp = P + qrow * NP + C_ZC + hd * 128; bf16_t* op = YC + qrow * 512 + hd * 128;
#pragma unroll
    for (int dt = 0; dt < 4; ++dt)
#pragma unroll
        for (int gq = 0; gq < 4; ++gq) {
            const int d0 = 32 * dt + 8 * gq + 4 * hh;
            const uint2 zz = *(const uint2*)(zp + d0);
            const float z0 = __uint_as_float(zz.x << 16), z1 = __uint_as_float(zz.x & 0xffff0000u), z2 = __uint_as_float(zz.y << 16), z3 = __uint_as_float(zz.y & 0xffff0000u);
            const unsigned o0 = (unsigned)f2bf(ot[dt][4 * gq] * inv * siluf_(z0)) | ((unsigned)f2bf(ot[dt][4 * gq + 1] * inv * siluf_(z1)) << 16);
            const unsigned o1 = (unsigned)f2bf(ot[dt][4 * gq + 2] * inv * siluf_(z2)) | ((unsigned)f2bf(ot[dt][4 * gq + 3] * inv * siluf_(z3)) << 16);
            *(uint2*)(op + d0) = make_uint2(o0, o1);
        }
}
DI void phase_attn(const Params& p, unsigned char* lds, const int bid, const int nb) {
    for (int u = bid; u < 512; u += nb) { if (u < 256) swa_unit(p, lds, u); else xattn_unit(p, lds, u - 256); }
}

namespace pg8 {
#define PG8_LAS __attribute__((address_space(3)))
typedef unsigned short bf16_t;
typedef short bf16x8 __attribute__((ext_vector_type(8)));
typedef float f32x4 __attribute__((ext_vector_type(4)));
typedef unsigned u32x4 __attribute__((ext_vector_type(4)));
constexpr int BM = 256, BK = 64, HALF = 128, HTB = HALF * BK * 2  , STAGE_BYTES = 8 * HTB, NXCD = 8, WGM = 8;

__host__ __device__ __forceinline__ int lds_byte(int r, int c) { const int st = (r >> 4) * 2 + (c >> 5), rr = r & 15, cc = c & 31, ob = rr * 64 + cc * 2; return st * 1024 + (ob ^ (((ob >> 9) & 1) << 5)); }
__host__ __device__ __forceinline__ void stage_rc(int b, int& R, int& C) { const int st = b / 1024, sb = b % 1024, swz = sb ^ (((sb >> 9) & 1) << 5); R = (st >> 1) * 16 + swz / 64; C = (st & 1) * 32 + (swz % 64) / 2; }
__host__ __device__ __forceinline__ int perm32(int rho) { const int n = rho >> 4, i = rho & 15; return 8 * (i >> 2) + 4 * n + (i & 3); }

struct Unit { int pm, pn; };
struct Gemm { const bf16_t* A; const bf16_t* Bt; int M, N, K; };

struct StaticOrder {
    int nM, nN, nwg, G, c;
    __host__ __device__ void init(int M, int N, int G_, int c_) { nM = M / BM; nN = N / BM; nwg = nM * nN; G = G_; c = c_; }
    __host__ __device__ bool next(int i, Unit& u) const {
        const long L = (long)i * G + c; if (L >= nwg) return false;
        int wgid = (int)L; { const int q = nwg / NXCD, r = nwg % NXCD, xcd = wgid % NXCD, off = wgid / NXCD; wgid = (xcd < r ? xcd * (q + 1) : r * (q + 1) + (xcd - r) * q) + off; }
        const int nig = WGM * nN, gid = wgid / nig, fm = gid * WGM, gsz = (nM - fm) < WGM ? (nM - fm) : WGM;
        u.pm = fm + ((wgid % nig) % gsz); u.pn = (wgid % nig) / gsz; return true;
    }
    __device__ __forceinline__ void a_ready(const Unit&) const {}
    __device__ __forceinline__ void done(const Unit&) const {}
};
__device__ __forceinline__ unsigned cvt_pk_bf16(float lo, float hi) { typedef float f2_ __attribute__((ext_vector_type(2))); typedef __bf16 b2_ __attribute__((ext_vector_type(2))); return __builtin_bit_cast(unsigned, __builtin_convertvector((f2_){lo, hi}, b2_)); }
typedef float f32x2 __attribute__((ext_vector_type(2)));
template <class Epi, class Sched, bool ALIGN_EPI = false, bool SP2 = false>
__device__ __forceinline__ void gemm_phase(PG8_LAS unsigned char* lds, const Gemm g, const Sched& S, const Epi& E) {
    const int tid = threadIdx.x, wid = __builtin_amdgcn_readfirstlane(tid >> 6), lane = tid & 63, wr = wid >> 2, wc = wid & 3, fr = lane & 15, fq = lane >> 4;
    const int K = g.K, nt = K / BK;
    unsigned voffA[2], voffB[2];
#pragma unroll
    for (int i = 0; i < 2; ++i) { int R, C; stage_rc(tid * 16 + i * 8192, R, C); const int Rb = Epi::PERM ? ((R & ~31) + perm32(R & 31)) : R;
        voffA[i] = (unsigned)(R * K + C) * 2u; voffB[i] = (unsigned)(Rb * K + C) * 2u; }
    const size_t kstep = (size_t)(BK * 2);
    const size_t hstep = (size_t)HALF * K * 2;
    const size_t tstep = 2 * hstep;
    const unsigned ldsw = (unsigned)wid * 1024u;
    const int aoff = lds_byte(wr * 64 + fr, fq * 8), boff = lds_byte(wc * 32 + fr, fq * 8);
#define PG8_SA(b, h) (((b) * 2 + (h)) * HTB)
#define PG8_SB(b, h) ((4 + (b) * 2 + (h)) * HTB)
#define PG8_STAGE(bufoff, gbase, voff) do { _Pragma("unroll") for (int _i = 0; _i < 2; ++_i) \
        __builtin_amdgcn_global_load_lds((const unsigned*)((const char*)(gbase) + (voff)[_i]), (PG8_LAS unsigned*)(lds + (bufoff) + ldsw + _i * 8192), 16, 0, 0); } while (0)
#define PG8_LDA(dst, b, h) do { _Pragma("unroll") for (int m = 0; m < 4; ++m) _Pragma("unroll") for (int k = 0; k < 2; ++k) dst[m][k] = *(const PG8_LAS bf16x8*)(lds + PG8_SA(b, h) + aoff + m * 2048 + k * 1024); } while (0)
#define PG8_LDB(dst, b, h) do { _Pragma("unroll") for (int n = 0; n < 2; ++n) _Pragma("unroll") for (int k = 0; k < 2; ++k) dst[n][k] = *(const PG8_LAS bf16x8*)(lds + PG8_SB(b, h) + boff + n * 2048 + k * 1024); } while (0)
#define PG8_MMA(ai, bj, At, Bt) do { __builtin_amdgcn_s_setprio(1); _Pragma("unroll") for (int m = 0; m < 4; ++m) _Pragma("unroll") for (int n = 0; n < 2; ++n) _Pragma("unroll") for (int k = 0; k < 2; ++k) \
        acc[ai][bj][m][n] = __builtin_amdgcn_mfma_f32_16x16x32_bf16(Bt[n][k], At[m][k], acc[ai][bj][m][n], 0, 0, 0); __builtin_amdgcn_s_setprio(0); } while (0)
#define PG8_WAIT_V(n) asm volatile("s_waitcnt vmcnt(" #n ")" ::: "memory")
#define PG8_WAIT_L(n) asm volatile("s_waitcnt lgkmcnt(" #n ")" ::: "memory")
#define PG8_BAR __builtin_amdgcn_s_barrier()
#define PG8_SCHED __builtin_amdgcn_sched_barrier(0)
    Unit cur, nxt; int ui = 0;
    if (!S.next(0, cur)) return;
    f32x4 acc[2][2][4][2];
#pragma unroll
    for (int a = 0; a < 2; ++a)
#pragma unroll
        for (int b = 0; b < 2; ++b)
#pragma unroll
            for (int m = 0; m < 4; ++m)
#pragma unroll
                for (int n = 0; n < 2; ++n) acc[a][b][m][n] = (f32x4){0.f, 0.f, 0.f, 0.f};
    bf16x8 At[4][2], B0[2][2], B1[2][2];
    const char* cA = (const char*)g.A + (size_t)cur.pm * tstep; const char* cB = (const char*)g.Bt + (size_t)cur.pn * tstep;
    S.a_ready(cur);
    if constexpr (SP2) {
        PG8_STAGE(PG8_SB(0, 0), cB, voffB); PG8_STAGE(PG8_SB(0, 1), cB + hstep, voffB); PG8_STAGE(PG8_SA(0, 0), cA, voffA); PG8_STAGE(PG8_SA(0, 1), cA + hstep, voffA);
        if (wr == 1) PG8_BAR;
        PG8_WAIT_V(2); PG8_BAR;
        PG8_STAGE(PG8_SB(1, 0), cB + kstep, voffB); PG8_STAGE(PG8_SA(1, 0), cA + kstep, voffA); PG8_STAGE(PG8_SB(1, 1), cB + hstep + kstep, voffB);
        PG8_WAIT_V(6); PG8_BAR;
    } else {
        PG8_STAGE(PG8_SB(0, 0), cB, voffB); PG8_STAGE(PG8_SA(0, 0), cA, voffA); PG8_STAGE(PG8_SB(0, 1), cB + hstep, voffB); PG8_STAGE(PG8_SA(0, 1), cA + hstep, voffA);
        if (wr == 1) PG8_BAR;
        PG8_WAIT_V(4); PG8_BAR;
        PG8_STAGE(PG8_SB(1, 0), cB + kstep, voffB); PG8_STAGE(PG8_SA(1, 0), cA + kstep, voffA); PG8_STAGE(PG8_SB(1, 1), cB + hstep + kstep, voffB);
        PG8_WAIT_V(6); PG8_BAR;
    }
    for (;;) {
        const bool has_next = S.next(ui + 1, nxt);
        const char* nA = has_next ? (const char*)g.A + (size_t)nxt.pm * tstep : cA; const char* nB = has_next ? (const char*)g.Bt + (size_t)nxt.pn * tstep : cB;
        for (int t = 0; t < nt; t += 2) {
            const bool last = (t == nt - 2);
            const char* a1 = cA + (size_t)(t + 1) * kstep;
            const char* a2 = last ? nA : cA + (size_t)(t + 2) * kstep; const char* b2 = last ? nB : cB + (size_t)(t + 2) * kstep;
            const char* a3 = a2 + kstep; const char* b3 = b2 + kstep;
            if (last && has_next) S.a_ready(nxt);
            if constexpr (SP2) {
            PG8_LDB(B0, 0, 0); PG8_LDB(B1, 0, 1); PG8_SCHED; PG8_LDA(At, 0, 0); PG8_STAGE(PG8_SA(1, 1), a1 + hstep, voffA);
            PG8_WAIT_V(8); PG8_WAIT_L(0); PG8_BAR; PG8_MMA(0, 0, At, B0); PG8_MMA(0, 1, At, B1); PG8_BAR; PG8_SCHED;
            PG8_LDA(At, 0, 1); PG8_STAGE(PG8_SB(0, 0), b2, voffB); PG8_STAGE(PG8_SB(0, 1), b2 + hstep, voffB); PG8_STAGE(PG8_SA(0, 0), a2, voffA);
            PG8_WAIT_V(8); PG8_WAIT_L(0); PG8_BAR; PG8_MMA(1, 0, At, B0); PG8_MMA(1, 1, At, B1); PG8_BAR; PG8_SCHED;
            PG8_LDB(B0, 1, 0); PG8_LDB(B1, 1, 1); PG8_SCHED; PG8_LDA(At, 1, 0); PG8_STAGE(PG8_SA(0, 1), a2 + hstep, voffA);
            PG8_WAIT_V(8); PG8_WAIT_L(0); PG8_BAR; PG8_MMA(0, 0, At, B0); PG8_MMA(0, 1, At, B1); PG8_BAR; PG8_SCHED;
            PG8_LDA(At, 1, 1); PG8_STAGE(PG8_SB(1, 0), b3, voffB); PG8_STAGE(PG8_SB(1, 1), b3 + hstep, voffB); PG8_STAGE(PG8_SA(1, 0), a3, voffA);
            PG8_WAIT_V(8); PG8_WAIT_L(0); PG8_BAR; PG8_MMA(1, 0, At, B0); PG8_MMA(1, 1, At, B1); PG8_BAR; PG8_SCHED;
            } else {
            PG8_LDB(B0, 0, 0); PG8_SCHED; PG8_LDA(At, 0, 0); PG8_STAGE(PG8_SA(1, 1), a1 + hstep, voffA);
            PG8_WAIT_L(8); PG8_BAR; PG8_WAIT_L(0); PG8_MMA(0, 0, At, B0); PG8_BAR; PG8_SCHED;
            PG8_LDB(B1, 0, 1); PG8_STAGE(PG8_SB(0, 0), b2, voffB);
            PG8_BAR; PG8_WAIT_L(0); PG8_MMA(0, 1, At, B1); PG8_BAR;
            PG8_LDA(At, 0, 1); PG8_STAGE(PG8_SA(0, 0), a2, voffA);
            PG8_BAR; PG8_WAIT_L(0); PG8_MMA(1, 0, At, B0); PG8_BAR; PG8_SCHED;
            PG8_STAGE(PG8_SB(0, 1), b2 + hstep, voffB);
            PG8_WAIT_V(6); PG8_BAR; PG8_MMA(1, 1, At, B1); PG8_BAR;
            PG8_LDB(B0, 1, 0); PG8_SCHED; PG8_LDA(At, 1, 0); PG8_STAGE(PG8_SA(0, 1), a2 + hstep, voffA);
            PG8_WAIT_L(8); PG8_BAR; PG8_WAIT_L(0); PG8_MMA(0, 0, At, B0); PG8_BAR; PG8_SCHED;
            PG8_LDB(B1, 1, 1); PG8_STAGE(PG8_SB(1, 0), b3, voffB);
            PG8_BAR; PG8_WAIT_L(0); PG8_MMA(0, 1, At, B1); PG8_BAR;
            PG8_LDA(At, 1, 1); PG8_STAGE(PG8_SA(1, 0), a3, voffA);
            PG8_BAR; PG8_WAIT_L(0); PG8_MMA(1, 0, At, B0); PG8_BAR; PG8_SCHED;
            PG8_STAGE(PG8_SB(1, 1), b3 + hstep, voffB);
            PG8_WAIT_V(6); PG8_BAR; PG8_MMA(1, 1, At, B1); PG8_BAR;
            }
        }
        if constexpr (ALIGN_EPI) { if (wr == 0) PG8_BAR; }
        if constexpr (!Epi::AFTER_DRAIN) { E(acc, cur, wr, wc, fr, fq); S.done(cur); }
        if (!has_next) break;
#pragma unroll
        for (int a = 0; a < 2; ++a)
#pragma unroll
            for (int b = 0; b < 2; ++b)
#pragma unroll
                for (int m = 0; m < 4; ++m)
#pragma unroll
                    for (int n = 0; n < 2; ++n) acc[a][b][m][n] = (f32x4){0.f, 0.f, 0.f, 0.f};
        cur = nxt; cA = nA; cB = nB; ++ui;
        if constexpr (ALIGN_EPI) { if (wr == 1) PG8_BAR; }
    }
    PG8_WAIT_V(0);
    if constexpr (!ALIGN_EPI) { if (wr == 0) PG8_BAR; }
    PG8_BAR;
    if constexpr (Epi::AFTER_DRAIN) { E.fused(acc, cur, wr, wc, fr, fq, lds, wid, lane); S.done(cur); }
#undef PG8_SA
#undef PG8_SB
#undef PG8_STAGE
#undef PG8_LDA
#undef PG8_LDB
#undef PG8_MMA
#undef PG8_WAIT_V
#undef PG8_WAIT_L
#undef PG8_BAR
#undef PG8_SCHED
}
}

namespace pg8 {
template <int ACT> struct EpiStore {
    static constexpr bool PERM = true, AFTER_DRAIN = false;
    bf16_t* O; int ldc;
    __device__ __forceinline__ void operator()(const f32x4 (&acc)[2][2][4][2], const Unit& u, int wr, int wc, int fr, int fq) const {
        const int row0 = u.pm * BM + wr * 64 + fr, col0 = u.pn * BM + wc * 32 + 8 * fq;
#pragma unroll
        for (int ai = 0; ai < 2; ++ai)
#pragma unroll
            for (int m = 0; m < 4; ++m) { bf16_t* rowp = O + (size_t)(row0 + ai * HALF + m * 16) * ldc + col0;
#pragma unroll
                for (int bj = 0; bj < 2; ++bj) { f32x4 v0 = acc[ai][bj][m][0], v1 = acc[ai][bj][m][1];
                    if (ACT == 1) {
#pragma unroll
                        for (int e = 0; e < 4; ++e) { v0[e] = __builtin_amdgcn_rcpf(1.f + __expf(-v0[e])); v1[e] = __builtin_amdgcn_rcpf(1.f + __expf(-v1[e])); } }
                    u32x4 w; w.x = cvt_pk_bf16(v0[0], v0[1]); w.y = cvt_pk_bf16(v0[2], v0[3]); w.z = cvt_pk_bf16(v1[0], v1[1]); w.w = cvt_pk_bf16(v1[2], v1[3]);
                    *(u32x4*)(rowp + bj * HALF) = w; } }
    }
};
template <bool ACCUM> struct EpiProj {
    static constexpr bool PERM = true, AFTER_DRAIN = false;
    bf16_t* MG; const bf16_t* SG; int gcol0;
    __device__ __forceinline__ void operator()(const f32x4 (&acc)[2][2][4][2], const Unit& u, int wr, int wc, int fr, int fq) const {
        const int row0 = u.pm * BM + wr * 64 + fr, col0 = u.pn * BM + wc * 32 + 8 * fq;
#pragma unroll
        for (int ai = 0; ai < 2; ++ai)
#pragma unroll
            for (int m = 0; m < 4; ++m) { const size_t row = (size_t)(row0 + ai * HALF + m * 16);
#pragma unroll
                for (int bj = 0; bj < 2; ++bj) {
                    const int col = col0 + bj * HALF;
                    const u32x4 gw = *(const u32x4*)(SG + row * 3072 + gcol0 + col);
                    u32x4 ow = (u32x4){0u, 0u, 0u, 0u};
                    if (ACCUM) ow = *(const u32x4*)(MG + row * 1024 + col);
                    float r[8];
#pragma unroll
                    for (int e = 0; e < 4; ++e) {
                        const float g0 = __uint_as_float(gw[e] << 16), g1 = __uint_as_float(gw[e] & 0xffff0000u);
                        const float a0 = e < 2 ? acc[ai][bj][m][0][2 * e] : acc[ai][bj][m][1][2 * e - 4], a1 = e < 2 ? acc[ai][bj][m][0][2 * e + 1] : acc[ai][bj][m][1][2 * e - 3];
                        r[2 * e] = g0 * a0; r[2 * e + 1] = g1 * a1;
                        if (ACCUM) { r[2 * e] += __uint_as_float(ow[e] << 16); r[2 * e + 1] += __uint_as_float(ow[e] & 0xffff0000u); }
                    }
                    u32x4 w; w.x = cvt_pk_bf16(r[0], r[1]); w.y = cvt_pk_bf16(r[2], r[3]); w.z = cvt_pk_bf16(r[4], r[5]); w.w = cvt_pk_bf16(r[6], r[7]);
                    *(u32x4*)(MG + row * 1024 + col) = w; } }
    }
};
struct EpiOut {
    static constexpr bool PERM = false, AFTER_DRAIN = false;
    const float* X; float* O;
    __device__ __forceinline__ void operator()(const f32x4 (&acc)[2][2][4][2], const Unit& u, int wr, int wc, int fr, int fq) const {
        const int row0 = u.pm * BM + wr * 64 + fr, col0 = u.pn * BM + wc * 32 + 4 * fq;
#pragma unroll
        for (int ai = 0; ai < 2; ++ai)
#pragma unroll
            for (int m = 0; m < 4; ++m) { const size_t off = (size_t)(row0 + ai * HALF + m * 16) * 1024 + col0;
#pragma unroll
                for (int bj = 0; bj < 2; ++bj)
#pragma unroll
                    for (int n = 0; n < 2; ++n) { const f32x4 xv = *(const f32x4*)(X + off + bj * HALF + n * 16); *(f32x4*)(O + off + bj * HALF + n * 16) = xv + acc[ai][bj][m][n]; } }
    }
};
}

DI void phase_gemm_gate(const Params& p, unsigned char* lds, const int bid, const int nb) {
    unsigned char* ws = p.ws;
    const bf16_t* H = (const bf16_t*)(ws + OFF_H); const bf16_t* Wt = (const bf16_t*)(ws + OFF_WIN) + (size_t)C_G * 1024;
    bf16_t* SG = (bf16_t*)(ws + OFF_SG);
    const int tn = 3072 / 128, nt = (M / 128) * tn;
    for (int it = bid; it < nt; it += nb) {
        GemmTile g; gemm_zero(g);
        const int m0 = (it / tn) * 128, n0 = (it % tn) * 128;
        gemm_tile_k(g, H, 1024, Wt, 1024, m0, n0, 1024, lds);
        GEMM_FOREACH(SG[(size_t)row * 3072 + col] = f2bf(sigmoidf_(g.acc[mi][ni][r])););
    }
}
DI void phase_gemm_proj(const Params& p, unsigned char* lds, const int bid, const int nb) {
    unsigned char* ws = p.ws;
    const bf16_t* SG = (const bf16_t*)(ws + OFF_SG); bf16_t* MG = (bf16_t*)(ws + OFF_MG);
    const int tn = 1024 / 128, nt = (M / 128) * tn;
    for (int it = bid; it < nt; it += nb) {
        const int m0 = (it / tn) * 128, n0 = (it % tn) * 128;
        GemmTile mg; gemm_zero(mg);
#pragma unroll 1
        for (int br = 0; br < 3; ++br) {
            GemmTile g; gemm_zero(g);
            const bf16_t* Y = (const bf16_t*)(ws + (br == 0 ? OFF_YA : br == 1 ? OFF_YB : OFF_YC));
            const bf16_t* W = (const bf16_t*)(ws + (br == 0 ? OFF_WPA : br == 1 ? OFF_WPB : OFF_WPC));
            gemm_tile_k(g, Y, 512, W, 512, m0, n0, 512, lds);
            GEMM_FOREACH(mg.acc[mi][ni][r] += bf2f(SG[(size_t)row * 3072 + br * 1024 + col]) * g.acc[mi][ni][r];);
        }
        GEMM_FOREACH(MG[(size_t)row * 1024 + col] = f2bf(mg.acc[mi][ni][r]););
    }
}
DI void phase_gemm_out(const Params& p, unsigned char* lds, const int bid, const int nb) {
    unsigned char* ws = p.ws;
    const bf16_t* MG = (const bf16_t*)(ws + OFF_MG); const bf16_t* W = (const bf16_t*)(ws + OFF_WO);
    const int tn = 1024 / 128, nt = (M / 128) * tn;
    for (int it = bid; it < nt; it += nb) {
        GemmTile g; gemm_zero(g);
        const int m0 = (it / tn) * 128, n0 = (it % tn) * 128;
        gemm_tile_k(g, MG, 1024, W, 1024, m0, n0, 1024, lds);
        GEMM_FOREACH(p.out[(size_t)row * 1024 + col] = p.x[(size_t)row * 1024 + col] + g.acc[mi][ni][r];);
    }
}

#define LASP(p_) ((__attribute__((address_space(3))) unsigned char*)(p_))
DI void phase_gemm_in_fast(const Params& p, unsigned char* lds, const int bid, const int nb) {
    unsigned char* ws = p.ws;
    {
        pg8::Gemm g{(const bf16_t*)(ws + OFF_H), (const bf16_t*)(ws + OFF_WIN), M, NP, 1024}; pg8::StaticOrder S; S.init(M, NP, nb, bid);
        pg8::EpiStore<0> E{(bf16_t*)(ws + OFF_P), NP};
        pg8::gemm_phase<pg8::EpiStore<0>, pg8::StaticOrder, true, true>(LASP(lds), g, S, E);
    }
    __syncthreads();
    const int tn2 = 1024 / 128, nt2 = (MM / 128) * tn2;
    for (int it = bid - nb / 2; it >= 0 && it < nt2; it += nb) {
        GemmTile g; gemm_zero(g);
        const int m0 = (it / tn2) * 128, n0 = (it % tn2) * 128;
        gemm_tile_k(g, (const bf16_t*)(ws + OFF_HM), 1024, (const bf16_t*)(ws + OFF_WKV), 1024, m0, n0, 1024, lds);
        bf16_t* KVM = (bf16_t*)(ws + OFF_KVM);
        GEMM_FOREACH(KVM[(size_t)row * 1024 + col] = f2bf(g.acc[mi][ni][r]););
    }
}
DI void phase_gemm_gate_fast(const Params& p, unsigned char* lds, const int bid, const int nb) {
    unsigned char* ws = p.ws;
    pg8::Gemm g{(const bf16_t*)(ws + OFF_H), (const bf16_t*)(ws + OFF_WIN) + (size_t)C_G * 1024, M, 3072, 1024}; pg8::StaticOrder S; S.init(M, 3072, nb, bid);
    pg8::EpiStore<1> E{(bf16_t*)(ws + OFF_SG), 3072};
    pg8::gemm_phase<pg8::EpiStore<1>, pg8::StaticOrder, true, true>(LASP(lds), g, S, E);
}
DI void phase_gemm_proj_fast(const Params& p, unsigned char* lds, const int bid, const int nb) {
    unsigned char* ws = p.ws;
    bf16_t* MG = (bf16_t*)(ws + OFF_MG); const bf16_t* SG = (const bf16_t*)(ws + OFF_SG);
    pg8::StaticOrder S; S.init(M, 1024, nb, bid);
    { pg8::Gemm g{(const bf16_t*)(ws + OFF_YA), (const bf16_t*)(ws + OFF_WPA), M, 1024, 512}; pg8::EpiProj<false> E{MG, SG, 0};
      pg8::gemm_phase<pg8::EpiProj<false>, pg8::StaticOrder, true, true>(LASP(lds), g, S, E); }
    { pg8::Gemm g{(const bf16_t*)(ws + OFF_YB), (const bf16_t*)(ws + OFF_WPB), M, 1024, 512}; pg8::EpiProj<true> E{MG, SG, 1024};
      pg8::gemm_phase<pg8::EpiProj<true>, pg8::StaticOrder, true, true>(LASP(lds), g, S, E); }
    { pg8::Gemm g{(const bf16_t*)(ws + OFF_YC), (const bf16_t*)(ws + OFF_WPC), M, 1024, 512}; pg8::EpiProj<true> E{MG, SG, 2048};
      pg8::gemm_phase<pg8::EpiProj<true>, pg8::StaticOrder, true, true>(LASP(lds), g, S, E); }
}
DI void phase_gemm_out_fast(const Params& p, unsigned char* lds, const int bid, const int nb) {
    unsigned char* ws = p.ws;
    pg8::Gemm g{(const bf16_t*)(ws + OFF_MG), (const bf16_t*)(ws + OFF_WO), M, 1024, 1024}; pg8::StaticOrder S; S.init(M, 1024, nb, bid);
    pg8::EpiOut E{p.x, p.out};
    pg8::gemm_phase<pg8::EpiOut, pg8::StaticOrder, true, true>(LASP(lds), g, S, E);
}

#define XB_TMO      128
#define XB_XCNT(j)  (256  + 64 * (j))
#define XB_XSUB(j)  (1280 + 64 * (j))
#define XB_XGEN(j)  (2304 + 64 * (j))
#define XB_TOP      3328
#define XB_TOPGEN   3392
#define XCD_BAR_WORDS 3456
#define XB_SPIN_CAP (1u << 22)
#define LAS __attribute__((address_space(3)))
DI unsigned xb_ld(unsigned* p)              { return __hip_atomic_load(p, __ATOMIC_RELAXED, __HIP_MEMORY_SCOPE_AGENT); }
DI unsigned xb_add(unsigned* p, unsigned v) { return __hip_atomic_fetch_add(p, v, __ATOMIC_RELAXED, __HIP_MEMORY_SCOPE_AGENT); }
DI unsigned xb_xcc_id() { return (unsigned)__builtin_amdgcn_s_getreg((3 << 11) | 20) & 0xFu; }
#define XB_SPIN(cond, bar) do { unsigned _sp = 0; while (cond) { __builtin_amdgcn_s_sleep(1); \
    if ((++_sp & 255u) == 0u) { if (xb_ld(&(bar)[XB_TMO])) break; if (_sp > XB_SPIN_CAP) { atomicAdd(&(bar)[XB_TMO], 1u); break; } } } } while (0)
struct XcdBarrier { unsigned* bar; unsigned x; volatile LAS unsigned* st; };
DI XcdBarrier xcd_barrier_post(unsigned* bar, volatile LAS unsigned* st) {
    XcdBarrier b; b.bar = bar; b.x = xb_xcc_id(); b.st = st;
    if (threadIdx.x == 0) (void)xb_add(&bar[XB_XCNT(b.x)], 1u);
    return b;
}
DI void xcd_barrier_complete(unsigned* bar, unsigned x, unsigned& nloc, unsigned& nx) {
    const unsigned G = gridDim.x * gridDim.y * gridDim.z;
    unsigned sum, cnt, mine, sp = 0u;
    for (;;) {
        sum = 0u; cnt = 0u; mine = 0u;
#pragma unroll
        for (unsigned j = 0; j < 16; ++j) { const unsigned c = xb_ld(&bar[XB_XCNT(j)]); sum += c; cnt += (c > 0u) ? 1u : 0u; mine = (j == x) ? c : mine; }
        if (sum == G) break;
        __builtin_amdgcn_s_sleep(1);
        if ((++sp & 255u) == 0u) { if (xb_ld(&bar[XB_TMO])) break; if (sp > XB_SPIN_CAP) { atomicAdd(&bar[XB_TMO], 1u); break; } }
    }
    nloc = mine > 0u ? mine : 1u; nx = cnt > 0u ? cnt : 1u;
}
DI void xcd_barrier(const XcdBarrier& b) {
    asm volatile("s_waitcnt vmcnt(0)" ::: "memory");
    __syncthreads();
    if (threadIdx.x == 0) {
        unsigned* bar = b.bar;
        __builtin_amdgcn_s_waitcnt(0);
        unsigned nloc = b.st[0], nx = b.st[1];
        if (nloc == 0u) { xcd_barrier_complete(bar, b.x, nloc, nx); b.st[0] = nloc; b.st[1] = nx; }
        const unsigned old = xb_add(&bar[XB_XSUB(b.x)], 1u);
        const unsigned gen = old / nloc;
        if (old + 1u == (gen + 1u) * nloc) {
            __builtin_amdgcn_fence(__ATOMIC_RELEASE, "agent");
            asm volatile("s_waitcnt vmcnt(0)" ::: "memory");
            const unsigned og = xb_add(&bar[XB_TOP], 1u);
            const unsigned tg = og / nx;
            if (og + 1u == (tg + 1u) * nx) xb_add(&bar[XB_TOPGEN], 1u);
            else XB_SPIN(xb_ld(&bar[XB_TOPGEN]) == tg, bar);
            __builtin_amdgcn_fence(__ATOMIC_ACQUIRE, "agent");
            xb_add(&bar[XB_XGEN(b.x)], 1u);
            asm volatile("s_waitcnt vmcnt(0)" ::: "memory");
        } else {
            XB_SPIN(xb_ld(&bar[XB_XGEN(b.x)]) == gen, bar);
            __builtin_amdgcn_fence(__ATOMIC_ACQUIRE, "agent");
            asm volatile("s_waitcnt vmcnt(0)" ::: "memory");
        }
    }
    __syncthreads();
}

constexpr int LDS_CTL_OFF = LDS_BYTES - 256;
__global__ void __launch_bounds__(NTHREADS, 2) k_mega(Params p) {
    extern __shared__ __attribute__((aligned(16))) unsigned char lds[];
    volatile LAS unsigned* st = (volatile LAS unsigned*)(lds + LDS_CTL_OFF);
    if (threadIdx.x == 0) { st[0] = 0u; st[1] = 0u; st[2] = 0u; st[3] = 0u; }
    __syncthreads();
    (void)xcd_barrier_post((unsigned*)(p.ws + OFF_CTL), st);
#define GRID_BAR() do { XcdBarrier b_; b_.bar = (unsigned*)(p.ws + OFF_CTL); b_.x = xb_xcc_id(); b_.st = (volatile LAS unsigned*)(lds + LDS_CTL_OFF); xcd_barrier(b_); } while (0)
    const int bid = blockIdx.x, nb = gridDim.x;
    phase_prologue(p, lds, bid, nb);
    GRID_BAR();
#ifndef FASTMASK
#define FASTMASK 15
#endif
    if (FASTMASK & 1) phase_gemm_in_fast(p, lds, bid, nb); else phase_gemm_in(p, lds, bid, nb);
    GRID_BAR();
    phase_attn_prep(p, lds, bid, nb);
    GRID_BAR();
    phase_rwkv_prep(p, lds, bid, nb);
    GRID_BAR();
    if (bid < 16) phase_rwkv_scan(p, lds, bid);
    else phase_attn(p, lds, bid - 16, nb - 16);
    GRID_BAR();
    phase_rwkv_out(p, lds, bid, nb);
    GRID_BAR();
    if (FASTMASK & 2) phase_gemm_gate_fast(p, lds, bid, nb); else phase_gemm_gate(p, lds, bid, nb);
    GRID_BAR();
    if (FASTMASK & 4) phase_gemm_proj_fast(p, lds, bid, nb); else phase_gemm_proj(p, lds, bid, nb);
    GRID_BAR();
    if (FASTMASK & 8) phase_gemm_out_fast(p, lds, bid, nb); else phase_gemm_out(p, lds, bid, nb);
}

extern "C" void kernel_launch(void* const* d_in, const int* in_sizes, int n_in, void* d_out, int out_size, void* d_ws, size_t ws_size, hipStream_t stream) {
    static int grid = 0;
    if (grid == 0) {
        if (n_in != 27 || ws_size < WS_END) { fprintf(stderr, "kernel_launch: unexpected inputs (n_in %d, ws %zu)\n", n_in, ws_size); grid = -1; return; }
        int dev = 0, cus = 0, per_cu = 0;
        if (hipGetDevice(&dev) != hipSuccess || hipDeviceGetAttribute(&cus, hipDeviceAttributeMultiprocessorCount, dev) != hipSuccess) { grid = -1; return; }
        if (hipFuncSetAttribute((const void*)k_mega, hipFuncAttributeMaxDynamicSharedMemorySize, LDS_BYTES) != hipSuccess) { fprintf(stderr, "kernel_launch: hipFuncSetAttribute failed\n"); grid = -1; return; }
        if (hipOccupancyMaxActiveBlocksPerMultiprocessor(&per_cu, (const void*)k_mega, NTHREADS, LDS_BYTES) != hipSuccess || per_cu < 1)
            fprintf(stderr, "kernel_launch: occupancy query reports %d workgroups per CU\n", per_cu);
        (void)hipGetLastError();
        grid = cus;
        if (grid < 32) { fprintf(stderr, "kernel_launch: too few CUs (%d)\n", grid); grid = -1; return; }
    }
    if (grid < 0) return;
    if (hipMemsetAsync((char*)d_ws + OFF_CTL, 0, 65536, stream) != hipSuccess) { fprintf(stderr, "kernel_launch: memset failed\n"); return; }
    Params p{};
    p.x = (const float*)d_in[0]; p.mem = (const float*)d_in[1]; p.pos = (const int*)d_in[2]; p.norm_g = (const float*)d_in[3]; p.mem_norm_g = (const float*)d_in[4];
    p.w_in = (const float*)d_in[5]; p.mu_rkv = (const float*)d_in[6]; p.mu_wa = (const float*)d_in[7]; p.w0 = (const float*)d_in[8]; p.w2 = (const float*)d_in[9];
    p.a0 = (const float*)d_in[10]; p.a2 = (const float*)d_in[11]; p.k_k = (const float*)d_in[12]; p.k_a = (const float*)d_in[13]; p.r_k = (const float*)d_in[14];
    p.lnx_g = (const float*)d_in[15]; p.lnx_b = (const float*)d_in[16]; p.q_norm_g = (const float*)d_in[17]; p.k_norm_g = (const float*)d_in[18]; p.sinks = (const float*)d_in[19];
    p.xq_norm_g = (const float*)d_in[20]; p.xk_norm_g = (const float*)d_in[21]; p.w_mem_kv = (const float*)d_in[22]; p.w_proj_a = (const float*)d_in[23];
    p.w_proj_b = (const float*)d_in[24]; p.w_proj_c = (const float*)d_in[25]; p.w_out = (const float*)d_in[26];
    p.out = (float*)d_out; p.ws = (unsigned char*)d_ws;
    hipLaunchKernelGGL(k_mega, dim3(grid), dim3(NTHREADS), LDS_BYTES, stream, p);
}
```

```cpp
#include <hip/hip_runtime.h>
#include <stdint.h>
#include <stdio.h>

#define DI __device__ __forceinline__
typedef unsigned short bf16_t;
typedef short bf16x8 __attribute__((ext_vector_type(8)));
typedef float f32x4 __attribute__((ext_vector_type(4)));

constexpr int BATCH = 2, T = 8192, M = BATCH * T, D = 1024, NIN = 7552, NP = 4608  ;
constexpr int MEMLEN = 256, MM = BATCH * MEMLEN;
constexpr int C_R = 0, C_K = 512, C_V = 1024, C_W = 1536, C_A = 1600, C_ZA = 1664, C_Q = 2176, C_SK = 2688, C_SV = 2816, C_ZB = 2944, C_XQ = 3456, C_ZC = 3968, C_G = 4480;
constexpr int NTHREADS = 512, NWAVES = 8;
constexpr int LDS_BYTES = 147456;

constexpr size_t OFF_CTL = 0;
constexpr size_t OFF_WIN = 65536;
constexpr size_t OFF_WKV = OFF_WIN + (size_t)7680 * 1024 * 2;
constexpr size_t OFF_WPA = OFF_WKV + (size_t)1024 * 1024 * 2;
constexpr size_t OFF_WPB = OFF_WPA + (size_t)1024 * 512 * 2;
constexpr size_t OFF_WPC = OFF_WPB + (size_t)1024 * 512 * 2;
constexpr size_t OFF_WO  = OFF_WPC + (size_t)1024 * 512 * 2;
constexpr size_t OFF_H   = OFF_WO + (size_t)1024 * 1024 * 2;
constexpr size_t OFF_HM  = OFF_H + (size_t)M * 1024 * 2;
constexpr size_t OFF_KVM = OFF_HM + (size_t)MM * 1024 * 2;
constexpr size_t OFF_ROPE = OFF_KVM + (size_t)MM * 1024 * 2;
constexpr size_t OFF_P   = OFF_ROPE + (size_t)M * 32 * 8;
constexpr size_t OFF_YA  = OFF_P + (size_t)M * NP * 2;
constexpr size_t OFF_YB  = OFF_YA + (size_t)M * 512 * 2;
constexpr size_t OFF_YC  = OFF_YB + (size_t)M * 512 * 2;
constexpr size_t WS_END  = OFF_YC + (size_t)M * 512 * 2;
constexpr size_t OFF_SG  = OFF_P;
constexpr size_t OFF_MG  = OFF_P + (size_t)M * 3072 * 2;
static_assert(WS_END <= (size_t)256 * 1024 * 1024, "workspace");
static_assert(OFF_MG + (size_t)M * 1024 * 2 <= OFF_YA, "overlay");

struct Params {
    const float* x; const float* mem; const int* pos; const float* norm_g; const float* mem_norm_g; const float* w_in;
    const float* mu_rkv; const float* mu_wa; const float* w0; const float* w2; const float* a0; const float* a2;
    const float* k_k; const float* k_a; const float* r_k; const float* lnx_g; const float* lnx_b;
    const float* q_norm_g; const float* k_norm_g; const float* sinks; const float* xq_norm_g; const float* xk_norm_g;
    const float* w_mem_kv; const float* w_proj_a; const float* w_proj_b; const float* w_proj_c; const float* w_out;
    float* out; unsigned char* ws;
};

DI bf16_t f2bf(float x) { return __builtin_bit_cast(unsigned short, (__bf16)x); }
DI float bf2f(bf16_t h) { return __uint_as_float(((unsigned)h) << 16); }
DI float wave_sum(float v) {
#pragma unroll
    for (int o = 32; o > 0; o >>= 1) v += __shfl_xor(v, o, 64);
    return v;
}
DI float wave_max(float v) {
#pragma unroll
    for (int o = 32; o > 0; o >>= 1) v = fmaxf(v, __shfl_xor(v, o, 64));
    return v;
}
DI float sigmoidf_(float x) { return 1.f / (1.f + __expf(-x)); }
DI float siluf_(float x) { return x / (1.f + __expf(-x)); }

DI void transpose_convert(const float* W, int K, int N, bf16_t* Wt, int item, float* tile  ) {
    const int tn = N / 64, kt = item / tn, nt = item % tn, tid = threadIdx.x;
    __syncthreads();
    for (int e = tid; e < 4096; e += NTHREADS) { const int r = e >> 6, c = e & 63; tile[r * 65 + c] = W[(size_t)(kt * 64 + r) * N + nt * 64 + c]; }
    __syncthreads();
    for (int e = tid; e < 4096; e += NTHREADS) { const int n = e >> 6, k = e & 63; Wt[(size_t)(nt * 64 + n) * K + kt * 64 + k] = f2bf(tile[k * 65 + n]); }
}

DI void phase_prologue(const Params& p, unsigned char* lds, const int bid, const int nb) {
    float* tile = (float*)lds;
    unsigned char* ws = p.ws;
    const int n_in = (1024 / 64) * (NIN / 64), n_kv = 16 * 16, n_pr = (512 / 64) * 16, n_o = 16 * 16;
    const int total = n_in + n_kv + 3 * n_pr + n_o;
    for (int it = bid; it < total; it += nb) {
        int i = it;
        if (i < n_in) { transpose_convert(p.w_in, 1024, NIN, (bf16_t*)(ws + OFF_WIN), i, tile); continue; } i -= n_in;
        if (i < n_kv) { transpose_convert(p.w_mem_kv, 1024, 1024, (bf16_t*)(ws + OFF_WKV), i, tile); continue; } i -= n_kv;
        if (i < n_pr) { transpose_convert(p.w_proj_a, 512, 1024, (bf16_t*)(ws + OFF_WPA), i, tile); continue; } i -= n_pr;
        if (i < n_pr) { transpose_convert(p.w_proj_b, 512, 1024, (bf16_t*)(ws + OFF_WPB), i, tile); continue; } i -= n_pr;
        if (i < n_pr) { transpose_convert(p.w_proj_c, 512, 1024, (bf16_t*)(ws + OFF_WPC), i, tile); continue; } i -= n_pr;
        transpose_convert(p.w_out, 1024, 1024, (bf16_t*)(ws + OFF_WO), i, tile);
    }
    {
        unsigned* z = (unsigned*)(ws + OFF_WIN + (size_t)NIN * 1024 * 2);
        const int nz = (7680 - NIN) * 1024 / 2;
        for (int i = bid * NTHREADS + threadIdx.x; i < nz; i += nb * NTHREADS) z[i] = 0u;
    }
    const int lane = threadIdx.x & 63, wid = threadIdx.x >> 6;
    for (int row = bid * NWAVES + wid; row < M + MM; row += nb * NWAVES) {
        const float* src = row < M ? p.x + (size_t)row * D : p.mem + (size_t)(row - M) * D;
        const float* g = row < M ? p.norm_g : p.mem_norm_g;
        bf16_t* dst = row < M ? (bf16_t*)(ws + OFF_H) + (size_t)row * D : (bf16_t*)(ws + OFF_HM) + (size_t)(row - M) * D;
        f32x4 v[4]; float ss = 0.f;
#pragma unroll
        for (int i = 0; i < 4; ++i) { v[i] = *(const f32x4*)(src + i * 256 + lane * 4); ss += v[i][0] * v[i][0] + v[i][1] * v[i][1] + v[i][2] * v[i][2] + v[i][3] * v[i][3]; }
        ss = wave_sum(ss);
        const float rs = rsqrtf(ss * (1.f / 1024.f) + 1e-6f);
#pragma unroll
        for (int i = 0; i < 4; ++i) {
            const f32x4 gg = *(const f32x4*)(g + i * 256 + lane * 4);
            ushort4 o; o.x = f2bf(v[i][0] * rs * gg[0]); o.y = f2bf(v[i][1] * rs * gg[1]); o.z = f2bf(v[i][2] * rs * gg[2]); o.w = f2bf(v[i][3] * rs * gg[3]);
            *(ushort4*)(dst + i * 256 + lane * 4) = o;
        }
    }
    float2* rope = (float2*)(ws + OFF_ROPE);
    for (int i = bid * NTHREADS + threadIdx.x; i < M * 32; i += nb * NTHREADS) {
        const int row = i >> 5, f = i & 31;
        const double inv = pow(10000.0, -(double)f / 32.0);
        const double ang = (double)p.pos[row] * inv;
        double s, c; sincos(ang, &s, &c);
        rope[i] = make_float2((float)c, (float)s);
    }
}

struct GemmTile { f32x4 acc[2][4]; };
DI void gemm_tile_k(GemmTile& g, const bf16_t* A, int lda, const bf16_t* Bt, int ldb, int m0, int n0, int K, unsigned char* lds) {
    bf16_t* sA = (bf16_t*)lds;
    bf16_t* sB = sA + 128 * 40;
    const int tid = threadIdx.x, lane = tid & 63, wid = tid >> 6, wm = wid & 3, wn = wid >> 2;
    const int srow = tid >> 2, sch = tid & 3;
    const bf16_t* ga = A + (size_t)(m0 + srow) * lda + sch * 8;
    const bf16_t* gb = Bt + (size_t)(n0 + srow) * ldb + sch * 8;
    const int fr = lane & 15, fq = lane >> 4;
    uint4 ra = *(const uint4*)ga, rb = *(const uint4*)gb;
    for (int k0 = 0; k0 < K; k0 += 32) {
        __syncthreads();
        *(uint4*)(sA + srow * 40 + sch * 8) = ra;
        *(uint4*)(sB + srow * 40 + sch * 8) = rb;
        __syncthreads();
        if (k0 + 32 < K) { ra = *(const uint4*)(ga + k0 + 32); rb = *(const uint4*)(gb + k0 + 32); }
        bf16x8 af[2], bfr[4];
#pragma unroll
        for (int mi = 0; mi < 2; ++mi) af[mi] = *(const bf16x8*)(sA + (wm * 32 + mi * 16 + fr) * 40 + fq * 8);
#pragma unroll
        for (int ni = 0; ni < 4; ++ni) bfr[ni] = *(const bf16x8*)(sB + (wn * 64 + ni * 16 + fr) * 40 + fq * 8);
#pragma unroll
        for (int mi = 0; mi < 2; ++mi)
#pragma unroll
            for (int ni = 0; ni < 4; ++ni) g.acc[mi][ni] = __builtin_amdgcn_mfma_f32_16x16x32_bf16(af[mi], bfr[ni], g.acc[mi][ni], 0, 0, 0);
    }
}
DI void gemm_zero(GemmTile& g) {
#pragma unroll
    for (int mi = 0; mi < 2; ++mi)
#pragma unroll
        for (int ni = 0; ni < 4; ++ni) g.acc[mi][ni] = (f32x4){0.f, 0.f, 0.f, 0.f};
}
#define GEMM_FOREACH(body) do { const int lane_ = threadIdx.x & 63, wid_ = threadIdx.x >> 6, wm_ = wid_ & 3, wn_ = wid_ >> 2, fr_ = lane_ & 15, fq_ = lane_ >> 4; \
    _Pragma("unroll") for (int mi = 0; mi < 2; ++mi) _Pragma("unroll") for (int ni = 0; ni < 4; ++ni) _Pragma("unroll") for (int r = 0; r < 4; ++r) { \
        const int row = m0 + wm_ * 32 + mi * 16 + fq_ * 4 + r, col = n0 + wn_ * 64 + ni * 16 + fr_; body } } while (0)

DI void phase_gemm_in(const Params& p, unsigned char* lds, const int bid, const int nb) {
    unsigned char* ws = p.ws;
    const bf16_t* H = (const bf16_t*)(ws + OFF_H); const bf16_t* Wt = (const bf16_t*)(ws + OFF_WIN);
    bf16_t* P = (bf16_t*)(ws + OFF_P);
    const int tn = NP / 128, nt1 = (M / 128) * tn;
    const int tn2 = 1024 / 128, nt2 = (MM / 128) * tn2;
    for (int it = bid; it < nt1 + nt2; it += nb) {
        GemmTile g; gemm_zero(g);
        if (it < nt1) {
            const int m0 = (it / tn) * 128, n0 = (it % tn) * 128;
            gemm_tile_k(g, H, 1024, Wt, 1024, m0, n0, 1024, lds);
            GEMM_FOREACH(P[(size_t)row * NP + col] = f2bf(g.acc[mi][ni][r]););
        } else {
            const int i2 = it - nt1; const int m0 = (i2 / tn2) * 128, n0 = (i2 % tn2) * 128;
            gemm_tile_k(g, (const bf16_t*)(ws + OFF_HM), 1024, (const bf16_t*)(ws + OFF_WKV), 1024, m0, n0, 1024, lds);
            bf16_t* KVM = (bf16_t*)(ws + OFF_KVM);
            GEMM_FOREACH(KVM[(size_t)row * 1024 + col] = f2bf(g.acc[mi][ni][r]););
        }
    }
}

DI void phase_attn_prep(const Params& p, unsigned char* lds, const int bid, const int nb) {
    unsigned char* ws = p.ws; bf16_t* P = (bf16_t*)(ws + OFF_P); bf16_t* KVM = (bf16_t*)(ws + OFF_KVM);
    const float2* rope = (const float2*)(ws + OFF_ROPE);
    const int lane = threadIdx.x & 63, wid = threadIdx.x >> 6;
    const long n1 = (long)M * 14, n2 = (long)MM * 4;
    for (long it = (long)bid * NWAVES + wid; it < n1 + n2; it += (long)nb * NWAVES) {
        if (it < n1) {
            const int row = (int)(it / 14), j = (int)(it % 14);
            if (j < 10) {
                bf16_t* ptr = P + (size_t)row * NP + (j < 8 ? C_Q + j * 64 : C_SK + (j - 8) * 64);
                const float g = j < 8 ? p.q_norm_g[lane] : p.k_norm_g[lane];
                const float xv = bf2f(ptr[lane]);
                const float ss = wave_sum(xv * xv);
                const float y = xv * rsqrtf(ss * (1.f / 64.f) + 1e-6f) * g;
                const float yp = __shfl_xor(y, 32, 64);
                const float2 cs = rope[(size_t)row * 32 + (lane & 31)];
                const float o = lane < 32 ? y * cs.x - yp * cs.y : y * cs.x + yp * cs.y;
                ptr[lane] = f2bf(o);
            } else {
                bf16_t* ptr = P + (size_t)row * NP + C_XQ + (j - 10) * 128;
                const float x0 = bf2f(ptr[lane]), x1 = bf2f(ptr[lane + 64]);
                const float ss = wave_sum(x0 * x0 + x1 * x1);
                const float rs = rsqrtf(ss * (1.f / 128.f) + 1e-6f);
                ptr[lane] = f2bf(x0 * rs * p.xq_norm_g[lane]); ptr[lane + 64] = f2bf(x1 * rs * p.xq_norm_g[lane + 64]);
            }
        } else {
            const long i2 = it - n1; const int row = (int)(i2 / 4), j = (int)(i2 % 4);
            bf16_t* ptr = KVM + (size_t)row * 1024 + j * 128;
            const float x0 = bf2f(ptr[lane]), x1 = bf2f(ptr[lane + 64]);
            const float ss = wave_sum(x0 * x0 + x1 * x1);
            const float rs = rsqrtf(ss * (1.f / 128.f) + 1e-6f);
            ptr[lane] = f2bf(x0 * rs * p.xk_norm_g[lane]); ptr[lane + 64] = f2bf(x1 * rs * p.xk_norm_g[lane + 64]);
        }
    }
}

DI void rwkv_stage(const Params& p, int b, int h, int t0, int ntok, float* ck, float* scratch  ) {
    const bf16_t* P = (const bf16_t*)(p.ws + OFF_P);
    const int lane = threadIdx.x & 63, wid = threadIdx.x >> 6, ch = h * 64 + lane;
    const float mu_r = p.mu_rkv[ch], mu_k = p.mu_rkv[512 + ch], mu_v = p.mu_rkv[1024 + ch], mu_w = p.mu_wa[lane], mu_a = p.mu_wa[64 + lane];
    const float w0c = p.w0[ch], a0c = p.a0[ch], kkc = p.k_k[ch], kac = p.k_a[ch];
    float* sc = scratch + wid * 128;
    for (int i = wid; i < ntok; i += NWAVES) {
        const int t = t0 + i; const bf16_t* pr = P + (size_t)(b * T + t) * NP; const bf16_t* pp = pr - NP; const bool hp = t > 0;
        const float rc = bf2f(pr[C_R + ch]), rp = hp ? bf2f(pp[C_R + ch]) : 0.f;
        const float kc = bf2f(pr[C_K + ch]), kp = hp ? bf2f(pp[C_K + ch]) : 0.f;
        const float vc = bf2f(pr[C_V + ch]), vp = hp ? bf2f(pp[C_V + ch]) : 0.f;
        const float wc = bf2f(pr[C_W + lane]), wp = hp ? bf2f(pp[C_W + lane]) : 0.f;
        const float ac = bf2f(pr[C_A + lane]), ap = hp ? bf2f(pp[C_A + lane]) : 0.f;
        const float r = rc + (rp - rc) * mu_r, k = kc + (kp - kc) * mu_k, v = vc + (vp - vc) * mu_v;
        const float lw = wc + (wp - wc) * mu_w, la = ac + (ap - ac) * mu_a;
        sc[lane] = tanhf(lw); sc[64 + lane] = la;
        float accw = 0.f, acca = 0.f;
#pragma unroll 8
        for (int j = 0; j < 64; ++j) { accw += sc[j] * p.w2[j * 512 + ch]; acca += sc[64 + j] * p.a2[j * 512 + ch]; }
        const float xw = -(w0c + accw);
        const float sp = xw > 20.f ? xw : log1pf(expf(xw));
        const float wlog = -sp - 0.5f;
        const float decay = expf(-expf(wlog));
        const float alpha = 1.f / (1.f + expf(-(a0c + acca)));
        const float kk0 = k * kkc;
        const float n2 = wave_sum(kk0 * kk0);
        const float kk = kk0 / fmaxf(sqrtf(n2), 1e-12f);
        const float k2 = k * (1.f + (alpha - 1.f) * kac);
        float* o = ck + i * 384;
        o[lane] = r; o[64 + lane] = decay; o[128 + lane] = k2; o[192 + lane] = v; o[256 + lane] = -kk; o[320 + lane] = kk * alpha;
    }
}

DI void phase_rwkv_direct(const Params& p, unsigned char* lds, const int bid, const int nb) {
    float* ck = (float*)lds; float* scratch = ck + 64 * 384;
    const int lane = threadIdx.x & 63, wid = threadIdx.x >> 6;
    const bf16_t* P = (const bf16_t*)(p.ws + OFF_P); bf16_t* YA = (bf16_t*)(p.ws + OFF_YA);
    for (int bh = bid; bh < BATCH * 8; bh += nb) {
        const int b = bh >> 3, h = bh & 7, ch = h * 64 + lane;
        float S[64];
#pragma unroll
        for (int k = 0; k < 64; ++k) S[k] = 0.f;
        const float rk = p.r_k[ch], lg = p.lnx_g[ch], lb = p.lnx_b[ch];
        for (int c = 0; c < T / 64; ++c) {
            __syncthreads();
            rwkv_stage(p, b, h, c * 64, 64, ck, scratch);
            __syncthreads();
            if (wid == 0) {
                for (int i = 0; i < 64; ++i) {
                    const float* cc = ck + i * 384;
                    float sa = 0.f;
#pragma unroll
                    for (int k = 0; k < 64; ++k) sa += S[k] * cc[256 + k];
                    const float vv = cc[192 + lane];
#pragma unroll
                    for (int k = 0; k < 64; ++k) S[k] = S[k] * cc[64 + k] + sa * cc[320 + k] + vv * cc[128 + k];
                    float y = 0.f;
#pragma unroll
                    for (int k = 0; k < 64; ++k) y += S[k] * cc[k];
                    const float mean = wave_sum(y) * (1.f / 64.f);
                    const float dy = y - mean;
                    const float var = wave_sum(dy * dy) * (1.f / 64.f);
                    const float yn = dy * rsqrtf(var + 64e-5f) * lg + lb;
                    const float bonus = wave_sum(cc[lane] * cc[128 + lane] * rk) * vv;
                    const int t = c * 64 + i; const size_t row = (size_t)(b * T + t);
                    const float z = bf2f(P[row * NP + C_ZA + ch]);
                    YA[row * 512 + ch] = f2bf((yn + bonus) * siluf_(z));
                }
            }
        }
    }
}

constexpr size_t AF_BYTES = 16384, NF_BYTES = 16384, NCHUNK = 128;
constexpr size_t OFF_AF = 0, OFF_NF = (size_t)16 * NCHUNK * AF_BYTES;
typedef float f32x16 __attribute__((ext_vector_type(16)));
typedef float f32x2 __attribute__((ext_vector_type(2)));

DI float quad_sum(float s) {
    s += __int_as_float(__builtin_amdgcn_update_dpp(0, __float_as_int(s), 0xB1, 0xF, 0xF, true));
    s += __int_as_float(__builtin_amdgcn_update_dpp(0, __float_as_int(s), 0x4E, 0xF, 0xF, true));
    return s;
}

DI float rwkv_stage_tok(const Params& p, const bf16_t* P, int b, int h, int t, float* o, float* sc, float mu_r, float mu_k, float mu_v, float mu_w, float mu_a,
                        float w0c, float a0c, float kkc, float kac, float rkc) {
    const int lane = threadIdx.x & 63, ch = h * 64 + lane;
    const bf16_t* pr = P + (size_t)(b * T + t) * NP; const bf16_t* pp = pr - NP; const bool hp = t > 0;
    const float rc = bf2f(pr[C_R + ch]), rp = hp ? bf2f(pp[C_R + ch]) : 0.f;
    const float kc = bf2f(pr[C_K + ch]), kp = hp ? bf2f(pp[C_K + ch]) : 0.f;
    const float vc = bf2f(pr[C_V + ch]), vp = hp ? bf2f(pp[C_V + ch]) : 0.f;
    const float wc = bf2f(pr[C_W + lane]), wp = hp ? bf2f(pp[C_W + lane]) : 0.f;
    const float ac = bf2f(pr[C_A + lane]), ap = hp ? bf2f(pp[C_A + lane]) : 0.f;
    const float r = rc + (rp - rc) * mu_r, k = kc + (kp - kc) * mu_k, v = vc + (vp - vc) * mu_v;
    const float lw = wc + (wp - wc) * mu_w, la = ac + (ap - ac) * mu_a;
    sc[lane] = tanhf(lw); sc[64 + lane] = la;
    float accw = 0.f, acca = 0.f;
    const float* w2p = p.w2; const float* a2p = p.a2;
    asm volatile("" : "+s"(w2p), "+s"(a2p));
#pragma unroll 8
    for (int j = 0; j < 64; ++j) { accw += sc[j] * w2p[j * 512 + ch]; acca += sc[64 + j] * a2p[j * 512 + ch]; }
    const float xw = -(w0c + accw);
    const float sp = xw > 20.f ? xw : log1pf(expf(xw));
    const float decay = expf(-expf(-sp - 0.5f));
    const float alpha = 1.f / (1.f + expf(-(a0c + acca)));
    const float kk0 = k * kkc;
    const float n2 = wave_sum(kk0 * kk0);
    const float kk = kk0 / fmaxf(sqrtf(n2), 1e-12f);
    const float k2 = k * (1.f + (alpha - 1.f) * kac);
    o[lane] = r; o[64 + lane] = decay; o[128 + lane] = k2; o[192 + lane] = v; o[256 + lane] = -kk; o[320 + lane] = kk * alpha;
    return wave_sum(r * k2 * rkc);
}

typedef float f32x4_t __attribute__((ext_vector_type(4)));
DI float row16_sum(float x) {
    x += __int_as_float(__builtin_amdgcn_update_dpp(0, __float_as_int(x), 0x128, 0xF, 0xF, true));
    x += __int_as_float(__builtin_amdgcn_update_dpp(0, __float_as_int(x), 0x124, 0xF, 0xF, true));
    x += __int_as_float(__builtin_amdgcn_update_dpp(0, __float_as_int(x), 0x122, 0xF, 0xF, true));
    x += __int_as_float(__builtin_amdgcn_update_dpp(0, __float_as_int(x), 0x121, 0xF, 0xF, true));
    return x;
}
DI void build_lora_frags(const Params& p, int h, unsigned char* bfrag) {
    for (int fidx = threadIdx.x; fidx < 1024; fidx += NTHREADS) {
        const int mat = fidx >> 9, nt = (fidx >> 7) & 3, ks = (fidx >> 6) & 1, l = fidx & 63, n = l & 15, kg = l >> 4;
        const float* W = (mat ? p.a2 : p.w2) + (size_t)(32 * ks + 8 * kg) * 512 + h * 64 + 16 * nt + n;
        unsigned w[4];
#pragma unroll
        for (int e2 = 0; e2 < 4; ++e2) w[e2] = (unsigned)f2bf(W[(2 * e2) * 512]) | ((unsigned)f2bf(W[(2 * e2 + 1) * 512]) << 16);
        *(uint4*)(bfrag + fidx * 16) = make_uint4(w[0], w[1], w[2], w[3]);
    }
}
template <int PART, int RS, bool R3>
DI void stage16(const Params& p, const bf16_t* P, int b, int h, int tg0, int tg1, int tg2, int tg3, float* recs, const unsigned char* bfrag) {
    asm volatile("" : "+s"(h));
    const int lane = threadIdx.x & 63, n = lane & 15, rg = lane >> 4;
    constexpr int FIELD = PART == 0 ? 0 : 128;
    {
        const float mu = PART == 0 ? p.mu_wa[lane] : p.mu_wa[64 + lane];
        const int colx = (PART == 0 ? C_W : C_A) + lane;
#pragma unroll
        for (int gi = 0; gi < 4; ++gi) {
            const int t0 = gi == 0 ? tg0 : gi == 1 ? tg1 : gi == 2 ? tg2 : tg3;
            const bf16_t* base = P + (size_t)(b * T + t0) * NP + colx;
            float prev = t0 > 0 ? bf2f(base[-NP]) : 0.f;
#pragma unroll
            for (int rr = 0; rr < 4; ++rr) {
                const float cur = bf2f(base[rr * NP]);
                const float x = cur + (prev - cur) * mu; prev = cur;
                float val = x;
                if (PART == 0) { const float e2 = __expf(2.f * x); val = 1.f - 2.f * __builtin_amdgcn_rcpf(1.f + e2); }
                *(bf16_t*)((unsigned char*)(recs + (gi * 4 + rr) * RS + FIELD) + 2 * lane) = f2bf(val);
            }
        }
    }
    f32x4 acc[4];
#pragma unroll
    for (int nt = 0; nt < 4; ++nt) acc[nt] = (f32x4){0.f, 0.f, 0.f, 0.f};
#pragma unroll
    for (int ks = 0; ks < 2; ++ks) {
        const bf16x8 af = *(const bf16x8*)((const unsigned char*)(recs + n * RS + FIELD) + ks * 64 + rg * 16);
#pragma unroll
        for (int nt = 0; nt < 4; ++nt) {
            const bf16x8 bfr = *(const bf16x8*)(bfrag + (((PART * 4 + nt) * 2 + ks) * 64 + lane) * 16);
            acc[nt] = __builtin_amdgcn_mfma_f32_16x16x32_bf16(af, bfr, acc[nt], 0, 0, 0);
        }
    }
    const int tgl = rg == 0 ? tg0 : rg == 1 ? tg1 : rg == 2 ? tg2 : tg3;
    const bf16_t* rowb = P + (size_t)(b * T + tgl) * NP;
    float* rec0 = recs + (4 * rg) * RS;
    const bool hp = tgl > 0;
    if (PART == 0) {
#pragma unroll
        for (int nt = 0; nt < 4; ++nt) {
            const int cl = 16 * nt + n, ch = h * 64 + cl;
            const float mu_r = p.mu_rkv[ch], mu_v = p.mu_rkv[1024 + ch], w0c = p.w0[ch];
            float rp = hp ? bf2f(rowb[-NP + C_R + ch]) : 0.f, vp = hp ? bf2f(rowb[-NP + C_V + ch]) : 0.f;
#pragma unroll
            for (int rr = 0; rr < 4; ++rr) {
                const float rc = bf2f(rowb[rr * NP + C_R + ch]), vc = bf2f(rowb[rr * NP + C_V + ch]);
                const float r = rc + (rp - rc) * mu_r, v = vc + (vp - vc) * mu_v; rp = rc; vp = vc;
                const float xw = -(w0c + acc[nt][rr]);
                const float sp = xw > 20.f ? xw : __logf(1.f + __expf(xw));
                const float decay = __expf(-__expf(-sp - 0.5f));
                float* o = rec0 + rr * RS;
                o[cl] = r; o[64 + cl] = decay; o[192 + cl] = v;
                if (R3) o[384 + cl] = bf2f(rowb[rr * NP + C_ZA + ch]);
            }
        }
    } else {
        float kv[4][4], kk0[4][4], al[4][4], rv[4][4], n2[4] = {0.f, 0.f, 0.f, 0.f};
#pragma unroll
        for (int nt = 0; nt < 4; ++nt) {
            const int ch = h * 64 + 16 * nt + n;
            const float mu_k = p.mu_rkv[512 + ch], mu_r = p.mu_rkv[ch], a0c = p.a0[ch], kkc = p.k_k[ch];
            float kp = hp ? bf2f(rowb[-NP + C_K + ch]) : 0.f, rp = (R3 && hp) ? bf2f(rowb[-NP + C_R + ch]) : 0.f;
#pragma unroll
            for (int rr = 0; rr < 4; ++rr) {
                const float kc = bf2f(rowb[rr * NP + C_K + ch]);
                const float k = kc + (kp - kc) * mu_k; kp = kc;
                if (R3) { const float rc = bf2f(rowb[rr * NP + C_R + ch]); rv[nt][rr] = rc + (rp - rc) * mu_r; rp = rc; }
                kv[nt][rr] = k; kk0[nt][rr] = k * kkc; n2[rr] += kk0[nt][rr] * kk0[nt][rr];
                al[nt][rr] = __builtin_amdgcn_rcpf(1.f + __expf(-(a0c + acc[nt][rr])));
            }
        }
        float inv[4], bon[4] = {0.f, 0.f, 0.f, 0.f};
#pragma unroll
        for (int rr = 0; rr < 4; ++rr) inv[rr] = 1.f / fmaxf(sqrtf(row16_sum(n2[rr])), 1e-12f);
#pragma unroll
        for (int nt = 0; nt < 4; ++nt) {
            const int cl = 16 * nt + n, ch = h * 64 + cl;
            const float kac = p.k_a[ch], rkc = p.r_k[ch];
#pragma unroll
            for (int rr = 0; rr < 4; ++rr) {
                const float kk = kk0[nt][rr] * inv[rr], k2 = kv[nt][rr] * (1.f + (al[nt][rr] - 1.f) * kac);
                float* o = rec0 + rr * RS;
                o[128 + cl] = k2; o[256 + cl] = -kk; o[320 + cl] = kk * al[nt][rr];
                if (R3) bon[rr] += rv[nt][rr] * k2 * rkc;
            }
        }
        if (R3) {
#pragma unroll
            for (int rr = 0; rr < 4; ++rr) { const float bs = row16_sum(bon[rr]); if (n == 0) rec0[rr * RS + 448] = bs; }
        }
    }
}

template <int MODE> DI void rwkv_step(float (&z)[4][16], const float* cc, int q, int g, float (&sa)[4]) {
    f32x4 av[4], wv[4], bv[4], kv[4];
#pragma unroll
    for (int u = 0; u < 4; ++u) { av[u] = *(const f32x4*)(cc + 256 + 16 * q + 4 * u); wv[u] = *(const f32x4*)(cc + 64 + 16 * q + 4 * u); bv[u] = *(const f32x4*)(cc + 320 + 16 * q + 4 * u);
        if (MODE == 1) kv[u] = *(const f32x4*)(cc + 128 + 16 * q + 4 * u); }
    f32x4 vr = (f32x4){0.f, 0.f, 0.f, 0.f};
    if (MODE == 1) vr = *(const f32x4*)(cc + 192 + 4 * g);
#pragma unroll
    for (int rr = 0; rr < 4; ++rr) {
        float s0 = 0.f, s1 = 0.f;
#pragma unroll
        for (int u = 0; u < 4; ++u) { s0 += z[rr][4 * u] * av[u][0] + z[rr][4 * u + 2] * av[u][2]; s1 += z[rr][4 * u + 1] * av[u][1] + z[rr][4 * u + 3] * av[u][3]; }
        sa[rr] = quad_sum(s0 + s1);
    }
#pragma unroll
    for (int rr = 0; rr < 4; ++rr)
#pragma unroll
        for (int u = 0; u < 4; ++u)
#pragma unroll
            for (int e = 0; e < 4; ++e) {
                float t = sa[rr] * bv[u][e];
                if (MODE == 1) t += vr[rr] * kv[u][e];
                z[rr][4 * u + e] = z[rr][4 * u + e] * wv[u][e] + t;
            }
}

DI void phase_rwkv_prep(const Params& p, unsigned char* lds, const int bid, const int nb) {
    float* ck = (float*)lds; unsigned char* bfrag = lds + 64 * 384 * 4; float* mat = (float*)lds;
    const bf16_t* P = (const bf16_t*)(p.ws + OFF_P);
    unsigned char* fr = (unsigned char*)p.out;
    const int tid = threadIdx.x, lane = tid & 63, wid = tid >> 6, q = lane & 3, g = lane >> 2, cl = wid >> 1, role = wid & 1;
    for (int item = bid; item < 512; item += nb) {
        const int bh = item >> 5, cq = item & 31, b = bh >> 3, h = bh & 7;
        __syncthreads();
        build_lora_frags(p, h, bfrag);
        float z[4][16];
#pragma unroll
        for (int rr = 0; rr < 4; ++rr)
#pragma unroll
            for (int c = 0; c < 16; ++c) z[rr][c] = (role == 0 && (4 * g + rr) == (16 * q + c)) ? 1.f : 0.f;
        for (int sl = 0; sl < 4; ++sl) {
            __syncthreads();
            {
                const int tb = (cq * 4 + cl) * 64 + sl * 16;
                if (role == 0) stage16<0, 384, false>(p, P, b, h, tb, tb + 4, tb + 8, tb + 12, ck + cl * 16 * 384, bfrag);
                else           stage16<1, 384, false>(p, P, b, h, tb, tb + 4, tb + 8, tb + 12, ck + cl * 16 * 384, bfrag);
            }
            __syncthreads();
            float sa[4];
            if (role == 0) {
#pragma unroll 1
                for (int i = 0; i < 16; ++i) rwkv_step<0>(z, ck + (cl * 16 + i) * 384, q, g, sa); }
            else {
#pragma unroll 1
                for (int i = 0; i < 16; ++i) rwkv_step<1>(z, ck + (cl * 16 + i) * 384, q, g, sa); }
        }
        for (int pass = 0; pass < 2; ++pass) {
            __syncthreads();
            if (role == pass) {
#pragma unroll
                for (int rr = 0; rr < 4; ++rr)
#pragma unroll
                    for (int u = 0; u < 4; ++u) *(f32x4*)(mat + (cl * 64 + 4 * g + rr) * 68 + 16 * q + 4 * u) = (f32x4){z[rr][4 * u], z[rr][4 * u + 1], z[rr][4 * u + 2], z[rr][4 * u + 3]};
            }
            __syncthreads();
            if (pass == 0) {
                for (int it = tid; it < 4 * 8 * 64; it += NTHREADS) {
                    const int clx = it >> 9, f = (it >> 6) & 7, l = it & 63, r = l & 31, hh = l >> 5, fi = f >> 2, fj = (f >> 1) & 1, fs = f & 1;
                    const size_t chunk = (size_t)bh * NCHUNK + cq * 4 + clx;
                    unsigned hi[4], lo[4];
#pragma unroll
                    for (int e2 = 0; e2 < 4; ++e2) {
                        unsigned short hs[2], ls[2];
#pragma unroll
                        for (int d = 0; d < 2; ++d) { const int e = 2 * e2 + d, kin = 32 * fj + 16 * fs + 8 * (e >> 2) + 4 * hh + (e & 3), kout = 32 * fi + r;
                            const float val = mat[(clx * 64 + kin) * 68 + kout]; hs[d] = f2bf(val); ls[d] = f2bf(val - bf2f(hs[d])); }
                        hi[e2] = (unsigned)hs[0] | ((unsigned)hs[1] << 16); lo[e2] = (unsigned)ls[0] | ((unsigned)ls[1] << 16);
                    }
                    unsigned char* dst = fr + OFF_AF + chunk * AF_BYTES + (size_t)((f * 2) * 64 + l) * 16;
                    *(uint4*)dst = make_uint4(hi[0], hi[1], hi[2], hi[3]);
                    *(uint4*)(dst + 64 * 16) = make_uint4(lo[0], lo[1], lo[2], lo[3]);
                }
            } else {
                for (int it = tid; it < 4 * 2 * 2 * 64 * 4; it += NTHREADS) {
                    const int gq = it & 3, l = (it >> 2) & 63, fi = (it >> 8) & 1, w2 = (it >> 9) & 1, clx = it >> 10, hh = l >> 5;
                    const size_t chunk = (size_t)bh * NCHUNK + cq * 4 + clx;
                    const f32x4 v4 = *(const f32x4*)(mat + (clx * 64 + 32 * w2 + (l & 31)) * 68 + 32 * fi + 8 * gq + 4 * hh);
                    *(f32x4*)(fr + OFF_NF + chunk * NF_BYTES + (size_t)(((w2 * 2 + fi) * 64 + l) * 16 + 4 * gq) * 4) = v4;
                }
            }
        }
    }
}

DI void split8(const f32x16& x, int s, bf16x8& hi, bf16x8& lo) {
#pragma unroll
    for (int e = 0; e < 8; ++e) { const float v = x[8 * s + e]; const bf16_t hb = f2bf(v); hi[e] = (short)hb; lo[e] = (short)f2bf(v - bf2f(hb)); }
}
DI void phase_rwkv_scan(const Params& p, unsigned char* lds, const int bh) {
    unsigned char* fr = (unsigned char*)p.out;
    const int tid = threadIdx.x, lane = tid & 63, wid = tid >> 6;
    const unsigned char* gA = fr + OFF_AF + (size_t)bh * NCHUNK * AF_BYTES;
    unsigned char* gN = fr + OFF_NF + (size_t)bh * NCHUNK * NF_BYTES;
    __syncthreads();
    for (int c = 0; c < 3; ++c)
        for (int e = tid; e < 2048; e += NTHREADS) {
            const uint4 v = e < 1024 ? *(const uint4*)(gA + (size_t)c * AF_BYTES + e * 16) : *(const uint4*)(gN + (size_t)c * NF_BYTES + (e - 1024) * 16);
            *(uint4*)(lds + c * 32768 + e * 16) = v;
        }
    const int ltid = tid - 128;
    const bool loader = (wid >= 2 && wid < 6);
    uint4 la0, la1, la2, la3, ln0, ln1, ln2, ln3;
#define SCAN_LOAD(cc_) do { const unsigned char* a_ = gA + (size_t)(cc_) * AF_BYTES + ltid * 16; const unsigned char* n_ = gN + (size_t)(cc_) * NF_BYTES + ltid * 16; \
        la0 = *(const uint4*)a_; la1 = *(const uint4*)(a_ + 4096); la2 = *(const uint4*)(a_ + 8192); la3 = *(const uint4*)(a_ + 12288); \
        ln0 = *(const uint4*)n_; ln1 = *(const uint4*)(n_ + 4096); ln2 = *(const uint4*)(n_ + 8192); ln3 = *(const uint4*)(n_ + 12288); } while (0)
#define SCAN_WRITE(slot_) do { unsigned char* d_ = lds + (slot_) * 32768 + ltid * 16; \
        *(uint4*)d_ = la0; *(uint4*)(d_ + 4096) = la1; *(uint4*)(d_ + 8192) = la2; *(uint4*)(d_ + 12288) = la3; \
        *(uint4*)(d_ + 16384) = ln0; *(uint4*)(d_ + 20480) = ln1; *(uint4*)(d_ + 24576) = ln2; *(uint4*)(d_ + 28672) = ln3; } while (0)
    if (loader) SCAN_LOAD(3);
    f32x16 X0, X1;
#pragma unroll
    for (int i = 0; i < 16; ++i) { X0[i] = 0.f; X1[i] = 0.f; }
    for (int c = 0; c < (int)NCHUNK; ++c) {
        __syncthreads();
        if (wid >= 2) {
            if (loader) {
                if (c + 3 < (int)NCHUNK) SCAN_WRITE((c + 3) & 3);
                if (c + 4 < (int)NCHUNK) SCAN_LOAD(c + 4);
            }
        } else {
            const int w2 = wid;
            const unsigned char* slot = lds + (c & 3) * 32768;
            float* gs = (float*)(gN + (size_t)c * NF_BYTES) + ((w2 * 2) * 64 + lane) * 16;
#pragma unroll
            for (int gq = 0; gq < 4; ++gq) { *(f32x4*)(gs + 4 * gq) = (f32x4){X0[4 * gq], X0[4 * gq + 1], X0[4 * gq + 2], X0[4 * gq + 3]};
                                             *(f32x4*)(gs + 64 * 16 + 4 * gq) = (f32x4){X1[4 * gq], X1[4 * gq + 1], X1[4 * gq + 2], X1[4 * gq + 3]}; }
            bf16x8 bhi[2][2], blo[2][2];
            split8(X0, 0, bhi[0][0], blo[0][0]); split8(X0, 1, bhi[0][1], blo[0][1]); split8(X1, 0, bhi[1][0], blo[1][0]); split8(X1, 1, bhi[1][1], blo[1][1]);
            f32x16 Dn[2];
#pragma unroll
            for (int i = 0; i < 2; ++i) {
                const float* np = (const float*)(slot + 16384) + ((w2 * 2 + i) * 64 + lane) * 16;
#pragma unroll
                for (int gq = 0; gq < 4; ++gq) { const f32x4 v4 = *(const f32x4*)(np + 4 * gq); Dn[i][4 * gq] = v4[0]; Dn[i][4 * gq + 1] = v4[1]; Dn[i][4 * gq + 2] = v4[2]; Dn[i][4 * gq + 3] = v4[3]; }
#pragma unroll
                for (int j = 0; j < 2; ++j)
#pragma unroll
                    for (int s = 0; s < 2; ++s) {
                        const int f = (i * 2 + j) * 2 + s;
                        const bf16x8 ah = *(const bf16x8*)(slot + ((f * 2) * 64 + lane) * 16), al = *(const bf16x8*)(slot + ((f * 2 + 1) * 64 + lane) * 16);
                        Dn[i] = __builtin_amdgcn_mfma_f32_32x32x16_bf16(ah, bhi[j][s], Dn[i], 0, 0, 0);
                        Dn[i] = __builtin_amdgcn_mfma_f32_32x32x16_bf16(ah, blo[j][s], Dn[i], 0, 0, 0);
                        Dn[i] = __builtin_amdgcn_mfma_f32_32x32x16_bf16(al, bhi[j][s], Dn[i], 0, 0, 0);
                    }
            }
            X0 = Dn[0]; X1 = Dn[1];
        }
    }
}

constexpr int RS3 = 464;
DI void phase_rwkv_out(const Params& p, unsigned char* lds, const int bid, const int nb) {
    const bf16_t* P = (const bf16_t*)(p.ws + OFF_P); bf16_t* YA = (bf16_t*)(p.ws + OFF_YA);
    const unsigned char* fr = (const unsigned char*)p.out;
    const int tid = threadIdx.x, lane = tid & 63, wid = tid >> 6, q = lane & 3, g = lane >> 2, pm = wid >> 1, part = wid & 1;
    float* ck = (float*)lds; unsigned char* bfrag = lds + 64 * RS3 * 4;
    for (int item = bid; item < 256; item += nb) {
        const int bh = item >> 4, co = item & 15, b = bh >> 3, h = bh & 7, c = co * 8 + wid, cA = co * 8 + 2 * pm;
        __syncthreads();
        build_lora_frags(p, h, bfrag);
        const int vo = 4 * g + q;
        const float lg = p.lnx_g[h * 64 + vo], lb = p.lnx_b[h * 64 + vo];
        float z[4][16];
        {
            const float* sf = (const float*)(fr + OFF_NF + ((size_t)bh * NCHUNK + c) * NF_BYTES);
#pragma unroll
            for (int rr = 0; rr < 4; ++rr) { const int v = 4 * g + rr, w2 = v >> 5, vl = v & 31, fi = q >> 1;
#pragma unroll
                for (int u = 0; u < 4; ++u) { const int hh = u & 1, r0 = 4 * (2 * (q & 1) + (u >> 1));
                    const f32x4 v4 = *(const f32x4*)(sf + ((w2 * 2 + fi) * 64 + vl + 32 * hh) * 16 + r0);
                    z[rr][4 * u] = v4[0]; z[rr][4 * u + 1] = v4[1]; z[rr][4 * u + 2] = v4[2]; z[rr][4 * u + 3] = v4[3]; } }
        }
#pragma unroll 1
        for (int sl = 0; sl < 8; ++sl) {
            __syncthreads();
            {
                const int ta = cA * 64 + sl * 8, tb = ta + 64;
                if (part == 0) stage16<0, RS3, true>(p, P, b, h, ta, ta + 4, tb, tb + 4, ck + pm * 16 * RS3, bfrag);
                else           stage16<1, RS3, true>(p, P, b, h, ta, ta + 4, tb, tb + 4, ck + pm * 16 * RS3, bfrag);
            }
            __syncthreads();
#pragma unroll 1
            for (int i = 0; i < 8; ++i) {
                const float* cc = ck + (wid * 8 + i) * RS3; float sa[4];
                rwkv_step<1>(z, cc, q, g, sa);
                f32x4 rv[4];
#pragma unroll
                for (int u = 0; u < 4; ++u) rv[u] = *(const f32x4*)(cc + 16 * q + 4 * u);
                float y[4];
#pragma unroll
                for (int rr = 0; rr < 4; ++rr) { float s0 = 0.f;
#pragma unroll
                    for (int u = 0; u < 4; ++u) s0 += z[rr][4 * u] * rv[u][0] + z[rr][4 * u + 1] * rv[u][1] + z[rr][4 * u + 2] * rv[u][2] + z[rr][4 * u + 3] * rv[u][3];
                    y[rr] = quad_sum(s0); }
                float tot = (y[0] + y[1]) + (y[2] + y[3]);
#pragma unroll
                for (int o2 = 4; o2 < 64; o2 <<= 1) tot += __shfl_xor(tot, o2, 64);
                const float mean = tot * (1.f / 64.f);
                float d0 = y[0] - mean, d1 = y[1] - mean, d2 = y[2] - mean, d3 = y[3] - mean;
                float vs = (d0 * d0 + d1 * d1) + (d2 * d2 + d3 * d3);
#pragma unroll
                for (int o2 = 4; o2 < 64; o2 <<= 1) vs += __shfl_xor(vs, o2, 64);
                const float rstd = rsqrtf(vs * (1.f / 64.f) + 64e-5f);
                const float dv = q == 0 ? d0 : q == 1 ? d1 : q == 2 ? d2 : d3;
                const float yn = dv * rstd * lg + lb;
                const float outv = (yn + cc[448] * cc[192 + vo]) * siluf_(cc[384 + vo]);
                const int t = c * 64 + sl * 8 + i;
                YA[(size_t)(b * T + t) * 512 + h * 64 + vo] = f2bf(outv);
            }
        }
    }
}

DI void phase_swa_simple(const Params& p, unsigned char* lds, const int bid, const int nb) {
    const bf16_t* P = (const bf16_t*)(p.ws + OFF_P); bf16_t* YB = (bf16_t*)(p.ws + OFF_YB);
    const long total = (long)BATCH * 8 * T;
    for (long it = (long)bid * NTHREADS + threadIdx.x; it < total; it += (long)nb * NTHREADS) {
        const int t = (int)(it % T), qh = (int)((it / T) % 8), b = (int)(it / ((long)T * 8)), kvh = qh >> 2;
        const size_t row = (size_t)(b * T + t);
        float q[64], acc[64];
        {
            const uint4* qp = (const uint4*)(P + row * NP + C_Q + qh * 64);
#pragma unroll
            for (int i = 0; i < 8; ++i) { const uint4 u = qp[i]; const unsigned w[4] = {u.x, u.y, u.z, u.w};
#pragma unroll
                for (int j = 0; j < 4; ++j) { q[i * 8 + j * 2] = __uint_as_float(w[j] << 16); q[i * 8 + j * 2 + 1] = __uint_as_float(w[j] & 0xffff0000u); } }
        }
#pragma unroll
        for (int d = 0; d < 64; ++d) acc[d] = 0.f;
        float m = p.sinks[qh], l = 1.f;
        for (int j = 0; j < 128; ++j) {
            const int s = t - 127 + j;
            if (s < 0) continue;
            const size_t krow = (size_t)(b * T + s) * NP;
            const uint4* kp = (const uint4*)(P + krow + C_SK + kvh * 64);
            float dot = 0.f;
#pragma unroll
            for (int i = 0; i < 8; ++i) { const uint4 u = kp[i]; const unsigned w[4] = {u.x, u.y, u.z, u.w};
#pragma unroll
                for (int jj = 0; jj < 4; ++jj) { dot += q[i * 8 + jj * 2] * __uint_as_float(w[jj] << 16) + q[i * 8 + jj * 2 + 1] * __uint_as_float(w[jj] & 0xffff0000u); } }
            const float sc = dot * 0.125f;
            const float mn = fmaxf(m, sc), corr = __expf(m - mn), pe = __expf(sc - mn);
            l = l * corr + pe; m = mn;
            const uint4* vp = (const uint4*)(P + krow + C_SV + kvh * 64);
#pragma unroll
            for (int i = 0; i < 8; ++i) { const uint4 u = vp[i]; const unsigned w[4] = {u.x, u.y, u.z, u.w};
#pragma unroll
                for (int jj = 0; jj < 4; ++jj) { acc[i * 8 + jj * 2] = acc[i * 8 + jj * 2] * corr + pe * __uint_as_float(w[jj] << 16);
                                                 acc[i * 8 + jj * 2 + 1] = acc[i * 8 + jj * 2 + 1] * corr + pe * __uint_as_float(w[jj] & 0xffff0000u); } }
        }
        const float inv = 1.f / l;
        const bf16_t* zp = P + row * NP + C_ZB + qh * 64; bf16_t* op = YB + row * 512 + qh * 64;
#pragma unroll
        for (int d = 0; d < 64; ++d) op[d] = f2bf(acc[d] * inv * siluf_(bf2f(zp[d])));
    }
}

DI void phase_xattn_simple(const Params& p, unsigned char* lds, const int bid, const int nb) {
    const bf16_t* P = (const bf16_t*)(p.ws + OFF_P); const bf16_t* KVM = (const bf16_t*)(p.ws + OFF_KVM); bf16_t* YC = (bf16_t*)(p.ws + OFF_YC);
    const int lane = threadIdx.x & 63, wid = threadIdx.x >> 6;
    const long total = (long)M * 4;
    const float scale = 0.08838834764831845f;
    for (long it = (long)bid * NWAVES + wid; it < total; it += (long)nb * NWAVES) {
        const int row = (int)(it >> 2), hd = (int)(it & 3), b = row / T;
        const bf16_t* qp = P + (size_t)row * NP + C_XQ + hd * 128;
        const bf16_t* kb = KVM + (size_t)(b * MEMLEN) * 1024 + hd * 128;
        float s[4] = {0.f, 0.f, 0.f, 0.f};
        for (int c = 0; c < 16; ++c) {
            const uint4 qu = *(const uint4*)(qp + c * 8); const unsigned qw[4] = {qu.x, qu.y, qu.z, qu.w};
#pragma unroll
            for (int i = 0; i < 4; ++i) {
                const uint4 ku = *(const uint4*)(kb + (size_t)(lane + 64 * i) * 1024 + c * 8); const unsigned kw[4] = {ku.x, ku.y, ku.z, ku.w};
#pragma unroll
                for (int j = 0; j < 4; ++j) s[i] += __uint_as_float(qw[j] << 16) * __uint_as_float(kw[j] << 16) + __uint_as_float(qw[j] & 0xffff0000u) * __uint_as_float(kw[j] & 0xffff0000u);
            }
        }
        float mx = -1e30f;
#pragma unroll
        for (int i = 0; i < 4; ++i) { s[i] *= scale; mx = fmaxf(mx, s[i]); }
        mx = wave_max(mx);
        float pe[4], sum = 0.f;
#pragma unroll
        for (int i = 0; i < 4; ++i) { pe[i] = __expf(s[i] - mx); sum += pe[i]; }
        sum = wave_sum(sum);
        const float inv = 1.f / sum;
        float o0 = 0.f, o1 = 0.f;
        const bf16_t* vb = kb + 512;
#pragma unroll
        for (int i = 0; i < 4; ++i)
            for (int mm = 0; mm < 64; ++mm) {
                const float pv = __shfl(pe[i], mm, 64);
                const bf16_t* vr = vb + (size_t)(mm + 64 * i) * 1024;
                o0 += pv * bf2f(vr[lane]); o1 += pv * bf2f(vr[lane + 64]);
            }
        const bf16_t* zp = P + (size_t)row * NP + C_ZC + hd * 128; bf16_t* op = YC + (size_t)row * 512 + hd * 128;
        op[lane] = f2bf(o0 * inv * siluf_(bf2f(zp[lane]))); op[lane + 64] = f2bf(o1 * inv * siluf_(bf2f(zp[lane + 64])));
    }
}

#define MFMA32(a, b, c) __builtin_amdgcn_mfma_f32_32x32x16_bf16((a), (b), (c), 0, 0, 0)
typedef short s16x4 __attribute__((ext_vector_type(4)));
DI int crow(int reg, int hh) { return (reg & 3) + 8 * (reg >> 2) + 4 * hh; }
template <int Dh> DI unsigned k_off(int row, int chunk) { return (unsigned)(row * (Dh * 2) + ((chunk ^ (row & (Dh / 8 - 1))) << 4)); }
DI bf16x8 pack8(const f32x16& x, int s) {
    bf16x8 r;
#pragma unroll
    for (int e = 0; e < 8; ++e) r[e] = (short)f2bf(x[8 * s + e]);
    return r;
}
constexpr int VS = 528;

DI void swa_unit(const Params& p, unsigned char* lds, int unit) {
    const bf16_t* P = (const bf16_t*)(p.ws + OFF_P); bf16_t* YB = (bf16_t*)(p.ws + OFF_YB);
    int tid = threadIdx.x; asm volatile("" : "+v"(tid));
    const int lane = tid & 63, wid = __builtin_amdgcn_readfirstlane(tid >> 6), c = lane & 31, hh = lane >> 5;
    const int n = unit & 63, kvh = (unit >> 6) & 1, b = unit >> 7;
    unsigned char* Kl = lds; unsigned char* Vt = lds + 32768;
    __syncthreads();
#pragma unroll
    for (int u = 0; u < 4; ++u) {
        const int idx = tid + 512 * u;
        { const int row = idx >> 3, chunk = idx & 7, t = n * 128 - 128 + row;
          uint4 v = make_uint4(0u, 0u, 0u, 0u);
          if (t >= 0) v = *(const uint4*)(P + (size_t)(b * T + t) * NP + C_SK + kvh * 64 + chunk * 8);
          *(uint4*)(Kl + k_off<64>(row, chunk)) = v; }
        { const int key = idx & 255, dch = idx >> 8, t = n * 128 - 128 + key;
          uint4 v = make_uint4(0u, 0u, 0u, 0u);
          if (t >= 0) v = *(const uint4*)(P + (size_t)(b * T + t) * NP + C_SV + kvh * 64 + dch * 8);
          const unsigned w[4] = {v.x, v.y, v.z, v.w};
#pragma unroll
          for (int e = 0; e < 8; ++e) *(bf16_t*)(Vt + (dch * 8 + e) * VS + key * 2) = (bf16_t)(e & 1 ? w[e >> 1] >> 16 : w[e >> 1] & 0xffffu); }
    }
    __syncthreads();
    const int qh = kvh * 4 + (wid >> 1), rh = wid & 1;
    const float sink = p.sinks[qh];
#pragma unroll 1
    for (int rt = 0; rt < 2; ++rt) {
        const int base = 64 * rh + 32 * rt;
        const size_t qrow = (size_t)(b * T + n * 128 + base + c);
        bf16x8 qf[4];
#pragma unroll
        for (int ds = 0; ds < 4; ++ds) qf[ds] = *(const bf16x8*)(P + qrow * NP + C_Q + qh * 64 + 16 * ds + 8 * hh);
        f32x16 st[5];
#pragma unroll
        for (int kt = 0; kt < 5; ++kt) {
#pragma unroll
            for (int i = 0; i < 16; ++i) st[kt][i] = 0.f;
#pragma unroll
            for (int ds = 0; ds < 4; ++ds) { const bf16x8 a = *(const bf16x8*)(Kl + k_off<64>(base + 32 * kt + c, 2 * ds + hh)); st[kt] = MFMA32(a, qf[ds], st[kt]); }
        }
        float mx = sink;
#pragma unroll
        for (int kt = 0; kt < 5; ++kt)
#pragma unroll
            for (int i = 0; i < 16; ++i) {
                const int cr = crow(i, hh);
                bool ok = true;
                if (kt == 0) ok = cr > c;
                if (kt == 4) ok = cr <= c;
                if (n == 0) ok = ok && (base + 32 * kt + cr >= 128);
                const float s = ok ? st[kt][i] * 0.125f : -1e30f;
                st[kt][i] = s; mx = fmaxf(mx, s);
            }
        mx = fmaxf(mx, __shfl_xor(mx, 32, 64));
        float ls = 0.f;
#pragma unroll
        for (int kt = 0; kt < 5; ++kt)
#pragma unroll
            for (int i = 0; i < 16; ++i) { const float pe = __expf(st[kt][i] - mx); st[kt][i] = pe; ls += pe; }
        ls += __shfl_xor(ls, 32, 64);
        const float inv = 1.f / (ls + __expf(sink - mx));
        f32x16 ot[2];
#pragma unroll
        for (int dt = 0; dt < 2; ++dt)
#pragma unroll
            for (int i = 0; i < 16; ++i) ot[dt][i] = 0.f;
#pragma unroll
        for (int kt = 0; kt < 5; ++kt)
#pragma unroll
            for (int s = 0; s < 2; ++s) {
                const bf16x8 pf = pack8(st[kt], s);
#pragma unroll
                for (int dt = 0; dt < 2; ++dt) {
                    const unsigned char* vp = Vt + (32 * dt + c) * VS + (base + 32 * kt + 16 * s + 4 * hh) * 2;
                    const s16x4 lo = *(const s16x4*)vp, hi = *(const s16x4*)(vp + 16);
                    const bf16x8 vf = __builtin_shufflevector(lo, hi, 0, 1, 2, 3, 4, 5, 6, 7);
                    ot[dt] = MFMA32(vf, pf, ot[dt]);
                }
            }
        const bf16_t* zp = P + qrow * NP + C_ZB + qh * 64; bf16_t* op = YB + qrow * 512 + qh * 64;
#pragma unroll
        for (int dt = 0; dt < 2; ++dt)
#pragma unroll
            for (int gq = 0; gq < 4; ++gq) {
                const int d0 = 32 * dt + 8 * gq + 4 * hh;
                const uint2 zz = *(const uint2*)(zp + d0);
                const float z0 = __uint_as_float(zz.x << 16), z1 = __uint_as_float(zz.x & 0xffff0000u), z2 = __uint_as_float(zz.y << 16), z3 = __uint_as_float(zz.y & 0xffff0000u);
                const unsigned o0 = (unsigned)f2bf(ot[dt][4 * gq] * inv * siluf_(z0)) | ((unsigned)f2bf(ot[dt][4 * gq + 1] * inv * siluf_(z1)) << 16);
                const unsigned o1 = (unsigned)f2bf(ot[dt][4 * gq + 2] * inv * siluf_(z2)) | ((unsigned)f2bf(ot[dt][4 * gq + 3] * inv * siluf_(z3)) << 16);
                *(uint2*)(op + d0) = make_uint2(o0, o1);
            }
    }
}

DI void xattn_unit(const Params& p, unsigned char* lds, int unit) {
    const bf16_t* P = (const bf16_t*)(p.ws + OFF_P); const bf16_t* KVM = (const bf16_t*)(p.ws + OFF_KVM); bf16_t* YC = (bf16_t*)(p.ws + OFF_YC);
    int tid = threadIdx.x; asm volatile("" : "+v"(tid));
    const int lane = tid & 63, wid = __builtin_amdgcn_readfirstlane(tid >> 6), c = lane & 31, hh = lane >> 5;
    const int qb = unit & 31, hd = (unit >> 5) & 3, b = unit >> 7;
    unsigned char* Kl = lds; unsigned char* Vt = lds + 65536;
    const bf16_t* kb = KVM + (size_t)(b * MEMLEN) * 1024 + hd * 128;
    __syncthreads();
#pragma unroll
    for (int u = 0; u < 8; ++u) {
        const int idx = tid + 512 * u;
        { const int row = idx >> 4, chunk = idx & 15;
          *(uint4*)(Kl + k_off<128>(row, chunk)) = *(const uint4*)(kb + (size_t)row * 1024 + chunk * 8); }
        { const int key = idx & 255, dch = idx >> 8;
          const uint4 v = *(const uint4*)(kb + (size_t)key * 1024 + 512 + dch * 8);
          const unsigned w[4] = {v.x, v.y, v.z, v.w};
#pragma unroll
          for (int e = 0; e < 8; ++e) *(bf16_t*)(Vt + (dch * 8 + e) * VS + key * 2) = (bf16_t)(e & 1 ? w[e >> 1] >> 16 : w[e >> 1] & 0xffffu); }
    }
    __syncthreads();
    const size_t qrow = (size_t)(b * T + qb * 256 + wid * 32 + c);
    const float scale = 0.08838834764831845f;
    bf16x8 qf[8];
#pragma unroll
    for (int ds = 0; ds < 8; ++ds) qf[ds] = *(const bf16x8*)(P + qrow * NP + C_XQ + hd * 128 + 16 * ds + 8 * hh);
    f32x16 ot[4];
#pragma unroll
    for (int dt = 0; dt < 4; ++dt)
#pragma unroll
        for (int i = 0; i < 16; ++i) ot[dt][i] = 0.f;
    float mrun = -1e30f, lrun = 0.f;
#pragma unroll 1
    for (int half = 0; half < 2; ++half) {
        f32x16 st[4];
#pragma unroll
        for (int kt = 0; kt < 4; ++kt) {
#pragma unroll
            for (int i = 0; i < 16; ++i) st[kt][i] = 0.f;
#pragma unroll
            for (int ds = 0; ds < 8; ++ds) { const bf16x8 a = *(const bf16x8*)(Kl + k_off<128>(128 * half + 32 * kt + c, 2 * ds + hh)); st[kt] = MFMA32(a, qf[ds], st[kt]); }
        }
        float mx = mrun;
#pragma unroll
        for (int kt = 0; kt < 4; ++kt)
#pragma unroll
            for (int i = 0; i < 16; ++i) { st[kt][i] *= scale; mx = fmaxf(mx, st[kt][i]); }
        mx = fmaxf(mx, __shfl_xor(mx, 32, 64));
        const float corr = __expf(mrun - mx);
        float ls = 0.f;
#pragma unroll
        for (int kt = 0; kt < 4; ++kt)
#pragma unroll
            for (int i = 0; i < 16; ++i) { const float pe = __expf(st[kt][i] - mx); st[kt][i] = pe; ls += pe; }
        ls += __shfl_xor(ls, 32, 64);
        lrun = lrun * corr + ls; mrun = mx;
#pragma unroll
        for (int dt = 0; dt < 4; ++dt)
#pragma unroll
            for (int i = 0; i < 16; ++i) ot[dt][i] *= corr;
#pragma unroll
        for (int kt = 0; kt < 4; ++kt)
#pragma unroll
            for (int s = 0; s < 2; ++s) {
                const bf16x8 pf = pack8(st[kt], s);
#pragma unroll
                for (int dt = 0; dt < 4; ++dt) {
                    const unsigned char* vp = Vt + (32 * dt + c) * VS + (128 * half + 32 * kt + 16 * s + 4 * hh) * 2;
                    const s16x4 lo = *(const s16x4*)vp, hi = *(const s16x4*)(vp + 16);
                    const bf16x8 vf = __builtin_shufflevector(lo, hi, 0, 1, 2, 3, 4, 5, 6, 7);
                    ot[dt] = MFMA32(vf, pf, ot[dt]);
                }
            }
    }
    const float inv = 1.f / lrun;
    const bf16_t* zp = P + qrow * NP + C_ZC + hd * 128; bf16_t* op = YC + qrow * 512 + hd * 128;
#pragma unroll
    for (int dt = 0; dt < 4; ++dt)
#pragma unroll
        for (int gq = 0; gq < 4; ++gq) {
            const int d0 = 32 * dt + 8 * gq + 4 * hh;
            const uint2 zz = *(const uint2*)(zp + d0);
            const float z0 = __uint_as_float(zz.x << 16), z1 = __uint_as_float(zz.x & 0xffff0000u), z2 = __uint_as_float(zz.y << 16), z3 = __uint_as_float(zz.y & 0xffff0000u);
            const unsigned o0 = (unsigned)f2bf(ot[dt][4 * gq] * inv * siluf_(z0)) | ((unsigned)f2bf(ot[dt][4 * gq + 1] * inv * siluf_(z1)) << 16);
            const unsigned o1 = (unsigned)f2bf(ot[dt][4 * gq + 2] * inv * siluf_(z2)) | ((unsigned)f2bf(ot[dt][4 * gq + 3] * inv * siluf_(z3)) << 16);
            *(uint2*)(op + d0) = make_uint2(o0, o1);
        }
}
DI void phase_attn(const Params& p, unsigned char* lds, const int bid, const int nb) {
    for (int u = bid; u < 512; u += nb) { if (u < 256) swa_unit(p, lds, u); else xattn_unit(p, lds, u - 256); }
}

namespace pg8 {
#define PG8_LAS __attribute__((address_space(3)))
typedef unsigned short bf16_t;
typedef short bf16x8 __attribute__((ext_vector_type(8)));
typedef float f32x4 __attribute__((ext_vector_type(4)));
typedef unsigned u32x4 __attribute__((ext_vector_type(4)));
constexpr int BM = 256, BK = 64, HALF = 128, HTB = HALF * BK * 2  , STAGE_BYTES = 8 * HTB, NXCD = 8, WGM = 8;

__host__ __device__ __forceinline__ int lds_byte(int r, int c) { const int st = (r >> 4) * 2 + (c >> 5), rr = r & 15, cc = c & 31, ob = rr * 64 + cc * 2; return st * 1024 + (ob ^ (((ob >> 9) & 1) << 5)); }
__host__ __device__ __forceinline__ void stage_rc(int b, int& R, int& C) { const int st = b / 1024, sb = b % 1024, swz = sb ^ (((sb >> 9) & 1) << 5); R = (st >> 1) * 16 + swz / 64; C = (st & 1) * 32 + (swz % 64) / 2; }
__host__ __device__ __forceinline__ int perm32(int rho) { const int n = rho >> 4, i = rho & 15; return 8 * (i >> 2) + 4 * n + (i & 3); }

struct Unit { int pm, pn; };
struct Gemm { const bf16_t* A; const bf16_t* Bt; int M, N, K; };

struct StaticOrder {
    int nM, nN, nwg, G, c;
    __host__ __device__ void init(int M, int N, int G_, int c_) { nM = M / BM; nN = N / BM; nwg = nM * nN; G = G_; c = c_; }
    __host__ __device__ bool next(int i, Unit& u) const {
        const long L = (long)i * G + c; if (L >= nwg) return false;
        int wgid = (int)L; { const int q = nwg / NXCD, r = nwg % NXCD, xcd = wgid % NXCD, off = wgid / NXCD; wgid = (xcd < r ? xcd * (q + 1) : r * (q + 1) + (xcd - r) * q) + off; }
        const int nig = WGM * nN, gid = wgid / nig, fm = gid * WGM, gsz = (nM - fm) < WGM ? (nM - fm) : WGM;
        u.pm = fm + ((wgid % nig) % gsz); u.pn = (wgid % nig) / gsz; return true;
    }
    __device__ __forceinline__ void a_ready(const Unit&) const {}
    __device__ __forceinline__ void done(const Unit&) const {}
};
__device__ __forceinline__ unsigned cvt_pk_bf16(float lo, float hi) { typedef float f2_ __attribute__((ext_vector_type(2))); typedef __bf16 b2_ __attribute__((ext_vector_type(2))); return __builtin_bit_cast(unsigned, __builtin_convertvector((f2_){lo, hi}, b2_)); }
typedef float f32x2 __attribute__((ext_vector_type(2)));
template <class Epi, class Sched, bool ALIGN_EPI = false, bool SP2 = false>
__device__ __forceinline__ void gemm_phase(PG8_LAS unsigned char* lds, const Gemm g, const Sched& S, const Epi& E) {
    const int tid = threadIdx.x, wid = __builtin_amdgcn_readfirstlane(tid >> 6), lane = tid & 63, wr = wid >> 2, wc = wid & 3, fr = lane & 15, fq = lane >> 4;
    const int K = g.K, nt = K / BK;
    unsigned voffA[2], voffB[2];
#pragma unroll
    for (int i = 0; i < 2; ++i) { int R, C; stage_rc(tid * 16 + i * 8192, R, C); const int Rb = Epi::PERM ? ((R & ~31) + perm32(R & 31)) : R;
        voffA[i] = (unsigned)(R * K + C) * 2u; voffB[i] = (unsigned)(Rb * K + C) * 2u; }
    const size_t kstep = (size_t)(BK * 2);
    const size_t hstep = (size_t)HALF * K * 2;
    const size_t tstep = 2 * hstep;
    const unsigned ldsw = (unsigned)wid * 1024u;
    const int aoff = lds_byte(wr * 64 + fr, fq * 8), boff = lds_byte(wc * 32 + fr, fq * 8);
#define PG8_SA(b, h) (((b) * 2 + (h)) * HTB)
#define PG8_SB(b, h) ((4 + (b) * 2 + (h)) * HTB)
#define PG8_STAGE(bufoff, gbase, voff) do { _Pragma("unroll") for (int _i = 0; _i < 2; ++_i) \
        __builtin_amdgcn_global_load_lds((const unsigned*)((const char*)(gbase) + (voff)[_i]), (PG8_LAS unsigned*)(lds + (bufoff) + ldsw + _i * 8192), 16, 0, 0); } while (0)
#define PG8_LDA(dst, b, h) do { _Pragma("unroll") for (int m = 0; m < 4; ++m) _Pragma("unroll") for (int k = 0; k < 2; ++k) dst[m][k] = *(const PG8_LAS bf16x8*)(lds + PG8_SA(b, h) + aoff + m * 2048 + k * 1024); } while (0)
#define PG8_LDB(dst, b, h) do { _Pragma("unroll") for (int n = 0; n < 2; ++n) _Pragma("unroll") for (int k = 0; k < 2; ++k) dst[n][k] = *(const PG8_LAS bf16x8*)(lds + PG8_SB(b, h) + boff + n * 2048 + k * 1024); } while (0)
#define PG8_MMA(ai, bj, At, Bt) do { __builtin_amdgcn_s_setprio(1); _Pragma("unroll") for (int m = 0; m < 4; ++m) _Pragma("unroll") for (int n = 0; n < 2; ++n) _Pragma("unroll") for (int k = 0; k < 2; ++k) \
        acc[ai][bj][m][n] = __builtin_amdgcn_mfma_f32_16x16x32_bf16(Bt[n][k], At[m][k], acc[ai][bj][m][n], 0, 0, 0); __builtin_amdgcn_s_setprio(0); } while (0)
#define PG8_WAIT_V(n) asm volatile("s_waitcnt vmcnt(" #n ")" ::: "memory")
#define PG8_WAIT_L(n) asm volatile("s_waitcnt lgkmcnt(" #n ")" ::: "memory")
#define PG8_BAR __builtin_amdgcn_s_barrier()
#define PG8_SCHED __builtin_amdgcn_sched_barrier(0)
    Unit cur, nxt; int ui = 0;
    if (!S.next(0, cur)) return;
    f32x4 acc[2][2][4][2];
#pragma unroll
    for (int a = 0; a < 2; ++a)
#pragma unroll
        for (int b = 0; b < 2; ++b)
#pragma unroll
            for (int m = 0; m < 4; ++m)
#pragma unroll
                for (int n = 0; n < 2; ++n) acc[a][b][m][n] = (f32x4){0.f, 0.f, 0.f, 0.f};
    bf16x8 At[4][2], B0[2][2], B1[2][2];
    const char* cA = (const char*)g.A + (size_t)cur.pm * tstep; const char* cB = (const char*)g.Bt + (size_t)cur.pn * tstep;
    S.a_ready(cur);
    if constexpr (SP2) {
        PG8_STAGE(PG8_SB(0, 0), cB, voffB); PG8_STAGE(PG8_SB(0, 1), cB + hstep, voffB); PG8_STAGE(PG8_SA(0, 0), cA, voffA); PG8_STAGE(PG8_SA(0, 1), cA + hstep, voffA);
        if (wr == 1) PG8_BAR;
        PG8_WAIT_V(2); PG8_BAR;
        PG8_STAGE(PG8_SB(1, 0), cB + kstep, voffB); PG8_STAGE(PG8_SA(1, 0), cA + kstep, voffA); PG8_STAGE(PG8_SB(1, 1), cB + hstep + kstep, voffB);
        PG8_WAIT_V(6); PG8_BAR;
    } else {
        PG8_STAGE(PG8_SB(0, 0), cB, voffB); PG8_STAGE(PG8_SA(0, 0), cA, voffA); PG8_STAGE(PG8_SB(0, 1), cB + hstep, voffB); PG8_STAGE(PG8_SA(0, 1), cA + hstep, voffA);
        if (wr == 1) PG8_BAR;
        PG8_WAIT_V(4); PG8_BAR;
        PG8_STAGE(PG8_SB(1, 0), cB + kstep, voffB); PG8_STAGE(PG8_SA(1, 0), cA + kstep, voffA); PG8_STAGE(PG8_SB(1, 1), cB + hstep + kstep, voffB);
        PG8_WAIT_V(6); PG8_BAR;
    }
    for (;;) {
        const bool has_next = S.next(ui + 1, nxt);
        const char* nA = has_next ? (const char*)g.A + (size_t)nxt.pm * tstep : cA; const char* nB = has_next ? (const char*)g.Bt + (size_t)nxt.pn * tstep : cB;
        for (int t = 0; t < nt; t += 2) {
            const bool last = (t == nt - 2);
            const char* a1 = cA + (size_t)(t + 1) * kstep;
            const char* a2 = last ? nA : cA + (size_t)(t + 2) * kstep; const char* b2 = last ? nB : cB + (size_t)(t + 2) * kstep;
            const char* a3 = a2 + kstep; const char* b3 = b2 + kstep;
            if (last && has_next) S.a_ready(nxt);
            if constexpr (SP2) {
            PG8_LDB(B0, 0, 0); PG8_LDB(B1, 0, 1); PG8_SCHED; PG8_LDA(At, 0, 0); PG8_STAGE(PG8_SA(1, 1), a1 + hstep, voffA);
            PG8_WAIT_V(8); PG8_WAIT_L(0); PG8_BAR; PG8_MMA(0, 0, At, B0); PG8_MMA(0, 1, At, B1); PG8_BAR; PG8_SCHED;
            PG8_LDA(At, 0, 1); PG8_STAGE(PG8_SB(0, 0), b2, voffB); PG8_STAGE(PG8_SB(0, 1), b2 + hstep, voffB); PG8_STAGE(PG8_SA(0, 0), a2, voffA);
            PG8_WAIT_V(8); PG8_WAIT_L(0); PG8_BAR; PG8_MMA(1, 0, At, B0); PG8_MMA(1, 1, At, B1); PG8_BAR; PG8_SCHED;
            PG8_LDB(B0, 1, 0); PG8_LDB(B1, 1, 1); PG8_SCHED; PG8_LDA(At, 1, 0); PG8_STAGE(PG8_SA(0, 1), a2 + hstep, voffA);
            PG8_WAIT_V(8); PG8_WAIT_L(0); PG8_BAR; PG8_MMA(0, 0, At, B0); PG8_MMA(0, 1, At, B1); PG8_BAR; PG8_SCHED;
            PG8_LDA(At, 1, 1); PG8_STAGE(PG8_SB(1, 0), b3, voffB); PG8_STAGE(PG8_SB(1, 1), b3 + hstep, voffB); PG8_STAGE(PG8_SA(1, 0), a3, voffA);
            PG8_WAIT_V(8); PG8_WAIT_L(0); PG8_BAR; PG8_MMA(1, 0, At, B0); PG8_MMA(1, 1, At, B1); PG8_BAR; PG8_SCHED;
            } else {
            PG8_LDB(B0, 0, 0); PG8_SCHED; PG8_LDA(At, 0, 0); PG8_STAGE(PG8_SA(1, 1), a1 + hstep, voffA);
            PG8_WAIT_L(8); PG8_BAR; PG8_WAIT_L(0); PG8_MMA(0, 0, At, B0); PG8_BAR; PG8_SCHED;
            PG8_LDB(B1, 0, 1); PG8_STAGE(PG8_SB(0, 0), b2, voffB);
            PG8_BAR; PG8_WAIT_L(0); PG8_MMA(0, 1, At, B1); PG8_BAR;
            PG8_LDA(At, 0, 1); PG8_STAGE(PG8_SA(0, 0), a2, voffA);
            PG8_BAR; PG8_WAIT_L(0); PG8_MMA(1, 0, At, B0); PG8_BAR; PG8_SCHED;
            PG8_STAGE(PG8_SB(0, 1), b2 + hstep, voffB);
            PG8_WAIT_V(6); PG8_BAR; PG8_MMA(1, 1, At, B1); PG8_BAR;
            PG8_LDB(B0, 1, 0); PG8_SCHED; PG8_LDA(At, 1, 0); PG8_STAGE(PG8_SA(0, 1), a2 + hstep, voffA);
            PG8_WAIT_L(8); PG8_BAR; PG8_WAIT_L(0); PG8_MMA(0, 0, At, B0); PG8_BAR; PG8_SCHED;
            PG8_LDB(B1, 1, 1); PG8_STAGE(PG8_SB(1, 0), b3, voffB);
            PG8_BAR; PG8_WAIT_L(0); PG8_MMA(0, 1, At, B1); PG8_BAR;
            PG8_LDA(At, 1, 1); PG8_STAGE(PG8_SA(1, 0), a3, voffA);
            PG8_BAR; PG8_WAIT_L(0); PG8_MMA(1, 0, At, B0); PG8_BAR; PG8_SCHED;
            PG8_STAGE(PG8_SB(1, 1), b3 + hstep, voffB);
            PG8_WAIT_V(6); PG8_BAR; PG8_MMA(1, 1, At, B1); PG8_BAR;
            }
        }
        if constexpr (ALIGN_EPI) { if (wr == 0) PG8_BAR; }
        if constexpr (!Epi::AFTER_DRAIN) { E(acc, cur, wr, wc, fr, fq); S.done(cur); }
        if (!has_next) break;
#pragma unroll
        for (int a = 0; a < 2; ++a)
#pragma unroll
            for (int b = 0; b < 2; ++b)
#pragma unroll
                for (int m = 0; m < 4; ++m)
#pragma unroll
                    for (int n = 0; n < 2; ++n) acc[a][b][m][n] = (f32x4){0.f, 0.f, 0.f, 0.f};
        cur = nxt; cA = nA; cB = nB; ++ui;
        if constexpr (ALIGN_EPI) { if (wr == 1) PG8_BAR; }
    }
    PG8_WAIT_V(0);
    if constexpr (!ALIGN_EPI) { if (wr == 0) PG8_BAR; }
    PG8_BAR;
    if constexpr (Epi::AFTER_DRAIN) { E.fused(acc, cur, wr, wc, fr, fq, lds, wid, lane); S.done(cur); }
#undef PG8_SA
#undef PG8_SB
#undef PG8_STAGE
#undef PG8_LDA
#undef PG8_LDB
#undef PG8_MMA
#undef PG8_WAIT_V
#undef PG8_WAIT_L
#undef PG8_BAR
#undef PG8_SCHED
}
}

namespace pg8 {
template <int ACT> struct EpiStore {
    static constexpr bool PERM = true, AFTER_DRAIN = false;
    bf16_t* O; int ldc;
    __device__ __forceinline__ void operator()(const f32x4 (&acc)[2][2][4][2], const Unit& u, int wr, int wc, int fr, int fq) const {
        const int row0 = u.pm * BM + wr * 64 + fr, col0 = u.pn * BM + wc * 32 + 8 * fq;
#pragma unroll
        for (int ai = 0; ai < 2; ++ai)
#pragma unroll
            for (int m = 0; m < 4; ++m) { bf16_t* rowp = O + (size_t)(row0 + ai * HALF + m * 16) * ldc + col0;
#pragma unroll
                for (int bj = 0; bj < 2; ++bj) { f32x4 v0 = acc[ai][bj][m][0], v1 = acc[ai][bj][m][1];
                    if (ACT == 1) {
#pragma unroll
                        for (int e = 0; e < 4; ++e) { v0[e] = __builtin_amdgcn_rcpf(1.f + __expf(-v0[e])); v1[e] = __builtin_amdgcn_rcpf(1.f + __expf(-v1[e])); } }
                    u32x4 w; w.x = cvt_pk_bf16(v0[0], v0[1]); w.y = cvt_pk_bf16(v0[2], v0[3]); w.z = cvt_pk_bf16(v1[0], v1[1]); w.w = cvt_pk_bf16(v1[2], v1[3]);
                    *(u32x4*)(rowp + bj * HALF) = w; } }
    }
};
template <bool ACCUM> struct EpiProj {
    static constexpr bool PERM = true, AFTER_DRAIN = false;
    bf16_t* MG; const bf16_t* SG; int gcol0;
    __device__ __forceinline__ void operator()(const f32x4 (&acc)[2][2][4][2], const Unit& u, int wr, int wc, int fr, int fq) const {
        const int row0 = u.pm * BM + wr * 64 + fr, col0 = u.pn * BM + wc * 32 + 8 * fq;
#pragma unroll
        for (int ai = 0; ai < 2; ++ai)
#pragma unroll
            for (int m = 0; m < 4; ++m) { const size_t row = (size_t)(row0 + ai * HALF + m * 16);
#pragma unroll
                for (int bj = 0; bj < 2; ++bj) {
                    const int col = col0 + bj * HALF;
                    const u32x4 gw = *(const u32x4*)(SG + row * 3072 + gcol0 + col);
                    u32x4 ow = (u32x4){0u, 0u, 0u, 0u};
                    if (ACCUM) ow = *(const u32x4*)(MG + row * 1024 + col);
                    float r[8];
#pragma unroll
                    for (int e = 0; e < 4; ++e) {
                        const float g0 = __uint_as_float(gw[e] << 16), g1 = __uint_as_float(gw[e] & 0xffff0000u);
                        const float a0 = e < 2 ? acc[ai][bj][m][0][2 * e] : acc[ai][bj][m][1][2 * e - 4], a1 = e < 2 ? acc[ai][bj][m][0][2 * e + 1] : acc[ai][bj][m][1][2 * e - 3];
                        r[2 * e] = g0 * a0; r[2 * e + 1] = g1 * a1;
                        if (ACCUM) { r[2 * e] += __uint_as_float(ow[e] << 16); r[2 * e + 1] += __uint_as_float(ow[e] & 0xffff0000u); }
                    }
                    u32x4 w; w.x = cvt_pk_bf16(r[0], r[1]); w.y = cvt_pk_bf16(r[2], r[3]); w.z = cvt_pk_bf16(r[4], r[5]); w.w = cvt_pk_bf16(r[6], r[7]);
                    *(u32x4*)(MG + row * 1024 + col) = w; } }
    }
};
struct EpiOut {
    static constexpr bool PERM = false, AFTER_DRAIN = false;
    const float* X; float* O;
    __device__ __forceinline__ void operator()(const f32x4 (&acc)[2][2][4][2], const Unit& u, int wr, int wc, int fr, int fq) const {
        const int row0 = u.pm * BM + wr * 64 + fr, col0 = u.pn * BM + wc * 32 + 4 * fq;
#pragma unroll
        for (int ai = 0; ai < 2; ++ai)
#pragma unroll
            for (int m = 0; m < 4; ++m) { const size_t off = (size_t)(row0 + ai * HALF + m * 16) * 1024 + col0;
#pragma unroll
                for (int bj = 0; bj < 2; ++bj)
#pragma unroll
                    for (int n = 0; n < 2; ++n) { const f32x4 xv = *(const f32x4*)(X + off + bj * HALF + n * 16); *(f32x4*)(O + off + bj * HALF + n * 16) = xv + acc[ai][bj][m][n]; } }
    }
};
}

DI void phase_gemm_gate(const Params& p, unsigned char* lds, const int bid, const int nb) {
    unsigned char* ws = p.ws;
    const bf16_t* H = (const bf16_t*)(ws + OFF_H); const bf16_t* Wt = (const bf16_t*)(ws + OFF_WIN) + (size_t)C_G * 1024;
    bf16_t* SG = (bf16_t*)(ws + OFF_SG);
    const int tn = 3072 / 128, nt = (M / 128) * tn;
    for (int it = bid; it < nt; it += nb) {
        GemmTile g; gemm_zero(g);
        const int m0 = (it / tn) * 128, n0 = (it % tn) * 128;
        gemm_tile_k(g, H, 1024, Wt, 1024, m0, n0, 1024, lds);
        GEMM_FOREACH(SG[(size_t)row * 3072 + col] = f2bf(sigmoidf_(g.acc[mi][ni][r])););
    }
}
DI void phase_gemm_proj(const Params& p, unsigned char* lds, const int bid, const int nb) {
    unsigned char* ws = p.ws;
    const bf16_t* SG = (const bf16_t*)(ws + OFF_SG); bf16_t* MG = (bf16_t*)(ws + OFF_MG);
    const int tn = 1024 / 128, nt = (M / 128) * tn;
    for (int it = bid; it < nt; it += nb) {
        const int m0 = (it / tn) * 128, n0 = (it % tn) * 128;
        GemmTile mg; gemm_zero(mg);
#pragma unroll 1
        for (int br = 0; br < 3; ++br) {
            GemmTile g; gemm_zero(g);
            const bf16_t* Y = (const bf16_t*)(ws + (br == 0 ? OFF_YA : br == 1 ? OFF_YB : OFF_YC));
            const bf16_t* W = (const bf16_t*)(ws + (br == 0 ? OFF_WPA : br == 1 ? OFF_WPB : OFF_WPC));
            gemm_tile_k(g, Y, 512, W, 512, m0, n0, 512, lds);
            GEMM_FOREACH(mg.acc[mi][ni][r] += bf2f(SG[(size_t)row * 3072 + br * 1024 + col]) * g.acc[mi][ni][r];);
        }
        GEMM_FOREACH(MG[(size_t)row * 1024 + col] = f2bf(mg.acc[mi][ni][r]););
    }
}
DI void phase_gemm_out(const Params& p, unsigned char* lds, const int bid, const int nb) {
    unsigned char* ws = p.ws;
    const bf16_t* MG = (const bf16_t*)(ws + OFF_MG); const bf16_t* W = (const bf16_t*)(ws + OFF_WO);
    const int tn = 1024 / 128, nt = (M / 128) * tn;
    for (int it = bid; it < nt; it += nb) {
        GemmTile g; gemm_zero(g);
        const int m0 = (it / tn) * 128, n0 = (it % tn) * 128;
        gemm_tile_k(g, MG, 1024, W, 1024, m0, n0, 1024, lds);
        GEMM_FOREACH(p.out[(size_t)row * 1024 + col] = p.x[(size_t)row * 1024 + col] + g.acc[mi][ni][r];);
    }
}

#define LASP(p_) ((__attribute__((address_space(3))) unsigned char*)(p_))
DI void phase_gemm_in_fast(const Params& p, unsigned char* lds, const int bid, const int nb) {
    unsigned char* ws = p.ws;
    {
        pg8::Gemm g{(const bf16_t*)(ws + OFF_H), (const bf16_t*)(ws + OFF_WIN), M, NP, 1024}; pg8::StaticOrder S; S.init(M, NP, nb, bid);
        pg8::EpiStore<0> E{(bf16_t*)(ws + OFF_P), NP};
        pg8::gemm_phase<pg8::EpiStore<0>, pg8::StaticOrder, true, true>(LASP(lds), g, S, E);
    }
    __syncthreads();
    const int tn2 = 1024 / 128, nt2 = (MM / 128) * tn2;
    for (int it = bid - nb / 2; it >= 0 && it < nt2; it += nb) {
        GemmTile g; gemm_zero(g);
        const int m0 = (it / tn2) * 128, n0 = (it % tn2) * 128;
        gemm_tile_k(g, (const bf16_t*)(ws + OFF_HM), 1024, (const bf16_t*)(ws + OFF_WKV), 1024, m0, n0, 1024, lds);
        bf16_t* KVM = (bf16_t*)(ws + OFF_KVM);
        GEMM_FOREACH(KVM[(size_t)row * 1024 + col] = f2bf(g.acc[mi][ni][r]););
    }
}
DI void phase_gemm_gate_fast(const Params& p, unsigned char* lds, const int bid, const int nb) {
    unsigned char* ws = p.ws;
    pg8::Gemm g{(const bf16_t*)(ws + OFF_H), (const bf16_t*)(ws + OFF_WIN) + (size_t)C_G * 1024, M, 3072, 1024}; pg8::StaticOrder S; S.init(M, 3072, nb, bid);
    pg8::EpiStore<1> E{(bf16_t*)(ws + OFF_SG), 3072};
    pg8::gemm_phase<pg8::EpiStore<1>, pg8::StaticOrder, true, true>(LASP(lds), g, S, E);
}
DI void phase_gemm_proj_fast(const Params& p, unsigned char* lds, const int bid, const int nb) {
    unsigned char* ws = p.ws;
    bf16_t* MG = (bf16_t*)(ws + OFF_MG); const bf16_t* SG = (const bf16_t*)(ws + OFF_SG);
    pg8::StaticOrder S; S.init(M, 1024, nb, bid);
    { pg8::Gemm g{(const bf16_t*)(ws + OFF_YA), (const bf16_t*)(ws + OFF_WPA), M, 1024, 512}; pg8::EpiProj<false> E{MG, SG, 0};
      pg8::gemm_phase<pg8::EpiProj<false>, pg8::StaticOrder, true, true>(LASP(lds), g, S, E); }
    { pg8::Gemm g{(const bf16_t*)(ws + OFF_YB), (const bf16_t*)(ws + OFF_WPB), M, 1024, 512}; pg8::EpiProj<true> E{MG, SG, 1024};
      pg8::gemm_phase<pg8::EpiProj<true>, pg8::StaticOrder, true, true>(LASP(lds), g, S, E); }
    { pg8::Gemm g{(const bf16_t*)(ws + OFF_YC), (const bf16_t*)(ws + OFF_WPC), M, 1024, 512}; pg8::EpiProj<true> E{MG, SG, 2048};
      pg8::gemm_phase<pg8::EpiProj<true>, pg8::StaticOrder, true, true>(LASP(lds), g, S, E); }
}
DI void phase_gemm_out_fast(const Params& p, unsigned char* lds, const int bid, const int nb) {
    unsigned char* ws = p.ws;
    pg8::Gemm g{(const bf16_t*)(ws + OFF_MG), (const bf16_t*)(ws + OFF_WO), M, 1024, 1024}; pg8::StaticOrder S; S.init(M, 1024, nb, bid);
    pg8::EpiOut E{p.x, p.out};
    pg8::gemm_phase<pg8::EpiOut, pg8::StaticOrder, true, true>(LASP(lds), g, S, E);
}

#define XB_TMO      128
#define XB_XCNT(j)  (256  + 64 * (j))
#define XB_XSUB(j)  (1280 + 64 * (j))
#define XB_XGEN(j)  (2304 + 64 * (j))
#define XB_TOP      3328
#define XB_TOPGEN   3392
#define XCD_BAR_WORDS 3456
#define XB_SPIN_CAP (1u << 22)
#define LAS __attribute__((address_space(3)))
DI unsigned xb_ld(unsigned* p)              { return __hip_atomic_load(p, __ATOMIC_RELAXED, __HIP_MEMORY_SCOPE_AGENT); }
DI unsigned xb_add(unsigned* p, unsigned v) { return __hip_atomic_fetch_add(p, v, __ATOMIC_RELAXED, __HIP_MEMORY_SCOPE_AGENT); }
DI unsigned xb_xcc_id() { return (unsigned)__builtin_amdgcn_s_getreg((3 << 11) | 20) & 0xFu; }
#define XB_SPIN(cond, bar) do { unsigned _sp = 0; while (cond) { __builtin_amdgcn_s_sleep(1); \
    if ((++_sp & 255u) == 0u) { if (xb_ld(&(bar)[XB_TMO])) break; if (_sp > XB_SPIN_CAP) { atomicAdd(&(bar)[XB_TMO], 1u); break; } } } } while (0)
struct XcdBarrier { unsigned* bar; unsigned x; volatile LAS unsigned* st; };
DI XcdBarrier xcd_barrier_post(unsigned* bar, volatile LAS unsigned* st) {
    XcdBarrier b; b.bar = bar; b.x = xb_xcc_id(); b.st = st;
    if (threadIdx.x == 0) (void)xb_add(&bar[XB_XCNT(b.x)], 1u);
    return b;
}
DI void xcd_barrier_complete(unsigned* bar, unsigned x, unsigned& nloc, unsigned& nx) {
    const unsigned G = gridDim.x * gridDim.y * gridDim.z;
    unsigned sum, cnt, mine, sp = 0u;
    for (;;) {
        sum = 0u; cnt = 0u; mine = 0u;
#pragma unroll
        for (unsigned j = 0; j < 16; ++j) { const unsigned c = xb_ld(&bar[XB_XCNT(j)]); sum += c; cnt += (c > 0u) ? 1u : 0u; mine = (j == x) ? c : mine; }
        if (sum == G) break;
        __builtin_amdgcn_s_sleep(1);
        if ((++sp & 255u) == 0u) { if (xb_ld(&bar[XB_TMO])) break; if (sp > XB_SPIN_CAP) { atomicAdd(&bar[XB_TMO], 1u); break; } }
    }
    nloc = mine > 0u ? mine : 1u; nx = cnt > 0u ? cnt : 1u;
}
DI void xcd_barrier(const XcdBarrier& b) {
    asm volatile("s_waitcnt vmcnt(0)" ::: "memory");
    __syncthreads();
    if (threadIdx.x == 0) {
        unsigned* bar = b.bar;
        __builtin_amdgcn_s_waitcnt(0);
        unsigned nloc = b.st[0], nx = b.st[1];
        if (nloc == 0u) { xcd_barrier_complete(bar, b.x, nloc, nx); b.st[0] = nloc; b.st[1] = nx; }
        const unsigned old = xb_add(&bar[XB_XSUB(b.x)], 1u);
        const unsigned gen = old / nloc;
        if (old + 1u == (gen + 1u) * nloc) {
            __builtin_amdgcn_fence(__ATOMIC_RELEASE, "agent");
            asm volatile("s_waitcnt vmcnt(0)" ::: "memory");
            const unsigned og = xb_add(&bar[XB_TOP], 1u);
            const unsigned tg = og / nx;
            if (og + 1u == (tg + 1u) * nx) xb_add(&bar[XB_TOPGEN], 1u);
            else XB_SPIN(xb_ld(&bar[XB_TOPGEN]) == tg, bar);
            __builtin_amdgcn_fence(__ATOMIC_ACQUIRE, "agent");
            xb_add(&bar[XB_XGEN(b.x)], 1u);
            asm volatile("s_waitcnt vmcnt(0)" ::: "memory");
        } else {
            XB_SPIN(xb_ld(&bar[XB_XGEN(b.x)]) == gen, bar);
            __builtin_amdgcn_fence(__ATOMIC_ACQUIRE, "agent");
            asm volatile("s_waitcnt vmcnt(0)" ::: "memory");
        }
    }
    __syncthreads();
}

constexpr int LDS_CTL_OFF = LDS_BYTES - 256;
__global__ void __launch_bounds__(NTHREADS, 2) k_mega(Params p) {
    extern __shared__ __attribute__((aligned(16))) unsigned char lds[];
    volatile LAS unsigned* st = (volatile LAS unsigned*)(lds + LDS_CTL_OFF);
    if (threadIdx.x == 0) { st[0] = 0u; st[1] = 0u; st[2] = 0u; st[3] = 0u; }
    __syncthreads();
    (void)xcd_barrier_post((unsigned*)(p.ws + OFF_CTL), st);
#define GRID_BAR() do { XcdBarrier b_; b_.bar = (unsigned*)(p.ws + OFF_CTL); b_.x = xb_xcc_id(); b_.st = (volatile LAS unsigned*)(lds + LDS_CTL_OFF); xcd_barrier(b_); } while (0)
    const int bid = blockIdx.x, nb = gridDim.x;
    phase_prologue(p, lds, bid, nb);
    GRID_BAR();
#ifndef FASTMASK
#define FASTMASK 15
#endif
    if (FASTMASK & 1) phase_gemm_in_fast(p, lds, bid, nb); else phase_gemm_in(p, lds, bid, nb);
    GRID_BAR();
    phase_attn_prep(p, lds, bid, nb);
    GRID_BAR();
    phase_rwkv_prep(p, lds, bid, nb);
    GRID_BAR();
    if (bid < 16) phase_rwkv_scan(p, lds, bid);
    else phase_attn(p, lds, bid - 16, nb - 16);
    GRID_BAR();
    phase_rwkv_out(p, lds, bid, nb);
    GRID_BAR();
    if (FASTMASK & 2) phase_gemm_gate_fast(p, lds, bid, nb); else phase_gemm_gate(p, lds, bid, nb);
    GRID_BAR();
    if (FASTMASK & 4) phase_gemm_proj_fast(p, lds, bid, nb); else phase_gemm_proj(p, lds, bid, nb);
    GRID_BAR();
    if (FASTMASK & 8) phase_gemm_out_fast(p, lds, bid, nb); else phase_gemm_out(p, lds, bid, nb);
}

extern "C" void kernel_launch(void* const* d_in, const int* in_sizes, int n_in, void* d_out, int out_size, void* d_ws, size_t ws_size, hipStream_t stream) {
    static int grid = 0;
    if (grid == 0) {
        if (n_in != 27 || ws_size < WS_END) { fprintf(stderr, "kernel_launch: unexpected inputs (n_in %d, ws %zu)\n", n_in, ws_size); grid = -1; return; }
        int dev = 0, cus = 0, per_cu = 0;
        if (hipGetDevice(&dev) != hipSuccess || hipDeviceGetAttribute(&cus, hipDeviceAttributeMultiprocessorCount, dev) != hipSuccess) { grid = -1; return; }
        if (hipFuncSetAttribute((const void*)k_mega, hipFuncAttributeMaxDynamicSharedMemorySize, LDS_BYTES) != hipSuccess) { fprintf(stderr, "kernel_launch: hipFuncSetAttribute failed\n"); grid = -1; return; }
        if (hipOccupancyMaxActiveBlocksPerMultiprocessor(&per_cu, (const void*)k_mega, NTHREADS, LDS_BYTES) != hipSuccess || per_cu < 1)
            fprintf(stderr, "kernel_launch: occupancy query reports %d workgroups per CU\n", per_cu);
        (void)hipGetLastError();
        grid = cus;
        if (grid < 32) { fprintf(stderr, "kernel_launch: too few CUs (%d)\n", grid); grid = -1; return; }
    }
    if (grid < 0) return;
    if (hipMemsetAsync((char*)d_ws + OFF_CTL, 0, 65536, stream) != hipSuccess) { fprintf(stderr, "kernel_launch: memset failed\n"); return; }
    Params p{};
    p.x = (const float*)d_in[0]; p.mem = (const float*)d_in[1]; p.pos = (const int*)d_in[2]; p.norm_g = (const float*)d_in[3]; p.mem_norm_g = (const float*)d_in[4];
    p.w_in = (const float*)d_in[5]; p.mu_rkv = (const float*)d_in[6]; p.mu_wa = (const float*)d_in[7]; p.w0 = (const float*)d_in[8]; p.w2 = (const float*)d_in[9];
    p.a0 = (const float*)d_in[10]; p.a2 = (const float*)d_in[11]; p.k_k = (const float*)d_in[12]; p.k_a = (const float*)d_in[13]; p.r_k = (const float*)d_in[14];
    p.lnx_g = (const float*)d_in[15]; p.lnx_b = (const float*)d_in[16]; p.q_norm_g = (const float*)d_in[17]; p.k_norm_g = (const float*)d_in[18]; p.sinks = (const float*)d_in[19];
    p.xq_norm_g = (const float*)d_in[20]; p.xk_norm_g = (const float*)d_in[21]; p.w_mem_kv = (const float*)d_in[22]; p.w_proj_a = (const float*)d_in[23];
    p.w_proj_b = (const float*)d_in[24]; p.w_proj_c = (const float*)d_in[25]; p.w_out = (const float*)d_in[26];
    p.out = (float*)d_out; p.ws = (unsigned char*)d_ws;
    hipLaunchKernelGGL(k_mega, dim3(grid), dim3(NTHREADS), LDS_BYTES, stream, p);
}
```

```cpp
#include <hip/hip_runtime.h>
#include <stdint.h>
#include <stdio.h>

#define DI __device__ __forceinline__
typedef unsigned short bf16_t;
typedef short bf16x8 __attribute__((ext_vector_type(8)));
typedef float f32x4 __attribute__((ext_vector_type(4)));

constexpr int BATCH = 2, T = 8192, M = BATCH * T, D = 1024, NIN = 7552, NP = 4608  ;
constexpr int MEMLEN = 256, MM = BATCH * MEMLEN;
constexpr int C_R = 0, C_K = 512, C_V = 1024, C_W = 1536, C_A = 1600, C_ZA = 1664, C_Q = 2176, C_SK = 2688, C_SV = 2816, C_ZB = 2944, C_XQ = 3456, C_ZC = 3968, C_G = 4480;
constexpr int NTHREADS = 512, NWAVES = 8;
constexpr int LDS_BYTES = 147456;

constexpr size_t OFF_CTL = 0;
constexpr size_t OFF_WIN = 65536;
constexpr size_t OFF_WKV = OFF_WIN + (size_t)7680 * 1024 * 2;
constexpr size_t OFF_WPA = OFF_WKV + (size_t)1024 * 1024 * 2;
constexpr size_t OFF_WPB = OFF_WPA + (size_t)1024 * 512 * 2;
constexpr size_t OFF_WPC = OFF_WPB + (size_t)1024 * 512 * 2;
constexpr size_t OFF_WO  = OFF_WPC + (size_t)1024 * 512 * 2;
constexpr size_t OFF_H   = OFF_WO + (size_t)1024 * 1024 * 2;
constexpr size_t OFF_HM  = OFF_H + (size_t)M * 1024 * 2;
constexpr size_t OFF_KVM = OFF_HM + (size_t)MM * 1024 * 2;
constexpr size_t OFF_ROPE = OFF_KVM + (size_t)MM * 1024 * 2;
constexpr size_t OFF_P   = OFF_ROPE + (size_t)M * 32 * 8;
constexpr size_t OFF_YA  = OFF_P + (size_t)M * NP * 2;
constexpr size_t OFF_YB  = OFF_YA + (size_t)M * 512 * 2;
constexpr size_t OFF_YC  = OFF_YB + (size_t)M * 512 * 2;
constexpr size_t WS_END  = OFF_YC + (size_t)M * 512 * 2;
constexpr size_t OFF_SG  = OFF_P;
constexpr size_t OFF_MG  = OFF_P + (size_t)M * 3072 * 2;
static_assert(WS_END <= (size_t)256 * 1024 * 1024, "workspace");
static_assert(OFF_MG + (size_t)M * 1024 * 2 <= OFF_YA, "overlay");

struct Params {
    const float* x; const float* mem; const int* pos; const float* norm_g; const float* mem_norm_g; const float* w_in;
    const float* mu_rkv; const float* mu_wa; const float* w0; const float* w2; const float* a0; const float* a2;
    const float* k_k; const float* k_a; const float* r_k; const float* lnx_g; const float* lnx_b;
    const float* q_norm_g; const float* k_norm_g; const float* sinks; const float* xq_norm_g; const float* xk_norm_g;
    const float* w_mem_kv; const float* w_proj_a; const float* w_proj_b; const float* w_proj_c; const float* w_out;
    float* out; unsigned char* ws;
};

DI bf16_t f2bf(float x) { return __builtin_bit_cast(unsigned short, (__bf16)x); }
DI float bf2f(bf16_t h) { return __uint_as_float(((unsigned)h) << 16); }
DI float wave_sum(float v) {
#pragma unroll
    for (int o = 32; o > 0; o >>= 1) v += __shfl_xor(v, o, 64);
    return v;
}
DI float wave_max(float v) {
#pragma unroll
    for (int o = 32; o > 0; o >>= 1) v = fmaxf(v, __shfl_xor(v, o, 64));
    return v;
}
DI float sigmoidf_(float x) { return 1.f / (1.f + __expf(-x)); }
DI float siluf_(float x) { return x / (1.f + __expf(-x)); }

DI void transpose_convert(const float* W, int K, int N, bf16_t* Wt, int item, float* tile  ) {
    const int tn = N / 64, kt = item / tn, nt = item % tn, tid = threadIdx.x;
    __syncthreads();
    for (int e = tid; e < 4096; e += NTHREADS) { const int r = e >> 6, c = e & 63; tile[r * 65 + c] = W[(size_t)(kt * 64 + r) * N + nt * 64 + c]; }
    __syncthreads();
    for (int e = tid; e < 4096; e += NTHREADS) { const int n = e >> 6, k = e & 63; Wt[(size_t)(nt * 64 + n) * K + kt * 64 + k] = f2bf(tile[k * 65 + n]); }
}

DI void phase_prologue(const Params& p, unsigned char* lds, const int bid, const int nb) {
    float* tile = (float*)lds;
    unsigned char* ws = p.ws;
    const int n_in = (1024 / 64) * (NIN / 64), n_kv = 16 * 16, n_pr = (512 / 64) * 16, n_o = 16 * 16;
    const int total = n_in + n_kv + 3 * n_pr + n_o;
    for (int it = bid; it < total; it += nb) {
        int i = it;
        if (i < n_in) { transpose_convert(p.w_in, 1024, NIN, (bf16_t*)(ws + OFF_WIN), i, tile); continue; } i -= n_in;
        if (i < n_kv) { transpose_convert(p.w_mem_kv, 1024, 1024, (bf16_t*)(ws + OFF_WKV), i, tile); continue; } i -= n_kv;
        if (i < n_pr) { transpose_convert(p.w_proj_a, 512, 1024, (bf16_t*)(ws + OFF_WPA), i, tile); continue; } i -= n_pr;
        if (i < n_pr) { transpose_convert(p.w_proj_b, 512, 1024, (bf16_t*)(ws + OFF_WPB), i, tile); continue; } i -= n_pr;
        if (i < n_pr) { transpose_convert(p.w_proj_c, 512, 1024, (bf16_t*)(ws + OFF_WPC), i, tile); continue; } i -= n_pr;
        transpose_convert(p.w_out, 1024, 1024, (bf16_t*)(ws + OFF_WO), i, tile);
    }
    {
        unsigned* z = (unsigned*)(ws + OFF_WIN + (size_t)NIN * 1024 * 2);
        const int nz = (7680 - NIN) * 1024 / 2;
        for (int i = bid * NTHREADS + threadIdx.x; i < nz; i += nb * NTHREADS) z[i] = 0u;
    }
    const int lane = threadIdx.x & 63, wid = threadIdx.x >> 6;
    for (int row = bid * NWAVES + wid; row < M + MM; row += nb * NWAVES) {
        const float* src = row < M ? p.x + (size_t)row * D : p.mem + (size_t)(row - M) * D;
        const float* g = row < M ? p.norm_g : p.mem_norm_g;
        bf16_t* dst = row < M ? (bf16_t*)(ws + OFF_H) + (size_t)row * D : (bf16_t*)(ws + OFF_HM) + (size_t)(row - M) * D;
        f32x4 v[4]; float ss = 0.f;
#pragma unroll
        for (int i = 0; i < 4; ++i) { v[i] = *(const f32x4*)(src + i * 256 + lane * 4); ss += v[i][0] * v[i][0] + v[i][1] * v[i][1] + v[i][2] * v[i][2] + v[i][3] * v[i][3]; }
        ss = wave_sum(ss);
        const float rs = rsqrtf(ss * (1.f / 1024.f) + 1e-6f);
#pragma unroll
        for (int i = 0; i < 4; ++i) {
            const f32x4 gg = *(const f32x4*)(g + i * 256 + lane * 4);
            ushort4 o; o.x = f2bf(v[i][0] * rs * gg[0]); o.y = f2bf(v[i][1] * rs * gg[1]); o.z = f2bf(v[i][2] * rs * gg[2]); o.w = f2bf(v[i][3] * rs * gg[3]);
            *(ushort4*)(dst + i * 256 + lane * 4) = o;
        }
    }
    float2* rope = (float2*)(ws + OFF_ROPE);
    for (int i = bid * NTHREADS + threadIdx.x; i < M * 32; i += nb * NTHREADS) {
        const int row = i >> 5, f = i & 31;
        const double inv = pow(10000.0, -(double)f / 32.0);
        const double ang = (double)p.pos[row] * inv;
        double s, c; sincos(ang, &s, &c);
        rope[i] = make_float2((float)c, (float)s);
    }
}

struct GemmTile { f32x4 acc[2][4]; };
DI void gemm_tile_k(GemmTile& g, const bf16_t* A, int lda, const bf16_t* Bt, int ldb, int m0, int n0, int K, unsigned char* lds) {
    bf16_t* sA = (bf16_t*)lds;
    bf16_t* sB = sA + 128 * 40;
    const int tid = threadIdx.x, lane = tid & 63, wid = tid >> 6, wm = wid & 3, wn = wid >> 2;
    const int srow = tid >> 2, sch = tid & 3;
    const bf16_t* ga = A + (size_t)(m0 + srow) * lda + sch * 8;
    const bf16_t* gb = Bt + (size_t)(n0 + srow) * ldb + sch * 8;
    const int fr = lane & 15, fq = lane >> 4;
    uint4 ra = *(const uint4*)ga, rb = *(const uint4*)gb;
    for (int k0 = 0; k0 < K; k0 += 32) {
        __syncthreads();
        *(uint4*)(sA + srow * 40 + sch * 8) = ra;
        *(uint4*)(sB + srow * 40 + sch * 8) = rb;
        __syncthreads();
        if (k0 + 32 < K) { ra = *(const uint4*)(ga + k0 + 32); rb = *(const uint4*)(gb + k0 + 32); }
        bf16x8 af[2], bfr[4];
#pragma unroll
        for (int mi = 0; mi < 2; ++mi) af[mi] = *(const bf16x8*)(sA + (wm * 32 + mi * 16 + fr) * 40 + fq * 8);
#pragma unroll
        for (int ni = 0; ni < 4; ++ni) bfr[ni] = *(const bf16x8*)(sB + (wn * 64 + ni * 16 + fr) * 40 + fq * 8);
#pragma unroll
        for (int mi = 0; mi < 2; ++mi)
#pragma unroll
            for (int ni = 0; ni < 4; ++ni) g.acc[mi][ni] = __builtin_amdgcn_mfma_f32_16x16x32_bf16(af[mi], bfr[ni], g.acc[mi][ni], 0, 0, 0);
    }
}
DI void gemm_zero(GemmTile& g) {
#pragma unroll
    for (int mi = 0; mi < 2; ++mi)
#pragma unroll
        for (int ni = 0; ni < 4; ++ni) g.acc[mi][ni] = (f32x4){0.f, 0.f, 0.f, 0.f};
}
#define GEMM_FOREACH(body) do { const int lane_ = threadIdx.x & 63, wid_ = threadIdx.x >> 6, wm_ = wid_ & 3, wn_ = wid_ >> 2, fr_ = lane_ & 15, fq_ = lane_ >> 4; \
    _Pragma("unroll") for (int mi = 0; mi < 2; ++mi) _Pragma("unroll") for (int ni = 0; ni < 4; ++ni) _Pragma("unroll") for (int r = 0; r < 4; ++r) { \
        const int row = m0 + wm_ * 32 + mi * 16 + fq_ * 4 + r, col = n0 + wn_ * 64 + ni * 16 + fr_; body } } while (0)

DI void phase_gemm_in(const Params& p, unsigned char* lds, const int bid, const int nb) {
    unsigned char* ws = p.ws;
    const bf16_t* H = (const bf16_t*)(ws + OFF_H); const bf16_t* Wt = (const bf16_t*)(ws + OFF_WIN);
    bf16_t* P = (bf16_t*)(ws + OFF_P);
    const int tn = NP / 128, nt1 = (M / 128) * tn;
    const int tn2 = 1024 / 128, nt2 = (MM / 128) * tn2;
    for (int it = bid; it < nt1 + nt2; it += nb) {
        GemmTile g; gemm_zero(g);
        if (it < nt1) {
            const int m0 = (it / tn) * 128, n0 = (it % tn) * 128;
            gemm_tile_k(g, H, 1024, Wt, 1024, m0, n0, 1024, lds);
            GEMM_FOREACH(P[(size_t)row * NP + col] = f2bf(g.acc[mi][ni][r]););
        } else {
            const int i2 = it - nt1; const int m0 = (i2 / tn2) * 128, n0 = (i2 % tn2) * 128;
            gemm_tile_k(g, (const bf16_t*)(ws + OFF_HM), 1024, (const bf16_t*)(ws + OFF_WKV), 1024, m0, n0, 1024, lds);
            bf16_t* KVM = (bf16_t*)(ws + OFF_KVM);
            GEMM_FOREACH(KVM[(size_t)row * 1024 + col] = f2bf(g.acc[mi][ni][r]););
        }
    }
}

DI void phase_attn_prep(const Params& p, unsigned char* lds, const int bid, const int nb) {
    unsigned char* ws = p.ws; bf16_t* P = (bf16_t*)(ws + OFF_P); bf16_t* KVM = (bf16_t*)(ws + OFF_KVM);
    const float2* rope = (const float2*)(ws + OFF_ROPE);
    const int lane = threadIdx.x & 63, wid = threadIdx.x >> 6;
    const long n1 = (long)M * 14, n2 = (long)MM * 4;
    for (long it = (long)bid * NWAVES + wid; it < n1 + n2; it += (long)nb * NWAVES) {
        if (it < n1) {
            const int row = (int)(it / 14), j = (int)(it % 14);
            if (j < 10) {
                bf16_t* ptr = P + (size_t)row * NP + (j < 8 ? C_Q + j * 64 : C_SK + (j - 8) * 64);
                const float g = j < 8 ? p.q_norm_g[lane] : p.k_norm_g[lane];
                const float xv = bf2f(ptr[lane]);
                const float ss = wave_sum(xv * xv);
                const float y = xv * rsqrtf(ss * (1.f / 64.f) + 1e-6f) * g;
                const float yp = __shfl_xor(y, 32, 64);
                const float2 cs = rope[(size_t)row * 32 + (lane & 31)];
                const float o = lane < 32 ? y * cs.x - yp * cs.y : y * cs.x + yp * cs.y;
                ptr[lane] = f2bf(o);
            } else {
                bf16_t* ptr = P + (size_t)row * NP + C_XQ + (j - 10) * 128;
                const float x0 = bf2f(ptr[lane]), x1 = bf2f(ptr[lane + 64]);
                const float ss = wave_sum(x0 * x0 + x1 * x1);
                const float rs = rsqrtf(ss * (1.f / 128.f) + 1e-6f);
                ptr[lane] = f2bf(x0 * rs * p.xq_norm_g[lane]); ptr[lane + 64] = f2bf(x1 * rs * p.xq_norm_g[lane + 64]);
            }
        } else {
            const long i2 = it - n1; const int row = (int)(i2 / 4), j = (int)(i2 % 4);
            bf16_t* ptr = KVM + (size_t)row * 1024 + j * 128;
            const float x0 = bf2f(ptr[lane]), x1 = bf2f(ptr[lane + 64]);
            const float ss = wave_sum(x0 * x0 + x1 * x1);
            const float rs = rsqrtf(ss * (1.f / 128.f) + 1e-6f);
            ptr[lane] = f2bf(x0 * rs * p.xk_norm_g[lane]); ptr[lane + 64] = f2bf(x1 * rs * p.xk_norm_g[lane + 64]);
        }
    }
}

DI void rwkv_stage(const Params& p, int b, int h, int t0, int ntok, float* ck, float* scratch  ) {
    const bf16_t* P = (const bf16_t*)(p.ws + OFF_P);
    const int lane = threadIdx.x & 63, wid = threadIdx.x >> 6, ch = h * 64 + lane;
    const float mu_r = p.mu_rkv[ch], mu_k = p.mu_rkv[512 + ch], mu_v = p.mu_rkv[1024 + ch], mu_w = p.mu_wa[lane], mu_a = p.mu_wa[64 + lane];
    const float w0c = p.w0[ch], a0c = p.a0[ch], kkc = p.k_k[ch], kac = p.k_a[ch];
    float* sc = scratch + wid * 128;
    for (int i = wid; i < ntok; i += NWAVES) {
        const int t = t0 + i; const bf16_t* pr = P + (size_t)(b * T + t) * NP; const bf16_t* pp = pr - NP; const bool hp = t > 0;
        const float rc = bf2f(pr[C_R + ch]), rp = hp ? bf2f(pp[C_R + ch]) : 0.f;
        const float kc = bf2f(pr[C_K + ch]), kp = hp ? bf2f(pp[C_K + ch]) : 0.f;
        const float vc = bf2f(pr[C_V + ch]), vp = hp ? bf2f(pp[C_V + ch]) : 0.f;
        const float wc = bf2f(pr[C_W + lane]), wp = hp ? bf2f(pp[C_W + lane]) : 0.f;
        const float ac = bf2f(pr[C_A + lane]), ap = hp ? bf2f(pp[C_A + lane]) : 0.f;
        const float r = rc + (rp - rc) * mu_r, k = kc + (kp - kc) * mu_k, v = vc + (vp - vc) * mu_v;
        const float lw = wc + (wp - wc) * mu_w, la = ac + (ap - ac) * mu_a;
        sc[lane] = tanhf(lw); sc[64 + lane] = la;
        float accw = 0.f, acca = 0.f;
#pragma unroll 8
        for (int j = 0; j < 64; ++j) { accw += sc[j] * p.w2[j * 512 + ch]; acca += sc[64 + j] * p.a2[j * 512 + ch]; }
        const float xw = -(w0c + accw);
        const float sp = xw > 20.f ? xw : log1pf(expf(xw));
        const float wlog = -sp - 0.5f;
        const float decay = expf(-expf(wlog));
        const float alpha = 1.f / (1.f + expf(-(a0c + acca)));
        const float kk0 = k * kkc;
        const float n2 = wave_sum(kk0 * kk0);
        const float kk = kk0 / fmaxf(sqrtf(n2), 1e-12f);
        const float k2 = k * (1.f + (alpha - 1.f) * kac);
        float* o = ck + i * 384;
        o[lane] = r; o[64 + lane] = decay; o[128 + lane] = k2; o[192 + lane] = v; o[256 + lane] = -kk; o[320 + lane] = kk * alpha;
    }
}

DI void phase_rwkv_direct(const Params& p, unsigned char* lds, const int bid, const int nb) {
    float* ck = (float*)lds; float* scratch = ck + 64 * 384;
    const int lane = threadIdx.x & 63, wid = threadIdx.x >> 6;
    const bf16_t* P = (const bf16_t*)(p.ws + OFF_P); bf16_t* YA = (bf16_t*)(p.ws + OFF_YA);
    for (int bh = bid; bh < BATCH * 8; bh += nb) {
        const int b = bh >> 3, h = bh & 7, ch = h * 64 + lane;
        float S[64];
#pragma unroll
        for (int k = 0; k < 64; ++k) S[k] = 0.f;
        const float rk = p.r_k[ch], lg = p.lnx_g[ch], lb = p.lnx_b[ch];
        for (int c = 0; c < T / 64; ++c) {
            __syncthreads();
            rwkv_stage(p, b, h, c * 64, 64, ck, scratch);
            __syncthreads();
            if (wid == 0) {
                for (int i = 0; i < 64; ++i) {
                    const float* cc = ck + i * 384;
                    float sa = 0.f;
#pragma unroll
                    for (int k = 0; k < 64; ++k) sa += S[k] * cc[256 + k];
                    const float vv = cc[192 + lane];
#pragma unroll
                    for (int k = 0; k < 64; ++k) S[k] = S[k] * cc[64 + k] + sa * cc[320 + k] + vv * cc[128 + k];
                    float y = 0.f;
#pragma unroll
                    for (int k = 0; k < 64; ++k) y += S[k] * cc[k];
                    const float mean = wave_sum(y) * (1.f / 64.f);
                    const float dy = y - mean;
                    const float var = wave_sum(dy * dy) * (1.f / 64.f);
                    const float yn = dy * rsqrtf(var + 64e-5f) * lg + lb;
                    const float bonus = wave_sum(cc[lane] * cc[128 + lane] * rk) * vv;
                    const int t = c * 64 + i; const size_t row = (size_t)(b * T + t);
                    const float z = bf2f(P[row * NP + C_ZA + ch]);
                    YA[row * 512 + ch] = f2bf((yn + bonus) * siluf_(z));
                }
            }
        }
    }
}

constexpr size_t AF_BYTES = 16384, NF_BYTES = 16384, NCHUNK = 128;
constexpr size_t OFF_AF = 0, OFF_NF = (size_t)16 * NCHUNK * AF_BYTES;
typedef float f32x16 __attribute__((ext_vector_type(16)));
typedef float f32x2 __attribute__((ext_vector_type(2)));

DI unsigned pk2f(float lo, float hi) { typedef float f2_ __attribute__((ext_vector_type(2))); typedef __bf16 b2_ __attribute__((ext_vector_type(2))); return __builtin_bit_cast(unsigned, __builtin_convertvector((f2_){lo, hi}, b2_)); }
DI float quad_sum(float s) {
    s += __int_as_float(__builtin_amdgcn_update_dpp(0, __float_as_int(s), 0xB1, 0xF, 0xF, true));
    s += __int_as_float(__builtin_amdgcn_update_dpp(0, __float_as_int(s), 0x4E, 0xF, 0xF, true));
    return s;
}

DI float rwkv_stage_tok(const Params& p, const bf16_t* P, int b, int h, int t, float* o, float* sc, float mu_r, float mu_k, float mu_v, float mu_w, float mu_a,
                        float w0c, float a0c, float kkc, float kac, float rkc) {
    const int lane = threadIdx.x & 63, ch = h * 64 + lane;
    const bf16_t* pr = P + (size_t)(b * T + t) * NP; const bf16_t* pp = pr - NP; const bool hp = t > 0;
    const float rc = bf2f(pr[C_R + ch]), rp = hp ? bf2f(pp[C_R + ch]) : 0.f;
    const float kc = bf2f(pr[C_K + ch]), kp = hp ? bf2f(pp[C_K + ch]) : 0.f;
    const float vc = bf2f(pr[C_V + ch]), vp = hp ? bf2f(pp[C_V + ch]) : 0.f;
    const float wc = bf2f(pr[C_W + lane]), wp = hp ? bf2f(pp[C_W + lane]) : 0.f;
    const float ac = bf2f(pr[C_A + lane]), ap = hp ? bf2f(pp[C_A + lane]) : 0.f;
    const float r = rc + (rp - rc) * mu_r, k = kc + (kp - kc) * mu_k, v = vc + (vp - vc) * mu_v;
    const float lw = wc + (wp - wc) * mu_w, la = ac + (ap - ac) * mu_a;
    sc[lane] = tanhf(lw); sc[64 + lane] = la;
    float accw = 0.f, acca = 0.f;
    const float* w2p = p.w2; const float* a2p = p.a2;
    asm volatile("" : "+s"(w2p), "+s"(a2p));
#pragma unroll 8
    for (int j = 0; j < 64; ++j) { accw += sc[j] * w2p[j * 512 + ch]; acca += sc[64 + j] * a2p[j * 512 + ch]; }
    const float xw = -(w0c + accw);
    const float sp = xw > 20.f ? xw : log1pf(expf(xw));
    const float decay = expf(-expf(-sp - 0.5f));
    const float alpha = 1.f / (1.f + expf(-(a0c + acca)));
    const float kk0 = k * kkc;
    const float n2 = wave_sum(kk0 * kk0);
    const float kk = kk0 / fmaxf(sqrtf(n2), 1e-12f);
    const float k2 = k * (1.f + (alpha - 1.f) * kac);
    o[lane] = r; o[64 + lane] = decay; o[128 + lane] = k2; o[192 + lane] = v; o[256 + lane] = -kk; o[320 + lane] = kk * alpha;
    return wave_sum(r * k2 * rkc);
}

typedef float f32x4_t __attribute__((ext_vector_type(4)));
DI float row16_sum(float x) {
    x += __int_as_float(__builtin_amdgcn_update_dpp(0, __float_as_int(x), 0x128, 0xF, 0xF, true));
    x += __int_as_float(__builtin_amdgcn_update_dpp(0, __float_as_int(x), 0x124, 0xF, 0xF, true));
    x += __int_as_float(__builtin_amdgcn_update_dpp(0, __float_as_int(x), 0x122, 0xF, 0xF, true));
    x += __int_as_float(__builtin_amdgcn_update_dpp(0, __float_as_int(x), 0x121, 0xF, 0xF, true));
    return x;
}
DI void build_lora_frags(const Params& p, int h, unsigned char* bfrag) {
    for (int fidx = threadIdx.x; fidx < 1024; fidx += NTHREADS) {
        const int mat = fidx >> 9, nt = (fidx >> 7) & 3, ks = (fidx >> 6) & 1, l = fidx & 63, n = l & 15, kg = l >> 4;
        const float* W = (mat ? p.a2 : p.w2) + (size_t)(32 * ks + 8 * kg) * 512 + h * 64 + 16 * nt + n;
        unsigned w[4];
#pragma unroll
        for (int e2 = 0; e2 < 4; ++e2) w[e2] = (unsigned)f2bf(W[(2 * e2) * 512]) | ((unsigned)f2bf(W[(2 * e2 + 1) * 512]) << 16);
        *(uint4*)(bfrag + fidx * 16) = make_uint4(w[0], w[1], w[2], w[3]);
    }
}
template <int PART, int RS, bool R3>
DI void stage16(const Params& p, const bf16_t* P, int b, int h, int tg0, int tg1, int tg2, int tg3, float* recs, const unsigned char* bfrag) {
    asm volatile("" : "+s"(h));
    const int lane = threadIdx.x & 63, n = lane & 15, rg = lane >> 4;
    constexpr int FIELD = PART == 0 ? 0 : 128;
    {
        const float mu = PART == 0 ? p.mu_wa[lane] : p.mu_wa[64 + lane];
        const int colx = (PART == 0 ? C_W : C_A) + lane;
#pragma unroll
        for (int gi = 0; gi < 4; ++gi) {
            const int t0 = gi == 0 ? tg0 : gi == 1 ? tg1 : gi == 2 ? tg2 : tg3;
            const bf16_t* base = P + (size_t)(b * T + t0) * NP + colx;
            float prev = t0 > 0 ? bf2f(base[-NP]) : 0.f;
#pragma unroll
            for (int rr = 0; rr < 4; ++rr) {
                const float cur = bf2f(base[rr * NP]);
                const float x = cur + (prev - cur) * mu; prev = cur;
                float val = x;
                if (PART == 0) { const float e2 = __expf(2.f * x); val = 1.f - 2.f * __builtin_amdgcn_rcpf(1.f + e2); }
                *(bf16_t*)((unsigned char*)(recs + (gi * 4 + rr) * RS + FIELD) + 2 * lane) = f2bf(val);
            }
        }
    }
    f32x4 acc[4];
#pragma unroll
    for (int nt = 0; nt < 4; ++nt) acc[nt] = (f32x4){0.f, 0.f, 0.f, 0.f};
#pragma unroll
    for (int ks = 0; ks < 2; ++ks) {
        const bf16x8 af = *(const bf16x8*)((const unsigned char*)(recs + n * RS + FIELD) + ks * 64 + rg * 16);
#pragma unroll
        for (int nt = 0; nt < 4; ++nt) {
            const bf16x8 bfr = *(const bf16x8*)(bfrag + (((PART * 4 + nt) * 2 + ks) * 64 + lane) * 16);
            acc[nt] = __builtin_amdgcn_mfma_f32_16x16x32_bf16(af, bfr, acc[nt], 0, 0, 0);
        }
    }
    const int tgl = rg == 0 ? tg0 : rg == 1 ? tg1 : rg == 2 ? tg2 : tg3;
    const bf16_t* rowb = P + (size_t)(b * T + tgl) * NP;
    float* rec0 = recs + (4 * rg) * RS;
    const bool hp = tgl > 0;
    if (PART == 0) {
#pragma unroll
        for (int nt = 0; nt < 4; ++nt) {
            const int cl = 16 * nt + n, ch = h * 64 + cl;
            const float mu_r = p.mu_rkv[ch], mu_v = p.mu_rkv[1024 + ch], w0c = p.w0[ch];
            float rp = hp ? bf2f(rowb[-NP + C_R + ch]) : 0.f, vp = hp ? bf2f(rowb[-NP + C_V + ch]) : 0.f;
#pragma unroll
            for (int rr = 0; rr < 4; ++rr) {
                const float rc = bf2f(rowb[rr * NP + C_R + ch]), vc = bf2f(rowb[rr * NP + C_V + ch]);
                const float r = rc + (rp - rc) * mu_r, v = vc + (vp - vc) * mu_v; rp = rc; vp = vc;
                const float xw = -(w0c + acc[nt][rr]);
                const float sp = xw > 20.f ? xw : __logf(1.f + __expf(xw));
                const float decay = __expf(-__expf(-sp - 0.5f));
                float* o = rec0 + rr * RS;
                o[cl] = r; o[64 + cl] = decay; o[192 + cl] = v;
                if (R3) o[384 + cl] = bf2f(rowb[rr * NP + C_ZA + ch]);
            }
        }
    } else {
        float kv[4][4], kk0[4][4], al[4][4], rv[4][4], n2[4] = {0.f, 0.f, 0.f, 0.f};
#pragma unroll
        for (int nt = 0; nt < 4; ++nt) {
            const int ch = h * 64 + 16 * nt + n;
            const float mu_k = p.mu_rkv[512 + ch], mu_r = p.mu_rkv[ch], a0c = p.a0[ch], kkc = p.k_k[ch];
            float kp = hp ? bf2f(rowb[-NP + C_K + ch]) : 0.f, rp = (R3 && hp) ? bf2f(rowb[-NP + C_R + ch]) : 0.f;
#pragma unroll
            for (int rr = 0; rr < 4; ++rr) {
                const float kc = bf2f(rowb[rr * NP + C_K + ch]);
                const float k = kc + (kp - kc) * mu_k; kp = kc;
                if (R3) { const float rc = bf2f(rowb[rr * NP + C_R + ch]); rv[nt][rr] = rc + (rp - rc) * mu_r; rp = rc; }
                kv[nt][rr] = k; kk0[nt][rr] = k * kkc; n2[rr] += kk0[nt][rr] * kk0[nt][rr];
                al[nt][rr] = __builtin_amdgcn_rcpf(1.f + __expf(-(a0c + acc[nt][rr])));
            }
        }
        float inv[4], bon[4] = {0.f, 0.f, 0.f, 0.f};
#pragma unroll
        for (int rr = 0; rr < 4; ++rr) inv[rr] = 1.f / fmaxf(sqrtf(row16_sum(n2[rr])), 1e-12f);
#pragma unroll
        for (int nt = 0; nt < 4; ++nt) {
            const int cl = 16 * nt + n, ch = h * 64 + cl;
            const float kac = p.k_a[ch], rkc = p.r_k[ch];
#pragma unroll
            for (int rr = 0; rr < 4; ++rr) {
                const float kk = kk0[nt][rr] * inv[rr], k2 = kv[nt][rr] * (1.f + (al[nt][rr] - 1.f) * kac);
                float* o = rec0 + rr * RS;
                o[128 + cl] = k2; o[256 + cl] = -kk; o[320 + cl] = kk * al[nt][rr];
                if (R3) bon[rr] += rv[nt][rr] * k2 * rkc;
            }
        }
        if (R3) {
#pragma unroll
            for (int rr = 0; rr < 4; ++rr) { const float bs = row16_sum(bon[rr]); if (n == 0) rec0[rr * RS + 448] = bs; }
        }
    }
}

template <int MODE> DI void rwkv_step(float (&z)[4][16], const float* cc, int q, int g, float (&sa)[4]) {
    f32x4 av[4], wv[4], bv[4], kv[4];
#pragma unroll
    for (int u = 0; u < 4; ++u) { av[u] = *(const f32x4*)(cc + 256 + 16 * q + 4 * u); wv[u] = *(const f32x4*)(cc + 64 + 16 * q + 4 * u); bv[u] = *(const f32x4*)(cc + 320 + 16 * q + 4 * u);
        if (MODE == 1) kv[u] = *(const f32x4*)(cc + 128 + 16 * q + 4 * u); }
    f32x4 vr = (f32x4){0.f, 0.f, 0.f, 0.f};
    if (MODE == 1) vr = *(const f32x4*)(cc + 192 + 4 * g);
#pragma unroll
    for (int rr = 0; rr < 4; ++rr) {
        float s0 = 0.f, s1 = 0.f;
#pragma unroll
        for (int u = 0; u < 4; ++u) { s0 += z[rr][4 * u] * av[u][0] + z[rr][4 * u + 2] * av[u][2]; s1 += z[rr][4 * u + 1] * av[u][1] + z[rr][4 * u + 3] * av[u][3]; }
        sa[rr] = quad_sum(s0 + s1);
    }
#pragma unroll
    for (int rr = 0; rr < 4; ++rr)
#pragma unroll
        for (int u = 0; u < 4; ++u)
#pragma unroll
            for (int e = 0; e < 4; ++e) {
                float t = sa[rr] * bv[u][e];
                if (MODE == 1) t += vr[rr] * kv[u][e];
                z[rr][4 * u + e] = z[rr][4 * u + e] * wv[u][e] + t;
            }
}

DI void phase_rwkv_prep(const Params& p, unsigned char* lds, const int bid, const int nb) {
    float* ck = (float*)lds; unsigned char* bfrag = lds + 64 * 384 * 4; float* mat = (float*)lds;
    const bf16_t* P = (const bf16_t*)(p.ws + OFF_P);
    unsigned char* fr = (unsigned char*)p.out;
    const int tid = threadIdx.x, lane = tid & 63, wid = tid >> 6, q = lane & 3, g = lane >> 2, cl = wid & 3, role = wid >> 2;
    for (int item = bid; item < 512; item += nb) {
        const int bh = item >> 5, cq = item & 31, b = bh >> 3, h = bh & 7;
        __syncthreads();
        build_lora_frags(p, h, bfrag);
        float z[4][16];
#pragma unroll
        for (int rr = 0; rr < 4; ++rr)
#pragma unroll
            for (int c = 0; c < 16; ++c) z[rr][c] = (role == 0 && (4 * g + rr) == (16 * q + c)) ? 1.f : 0.f;
        for (int sl = 0; sl < 4; ++sl) {
            __syncthreads();
            {
                const int tb = (cq * 4 + cl) * 64 + sl * 16;
                if (role == 0) stage16<0, 384, false>(p, P, b, h, tb, tb + 4, tb + 8, tb + 12, ck + cl * 16 * 384, bfrag);
                else           stage16<1, 384, false>(p, P, b, h, tb, tb + 4, tb + 8, tb + 12, ck + cl * 16 * 384, bfrag);
            }
            __syncthreads();
            float sa[4];
            if (role == 0) {
#pragma unroll 1
                for (int i = 0; i < 16; ++i) rwkv_step<0>(z, ck + (cl * 16 + i) * 384, q, g, sa); }
            else {
#pragma unroll 1
                for (int i = 0; i < 16; ++i) rwkv_step<1>(z, ck + (cl * 16 + i) * 384, q, g, sa); }
        }
        for (int pass = 0; pass < 2; ++pass) {
            __syncthreads();
            if (role == pass) {
#pragma unroll
                for (int rr = 0; rr < 4; ++rr)
#pragma unroll
                    for (int u = 0; u < 4; ++u) *(f32x4*)(mat + (cl * 64 + 4 * g + rr) * 68 + 16 * q + 4 * u) = (f32x4){z[rr][4 * u], z[rr][4 * u + 1], z[rr][4 * u + 2], z[rr][4 * u + 3]};
            }
            __syncthreads();
            if (pass == 0) {
                for (int it = tid; it < 4 * 8 * 64; it += NTHREADS) {
                    const int clx = it >> 9, f = (it >> 6) & 7, l = it & 63, r = l & 31, hh = l >> 5, fi = f >> 2, fj = (f >> 1) & 1, fs = f & 1;
                    const size_t chunk = (size_t)bh * NCHUNK + cq * 4 + clx;
                    unsigned hi[4], lo[4];
#pragma unroll
                    for (int e2 = 0; e2 < 4; ++e2) {
                        unsigned short hs[2], ls[2];
#pragma unroll
                        for (int d = 0; d < 2; ++d) { const int e = 2 * e2 + d, kin = 32 * fj + 16 * fs + 8 * (e >> 2) + 4 * hh + (e & 3), kout = 32 * fi + r;
                            const float val = mat[(clx * 64 + kin) * 68 + kout]; hs[d] = f2bf(val); ls[d] = f2bf(val - bf2f(hs[d])); }
                        hi[e2] = (unsigned)hs[0] | ((unsigned)hs[1] << 16); lo[e2] = (unsigned)ls[0] | ((unsigned)ls[1] << 16);
                    }
                    unsigned char* dst = fr + OFF_AF + chunk * AF_BYTES + (size_t)((f * 2) * 64 + l) * 16;
                    *(uint4*)dst = make_uint4(hi[0], hi[1], hi[2], hi[3]);
                    *(uint4*)(dst + 64 * 16) = make_uint4(lo[0], lo[1], lo[2], lo[3]);
                }
            } else {
                for (int it = tid; it < 4 * 2 * 2 * 64 * 4; it += NTHREADS) {
                    const int gq = it & 3, l = (it >> 2) & 63, fi = (it >> 8) & 1, w2 = (it >> 9) & 1, clx = it >> 10, hh = l >> 5;
                    const size_t chunk = (size_t)bh * NCHUNK + cq * 4 + clx;
                    const f32x4 v4 = *(const f32x4*)(mat + (clx * 64 + 32 * w2 + (l & 31)) * 68 + 32 * fi + 8 * gq + 4 * hh);
                    *(f32x4*)(fr + OFF_NF + chunk * NF_BYTES + (size_t)(((w2 * 2 + fi) * 64 + l) * 16 + 4 * gq) * 4) = v4;
                }
            }
        }
    }
}

DI void split8(const f32x16& x, int s, bf16x8& hi, bf16x8& lo) {
#pragma unroll
    for (int e = 0; e < 8; ++e) { const float v = x[8 * s + e]; const bf16_t hb = f2bf(v); hi[e] = (short)hb; lo[e] = (short)f2bf(v - bf2f(hb)); }
}
DI void phase_rwkv_scan(const Params& p, unsigned char* lds, const int bh) {
    unsigned char* fr = (unsigned char*)p.out;
    const int tid = threadIdx.x, lane = tid & 63, wid = tid >> 6;
    const unsigned char* gA = fr + OFF_AF + (size_t)bh * NCHUNK * AF_BYTES;
    unsigned char* gN = fr + OFF_NF + (size_t)bh * NCHUNK * NF_BYTES;
    __syncthreads();
    for (int c = 0; c < 3; ++c)
        for (int e = tid; e < 2048; e += NTHREADS) {
            const uint4 v = e < 1024 ? *(const uint4*)(gA + (size_t)c * AF_BYTES + e * 16) : *(const uint4*)(gN + (size_t)c * NF_BYTES + (e - 1024) * 16);
            *(uint4*)(lds + c * 32768 + e * 16) = v;
        }
    const int ltid = tid - 128;
    const bool loader = (wid >= 2 && wid < 6);
    uint4 la0, la1, la2, la3, ln0, ln1, ln2, ln3;
#define SCAN_LOAD(cc_) do { const unsigned char* a_ = gA + (size_t)(cc_) * AF_BYTES + ltid * 16; const unsigned char* n_ = gN + (size_t)(cc_) * NF_BYTES + ltid * 16; \
        la0 = *(const uint4*)a_; la1 = *(const uint4*)(a_ + 4096); la2 = *(const uint4*)(a_ + 8192); la3 = *(const uint4*)(a_ + 12288); \
        ln0 = *(const uint4*)n_; ln1 = *(const uint4*)(n_ + 4096); ln2 = *(const uint4*)(n_ + 8192); ln3 = *(const uint4*)(n_ + 12288); } while (0)
#define SCAN_WRITE(slot_) do { unsigned char* d_ = lds + (slot_) * 32768 + ltid * 16; \
        *(uint4*)d_ = la0; *(uint4*)(d_ + 4096) = la1; *(uint4*)(d_ + 8192) = la2; *(uint4*)(d_ + 12288) = la3; \
        *(uint4*)(d_ + 16384) = ln0; *(uint4*)(d_ + 20480) = ln1; *(uint4*)(d_ + 24576) = ln2; *(uint4*)(d_ + 28672) = ln3; } while (0)
    if (loader) SCAN_LOAD(3);
    f32x16 X0, X1;
#pragma unroll
    for (int i = 0; i < 16; ++i) { X0[i] = 0.f; X1[i] = 0.f; }
    for (int c = 0; c < (int)NCHUNK; ++c) {
        asm volatile("s_waitcnt lgkmcnt(0)" ::: "memory"); __builtin_amdgcn_s_barrier(); asm volatile("" ::: "memory");
        if (wid >= 2) {
            if (loader) {
                if (c + 3 < (int)NCHUNK) SCAN_WRITE((c + 3) & 3);
                if (c + 4 < (int)NCHUNK) SCAN_LOAD(c + 4);
            }
        } else {
            const int w2 = wid;
            const unsigned char* slot = lds + (c & 3) * 32768;
            float* gs = (float*)(gN + (size_t)c * NF_BYTES) + ((w2 * 2) * 64 + lane) * 16;
#pragma unroll
            for (int gq = 0; gq < 4; ++gq) { *(f32x4*)(gs + 4 * gq) = (f32x4){X0[4 * gq], X0[4 * gq + 1], X0[4 * gq + 2], X0[4 * gq + 3]};
                                             *(f32x4*)(gs + 64 * 16 + 4 * gq) = (f32x4){X1[4 * gq], X1[4 * gq + 1], X1[4 * gq + 2], X1[4 * gq + 3]}; }
            bf16x8 bhi[2][2], blo[2][2];
            split8(X0, 0, bhi[0][0], blo[0][0]); split8(X0, 1, bhi[0][1], blo[0][1]); split8(X1, 0, bhi[1][0], blo[1][0]); split8(X1, 1, bhi[1][1], blo[1][1]);
            f32x16 Dn[2];
#pragma unroll
            for (int i = 0; i < 2; ++i) {
                const float* np = (const float*)(slot + 16384) + ((w2 * 2 + i) * 64 + lane) * 16;
#pragma unroll
                for (int gq = 0; gq < 4; ++gq) { const f32x4 v4 = *(const f32x4*)(np + 4 * gq); Dn[i][4 * gq] = v4[0]; Dn[i][4 * gq + 1] = v4[1]; Dn[i][4 * gq + 2] = v4[2]; Dn[i][4 * gq + 3] = v4[3]; }
#pragma unroll
                for (int j = 0; j < 2; ++j)
#pragma unroll
                    for (int s = 0; s < 2; ++s) {
                        const int f = (i * 2 + j) * 2 + s;
                        const bf16x8 ah = *(const bf16x8*)(slot + ((f * 2) * 64 + lane) * 16), al = *(const bf16x8*)(slot + ((f * 2 + 1) * 64 + lane) * 16);
                        Dn[i] = __builtin_amdgcn_mfma_f32_32x32x16_bf16(ah, bhi[j][s], Dn[i], 0, 0, 0);
                        Dn[i] = __builtin_amdgcn_mfma_f32_32x32x16_bf16(ah, blo[j][s], Dn[i], 0, 0, 0);
                        Dn[i] = __builtin_amdgcn_mfma_f32_32x32x16_bf16(al, bhi[j][s], Dn[i], 0, 0, 0);
                    }
            }
            X0 = Dn[0]; X1 = Dn[1];
        }
    }
}

constexpr int RS3 = 464;
DI void phase_rwkv_out(const Params& p, unsigned char* lds, const int bid, const int nb) {
    const bf16_t* P = (const bf16_t*)(p.ws + OFF_P); bf16_t* YA = (bf16_t*)(p.ws + OFF_YA);
    const unsigned char* fr = (const unsigned char*)p.out;
    const int tid = threadIdx.x, lane = tid & 63, wid = tid >> 6, q = lane & 3, g = lane >> 2, pm = wid >> 1, part = wid & 1;
    float* ck = (float*)lds; unsigned char* bfrag = lds + 64 * RS3 * 4;
    for (int item = bid; item < 256; item += nb) {
        const int bh = item >> 4, co = item & 15, b = bh >> 3, h = bh & 7, c = co * 8 + wid, cA = co * 8 + 2 * pm;
        __syncthreads();
        build_lora_frags(p, h, bfrag);
        const int vo = 4 * g + q;
        float z[4][16];
        {
            const float* sf = (const float*)(fr + OFF_NF + ((size_t)bh * NCHUNK + c) * NF_BYTES);
#pragma unroll
            for (int rr = 0; rr < 4; ++rr) { const int v = 4 * g + rr, w2 = v >> 5, vl = v & 31, fi = q >> 1;
#pragma unroll
                for (int u = 0; u < 4; ++u) { const int hh = u & 1, r0 = 4 * (2 * (q & 1) + (u >> 1));
                    const f32x4 v4 = *(const f32x4*)(sf + ((w2 * 2 + fi) * 64 + vl + 32 * hh) * 16 + r0);
                    z[rr][4 * u] = v4[0]; z[rr][4 * u + 1] = v4[1]; z[rr][4 * u + 2] = v4[2]; z[rr][4 * u + 3] = v4[3]; } }
        }
#pragma unroll 1
        for (int sl = 0; sl < 8; ++sl) {
            __syncthreads();
            {
                const int ta = cA * 64 + sl * 8, tb = ta + 64;
                if (part == 0) stage16<0, RS3, true>(p, P, b, h, ta, ta + 4, tb, tb + 4, ck + pm * 16 * RS3, bfrag);
                else           stage16<1, RS3, true>(p, P, b, h, ta, ta + 4, tb, tb + 4, ck + pm * 16 * RS3, bfrag);
            }
            __syncthreads();
#pragma unroll 1
            for (int i = 0; i < 8; ++i) {
                float* cc = ck + (wid * 8 + i) * RS3; float sa[4];
                rwkv_step<1>(z, cc, q, g, sa);
                f32x4 rv[4];
#pragma unroll
                for (int u = 0; u < 4; ++u) rv[u] = *(const f32x4*)(cc + 16 * q + 4 * u);
                float y[4];
#pragma unroll
                for (int rr = 0; rr < 4; ++rr) { float s0 = 0.f;
#pragma unroll
                    for (int u = 0; u < 4; ++u) s0 += z[rr][4 * u] * rv[u][0] + z[rr][4 * u + 1] * rv[u][1] + z[rr][4 * u + 2] * rv[u][2] + z[rr][4 * u + 3] * rv[u][3];
                    y[rr] = quad_sum(s0); }
                cc[vo] = q == 0 ? y[0] : q == 1 ? y[1] : q == 2 ? y[2] : y[3];
            }
            {
                const int i = lane >> 3, pt = lane & 7;
                const float* cc = ck + (wid * 8 + i) * RS3;
                const f32x4 ya = *(const f32x4*)(cc + 8 * pt), yb = *(const f32x4*)(cc + 8 * pt + 4);
                float s1 = (ya[0] + ya[1]) + (ya[2] + ya[3]) + (yb[0] + yb[1]) + (yb[2] + yb[3]);
                s1 = quad_sum(s1); s1 += __int_as_float(__builtin_amdgcn_update_dpp(0, __float_as_int(s1), 0x141, 0xF, 0xF, true));
                const float mean = s1 * (1.f / 64.f);
                float dd[8];
#pragma unroll
                for (int e = 0; e < 4; ++e) { dd[e] = ya[e] - mean; dd[4 + e] = yb[e] - mean; }
                float s2 = 0.f;
#pragma unroll
                for (int e = 0; e < 8; ++e) s2 += dd[e] * dd[e];
                s2 = quad_sum(s2); s2 += __int_as_float(__builtin_amdgcn_update_dpp(0, __float_as_int(s2), 0x141, 0xF, 0xF, true));
                const float rstd = rsqrtf(s2 * (1.f / 64.f) + 64e-5f), bon = cc[448];
                const f32x4 va = *(const f32x4*)(cc + 192 + 8 * pt), vb = *(const f32x4*)(cc + 196 + 8 * pt), za = *(const f32x4*)(cc + 384 + 8 * pt), zb = *(const f32x4*)(cc + 388 + 8 * pt);
                const f32x4 ga = *(const f32x4*)(p.lnx_g + h * 64 + 8 * pt), gb = *(const f32x4*)(p.lnx_g + h * 64 + 8 * pt + 4), ba = *(const f32x4*)(p.lnx_b + h * 64 + 8 * pt), bb = *(const f32x4*)(p.lnx_b + h * 64 + 8 * pt + 4);
                float o[8];
#pragma unroll
                for (int e = 0; e < 4; ++e) { o[e] = (dd[e] * rstd * ga[e] + ba[e] + bon * va[e]) * siluf_(za[e]); o[4 + e] = (dd[4 + e] * rstd * gb[e] + bb[e] + bon * vb[e]) * siluf_(zb[e]); }
                const int t = c * 64 + sl * 8 + i;
                *(uint4*)(YA + (size_t)(b * T + t) * 512 + h * 64 + 8 * pt) = make_uint4(pk2f(o[0], o[1]), pk2f(o[2], o[3]), pk2f(o[4], o[5]), pk2f(o[6], o[7]));
            }
        }
    }
}

DI void phase_swa_simple(const Params& p, unsigned char* lds, const int bid, const int nb) {
    const bf16_t* P = (const bf16_t*)(p.ws + OFF_P); bf16_t* YB = (bf16_t*)(p.ws + OFF_YB);
    const long total = (long)BATCH * 8 * T;
    for (long it = (long)bid * NTHREADS + threadIdx.x; it < total; it += (long)nb * NTHREADS) {
        const int t = (int)(it % T), qh = (int)((it / T) % 8), b = (int)(it / ((long)T * 8)), kvh = qh >> 2;
        const size_t row = (size_t)(b * T + t);
        float q[64], acc[64];
        {
            const uint4* qp = (const uint4*)(P + row * NP + C_Q + qh * 64);
#pragma unroll
            for (int i = 0; i < 8; ++i) { const uint4 u = qp[i]; const unsigned w[4] = {u.x, u.y, u.z, u.w};
#pragma unroll
                for (int j = 0; j < 4; ++j) { q[i * 8 + j * 2] = __uint_as_float(w[j] << 16); q[i * 8 + j * 2 + 1] = __uint_as_float(w[j] & 0xffff0000u); } }
        }
#pragma unroll
        for (int d = 0; d < 64; ++d) acc[d] = 0.f;
        float m = p.sinks[qh], l = 1.f;
        for (int j = 0; j < 128; ++j) {
            const int s = t - 127 + j;
            if (s < 0) continue;
            const size_t krow = (size_t)(b * T + s) * NP;
            const uint4* kp = (const uint4*)(P + krow + C_SK + kvh * 64);
            float dot = 0.f;
#pragma unroll
            for (int i = 0; i < 8; ++i) { const uint4 u = kp[i]; const unsigned w[4] = {u.x, u.y, u.z, u.w};
#pragma unroll
                for (int jj = 0; jj < 4; ++jj) { dot += q[i * 8 + jj * 2] * __uint_as_float(w[jj] << 16) + q[i * 8 + jj * 2 + 1] * __uint_as_float(w[jj] & 0xffff0000u); } }
            const float sc = dot * 0.125f;
            const float mn = fmaxf(m, sc), corr = __expf(m - mn), pe = __expf(sc - mn);
            l = l * corr + pe; m = mn;
            const uint4* vp = (const uint4*)(P + krow + C_SV + kvh * 64);
#pragma unroll
            for (int i = 0; i < 8; ++i) { const uint4 u = vp[i]; const unsigned w[4] = {u.x, u.y, u.z, u.w};
#pragma unroll
                for (int jj = 0; jj < 4; ++jj) { acc[i * 8 + jj * 2] = acc[i * 8 + jj * 2] * corr + pe * __uint_as_float(w[jj] << 16);
                                                 acc[i * 8 + jj * 2 + 1] = acc[i * 8 + jj * 2 + 1] * corr + pe * __uint_as_float(w[jj] & 0xffff0000u); } }
        }
        const float inv = 1.f / l;
        const bf16_t* zp = P + row * NP + C_ZB + qh * 64; bf16_t* op = YB + row * 512 + qh * 64;
#pragma unroll
        for (int d = 0; d < 64; ++d) op[d] = f2bf(acc[d] * inv * siluf_(bf2f(zp[d])));
    }
}

DI void phase_xattn_simple(const Params& p, unsigned char* lds, const int bid, const int nb) {
    const bf16_t* P = (const bf16_t*)(p.ws + OFF_P); const bf16_t* KVM = (const bf16_t*)(p.ws + OFF_KVM); bf16_t* YC = (bf16_t*)(p.ws + OFF_YC);
    const int lane = threadIdx.x & 63, wid = threadIdx.x >> 6;
    const long total = (long)M * 4;
    const float scale = 0.08838834764831845f;
    for (long it = (long)bid * NWAVES + wid; it < total; it += (long)nb * NWAVES) {
        const int row = (int)(it >> 2), hd = (int)(it & 3), b = row / T;
        const bf16_t* qp = P + (size_t)row * NP + C_XQ + hd * 128;
        const bf16_t* kb = KVM + (size_t)(b * MEMLEN) * 1024 + hd * 128;
        float s[4] = {0.f, 0.f, 0.f, 0.f};
        for (int c = 0; c < 16; ++c) {
            const uint4 qu = *(const uint4*)(qp + c * 8); const unsigned qw[4] = {qu.x, qu.y, qu.z, qu.w};
#pragma unroll
            for (int i = 0; i < 4; ++i) {
                const uint4 ku = *(const uint4*)(kb + (size_t)(lane + 64 * i) * 1024 + c * 8); const unsigned kw[4] = {ku.x, ku.y, ku.z, ku.w};
#pragma unroll
                for (int j = 0; j < 4; ++j) s[i] += __uint_as_float(qw[j] << 16) * __uint_as_float(kw[j] << 16) + __uint_as_float(qw[j] & 0xffff0000u) * __uint_as_float(kw[j] & 0xffff0000u);
            }
        }
        float mx = -1e30f;
#pragma unroll
        for (int i = 0; i < 4; ++i) { s[i] *= scale; mx = fmaxf(mx, s[i]); }
        mx = wave_max(mx);
        float pe[4], sum = 0.f;
#pragma unroll
        for (int i = 0; i < 4; ++i) { pe[i] = __expf(s[i] - mx); sum += pe[i]; }
        sum = wave_sum(sum);
        const float inv = 1.f / sum;
        float o0 = 0.f, o1 = 0.f;
        const bf16_t* vb = kb + 512;
#pragma unroll
        for (int i = 0; i < 4; ++i)
            for (int mm = 0; mm < 64; ++mm) {
                const float pv = __shfl(pe[i], mm, 64);
                const bf16_t* vr = vb + (size_t)(mm + 64 * i) * 1024;
                o0 += pv * bf2f(vr[lane]); o1 += pv * bf2f(vr[lane + 64]);
            }
        const bf16_t* zp = P + (size_t)row * NP + C_ZC + hd * 128; bf16_t* op = YC + (size_t)row * 512 + hd * 128;
        op[lane] = f2bf(o0 * inv * siluf_(bf2f(zp[lane]))); op[lane + 64] = f2bf(o1 * inv * siluf_(bf2f(zp[lane + 64])));
    }
}

#define MFMA32(a, b, c) __builtin_amdgcn_mfma_f32_32x32x16_bf16((a), (b), (c), 0, 0, 0)
typedef short s16x4 __attribute__((ext_vector_type(4)));
DI int crow(int reg, int hh) { return (reg & 3) + 8 * (reg >> 2) + 4 * hh; }
template <int Dh> DI unsigned k_off(int row, int chunk) { return (unsigned)(row * (Dh * 2) + ((chunk ^ (row & (Dh / 8 - 1))) << 4)); }
DI bf16x8 pack8(const f32x16& x, int s) {
    bf16x8 r;
#pragma unroll
    for (int e = 0; e < 8; ++e) r[e] = (short)f2bf(x[8 * s + e]);
    return r;
}
DI unsigned pk2(float lo, float hi) { typedef float f2_ __attribute__((ext_vector_type(2))); typedef __bf16 b2_ __attribute__((ext_vector_type(2))); return __builtin_bit_cast(unsigned, __builtin_convertvector((f2_){lo, hi}, b2_)); }
DI void unpack8(const uint4& v, float (&x)[8]) { const unsigned w[4] = {v.x, v.y, v.z, v.w};
#pragma unroll
    for (int i = 0; i < 4; ++i) { x[2 * i] = __uint_as_float(w[i] << 16); x[2 * i + 1] = __uint_as_float(w[i] & 0xffff0000u); } }
DI uint4 pack8f(const float (&x)[8]) { return make_uint4(pk2(x[0], x[1]), pk2(x[2], x[3]), pk2(x[4], x[5]), pk2(x[6], x[7])); }
constexpr int VS = 528;

DI void swa_unit(const Params& p, unsigned char* lds, int unit) {
    const bf16_t* P = (const bf16_t*)(p.ws + OFF_P); bf16_t* YB = (bf16_t*)(p.ws + OFF_YB);
    int tid = threadIdx.x; asm volatile("" : "+v"(tid));
    const int lane = tid & 63, wid = __builtin_amdgcn_readfirstlane(tid >> 6), c = lane & 31, hh = lane >> 5;
    const int n = unit & 63, kvh = (unit >> 6) & 1, b = unit >> 7;
    unsigned char* Kl = lds; unsigned char* Vt = lds + 32768;
    __syncthreads();
#pragma unroll
    for (int u = 0; u < 4; ++u) {
        const int idx = tid + 512 * u;
        { const int row = idx >> 3, chunk = idx & 7, t = n * 128 - 128 + row, tc = t < 0 ? 0 : t;
          const uint4 v = *(const uint4*)(P + (size_t)(b * T + tc) * NP + C_SK + kvh * 64 + chunk * 8);
          float x[8]; unpack8(v, x);
          float ss = 0.f;
#pragma unroll
          for (int e = 0; e < 8; ++e) ss += x[e] * x[e];
          ss = quad_sum(ss); ss += __shfl_xor(ss, 4, 64);
          const float rs = rsqrtf(ss * (1.f / 64.f) + 1e-6f);
          const float2* rp = (const float2*)(p.ws + OFF_ROPE) + (size_t)(b * T + tc) * 32 + (chunk & 3) * 8;
          float o[8];
#pragma unroll
          for (int e = 0; e < 8; ++e) { const float y = x[e] * rs * p.k_norm_g[chunk * 8 + e]; const float yp = __shfl_xor(y, 4, 64); const float2 cs = rp[e];
              o[e] = chunk < 4 ? y * cs.x - yp * cs.y : y * cs.x + yp * cs.y; if (t < 0) o[e] = 0.f; }
          *(uint4*)(Kl + k_off<64>(row, chunk)) = pack8f(o); }
        { const int key = idx & 255, dch = idx >> 8, t = n * 128 - 128 + key;
          uint4 v = make_uint4(0u, 0u, 0u, 0u);
          if (t >= 0) v = *(const uint4*)(P + (size_t)(b * T + t) * NP + C_SV + kvh * 64 + dch * 8);
          const unsigned w[4] = {v.x, v.y, v.z, v.w};
#pragma unroll
          for (int e = 0; e < 8; ++e) *(bf16_t*)(Vt + (dch * 8 + e) * VS + key * 2) = (bf16_t)(e & 1 ? w[e >> 1] >> 16 : w[e >> 1] & 0xffffu); }
    }
    __syncthreads();
    const int qh = kvh * 4 + (wid >> 1), rh = wid & 1;
    const float sink = p.sinks[qh];
#pragma unroll 1
    for (int rt = 0; rt < 2; ++rt) {
        const int base = 64 * rh + 32 * rt;
        const size_t qrow = (size_t)(b * T + n * 128 + base + c);
        bf16x8 qf[4];
        {
            float xq[4][8]; float ss = 0.f;
#pragma unroll
            for (int ds = 0; ds < 4; ++ds) { unpack8(*(const uint4*)(P + qrow * NP + C_Q + qh * 64 + 16 * ds + 8 * hh), xq[ds]);
#pragma unroll
                for (int e = 0; e < 8; ++e) ss += xq[ds][e] * xq[ds][e]; }
            ss += __shfl_xor(ss, 32, 64);
            const float rs = rsqrtf(ss * (1.f / 64.f) + 1e-6f);
#pragma unroll
            for (int ds = 0; ds < 4; ++ds)
#pragma unroll
                for (int e = 0; e < 8; ++e) xq[ds][e] *= rs * p.q_norm_g[16 * ds + 8 * hh + e];
            const float2* rp = (const float2*)(p.ws + OFF_ROPE) + qrow * 32 + 8 * hh;
#pragma unroll
            for (int ds = 0; ds < 2; ++ds) { float lo[8], hi[8];
#pragma unroll
                for (int e = 0; e < 8; ++e) { const float2 cs = rp[16 * ds + e]; lo[e] = xq[ds][e] * cs.x - xq[ds + 2][e] * cs.y; hi[e] = xq[ds + 2][e] * cs.x + xq[ds][e] * cs.y; }
                qf[ds] = __builtin_bit_cast(bf16x8, pack8f(lo)); qf[ds + 2] = __builtin_bit_cast(bf16x8, pack8f(hi)); }
        }
        f32x16 st[5];
#pragma unroll
        for (int kt = 0; kt < 5; ++kt) {
#pragma unroll
            for (int i = 0; i < 16; ++i) st[kt][i] = 0.f;
#pragma unroll
            for (int ds = 0; ds < 4; ++ds) { const bf16x8 a = *(const bf16x8*)(Kl + k_off<64>(base + 32 * kt + c, 2 * ds + hh)); st[kt] = MFMA32(a, qf[ds], st[kt]); }
        }
        float mx = sink;
#pragma unroll
        for (int kt = 0; kt < 5; ++kt)
#pragma unroll
            for (int i = 0; i < 16; ++i) {
                const int cr = crow(i, hh);
                bool ok = true;
                if (kt == 0) ok = cr > c;
                if (kt == 4) ok = cr <= c;
                if (n == 0) ok = ok && (base + 32 * kt + cr >= 128);
                const float s = ok ? st[kt][i] * 0.125f : -1e30f;
                st[kt][i] = s; mx = fmaxf(mx, s);
            }
        mx = fmaxf(mx, __shfl_xor(mx, 32, 64));
        float ls = 0.f;
#pragma unroll
        for (int kt = 0; kt < 5; ++kt)
#pragma unroll
            for (int i = 0; i < 16; ++i) { const float pe = __expf(st[kt][i] - mx); st[kt][i] = pe; ls += pe; }
        ls += __shfl_xor(ls, 32, 64);
        const float inv = 1.f / (ls + __expf(sink - mx));
        f32x16 ot[2];
#pragma unroll
        for (int dt = 0; dt < 2; ++dt)
#pragma unroll
            for (int i = 0; i < 16; ++i) ot[dt][i] = 0.f;
#pragma unroll
        for (int kt = 0; kt < 5; ++kt)
#pragma unroll
            for (int s = 0; s < 2; ++s) {
                const bf16x8 pf = pack8(st[kt], s);
#pragma unroll
                for (int dt = 0; dt < 2; ++dt) {
                    const unsigned char* vp = Vt + (32 * dt + c) * VS + (base + 32 * kt + 16 * s + 4 * hh) * 2;
                    const s16x4 lo = *(const s16x4*)vp, hi = *(const s16x4*)(vp + 16);
                    const bf16x8 vf = __builtin_shufflevector(lo, hi, 0, 1, 2, 3, 4, 5, 6, 7);
                    ot[dt] = MFMA32(vf, pf, ot[dt]);
                }
            }
        const bf16_t* zp = P + qrow * NP + C_ZB + qh * 64; bf16_t* op = YB + qrow * 512 + qh * 64;
#pragma unroll
        for (int dt = 0; dt < 2; ++dt)
#pragma unroll
            for (int gq = 0; gq < 4; ++gq) {
                const int d0 = 32 * dt + 8 * gq + 4 * hh;
                const uint2 zz = *(const uint2*)(zp + d0);
                const float z0 = __uint_as_float(zz.x << 16), z1 = __uint_as_float(zz.x & 0xffff0000u), z2 = __uint_as_float(zz.y << 16), z3 = __uint_as_float(zz.y & 0xffff0000u);
                const unsigned o0 = (unsigned)f2bf(ot[dt][4 * gq] * inv * siluf_(z0)) | ((unsigned)f2bf(ot[dt][4 * gq + 1] * inv * siluf_(z1)) << 16);
                const unsigned o1 = (unsigned)f2bf(ot[dt][4 * gq + 2] * inv * siluf_(z2)) | ((unsigned)f2bf(ot[dt][4 * gq + 3] * inv * siluf_(z3)) << 16);
                *(uint2*)(op + d0) = make_uint2(o0, o1);
            }
    }
}

DI void xattn_unit(const Params& p, unsigned char* lds, int unit) {
    const bf16_t* P = (const bf16_t*)(p.ws + OFF_P); const bf16_t* KVM = (const bf16_t*)(p.ws + OFF_KVM); bf16_t* YC = (bf16_t*)(p.ws + OFF_YC);
    int tid = threadIdx.x; asm volatile("" : "+v"(tid));
    const int lane = tid & 63, wid = __builtin_amdgcn_readfirstlane(tid >> 6), c = lane & 31, hh = lane >> 5;
    const int qb = unit & 31, hd = (unit >> 5) & 3, b = unit >> 7;
    unsigned char* Kl = lds; unsigned char* Vt = lds + 65536;
    const bf16_t* kb = KVM + (size_t)(b * MEMLEN) * 1024 + hd * 128;
    __syncthreads();
#pragma unroll
    for (int u = 0; u < 8; ++u) {
        const int idx = tid + 512 * u;
        { const int row = idx >> 4, chunk = idx & 15;
          float x[8]; unpack8(*(const uint4*)(kb + (size_t)row * 1024 + chunk * 8), x);
          float ss = 0.f;
#pragma unroll
          for (int e = 0; e < 8; ++e) ss += x[e] * x[e];
          const float rs = rsqrtf(row16_sum(ss) * (1.f / 128.f) + 1e-6f);
#pragma unroll
          for (int e = 0; e < 8; ++e) x[e] *= rs * p.xk_norm_g[chunk * 8 + e];
          *(uint4*)(Kl + k_off<128>(row, chunk)) = pack8f(x); }
        { const int key = idx & 255, dch = idx >> 8;
          const uint4 v = *(const uint4*)(kb + (size_t)key * 1024 + 512 + dch * 8);
          const unsigned w[4] = {v.x, v.y, v.z, v.w};
#pragma unroll
          for (int e = 0; e < 8; ++e) *(bf16_t*)(Vt + (dch * 8 + e) * VS + key * 2) = (bf16_t)(e & 1 ? w[e >> 1] >> 16 : w[e >> 1] & 0xffffu); }
    }
    __syncthreads();
    const size_t qrow = (size_t)(b * T + qb * 256 + wid * 32 + c);
    const float scale = 0.08838834764831845f;
    bf16x8 qf[8];
    {
        float ss = 0.f; uint4 raw[8];
#pragma unroll
        for (int ds = 0; ds < 8; ++ds) { raw[ds] = *(const uint4*)(P + qrow * NP + C_XQ + hd * 128 + 16 * ds + 8 * hh); float x[8]; unpack8(raw[ds], x);
#pragma unroll
            for (int e = 0; e < 8; ++e) ss += x[e] * x[e]; }
        ss += __shfl_xor(ss, 32, 64);
        const float rs = rsqrtf(ss * (1.f / 128.f) + 1e-6f);
#pragma unroll
        for (int ds = 0; ds < 8; ++ds) { float x[8]; unpack8(raw[ds], x);
#pragma unroll
            for (int e = 0; e < 8; ++e) x[e] *= rs * p.xq_norm_g[16 * ds + 8 * hh + e];
            qf[ds] = __builtin_bit_cast(bf16x8, pack8f(x)); }
    }
    f32x16 ot[4];
#pragma unroll
    for (int dt = 0; dt < 4; ++dt)
#pragma unroll
        for (int i = 0; i < 16; ++i) ot[dt][i] = 0.f;
    float mrun = -1e30f, lrun = 0.f;
#pragma unroll 1
    for (int half = 0; half < 2; ++half) {
        f32x16 st[4];
#pragma unroll
        for (int kt = 0; kt < 4; ++kt) {
#pragma unroll
            for (int i = 0; i < 16; ++i) st[kt][i] = 0.f;
#pragma unroll
            for (int ds = 0; ds < 8; ++ds) { const bf16x8 a = *(const bf16x8*)(Kl + k_off<128>(128 * half + 32 * kt + c, 2 * ds + hh)); st[kt] = MFMA32(a, qf[ds], st[kt]); }
        }
        float mx = mrun;
#pragma unroll
        for (int kt = 0; kt < 4; ++kt)
#pragma unroll
            for (int i = 0; i < 16; ++i) { st[kt][i] *= scale; mx = fmaxf(mx, st[kt][i]); }
        mx = fmaxf(mx, __shfl_xor(mx, 32, 64));
        const float corr = __expf(mrun - mx);
        float ls = 0.f;
#pragma unroll
        for (int kt = 0; kt < 4; ++kt)
#pragma unroll
            for (int i = 0; i < 16; ++i) { const float pe = __expf(st[kt][i] - mx); st[kt][i] = pe; ls += pe; }
        ls += __shfl_xor(ls, 32, 64);
        lrun = lrun * corr + ls; mrun = mx;
#pragma unroll
        for (int dt = 0; dt < 4; ++dt)
#pragma unroll
            for (int i = 0; i < 16; ++i) ot[dt][i] *= corr;
#pragma unroll
        for (int kt = 0; kt < 4; ++kt)
#pragma unroll
            for (int s = 0; s < 2; ++s) {
                const bf16x8 pf = pack8(st[kt], s);
#pragma unroll
                for (int dt = 0; dt < 4; ++dt) {
                    const unsigned char* vp = Vt + (32 * dt + c) * VS + (128 * half + 32 * kt + 16 * s + 4 * hh) * 2;
                    const s16x4 lo = *(const s16x4*)vp, hi = *(const s16x4*)(vp + 16);
                    const bf16x8 vf = __builtin_shufflevector(lo, hi, 0, 1, 2, 3, 4, 5, 6, 7);
                    ot[dt] = MFMA32(vf, pf, ot[dt]);
                }
            }
    }
    const float inv = 1.f / lrun;
    const bf16_t* zp = P + qrow * NP + C_ZC + hd * 128; bf16_t* op = YC + qrow * 512 + hd * 128;
#pragma unroll
    for (int dt = 0; dt < 4; ++dt)
#pragma unroll
        for (int gq = 0; gq < 4; ++gq) {
            const int d0 = 32 * dt + 8 * gq + 4 * hh;
            const uint2 zz = *(const uint2*)(zp + d0);
            const float z0 = __uint_as_float(zz.x << 16), z1 = __uint_as_float(zz.x & 0xffff0000u), z2 = __uint_as_float(zz.y << 16), z3 = __uint_as_float(zz.y & 0xffff0000u);
            const unsigned o0 = (unsigned)f2bf(ot[dt][4 * gq] * inv * siluf_(z0)) | ((unsigned)f2bf(ot[dt][4 * gq + 1] * inv * siluf_(z1)) << 16);
            const unsigned o1 = (unsigned)f2bf(ot[dt][4 * gq + 2] * inv * siluf_(z2)) | ((unsigned)f2bf(ot[dt][4 * gq + 3] * inv * siluf_(z3)) << 16);
            *(uint2*)(op + d0) = make_uint2(o0, o1);
        }
}
DI void phase_attn(const Params& p, unsigned char* lds, const int bid, const int nb) {
    for (int u = bid; u < 512; u += nb) { if (u < 256) swa_unit(p, lds, u); else xattn_unit(p, lds, u - 256); }
}

namespace pg8 {
#define PG8_LAS __attribute__((address_space(3)))
typedef unsigned short bf16_t;
typedef short bf16x8 __attribute__((ext_vector_type(8)));
typedef float f32x4 __attribute__((ext_vector_type(4)));
typedef unsigned u32x4 __attribute__((ext_vector_type(4)));
constexpr int BM = 256, BK = 64, HALF = 128, HTB = HALF * BK * 2  , STAGE_BYTES = 8 * HTB, NXCD = 8, WGM = 8;

__host__ __device__ __forceinline__ int lds_byte(int r, int c) { const int st = (r >> 4) * 2 + (c >> 5), rr = r & 15, cc = c & 31, ob = rr * 64 + cc * 2; return st * 1024 + (ob ^ (((ob >> 9) & 1) << 5)); }
__host__ __device__ __forceinline__ void stage_rc(int b, int& R, int& C) { const int st = b / 1024, sb = b % 1024, swz = sb ^ (((sb >> 9) & 1) << 5); R = (st >> 1) * 16 + swz / 64; C = (st & 1) * 32 + (swz % 64) / 2; }
__host__ __device__ __forceinline__ int perm32(int rho) { const int n = rho >> 4, i = rho & 15; return 8 * (i >> 2) + 4 * n + (i & 3); }

struct Unit { int pm, pn; };
struct Gemm { const bf16_t* A; const bf16_t* Bt; int M, N, K; };

struct StaticOrder {
    int nM, nN, nwg, G, c;
    __host__ __device__ void init(int M, int N, int G_, int c_) { nM = M / BM; nN = N / BM; nwg = nM * nN; G = G_; c = c_; }
    __host__ __device__ bool next(int i, Unit& u) const {
        const long L = (long)i * G + c; if (L >= nwg) return false;
        int wgid = (int)L; { const int q = nwg / NXCD, r = nwg % NXCD, xcd = wgid % NXCD, off = wgid / NXCD; wgid = (xcd < r ? xcd * (q + 1) : r * (q + 1) + (xcd - r) * q) + off; }
        const int nig = WGM * nN, gid = wgid / nig, fm = gid * WGM, gsz = (nM - fm) < WGM ? (nM - fm) : WGM;
        u.pm = fm + ((wgid % nig) % gsz); u.pn = (wgid % nig) / gsz; return true;
    }
    __device__ __forceinline__ void a_ready(const Unit&) const {}
    __device__ __forceinline__ void done(const Unit&) const {}
};
__device__ __forceinline__ unsigned cvt_pk_bf16(float lo, float hi) { typedef float f2_ __attribute__((ext_vector_type(2))); typedef __bf16 b2_ __attribute__((ext_vector_type(2))); return __builtin_bit_cast(unsigned, __builtin_convertvector((f2_){lo, hi}, b2_)); }
typedef float f32x2 __attribute__((ext_vector_type(2)));
template <class Epi, class Sched, bool ALIGN_EPI = false, bool SP2 = false>
__device__ __forceinline__ void gemm_phase(PG8_LAS unsigned char* lds, const Gemm g, const Sched& S, const Epi& E) {
    const int tid = threadIdx.x, wid = __builtin_amdgcn_readfirstlane(tid >> 6), lane = tid & 63, wr = wid >> 2, wc = wid & 3, fr = lane & 15, fq = lane >> 4;
    const int K = g.K, nt = K / BK;
    unsigned voffA[2], voffB[2];
#pragma unroll
    for (int i = 0; i < 2; ++i) { int R, C; stage_rc(tid * 16 + i * 8192, R, C); const int Rb = Epi::PERM ? ((R & ~31) + perm32(R & 31)) : R;
        voffA[i] = (unsigned)(R * K + C) * 2u; voffB[i] = (unsigned)(Rb * K + C) * 2u; }
    const size_t kstep = (size_t)(BK * 2);
    const size_t hstep = (size_t)HALF * K * 2;
    const size_t tstep = 2 * hstep;
    const unsigned ldsw = (unsigned)wid * 1024u;
    const int aoff = lds_byte(wr * 64 + fr, fq * 8), boff = lds_byte(wc * 32 + fr, fq * 8);
#define PG8_SA(b, h) (((b) * 2 + (h)) * HTB)
#define PG8_SB(b, h) ((4 + (b) * 2 + (h)) * HTB)
#define PG8_STAGE(bufoff, gbase, voff) do { _Pragma("unroll") for (int _i = 0; _i < 2; ++_i) \
        __builtin_amdgcn_global_load_lds((const unsigned*)((const char*)(gbase) + (voff)[_i]), (PG8_LAS unsigned*)(lds + (bufoff) + ldsw + _i * 8192), 16, 0, 0); } while (0)
#define PG8_LDA(dst, b, h) do { _Pragma("unroll") for (int m = 0; m < 4; ++m) _Pragma("unroll") for (int k = 0; k < 2; ++k) dst[m][k] = *(const PG8_LAS bf16x8*)(lds + PG8_SA(b, h) + aoff + m * 2048 + k * 1024); } while (0)
#define PG8_LDB(dst, b, h) do { _Pragma("unroll") for (int n = 0; n < 2; ++n) _Pragma("unroll") for (int k = 0; k < 2; ++k) dst[n][k] = *(const PG8_LAS bf16x8*)(lds + PG8_SB(b, h) + boff + n * 2048 + k * 1024); } while (0)
#define PG8_MMA(ai, bj, At, Bt) do { __builtin_amdgcn_s_setprio(1); _Pragma("unroll") for (int m = 0; m < 4; ++m) _Pragma("unroll") for (int n = 0; n < 2; ++n) _Pragma("unroll") for (int k = 0; k < 2; ++k) \
        acc[ai][bj][m][n] = __builtin_amdgcn_mfma_f32_16x16x32_bf16(Bt[n][k], At[m][k], acc[ai][bj][m][n], 0, 0, 0); __builtin_amdgcn_s_setprio(0); } while (0)
#define PG8_WAIT_V(n) asm volatile("s_waitcnt vmcnt(" #n ")" ::: "memory")
#define PG8_WAIT_L(n) asm volatile("s_waitcnt lgkmcnt(" #n ")" ::: "memory")
#define PG8_BAR __builtin_amdgcn_s_barrier()
#define PG8_SCHED __builtin_amdgcn_sched_barrier(0)
    Unit cur, nxt; int ui = 0;
    if (!S.next(0, cur)) return;
    f32x4 acc[2][2][4][2];
#pragma unroll
    for (int a = 0; a < 2; ++a)
#pragma unroll
        for (int b = 0; b < 2; ++b)
#pragma unroll
            for (int m = 0; m < 4; ++m)
#pragma unroll
                for (int n = 0; n < 2; ++n) acc[a][b][m][n] = (f32x4){0.f, 0.f, 0.f, 0.f};
    bf16x8 At[4][2], B0[2][2], B1[2][2];
    const char* cA = (const char*)g.A + (size_t)cur.pm * tstep; const char* cB = (const char*)g.Bt + (size_t)cur.pn * tstep;
    S.a_ready(cur);
    if constexpr (SP2) {
        PG8_STAGE(PG8_SB(0, 0), cB, voffB); PG8_STAGE(PG8_SB(0, 1), cB + hstep, voffB); PG8_STAGE(PG8_SA(0, 0), cA, voffA); PG8_STAGE(PG8_SA(0, 1), cA + hstep, voffA);
        if (wr == 1) PG8_BAR;
        PG8_WAIT_V(2); PG8_BAR;
        PG8_STAGE(PG8_SB(1, 0), cB + kstep, voffB); PG8_STAGE(PG8_SA(1, 0), cA + kstep, voffA); PG8_STAGE(PG8_SB(1, 1), cB + hstep + kstep, voffB);
        PG8_WAIT_V(6); PG8_BAR;
    } else {
        PG8_STAGE(PG8_SB(0, 0), cB, voffB); PG8_STAGE(PG8_SA(0, 0), cA, voffA); PG8_STAGE(PG8_SB(0, 1), cB + hstep, voffB); PG8_STAGE(PG8_SA(0, 1), cA + hstep, voffA);
        if (wr == 1) PG8_BAR;
        PG8_WAIT_V(4); PG8_BAR;
        PG8_STAGE(PG8_SB(1, 0), cB + kstep, voffB); PG8_STAGE(PG8_SA(1, 0), cA + kstep, voffA); PG8_STAGE(PG8_SB(1, 1), cB + hstep + kstep, voffB);
        PG8_WAIT_V(6); PG8_BAR;
    }
    for (;;) {
        const bool has_next = S.next(ui + 1, nxt);
        const char* nA = has_next ? (const char*)g.A + (size_t)nxt.pm * tstep : cA; const char* nB = has_next ? (const char*)g.Bt + (size_t)nxt.pn * tstep : cB;
        for (int t = 0; t < nt; t += 2) {
            const bool last = (t == nt - 2);
            const char* a1 = cA + (size_t)(t + 1) * kstep;
            const char* a2 = last ? nA : cA + (size_t)(t + 2) * kstep; const char* b2 = last ? nB : cB + (size_t)(t + 2) * kstep;
            const char* a3 = a2 + kstep; const char* b3 = b2 + kstep;
            if (last && has_next) S.a_ready(nxt);
            if constexpr (SP2) {
            PG8_LDB(B0, 0, 0); PG8_LDB(B1, 0, 1); PG8_SCHED; PG8_LDA(At, 0, 0); PG8_STAGE(PG8_SA(1, 1), a1 + hstep, voffA);
            PG8_WAIT_V(8); PG8_WAIT_L(0); PG8_BAR; PG8_MMA(0, 0, At, B0); PG8_MMA(0, 1, At, B1); PG8_BAR; PG8_SCHED;
            PG8_LDA(At, 0, 1); PG8_STAGE(PG8_SB(0, 0), b2, voffB); PG8_STAGE(PG8_SB(0, 1), b2 + hstep, voffB); PG8_STAGE(PG8_SA(0, 0), a2, voffA);
            PG8_WAIT_V(8); PG8_WAIT_L(0); PG8_BAR; PG8_MMA(1, 0, At, B0); PG8_MMA(1, 1, At, B1); PG8_BAR; PG8_SCHED;
            PG8_LDB(B0, 1, 0); PG8_LDB(B1, 1, 1); PG8_SCHED; PG8_LDA(At, 1, 0); PG8_STAGE(PG8_SA(0, 1), a2 + hstep, voffA);
            PG8_WAIT_V(8); PG8_WAIT_L(0); PG8_BAR; PG8_MMA(0, 0, At, B0); PG8_MMA(0, 1, At, B1); PG8_BAR; PG8_SCHED;
            PG8_LDA(At, 1, 1); PG8_STAGE(PG8_SB(1, 0), b3, voffB); PG8_STAGE(PG8_SB(1, 1), b3 + hstep, voffB); PG8_STAGE(PG8_SA(1, 0), a3, voffA);
            PG8_WAIT_V(8); PG8_WAIT_L(0); PG8_BAR; PG8_MMA(1, 0, At, B0); PG8_MMA(1, 1, At, B1); PG8_BAR; PG8_SCHED;
            } else {
            PG8_LDB(B0, 0, 0); PG8_SCHED; PG8_LDA(At, 0, 0); PG8_STAGE(PG8_SA(1, 1), a1 + hstep, voffA);
            PG8_WAIT_L(8); PG8_BAR; PG8_WAIT_L(0); PG8_MMA(0, 0, At, B0); PG8_BAR; PG8_SCHED;
            PG8_LDB(B1, 0, 1); PG8_STAGE(PG8_SB(0, 0), b2, voffB);
            PG8_BAR; PG8_WAIT_L(0); PG8_MMA(0, 1, At, B1); PG8_BAR;
            PG8_LDA(At, 0, 1); PG8_STAGE(PG8_SA(0, 0), a2, voffA);
            PG8_BAR; PG8_WAIT_L(0); PG8_MMA(1, 0, At, B0); PG8_BAR; PG8_SCHED;
            PG8_STAGE(PG8_SB(0, 1), b2 + hstep, voffB);
            PG8_WAIT_V(6); PG8_BAR; PG8_MMA(1, 1, At, B1); PG8_BAR;
            PG8_LDB(B0, 1, 0); PG8_SCHED; PG8_LDA(At, 1, 0); PG8_STAGE(PG8_SA(0, 1), a2 + hstep, voffA);
            PG8_WAIT_L(8); PG8_BAR; PG8_WAIT_L(0); PG8_MMA(0, 0, At, B0); PG8_BAR; PG8_SCHED;
            PG8_LDB(B1, 1, 1); PG8_STAGE(PG8_SB(1, 0), b3, voffB);
            PG8_BAR; PG8_WAIT_L(0); PG8_MMA(0, 1, At, B1); PG8_BAR;
            PG8_LDA(At, 1, 1); PG8_STAGE(PG8_SA(1, 0), a3, voffA);
            PG8_BAR; PG8_WAIT_L(0); PG8_MMA(1, 0, At, B0); PG8_BAR; PG8_SCHED;
            PG8_STAGE(PG8_SB(1, 1), b3 + hstep, voffB);
            PG8_WAIT_V(6); PG8_BAR; PG8_MMA(1, 1, At, B1); PG8_BAR;
            }
        }
        if constexpr (ALIGN_EPI) { if (wr == 0) PG8_BAR; }
        if constexpr (!Epi::AFTER_DRAIN) { E(acc, cur, wr, wc, fr, fq); S.done(cur); }
        if (!has_next) break;
#pragma unroll
        for (int a = 0; a < 2; ++a)
#pragma unroll
            for (int b = 0; b < 2; ++b)
#pragma unroll
                for (int m = 0; m < 4; ++m)
#pragma unroll
                    for (int n = 0; n < 2; ++n) acc[a][b][m][n] = (f32x4){0.f, 0.f, 0.f, 0.f};
        cur = nxt; cA = nA; cB = nB; ++ui;
        if constexpr (ALIGN_EPI) { if (wr == 1) PG8_BAR; }
    }
    PG8_WAIT_V(0);
    if constexpr (!ALIGN_EPI) { if (wr == 0) PG8_BAR; }
    PG8_BAR;
    if constexpr (Epi::AFTER_DRAIN) { E.fused(acc, cur, wr, wc, fr, fq, lds, wid, lane); S.done(cur); }
#undef PG8_SA
#undef PG8_SB
#undef PG8_STAGE
#undef PG8_LDA
#undef PG8_LDB
#undef PG8_MMA
#undef PG8_WAIT_V
#undef PG8_WAIT_L
#undef PG8_BAR
#undef PG8_SCHED
}
}

namespace pg8 {
template <int ACT> struct EpiStore {
    static constexpr bool PERM = true, AFTER_DRAIN = false;
    bf16_t* O; int ldc;
    __device__ __forceinline__ void operator()(const f32x4 (&acc)[2][2][4][2], const Unit& u, int wr, int wc, int fr, int fq) const {
        const int row0 = u.pm * BM + wr * 64 + fr, col0 = u.pn * BM + wc * 32 + 8 * fq;
#pragma unroll
        for (int ai = 0; ai < 2; ++ai)
#pragma unroll
            for (int m = 0; m < 4; ++m) { bf16_t* rowp = O + (size_t)(row0 + ai * HALF + m * 16) * ldc + col0;
#pragma unroll
                for (int bj = 0; bj < 2; ++bj) { f32x4 v0 = acc[ai][bj][m][0], v1 = acc[ai][bj][m][1];
                    if (ACT == 1) {
#pragma unroll
                        for (int e = 0; e < 4; ++e) { v0[e] = __builtin_amdgcn_rcpf(1.f + __expf(-v0[e])); v1[e] = __builtin_amdgcn_rcpf(1.f + __expf(-v1[e])); } }
                    u32x4 w; w.x = cvt_pk_bf16(v0[0], v0[1]); w.y = cvt_pk_bf16(v0[2], v0[3]); w.z = cvt_pk_bf16(v1[0], v1[1]); w.w = cvt_pk_bf16(v1[2], v1[3]);
                    *(u32x4*)(rowp + bj * HALF) = w; } }
    }
};
template <bool ACCUM> struct EpiProj {
    static constexpr bool PERM = true, AFTER_DRAIN = false;
    bf16_t* MG; const bf16_t* SG; int gcol0;
    __device__ __forceinline__ void operator()(const f32x4 (&acc)[2][2][4][2], const Unit& u, int wr, int wc, int fr, int fq) const {
        const int row0 = u.pm * BM + wr * 64 + fr, col0 = u.pn * BM + wc * 32 + 8 * fq;
#pragma unroll
        for (int ai = 0; ai < 2; ++ai)
#pragma unroll
            for (int m = 0; m < 4; ++m) { const size_t row = (size_t)(row0 + ai * HALF + m * 16);
#pragma unroll
                for (int bj = 0; bj < 2; ++bj) {
                    const int col = col0 + bj * HALF;
                    const u32x4 gw = *(const u32x4*)(SG + row * 3072 + gcol0 + col);
                    u32x4 ow = (u32x4){0u, 0u, 0u, 0u};
                    if (ACCUM) ow = *(const u32x4*)(MG + row * 1024 + col);
                    float r[8];
#pragma unroll
                    for (int e = 0; e < 4; ++e) {
                        const float g0 = __uint_as_float(gw[e] << 16), g1 = __uint_as_float(gw[e] & 0xffff0000u);
                        const float a0 = e < 2 ? acc[ai][bj][m][0][2 * e] : acc[ai][bj][m][1][2 * e - 4], a1 = e < 2 ? acc[ai][bj][m][0][2 * e + 1] : acc[ai][bj][m][1][2 * e - 3];
                        r[2 * e] = g0 * a0; r[2 * e + 1] = g1 * a1;
                        if (ACCUM) { r[2 * e] += __uint_as_float(ow[e] << 16); r[2 * e + 1] += __uint_as_float(ow[e] & 0xffff0000u); }
                    }
                    u32x4 w; w.x = cvt_pk_bf16(r[0], r[1]); w.y = cvt_pk_bf16(r[2], r[3]); w.z = cvt_pk_bf16(r[4], r[5]); w.w = cvt_pk_bf16(r[6], r[7]);
                    *(u32x4*)(MG + row * 1024 + col) = w; } }
    }
};
struct EpiOut {
    static constexpr bool PERM = false, AFTER_DRAIN = false;
    const float* X; float* O;
    __device__ __forceinline__ void operator()(const f32x4 (&acc)[2][2][4][2], const Unit& u, int wr, int wc, int fr, int fq) const {
        const int row0 = u.pm * BM + wr * 64 + fr, col0 = u.pn * BM + wc * 32 + 4 * fq;
#pragma unroll
        for (int ai = 0; ai < 2; ++ai)
#pragma unroll
            for (int m = 0; m < 4; ++m) { const size_t off = (size_t)(row0 + ai * HALF + m * 16) * 1024 + col0;
#pragma unroll
                for (int bj = 0; bj < 2; ++bj)
#pragma unroll
                    for (int n = 0; n < 2; ++n) { const f32x4 xv = *(const f32x4*)(X + off + bj * HALF + n * 16); *(f32x4*)(O + off + bj * HALF + n * 16) = xv + acc[ai][bj][m][n]; } }
    }
};
}

DI void phase_gemm_gate(const Params& p, unsigned char* lds, const int bid, const int nb) {
    unsigned char* ws = p.ws;
    const bf16_t* H = (const bf16_t*)(ws + OFF_H); const bf16_t* Wt = (const bf16_t*)(ws + OFF_WIN) + (size_t)C_G * 1024;
    bf16_t* SG = (bf16_t*)(ws + OFF_SG);
    const int tn = 3072 / 128, nt = (M / 128) * tn;
    for (int it = bid; it < nt; it += nb) {
        GemmTile g; gemm_zero(g);
        const int m0 = (it / tn) * 128, n0 = (it % tn) * 128;
        gemm_tile_k(g, H, 1024, Wt, 1024, m0, n0, 1024, lds);
        GEMM_FOREACH(SG[(size_t)row * 3072 + col] = f2bf(sigmoidf_(g.acc[mi][ni][r])););
    }
}
DI void phase_gemm_proj(const Params& p, unsigned char* lds, const int bid, const int nb) {
    unsigned char* ws = p.ws;
    const bf16_t* SG = (const bf16_t*)(ws + OFF_SG); bf16_t* MG = (bf16_t*)(ws + OFF_MG);
    const int tn = 1024 / 128, nt = (M / 128) * tn;
    for (int it = bid; it < nt; it += nb) {
        const int m0 = (it / tn) * 128, n0 = (it % tn) * 128;
        GemmTile mg; gemm_zero(mg);
#pragma unroll 1
        for (int br = 0; br < 3; ++br) {
            GemmTile g; gemm_zero(g);
            const bf16_t* Y = (const bf16_t*)(ws + (br == 0 ? OFF_YA : br == 1 ? OFF_YB : OFF_YC));
            const bf16_t* W = (const bf16_t*)(ws + (br == 0 ? OFF_WPA : br == 1 ? OFF_WPB : OFF_WPC));
            gemm_tile_k(g, Y, 512, W, 512, m0, n0, 512, lds);
            GEMM_FOREACH(mg.acc[mi][ni][r] += bf2f(SG[(size_t)row * 3072 + br * 1024 + col]) * g.acc[mi][ni][r];);
        }
        GEMM_FOREACH(MG[(size_t)row * 1024 + col] = f2bf(mg.acc[mi][ni][r]););
    }
}
DI void phase_gemm_out(const Params& p, unsigned char* lds, const int bid, const int nb) {
    unsigned char* ws = p.ws;
    const bf16_t* MG = (const bf16_t*)(ws + OFF_MG); const bf16_t* W = (const bf16_t*)(ws + OFF_WO);
    const int tn = 1024 / 128, nt = (M / 128) * tn;
    for (int it = bid; it < nt; it += nb) {
        GemmTile g; gemm_zero(g);
        const int m0 = (it / tn) * 128, n0 = (it % tn) * 128;
        gemm_tile_k(g, MG, 1024, W, 1024, m0, n0, 1024, lds);
        GEMM_FOREACH(p.out[(size_t)row * 1024 + col] = p.x[(size_t)row * 1024 + col] + g.acc[mi][ni][r];);
    }
}

#define LASP(p_) ((__attribute__((address_space(3))) unsigned char*)(p_))
DI void phase_gemm_in_fast(const Params& p, unsigned char* lds, const int bid, const int nb) {
    unsigned char* ws = p.ws;
    {
        pg8::Gemm g{(const bf16_t*)(ws + OFF_H), (const bf16_t*)(ws + OFF_WIN), M, NP, 1024}; pg8::StaticOrder S; S.init(M, NP, nb, bid);
        pg8::EpiStore<0> E{(bf16_t*)(ws + OFF_P), NP};
        pg8::gemm_phase<pg8::EpiStore<0>, pg8::StaticOrder, true, true>(LASP(lds), g, S, E);
    }
    __syncthreads();
    const int tn2 = 1024 / 128, nt2 = (MM / 128) * tn2;
    for (int it = bid - nb / 2; it >= 0 && it < nt2; it += nb) {
        GemmTile g; gemm_zero(g);
        const int m0 = (it / tn2) * 128, n0 = (it % tn2) * 128;
        gemm_tile_k(g, (const bf16_t*)(ws + OFF_HM), 1024, (const bf16_t*)(ws + OFF_WKV), 1024, m0, n0, 1024, lds);
        bf16_t* KVM = (bf16_t*)(ws + OFF_KVM);
        GEMM_FOREACH(KVM[(size_t)row * 1024 + col] = f2bf(g.acc[mi][ni][r]););
    }
}
DI void phase_gemm_gate_fast(const Params& p, unsigned char* lds, const int bid, const int nb) {
    unsigned char* ws = p.ws;
    pg8::Gemm g{(const bf16_t*)(ws + OFF_H), (const bf16_t*)(ws + OFF_WIN) + (size_t)C_G * 1024, M, 3072, 1024}; pg8::StaticOrder S; S.init(M, 3072, nb, bid);
    pg8::EpiStore<1> E{(bf16_t*)(ws + OFF_SG), 3072};
    pg8::gemm_phase<pg8::EpiStore<1>, pg8::StaticOrder, true, true>(LASP(lds), g, S, E);
}
DI void phase_gemm_proj_fast(const Params& p, unsigned char* lds, const int bid, const int nb) {
    unsigned char* ws = p.ws;
    bf16_t* MG = (bf16_t*)(ws + OFF_MG); const bf16_t* SG = (const bf16_t*)(ws + OFF_SG);
    pg8::StaticOrder S; S.init(M, 1024, nb, bid);
    { pg8::Gemm g{(const bf16_t*)(ws + OFF_YA), (const bf16_t*)(ws + OFF_WPA), M, 1024, 512}; pg8::EpiProj<false> E{MG, SG, 0};
      pg8::gemm_phase<pg8::EpiProj<false>, pg8::StaticOrder, true, true>(LASP(lds), g, S, E); }
    { pg8::Gemm g{(const bf16_t*)(ws + OFF_YB), (const bf16_t*)(ws + OFF_WPB), M, 1024, 512}; pg8::EpiProj<true> E{MG, SG, 1024};
      pg8::gemm_phase<pg8::EpiProj<true>, pg8::StaticOrder, true, true>(LASP(lds), g, S, E); }
    { pg8::Gemm g{(const bf16_t*)(ws + OFF_YC), (const bf16_t*)(ws + OFF_WPC), M, 1024, 512}; pg8::EpiProj<true> E{MG, SG, 2048};
      pg8::gemm_phase<pg8::EpiProj<true>, pg8::StaticOrder, true, true>(LASP(lds), g, S, E); }
}
DI void phase_gemm_out_fast(const Params& p, unsigned char* lds, const int bid, const int nb) {
    unsigned char* ws = p.ws;
    pg8::Gemm g{(const bf16_t*)(ws + OFF_MG), (const bf16_t*)(ws + OFF_WO), M, 1024, 1024}; pg8::StaticOrder S; S.init(M, 1024, nb, bid);
    pg8::EpiOut E{p.x, p.out};
    pg8::gemm_phase<pg8::EpiOut, pg8::StaticOrder, true, true>(LASP(lds), g, S, E);
}

#define XB_TMO      128
#define XB_XCNT(j)  (256  + 64 * (j))
#define XB_XSUB(j)  (1280 + 64 * (j))
#define XB_XGEN(j)  (2304 + 64 * (j))
#define XB_TOP      3328
#define XB_TOPGEN   3392
#define XCD_BAR_WORDS 3456
#define XB_SPIN_CAP (1u << 22)
#define LAS __attribute__((address_space(3)))
DI unsigned xb_ld(unsigned* p)              { return __hip_atomic_load(p, __ATOMIC_RELAXED, __HIP_MEMORY_SCOPE_AGENT); }
DI unsigned xb_add(unsigned* p, unsigned v) { return __hip_atomic_fetch_add(p, v, __ATOMIC_RELAXED, __HIP_MEMORY_SCOPE_AGENT); }
DI unsigned xb_xcc_id() { return (unsigned)__builtin_amdgcn_s_getreg((3 << 11) | 20) & 0xFu; }
#define XB_SPIN(cond, bar) do { unsigned _sp = 0; while (cond) { __builtin_amdgcn_s_sleep(1); \
    if ((++_sp & 255u) == 0u) { if (xb_ld(&(bar)[XB_TMO])) break; if (_sp > XB_SPIN_CAP) { atomicAdd(&(bar)[XB_TMO], 1u); break; } } } } while (0)
struct XcdBarrier { unsigned* bar; unsigned x; volatile LAS unsigned* st; };
DI XcdBarrier xcd_barrier_post(unsigned* bar, volatile LAS unsigned* st) {
    XcdBarrier b; b.bar = bar; b.x = xb_xcc_id(); b.st = st;
    if (threadIdx.x == 0) (void)xb_add(&bar[XB_XCNT(b.x)], 1u);
    return b;
}
DI void xcd_barrier_complete(unsigned* bar, unsigned x, unsigned& nloc, unsigned& nx) {
    const unsigned G = gridDim.x * gridDim.y * gridDim.z;
    unsigned sum, cnt, mine, sp = 0u;
    for (;;) {
        sum = 0u; cnt = 0u; mine = 0u;
#pragma unroll
        for (unsigned j = 0; j < 16; ++j) { const unsigned c = xb_ld(&bar[XB_XCNT(j)]); sum += c; cnt += (c > 0u) ? 1u : 0u; mine = (j == x) ? c : mine; }
        if (sum == G) break;
        __builtin_amdgcn_s_sleep(1);
        if ((++sp & 255u) == 0u) { if (xb_ld(&bar[XB_TMO])) break; if (sp > XB_SPIN_CAP) { atomicAdd(&bar[XB_TMO], 1u); break; } }
    }
    nloc = mine > 0u ? mine : 1u; nx = cnt > 0u ? cnt : 1u;
}
DI void xcd_barrier(const XcdBarrier& b) {
    asm volatile("s_waitcnt vmcnt(0)" ::: "memory");
    __syncthreads();
    if (threadIdx.x == 0) {
        unsigned* bar = b.bar;
        __builtin_amdgcn_s_waitcnt(0);
        unsigned nloc = b.st[0], nx = b.st[1];
        if (nloc == 0u) { xcd_barrier_complete(bar, b.x, nloc, nx); b.st[0] = nloc; b.st[1] = nx; }
        const unsigned old = xb_add(&bar[XB_XSUB(b.x)], 1u);
        const unsigned gen = old / nloc;
        if (old + 1u == (gen + 1u) * nloc) {
            __builtin_amdgcn_fence(__ATOMIC_RELEASE, "agent");
            asm volatile("s_waitcnt vmcnt(0)" ::: "memory");
            const unsigned og = xb_add(&bar[XB_TOP], 1u);
            const unsigned tg = og / nx;
            if (og + 1u == (tg + 1u) * nx) xb_add(&bar[XB_TOPGEN], 1u);
            else XB_SPIN(xb_ld(&bar[XB_TOPGEN]) == tg, bar);
            __builtin_amdgcn_fence(__ATOMIC_ACQUIRE, "agent");
            xb_add(&bar[XB_XGEN(b.x)], 1u);
            asm volatile("s_waitcnt vmcnt(0)" ::: "memory");
        } else {
            XB_SPIN(xb_ld(&bar[XB_XGEN(b.x)]) == gen, bar);
            __builtin_amdgcn_fence(__ATOMIC_ACQUIRE, "agent");
            asm volatile("s_waitcnt vmcnt(0)" ::: "memory");
        }
    }
    __syncthreads();
}

constexpr int LDS_CTL_OFF = LDS_BYTES - 256;
__global__ void __launch_bounds__(NTHREADS, 2) k_mega(Params p) {
    extern __shared__ __attribute__((aligned(16))) unsigned char lds[];
    volatile LAS unsigned* st = (volatile LAS unsigned*)(lds + LDS_CTL_OFF);
    if (threadIdx.x == 0) { st[0] = 0u; st[1] = 0u; st[2] = 0u; st[3] = 0u; }
    __syncthreads();
    (void)xcd_barrier_post((unsigned*)(p.ws + OFF_CTL), st);
#define GRID_BAR() do { XcdBarrier b_; b_.bar = (unsigned*)(p.ws + OFF_CTL); b_.x = xb_xcc_id(); b_.st = (volatile LAS unsigned*)(lds + LDS_CTL_OFF); xcd_barrier(b_); } while (0)
    const int bid = blockIdx.x, nb = gridDim.x;
#ifndef REPMASK
#define REPMASK 0
#endif
#ifndef REPCNT
#define REPCNT 1
#endif
#define REP(bit_, call_) do { call_; if (REPMASK & (bit_)) { for (int rep_ = 0; rep_ < REPCNT; ++rep_) { __syncthreads(); call_; } } } while (0)
    REP(1, phase_prologue(p, lds, bid, nb));
    GRID_BAR();
    REP(2, phase_gemm_in_fast(p, lds, bid, nb));
    GRID_BAR();
    REP(8, phase_rwkv_prep(p, lds, bid, nb));
    GRID_BAR();
    if (bid < 16) phase_rwkv_scan(p, lds, bid);
    else REP(16, phase_attn(p, lds, bid - 16, nb - 16));
    GRID_BAR();
    REP(32, phase_rwkv_out(p, lds, bid, nb));
    GRID_BAR();
    REP(64, phase_gemm_gate_fast(p, lds, bid, nb));
    GRID_BAR();
    REP(128, phase_gemm_proj_fast(p, lds, bid, nb));
    GRID_BAR();
    REP(256, phase_gemm_out_fast(p, lds, bid, nb));
}

extern "C" void kernel_launch(void* const* d_in, const int* in_sizes, int n_in, void* d_out, int out_size, void* d_ws, size_t ws_size, hipStream_t stream) {
    static int grid = 0;
    if (grid == 0) {
        if (n_in != 27 || ws_size < WS_END) { fprintf(stderr, "kernel_launch: unexpected inputs (n_in %d, ws %zu)\n", n_in, ws_size); grid = -1; return; }
        int dev = 0, cus = 0, per_cu = 0;
        if (hipGetDevice(&dev) != hipSuccess || hipDeviceGetAttribute(&cus, hipDeviceAttributeMultiprocessorCount, dev) != hipSuccess) { grid = -1; return; }
        if (hipFuncSetAttribute((const void*)k_mega, hipFuncAttributeMaxDynamicSharedMemorySize, LDS_BYTES) != hipSuccess) { fprintf(stderr, "kernel_launch: hipFuncSetAttribute failed\n"); grid = -1; return; }
        if (hipOccupancyMaxActiveBlocksPerMultiprocessor(&per_cu, (const void*)k_mega, NTHREADS, LDS_BYTES) != hipSuccess || per_cu < 1)
            fprintf(stderr, "kernel_launch: occupancy query reports %d workgroups per CU\n", per_cu);
        (void)hipGetLastError();
        grid = cus;
        if (grid < 32) { fprintf(stderr, "kernel_launch: too few CUs (%d)\n", grid); grid = -1; return; }
    }
    if (grid < 0) return;
    if (hipMemsetAsync((char*)d_ws + OFF_CTL, 0, 65536, stream) != hipSuccess) { fprintf(stderr, "kernel_launch: memset failed\n"); return; }
    Params p{};
    p.x = (const float*)d_in[0]; p.mem = (const float*)d_in[1]; p.pos = (const int*)d_in[2]; p.norm_g = (const float*)d_in[3]; p.mem_norm_g = (const float*)d_in[4];
    p.w_in = (const float*)d_in[5]; p.mu_rkv = (const float*)d_in[6]; p.mu_wa = (const float*)d_in[7]; p.w0 = (const float*)d_in[8]; p.w2 = (const float*)d_in[9];
    p.a0 = (const float*)d_in[10]; p.a2 = (const float*)d_in[11]; p.k_k = (const float*)d_in[12]; p.k_a = (const float*)d_in[13]; p.r_k = (const float*)d_in[14];
    p.lnx_g = (const float*)d_in[15]; p.lnx_b = (const float*)d_in[16]; p.q_norm_g = (const float*)d_in[17]; p.k_norm_g = (const float*)d_in[18]; p.sinks = (const float*)d_in[19];
    p.xq_norm_g = (const float*)d_in[20]; p.xk_norm_g = (const float*)d_in[21]; p.w_mem_kv = (const float*)d_in[22]; p.w_proj_a = (const float*)d_in[23];
    p.w_proj_b = (const float*)d_in[24]; p.w_proj_c = (const float*)d_in[25]; p.w_out = (const float*)d_in[26];
    p.out = (float*)d_out; p.ws = (unsigned char*)d_ws;
    hipLaunchKernelGGL(k_mega, dim3(grid), dim3(NTHREADS), LDS_BYTES, stream, p);
}
```

```cpp
#include <hip/hip_runtime.h>
#include <stdint.h>
#include <stdio.h>

#define DI __device__ __forceinline__
#define LASP(p_) ((__attribute__((address_space(3))) unsigned char*)(p_))
typedef unsigned short bf16_t;
typedef short bf16x8 __attribute__((ext_vector_type(8)));
typedef float f32x4 __attribute__((ext_vector_type(4)));

constexpr int BATCH = 2, T = 8192, M = BATCH * T, D = 1024, NIN = 7552, NP = 4608  ;
constexpr int MEMLEN = 256, MM = BATCH * MEMLEN;
constexpr int C_R = 0, C_K = 512, C_V = 1024, C_W = 1536, C_A = 1600, C_ZA = 1664, C_Q = 2176, C_SK = 2688, C_SV = 2816, C_ZB = 2944, C_XQ = 3456, C_ZC = 3968, C_G = 4480;
constexpr int NTHREADS = 512, NWAVES = 8;
constexpr int LDS_BYTES = 147456;
constexpr int LDS_CTL_OFF = LDS_BYTES - 256;
#define LAS __attribute__((address_space(3)))

constexpr size_t OFF_CTL = 0;
constexpr size_t OFF_WIN = 65536;
constexpr size_t OFF_WKV = OFF_WIN + (size_t)7680 * 1024 * 2;
constexpr size_t OFF_WPA = OFF_WKV + (size_t)1024 * 1024 * 2;
constexpr size_t OFF_WPB = OFF_WPA + (size_t)1024 * 512 * 2;
constexpr size_t OFF_WPC = OFF_WPB + (size_t)1024 * 512 * 2;
constexpr size_t OFF_WO  = OFF_WPC + (size_t)1024 * 512 * 2;
constexpr size_t OFF_H   = OFF_WO + (size_t)1024 * 1024 * 2;
constexpr size_t OFF_HM  = OFF_H + (size_t)M * 1024 * 2;
constexpr size_t OFF_KVM = OFF_HM + (size_t)MM * 1024 * 2;
constexpr size_t OFF_ROPE = OFF_KVM + (size_t)MM * 1024 * 2;
constexpr size_t OFF_P   = OFF_ROPE + (size_t)M * 32 * 8;
constexpr size_t OFF_YA  = OFF_P + (size_t)M * NP * 2;
constexpr size_t OFF_YB  = OFF_YA + (size_t)M * 512 * 2;
constexpr size_t OFF_YC  = OFF_YB + (size_t)M * 512 * 2;
constexpr size_t WS_END  = OFF_YC + (size_t)M * 512 * 2;
constexpr size_t OFF_SG  = OFF_P;
constexpr size_t OFF_MG  = OFF_P + (size_t)M * 3072 * 2;
static_assert(WS_END <= (size_t)256 * 1024 * 1024, "workspace");
static_assert(OFF_MG + (size_t)M * 1024 * 2 <= OFF_YA, "overlay");

struct Params {
    const float* x; const float* mem; const int* pos; const float* norm_g; const float* mem_norm_g; const float* w_in;
    const float* mu_rkv; const float* mu_wa; const float* w0; const float* w2; const float* a0; const float* a2;
    const float* k_k; const float* k_a; const float* r_k; const float* lnx_g; const float* lnx_b;
    const float* q_norm_g; const float* k_norm_g; const float* sinks; const float* xq_norm_g; const float* xk_norm_g;
    const float* w_mem_kv; const float* w_proj_a; const float* w_proj_b; const float* w_proj_c; const float* w_out;
    float* out; unsigned char* ws;
};

DI bf16_t f2bf(float x) { return __builtin_bit_cast(unsigned short, (__bf16)x); }
DI float bf2f(bf16_t h) { return __uint_as_float(((unsigned)h) << 16); }
DI float wave_sum(float v) {
#pragma unroll
    for (int o = 32; o > 0; o >>= 1) v += __shfl_xor(v, o, 64);
    return v;
}
DI float wave_max(float v) {
#pragma unroll
    for (int o = 32; o > 0; o >>= 1) v = fmaxf(v, __shfl_xor(v, o, 64));
    return v;
}
DI float sigmoidf_(float x) { return __builtin_amdgcn_rcpf(1.f + __expf(-x)); }
DI float siluf_(float x) { return x * __builtin_amdgcn_rcpf(1.f + __expf(-x)); }

DI void transpose_convert(const float* W, int K, int N, bf16_t* Wt, int item, float* tile  ) {
    int tid = threadIdx.x; asm volatile("" : "+v"(tid));
    const int tn = N / 64, kt = item / tn, nt = item % tn;
    __syncthreads();
#pragma unroll
    for (int u = 0; u < 2; ++u) { const int idx = tid + NTHREADS * u, r = idx >> 4, c4 = idx & 15;
        *(f32x4*)(tile + r * 68 + c4 * 4) = *(const f32x4*)(W + (size_t)(kt * 64 + r) * N + nt * 64 + c4 * 4); }
    __syncthreads();
    {
        const int n = tid >> 3, k8 = tid & 7;
        unsigned w[4];
#pragma unroll
        for (int e2 = 0; e2 < 4; ++e2) w[e2] = (unsigned)f2bf(tile[(k8 * 8 + 2 * e2) * 68 + n]) | ((unsigned)f2bf(tile[(k8 * 8 + 2 * e2 + 1) * 68 + n]) << 16);
        *(uint4*)(Wt + (size_t)(nt * 64 + n) * K + kt * 64 + k8 * 8) = make_uint4(w[0], w[1], w[2], w[3]);
    }
}

DI void convert_late(const Params& p, unsigned char* lds, const int vb, const int nvb) {
    float* tile = (float*)lds; unsigned char* ws = p.ws;
    const int n_g = 16 * (NIN / 64 - 72), n_pr = (512 / 64) * 16, n_o = 16 * 16, total = n_g + 3 * n_pr + n_o;
    for (int it = vb * 8; it < vb * 8 + 8 && it < total; ++it) {
        int i = it;
        if (i < n_g) { const int kt = i / (NIN / 64 - 72), nt = 72 + i % (NIN / 64 - 72); transpose_convert(p.w_in, 1024, NIN, (bf16_t*)(ws + OFF_WIN), kt * (NIN / 64) + nt, tile); continue; } i -= n_g;
        if (i < n_pr) { transpose_convert(p.w_proj_a, 512, 1024, (bf16_t*)(ws + OFF_WPA), i, tile); continue; } i -= n_pr;
        if (i < n_pr) { transpose_convert(p.w_proj_b, 512, 1024, (bf16_t*)(ws + OFF_WPB), i, tile); continue; } i -= n_pr;
        if (i < n_pr) { transpose_convert(p.w_proj_c, 512, 1024, (bf16_t*)(ws + OFF_WPC), i, tile); continue; } i -= n_pr;
        transpose_convert(p.w_out, 1024, 1024, (bf16_t*)(ws + OFF_WO), i, tile);
    }
}
DI void phase_prologue(const Params& p, unsigned char* lds, const int bid, const int nb) {
    float* tile = (float*)lds;
    unsigned char* ws = p.ws;
    const int n_in = (1024 / 64) * 72, n_kv = 16 * 16;
    for (int it = bid; it < n_in + n_kv; it += nb) {
        if (it < n_in) { const int kt = it / 72, nt = it % 72; transpose_convert(p.w_in, 1024, NIN, (bf16_t*)(ws + OFF_WIN), kt * (NIN / 64) + nt, tile); }
        else transpose_convert(p.w_mem_kv, 1024, 1024, (bf16_t*)(ws + OFF_WKV), it - n_in, tile);
    }
    const int lane = threadIdx.x & 63, wid = threadIdx.x >> 6;
    for (int row = bid * NWAVES + wid; row < M + MM; row += nb * NWAVES) {
        const float* src = row < M ? p.x + (size_t)row * D : p.mem + (size_t)(row - M) * D;
        const float* g = row < M ? p.norm_g : p.mem_norm_g;
        bf16_t* dst = row < M ? (bf16_t*)(ws + OFF_H) + (size_t)row * D : (bf16_t*)(ws + OFF_HM) + (size_t)(row - M) * D;
        f32x4 v[4]; float ss = 0.f;
#pragma unroll
        for (int i = 0; i < 4; ++i) { v[i] = *(const f32x4*)(src + i * 256 + lane * 4); ss += v[i][0] * v[i][0] + v[i][1] * v[i][1] + v[i][2] * v[i][2] + v[i][3] * v[i][3]; }
        ss = wave_sum(ss);
        const float rs = rsqrtf(ss * (1.f / 1024.f) + 1e-6f);
#pragma unroll
        for (int i = 0; i < 4; ++i) {
            const f32x4 gg = *(const f32x4*)(g + i * 256 + lane * 4);
            ushort4 o; o.x = f2bf(v[i][0] * rs * gg[0]); o.y = f2bf(v[i][1] * rs * gg[1]); o.z = f2bf(v[i][2] * rs * gg[2]); o.w = f2bf(v[i][3] * rs * gg[3]);
            *(ushort4*)(dst + i * 256 + lane * 4) = o;
        }
    }
    float2* rope = (float2*)(ws + OFF_ROPE);
    for (int i = bid * NTHREADS + threadIdx.x; i < M * 32; i += nb * NTHREADS) {
        const int row = i >> 5, f = i & 31;
        const double inv = pow(10000.0, -(double)f / 32.0);
        const double ang = (double)p.pos[row] * inv;
        double s, c; sincos(ang, &s, &c);
        rope[i] = make_float2((float)c, (float)s);
    }
}

struct GemmTile { f32x4 acc[2][4]; };
DI void gemm_tile_k(GemmTile& g, const bf16_t* A, int lda, const bf16_t* Bt, int ldb, int m0, int n0, int K, unsigned char* lds) {
    bf16_t* sA = (bf16_t*)lds;
    bf16_t* sB = sA + 128 * 40;
    const int tid = threadIdx.x, lane = tid & 63, wid = tid >> 6, wm = wid & 3, wn = wid >> 2;
    const int srow = tid >> 2, sch = tid & 3;
    const bf16_t* ga = A + (size_t)(m0 + srow) * lda + sch * 8;
    const bf16_t* gb = Bt + (size_t)(n0 + srow) * ldb + sch * 8;
    const int fr = lane & 15, fq = lane >> 4;
    uint4 ra = *(const uint4*)ga, rb = *(const uint4*)gb;
    for (int k0 = 0; k0 < K; k0 += 32) {
        __syncthreads();
        *(uint4*)(sA + srow * 40 + sch * 8) = ra;
        *(uint4*)(sB + srow * 40 + sch * 8) = rb;
        __syncthreads();
        if (k0 + 32 < K) { ra = *(const uint4*)(ga + k0 + 32); rb = *(const uint4*)(gb + k0 + 32); }
        bf16x8 af[2], bfr[4];
#pragma unroll
        for (int mi = 0; mi < 2; ++mi) af[mi] = *(const bf16x8*)(sA + (wm * 32 + mi * 16 + fr) * 40 + fq * 8);
#pragma unroll
        for (int ni = 0; ni < 4; ++ni) bfr[ni] = *(const bf16x8*)(sB + (wn * 64 + ni * 16 + fr) * 40 + fq * 8);
#pragma unroll
        for (int mi = 0; mi < 2; ++mi)
#pragma unroll
            for (int ni = 0; ni < 4; ++ni) g.acc[mi][ni] = __builtin_amdgcn_mfma_f32_16x16x32_bf16(af[mi], bfr[ni], g.acc[mi][ni], 0, 0, 0);
    }
}
DI void gemm_zero(GemmTile& g) {
#pragma unroll
    for (int mi = 0; mi < 2; ++mi)
#pragma unroll
        for (int ni = 0; ni < 4; ++ni) g.acc[mi][ni] = (f32x4){0.f, 0.f, 0.f, 0.f};
}
#define GEMM_FOREACH(body) do { const int lane_ = threadIdx.x & 63, wid_ = threadIdx.x >> 6, wm_ = wid_ & 3, wn_ = wid_ >> 2, fr_ = lane_ & 15, fq_ = lane_ >> 4; \
    _Pragma("unroll") for (int mi = 0; mi < 2; ++mi) _Pragma("unroll") for (int ni = 0; ni < 4; ++ni) _Pragma("unroll") for (int r = 0; r < 4; ++r) { \
        const int row = m0 + wm_ * 32 + mi * 16 + fq_ * 4 + r, col = n0 + wn_ * 64 + ni * 16 + fr_; body } } while (0)

DI void phase_gemm_in(const Params& p, unsigned char* lds, const int bid, const int nb) {
    unsigned char* ws = p.ws;
    const bf16_t* H = (const bf16_t*)(ws + OFF_H); const bf16_t* Wt = (const bf16_t*)(ws + OFF_WIN);
    bf16_t* P = (bf16_t*)(ws + OFF_P);
    const int tn = NP / 128, nt1 = (M / 128) * tn;
    const int tn2 = 1024 / 128, nt2 = (MM / 128) * tn2;
    for (int it = bid; it < nt1 + nt2; it += nb) {
        GemmTile g; gemm_zero(g);
        if (it < nt1) {
            const int m0 = (it / tn) * 128, n0 = (it % tn) * 128;
            gemm_tile_k(g, H, 1024, Wt, 1024, m0, n0, 1024, lds);
            GEMM_FOREACH(P[(size_t)row * NP + col] = f2bf(g.acc[mi][ni][r]););
        } else {
            const int i2 = it - nt1; const int m0 = (i2 / tn2) * 128, n0 = (i2 % tn2) * 128;
            gemm_tile_k(g, (const bf16_t*)(ws + OFF_HM), 1024, (const bf16_t*)(ws + OFF_WKV), 1024, m0, n0, 1024, lds);
            bf16_t* KVM = (bf16_t*)(ws + OFF_KVM);
            GEMM_FOREACH(KVM[(size_t)row * 1024 + col] = f2bf(g.acc[mi][ni][r]););
        }
    }
}

DI void phase_attn_prep(const Params& p, unsigned char* lds, const int bid, const int nb) {
    unsigned char* ws = p.ws; bf16_t* P = (bf16_t*)(ws + OFF_P); bf16_t* KVM = (bf16_t*)(ws + OFF_KVM);
    const float2* rope = (const float2*)(ws + OFF_ROPE);
    const int lane = threadIdx.x & 63, wid = threadIdx.x >> 6;
    const long n1 = (long)M * 14, n2 = (long)MM * 4;
    for (long it = (long)bid * NWAVES + wid; it < n1 + n2; it += (long)nb * NWAVES) {
        if (it < n1) {
            const int row = (int)(it / 14), j = (int)(it % 14);
            if (j < 10) {
                bf16_t* ptr = P + (size_t)row * NP + (j < 8 ? C_Q + j * 64 : C_SK + (j - 8) * 64);
                const float g = j < 8 ? p.q_norm_g[lane] : p.k_norm_g[lane];
                const float xv = bf2f(ptr[lane]);
                const float ss = wave_sum(xv * xv);
                const float y = xv * rsqrtf(ss * (1.f / 64.f) + 1e-6f) * g;
                const float yp = __shfl_xor(y, 32, 64);
                const float2 cs = rope[(size_t)row * 32 + (lane & 31)];
                const float o = lane < 32 ? y * cs.x - yp * cs.y : y * cs.x + yp * cs.y;
                ptr[lane] = f2bf(o);
            } else {
                bf16_t* ptr = P + (size_t)row * NP + C_XQ + (j - 10) * 128;
                const float x0 = bf2f(ptr[lane]), x1 = bf2f(ptr[lane + 64]);
                const float ss = wave_sum(x0 * x0 + x1 * x1);
                const float rs = rsqrtf(ss * (1.f / 128.f) + 1e-6f);
                ptr[lane] = f2bf(x0 * rs * p.xq_norm_g[lane]); ptr[lane + 64] = f2bf(x1 * rs * p.xq_norm_g[lane + 64]);
            }
        } else {
            const long i2 = it - n1; const int row = (int)(i2 / 4), j = (int)(i2 % 4);
            bf16_t* ptr = KVM + (size_t)row * 1024 + j * 128;
            const float x0 = bf2f(ptr[lane]), x1 = bf2f(ptr[lane + 64]);
            const float ss = wave_sum(x0 * x0 + x1 * x1);
            const float rs = rsqrtf(ss * (1.f / 128.f) + 1e-6f);
            ptr[lane] = f2bf(x0 * rs * p.xk_norm_g[lane]); ptr[lane + 64] = f2bf(x1 * rs * p.xk_norm_g[lane + 64]);
        }
    }
}

DI void rwkv_stage(const Params& p, int b, int h, int t0, int ntok, float* ck, float* scratch  ) {
    const bf16_t* P = (const bf16_t*)(p.ws + OFF_P);
    const int lane = threadIdx.x & 63, wid = threadIdx.x >> 6, ch = h * 64 + lane;
    const float mu_r = p.mu_rkv[ch], mu_k = p.mu_rkv[512 + ch], mu_v = p.mu_rkv[1024 + ch], mu_w = p.mu_wa[lane], mu_a = p.mu_wa[64 + lane];
    const float w0c = p.w0[ch], a0c = p.a0[ch], kkc = p.k_k[ch], kac = p.k_a[ch];
    float* sc = scratch + wid * 128;
    for (int i = wid; i < ntok; i += NWAVES) {
        const int t = t0 + i; const bf16_t* pr = P + (size_t)(b * T + t) * NP; const bf16_t* pp = pr - NP; const bool hp = t > 0;
        const float rc = bf2f(pr[C_R + ch]), rp = hp ? bf2f(pp[C_R + ch]) : 0.f;
        const float kc = bf2f(pr[C_K + ch]), kp = hp ? bf2f(pp[C_K + ch]) : 0.f;
        const float vc = bf2f(pr[C_V + ch]), vp = hp ? bf2f(pp[C_V + ch]) : 0.f;
        const float wc = bf2f(pr[C_W + lane]), wp = hp ? bf2f(pp[C_W + lane]) : 0.f;
        const float ac = bf2f(pr[C_A + lane]), ap = hp ? bf2f(pp[C_A + lane]) : 0.f;
        const float r = rc + (rp - rc) * mu_r, k = kc + (kp - kc) * mu_k, v = vc + (vp - vc) * mu_v;
        const float lw = wc + (wp - wc) * mu_w, la = ac + (ap - ac) * mu_a;
        sc[lane] = tanhf(lw); sc[64 + lane] = la;
        float accw = 0.f, acca = 0.f;
#pragma unroll 8
        for (int j = 0; j < 64; ++j) { accw += sc[j] * p.w2[j * 512 + ch]; acca += sc[64 + j] * p.a2[j * 512 + ch]; }
        const float xw = -(w0c + accw);
        const float sp = xw > 20.f ? xw : log1pf(expf(xw));
        const float wlog = -sp - 0.5f;
        const float decay = expf(-expf(wlog));
        const float alpha = 1.f / (1.f + expf(-(a0c + acca)));
        const float kk0 = k * kkc;
        const float n2 = wave_sum(kk0 * kk0);
        const float kk = kk0 / fmaxf(sqrtf(n2), 1e-12f);
        const float k2 = k * (1.f + (alpha - 1.f) * kac);
        float* o = ck + i * 384;
        o[lane] = r; o[64 + lane] = decay; o[128 + lane] = k2; o[192 + lane] = v; o[256 + lane] = -kk; o[320 + lane] = kk * alpha;
    }
}

DI void phase_rwkv_direct(const Params& p, unsigned char* lds, const int bid, const int nb) {
    float* ck = (float*)lds; float* scratch = ck + 64 * 384;
    const int lane = threadIdx.x & 63, wid = threadIdx.x >> 6;
    const bf16_t* P = (const bf16_t*)(p.ws + OFF_P); bf16_t* YA = (bf16_t*)(p.ws + OFF_YA);
    for (int bh = bid; bh < BATCH * 8; bh += nb) {
        const int b = bh >> 3, h = bh & 7, ch = h * 64 + lane;
        float S[64];
#pragma unroll
        for (int k = 0; k < 64; ++k) S[k] = 0.f;
        const float rk = p.r_k[ch], lg = p.lnx_g[ch], lb = p.lnx_b[ch];
        for (int c = 0; c < T / 64; ++c) {
            __syncthreads();
            rwkv_stage(p, b, h, c * 64, 64, ck, scratch);
            __syncthreads();
            if (wid == 0) {
                for (int i = 0; i < 64; ++i) {
                    const float* cc = ck + i * 384;
                    float sa = 0.f;
#pragma unroll
                    for (int k = 0; k < 64; ++k) sa += S[k] * cc[256 + k];
                    const float vv = cc[192 + lane];
#pragma unroll
                    for (int k = 0; k < 64; ++k) S[k] = S[k] * cc[64 + k] + sa * cc[320 + k] + vv * cc[128 + k];
                    float y = 0.f;
#pragma unroll
                    for (int k = 0; k < 64; ++k) y += S[k] * cc[k];
                    const float mean = wave_sum(y) * (1.f / 64.f);
                    const float dy = y - mean;
                    const float var = wave_sum(dy * dy) * (1.f / 64.f);
                    const float yn = dy * rsqrtf(var + 64e-5f) * lg + lb;
                    const float bonus = wave_sum(cc[lane] * cc[128 + lane] * rk) * vv;
                    const int t = c * 64 + i; const size_t row = (size_t)(b * T + t);
                    const float z = bf2f(P[row * NP + C_ZA + ch]);
                    YA[row * 512 + ch] = f2bf((yn + bonus) * siluf_(z));
                }
            }
        }
    }
}

constexpr size_t AF_BYTES = 16384, NF_BYTES = 16384, NCHUNK = 64;
constexpr int CHT = 128;
constexpr size_t OFF_AF = 0, OFF_NF = (size_t)16 * NCHUNK * AF_BYTES;
constexpr size_t OFF_QH = OFF_NF + (size_t)16 * NCHUNK * NF_BYTES;
constexpr size_t OFF_BON = OFF_QH + (size_t)16 * T * 64 * 2;
static_assert(OFF_BON + (size_t)16 * T * 4 <= (size_t)M * 1024 * 4, "d_out scratch");
typedef float f32x16 __attribute__((ext_vector_type(16)));
#define MFMA32(a, b, c) __builtin_amdgcn_mfma_f32_32x32x16_bf16((a), (b), (c), 0, 0, 0)
typedef float f32x2 __attribute__((ext_vector_type(2)));

DI unsigned pk2f(float lo, float hi) { typedef float f2_ __attribute__((ext_vector_type(2))); typedef __bf16 b2_ __attribute__((ext_vector_type(2))); return __builtin_bit_cast(unsigned, __builtin_convertvector((f2_){lo, hi}, b2_)); }
DI float quad_sum(float s) {
    s += __int_as_float(__builtin_amdgcn_update_dpp(0, __float_as_int(s), 0xB1, 0xF, 0xF, true));
    s += __int_as_float(__builtin_amdgcn_update_dpp(0, __float_as_int(s), 0x4E, 0xF, 0xF, true));
    return s;
}

DI float rwkv_stage_tok(const Params& p, const bf16_t* P, int b, int h, int t, float* o, float* sc, float mu_r, float mu_k, float mu_v, float mu_w, float mu_a,
                        float w0c, float a0c, float kkc, float kac, float rkc) {
    const int lane = threadIdx.x & 63, ch = h * 64 + lane;
    const bf16_t* pr = P + (size_t)(b * T + t) * NP; const bf16_t* pp = pr - NP; const bool hp = t > 0;
    const float rc = bf2f(pr[C_R + ch]), rp = hp ? bf2f(pp[C_R + ch]) : 0.f;
    const float kc = bf2f(pr[C_K + ch]), kp = hp ? bf2f(pp[C_K + ch]) : 0.f;
    const float vc = bf2f(pr[C_V + ch]), vp = hp ? bf2f(pp[C_V + ch]) : 0.f;
    const float wc = bf2f(pr[C_W + lane]), wp = hp ? bf2f(pp[C_W + lane]) : 0.f;
    const float ac = bf2f(pr[C_A + lane]), ap = hp ? bf2f(pp[C_A + lane]) : 0.f;
    const float r = rc + (rp - rc) * mu_r, k = kc + (kp - kc) * mu_k, v = vc + (vp - vc) * mu_v;
    const float lw = wc + (wp - wc) * mu_w, la = ac + (ap - ac) * mu_a;
    sc[lane] = tanhf(lw); sc[64 + lane] = la;
    float accw = 0.f, acca = 0.f;
    const float* w2p = p.w2; const float* a2p = p.a2;
    asm volatile("" : "+s"(w2p), "+s"(a2p));
#pragma unroll 8
    for (int j = 0; j < 64; ++j) { accw += sc[j] * w2p[j * 512 + ch]; acca += sc[64 + j] * a2p[j * 512 + ch]; }
    const float xw = -(w0c + accw);
    const float sp = xw > 20.f ? xw : log1pf(expf(xw));
    const float decay = expf(-expf(-sp - 0.5f));
    const float alpha = 1.f / (1.f + expf(-(a0c + acca)));
    const float kk0 = k * kkc;
    const float n2 = wave_sum(kk0 * kk0);
    const float kk = kk0 / fmaxf(sqrtf(n2), 1e-12f);
    const float k2 = k * (1.f + (alpha - 1.f) * kac);
    o[lane] = r; o[64 + lane] = decay; o[128 + lane] = k2; o[192 + lane] = v; o[256 + lane] = -kk; o[320 + lane] = kk * alpha;
    return wave_sum(r * k2 * rkc);
}

typedef float f32x4_t __attribute__((ext_vector_type(4)));
DI float row16_sum(float x) {
    x += __int_as_float(__builtin_amdgcn_update_dpp(0, __float_as_int(x), 0x128, 0xF, 0xF, true));
    x += __int_as_float(__builtin_amdgcn_update_dpp(0, __float_as_int(x), 0x124, 0xF, 0xF, true));
    x += __int_as_float(__builtin_amdgcn_update_dpp(0, __float_as_int(x), 0x122, 0xF, 0xF, true));
    x += __int_as_float(__builtin_amdgcn_update_dpp(0, __float_as_int(x), 0x121, 0xF, 0xF, true));
    return x;
}
DI void build_lora_frags(const Params& p, int h, unsigned char* bfrag) {
    for (int fidx = threadIdx.x; fidx < 1024; fidx += NTHREADS) {
        const int mat = fidx >> 9, nt = (fidx >> 7) & 3, ks = (fidx >> 6) & 1, l = fidx & 63, n = l & 15, kg = l >> 4;
        const float* W = (mat ? p.a2 : p.w2) + (size_t)(32 * ks + 8 * kg) * 512 + h * 64 + 16 * nt + n;
        unsigned w[4];
#pragma unroll
        for (int e2 = 0; e2 < 4; ++e2) w[e2] = (unsigned)f2bf(W[(2 * e2) * 512]) | ((unsigned)f2bf(W[(2 * e2 + 1) * 512]) << 16);
        *(uint4*)(bfrag + fidx * 16) = make_uint4(w[0], w[1], w[2], w[3]);
    }
}
template <int PART, int RS, bool R3>
DI void stage16(const Params& p, const bf16_t* P, int b, int h, int tg0, int tg1, int tg2, int tg3, float* recs, const unsigned char* bfrag, float* bon_out  ) {
    asm volatile("" : "+s"(h));
    const int lane = threadIdx.x & 63, n = lane & 15, rg = lane >> 4;
    constexpr int FIELD = PART == 0 ? 0 : 128;
    {
        const float mu = PART == 0 ? p.mu_wa[lane] : p.mu_wa[64 + lane];
        const int colx = (PART == 0 ? C_W : C_A) + lane;
#pragma unroll
        for (int gi = 0; gi < 4; ++gi) {
            const int t0 = gi == 0 ? tg0 : gi == 1 ? tg1 : gi == 2 ? tg2 : tg3;
            const bf16_t* base = P + (size_t)(b * T + t0) * NP + colx;
            float prev = t0 > 0 ? bf2f(base[-NP]) : 0.f;
#pragma unroll
            for (int rr = 0; rr < 4; ++rr) {
                const float cur = bf2f(base[rr * NP]);
                const float x = cur + (prev - cur) * mu; prev = cur;
                float val = x;
                if (PART == 0) { const float e2 = __expf(2.f * x); val = 1.f - 2.f * __builtin_amdgcn_rcpf(1.f + e2); }
                *(bf16_t*)((unsigned char*)(recs + (gi * 4 + rr) * RS + FIELD) + 2 * lane) = f2bf(val);
            }
        }
    }
    f32x4 acc[4];
#pragma unroll
    for (int nt = 0; nt < 4; ++nt) acc[nt] = (f32x4){0.f, 0.f, 0.f, 0.f};
#pragma unroll
    for (int ks = 0; ks < 2; ++ks) {
        const bf16x8 af = *(const bf16x8*)((const unsigned char*)(recs + n * RS + FIELD) + ks * 64 + rg * 16);
#pragma unroll
        for (int nt = 0; nt < 4; ++nt) {
            const bf16x8 bfr = *(const bf16x8*)(bfrag + (((PART * 4 + nt) * 2 + ks) * 64 + lane) * 16);
            acc[nt] = __builtin_amdgcn_mfma_f32_16x16x32_bf16(af, bfr, acc[nt], 0, 0, 0);
        }
    }
    const int tgl = rg == 0 ? tg0 : rg == 1 ? tg1 : rg == 2 ? tg2 : tg3;
    const bf16_t* rowb = P + (size_t)(b * T + tgl) * NP;
    float* rec0 = recs + (4 * rg) * RS;
    const bool hp = tgl > 0;
    if (PART == 0) {
#pragma unroll
        for (int nt = 0; nt < 4; ++nt) {
            const int cl = 16 * nt + n, ch = h * 64 + cl;
            const float mu_r = p.mu_rkv[ch], mu_v = p.mu_rkv[1024 + ch], w0c = p.w0[ch];
            float rp = hp ? bf2f(rowb[-NP + C_R + ch]) : 0.f, vp = hp ? bf2f(rowb[-NP + C_V + ch]) : 0.f;
#pragma unroll
            for (int rr = 0; rr < 4; ++rr) {
                const float rc = bf2f(rowb[rr * NP + C_R + ch]), vc = bf2f(rowb[rr * NP + C_V + ch]);
                const float r = rc + (rp - rc) * mu_r, v = vc + (vp - vc) * mu_v; rp = rc; vp = vc;
                const float xw = -(w0c + acc[nt][rr]);
                const float sp = xw > 20.f ? xw : __logf(1.f + __expf(xw));
                const float decay = __expf(-__expf(-sp - 0.5f));
                float* o = rec0 + rr * RS;
                o[cl] = r; o[64 + cl] = decay; o[192 + cl] = v;
            }
        }
    } else {
        float kv[4][4], kk0[4][4], al[4][4], rv[4][4], n2[4] = {0.f, 0.f, 0.f, 0.f};
#pragma unroll
        for (int nt = 0; nt < 4; ++nt) {
            const int ch = h * 64 + 16 * nt + n;
            const float mu_k = p.mu_rkv[512 + ch], mu_r = p.mu_rkv[ch], a0c = p.a0[ch], kkc = p.k_k[ch];
            float kp = hp ? bf2f(rowb[-NP + C_K + ch]) : 0.f, rp = (R3 && hp) ? bf2f(rowb[-NP + C_R + ch]) : 0.f;
#pragma unroll
            for (int rr = 0; rr < 4; ++rr) {
                const float kc = bf2f(rowb[rr * NP + C_K + ch]);
                const float k = kc + (kp - kc) * mu_k; kp = kc;
                if (R3) { const float rc = bf2f(rowb[rr * NP + C_R + ch]); rv[nt][rr] = rc + (rp - rc) * mu_r; rp = rc; }
                kv[nt][rr] = k; kk0[nt][rr] = k * kkc; n2[rr] += kk0[nt][rr] * kk0[nt][rr];
                al[nt][rr] = __builtin_amdgcn_rcpf(1.f + __expf(-(a0c + acc[nt][rr])));
            }
        }
        float inv[4], bon[4] = {0.f, 0.f, 0.f, 0.f};
#pragma unroll
        for (int rr = 0; rr < 4; ++rr) inv[rr] = 1.f / fmaxf(sqrtf(row16_sum(n2[rr])), 1e-12f);
#pragma unroll
        for (int nt = 0; nt < 4; ++nt) {
            const int cl = 16 * nt + n, ch = h * 64 + cl;
            const float kac = p.k_a[ch], rkc = p.r_k[ch];
#pragma unroll
            for (int rr = 0; rr < 4; ++rr) {
                const float kk = kk0[nt][rr] * inv[rr], k2 = kv[nt][rr] * (1.f + (al[nt][rr] - 1.f) * kac);
                float* o = rec0 + rr * RS;
                o[128 + cl] = k2; o[256 + cl] = -kk; o[320 + cl] = kk * al[nt][rr];
                if (R3) bon[rr] += rv[nt][rr] * k2 * rkc;
            }
        }
        if (R3) {
#pragma unroll
            for (int rr = 0; rr < 4; ++rr) { const float bs = row16_sum(bon[rr]); if (n == 0) bon_out[tgl + rr] = bs; }
        }
    }
}

constexpr size_t OFF_LWF = OFF_YB, OFF_ALF = OFF_YC;
DI void lora_group(const Params& p, const bf16_t* P, int b, int h, int bh, int t0, unsigned char* scr, const unsigned char* bfrag) {
    int lane = threadIdx.x & 63; asm volatile("" : "+v"(lane));
    const int n = lane & 15, rg = lane >> 4;
    {
        const float mu_w = p.mu_wa[lane], mu_a = p.mu_wa[64 + lane];
#pragma unroll
        for (int u = 0; u < 3; ++u) {
            const int pi = lane + 64 * u, row = pi >> 3, p16 = pi & 7, tt = t0 - 1 + row;
            if (pi < 17 * 8) {
                uint4 vw = make_uint4(0u, 0u, 0u, 0u), va = make_uint4(0u, 0u, 0u, 0u);
                if (tt >= 0) { vw = *(const uint4*)(P + (size_t)(b * T + tt) * NP + C_W + p16 * 8); va = *(const uint4*)(P + (size_t)(b * T + tt) * NP + C_A + p16 * 8); }
                *(uint4*)(scr + row * 128 + p16 * 16) = vw; *(uint4*)(scr + 2176 + row * 128 + p16 * 16) = va;
            }
        }
        float rw[17], ra[17];
#pragma unroll
        for (int i = 0; i < 17; ++i) { rw[i] = bf2f(*(const bf16_t*)(scr + i * 128 + 2 * lane)); ra[i] = bf2f(*(const bf16_t*)(scr + 2176 + i * 128 + 2 * lane)); }
        asm volatile("" ::: "memory");
#pragma unroll
        for (int i = 0; i < 16; ++i) {
            const float xw = rw[i + 1] + (rw[i] - rw[i + 1]) * mu_w;
            const float e2 = __expf(2.f * xw);
            *(bf16_t*)(scr + (i + 1) * 128 + 2 * lane) = f2bf(1.f - 2.f * __builtin_amdgcn_rcpf(1.f + e2));
            *(bf16_t*)(scr + 2176 + (i + 1) * 128 + 2 * lane) = f2bf(ra[i + 1] + (ra[i] - ra[i + 1]) * mu_a);
        }
    }
    f32x4 accw[4], acca[4];
#pragma unroll
    for (int nt = 0; nt < 4; ++nt) { accw[nt] = (f32x4){0.f, 0.f, 0.f, 0.f}; acca[nt] = (f32x4){0.f, 0.f, 0.f, 0.f}; }
#pragma unroll
    for (int ks = 0; ks < 2; ++ks) {
        const bf16x8 afw = *(const bf16x8*)(scr + (n + 1) * 128 + ks * 64 + rg * 16), afa = *(const bf16x8*)(scr + 2176 + (n + 1) * 128 + ks * 64 + rg * 16);
#pragma unroll
        for (int nt = 0; nt < 4; ++nt) {
            accw[nt] = __builtin_amdgcn_mfma_f32_16x16x32_bf16(afw, *(const bf16x8*)(bfrag + ((nt * 2 + ks) * 64 + lane) * 16), accw[nt], 0, 0, 0);
            acca[nt] = __builtin_amdgcn_mfma_f32_16x16x32_bf16(afa, *(const bf16x8*)(bfrag + (((4 + nt) * 2 + ks) * 64 + lane) * 16), acca[nt], 0, 0, 0);
        }
    }
    uint2* lwf = (uint2*)(p.ws + OFF_LWF) + ((size_t)(bh * 512 + (t0 >> 4)) * 4) * 64 + lane;
    uint2* alf = (uint2*)(p.ws + OFF_ALF) + ((size_t)(bh * 512 + (t0 >> 4)) * 4) * 64 + lane;
#pragma unroll
    for (int nt = 0; nt < 4; ++nt) {
        const int ch = h * 64 + 16 * nt + n;
        const float w0c = p.w0[ch], a0c = p.a0[ch];
        float lw[4], al[4];
#pragma unroll
        for (int rr = 0; rr < 4; ++rr) { const float xw = -(w0c + accw[nt][rr]); const float sp = fmaxf(xw, 0.f) + __logf(1.f + __expf(-fabsf(xw))); lw[rr] = -__expf(-sp - 0.5f);
            al[rr] = __builtin_amdgcn_rcpf(1.f + __expf(-(a0c + acca[nt][rr]))); }
        lwf[nt * 64] = make_uint2(pk2f(lw[0], lw[1]), pk2f(lw[2], lw[3]));
        alf[nt * 64] = make_uint2(pk2f(al[0], al[1]), pk2f(al[2], al[3]));
    }
}
template <int PART>
DI void stage16s(const Params& p, const unsigned char* rawc  , int h, int bh, int t0, float* recs, float* bon_out, float (&Lb)[4]) {
    asm volatile("" : "+s"(h));
    int lane = threadIdx.x & 63; asm volatile("" : "+v"(lane));
    const int n = lane & 15, rg = lane >> 4;
    constexpr int RS = 384;
    const int tgl = t0 + 4 * rg;
    const unsigned char* rawl = rawc + (4 * rg) * 384;
    const float hpf = tgl > 0 ? 1.f : 0.f;
    float* rec0 = recs + (4 * rg) * RS;
    const uint2* lwf = (const uint2*)(p.ws + OFF_LWF) + ((size_t)(bh * 512 + (t0 >> 4)) * 4) * 64 + lane;
    const uint2* alf = (const uint2*)(p.ws + OFF_ALF) + ((size_t)(bh * 512 + (t0 >> 4)) * 4) * 64 + lane;
#define S16S_L(nt_) \
        float eL[4], eLm[4], eN[4]; { const uint2 lwp = lwf[(nt_) * 64]; float lw[4], pl[4]; \
        lw[0] = __uint_as_float(lwp.x << 16); lw[1] = __uint_as_float(lwp.x & 0xffff0000u); lw[2] = __uint_as_float(lwp.y << 16); lw[3] = __uint_as_float(lwp.y & 0xffff0000u); \
        pl[0] = lw[0]; pl[1] = pl[0] + lw[1]; pl[2] = pl[1] + lw[2]; pl[3] = pl[2] + lw[3]; \
        float inc = pl[3]; float y_ = __shfl_up(inc, 16, 64); if (rg >= 1) inc += y_; y_ = __shfl_up(inc, 32, 64); if (rg >= 2) inc += y_; \
        const float tot = __shfl(inc, 48 + n, 64); const float base_ = Lb[nt_] + inc - pl[3]; \
        _Pragma("unroll") for (int rr = 0; rr < 4; ++rr) { const float L = base_ + pl[rr]; const float Lc = fmaxf(L, -80.f), Lm = fmaxf(L - lw[rr], -80.f); eL[rr] = __expf(Lc); eLm[rr] = __expf(Lm); eN[rr] = __expf(-Lc); } \
        Lb[nt_] += tot; }
    if (PART == 0) {
#pragma unroll
        for (int nt = 0; nt < 4; ++nt) {
            S16S_L(nt)
            (void)eLm; (void)eN;
            const int cl = 16 * nt + n, ch = h * 64 + cl;
            const float mu_r = p.mu_rkv[ch], mu_v = p.mu_rkv[1024 + ch];
            float rr_[5], vv_[5];
#pragma unroll
            for (int r5 = 0; r5 < 5; ++r5) { rr_[r5] = bf2f(*(const bf16_t*)(rawl + r5 * 384 + cl * 2)); vv_[r5] = bf2f(*(const bf16_t*)(rawl + r5 * 384 + 256 + cl * 2)); }
            rr_[0] *= hpf; vv_[0] *= hpf;
#pragma unroll
            for (int rr = 0; rr < 4; ++rr) {
                const float r = rr_[rr + 1] + (rr_[rr] - rr_[rr + 1]) * mu_r, v = vv_[rr + 1] + (vv_[rr] - vv_[rr + 1]) * mu_v;
                float* o = rec0 + rr * RS;
                o[cl] = r * eL[rr]; o[192 + cl] = v;
            }
            asm volatile("" ::: "memory");
        }
    } else {
        float kv[4][4], n2[4] = {0.f, 0.f, 0.f, 0.f};
#pragma unroll
        for (int nt = 0; nt < 4; ++nt) {
            const int ch = h * 64 + 16 * nt + n;
            const float mu_k = p.mu_rkv[512 + ch], kkc = p.k_k[ch];
            float kk_[5];
#pragma unroll
            for (int r5 = 0; r5 < 5; ++r5) kk_[r5] = bf2f(*(const bf16_t*)(rawl + r5 * 384 + 128 + (16 * nt + n) * 2));
            kk_[0] *= hpf;
#pragma unroll
            for (int rr = 0; rr < 4; ++rr) { const float k = kk_[rr + 1] + (kk_[rr] - kk_[rr + 1]) * mu_k; kv[nt][rr] = k; const float k0 = k * kkc; n2[rr] += k0 * k0; }
        }
        float inv[4], bon[4] = {0.f, 0.f, 0.f, 0.f};
#pragma unroll
        for (int rr = 0; rr < 4; ++rr) inv[rr] = 1.f / fmaxf(sqrtf(row16_sum(n2[rr])), 1e-12f);
#pragma unroll
        for (int nt = 0; nt < 4; ++nt) {
            S16S_L(nt)
            (void)eL;
            const int cl = 16 * nt + n, ch = h * 64 + cl;
            const float kac = p.k_a[ch], rkc = p.r_k[ch], mu_r = p.mu_rkv[ch], kkc = p.k_k[ch];
            const uint2 alp = alf[nt * 64];
            const float al4[4] = {__uint_as_float(alp.x << 16), __uint_as_float(alp.x & 0xffff0000u), __uint_as_float(alp.y << 16), __uint_as_float(alp.y & 0xffff0000u)};
            float rr_[5];
#pragma unroll
            for (int r5 = 0; r5 < 5; ++r5) rr_[r5] = bf2f(*(const bf16_t*)(rawl + r5 * 384 + cl * 2));
            rr_[0] *= hpf;
#pragma unroll
            for (int rr = 0; rr < 4; ++rr) {
                const float r = rr_[rr + 1] + (rr_[rr] - rr_[rr + 1]) * mu_r;
                const float al = al4[rr];
                const float k = kv[nt][rr], kk = k * kkc * inv[rr], k2 = k * (1.f + (al - 1.f) * kac);
                float* o = rec0 + rr * RS;
                o[128 + cl] = k2 * eN[rr]; o[256 + cl] = -kk * eLm[rr]; o[320 + cl] = kk * al * eN[rr];
                bon[rr] += r * k2 * rkc;
            }
            asm volatile("" ::: "memory");
        }
#pragma unroll
        for (int rr = 0; rr < 4; ++rr) { const float bs = row16_sum(bon[rr]); if (n == 0) bon_out[tgl + rr] = bs; }
    }
#undef S16S_L
}
template <int MODE> DI void rwkv_step_s(float (&z)[4][16], const float* cc, int q, int g, float (&yo)[4]) {
    f32x4 av[4], bv[4], kv[4], rv[4];
#pragma unroll
    for (int u = 0; u < 4; ++u) { av[u] = *(const f32x4*)(cc + 256 + 16 * q + 4 * u); bv[u] = *(const f32x4*)(cc + 320 + 16 * q + 4 * u); rv[u] = *(const f32x4*)(cc + 16 * q + 4 * u);
        if (MODE == 1) kv[u] = *(const f32x4*)(cc + 128 + 16 * q + 4 * u); }
    f32x4 vr = (f32x4){0.f, 0.f, 0.f, 0.f};
    if (MODE == 1) vr = *(const f32x4*)(cc + 192 + 4 * g);
    float sa[4];
#pragma unroll
    for (int rr = 0; rr < 4; ++rr) {
        float s0 = 0.f, s1 = 0.f;
#pragma unroll
        for (int u = 0; u < 4; ++u) { s0 += z[rr][4 * u] * av[u][0] + z[rr][4 * u + 2] * av[u][2]; s1 += z[rr][4 * u + 1] * av[u][1] + z[rr][4 * u + 3] * av[u][3]; }
        sa[rr] = quad_sum(s0 + s1);
    }
#pragma unroll
    for (int rr = 0; rr < 4; ++rr)
#pragma unroll
        for (int u = 0; u < 4; ++u)
#pragma unroll
            for (int e = 0; e < 4; ++e) {
                float t = z[rr][4 * u + e] + sa[rr] * bv[u][e];
                if (MODE == 1) t += vr[rr] * kv[u][e];
                z[rr][4 * u + e] = t;
            }
#pragma unroll
    for (int rr = 0; rr < 4; ++rr) {
        float s0 = 0.f, s1 = 0.f;
#pragma unroll
        for (int u = 0; u < 4; ++u) { s0 += z[rr][4 * u] * rv[u][0] + z[rr][4 * u + 2] * rv[u][2]; s1 += z[rr][4 * u + 1] * rv[u][1] + z[rr][4 * u + 3] * rv[u][3]; }
        yo[rr] = quad_sum(s0 + s1);
    }
}

template <int MODE> DI void rwkv_step(float (&z)[4][16], const float* cc, int q, int g, float (&sa)[4], float (&yo)[4]) {
    f32x4 av[4], wv[4], bv[4], kv[4];
#pragma unroll
    for (int u = 0; u < 4; ++u) { av[u] = *(const f32x4*)(cc + 256 + 16 * q + 4 * u); wv[u] = *(const f32x4*)(cc + 64 + 16 * q + 4 * u); bv[u] = *(const f32x4*)(cc + 320 + 16 * q + 4 * u);
        if (MODE == 1) kv[u] = *(const f32x4*)(cc + 128 + 16 * q + 4 * u); }
    f32x4 vr = (f32x4){0.f, 0.f, 0.f, 0.f};
    if (MODE == 1) vr = *(const f32x4*)(cc + 192 + 4 * g);
#pragma unroll
    for (int rr = 0; rr < 4; ++rr) {
        float s0 = 0.f, s1 = 0.f;
#pragma unroll
        for (int u = 0; u < 4; ++u) { s0 += z[rr][4 * u] * av[u][0] + z[rr][4 * u + 2] * av[u][2]; s1 += z[rr][4 * u + 1] * av[u][1] + z[rr][4 * u + 3] * av[u][3]; }
        sa[rr] = quad_sum(s0 + s1);
    }
#pragma unroll
    for (int rr = 0; rr < 4; ++rr)
#pragma unroll
        for (int u = 0; u < 4; ++u)
#pragma unroll
            for (int e = 0; e < 4; ++e) {
                float t = sa[rr] * bv[u][e];
                if (MODE == 1) t += vr[rr] * kv[u][e];
                z[rr][4 * u + e] = z[rr][4 * u + e] * wv[u][e] + t;
            }
    f32x4 rv[4];
#pragma unroll
    for (int u = 0; u < 4; ++u) rv[u] = *(const f32x4*)(cc + 16 * q + 4 * u);
#pragma unroll
    for (int rr = 0; rr < 4; ++rr) {
        float s0 = 0.f, s1 = 0.f;
#pragma unroll
        for (int u = 0; u < 4; ++u) { s0 += z[rr][4 * u] * rv[u][0] + z[rr][4 * u + 2] * rv[u][2]; s1 += z[rr][4 * u + 1] * rv[u][1] + z[rr][4 * u + 3] * rv[u][3]; }
        yo[rr] = quad_sum(s0 + s1);
    }
}

DI void phase_rwkv_prep(const Params& p, unsigned char* lds, const int bid, const int nb) {
    float* ck = (float*)lds; unsigned char* bfrag = lds + 64 * 384 * 4; float* mat = (float*)lds;
    const bf16_t* P = (const bf16_t*)(p.ws + OFF_P);
    unsigned char* fr = (unsigned char*)p.out;
    bf16_t* YA = (bf16_t*)(p.ws + OFF_YA);
    for (int item = bid; item < 256; item += nb) {
        int tid = threadIdx.x; asm volatile("" : "+v"(tid));
        const int lane = tid & 63, wid = __builtin_amdgcn_readfirstlane(tid >> 6), q = lane & 3, g = lane >> 2, cl = wid & 3, role = wid >> 2;
        const int bh = item >> 4, cq = item & 15, b = bh >> 3, h = bh & 7;
        __syncthreads();
        build_lora_frags(p, h, bfrag);
        __syncthreads();
        {
#pragma unroll 1
            for (int gi = 0; gi < 4; ++gi) lora_group(p, P, b, h, bh, cq * 4 * CHT + (wid + 8 * gi) * 16, lds + wid * 4352, bfrag);
            asm volatile("s_waitcnt vmcnt(0)" ::: "memory");
            __syncthreads();
            if (tid == 0) __builtin_amdgcn_fence(__ATOMIC_ACQUIRE, "agent");
            asm volatile("s_waitcnt vmcnt(0)" ::: "memory");
        }
        float z[4][16];
#pragma unroll
        for (int rr = 0; rr < 4; ++rr)
#pragma unroll
            for (int c = 0; c < 16; ++c) z[rr][c] = (role == 0 && (4 * g + rr) == (16 * q + c)) ? 1.f : 0.f;
        bf16_t* qh = (bf16_t*)(fr + OFF_QH) + (size_t)bh * T * 64;
        float* bon = (float*)(fr + OFF_BON) + (size_t)bh * T;
        float Lb[4] = {0.f, 0.f, 0.f, 0.f};
        unsigned char* rawbuf = lds + 64 * 384 * 4 + 16384 + 2048;
#define RAW_DMA(sl_) do { int ln_ = lane; asm volatile("" : "+v"(ln_)); _Pragma("unroll") for (int u_ = 0; u_ < 4; ++u_) { const int slot_ = u_ * 8 + wid; if (slot_ < 26) { int pi = slot_ * 64 + ln_; pi = pi < 1632 ? pi : 1631; \
            const int clx = pi / 408, rem = pi - clx * 408, row = rem / 24, r2 = rem - row * 24, seg = r2 >> 3, p16 = r2 & 7; int tt = (cq * 4 + clx) * CHT + (sl_) * 16 - 1 + row; tt = tt < 0 ? 0 : tt; \
            __builtin_amdgcn_global_load_lds((const unsigned*)(P + (size_t)(b * T + tt) * NP + (seg == 0 ? C_R : seg == 1 ? C_K : C_V) + h * 64 + p16 * 8), (LAS unsigned*)(LASP(rawbuf) + slot_ * 1024), 16, 0, 0); } } } while (0)
        RAW_DMA(0);
#pragma unroll 1
        for (int sl = 0; sl < CHT / 16; ++sl) {
            const int tb = (cq * 4 + cl) * CHT + sl * 16;
            __syncthreads();
            if (role == 0) stage16s<0>(p, rawbuf + cl * 6528, h, bh, tb, ck + cl * 16 * 384, bon, Lb);
            else           stage16s<1>(p, rawbuf + cl * 6528, h, bh, tb, ck + cl * 16 * 384, bon, Lb);
            __syncthreads();
            if (sl + 1 < CHT / 16) RAW_DMA(sl + 1);
            float yo[4];
            if (role == 0) {
#pragma unroll 1
                for (int i = 0; i < 16; ++i) { rwkv_step_s<0>(z, ck + (cl * 16 + i) * 384, q, g, yo);
                    qh[(size_t)(tb + i) * 64 + 4 * g + q] = f2bf(q == 0 ? yo[0] : q == 1 ? yo[1] : q == 2 ? yo[2] : yo[3]); } }
            else {
#pragma unroll 1
                for (int i = 0; i < 16; ++i) { rwkv_step_s<1>(z, ck + (cl * 16 + i) * 384, q, g, yo);
                    YA[(size_t)(b * T + tb + i) * 512 + h * 64 + 4 * g + q] = f2bf(q == 0 ? yo[0] : q == 1 ? yo[1] : q == 2 ? yo[2] : yo[3]); } }
        }
        {
            float* gC = (float*)(lds + 64 * 384 * 4 + 16384) + wid * 64;
            __syncthreads();
            if ((lane >> 4) == 0) {
#pragma unroll
                for (int nt = 0; nt < 4; ++nt) gC[16 * nt + (lane & 15)] = __expf(fmaxf(Lb[nt], -80.f));
            }
            asm volatile("s_waitcnt lgkmcnt(0)" ::: "memory");
#pragma unroll
            for (int u = 0; u < 4; ++u) { const f32x4 g4 = *(const f32x4*)(gC + 16 * q + 4 * u);
#pragma unroll
                for (int rr = 0; rr < 4; ++rr)
#pragma unroll
                    for (int e = 0; e < 4; ++e) z[rr][4 * u + e] *= g4[e]; }
        }
        for (int pass = 0; pass < 2; ++pass) {
            __syncthreads();
            if (role == pass) {
#pragma unroll
                for (int rr = 0; rr < 4; ++rr)
#pragma unroll
                    for (int u = 0; u < 4; ++u) *(f32x4*)(mat + (cl * 64 + 4 * g + rr) * 68 + 16 * q + 4 * u) = (f32x4){z[rr][4 * u], z[rr][4 * u + 1], z[rr][4 * u + 2], z[rr][4 * u + 3]};
            }
            __syncthreads();
            int tidb = threadIdx.x; asm volatile("" : "+v"(tidb));
            if (pass == 0) {
                for (int it = tidb; it < 4 * 8 * 64; it += NTHREADS) {
                    const int clx = it >> 9, f = (it >> 6) & 7, l = it & 63, n16 = l & 15, gg = l >> 4, fi = f >> 1, fs = f & 1;
                    const size_t chunk = (size_t)bh * NCHUNK + cq * 4 + clx;
                    unsigned hi[4], lo[4];
#pragma unroll
                    for (int e2 = 0; e2 < 4; ++e2) {
                        unsigned short hs[2], ls[2];
#pragma unroll
                        for (int d = 0; d < 2; ++d) { const int e = 2 * e2 + d, kin = 32 * fs + 16 * (e >> 2) + 4 * gg + (e & 3), kout = 16 * fi + n16;
                            const float val = mat[(clx * 64 + kin) * 68 + kout]; hs[d] = f2bf(val); ls[d] = f2bf(val - bf2f(hs[d])); }
                        hi[e2] = (unsigned)hs[0] | ((unsigned)hs[1] << 16); lo[e2] = (unsigned)ls[0] | ((unsigned)ls[1] << 16);
                    }
                    unsigned char* dst = fr + OFF_AF + chunk * AF_BYTES + (size_t)((f * 2) * 64 + l) * 16;
                    *(uint4*)dst = make_uint4(hi[0], hi[1], hi[2], hi[3]);
                    *(uint4*)(dst + 64 * 16) = make_uint4(lo[0], lo[1], lo[2], lo[3]);
                }
            } else {
                for (int it = tidb; it < 4 * 4 * 4 * 64; it += NTHREADS) {
                    const int l = it & 63, fi = (it >> 6) & 3, w4 = (it >> 8) & 3, clx = it >> 10, gg = l >> 4;
                    const size_t chunk = (size_t)bh * NCHUNK + cq * 4 + clx;
                    const f32x4 v4 = *(const f32x4*)(mat + (clx * 64 + 16 * w4 + (l & 15)) * 68 + 16 * fi + 4 * gg);
                    *(f32x4*)(fr + OFF_NF + chunk * NF_BYTES + (size_t)(((w4 * 4 + fi) * 64 + l) * 4) * 4) = v4;
                }
            }
        }
    }
}

DI void split4x2(const f32x4& xa, const f32x4& xb, bf16x8& hi, bf16x8& lo) {
#pragma unroll
    for (int e = 0; e < 4; ++e) { const float va = xa[e], vb = xb[e]; const bf16_t ha = f2bf(va), hb = f2bf(vb);
        hi[e] = (short)ha; hi[4 + e] = (short)hb; lo[e] = (short)f2bf(va - bf2f(ha)); lo[4 + e] = (short)f2bf(vb - bf2f(hb)); }
}
DI void phase_rwkv_scan(const Params& p, unsigned char* lds, const int bh) {
    unsigned char* fr = (unsigned char*)p.out;
    const int tid = threadIdx.x, lane = tid & 63, wid = tid >> 6;
    const unsigned char* gA = fr + OFF_AF + (size_t)bh * NCHUNK * AF_BYTES;
    unsigned char* gN = fr + OFF_NF + (size_t)bh * NCHUNK * NF_BYTES;
    const bool loader = wid >= 4;
    const int wl = __builtin_amdgcn_readfirstlane(wid - 4);
#define SCAN_DMA(cc_) do { const unsigned char* ga_ = gA + (size_t)(cc_) * AF_BYTES + wl * 4096 + lane * 16; const unsigned char* gn_ = gN + (size_t)(cc_) * NF_BYTES + wl * 4096 + lane * 16; \
        __attribute__((address_space(3))) unsigned char* sl_ = LASP(lds) + ((cc_) & 3) * 32768 + wl * 4096; \
        _Pragma("unroll") for (int j_ = 0; j_ < 4; ++j_) __builtin_amdgcn_global_load_lds((const unsigned*)(ga_ + j_ * 1024), (__attribute__((address_space(3))) unsigned*)(sl_ + j_ * 1024), 16, 0, 0); \
        _Pragma("unroll") for (int j_ = 0; j_ < 4; ++j_) __builtin_amdgcn_global_load_lds((const unsigned*)(gn_ + j_ * 1024), (__attribute__((address_space(3))) unsigned*)(sl_ + 16384 + j_ * 1024), 16, 0, 0); } while (0)
    __syncthreads();
    if (loader) { SCAN_DMA(0); SCAN_DMA(1); SCAN_DMA(2); SCAN_DMA(3); asm volatile("s_waitcnt vmcnt(0)" ::: "memory"); }
    f32x4 X[4];
#pragma unroll
    for (int i = 0; i < 4; ++i) X[i] = (f32x4){0.f, 0.f, 0.f, 0.f};
    bf16x8 ah[8], al[8]; f32x4 nt[4];
#define SCAN_FRAGS(cc_) do { const unsigned char* s_ = lds + ((cc_) & 3) * 32768; \
        _Pragma("unroll") for (int f = 0; f < 8; ++f) { ah[f] = *(const bf16x8*)(s_ + ((f * 2) * 64 + lane) * 16); al[f] = *(const bf16x8*)(s_ + ((f * 2 + 1) * 64 + lane) * 16); } \
        _Pragma("unroll") for (int i = 0; i < 4; ++i) nt[i] = *(const f32x4*)(s_ + 16384 + ((wid * 4 + i) * 64 + lane) * 16); } while (0)
    asm volatile("s_waitcnt lgkmcnt(0)" ::: "memory"); __builtin_amdgcn_s_barrier(); asm volatile("" ::: "memory");
    if (!loader) SCAN_FRAGS(0);
    for (int c = 0; c < (int)NCHUNK; ++c) {
        if (loader) {
            if (c + 4 < (int)NCHUNK) { SCAN_DMA(c + 4); asm volatile("s_waitcnt vmcnt(16)" ::: "memory"); } else asm volatile("s_waitcnt vmcnt(0)" ::: "memory");
        } else {
            const int w4 = wid;
            float* gs = (float*)(gN + (size_t)c * NF_BYTES) + ((w4 * 4) * 64 + lane) * 4;
#pragma unroll
            for (int i = 0; i < 4; ++i) *(f32x4*)(gs + i * 256) = X[i];
            bf16x8 bhi[2], blo[2];
            split4x2(X[0], X[1], bhi[0], blo[0]); split4x2(X[2], X[3], bhi[1], blo[1]);
#pragma unroll
            for (int i = 0; i < 4; ++i) {
                f32x4 D = nt[i];
#pragma unroll
                for (int s = 0; s < 2; ++s) {
                    const int f = i * 2 + s;
                    D = __builtin_amdgcn_mfma_f32_16x16x32_bf16(ah[f], bhi[s], D, 0, 0, 0);
                    D = __builtin_amdgcn_mfma_f32_16x16x32_bf16(ah[f], blo[s], D, 0, 0, 0);
                    D = __builtin_amdgcn_mfma_f32_16x16x32_bf16(al[f], bhi[s], D, 0, 0, 0);
                }
                X[i] = D;
            }
            if (c + 1 < (int)NCHUNK) SCAN_FRAGS(c + 1);
        }
        asm volatile("s_waitcnt lgkmcnt(0)" ::: "memory"); __builtin_amdgcn_s_barrier(); asm volatile("" ::: "memory");
    }
    asm volatile("s_waitcnt vmcnt(0)" ::: "memory");
    __syncthreads();
    if (tid == 0) {
        __builtin_amdgcn_fence(__ATOMIC_RELEASE, "agent");
        asm volatile("s_waitcnt vmcnt(0)" ::: "memory");
        __hip_atomic_store((unsigned*)(p.ws + OFF_CTL + 32768 + 256) + bh, 1u, __ATOMIC_RELAXED, __HIP_MEMORY_SCOPE_AGENT);
    }
}

DI void rwkv_out_item(const Params& p, unsigned char* lds, const int item) {
    const bf16_t* P = (const bf16_t*)(p.ws + OFF_P); bf16_t* YA = (bf16_t*)(p.ws + OFF_YA);
    const unsigned char* fr = (const unsigned char*)p.out;
    int tid = threadIdx.x; asm volatile("" : "+v"(tid));
    const int lane = tid & 63, wid = __builtin_amdgcn_readfirstlane(tid >> 6), c = lane & 31, hh = lane >> 5;
    {
        const int chunkg = item * 2 + (wid >> 2), bh = chunkg >> 6, cc = chunkg & 63, b = bh >> 3, h = bh & 7, tt = wid & 3;
        const int t = cc * CHT + tt * 32 + c;
        const float* sf = (const float*)(fr + OFF_NF + (size_t)chunkg * NF_BYTES);
        const bf16_t* qh = (const bf16_t*)(fr + OFF_QH) + ((size_t)bh * T + t) * 64;
        bf16x8 qf[4];
#pragma unroll
        for (int ks = 0; ks < 4; ++ks) qf[ks] = *(const bf16x8*)(qh + 16 * ks + 8 * hh);
        f32x16 yt[2];
#pragma unroll
        for (int vt = 0; vt < 2; ++vt) {
#pragma unroll
            for (int i = 0; i < 16; ++i) yt[vt][i] = 0.f;
#pragma unroll
            for (int ks = 0; ks < 4; ++ks) {
                const int v = 32 * vt + c;
                const float* s0 = sf + (((v >> 4) * 4 + ks) * 64 + (v & 15) + 32 * hh) * 4;
                const f32x4 lo4 = *(const f32x4*)s0, hi4 = *(const f32x4*)(s0 + 64);
                bf16x8 ah, al;
#pragma unroll
                for (int e = 0; e < 4; ++e) { const bf16_t h0 = f2bf(lo4[e]), h1 = f2bf(hi4[e]); ah[e] = (short)h0; ah[4 + e] = (short)h1;
                    al[e] = (short)f2bf(lo4[e] - bf2f(h0)); al[4 + e] = (short)f2bf(hi4[e] - bf2f(h1)); }
                yt[vt] = MFMA32(ah, qf[ks], yt[vt]);
                yt[vt] = MFMA32(al, qf[ks], yt[vt]);
            }
        }
        const size_t row = (size_t)(b * T + t);
        bf16_t* yrow = YA + row * 512 + h * 64;
        float s1 = 0.f;
#pragma unroll
        for (int vt = 0; vt < 2; ++vt)
#pragma unroll
            for (int gq = 0; gq < 4; ++gq) {
                const uint2 yl = *(const uint2*)(yrow + 32 * vt + 8 * gq + 4 * hh);
                yt[vt][4 * gq] += __uint_as_float(yl.x << 16); yt[vt][4 * gq + 1] += __uint_as_float(yl.x & 0xffff0000u);
                yt[vt][4 * gq + 2] += __uint_as_float(yl.y << 16); yt[vt][4 * gq + 3] += __uint_as_float(yl.y & 0xffff0000u);
                s1 += (yt[vt][4 * gq] + yt[vt][4 * gq + 1]) + (yt[vt][4 * gq + 2] + yt[vt][4 * gq + 3]);
            }
        s1 += __shfl_xor(s1, 32, 64);
        const float mean = s1 * (1.f / 64.f);
        float s2 = 0.f;
#pragma unroll
        for (int vt = 0; vt < 2; ++vt)
#pragma unroll
            for (int i = 0; i < 16; ++i) { yt[vt][i] -= mean; s2 += yt[vt][i] * yt[vt][i]; }
        s2 += __shfl_xor(s2, 32, 64);
        const float rstd = rsqrtf(s2 * (1.f / 64.f) + 64e-5f);
        const float bon = *((const float*)(fr + OFF_BON) + (size_t)bh * T + t);
        const bf16_t* pr = P + row * NP; const bool hp = t > 0;
#pragma unroll
        for (int vt = 0; vt < 2; ++vt)
#pragma unroll
            for (int gq = 0; gq < 4; ++gq) {
                const int v0 = 32 * vt + 8 * gq + 4 * hh, ch = h * 64 + v0;
                const uint2 vc = *(const uint2*)(pr + C_V + ch), vp = hp ? *(const uint2*)(pr - NP + C_V + ch) : make_uint2(0u, 0u), zz = *(const uint2*)(pr + C_ZA + ch);
                const f32x4 mu = *(const f32x4*)(p.mu_rkv + 1024 + ch), lg = *(const f32x4*)(p.lnx_g + ch), lb = *(const f32x4*)(p.lnx_b + ch);
                float o[4];
#pragma unroll
                for (int e = 0; e < 4; ++e) {
                    const unsigned wc = e < 2 ? vc.x : vc.y, wp = e < 2 ? vp.x : vp.y, wz = e < 2 ? zz.x : zz.y;
                    const float vcur = (e & 1) ? __uint_as_float(wc & 0xffff0000u) : __uint_as_float(wc << 16), vprv = (e & 1) ? __uint_as_float(wp & 0xffff0000u) : __uint_as_float(wp << 16);
                    const float zv = (e & 1) ? __uint_as_float(wz & 0xffff0000u) : __uint_as_float(wz << 16);
                    const float vmix = vcur + (vprv - vcur) * mu[e];
                    o[e] = (yt[vt][4 * gq + e] * rstd * lg[e] + lb[e] + bon * vmix) * siluf_(zv);
                }
                *(uint2*)(yrow + v0) = make_uint2(pk2f(o[0], o[1]), pk2f(o[2], o[3]));
            }
    }
}

DI void phase_swa_simple(const Params& p, unsigned char* lds, const int bid, const int nb) {
    const bf16_t* P = (const bf16_t*)(p.ws + OFF_P); bf16_t* YB = (bf16_t*)(p.ws + OFF_YB);
    const long total = (long)BATCH * 8 * T;
    for (long it = (long)bid * NTHREADS + threadIdx.x; it < total; it += (long)nb * NTHREADS) {
        const int t = (int)(it % T), qh = (int)((it / T) % 8), b = (int)(it / ((long)T * 8)), kvh = qh >> 2;
        const size_t row = (size_t)(b * T + t);
        float q[64], acc[64];
        {
            const uint4* qp = (const uint4*)(P + row * NP + C_Q + qh * 64);
#pragma unroll
            for (int i = 0; i < 8; ++i) { const uint4 u = qp[i]; const unsigned w[4] = {u.x, u.y, u.z, u.w};
#pragma unroll
                for (int j = 0; j < 4; ++j) { q[i * 8 + j * 2] = __uint_as_float(w[j] << 16); q[i * 8 + j * 2 + 1] = __uint_as_float(w[j] & 0xffff0000u); } }
        }
#pragma unroll
        for (int d = 0; d < 64; ++d) acc[d] = 0.f;
        float m = p.sinks[qh], l = 1.f;
        for (int j = 0; j < 128; ++j) {
            const int s = t - 127 + j;
            if (s < 0) continue;
            const size_t krow = (size_t)(b * T + s) * NP;
            const uint4* kp = (const uint4*)(P + krow + C_SK + kvh * 64);
            float dot = 0.f;
#pragma unroll
            for (int i = 0; i < 8; ++i) { const uint4 u = kp[i]; const unsigned w[4] = {u.x, u.y, u.z, u.w};
#pragma unroll
                for (int jj = 0; jj < 4; ++jj) { dot += q[i * 8 + jj * 2] * __uint_as_float(w[jj] << 16) + q[i * 8 + jj * 2 + 1] * __uint_as_float(w[jj] & 0xffff0000u); } }
            const float sc = dot * 0.125f;
            const float mn = fmaxf(m, sc), corr = __expf(m - mn), pe = __expf(sc - mn);
            l = l * corr + pe; m = mn;
            const uint4* vp = (const uint4*)(P + krow + C_SV + kvh * 64);
#pragma unroll
            for (int i = 0; i < 8; ++i) { const uint4 u = vp[i]; const unsigned w[4] = {u.x, u.y, u.z, u.w};
#pragma unroll
                for (int jj = 0; jj < 4; ++jj) { acc[i * 8 + jj * 2] = acc[i * 8 + jj * 2] * corr + pe * __uint_as_float(w[jj] << 16);
                                                 acc[i * 8 + jj * 2 + 1] = acc[i * 8 + jj * 2 + 1] * corr + pe * __uint_as_float(w[jj] & 0xffff0000u); } }
        }
        const float inv = 1.f / l;
        const bf16_t* zp = P + row * NP + C_ZB + qh * 64; bf16_t* op = YB + row * 512 + qh * 64;
#pragma unroll
        for (int d = 0; d < 64; ++d) op[d] = f2bf(acc[d] * inv * siluf_(bf2f(zp[d])));
    }
}

DI void phase_xattn_simple(const Params& p, unsigned char* lds, const int bid, const int nb) {
    const bf16_t* P = (const bf16_t*)(p.ws + OFF_P); const bf16_t* KVM = (const bf16_t*)(p.ws + OFF_KVM); bf16_t* YC = (bf16_t*)(p.ws + OFF_YC);
    const int lane = threadIdx.x & 63, wid = threadIdx.x >> 6;
    const long total = (long)M * 4;
    const float scale = 0.08838834764831845f;
    for (long it = (long)bid * NWAVES + wid; it < total; it += (long)nb * NWAVES) {
        const int row = (int)(it >> 2), hd = (int)(it & 3), b = row / T;
        const bf16_t* qp = P + (size_t)row * NP + C_XQ + hd * 128;
        const bf16_t* kb = KVM + (size_t)(b * MEMLEN) * 1024 + hd * 128;
        float s[4] = {0.f, 0.f, 0.f, 0.f};
        for (int c = 0; c < 16; ++c) {
            const uint4 qu = *(const uint4*)(qp + c * 8); const unsigned qw[4] = {qu.x, qu.y, qu.z, qu.w};
#pragma unroll
            for (int i = 0; i < 4; ++i) {
                const uint4 ku = *(const uint4*)(kb + (size_t)(lane + 64 * i) * 1024 + c * 8); const unsigned kw[4] = {ku.x, ku.y, ku.z, ku.w};
#pragma unroll
                for (int j = 0; j < 4; ++j) s[i] += __uint_as_float(qw[j] << 16) * __uint_as_float(kw[j] << 16) + __uint_as_float(qw[j] & 0xffff0000u) * __uint_as_float(kw[j] & 0xffff0000u);
            }
        }
        float mx = -1e30f;
#pragma unroll
        for (int i = 0; i < 4; ++i) { s[i] *= scale; mx = fmaxf(mx, s[i]); }
        mx = wave_max(mx);
        float pe[4], sum = 0.f;
#pragma unroll
        for (int i = 0; i < 4; ++i) { pe[i] = __expf(s[i] - mx); sum += pe[i]; }
        sum = wave_sum(sum);
        const float inv = 1.f / sum;
        float o0 = 0.f, o1 = 0.f;
        const bf16_t* vb = kb + 512;
#pragma unroll
        for (int i = 0; i < 4; ++i)
            for (int mm = 0; mm < 64; ++mm) {
                const float pv = __shfl(pe[i], mm, 64);
                const bf16_t* vr = vb + (size_t)(mm + 64 * i) * 1024;
                o0 += pv * bf2f(vr[lane]); o1 += pv * bf2f(vr[lane + 64]);
            }
        const bf16_t* zp = P + (size_t)row * NP + C_ZC + hd * 128; bf16_t* op = YC + (size_t)row * 512 + hd * 128;
        op[lane] = f2bf(o0 * inv * siluf_(bf2f(zp[lane]))); op[lane + 64] = f2bf(o1 * inv * siluf_(bf2f(zp[lane + 64])));
    }
}

typedef short s16x4 __attribute__((ext_vector_type(4)));
DI int crow(int reg, int hh) { return (reg & 3) + 8 * (reg >> 2) + 4 * hh; }
template <int Dh> DI unsigned k_off(int row, int chunk) { return (unsigned)(row * (Dh * 2) + ((chunk ^ (row & (Dh / 8 - 1))) << 4)); }
DI bf16x8 pack8(const f32x16& x, int s) {
    bf16x8 r;
#pragma unroll
    for (int e = 0; e < 8; ++e) r[e] = (short)f2bf(x[8 * s + e]);
    return r;
}
DI unsigned pk2(float lo, float hi) { typedef float f2_ __attribute__((ext_vector_type(2))); typedef __bf16 b2_ __attribute__((ext_vector_type(2))); return __builtin_bit_cast(unsigned, __builtin_convertvector((f2_){lo, hi}, b2_)); }
DI void unpack8(const uint4& v, float (&x)[8]) { const unsigned w[4] = {v.x, v.y, v.z, v.w};
#pragma unroll
    for (int i = 0; i < 4; ++i) { x[2 * i] = __uint_as_float(w[i] << 16); x[2 * i + 1] = __uint_as_float(w[i] & 0xffff0000u); } }
DI uint4 pack8f(const float (&x)[8]) { return make_uint4(pk2(x[0], x[1]), pk2(x[2], x[3]), pk2(x[4], x[5]), pk2(x[6], x[7])); }
constexpr int VS = 528;

DI void swa_unit(const Params& p, unsigned char* lds, int unit) {
    const bf16_t* P = (const bf16_t*)(p.ws + OFF_P); bf16_t* YB = (bf16_t*)(p.ws + OFF_YB);
    int tid = threadIdx.x; asm volatile("" : "+v"(tid));
    const int lane = tid & 63, wid = __builtin_amdgcn_readfirstlane(tid >> 6), c = lane & 31, hh = lane >> 5;
    const int n = unit & 63, kvh = (unit >> 6) & 1, b = unit >> 7;
    unsigned char* Kl = lds; unsigned char* Vt = lds + 32768;
    __syncthreads();
#pragma unroll
    for (int u = 0; u < 4; ++u) {
        const int idx = tid + 512 * u;
        { const int row = idx >> 3, chunk = idx & 7, t = n * 128 - 128 + row, tc = t < 0 ? 0 : t;
          const uint4 v = *(const uint4*)(P + (size_t)(b * T + tc) * NP + C_SK + kvh * 64 + chunk * 8);
          float x[8]; unpack8(v, x);
          float ss = 0.f;
#pragma unroll
          for (int e = 0; e < 8; ++e) ss += x[e] * x[e];
          ss = quad_sum(ss); ss += __shfl_xor(ss, 4, 64);
          const float rs = rsqrtf(ss * (1.f / 64.f) + 1e-6f);
          const float2* rp = (const float2*)(p.ws + OFF_ROPE) + (size_t)(b * T + tc) * 32 + (chunk & 3) * 8;
          float o[8];
#pragma unroll
          for (int e = 0; e < 8; ++e) { const float y = x[e] * rs * p.k_norm_g[chunk * 8 + e]; const float yp = __shfl_xor(y, 4, 64); const float2 cs = rp[e];
              o[e] = chunk < 4 ? y * cs.x - yp * cs.y : y * cs.x + yp * cs.y; if (t < 0) o[e] = 0.f; }
          *(uint4*)(Kl + k_off<64>(row, chunk)) = pack8f(o); }
        { const int row = idx >> 3, chunk = idx & 7, t = n * 128 - 128 + row;
          uint4 v = make_uint4(0u, 0u, 0u, 0u);
          if (t >= 0) v = *(const uint4*)(P + (size_t)(b * T + t) * NP + C_SV + kvh * 64 + chunk * 8);
          *(uint4*)(Vt + k_off<64>(row, chunk)) = v; }
    }
    __syncthreads();
    const int qh = kvh * 4 + (wid >> 1), rh = wid & 1;
    const float sink = p.sinks[qh];
#pragma unroll 2
    for (int rt = 0; rt < 2; ++rt) {
        const int base = 64 * rh + 32 * rt;
        const size_t qrow = (size_t)(b * T + n * 128 + base + c);
        bf16x8 qf[4];
        {
            float xq[4][8]; float ss = 0.f;
#pragma unroll
            for (int ds = 0; ds < 4; ++ds) { unpack8(*(const uint4*)(P + qrow * NP + C_Q + qh * 64 + 16 * ds + 8 * hh), xq[ds]);
#pragma unroll
                for (int e = 0; e < 8; ++e) ss += xq[ds][e] * xq[ds][e]; }
            ss += __shfl_xor(ss, 32, 64);
            const float rs = rsqrtf(ss * (1.f / 64.f) + 1e-6f);
#pragma unroll
            for (int ds = 0; ds < 4; ++ds)
#pragma unroll
                for (int e = 0; e < 8; ++e) xq[ds][e] *= rs * p.q_norm_g[16 * ds + 8 * hh + e];
            const float2* rp = (const float2*)(p.ws + OFF_ROPE) + qrow * 32 + 8 * hh;
#pragma unroll
            for (int ds = 0; ds < 2; ++ds) { float lo[8], hi[8];
#pragma unroll
                for (int e = 0; e < 8; ++e) { const float2 cs = rp[16 * ds + e]; lo[e] = xq[ds][e] * cs.x - xq[ds + 2][e] * cs.y; hi[e] = xq[ds + 2][e] * cs.x + xq[ds][e] * cs.y; }
                qf[ds] = __builtin_bit_cast(bf16x8, pack8f(lo)); qf[ds + 2] = __builtin_bit_cast(bf16x8, pack8f(hi)); }
        }
        f32x16 st[5];
#pragma unroll
        for (int kt = 0; kt < 5; ++kt) {
#pragma unroll
            for (int i = 0; i < 16; ++i) st[kt][i] = 0.f;
#pragma unroll
            for (int ds = 0; ds < 4; ++ds) { const bf16x8 a = *(const bf16x8*)(Kl + k_off<64>(base + 32 * kt + c, 2 * ds + hh)); st[kt] = MFMA32(a, qf[ds], st[kt]); }
        }
        float mx = sink;
#pragma unroll
        for (int kt = 0; kt < 5; ++kt)
#pragma unroll
            for (int i = 0; i < 16; ++i) {
                const int cr = crow(i, hh);
                bool ok = true;
                if (kt == 0) ok = cr > c;
                if (kt == 4) ok = cr <= c;
                if (n == 0) ok = ok && (base + 32 * kt + cr >= 128);
                const float s = ok ? st[kt][i] * 0.125f : -1e30f;
                st[kt][i] = s; mx = fmaxf(mx, s);
            }
        mx = fmaxf(mx, __shfl_xor(mx, 32, 64));
        float ls = 0.f;
#pragma unroll
        for (int kt = 0; kt < 5; ++kt)
#pragma unroll
            for (int i = 0; i < 16; ++i) { const float pe = __expf(st[kt][i] - mx); st[kt][i] = pe; ls += pe; }
        ls += __shfl_xor(ls, 32, 64);
        const float inv = 1.f / (ls + __expf(sink - mx));
        f32x16 ot[2];
#pragma unroll
        for (int dt = 0; dt < 2; ++dt)
#pragma unroll
            for (int i = 0; i < 16; ++i) ot[dt][i] = 0.f;
#pragma unroll
        for (int kt = 0; kt < 5; ++kt)
#pragma unroll
            for (int s = 0; s < 2; ++s) {
                const bf16x8 pf = pack8(st[kt], s);
#pragma unroll
                for (int dt = 0; dt < 2; ++dt) {
                    const int key0 = base + 32 * kt + 16 * s + 4 * hh + ((lane & 15) >> 2), ch16 = 4 * dt + 2 * ((lane >> 4) & 1) + ((lane & 3) >> 1), sub = (lane & 1) * 8;
                    const s16x4 lo = __builtin_amdgcn_ds_read_tr16_b64_v4i16((LAS s16x4*)(Vt + k_off<64>(key0, ch16) + sub));
                    const s16x4 hi = __builtin_amdgcn_ds_read_tr16_b64_v4i16((LAS s16x4*)(Vt + k_off<64>(key0 + 8, ch16) + sub));
                    const bf16x8 vf = __builtin_shufflevector(lo, hi, 0, 1, 2, 3, 4, 5, 6, 7);
                    ot[dt] = MFMA32(vf, pf, ot[dt]);
                }
            }
        const bf16_t* zp = P + qrow * NP + C_ZB + qh * 64; bf16_t* op = YB + qrow * 512 + qh * 64;
#pragma unroll
        for (int dt = 0; dt < 2; ++dt)
#pragma unroll
            for (int gq = 0; gq < 4; ++gq) {
                const int d0 = 32 * dt + 8 * gq + 4 * hh;
                const uint2 zz = *(const uint2*)(zp + d0);
                const float z0 = __uint_as_float(zz.x << 16), z1 = __uint_as_float(zz.x & 0xffff0000u), z2 = __uint_as_float(zz.y << 16), z3 = __uint_as_float(zz.y & 0xffff0000u);
                const unsigned o0 = (unsigned)f2bf(ot[dt][4 * gq] * inv * siluf_(z0)) | ((unsigned)f2bf(ot[dt][4 * gq + 1] * inv * siluf_(z1)) << 16);
                const unsigned o1 = (unsigned)f2bf(ot[dt][4 * gq + 2] * inv * siluf_(z2)) | ((unsigned)f2bf(ot[dt][4 * gq + 3] * inv * siluf_(z3)) << 16);
                *(uint2*)(op + d0) = make_uint2(o0, o1);
            }
    }
}

DI void xattn_unit(const Params& p, unsigned char* lds, int unit) {
    const bf16_t* P = (const bf16_t*)(p.ws + OFF_P); const bf16_t* KVM = (const bf16_t*)(p.ws + OFF_KVM); bf16_t* YC = (bf16_t*)(p.ws + OFF_YC);
    int tid = threadIdx.x; asm volatile("" : "+v"(tid));
    const int lane = tid & 63, wid = __builtin_amdgcn_readfirstlane(tid >> 6), c = lane & 31, hh = lane >> 5;
    const int qb = unit & 31, hd = (unit >> 5) & 3, b = unit >> 7;
    unsigned char* Kl = lds; unsigned char* Vt = lds + 65536;
    const bf16_t* kb = KVM + (size_t)(b * MEMLEN) * 1024 + hd * 128;
    __syncthreads();
#pragma unroll
    for (int u = 0; u < 8; ++u) {
        const int idx = tid + 512 * u;
        { const int row = idx >> 4, chunk = idx & 15;
          float x[8]; unpack8(*(const uint4*)(kb + (size_t)row * 1024 + chunk * 8), x);
          float ss = 0.f;
#pragma unroll
          for (int e = 0; e < 8; ++e) ss += x[e] * x[e];
          const float rs = rsqrtf(row16_sum(ss) * (1.f / 128.f) + 1e-6f);
#pragma unroll
          for (int e = 0; e < 8; ++e) x[e] *= rs * p.xk_norm_g[chunk * 8 + e];
          *(uint4*)(Kl + k_off<128>(row, chunk)) = pack8f(x); }
        { const int row = idx >> 4, chunk = idx & 15;
          *(uint4*)(Vt + k_off<128>(row, chunk)) = *(const uint4*)(kb + (size_t)row * 1024 + 512 + chunk * 8); }
    }
    __syncthreads();
    const size_t qrow = (size_t)(b * T + qb * 256 + wid * 32 + c);
    const float scale = 0.08838834764831845f;
    bf16x8 qf[8];
    {
        float ss = 0.f; uint4 raw[8];
#pragma unroll
        for (int ds = 0; ds < 8; ++ds) { raw[ds] = *(const uint4*)(P + qrow * NP + C_XQ + hd * 128 + 16 * ds + 8 * hh); float x[8]; unpack8(raw[ds], x);
#pragma unroll
            for (int e = 0; e < 8; ++e) ss += x[e] * x[e]; }
        ss += __shfl_xor(ss, 32, 64);
        const float rs = rsqrtf(ss * (1.f / 128.f) + 1e-6f);
#pragma unroll
        for (int ds = 0; ds < 8; ++ds) { float x[8]; unpack8(raw[ds], x);
#pragma unroll
            for (int e = 0; e < 8; ++e) x[e] *= rs * p.xq_norm_g[16 * ds + 8 * hh + e];
            qf[ds] = __builtin_bit_cast(bf16x8, pack8f(x)); }
    }
    f32x16 ot[4];
#pragma unroll
    for (int dt = 0; dt < 4; ++dt)
#pragma unroll
        for (int i = 0; i < 16; ++i) ot[dt][i] = 0.f;
    float mrun = -1e30f, lrun = 0.f;
#pragma unroll 1
    for (int half = 0; half < 2; ++half) {
        f32x16 st[4];
#pragma unroll
        for (int kt = 0; kt < 4; ++kt) {
#pragma unroll
            for (int i = 0; i < 16; ++i) st[kt][i] = 0.f;
#pragma unroll
            for (int ds = 0; ds < 8; ++ds) { const bf16x8 a = *(const bf16x8*)(Kl + k_off<128>(128 * half + 32 * kt + c, 2 * ds + hh)); st[kt] = MFMA32(a, qf[ds], st[kt]); }
        }
        float mx = mrun;
#pragma unroll
        for (int kt = 0; kt < 4; ++kt)
#pragma unroll
            for (int i = 0; i < 16; ++i) { st[kt][i] *= scale; mx = fmaxf(mx, st[kt][i]); }
        mx = fmaxf(mx, __shfl_xor(mx, 32, 64));
        const float corr = __expf(mrun - mx);
        float ls = 0.f;
#pragma unroll
        for (int kt = 0; kt < 4; ++kt)
#pragma unroll
            for (int i = 0; i < 16; ++i) { const float pe = __expf(st[kt][i] - mx); st[kt][i] = pe; ls += pe; }
        ls += __shfl_xor(ls, 32, 64);
        lrun = lrun * corr + ls; mrun = mx;
#pragma unroll
        for (int dt = 0; dt < 4; ++dt)
#pragma unroll
            for (int i = 0; i < 16; ++i) ot[dt][i] *= corr;
#pragma unroll
        for (int kt = 0; kt < 4; ++kt)
#pragma unroll
            for (int s = 0; s < 2; ++s) {
                const bf16x8 pf = pack8(st[kt], s);
#pragma unroll
                for (int dt = 0; dt < 4; ++dt) {
                    const int key0 = 128 * half + 32 * kt + 16 * s + 4 * hh + ((lane & 15) >> 2), ch16 = 4 * dt + 2 * ((lane >> 4) & 1) + ((lane & 3) >> 1), sub = (lane & 1) * 8;
                    const s16x4 lo = __builtin_amdgcn_ds_read_tr16_b64_v4i16((LAS s16x4*)(Vt + k_off<128>(key0, ch16) + sub));
                    const s16x4 hi = __builtin_amdgcn_ds_read_tr16_b64_v4i16((LAS s16x4*)(Vt + k_off<128>(key0 + 8, ch16) + sub));
                    const bf16x8 vf = __builtin_shufflevector(lo, hi, 0, 1, 2, 3, 4, 5, 6, 7);
                    ot[dt] = MFMA32(vf, pf, ot[dt]);
                }
            }
    }
    const float inv = 1.f / lrun;
    const bf16_t* zp = P + qrow * NP + C_ZC + hd * 128; bf16_t* op = YC + qrow * 512 + hd * 128;
#pragma unroll
    for (int dt = 0; dt < 4; ++dt)
#pragma unroll
        for (int gq = 0; gq < 4; ++gq) {
            const int d0 = 32 * dt + 8 * gq + 4 * hh;
            const uint2 zz = *(const uint2*)(zp + d0);
            const float z0 = __uint_as_float(zz.x << 16), z1 = __uint_as_float(zz.x & 0xffff0000u), z2 = __uint_as_float(zz.y << 16), z3 = __uint_as_float(zz.y & 0xffff0000u);
            const unsigned o0 = (unsigned)f2bf(ot[dt][4 * gq] * inv * siluf_(z0)) | ((unsigned)f2bf(ot[dt][4 * gq + 1] * inv * siluf_(z1)) << 16);
            const unsigned o1 = (unsigned)f2bf(ot[dt][4 * gq + 2] * inv * siluf_(z2)) | ((unsigned)f2bf(ot[dt][4 * gq + 3] * inv * siluf_(z3)) << 16);
            *(uint2*)(op + d0) = make_uint2(o0, o1);
        }
}
DI void phase_attn_queue(const Params& p, unsigned char* lds) {
    unsigned* head = (unsigned*)(p.ws + OFF_CTL + 32768);
    volatile LAS unsigned* bc = (volatile LAS unsigned*)(lds + LDS_CTL_OFF + 128);
    for (;;) {
        __syncthreads();
        if (threadIdx.x == 0) bc[0] = __hip_atomic_fetch_add(head, 1u, __ATOMIC_RELAXED, __HIP_MEMORY_SCOPE_AGENT);
        __syncthreads();
        const unsigned u = bc[0];
        if (u >= 1024u + 172u) break;
        if (u >= 512u && u < 684u) { convert_late(p, lds, (int)u - 512, 172); continue; }
        if (u < 512u) { if (u & 1u) xattn_unit(p, lds, (int)(u >> 1)); else swa_unit(p, lds, (int)(u >> 1)); }
        else {
            const int item = (int)u - 684, bh = item >> 5;
            if (threadIdx.x == 0) {
                unsigned* flag = (unsigned*)(p.ws + OFF_CTL + 32768 + 256) + bh; unsigned sp = 0;
                while (__hip_atomic_load(flag, __ATOMIC_RELAXED, __HIP_MEMORY_SCOPE_AGENT) == 0u) { __builtin_amdgcn_s_sleep(8); if (++sp > (1u << 22)) break; }
                __builtin_amdgcn_fence(__ATOMIC_ACQUIRE, "agent");
                asm volatile("s_waitcnt vmcnt(0)" ::: "memory");
            }
            __syncthreads();
            rwkv_out_item(p, lds, item);
        }
    }
}

namespace pg8 {
#define PG8_LAS __attribute__((address_space(3)))
typedef unsigned short bf16_t;
typedef short bf16x8 __attribute__((ext_vector_type(8)));
typedef float f32x4 __attribute__((ext_vector_type(4)));
typedef unsigned u32x4 __attribute__((ext_vector_type(4)));
constexpr int BM = 256, BK = 64, HALF = 128, HTB = HALF * BK * 2  , STAGE_BYTES = 8 * HTB, NXCD = 8, WGM = 8;

__host__ __device__ __forceinline__ int lds_byte(int r, int c) { const int st = (r >> 4) * 2 + (c >> 5), rr = r & 15, cc = c & 31, ob = rr * 64 + cc * 2; return st * 1024 + (ob ^ (((ob >> 9) & 1) << 5)); }
__host__ __device__ __forceinline__ void stage_rc(int b, int& R, int& C) { const int st = b / 1024, sb = b % 1024, swz = sb ^ (((sb >> 9) & 1) << 5); R = (st >> 1) * 16 + swz / 64; C = (st & 1) * 32 + (swz % 64) / 2; }
__host__ __device__ __forceinline__ int perm32(int rho) { const int n = rho >> 4, i = rho & 15; return 8 * (i >> 2) + 4 * n + (i & 3); }

struct Unit { int pm, pn; };
struct Gemm { const bf16_t* A; const bf16_t* Bt; int M, N, K; };

struct StaticOrder {
    int nM, nN, nwg, G, c;
    __host__ __device__ void init(int M, int N, int G_, int c_) { nM = M / BM; nN = N / BM; nwg = nM * nN; G = G_; c = c_; }
    __host__ __device__ bool next(int i, Unit& u) const {
        const long L = (long)i * G + c; if (L >= nwg) return false;
        int wgid = (int)L; { const int q = nwg / NXCD, r = nwg % NXCD, xcd = wgid % NXCD, off = wgid / NXCD; wgid = (xcd < r ? xcd * (q + 1) : r * (q + 1) + (xcd - r) * q) + off; }
        const int nig = WGM * nN, gid = wgid / nig, fm = gid * WGM, gsz = (nM - fm) < WGM ? (nM - fm) : WGM;
        u.pm = fm + ((wgid % nig) % gsz); u.pn = (wgid % nig) / gsz; return true;
    }
    __device__ __forceinline__ void a_ready(const Unit&) const {}
    __device__ __forceinline__ void done(const Unit&) const {}
};
__device__ __forceinline__ unsigned cvt_pk_bf16(float lo, float hi) { typedef float f2_ __attribute__((ext_vector_type(2))); typedef __bf16 b2_ __attribute__((ext_vector_type(2))); return __builtin_bit_cast(unsigned, __builtin_convertvector((f2_){lo, hi}, b2_)); }
typedef float f32x2 __attribute__((ext_vector_type(2)));
template <class Epi, class Sched, bool ALIGN_EPI = false, bool SP2 = false>
__device__ __forceinline__ void gemm_phase(PG8_LAS unsigned char* lds, const Gemm g, const Sched& S, const Epi& E) {
    int tid = threadIdx.x; asm volatile("" : "+v"(tid));
    const int wid = __builtin_amdgcn_readfirstlane(tid >> 6), lane = tid & 63, wr = wid >> 2, wc = wid & 3, fr = lane & 15, fq = lane >> 4;
    const int K = g.K, nt = K / BK;
    unsigned voffA[2], voffB[2];
#pragma unroll
    for (int i = 0; i < 2; ++i) { int R, C; stage_rc(tid * 16 + i * 8192, R, C); const int Rb = Epi::PERM ? ((R & ~31) + perm32(R & 31)) : R;
        voffA[i] = (unsigned)(R * K + C) * 2u; voffB[i] = (unsigned)(Rb * K + C) * 2u; }
    const size_t kstep = (size_t)(BK * 2);
    const size_t hstep = (size_t)HALF * K * 2;
    const size_t tstep = 2 * hstep;
    const unsigned ldsw = (unsigned)wid * 1024u;
    const int aoff = lds_byte(wr * 64 + fr, fq * 8), boff = lds_byte(wc * 32 + fr, fq * 8);
#define PG8_SA(b, h) (((b) * 2 + (h)) * HTB)
#define PG8_SB(b, h) ((4 + (b) * 2 + (h)) * HTB)
#define PG8_STAGE(bufoff, gbase, voff) do { _Pragma("unroll") for (int _i = 0; _i < 2; ++_i) \
        __builtin_amdgcn_global_load_lds((const unsigned*)((const char*)(gbase) + (voff)[_i]), (PG8_LAS unsigned*)(lds + (bufoff) + ldsw + _i * 8192), 16, 0, 0); } while (0)
#define PG8_LDA(dst, b, h) do { _Pragma("unroll") for (int m = 0; m < 4; ++m) _Pragma("unroll") for (int k = 0; k < 2; ++k) dst[m][k] = *(const PG8_LAS bf16x8*)(lds + PG8_SA(b, h) + aoff + m * 2048 + k * 1024); } while (0)
#define PG8_LDB(dst, b, h) do { _Pragma("unroll") for (int n = 0; n < 2; ++n) _Pragma("unroll") for (int k = 0; k < 2; ++k) dst[n][k] = *(const PG8_LAS bf16x8*)(lds + PG8_SB(b, h) + boff + n * 2048 + k * 1024); } while (0)
#define PG8_MMA(ai, bj, At, Bt) do { __builtin_amdgcn_s_setprio(1); _Pragma("unroll") for (int m = 0; m < 4; ++m) _Pragma("unroll") for (int n = 0; n < 2; ++n) _Pragma("unroll") for (int k = 0; k < 2; ++k) \
        acc[ai][bj][m][n] = __builtin_amdgcn_mfma_f32_16x16x32_bf16(Bt[n][k], At[m][k], acc[ai][bj][m][n], 0, 0, 0); __builtin_amdgcn_s_setprio(0); } while (0)
#define PG8_WAIT_V(n) asm volatile("s_waitcnt vmcnt(" #n ")" ::: "memory")
#define PG8_WAIT_L(n) asm volatile("s_waitcnt lgkmcnt(" #n ")" ::: "memory")
#define PG8_BAR __builtin_amdgcn_s_barrier()
#define PG8_SCHED __builtin_amdgcn_sched_barrier(0)
    Unit cur, nxt; int ui = 0;
    if (!S.next(0, cur)) return;
    f32x4 acc[2][2][4][2];
#pragma unroll
    for (int a = 0; a < 2; ++a)
#pragma unroll
        for (int b = 0; b < 2; ++b)
#pragma unroll
            for (int m = 0; m < 4; ++m)
#pragma unroll
                for (int n = 0; n < 2; ++n) acc[a][b][m][n] = (f32x4){0.f, 0.f, 0.f, 0.f};
    bf16x8 At[4][2], B0[2][2], B1[2][2];
    const char* cA = (const char*)g.A + (size_t)cur.pm * tstep; const char* cB = (const char*)g.Bt + (size_t)cur.pn * tstep;
    S.a_ready(cur);
    if constexpr (SP2) {
        PG8_STAGE(PG8_SB(0, 0), cB, voffB); PG8_STAGE(PG8_SB(0, 1), cB + hstep, voffB); PG8_STAGE(PG8_SA(0, 0), cA, voffA); PG8_STAGE(PG8_SA(0, 1), cA + hstep, voffA);
        if (wr == 1) PG8_BAR;
        PG8_WAIT_V(2); PG8_BAR;
        PG8_STAGE(PG8_SB(1, 0), cB + kstep, voffB); PG8_STAGE(PG8_SA(1, 0), cA + kstep, voffA); PG8_STAGE(PG8_SB(1, 1), cB + hstep + kstep, voffB);
        PG8_WAIT_V(6); PG8_BAR;
    } else {
        PG8_STAGE(PG8_SB(0, 0), cB, voffB); PG8_STAGE(PG8_SA(0, 0), cA, voffA); PG8_STAGE(PG8_SB(0, 1), cB + hstep, voffB); PG8_STAGE(PG8_SA(0, 1), cA + hstep, voffA);
        if (wr == 1) PG8_BAR;
        PG8_WAIT_V(4); PG8_BAR;
        PG8_STAGE(PG8_SB(1, 0), cB + kstep, voffB); PG8_STAGE(PG8_SA(1, 0), cA + kstep, voffA); PG8_STAGE(PG8_SB(1, 1), cB + hstep + kstep, voffB);
        PG8_WAIT_V(6); PG8_BAR;
    }
    for (;;) {
        const bool has_next = S.next(ui + 1, nxt);
        const char* nA = has_next ? (const char*)g.A + (size_t)nxt.pm * tstep : cA; const char* nB = has_next ? (const char*)g.Bt + (size_t)nxt.pn * tstep : cB;
        for (int t = 0; t < nt; t += 2) {
            const bool last = (t == nt - 2);
            const char* a1 = cA + (size_t)(t + 1) * kstep;
            const char* a2 = last ? nA : cA + (size_t)(t + 2) * kstep; const char* b2 = last ? nB : cB + (size_t)(t + 2) * kstep;
            const char* a3 = a2 + kstep; const char* b3 = b2 + kstep;
            if (last && has_next) S.a_ready(nxt);
            if constexpr (SP2) {
            PG8_LDB(B0, 0, 0); PG8_LDB(B1, 0, 1); PG8_SCHED; PG8_LDA(At, 0, 0); PG8_STAGE(PG8_SA(1, 1), a1 + hstep, voffA);
            PG8_WAIT_V(8); PG8_WAIT_L(0); PG8_BAR; PG8_MMA(0, 0, At, B0); PG8_MMA(0, 1, At, B1); PG8_BAR; PG8_SCHED;
            PG8_LDA(At, 0, 1); PG8_STAGE(PG8_SB(0, 0), b2, voffB); PG8_STAGE(PG8_SB(0, 1), b2 + hstep, voffB); PG8_STAGE(PG8_SA(0, 0), a2, voffA);
            PG8_WAIT_V(8); PG8_WAIT_L(0); PG8_BAR; PG8_MMA(1, 0, At, B0); PG8_MMA(1, 1, At, B1); PG8_BAR; PG8_SCHED;
            PG8_LDB(B0, 1, 0); PG8_LDB(B1, 1, 1); PG8_SCHED; PG8_LDA(At, 1, 0); PG8_STAGE(PG8_SA(0, 1), a2 + hstep, voffA);
            PG8_WAIT_V(8); PG8_WAIT_L(0); PG8_BAR; PG8_MMA(0, 0, At, B0); PG8_MMA(0, 1, At, B1); PG8_BAR; PG8_SCHED;
            PG8_LDA(At, 1, 1); PG8_STAGE(PG8_SB(1, 0), b3, voffB); PG8_STAGE(PG8_SB(1, 1), b3 + hstep, voffB); PG8_STAGE(PG8_SA(1, 0), a3, voffA);
            PG8_WAIT_V(8); PG8_WAIT_L(0); PG8_BAR; PG8_MMA(1, 0, At, B0); PG8_MMA(1, 1, At, B1); PG8_BAR; PG8_SCHED;
            } else {
            PG8_LDB(B0, 0, 0); PG8_SCHED; PG8_LDA(At, 0, 0); PG8_STAGE(PG8_SA(1, 1), a1 + hstep, voffA);
            PG8_WAIT_L(8); PG8_BAR; PG8_WAIT_L(0); PG8_MMA(0, 0, At, B0); PG8_BAR; PG8_SCHED;
            PG8_LDB(B1, 0, 1); PG8_STAGE(PG8_SB(0, 0), b2, voffB);
            PG8_BAR; PG8_WAIT_L(0); PG8_MMA(0, 1, At, B1); PG8_BAR;
            PG8_LDA(At, 0, 1); PG8_STAGE(PG8_SA(0, 0), a2, voffA);
            PG8_BAR; PG8_WAIT_L(0); PG8_MMA(1, 0, At, B0); PG8_BAR; PG8_SCHED;
            PG8_STAGE(PG8_SB(0, 1), b2 + hstep, voffB);
            PG8_WAIT_V(6); PG8_BAR; PG8_MMA(1, 1, At, B1); PG8_BAR;
            PG8_LDB(B0, 1, 0); PG8_SCHED; PG8_LDA(At, 1, 0); PG8_STAGE(PG8_SA(0, 1), a2 + hstep, voffA);
            PG8_WAIT_L(8); PG8_BAR; PG8_WAIT_L(0); PG8_MMA(0, 0, At, B0); PG8_BAR; PG8_SCHED;
            PG8_LDB(B1, 1, 1); PG8_STAGE(PG8_SB(1, 0), b3, voffB);
            PG8_BAR; PG8_WAIT_L(0); PG8_MMA(0, 1, At, B1); PG8_BAR;
            PG8_LDA(At, 1, 1); PG8_STAGE(PG8_SA(1, 0), a3, voffA);
            PG8_BAR; PG8_WAIT_L(0); PG8_MMA(1, 0, At, B0); PG8_BAR; PG8_SCHED;
            PG8_STAGE(PG8_SB(1, 1), b3 + hstep, voffB);
            PG8_WAIT_V(6); PG8_BAR; PG8_MMA(1, 1, At, B1); PG8_BAR;
            }
        }
        if constexpr (ALIGN_EPI) { if (wr == 0) PG8_BAR; }
        if constexpr (!Epi::AFTER_DRAIN) { E(acc, cur, wr, wc, fr, fq); S.done(cur); }
        if (!has_next) break;
#pragma unroll
        for (int a = 0; a < 2; ++a)
#pragma unroll
            for (int b = 0; b < 2; ++b)
#pragma unroll
                for (int m = 0; m < 4; ++m)
#pragma unroll
                    for (int n = 0; n < 2; ++n) acc[a][b][m][n] = (f32x4){0.f, 0.f, 0.f, 0.f};
        cur = nxt; cA = nA; cB = nB; ++ui;
        if constexpr (ALIGN_EPI) { if (wr == 1) PG8_BAR; }
    }
    PG8_WAIT_V(0);
    if constexpr (!ALIGN_EPI) { if (wr == 0) PG8_BAR; }
    PG8_BAR;
    if constexpr (Epi::AFTER_DRAIN) { E.fused(acc, cur, wr, wc, fr, fq, lds, wid, lane); S.done(cur); }
#undef PG8_SA
#undef PG8_SB
#undef PG8_STAGE
#undef PG8_LDA
#undef PG8_LDB
#undef PG8_MMA
#undef PG8_WAIT_V
#undef PG8_WAIT_L
#undef PG8_BAR
#undef PG8_SCHED
}
}

namespace pg8 {
__device__ __forceinline__ void store16_wt(void* ptr, u32x4 v) { asm volatile("global_store_dwordx4 %0, %1, off sc1\n\ts_nop 1" :: "v"(ptr), "v"(v) : "memory"); }
template <int ACT> struct EpiStore {
    static constexpr bool PERM = true, AFTER_DRAIN = false;
    bf16_t* O; int ldc;
    __device__ __forceinline__ void operator()(const f32x4 (&acc)[2][2][4][2], const Unit& u, int wr, int wc, int fr, int fq) const {
        const int row0 = u.pm * BM + wr * 64 + fr, col0 = u.pn * BM + wc * 32 + 8 * fq;
#pragma unroll
        for (int ai = 0; ai < 2; ++ai)
#pragma unroll
            for (int m = 0; m < 4; ++m) { bf16_t* rowp = O + (size_t)(row0 + ai * HALF + m * 16) * ldc + col0;
#pragma unroll
                for (int bj = 0; bj < 2; ++bj) { f32x4 v0 = acc[ai][bj][m][0], v1 = acc[ai][bj][m][1];
                    if (ACT == 1) {
#pragma unroll
                        for (int e = 0; e < 4; ++e) { v0[e] = __builtin_amdgcn_rcpf(1.f + __expf(-v0[e])); v1[e] = __builtin_amdgcn_rcpf(1.f + __expf(-v1[e])); } }
                    u32x4 w; w.x = cvt_pk_bf16(v0[0], v0[1]); w.y = cvt_pk_bf16(v0[2], v0[3]); w.z = cvt_pk_bf16(v1[0], v1[1]); w.w = cvt_pk_bf16(v1[2], v1[3]);
                    store16_wt(rowp + bj * HALF, w); } }
    }
};
template <bool ACCUM> struct EpiProj {
    static constexpr bool PERM = true, AFTER_DRAIN = false;
    bf16_t* MG; const bf16_t* SG; int gcol0;
    __device__ __forceinline__ void operator()(const f32x4 (&acc)[2][2][4][2], const Unit& u, int wr, int wc, int fr, int fq) const {
        const int row0 = u.pm * BM + wr * 64 + fr, col0 = u.pn * BM + wc * 32 + 8 * fq;
#pragma unroll
        for (int ai = 0; ai < 2; ++ai)
#pragma unroll
            for (int m = 0; m < 4; ++m) { const size_t row = (size_t)(row0 + ai * HALF + m * 16);
#pragma unroll
                for (int bj = 0; bj < 2; ++bj) {
                    const int col = col0 + bj * HALF;
                    const u32x4 gw = *(const u32x4*)(SG + row * 3072 + gcol0 + col);
                    u32x4 ow = (u32x4){0u, 0u, 0u, 0u};
                    if (ACCUM) ow = *(const u32x4*)(MG + row * 1024 + col);
                    float r[8];
#pragma unroll
                    for (int e = 0; e < 4; ++e) {
                        const float g0 = __uint_as_float(gw[e] << 16), g1 = __uint_as_float(gw[e] & 0xffff0000u);
                        const float a0 = e < 2 ? acc[ai][bj][m][0][2 * e] : acc[ai][bj][m][1][2 * e - 4], a1 = e < 2 ? acc[ai][bj][m][0][2 * e + 1] : acc[ai][bj][m][1][2 * e - 3];
                        r[2 * e] = g0 * a0; r[2 * e + 1] = g1 * a1;
                        if (ACCUM) { r[2 * e] += __uint_as_float(ow[e] << 16); r[2 * e + 1] += __uint_as_float(ow[e] & 0xffff0000u); }
                    }
                    u32x4 w; w.x = cvt_pk_bf16(r[0], r[1]); w.y = cvt_pk_bf16(r[2], r[3]); w.z = cvt_pk_bf16(r[4], r[5]); w.w = cvt_pk_bf16(r[6], r[7]);
                    *(u32x4*)(MG + row * 1024 + col) = w; } }
    }
};
struct ProjOrder {
    int pm, pn, valid;
    __host__ __device__ bool next(int i, Unit& u) const { if (!valid || i >= 3) return false; u.pm = i * 64 + pm; u.pn = i * 4 + pn; return true; }
    __device__ __forceinline__ void a_ready(const Unit&) const {}
    __device__ __forceinline__ void done(const Unit&) const {}
};
struct EpiProj3 {
    static constexpr bool PERM = true, AFTER_DRAIN = false;
    bf16_t* MG; const bf16_t* SG;
    __device__ __forceinline__ void operator()(const f32x4 (&acc)[2][2][4][2], const Unit& u, int wr, int wc, int fr, int fq) const {
        const int br = u.pm >> 6, pm = u.pm & 63, pn = u.pn & 3, gcol0 = br * 1024;
        const int row0 = pm * BM + wr * 64 + fr, col0 = pn * BM + wc * 32 + 8 * fq;
#pragma unroll
        for (int ai = 0; ai < 2; ++ai)
#pragma unroll
            for (int m = 0; m < 4; ++m) { const size_t row = (size_t)(row0 + ai * HALF + m * 16);
#pragma unroll
                for (int bj = 0; bj < 2; ++bj) {
                    const int col = col0 + bj * HALF;
                    const u32x4 gw = *(const u32x4*)(SG + row * 3072 + gcol0 + col);
                    u32x4 ow = (u32x4){0u, 0u, 0u, 0u};
                    if (br > 0) ow = *(const u32x4*)(MG + row * 1024 + col);
                    float r[8];
#pragma unroll
                    for (int e = 0; e < 4; ++e) {
                        const float g0 = __uint_as_float(gw[e] << 16), g1 = __uint_as_float(gw[e] & 0xffff0000u);
                        const float a0 = e < 2 ? acc[ai][bj][m][0][2 * e] : acc[ai][bj][m][1][2 * e - 4], a1 = e < 2 ? acc[ai][bj][m][0][2 * e + 1] : acc[ai][bj][m][1][2 * e - 3];
                        r[2 * e] = g0 * a0 + __uint_as_float(ow[e] << 16); r[2 * e + 1] = g1 * a1 + __uint_as_float(ow[e] & 0xffff0000u);
                    }
                    u32x4 w; w.x = cvt_pk_bf16(r[0], r[1]); w.y = cvt_pk_bf16(r[2], r[3]); w.z = cvt_pk_bf16(r[4], r[5]); w.w = cvt_pk_bf16(r[6], r[7]);
                    *(u32x4*)(MG + row * 1024 + col) = w; } }
    }
};
struct EpiOut {
    static constexpr bool PERM = false, AFTER_DRAIN = false;
    const float* X; float* O;
    __device__ __forceinline__ void operator()(const f32x4 (&acc)[2][2][4][2], const Unit& u, int wr, int wc, int fr, int fq) const {
        const int row0 = u.pm * BM + wr * 64 + fr, col0 = u.pn * BM + wc * 32 + 4 * fq;
#pragma unroll
        for (int ai = 0; ai < 2; ++ai)
#pragma unroll
            for (int m = 0; m < 4; ++m) { const size_t off = (size_t)(row0 + ai * HALF + m * 16) * 1024 + col0;
#pragma unroll
                for (int bj = 0; bj < 2; ++bj)
#pragma unroll
                    for (int n = 0; n < 2; ++n) { const f32x4 xv = *(const f32x4*)(X + off + bj * HALF + n * 16); *(f32x4*)(O + off + bj * HALF + n * 16) = xv + acc[ai][bj][m][n]; } }
    }
};
}

DI void phase_gemm_gate(const Params& p, unsigned char* lds, const int bid, const int nb) {
    unsigned char* ws = p.ws;
    const bf16_t* H = (const bf16_t*)(ws + OFF_H); const bf16_t* Wt = (const bf16_t*)(ws + OFF_WIN) + (size_t)C_G * 1024;
    bf16_t* SG = (bf16_t*)(ws + OFF_SG);
    const int tn = 3072 / 128, nt = (M / 128) * tn;
    for (int it = bid; it < nt; it += nb) {
        GemmTile g; gemm_zero(g);
        const int m0 = (it / tn) * 128, n0 = (it % tn) * 128;
        gemm_tile_k(g, H, 1024, Wt, 1024, m0, n0, 1024, lds);
        GEMM_FOREACH(SG[(size_t)row * 3072 + col] = f2bf(sigmoidf_(g.acc[mi][ni][r])););
    }
}
DI void phase_gemm_proj(const Params& p, unsigned char* lds, const int bid, const int nb) {
    unsigned char* ws = p.ws;
    const bf16_t* SG = (const bf16_t*)(ws + OFF_SG); bf16_t* MG = (bf16_t*)(ws + OFF_MG);
    const int tn = 1024 / 128, nt = (M / 128) * tn;
    for (int it = bid; it < nt; it += nb) {
        const int m0 = (it / tn) * 128, n0 = (it % tn) * 128;
        GemmTile mg; gemm_zero(mg);
#pragma unroll 1
        for (int br = 0; br < 3; ++br) {
            GemmTile g; gemm_zero(g);
            const bf16_t* Y = (const bf16_t*)(ws + (br == 0 ? OFF_YA : br == 1 ? OFF_YB : OFF_YC));
            const bf16_t* W = (const bf16_t*)(ws + (br == 0 ? OFF_WPA : br == 1 ? OFF_WPB : OFF_WPC));
            gemm_tile_k(g, Y, 512, W, 512, m0, n0, 512, lds);
            GEMM_FOREACH(mg.acc[mi][ni][r] += bf2f(SG[(size_t)row * 3072 + br * 1024 + col]) * g.acc[mi][ni][r];);
        }
        GEMM_FOREACH(MG[(size_t)row * 1024 + col] = f2bf(mg.acc[mi][ni][r]););
    }
}
DI void phase_gemm_out(const Params& p, unsigned char* lds, const int bid, const int nb) {
    unsigned char* ws = p.ws;
    const bf16_t* MG = (const bf16_t*)(ws + OFF_MG); const bf16_t* W = (const bf16_t*)(ws + OFF_WO);
    const int tn = 1024 / 128, nt = (M / 128) * tn;
    for (int it = bid; it < nt; it += nb) {
        GemmTile g; gemm_zero(g);
        const int m0 = (it / tn) * 128, n0 = (it % tn) * 128;
        gemm_tile_k(g, MG, 1024, W, 1024, m0, n0, 1024, lds);
        GEMM_FOREACH(p.out[(size_t)row * 1024 + col] = p.x[(size_t)row * 1024 + col] + g.acc[mi][ni][r];);
    }
}

DI void phase_gemm_in_fast(const Params& p, unsigned char* lds, const int bid, const int nb) {
    unsigned char* ws = p.ws;
    {
        pg8::Gemm g{(const bf16_t*)(ws + OFF_H), (const bf16_t*)(ws + OFF_WIN), M, NP, 1024}; pg8::StaticOrder S; S.init(M, NP, nb, bid);
        pg8::EpiStore<0> E{(bf16_t*)(ws + OFF_P), NP};
        pg8::gemm_phase<pg8::EpiStore<0>, pg8::StaticOrder, true, true>(LASP(lds), g, S, E);
    }
    __syncthreads();
    const int tn2 = 1024 / 128, nt2 = (MM / 128) * tn2;
    for (int it = bid - nb / 2; it >= 0 && it < nt2; it += nb) {
        GemmTile g; gemm_zero(g);
        const int m0 = (it / tn2) * 128, n0 = (it % tn2) * 128;
        gemm_tile_k(g, (const bf16_t*)(ws + OFF_HM), 1024, (const bf16_t*)(ws + OFF_WKV), 1024, m0, n0, 1024, lds);
        bf16_t* KVM = (bf16_t*)(ws + OFF_KVM);
        GEMM_FOREACH(KVM[(size_t)row * 1024 + col] = f2bf(g.acc[mi][ni][r]););
    }
}
DI void phase_gemm_gate_fast(const Params& p, unsigned char* lds, const int bid, const int nb) {
    unsigned char* ws = p.ws;
    pg8::Gemm g{(const bf16_t*)(ws + OFF_H), (const bf16_t*)(ws + OFF_WIN) + (size_t)C_G * 1024, M, 3072, 1024}; pg8::StaticOrder S; S.init(M, 3072, nb, bid);
    pg8::EpiStore<1> E{(bf16_t*)(ws + OFF_SG), 3072};
    pg8::gemm_phase<pg8::EpiStore<1>, pg8::StaticOrder, true, true>(LASP(lds), g, S, E);
}
DI void phase_gemm_proj_fast(const Params& p, unsigned char* lds, const int bid, const int nb) {
    unsigned char* ws = p.ws;
    bf16_t* MG = (bf16_t*)(ws + OFF_MG); const bf16_t* SG = (const bf16_t*)(ws + OFF_SG);
    pg8::StaticOrder S; S.init(M, 1024, nb, bid);
    { pg8::Gemm g{(const bf16_t*)(ws + OFF_YA), (const bf16_t*)(ws + OFF_WPA), M, 1024, 512}; pg8::EpiProj<false> E{MG, SG, 0};
      pg8::gemm_phase<pg8::EpiProj<false>, pg8::StaticOrder, true, true>(LASP(lds), g, S, E); }
    { pg8::Gemm g{(const bf16_t*)(ws + OFF_YB), (const bf16_t*)(ws + OFF_WPB), M, 1024, 512}; pg8::EpiProj<true> E{MG, SG, 1024};
      pg8::gemm_phase<pg8::EpiProj<true>, pg8::StaticOrder, true, true>(LASP(lds), g, S, E); }
    { pg8::Gemm g{(const bf16_t*)(ws + OFF_YC), (const bf16_t*)(ws + OFF_WPC), M, 1024, 512}; pg8::EpiProj<true> E{MG, SG, 2048};
      pg8::gemm_phase<pg8::EpiProj<true>, pg8::StaticOrder, true, true>(LASP(lds), g, S, E); }
}
DI void phase_gemm_proj3(const Params& p, unsigned char* lds, const int bid, const int nb) {
    unsigned char* ws = p.ws;
    static_assert(OFF_YB == OFF_YA + (size_t)M * 512 * 2 && OFF_YC == OFF_YB + (size_t)M * 512 * 2 && OFF_WPB == OFF_WPA + (size_t)1024 * 512 * 2 && OFF_WPC == OFF_WPB + (size_t)1024 * 512 * 2, "contiguous branches");
    pg8::StaticOrder S; S.init(M, 1024, nb, bid);
    pg8::Unit own; const bool has = S.next(0, own);
    pg8::ProjOrder O{own.pm, own.pn, has ? 1 : 0};
    pg8::Gemm g{(const bf16_t*)(ws + OFF_YA), (const bf16_t*)(ws + OFF_WPA), 3 * M, 3072, 512};
    pg8::EpiProj3 E{(bf16_t*)(ws + OFF_MG), (const bf16_t*)(ws + OFF_SG)};
    pg8::gemm_phase<pg8::EpiProj3, pg8::ProjOrder, true, true>(LASP(lds), g, O, E);
}
DI void phase_gemm_out_fast(const Params& p, unsigned char* lds, const int bid, const int nb) {
    unsigned char* ws = p.ws;
    pg8::Gemm g{(const bf16_t*)(ws + OFF_MG), (const bf16_t*)(ws + OFF_WO), M, 1024, 1024}; pg8::StaticOrder S; S.init(M, 1024, nb, bid);
    pg8::EpiOut E{p.x, p.out};
    pg8::gemm_phase<pg8::EpiOut, pg8::StaticOrder, true, true>(LASP(lds), g, S, E);
}

#define XB_TMO      128
#define XB_XCNT(j)  (256  + 64 * (j))
#define XB_XSUB(j)  (1280 + 64 * (j))
#define XB_XGEN(j)  (2304 + 64 * (j))
#define XB_TOP      3328
#define XB_TOPGEN   3392
#define XCD_BAR_WORDS 3456
#define XB_SPIN_CAP (1u << 22)
DI unsigned xb_ld(unsigned* p)              { return __hip_atomic_load(p, __ATOMIC_RELAXED, __HIP_MEMORY_SCOPE_AGENT); }
DI unsigned xb_add(unsigned* p, unsigned v) { return __hip_atomic_fetch_add(p, v, __ATOMIC_RELAXED, __HIP_MEMORY_SCOPE_AGENT); }
DI unsigned xb_xcc_id() { return (unsigned)__builtin_amdgcn_s_getreg((3 << 11) | 20) & 0xFu; }
#define XB_SPIN(cond, bar) do { unsigned _sp = 0; while (cond) { __builtin_amdgcn_s_sleep(1); \
    if ((++_sp & 255u) == 0u) { if (xb_ld(&(bar)[XB_TMO])) break; if (_sp > XB_SPIN_CAP) { atomicAdd(&(bar)[XB_TMO], 1u); break; } } } } while (0)
struct XcdBarrier { unsigned* bar; unsigned x; volatile LAS unsigned* st; };
DI XcdBarrier xcd_barrier_post(unsigned* bar, volatile LAS unsigned* st) {
    XcdBarrier b; b.bar = bar; b.x = xb_xcc_id(); b.st = st;
    if (threadIdx.x == 0) (void)xb_add(&bar[XB_XCNT(b.x)], 1u);
    return b;
}
DI void xcd_barrier_complete(unsigned* bar, unsigned x, unsigned& nloc, unsigned& nx) {
    const unsigned G = gridDim.x * gridDim.y * gridDim.z;
    unsigned sum, cnt, mine, sp = 0u;
    for (;;) {
        sum = 0u; cnt = 0u; mine = 0u;
#pragma unroll
        for (unsigned j = 0; j < 16; ++j) { const unsigned c = xb_ld(&bar[XB_XCNT(j)]); sum += c; cnt += (c > 0u) ? 1u : 0u; mine = (j == x) ? c : mine; }
        if (sum == G) break;
        __builtin_amdgcn_s_sleep(1);
        if ((++sp & 255u) == 0u) { if (xb_ld(&bar[XB_TMO])) break; if (sp > XB_SPIN_CAP) { atomicAdd(&bar[XB_TMO], 1u); break; } }
    }
    nloc = mine > 0u ? mine : 1u; nx = cnt > 0u ? cnt : 1u;
}
DI void xcd_barrier(const XcdBarrier& b) {
    asm volatile("s_waitcnt vmcnt(0)" ::: "memory");
    __syncthreads();
    if (threadIdx.x == 0) {
        unsigned* bar = b.bar;
        __builtin_amdgcn_s_waitcnt(0);
        unsigned nloc = b.st[0], nx = b.st[1];
        if (nloc == 0u) { xcd_barrier_complete(bar, b.x, nloc, nx); b.st[0] = nloc; b.st[1] = nx; }
        const unsigned old = xb_add(&bar[XB_XSUB(b.x)], 1u);
        const unsigned gen = old / nloc;
        if (old + 1u == (gen + 1u) * nloc) {
            __builtin_amdgcn_fence(__ATOMIC_RELEASE, "agent");
            asm volatile("s_waitcnt vmcnt(0)" ::: "memory");
            const unsigned og = xb_add(&bar[XB_TOP], 1u);
            const unsigned tg = og / nx;
            if (og + 1u == (tg + 1u) * nx) xb_add(&bar[XB_TOPGEN], 1u);
            else XB_SPIN(xb_ld(&bar[XB_TOPGEN]) == tg, bar);
            __builtin_amdgcn_fence(__ATOMIC_ACQUIRE, "agent");
            xb_add(&bar[XB_XGEN(b.x)], 1u);
            asm volatile("s_waitcnt vmcnt(0)" ::: "memory");
        } else {
            XB_SPIN(xb_ld(&bar[XB_XGEN(b.x)]) == gen, bar);
            __builtin_amdgcn_fence(__ATOMIC_ACQUIRE, "agent");
            asm volatile("s_waitcnt vmcnt(0)" ::: "memory");
        }
    }
    __syncthreads();
}

__global__ void __launch_bounds__(NTHREADS, 2) k_mega(Params p) {
    extern __shared__ __attribute__((aligned(16))) unsigned char lds[];
    volatile LAS unsigned* st = (volatile LAS unsigned*)(lds + LDS_CTL_OFF);
    if (threadIdx.x == 0) { st[0] = 0u; st[1] = 0u; st[2] = 0u; st[3] = 0u; }
    __syncthreads();
    (void)xcd_barrier_post((unsigned*)(p.ws + OFF_CTL), st);
#define GRID_BAR() do { XcdBarrier b_; b_.bar = (unsigned*)(p.ws + OFF_CTL); b_.x = xb_xcc_id(); b_.st = (volatile LAS unsigned*)(lds + LDS_CTL_OFF); xcd_barrier(b_); } while (0)
    const int bid = blockIdx.x, nb = gridDim.x;
#ifndef REPMASK
#define REPMASK 0
#endif
#ifndef REPCNT
#define REPCNT 1
#endif
#ifndef STAMP_PH
#define STAMP_PH -1
#endif
    volatile LAS unsigned* stp = (volatile LAS unsigned*)(lds + LDS_CTL_OFF + 64);
    int nst = 0;
#define STAMP() do { if (STAMP_PH >= 0 && blockIdx.x == 0 && threadIdx.x == 0) stp[nst] = (unsigned)__builtin_amdgcn_s_memrealtime(); ++nst; } while (0)
    STAMP();
#define REP(bit_, call_) do { call_; if (REPMASK & (bit_)) { for (int rep_ = 0; rep_ < REPCNT; ++rep_) { __syncthreads(); call_; } } } while (0)
    REP(1, phase_prologue(p, lds, bid, nb));
    GRID_BAR(); STAMP();
    REP(2, phase_gemm_in_fast(p, lds, bid, nb));
    GRID_BAR(); STAMP();
    REP(8, phase_rwkv_prep(p, lds, bid, nb));
    GRID_BAR(); STAMP();
    if (bid < 16) phase_rwkv_scan(p, lds, bid);
    phase_attn_queue(p, lds);
    GRID_BAR(); STAMP();
    REP(64, phase_gemm_gate_fast(p, lds, bid, nb));
    GRID_BAR(); STAMP();
    phase_gemm_proj3(p, lds, bid, nb);
    GRID_BAR(); STAMP();
    REP(256, phase_gemm_out_fast(p, lds, bid, nb));
    if (STAMP_PH >= 0) { GRID_BAR(); STAMP();
        if (blockIdx.x == 0) {
            float* sm = (float*)lds; float best = 1e30f; int bi = 0;
            for (int i = threadIdx.x; i < 65536; i += NTHREADS) { const float a = fabsf(p.out[i]); if (a < best) { best = a; bi = i; } }
            sm[threadIdx.x] = best; ((int*)sm)[512 + threadIdx.x] = bi;
            __syncthreads();
            if (threadIdx.x == 0) {
                for (int i = 1; i < NTHREADS; ++i) if (sm[i] < best) { best = sm[i]; bi = ((int*)sm)[512 + i]; }
                const float tot = (float)(stp[nst - 1] - stp[0]); const float ph = STAMP_PH < 20 ? (float)(stp[STAMP_PH + 1] - stp[STAMP_PH]) : tot * 0.5f;
                const float v = STAMP_PH == 99 ? 0.04f + tot * 1e-6f : 0.05f + 0.1f * ph / tot; p.out[bi] += v; }
        } }
}

extern "C" void kernel_launch(void* const* d_in, const int* in_sizes, int n_in, void* d_out, int out_size, void* d_ws, size_t ws_size, hipStream_t stream) {
    static int grid = 0;
    if (grid == 0) {
        if (n_in != 27 || ws_size < WS_END) { fprintf(stderr, "kernel_launch: unexpected inputs (n_in %d, ws %zu)\n", n_in, ws_size); grid = -1; return; }
        int dev = 0, cus = 0, per_cu = 0;
        if (hipGetDevice(&dev) != hipSuccess || hipDeviceGetAttribute(&cus, hipDeviceAttributeMultiprocessorCount, dev) != hipSuccess) { grid = -1; return; }
        if (hipFuncSetAttribute((const void*)k_mega, hipFuncAttributeMaxDynamicSharedMemorySize, LDS_BYTES) != hipSuccess) { fprintf(stderr, "kernel_launch: hipFuncSetAttribute failed\n"); grid = -1; return; }
        if (hipOccupancyMaxActiveBlocksPerMultiprocessor(&per_cu, (const void*)k_mega, NTHREADS, LDS_BYTES) != hipSuccess || per_cu < 1)
            fprintf(stderr, "kernel_launch: occupancy query reports %d workgroups per CU\n", per_cu);
        (void)hipGetLastError();
        grid = cus;
        if (grid < 32) { fprintf(stderr, "kernel_launch: too few CUs (%d)\n", grid); grid = -1; return; }
    }
    if (grid < 0) return;
    if (hipMemsetAsync((char*)d_ws + OFF_CTL, 0, 65536, stream) != hipSuccess) { fprintf(stderr, "kernel_launch: memset failed\n"); return; }
    Params p{};
    p.x = (const float*)d_in[0]; p.mem = (const float*)d_in[1]; p.pos = (const int*)d_in[2]; p.norm_g = (const float*)d_in[3]; p.mem_norm_g = (const float*)d_in[4];
    p.w_in = (const float*)d_in[5]; p.mu_rkv = (const float*)d_in[6]; p.mu_wa = (const float*)d_in[7]; p.w0 = (const float*)d_in[8]; p.w2 = (const float*)d_in[9];
    p.a0 = (const float*)d_in[10]; p.a2 = (const float*)d_in[11]; p.k_k = (const float*)d_in[12]; p.k_a = (const float*)d_in[13]; p.r_k = (const float*)d_in[14];
    p.lnx_g = (const float*)d_in[15]; p.lnx_b = (const float*)d_in[16]; p.q_norm_g = (const float*)d_in[17]; p.k_norm_g = (const float*)d_in[18]; p.sinks = (const float*)d_in[19];
    p.xq_norm_g = (const float*)d_in[20]; p.xk_norm_g = (const float*)d_in[21]; p.w_mem_kv = (const float*)d_in[22]; p.w_proj_a = (const float*)d_in[23];
    p.w_proj_b = (const float*)d_in[24]; p.w_proj_c = (const float*)d_in[25]; p.w_out = (const float*)d_in[26];
    p.out = (float*)d_out; p.ws = (unsigned char*)d_ws;
    hipLaunchKernelGGL(k_mega, dim3(grid), dim3(NTHREADS), LDS_BYTES, stream, p);
}
```

```cpp
#include <hip/hip_runtime.h>
#include <stdint.h>
#include <stdio.h>

#define DI __device__ __forceinline__
#define LASP(p_) ((__attribute__((address_space(3))) unsigned char*)(p_))
typedef unsigned short bf16_t;
typedef short bf16x8 __attribute__((ext_vector_type(8)));
typedef float f32x4 __attribute__((ext_vector_type(4)));

constexpr int BATCH = 2, T = 8192, M = BATCH * T, D = 1024, NIN = 7552, NP = 4608  ;
constexpr int MEMLEN = 256, MM = BATCH * MEMLEN;
constexpr int C_R = 0, C_K = 512, C_V = 1024, C_W = 1536, C_A = 1600, C_ZA = 1664, C_Q = 2176, C_SK = 2688, C_SV = 2816, C_ZB = 2944, C_XQ = 3456, C_ZC = 3968, C_G = 4480;
constexpr int NTHREADS = 512, NWAVES = 8;
constexpr int LDS_BYTES = 147456;
constexpr int LDS_CTL_OFF = LDS_BYTES - 256;
#define LAS __attribute__((address_space(3)))

constexpr size_t OFF_CTL = 0;
constexpr size_t OFF_WIN = 65536;
constexpr size_t OFF_WKV = OFF_WIN + (size_t)7680 * 1024 * 2;
constexpr size_t OFF_WPA = OFF_WKV + (size_t)1024 * 1024 * 2;
constexpr size_t OFF_WPB = OFF_WPA + (size_t)1024 * 512 * 2;
constexpr size_t OFF_WPC = OFF_WPB + (size_t)1024 * 512 * 2;
constexpr size_t OFF_WO  = OFF_WPC + (size_t)1024 * 512 * 2;
constexpr size_t OFF_H   = OFF_WO + (size_t)1024 * 1024 * 2;
constexpr size_t OFF_HM  = OFF_H + (size_t)M * 1024 * 2;
constexpr size_t OFF_KVM = OFF_HM + (size_t)MM * 1024 * 2;
constexpr size_t OFF_ROPE = OFF_KVM + (size_t)MM * 1024 * 2;
constexpr size_t OFF_P   = OFF_ROPE + (size_t)M * 32 * 8;
constexpr size_t OFF_YA  = OFF_P + (size_t)M * NP * 2;
constexpr size_t OFF_YB  = OFF_YA + (size_t)M * 512 * 2;
constexpr size_t OFF_YC  = OFF_YB + (size_t)M * 512 * 2;
constexpr size_t WS_END  = OFF_YC + (size_t)M * 512 * 2;
constexpr size_t OFF_SG  = OFF_P;
constexpr size_t OFF_MG  = OFF_P + (size_t)M * 3072 * 2;
static_assert(WS_END <= (size_t)256 * 1024 * 1024, "workspace");
static_assert(OFF_MG + (size_t)M * 1024 * 2 <= OFF_YA, "overlay");

struct Params {
    const float* x; const float* mem; const int* pos; const float* norm_g; const float* mem_norm_g; const float* w_in;
    const float* mu_rkv; const float* mu_wa; const float* w0; const float* w2; const float* a0; const float* a2;
    const float* k_k; const float* k_a; const float* r_k; const float* lnx_g; const float* lnx_b;
    const float* q_norm_g; const float* k_norm_g; const float* sinks; const float* xq_norm_g; const float* xk_norm_g;
    const float* w_mem_kv; const float* w_proj_a; const float* w_proj_b; const float* w_proj_c; const float* w_out;
    float* out; unsigned char* ws;
};

DI bf16_t f2bf(float x) { return __builtin_bit_cast(unsigned short, (__bf16)x); }
DI float bf2f(bf16_t h) { return __uint_as_float(((unsigned)h) << 16); }
DI float wave_sum(float v) {
#pragma unroll
    for (int o = 32; o > 0; o >>= 1) v += __shfl_xor(v, o, 64);
    return v;
}
DI float wave_max(float v) {
#pragma unroll
    for (int o = 32; o > 0; o >>= 1) v = fmaxf(v, __shfl_xor(v, o, 64));
    return v;
}
DI float sigmoidf_(float x) { return __builtin_amdgcn_rcpf(1.f + __expf(-x)); }
DI float siluf_(float x) { return x * __builtin_amdgcn_rcpf(1.f + __expf(-x)); }

DI void transpose_convert(const float* W, int K, int N, bf16_t* Wt, int item, float* tile  ) {
    int tid = threadIdx.x; asm volatile("" : "+v"(tid));
    const int tn = N / 64, kt = item / tn, nt = item % tn;
    __syncthreads();
#pragma unroll
    for (int u = 0; u < 2; ++u) { const int idx = tid + NTHREADS * u, r = idx >> 4, c4 = idx & 15;
        *(f32x4*)(tile + r * 68 + c4 * 4) = *(const f32x4*)(W + (size_t)(kt * 64 + r) * N + nt * 64 + c4 * 4); }
    __syncthreads();
    {
        const int n = tid >> 3, k8 = tid & 7;
        unsigned w[4];
#pragma unroll
        for (int e2 = 0; e2 < 4; ++e2) w[e2] = (unsigned)f2bf(tile[(k8 * 8 + 2 * e2) * 68 + n]) | ((unsigned)f2bf(tile[(k8 * 8 + 2 * e2 + 1) * 68 + n]) << 16);
        *(uint4*)(Wt + (size_t)(nt * 64 + n) * K + kt * 64 + k8 * 8) = make_uint4(w[0], w[1], w[2], w[3]);
    }
}

DI void convert_late(const Params& p, unsigned char* lds, const int vb, const int nvb) {
    float* tile = (float*)lds; unsigned char* ws = p.ws;
    const int n_g = 16 * (NIN / 64 - 72), n_pr = (512 / 64) * 16, n_o = 16 * 16, total = n_g + 3 * n_pr + n_o;
    for (int it = vb * 8; it < vb * 8 + 8 && it < total; ++it) {
        int i = it;
        if (i < n_g) { const int kt = i / (NIN / 64 - 72), nt = 72 + i % (NIN / 64 - 72); transpose_convert(p.w_in, 1024, NIN, (bf16_t*)(ws + OFF_WIN), kt * (NIN / 64) + nt, tile); continue; } i -= n_g;
        if (i < n_pr) { transpose_convert(p.w_proj_a, 512, 1024, (bf16_t*)(ws + OFF_WPA), i, tile); continue; } i -= n_pr;
        if (i < n_pr) { transpose_convert(p.w_proj_b, 512, 1024, (bf16_t*)(ws + OFF_WPB), i, tile); continue; } i -= n_pr;
        if (i < n_pr) { transpose_convert(p.w_proj_c, 512, 1024, (bf16_t*)(ws + OFF_WPC), i, tile); continue; } i -= n_pr;
        transpose_convert(p.w_out, 1024, 1024, (bf16_t*)(ws + OFF_WO), i, tile);
    }
}
DI void phase_prologue(const Params& p, unsigned char* lds, const int bid, const int nb) {
    float* tile = (float*)lds;
    unsigned char* ws = p.ws;
    const int n_in = (1024 / 64) * 72, n_kv = 16 * 16;
    for (int it = bid; it < n_in + n_kv; it += nb) {
        if (it < n_in) { const int kt = it / 72, nt = it % 72; transpose_convert(p.w_in, 1024, NIN, (bf16_t*)(ws + OFF_WIN), kt * (NIN / 64) + nt, tile); }
        else transpose_convert(p.w_mem_kv, 1024, 1024, (bf16_t*)(ws + OFF_WKV), it - n_in, tile);
    }
    const int lane = threadIdx.x & 63, wid = threadIdx.x >> 6;
    for (int row = bid * NWAVES + wid; row < M + MM; row += nb * NWAVES) {
        const float* src = row < M ? p.x + (size_t)row * D : p.mem + (size_t)(row - M) * D;
        const float* g = row < M ? p.norm_g : p.mem_norm_g;
        bf16_t* dst = row < M ? (bf16_t*)(ws + OFF_H) + (size_t)row * D : (bf16_t*)(ws + OFF_HM) + (size_t)(row - M) * D;
        f32x4 v[4]; float ss = 0.f;
#pragma unroll
        for (int i = 0; i < 4; ++i) { v[i] = *(const f32x4*)(src + i * 256 + lane * 4); ss += v[i][0] * v[i][0] + v[i][1] * v[i][1] + v[i][2] * v[i][2] + v[i][3] * v[i][3]; }
        ss = wave_sum(ss);
        const float rs = rsqrtf(ss * (1.f / 1024.f) + 1e-6f);
#pragma unroll
        for (int i = 0; i < 4; ++i) {
            const f32x4 gg = *(const f32x4*)(g + i * 256 + lane * 4);
            ushort4 o; o.x = f2bf(v[i][0] * rs * gg[0]); o.y = f2bf(v[i][1] * rs * gg[1]); o.z = f2bf(v[i][2] * rs * gg[2]); o.w = f2bf(v[i][3] * rs * gg[3]);
            *(ushort4*)(dst + i * 256 + lane * 4) = o;
        }
    }
    float2* rope = (float2*)(ws + OFF_ROPE);
    for (int i = bid * NTHREADS + threadIdx.x; i < M * 32; i += nb * NTHREADS) {
        const int row = i >> 5, f = i & 31;
        const double inv = pow(10000.0, -(double)f / 32.0);
        const double ang = (double)p.pos[row] * inv;
        double s, c; sincos(ang, &s, &c);
        rope[i] = make_float2((float)c, (float)s);
    }
}

struct GemmTile { f32x4 acc[2][4]; };
DI void gemm_tile_k(GemmTile& g, const bf16_t* A, int lda, const bf16_t* Bt, int ldb, int m0, int n0, int K, unsigned char* lds) {
    bf16_t* sA = (bf16_t*)lds;
    bf16_t* sB = sA + 128 * 40;
    const int tid = threadIdx.x, lane = tid & 63, wid = tid >> 6, wm = wid & 3, wn = wid >> 2;
    const int srow = tid >> 2, sch = tid & 3;
    const bf16_t* ga = A + (size_t)(m0 + srow) * lda + sch * 8;
    const bf16_t* gb = Bt + (size_t)(n0 + srow) * ldb + sch * 8;
    const int fr = lane & 15, fq = lane >> 4;
    uint4 ra = *(const uint4*)ga, rb = *(const uint4*)gb;
    for (int k0 = 0; k0 < K; k0 += 32) {
        __syncthreads();
        *(uint4*)(sA + srow * 40 + sch * 8) = ra;
        *(uint4*)(sB + srow * 40 + sch * 8) = rb;
        __syncthreads();
        if (k0 + 32 < K) { ra = *(const uint4*)(ga + k0 + 32); rb = *(const uint4*)(gb + k0 + 32); }
        bf16x8 af[2], bfr[4];
#pragma unroll
        for (int mi = 0; mi < 2; ++mi) af[mi] = *(const bf16x8*)(sA + (wm * 32 + mi * 16 + fr) * 40 + fq * 8);
#pragma unroll
        for (int ni = 0; ni < 4; ++ni) bfr[ni] = *(const bf16x8*)(sB + (wn * 64 + ni * 16 + fr) * 40 + fq * 8);
#pragma unroll
        for (int mi = 0; mi < 2; ++mi)
#pragma unroll
            for (int ni = 0; ni < 4; ++ni) g.acc[mi][ni] = __builtin_amdgcn_mfma_f32_16x16x32_bf16(af[mi], bfr[ni], g.acc[mi][ni], 0, 0, 0);
    }
}
DI void gemm_zero(GemmTile& g) {
#pragma unroll
    for (int mi = 0; mi < 2; ++mi)
#pragma unroll
        for (int ni = 0; ni < 4; ++ni) g.acc[mi][ni] = (f32x4){0.f, 0.f, 0.f, 0.f};
}
#define GEMM_FOREACH(body) do { const int lane_ = threadIdx.x & 63, wid_ = threadIdx.x >> 6, wm_ = wid_ & 3, wn_ = wid_ >> 2, fr_ = lane_ & 15, fq_ = lane_ >> 4; \
    _Pragma("unroll") for (int mi = 0; mi < 2; ++mi) _Pragma("unroll") for (int ni = 0; ni < 4; ++ni) _Pragma("unroll") for (int r = 0; r < 4; ++r) { \
        const int row = m0 + wm_ * 32 + mi * 16 + fq_ * 4 + r, col = n0 + wn_ * 64 + ni * 16 + fr_; body } } while (0)

DI void phase_gemm_in(const Params& p, unsigned char* lds, const int bid, const int nb) {
    unsigned char* ws = p.ws;
    const bf16_t* H = (const bf16_t*)(ws + OFF_H); const bf16_t* Wt = (const bf16_t*)(ws + OFF_WIN);
    bf16_t* P = (bf16_t*)(ws + OFF_P);
    const int tn = NP / 128, nt1 = (M / 128) * tn;
    const int tn2 = 1024 / 128, nt2 = (MM / 128) * tn2;
    for (int it = bid; it < nt1 + nt2; it += nb) {
        GemmTile g; gemm_zero(g);
        if (it < nt1) {
            const int m0 = (it / tn) * 128, n0 = (it % tn) * 128;
            gemm_tile_k(g, H, 1024, Wt, 1024, m0, n0, 1024, lds);
            GEMM_FOREACH(P[(size_t)row * NP + col] = f2bf(g.acc[mi][ni][r]););
        } else {
            const int i2 = it - nt1; const int m0 = (i2 / tn2) * 128, n0 = (i2 % tn2) * 128;
            gemm_tile_k(g, (const bf16_t*)(ws + OFF_HM), 1024, (const bf16_t*)(ws + OFF_WKV), 1024, m0, n0, 1024, lds);
            bf16_t* KVM = (bf16_t*)(ws + OFF_KVM);
            GEMM_FOREACH(KVM[(size_t)row * 1024 + col] = f2bf(g.acc[mi][ni][r]););
        }
    }
}

DI void phase_attn_prep(const Params& p, unsigned char* lds, const int bid, const int nb) {
    unsigned char* ws = p.ws; bf16_t* P = (bf16_t*)(ws + OFF_P); bf16_t* KVM = (bf16_t*)(ws + OFF_KVM);
    const float2* rope = (const float2*)(ws + OFF_ROPE);
    const int lane = threadIdx.x & 63, wid = threadIdx.x >> 6;
    const long n1 = (long)M * 14, n2 = (long)MM * 4;
    for (long it = (long)bid * NWAVES + wid; it < n1 + n2; it += (long)nb * NWAVES) {
        if (it < n1) {
            const int row = (int)(it / 14), j = (int)(it % 14);
            if (j < 10) {
                bf16_t* ptr = P + (size_t)row * NP + (j < 8 ? C_Q + j * 64 : C_SK + (j - 8) * 64);
                const float g = j < 8 ? p.q_norm_g[lane] : p.k_norm_g[lane];
                const float xv = bf2f(ptr[lane]);
                const float ss = wave_sum(xv * xv);
                const float y = xv * rsqrtf(ss * (1.f / 64.f) + 1e-6f) * g;
                const float yp = __shfl_xor(y, 32, 64);
                const float2 cs = rope[(size_t)row * 32 + (lane & 31)];
                const float o = lane < 32 ? y * cs.x - yp * cs.y : y * cs.x + yp * cs.y;
                ptr[lane] = f2bf(o);
            } else {
                bf16_t* ptr = P + (size_t)row * NP + C_XQ + (j - 10) * 128;
                const float x0 = bf2f(ptr[lane]), x1 = bf2f(ptr[lane + 64]);
                const float ss = wave_sum(x0 * x0 + x1 * x1);
                const float rs = rsqrtf(ss * (1.f / 128.f) + 1e-6f);
                ptr[lane] = f2bf(x0 * rs * p.xq_norm_g[lane]); ptr[lane + 64] = f2bf(x1 * rs * p.xq_norm_g[lane + 64]);
            }
        } else {
            const long i2 = it - n1; const int row = (int)(i2 / 4), j = (int)(i2 % 4);
            bf16_t* ptr = KVM + (size_t)row * 1024 + j * 128;
            const float x0 = bf2f(ptr[lane]), x1 = bf2f(ptr[lane + 64]);
            const float ss = wave_sum(x0 * x0 + x1 * x1);
            const float rs = rsqrtf(ss * (1.f / 128.f) + 1e-6f);
            ptr[lane] = f2bf(x0 * rs * p.xk_norm_g[lane]); ptr[lane + 64] = f2bf(x1 * rs * p.xk_norm_g[lane + 64]);
        }
    }
}

DI void rwkv_stage(const Params& p, int b, int h, int t0, int ntok, float* ck, float* scratch  ) {
    const bf16_t* P = (const bf16_t*)(p.ws + OFF_P);
    const int lane = threadIdx.x & 63, wid = threadIdx.x >> 6, ch = h * 64 + lane;
    const float mu_r = p.mu_rkv[ch], mu_k = p.mu_rkv[512 + ch], mu_v = p.mu_rkv[1024 + ch], mu_w = p.mu_wa[lane], mu_a = p.mu_wa[64 + lane];
    const float w0c = p.w0[ch], a0c = p.a0[ch], kkc = p.k_k[ch], kac = p.k_a[ch];
    float* sc = scratch + wid * 128;
    for (int i = wid; i < ntok; i += NWAVES) {
        const int t = t0 + i; const bf16_t* pr = P + (size_t)(b * T + t) * NP; const bf16_t* pp = pr - NP; const bool hp = t > 0;
        const float rc = bf2f(pr[C_R + ch]), rp = hp ? bf2f(pp[C_R + ch]) : 0.f;
        const float kc = bf2f(pr[C_K + ch]), kp = hp ? bf2f(pp[C_K + ch]) : 0.f;
        const float vc = bf2f(pr[C_V + ch]), vp = hp ? bf2f(pp[C_V + ch]) : 0.f;
        const float wc = bf2f(pr[C_W + lane]), wp = hp ? bf2f(pp[C_W + lane]) : 0.f;
        const float ac = bf2f(pr[C_A + lane]), ap = hp ? bf2f(pp[C_A + lane]) : 0.f;
        const float r = rc + (rp - rc) * mu_r, k = kc + (kp - kc) * mu_k, v = vc + (vp - vc) * mu_v;
        const float lw = wc + (wp - wc) * mu_w, la = ac + (ap - ac) * mu_a;
        sc[lane] = tanhf(lw); sc[64 + lane] = la;
        float accw = 0.f, acca = 0.f;
#pragma unroll 8
        for (int j = 0; j < 64; ++j) { accw += sc[j] * p.w2[j * 512 + ch]; acca += sc[64 + j] * p.a2[j * 512 + ch]; }
        const float xw = -(w0c + accw);
        const float sp = xw > 20.f ? xw : log1pf(expf(xw));
        const float wlog = -sp - 0.5f;
        const float decay = expf(-expf(wlog));
        const float alpha = 1.f / (1.f + expf(-(a0c + acca)));
        const float kk0 = k * kkc;
        const float n2 = wave_sum(kk0 * kk0);
        const float kk = kk0 / fmaxf(sqrtf(n2), 1e-12f);
        const float k2 = k * (1.f + (alpha - 1.f) * kac);
        float* o = ck + i * 384;
        o[lane] = r; o[64 + lane] = decay; o[128 + lane] = k2; o[192 + lane] = v; o[256 + lane] = -kk; o[320 + lane] = kk * alpha;
    }
}

DI void phase_rwkv_direct(const Params& p, unsigned char* lds, const int bid, const int nb) {
    float* ck = (float*)lds; float* scratch = ck + 64 * 384;
    const int lane = threadIdx.x & 63, wid = threadIdx.x >> 6;
    const bf16_t* P = (const bf16_t*)(p.ws + OFF_P); bf16_t* YA = (bf16_t*)(p.ws + OFF_YA);
    for (int bh = bid; bh < BATCH * 8; bh += nb) {
        const int b = bh >> 3, h = bh & 7, ch = h * 64 + lane;
        float S[64];
#pragma unroll
        for (int k = 0; k < 64; ++k) S[k] = 0.f;
        const float rk = p.r_k[ch], lg = p.lnx_g[ch], lb = p.lnx_b[ch];
        for (int c = 0; c < T / 64; ++c) {
            __syncthreads();
            rwkv_stage(p, b, h, c * 64, 64, ck, scratch);
            __syncthreads();
            if (wid == 0) {
                for (int i = 0; i < 64; ++i) {
                    const float* cc = ck + i * 384;
                    float sa = 0.f;
#pragma unroll
                    for (int k = 0; k < 64; ++k) sa += S[k] * cc[256 + k];
                    const float vv = cc[192 + lane];
#pragma unroll
                    for (int k = 0; k < 64; ++k) S[k] = S[k] * cc[64 + k] + sa * cc[320 + k] + vv * cc[128 + k];
                    float y = 0.f;
#pragma unroll
                    for (int k = 0; k < 64; ++k) y += S[k] * cc[k];
                    const float mean = wave_sum(y) * (1.f / 64.f);
                    const float dy = y - mean;
                    const float var = wave_sum(dy * dy) * (1.f / 64.f);
                    const float yn = dy * rsqrtf(var + 64e-5f) * lg + lb;
                    const float bonus = wave_sum(cc[lane] * cc[128 + lane] * rk) * vv;
                    const int t = c * 64 + i; const size_t row = (size_t)(b * T + t);
                    const float z = bf2f(P[row * NP + C_ZA + ch]);
                    YA[row * 512 + ch] = f2bf((yn + bonus) * siluf_(z));
                }
            }
        }
    }
}

constexpr size_t AF_BYTES = 16384, NF_BYTES = 16384, NCHUNK = 64;
constexpr int CHT = 128;
constexpr size_t OFF_AF = 0, OFF_NF = (size_t)16 * NCHUNK * AF_BYTES;
constexpr size_t OFF_QH = OFF_NF + (size_t)16 * NCHUNK * NF_BYTES;
constexpr size_t OFF_BON = OFF_QH + (size_t)16 * T * 64 * 2;
static_assert(OFF_BON + (size_t)16 * T * 4 <= (size_t)M * 1024 * 4, "d_out scratch");
typedef float f32x16 __attribute__((ext_vector_type(16)));
#define MFMA32(a, b, c) __builtin_amdgcn_mfma_f32_32x32x16_bf16((a), (b), (c), 0, 0, 0)
typedef float f32x2 __attribute__((ext_vector_type(2)));

DI unsigned pk2f(float lo, float hi) { typedef float f2_ __attribute__((ext_vector_type(2))); typedef __bf16 b2_ __attribute__((ext_vector_type(2))); return __builtin_bit_cast(unsigned, __builtin_convertvector((f2_){lo, hi}, b2_)); }
DI float quad_sum(float s) {
    s += __int_as_float(__builtin_amdgcn_update_dpp(0, __float_as_int(s), 0xB1, 0xF, 0xF, true));
    s += __int_as_float(__builtin_amdgcn_update_dpp(0, __float_as_int(s), 0x4E, 0xF, 0xF, true));
    return s;
}

DI float rwkv_stage_tok(const Params& p, const bf16_t* P, int b, int h, int t, float* o, float* sc, float mu_r, float mu_k, float mu_v, float mu_w, float mu_a,
                        float w0c, float a0c, float kkc, float kac, float rkc) {
    const int lane = threadIdx.x & 63, ch = h * 64 + lane;
    const bf16_t* pr = P + (size_t)(b * T + t) * NP; const bf16_t* pp = pr - NP; const bool hp = t > 0;
    const float rc = bf2f(pr[C_R + ch]), rp = hp ? bf2f(pp[C_R + ch]) : 0.f;
    const float kc = bf2f(pr[C_K + ch]), kp = hp ? bf2f(pp[C_K + ch]) : 0.f;
    const float vc = bf2f(pr[C_V + ch]), vp = hp ? bf2f(pp[C_V + ch]) : 0.f;
    const float wc = bf2f(pr[C_W + lane]), wp = hp ? bf2f(pp[C_W + lane]) : 0.f;
    const float ac = bf2f(pr[C_A + lane]), ap = hp ? bf2f(pp[C_A + lane]) : 0.f;
    const float r = rc + (rp - rc) * mu_r, k = kc + (kp - kc) * mu_k, v = vc + (vp - vc) * mu_v;
    const float lw = wc + (wp - wc) * mu_w, la = ac + (ap - ac) * mu_a;
    sc[lane] = tanhf(lw); sc[64 + lane] = la;
    float accw = 0.f, acca = 0.f;
    const float* w2p = p.w2; const float* a2p = p.a2;
    asm volatile("" : "+s"(w2p), "+s"(a2p));
#pragma unroll 8
    for (int j = 0; j < 64; ++j) { accw += sc[j] * w2p[j * 512 + ch]; acca += sc[64 + j] * a2p[j * 512 + ch]; }
    const float xw = -(w0c + accw);
    const float sp = xw > 20.f ? xw : log1pf(expf(xw));
    const float decay = expf(-expf(-sp - 0.5f));
    const float alpha = 1.f / (1.f + expf(-(a0c + acca)));
    const float kk0 = k * kkc;
    const float n2 = wave_sum(kk0 * kk0);
    const float kk = kk0 / fmaxf(sqrtf(n2), 1e-12f);
    const float k2 = k * (1.f + (alpha - 1.f) * kac);
    o[lane] = r; o[64 + lane] = decay; o[128 + lane] = k2; o[192 + lane] = v; o[256 + lane] = -kk; o[320 + lane] = kk * alpha;
    return wave_sum(r * k2 * rkc);
}

typedef float f32x4_t __attribute__((ext_vector_type(4)));
DI float row16_sum(float x) {
    x += __int_as_float(__builtin_amdgcn_update_dpp(0, __float_as_int(x), 0x128, 0xF, 0xF, true));
    x += __int_as_float(__builtin_amdgcn_update_dpp(0, __float_as_int(x), 0x124, 0xF, 0xF, true));
    x += __int_as_float(__builtin_amdgcn_update_dpp(0, __float_as_int(x), 0x122, 0xF, 0xF, true));
    x += __int_as_float(__builtin_amdgcn_update_dpp(0, __float_as_int(x), 0x121, 0xF, 0xF, true));
    return x;
}
DI void build_lora_frags(const Params& p, int h, unsigned char* bfrag) {
    for (int fidx = threadIdx.x; fidx < 1024; fidx += NTHREADS) {
        const int mat = fidx >> 9, nt = (fidx >> 7) & 3, ks = (fidx >> 6) & 1, l = fidx & 63, n = l & 15, kg = l >> 4;
        const float* W = (mat ? p.a2 : p.w2) + (size_t)(32 * ks + 8 * kg) * 512 + h * 64 + 16 * nt + n;
        unsigned w[4];
#pragma unroll
        for (int e2 = 0; e2 < 4; ++e2) w[e2] = (unsigned)f2bf(W[(2 * e2) * 512]) | ((unsigned)f2bf(W[(2 * e2 + 1) * 512]) << 16);
        *(uint4*)(bfrag + fidx * 16) = make_uint4(w[0], w[1], w[2], w[3]);
    }
}
template <int PART, int RS, bool R3>
DI void stage16(const Params& p, const bf16_t* P, int b, int h, int tg0, int tg1, int tg2, int tg3, float* recs, const unsigned char* bfrag, float* bon_out  ) {
    asm volatile("" : "+s"(h));
    const int lane = threadIdx.x & 63, n = lane & 15, rg = lane >> 4;
    constexpr int FIELD = PART == 0 ? 0 : 128;
    {
        const float mu = PART == 0 ? p.mu_wa[lane] : p.mu_wa[64 + lane];
        const int colx = (PART == 0 ? C_W : C_A) + lane;
#pragma unroll
        for (int gi = 0; gi < 4; ++gi) {
            const int t0 = gi == 0 ? tg0 : gi == 1 ? tg1 : gi == 2 ? tg2 : tg3;
            const bf16_t* base = P + (size_t)(b * T + t0) * NP + colx;
            float prev = t0 > 0 ? bf2f(base[-NP]) : 0.f;
#pragma unroll
            for (int rr = 0; rr < 4; ++rr) {
                const float cur = bf2f(base[rr * NP]);
                const float x = cur + (prev - cur) * mu; prev = cur;
                float val = x;
                if (PART == 0) { const float e2 = __expf(2.f * x); val = 1.f - 2.f * __builtin_amdgcn_rcpf(1.f + e2); }
                *(bf16_t*)((unsigned char*)(recs + (gi * 4 + rr) * RS + FIELD) + 2 * lane) = f2bf(val);
            }
        }
    }
    f32x4 acc[4];
#pragma unroll
    for (int nt = 0; nt < 4; ++nt) acc[nt] = (f32x4){0.f, 0.f, 0.f, 0.f};
#pragma unroll
    for (int ks = 0; ks < 2; ++ks) {
        const bf16x8 af = *(const bf16x8*)((const unsigned char*)(recs + n * RS + FIELD) + ks * 64 + rg * 16);
#pragma unroll
        for (int nt = 0; nt < 4; ++nt) {
            const bf16x8 bfr = *(const bf16x8*)(bfrag + (((PART * 4 + nt) * 2 + ks) * 64 + lane) * 16);
            acc[nt] = __builtin_amdgcn_mfma_f32_16x16x32_bf16(af, bfr, acc[nt], 0, 0, 0);
        }
    }
    const int tgl = rg == 0 ? tg0 : rg == 1 ? tg1 : rg == 2 ? tg2 : tg3;
    const bf16_t* rowb = P + (size_t)(b * T + tgl) * NP;
    float* rec0 = recs + (4 * rg) * RS;
    const bool hp = tgl > 0;
    if (PART == 0) {
#pragma unroll
        for (int nt = 0; nt < 4; ++nt) {
            const int cl = 16 * nt + n, ch = h * 64 + cl;
            const float mu_r = p.mu_rkv[ch], mu_v = p.mu_rkv[1024 + ch], w0c = p.w0[ch];
            float rp = hp ? bf2f(rowb[-NP + C_R + ch]) : 0.f, vp = hp ? bf2f(rowb[-NP + C_V + ch]) : 0.f;
#pragma unroll
            for (int rr = 0; rr < 4; ++rr) {
                const float rc = bf2f(rowb[rr * NP + C_R + ch]), vc = bf2f(rowb[rr * NP + C_V + ch]);
                const float r = rc + (rp - rc) * mu_r, v = vc + (vp - vc) * mu_v; rp = rc; vp = vc;
                const float xw = -(w0c + acc[nt][rr]);
                const float sp = xw > 20.f ? xw : __logf(1.f + __expf(xw));
                const float decay = __expf(-__expf(-sp - 0.5f));
                float* o = rec0 + rr * RS;
                o[cl] = r; o[64 + cl] = decay; o[192 + cl] = v;
            }
        }
    } else {
        float kv[4][4], kk0[4][4], al[4][4], rv[4][4], n2[4] = {0.f, 0.f, 0.f, 0.f};
#pragma unroll
        for (int nt = 0; nt < 4; ++nt) {
            const int ch = h * 64 + 16 * nt + n;
            const float mu_k = p.mu_rkv[512 + ch], mu_r = p.mu_rkv[ch], a0c = p.a0[ch], kkc = p.k_k[ch];
            float kp = hp ? bf2f(rowb[-NP + C_K + ch]) : 0.f, rp = (R3 && hp) ? bf2f(rowb[-NP + C_R + ch]) : 0.f;
#pragma unroll
            for (int rr = 0; rr < 4; ++rr) {
                const float kc = bf2f(rowb[rr * NP + C_K + ch]);
                const float k = kc + (kp - kc) * mu_k; kp = kc;
                if (R3) { const float rc = bf2f(rowb[rr * NP + C_R + ch]); rv[nt][rr] = rc + (rp - rc) * mu_r; rp = rc; }
                kv[nt][rr] = k; kk0[nt][rr] = k * kkc; n2[rr] += kk0[nt][rr] * kk0[nt][rr];
                al[nt][rr] = __builtin_amdgcn_rcpf(1.f + __expf(-(a0c + acc[nt][rr])));
            }
        }
        float inv[4], bon[4] = {0.f, 0.f, 0.f, 0.f};
#pragma unroll
        for (int rr = 0; rr < 4; ++rr) inv[rr] = 1.f / fmaxf(sqrtf(row16_sum(n2[rr])), 1e-12f);
#pragma unroll
        for (int nt = 0; nt < 4; ++nt) {
            const int cl = 16 * nt + n, ch = h * 64 + cl;
            const float kac = p.k_a[ch], rkc = p.r_k[ch];
#pragma unroll
            for (int rr = 0; rr < 4; ++rr) {
                const float kk = kk0[nt][rr] * inv[rr], k2 = kv[nt][rr] * (1.f + (al[nt][rr] - 1.f) * kac);
                float* o = rec0 + rr * RS;
                o[128 + cl] = k2; o[256 + cl] = -kk; o[320 + cl] = kk * al[nt][rr];
                if (R3) bon[rr] += rv[nt][rr] * k2 * rkc;
            }
        }
        if (R3) {
#pragma unroll
            for (int rr = 0; rr < 4; ++rr) { const float bs = row16_sum(bon[rr]); if (n == 0) bon_out[tgl + rr] = bs; }
        }
    }
}

constexpr size_t OFF_LWF = OFF_YB, OFF_ALF = OFF_YC;
DI void lora_group(const Params& p, const bf16_t* P, int b, int h, int bh, int t0, unsigned char* scr, const unsigned char* bfrag) {
    int lane = threadIdx.x & 63; asm volatile("" : "+v"(lane));
    const int n = lane & 15, rg = lane >> 4;
    {
        const float mu_w = p.mu_wa[lane], mu_a = p.mu_wa[64 + lane];
#pragma unroll
        for (int u = 0; u < 3; ++u) {
            const int pi = lane + 64 * u, row = pi >> 3, p16 = pi & 7, tt = t0 - 1 + row;
            if (pi < 17 * 8) {
                uint4 vw = make_uint4(0u, 0u, 0u, 0u), va = make_uint4(0u, 0u, 0u, 0u);
                if (tt >= 0) { vw = *(const uint4*)(P + (size_t)(b * T + tt) * NP + C_W + p16 * 8); va = *(const uint4*)(P + (size_t)(b * T + tt) * NP + C_A + p16 * 8); }
                *(uint4*)(scr + row * 128 + p16 * 16) = vw; *(uint4*)(scr + 2176 + row * 128 + p16 * 16) = va;
            }
        }
        float rw[17], ra[17];
#pragma unroll
        for (int i = 0; i < 17; ++i) { rw[i] = bf2f(*(const bf16_t*)(scr + i * 128 + 2 * lane)); ra[i] = bf2f(*(const bf16_t*)(scr + 2176 + i * 128 + 2 * lane)); }
        asm volatile("" ::: "memory");
#pragma unroll
        for (int i = 0; i < 16; ++i) {
            const float xw = rw[i + 1] + (rw[i] - rw[i + 1]) * mu_w;
            const float e2 = __expf(2.f * xw);
            *(bf16_t*)(scr + (i + 1) * 128 + 2 * lane) = f2bf(1.f - 2.f * __builtin_amdgcn_rcpf(1.f + e2));
            *(bf16_t*)(scr + 2176 + (i + 1) * 128 + 2 * lane) = f2bf(ra[i + 1] + (ra[i] - ra[i + 1]) * mu_a);
        }
    }
    f32x4 accw[4], acca[4];
#pragma unroll
    for (int nt = 0; nt < 4; ++nt) { accw[nt] = (f32x4){0.f, 0.f, 0.f, 0.f}; acca[nt] = (f32x4){0.f, 0.f, 0.f, 0.f}; }
#pragma unroll
    for (int ks = 0; ks < 2; ++ks) {
        const bf16x8 afw = *(const bf16x8*)(scr + (n + 1) * 128 + ks * 64 + rg * 16), afa = *(const bf16x8*)(scr + 2176 + (n + 1) * 128 + ks * 64 + rg * 16);
#pragma unroll
        for (int nt = 0; nt < 4; ++nt) {
            accw[nt] = __builtin_amdgcn_mfma_f32_16x16x32_bf16(afw, *(const bf16x8*)(bfrag + ((nt * 2 + ks) * 64 + lane) * 16), accw[nt], 0, 0, 0);
            acca[nt] = __builtin_amdgcn_mfma_f32_16x16x32_bf16(afa, *(const bf16x8*)(bfrag + (((4 + nt) * 2 + ks) * 64 + lane) * 16), acca[nt], 0, 0, 0);
        }
    }
    uint2* lwf = (uint2*)(p.ws + OFF_LWF) + ((size_t)(bh * 512 + (t0 >> 4)) * 4) * 64 + lane;
    uint2* alf = (uint2*)(p.ws + OFF_ALF) + ((size_t)(bh * 512 + (t0 >> 4)) * 4) * 64 + lane;
#pragma unroll
    for (int nt = 0; nt < 4; ++nt) {
        const int ch = h * 64 + 16 * nt + n;
        const float w0c = p.w0[ch], a0c = p.a0[ch];
        float lw[4], al[4];
#pragma unroll
        for (int rr = 0; rr < 4; ++rr) { const float xw = -(w0c + accw[nt][rr]); const float sp = fmaxf(xw, 0.f) + __logf(1.f + __expf(-fabsf(xw))); lw[rr] = -__expf(-sp - 0.5f);
            al[rr] = __builtin_amdgcn_rcpf(1.f + __expf(-(a0c + acca[nt][rr]))); }
        lwf[nt * 64] = make_uint2(pk2f(lw[0], lw[1]), pk2f(lw[2], lw[3]));
        alf[nt * 64] = make_uint2(pk2f(al[0], al[1]), pk2f(al[2], al[3]));
    }
}
template <int PART>
DI void stage16s(const Params& p, const unsigned char* rawc  , int h, int bh, int t0, float* recs, float* bon_out, float (&Lb)[4]) {
    asm volatile("" : "+s"(h));
    int lane = threadIdx.x & 63; asm volatile("" : "+v"(lane));
    const int n = lane & 15, rg = lane >> 4;
    constexpr int RS = 384;
    const int tgl = t0 + 4 * rg;
    const unsigned char* rawl = rawc + (4 * rg) * 384;
    const float hpf = tgl > 0 ? 1.f : 0.f;
    float* rec0 = recs + (4 * rg) * RS;
    const uint2* lwf = (const uint2*)(p.ws + OFF_LWF) + ((size_t)(bh * 512 + (t0 >> 4)) * 4) * 64 + lane;
    const uint2* alf = (const uint2*)(p.ws + OFF_ALF) + ((size_t)(bh * 512 + (t0 >> 4)) * 4) * 64 + lane;
#define S16S_L(nt_) \
        float eL[4], eLm[4], eN[4]; { const uint2 lwp = lwf[(nt_) * 64]; float lw[4], pl[4]; \
        lw[0] = __uint_as_float(lwp.x << 16); lw[1] = __uint_as_float(lwp.x & 0xffff0000u); lw[2] = __uint_as_float(lwp.y << 16); lw[3] = __uint_as_float(lwp.y & 0xffff0000u); \
        pl[0] = lw[0]; pl[1] = pl[0] + lw[1]; pl[2] = pl[1] + lw[2]; pl[3] = pl[2] + lw[3]; \
        float inc = pl[3]; float y_ = __shfl_up(inc, 16, 64); if (rg >= 1) inc += y_; y_ = __shfl_up(inc, 32, 64); if (rg >= 2) inc += y_; \
        const float tot = __shfl(inc, 48 + n, 64); const float base_ = Lb[nt_] + inc - pl[3]; \
        _Pragma("unroll") for (int rr = 0; rr < 4; ++rr) { const float L = base_ + pl[rr]; const float Lc = fmaxf(L, -80.f), Lm = fmaxf(L - lw[rr], -80.f); eL[rr] = __expf(Lc); eLm[rr] = __expf(Lm); eN[rr] = __expf(-Lc); } \
        Lb[nt_] += tot; }
    if (PART == 0) {
#pragma unroll
        for (int nt = 0; nt < 4; ++nt) {
            S16S_L(nt)
            (void)eLm; (void)eN;
            const int cl = 16 * nt + n, ch = h * 64 + cl;
            const float mu_r = p.mu_rkv[ch], mu_v = p.mu_rkv[1024 + ch];
            float rr_[5], vv_[5];
#pragma unroll
            for (int r5 = 0; r5 < 5; ++r5) { rr_[r5] = bf2f(*(const bf16_t*)(rawl + r5 * 384 + cl * 2)); vv_[r5] = bf2f(*(const bf16_t*)(rawl + r5 * 384 + 256 + cl * 2)); }
            rr_[0] *= hpf; vv_[0] *= hpf;
#pragma unroll
            for (int rr = 0; rr < 4; ++rr) {
                const float r = rr_[rr + 1] + (rr_[rr] - rr_[rr + 1]) * mu_r, v = vv_[rr + 1] + (vv_[rr] - vv_[rr + 1]) * mu_v;
                float* o = rec0 + rr * RS;
                o[cl] = r * eL[rr]; o[192 + cl] = v;
            }
            asm volatile("" ::: "memory");
        }
    } else {
        float kv[4][4], n2[4] = {0.f, 0.f, 0.f, 0.f};
#pragma unroll
        for (int nt = 0; nt < 4; ++nt) {
            const int ch = h * 64 + 16 * nt + n;
            const float mu_k = p.mu_rkv[512 + ch], kkc = p.k_k[ch];
            float kk_[5];
#pragma unroll
            for (int r5 = 0; r5 < 5; ++r5) kk_[r5] = bf2f(*(const bf16_t*)(rawl + r5 * 384 + 128 + (16 * nt + n) * 2));
            kk_[0] *= hpf;
#pragma unroll
            for (int rr = 0; rr < 4; ++rr) { const float k = kk_[rr + 1] + (kk_[rr] - kk_[rr + 1]) * mu_k; kv[nt][rr] = k; const float k0 = k * kkc; n2[rr] += k0 * k0; }
        }
        float inv[4], bon[4] = {0.f, 0.f, 0.f, 0.f};
#pragma unroll
        for (int rr = 0; rr < 4; ++rr) inv[rr] = 1.f / fmaxf(sqrtf(row16_sum(n2[rr])), 1e-12f);
#pragma unroll
        for (int nt = 0; nt < 4; ++nt) {
            S16S_L(nt)
            (void)eL;
            const int cl = 16 * nt + n, ch = h * 64 + cl;
            const float kac = p.k_a[ch], rkc = p.r_k[ch], mu_r = p.mu_rkv[ch], kkc = p.k_k[ch];
            const uint2 alp = alf[nt * 64];
            const float al4[4] = {__uint_as_float(alp.x << 16), __uint_as_float(alp.x & 0xffff0000u), __uint_as_float(alp.y << 16), __uint_as_float(alp.y & 0xffff0000u)};
            float rr_[5];
#pragma unroll
            for (int r5 = 0; r5 < 5; ++r5) rr_[r5] = bf2f(*(const bf16_t*)(rawl + r5 * 384 + cl * 2));
            rr_[0] *= hpf;
#pragma unroll
            for (int rr = 0; rr < 4; ++rr) {
                const float r = rr_[rr + 1] + (rr_[rr] - rr_[rr + 1]) * mu_r;
                const float al = al4[rr];
                const float k = kv[nt][rr], kk = k * kkc * inv[rr], k2 = k * (1.f + (al - 1.f) * kac);
                float* o = rec0 + rr * RS;
                o[128 + cl] = k2 * eN[rr]; o[256 + cl] = -kk * eLm[rr]; o[320 + cl] = kk * al * eN[rr];
                bon[rr] += r * k2 * rkc;
            }
            asm volatile("" ::: "memory");
        }
#pragma unroll
        for (int rr = 0; rr < 4; ++rr) { const float bs = row16_sum(bon[rr]); if (n == 0) bon_out[tgl + rr] = bs; }
    }
#undef S16S_L
}
typedef float v2f __attribute__((ext_vector_type(2)));
template <int MODE> DI void rwkv_step_s(v2f (&z)[4][8], const float* cc, int q, int g, float (&yo)[4]) {
    f32x4 av[4], bv[4], kv[4], rv[4];
#pragma unroll
    for (int u = 0; u < 4; ++u) { av[u] = *(const f32x4*)(cc + 256 + 16 * q + 4 * u); bv[u] = *(const f32x4*)(cc + 320 + 16 * q + 4 * u); rv[u] = *(const f32x4*)(cc + 16 * q + 4 * u);
        if (MODE == 1) kv[u] = *(const f32x4*)(cc + 128 + 16 * q + 4 * u); }
    f32x4 vr = (f32x4){0.f, 0.f, 0.f, 0.f};
    if (MODE == 1) vr = *(const f32x4*)(cc + 192 + 4 * g);
#define V2LO(x_) ((v2f){(x_)[0], (x_)[1]})
#define V2HI(x_) ((v2f){(x_)[2], (x_)[3]})
    float sa[4];
#pragma unroll
    for (int rr = 0; rr < 4; ++rr) {
        v2f s = z[rr][0] * V2LO(av[0]);
        s = __builtin_elementwise_fma(z[rr][1], V2HI(av[0]), s);
#pragma unroll
        for (int u = 1; u < 4; ++u) { s = __builtin_elementwise_fma(z[rr][2 * u], V2LO(av[u]), s); s = __builtin_elementwise_fma(z[rr][2 * u + 1], V2HI(av[u]), s); }
        sa[rr] = quad_sum(s[0] + s[1]);
    }
#pragma unroll
    for (int rr = 0; rr < 4; ++rr) {
        const v2f sa2 = (v2f){sa[rr], sa[rr]}, vr2 = (v2f){vr[rr], vr[rr]};
#pragma unroll
        for (int u = 0; u < 4; ++u) {
            v2f t0 = __builtin_elementwise_fma(sa2, V2LO(bv[u]), z[rr][2 * u]), t1 = __builtin_elementwise_fma(sa2, V2HI(bv[u]), z[rr][2 * u + 1]);
            if (MODE == 1) { t0 = __builtin_elementwise_fma(vr2, V2LO(kv[u]), t0); t1 = __builtin_elementwise_fma(vr2, V2HI(kv[u]), t1); }
            z[rr][2 * u] = t0; z[rr][2 * u + 1] = t1;
        }
    }
#pragma unroll
    for (int rr = 0; rr < 4; ++rr) {
        v2f s = z[rr][0] * V2LO(rv[0]);
        s = __builtin_elementwise_fma(z[rr][1], V2HI(rv[0]), s);
#pragma unroll
        for (int u = 1; u < 4; ++u) { s = __builtin_elementwise_fma(z[rr][2 * u], V2LO(rv[u]), s); s = __builtin_elementwise_fma(z[rr][2 * u + 1], V2HI(rv[u]), s); }
        yo[rr] = quad_sum(s[0] + s[1]);
    }
#undef V2LO
#undef V2HI
}

template <int MODE> DI void rwkv_step(float (&z)[4][16], const float* cc, int q, int g, float (&sa)[4], float (&yo)[4]) {
    f32x4 av[4], wv[4], bv[4], kv[4];
#pragma unroll
    for (int u = 0; u < 4; ++u) { av[u] = *(const f32x4*)(cc + 256 + 16 * q + 4 * u); wv[u] = *(const f32x4*)(cc + 64 + 16 * q + 4 * u); bv[u] = *(const f32x4*)(cc + 320 + 16 * q + 4 * u);
        if (MODE == 1) kv[u] = *(const f32x4*)(cc + 128 + 16 * q + 4 * u); }
    f32x4 vr = (f32x4){0.f, 0.f, 0.f, 0.f};
    if (MODE == 1) vr = *(const f32x4*)(cc + 192 + 4 * g);
#pragma unroll
    for (int rr = 0; rr < 4; ++rr) {
        float s0 = 0.f, s1 = 0.f;
#pragma unroll
        for (int u = 0; u < 4; ++u) { s0 += z[rr][4 * u] * av[u][0] + z[rr][4 * u + 2] * av[u][2]; s1 += z[rr][4 * u + 1] * av[u][1] + z[rr][4 * u + 3] * av[u][3]; }
        sa[rr] = quad_sum(s0 + s1);
    }
#pragma unroll
    for (int rr = 0; rr < 4; ++rr)
#pragma unroll
        for (int u = 0; u < 4; ++u)
#pragma unroll
            for (int e = 0; e < 4; ++e) {
                float t = sa[rr] * bv[u][e];
                if (MODE == 1) t += vr[rr] * kv[u][e];
                z[rr][4 * u + e] = z[rr][4 * u + e] * wv[u][e] + t;
            }
    f32x4 rv[4];
#pragma unroll
    for (int u = 0; u < 4; ++u) rv[u] = *(const f32x4*)(cc + 16 * q + 4 * u);
#pragma unroll
    for (int rr = 0; rr < 4; ++rr) {
        float s0 = 0.f, s1 = 0.f;
#pragma unroll
        for (int u = 0; u < 4; ++u) { s0 += z[rr][4 * u] * rv[u][0] + z[rr][4 * u + 2] * rv[u][2]; s1 += z[rr][4 * u + 1] * rv[u][1] + z[rr][4 * u + 3] * rv[u][3]; }
        yo[rr] = quad_sum(s0 + s1);
    }
}

DI void phase_rwkv_prep(const Params& p, unsigned char* lds, const int bid, const int nb) {
    float* ck = (float*)lds; unsigned char* bfrag = lds + 64 * 384 * 4; float* mat = (float*)lds;
    const bf16_t* P = (const bf16_t*)(p.ws + OFF_P);
    unsigned char* fr = (unsigned char*)p.out;
    bf16_t* YA = (bf16_t*)(p.ws + OFF_YA);
    for (int item = bid; item < 256; item += nb) {
        int tid = threadIdx.x; asm volatile("" : "+v"(tid));
        const int lane = tid & 63, wid = __builtin_amdgcn_readfirstlane(tid >> 6), q = lane & 3, g = lane >> 2, cl = wid & 3, role = wid >> 2;
        const int bh = item >> 4, cq = item & 15, b = bh >> 3, h = bh & 7;
        __syncthreads();
        build_lora_frags(p, h, bfrag);
        __syncthreads();
        {
#pragma unroll 1
            for (int gi = 0; gi < 4; ++gi) lora_group(p, P, b, h, bh, cq * 4 * CHT + (wid + 8 * gi) * 16, lds + wid * 4352, bfrag);
            asm volatile("s_waitcnt vmcnt(0)" ::: "memory");
            __syncthreads();
            if (tid == 0) __builtin_amdgcn_fence(__ATOMIC_ACQUIRE, "agent");
            asm volatile("s_waitcnt vmcnt(0)" ::: "memory");
        }
        v2f z[4][8];
#pragma unroll
        for (int rr = 0; rr < 4; ++rr)
#pragma unroll
            for (int c = 0; c < 16; ++c) z[rr][c >> 1][c & 1] = (role == 0 && (4 * g + rr) == (16 * q + c)) ? 1.f : 0.f;
        bf16_t* qh = (bf16_t*)(fr + OFF_QH) + (size_t)bh * T * 64;
        float* bon = (float*)(fr + OFF_BON) + (size_t)bh * T;
        float Lb[4] = {0.f, 0.f, 0.f, 0.f};
        unsigned char* rawbuf = lds + 64 * 384 * 4 + 16384 + 2048;
#define RAW_DMA(sl_) do { int ln_ = lane; asm volatile("" : "+v"(ln_)); _Pragma("unroll") for (int u_ = 0; u_ < 4; ++u_) { const int slot_ = u_ * 8 + wid; if (slot_ < 26) { int pi = slot_ * 64 + ln_; pi = pi < 1632 ? pi : 1631; \
            const int clx = pi / 408, rem = pi - clx * 408, row = rem / 24, r2 = rem - row * 24, seg = r2 >> 3, p16 = r2 & 7; int tt = (cq * 4 + clx) * CHT + (sl_) * 16 - 1 + row; tt = tt < 0 ? 0 : tt; \
            __builtin_amdgcn_global_load_lds((const unsigned*)(P + (size_t)(b * T + tt) * NP + (seg == 0 ? C_R : seg == 1 ? C_K : C_V) + h * 64 + p16 * 8), (LAS unsigned*)(LASP(rawbuf) + slot_ * 1024), 16, 0, 0); } } } while (0)
        RAW_DMA(0);
#pragma unroll 1
        for (int sl = 0; sl < CHT / 16; ++sl) {
            const int tb = (cq * 4 + cl) * CHT + sl * 16;
            __syncthreads();
            if (role == 0) stage16s<0>(p, rawbuf + cl * 6528, h, bh, tb, ck + cl * 16 * 384, bon, Lb);
            else           stage16s<1>(p, rawbuf + cl * 6528, h, bh, tb, ck + cl * 16 * 384, bon, Lb);
            __syncthreads();
            if (sl + 1 < CHT / 16) RAW_DMA(sl + 1);
            float yo[4];
            if (role == 0) {
#pragma unroll 1
                for (int i = 0; i < 16; ++i) { rwkv_step_s<0>(z, ck + (cl * 16 + i) * 384, q, g, yo);
                    qh[(size_t)(tb + i) * 64 + 4 * g + q] = f2bf(q == 0 ? yo[0] : q == 1 ? yo[1] : q == 2 ? yo[2] : yo[3]); } }
            else {
#pragma unroll 1
                for (int i = 0; i < 16; ++i) { rwkv_step_s<1>(z, ck + (cl * 16 + i) * 384, q, g, yo);
                    YA[(size_t)(b * T + tb + i) * 512 + h * 64 + 4 * g + q] = f2bf(q == 0 ? yo[0] : q == 1 ? yo[1] : q == 2 ? yo[2] : yo[3]); } }
        }
        {
            float* gC = (float*)(lds + 64 * 384 * 4 + 16384) + wid * 64;
            __syncthreads();
            if ((lane >> 4) == 0) {
#pragma unroll
                for (int nt = 0; nt < 4; ++nt) gC[16 * nt + (lane & 15)] = __expf(fmaxf(Lb[nt], -80.f));
            }
            asm volatile("s_waitcnt lgkmcnt(0)" ::: "memory");
#pragma unroll
            for (int u = 0; u < 4; ++u) { const f32x4 g4 = *(const f32x4*)(gC + 16 * q + 4 * u);
#pragma unroll
                for (int rr = 0; rr < 4; ++rr)
#pragma unroll
                    for (int e = 0; e < 4; ++e) z[rr][2 * u + (e >> 1)][e & 1] *= g4[e]; }
        }
        for (int pass = 0; pass < 2; ++pass) {
            __syncthreads();
            if (role == pass) {
#pragma unroll
                for (int rr = 0; rr < 4; ++rr)
#pragma unroll
                    for (int u = 0; u < 4; ++u) *(f32x4*)(mat + (cl * 64 + 4 * g + rr) * 68 + 16 * q + 4 * u) = (f32x4){z[rr][2 * u][0], z[rr][2 * u][1], z[rr][2 * u + 1][0], z[rr][2 * u + 1][1]};
            }
            __syncthreads();
            int tidb = threadIdx.x; asm volatile("" : "+v"(tidb));
            if (pass == 0) {
                for (int it = tidb; it < 4 * 8 * 64; it += NTHREADS) {
                    const int clx = it >> 9, f = (it >> 6) & 7, l = it & 63, n16 = l & 15, gg = l >> 4, fi = f >> 1, fs = f & 1;
                    const size_t chunk = (size_t)bh * NCHUNK + cq * 4 + clx;
                    unsigned hi[4], lo[4];
#pragma unroll
                    for (int e2 = 0; e2 < 4; ++e2) {
                        unsigned short hs[2], ls[2];
#pragma unroll
                        for (int d = 0; d < 2; ++d) { const int e = 2 * e2 + d, kin = 32 * fs + 16 * (e >> 2) + 4 * gg + (e & 3), kout = 16 * fi + n16;
                            const float val = mat[(clx * 64 + kin) * 68 + kout]; hs[d] = f2bf(val); ls[d] = f2bf(val - bf2f(hs[d])); }
                        hi[e2] = (unsigned)hs[0] | ((unsigned)hs[1] << 16); lo[e2] = (unsigned)ls[0] | ((unsigned)ls[1] << 16);
                    }
                    unsigned char* dst = fr + OFF_AF + chunk * AF_BYTES + (size_t)((f * 2) * 64 + l) * 16;
                    *(uint4*)dst = make_uint4(hi[0], hi[1], hi[2], hi[3]);
                    *(uint4*)(dst + 64 * 16) = make_uint4(lo[0], lo[1], lo[2], lo[3]);
                }
            } else {
                for (int it = tidb; it < 4 * 4 * 4 * 64; it += NTHREADS) {
                    const int l = it & 63, fi = (it >> 6) & 3, w4 = (it >> 8) & 3, clx = it >> 10, gg = l >> 4;
                    const size_t chunk = (size_t)bh * NCHUNK + cq * 4 + clx;
                    const f32x4 v4 = *(const f32x4*)(mat + (clx * 64 + 16 * w4 + (l & 15)) * 68 + 16 * fi + 4 * gg);
                    *(f32x4*)(fr + OFF_NF + chunk * NF_BYTES + (size_t)(((w4 * 4 + fi) * 64 + l) * 4) * 4) = v4;
                }
            }
        }
    }
}

DI void split4x2(const f32x4& xa, const f32x4& xb, bf16x8& hi, bf16x8& lo) {
#pragma unroll
    for (int e = 0; e < 4; ++e) { const float va = xa[e], vb = xb[e]; const bf16_t ha = f2bf(va), hb = f2bf(vb);
        hi[e] = (short)ha; hi[4 + e] = (short)hb; lo[e] = (short)f2bf(va - bf2f(ha)); lo[4 + e] = (short)f2bf(vb - bf2f(hb)); }
}
DI void phase_rwkv_scan(const Params& p, unsigned char* lds, const int bh) {
    unsigned char* fr = (unsigned char*)p.out;
    const int tid = threadIdx.x, lane = tid & 63, wid = tid >> 6;
    const unsigned char* gA = fr + OFF_AF + (size_t)bh * NCHUNK * AF_BYTES;
    unsigned char* gN = fr + OFF_NF + (size_t)bh * NCHUNK * NF_BYTES;
    const bool loader = wid >= 4;
    const int wl = __builtin_amdgcn_readfirstlane(wid - 4);
#define SCAN_DMA(cc_) do { const unsigned char* ga_ = gA + (size_t)(cc_) * AF_BYTES + wl * 4096 + lane * 16; const unsigned char* gn_ = gN + (size_t)(cc_) * NF_BYTES + wl * 4096 + lane * 16; \
        __attribute__((address_space(3))) unsigned char* sl_ = LASP(lds) + ((cc_) & 3) * 32768 + wl * 4096; \
        _Pragma("unroll") for (int j_ = 0; j_ < 4; ++j_) __builtin_amdgcn_global_load_lds((const unsigned*)(ga_ + j_ * 1024), (__attribute__((address_space(3))) unsigned*)(sl_ + j_ * 1024), 16, 0, 0); \
        _Pragma("unroll") for (int j_ = 0; j_ < 4; ++j_) __builtin_amdgcn_global_load_lds((const unsigned*)(gn_ + j_ * 1024), (__attribute__((address_space(3))) unsigned*)(sl_ + 16384 + j_ * 1024), 16, 0, 0); } while (0)
    __syncthreads();
    if (loader) { SCAN_DMA(0); SCAN_DMA(1); SCAN_DMA(2); SCAN_DMA(3); asm volatile("s_waitcnt vmcnt(0)" ::: "memory"); }
    f32x4 X[4];
#pragma unroll
    for (int i = 0; i < 4; ++i) X[i] = (f32x4){0.f, 0.f, 0.f, 0.f};
    bf16x8 ah[8], al[8]; f32x4 nt[4];
#define SCAN_FRAGS(cc_) do { const unsigned char* s_ = lds + ((cc_) & 3) * 32768; \
        _Pragma("unroll") for (int f = 0; f < 8; ++f) { ah[f] = *(const bf16x8*)(s_ + ((f * 2) * 64 + lane) * 16); al[f] = *(const bf16x8*)(s_ + ((f * 2 + 1) * 64 + lane) * 16); } \
        _Pragma("unroll") for (int i = 0; i < 4; ++i) nt[i] = *(const f32x4*)(s_ + 16384 + ((wid * 4 + i) * 64 + lane) * 16); } while (0)
    asm volatile("s_waitcnt lgkmcnt(0)" ::: "memory"); __builtin_amdgcn_s_barrier(); asm volatile("" ::: "memory");
    if (!loader) SCAN_FRAGS(0);
    for (int c = 0; c < (int)NCHUNK; ++c) {
        if (loader) {
            if (c + 4 < (int)NCHUNK) { SCAN_DMA(c + 4); asm volatile("s_waitcnt vmcnt(16)" ::: "memory"); } else asm volatile("s_waitcnt vmcnt(0)" ::: "memory");
        } else {
            const int w4 = wid;
            float* gs = (float*)(gN + (size_t)c * NF_BYTES) + ((w4 * 4) * 64 + lane) * 4;
#pragma unroll
            for (int i = 0; i < 4; ++i) *(f32x4*)(gs + i * 256) = X[i];
            bf16x8 bhi[2], blo[2];
            split4x2(X[0], X[1], bhi[0], blo[0]); split4x2(X[2], X[3], bhi[1], blo[1]);
#pragma unroll
            for (int i = 0; i < 4; ++i) {
                f32x4 D = nt[i];
#pragma unroll
                for (int s = 0; s < 2; ++s) {
                    const int f = i * 2 + s;
                    D = __builtin_amdgcn_mfma_f32_16x16x32_bf16(ah[f], bhi[s], D, 0, 0, 0);
                    D = __builtin_amdgcn_mfma_f32_16x16x32_bf16(ah[f], blo[s], D, 0, 0, 0);
                    D = __builtin_amdgcn_mfma_f32_16x16x32_bf16(al[f], bhi[s], D, 0, 0, 0);
                }
                X[i] = D;
            }
            if (c + 1 < (int)NCHUNK) SCAN_FRAGS(c + 1);
        }
        asm volatile("s_waitcnt lgkmcnt(0)" ::: "memory"); __builtin_amdgcn_s_barrier(); asm volatile("" ::: "memory");
    }
    asm volatile("s_waitcnt vmcnt(0)" ::: "memory");
    __syncthreads();
    if (tid == 0) {
        __builtin_amdgcn_fence(__ATOMIC_RELEASE, "agent");
        asm volatile("s_waitcnt vmcnt(0)" ::: "memory");
        __hip_atomic_store((unsigned*)(p.ws + OFF_CTL + 32768 + 256) + bh, 1u, __ATOMIC_RELAXED, __HIP_MEMORY_SCOPE_AGENT);
    }
}

DI void rwkv_out_item(const Params& p, unsigned char* lds, const int item) {
    const bf16_t* P = (const bf16_t*)(p.ws + OFF_P); bf16_t* YA = (bf16_t*)(p.ws + OFF_YA);
    const unsigned char* fr = (const unsigned char*)p.out;
    int tid = threadIdx.x; asm volatile("" : "+v"(tid));
    const int lane = tid & 63, wid = __builtin_amdgcn_readfirstlane(tid >> 6), c = lane & 31, hh = lane >> 5;
    {
        const int chunkg = item * 2 + (wid >> 2), bh = chunkg >> 6, cc = chunkg & 63, b = bh >> 3, h = bh & 7, tt = wid & 3;
        const int t = cc * CHT + tt * 32 + c;
        const float* sf = (const float*)(fr + OFF_NF + (size_t)chunkg * NF_BYTES);
        const bf16_t* qh = (const bf16_t*)(fr + OFF_QH) + ((size_t)bh * T + t) * 64;
        bf16x8 qf[4];
#pragma unroll
        for (int ks = 0; ks < 4; ++ks) qf[ks] = *(const bf16x8*)(qh + 16 * ks + 8 * hh);
        f32x16 yt[2];
#pragma unroll
        for (int vt = 0; vt < 2; ++vt) {
#pragma unroll
            for (int i = 0; i < 16; ++i) yt[vt][i] = 0.f;
#pragma unroll
            for (int ks = 0; ks < 4; ++ks) {
                const int v = 32 * vt + c;
                const float* s0 = sf + (((v >> 4) * 4 + ks) * 64 + (v & 15) + 32 * hh) * 4;
                const f32x4 lo4 = *(const f32x4*)s0, hi4 = *(const f32x4*)(s0 + 64);
                bf16x8 ah, al;
#pragma unroll
                for (int e = 0; e < 4; ++e) { const bf16_t h0 = f2bf(lo4[e]), h1 = f2bf(hi4[e]); ah[e] = (short)h0; ah[4 + e] = (short)h1;
                    al[e] = (short)f2bf(lo4[e] - bf2f(h0)); al[4 + e] = (short)f2bf(hi4[e] - bf2f(h1)); }
                yt[vt] = MFMA32(ah, qf[ks], yt[vt]);
                yt[vt] = MFMA32(al, qf[ks], yt[vt]);
            }
        }
        const size_t row = (size_t)(b * T + t);
        bf16_t* yrow = YA + row * 512 + h * 64;
        float s1 = 0.f;
#pragma unroll
        for (int vt = 0; vt < 2; ++vt)
#pragma unroll
            for (int gq = 0; gq < 4; ++gq) {
                const uint2 yl = *(const uint2*)(yrow + 32 * vt + 8 * gq + 4 * hh);
                yt[vt][4 * gq] += __uint_as_float(yl.x << 16); yt[vt][4 * gq + 1] += __uint_as_float(yl.x & 0xffff0000u);
                yt[vt][4 * gq + 2] += __uint_as_float(yl.y << 16); yt[vt][4 * gq + 3] += __uint_as_float(yl.y & 0xffff0000u);
                s1 += (yt[vt][4 * gq] + yt[vt][4 * gq + 1]) + (yt[vt][4 * gq + 2] + yt[vt][4 * gq + 3]);
            }
        s1 += __shfl_xor(s1, 32, 64);
        const float mean = s1 * (1.f / 64.f);
        float s2 = 0.f;
#pragma unroll
        for (int vt = 0; vt < 2; ++vt)
#pragma unroll
            for (int i = 0; i < 16; ++i) { yt[vt][i] -= mean; s2 += yt[vt][i] * yt[vt][i]; }
        s2 += __shfl_xor(s2, 32, 64);
        const float rstd = rsqrtf(s2 * (1.f / 64.f) + 64e-5f);
        const float bon = *((const float*)(fr + OFF_BON) + (size_t)bh * T + t);
        const bf16_t* pr = P + row * NP; const bool hp = t > 0;
#pragma unroll
        for (int vt = 0; vt < 2; ++vt)
#pragma unroll
            for (int gq = 0; gq < 4; ++gq) {
                const int v0 = 32 * vt + 8 * gq + 4 * hh, ch = h * 64 + v0;
                const uint2 vc = *(const uint2*)(pr + C_V + ch), vp = hp ? *(const uint2*)(pr - NP + C_V + ch) : make_uint2(0u, 0u), zz = *(const uint2*)(pr + C_ZA + ch);
                const f32x4 mu = *(const f32x4*)(p.mu_rkv + 1024 + ch), lg = *(const f32x4*)(p.lnx_g + ch), lb = *(const f32x4*)(p.lnx_b + ch);
                float o[4];
#pragma unroll
                for (int e = 0; e < 4; ++e) {
                    const unsigned wc = e < 2 ? vc.x : vc.y, wp = e < 2 ? vp.x : vp.y, wz = e < 2 ? zz.x : zz.y;
                    const float vcur = (e & 1) ? __uint_as_float(wc & 0xffff0000u) : __uint_as_float(wc << 16), vprv = (e & 1) ? __uint_as_float(wp & 0xffff0000u) : __uint_as_float(wp << 16);
                    const float zv = (e & 1) ? __uint_as_float(wz & 0xffff0000u) : __uint_as_float(wz << 16);
                    const float vmix = vcur + (vprv - vcur) * mu[e];
                    o[e] = (yt[vt][4 * gq + e] * rstd * lg[e] + lb[e] + bon * vmix) * siluf_(zv);
                }
                *(uint2*)(yrow + v0) = make_uint2(pk2f(o[0], o[1]), pk2f(o[2], o[3]));
            }
    }
}

DI void phase_swa_simple(const Params& p, unsigned char* lds, const int bid, const int nb) {
    const bf16_t* P = (const bf16_t*)(p.ws + OFF_P); bf16_t* YB = (bf16_t*)(p.ws + OFF_YB);
    const long total = (long)BATCH * 8 * T;
    for (long it = (long)bid * NTHREADS + threadIdx.x; it < total; it += (long)nb * NTHREADS) {
        const int t = (int)(it % T), qh = (int)((it / T) % 8), b = (int)(it / ((long)T * 8)), kvh = qh >> 2;
        const size_t row = (size_t)(b * T + t);
        float q[64], acc[64];
        {
            const uint4* qp = (const uint4*)(P + row * NP + C_Q + qh * 64);
#pragma unroll
            for (int i = 0; i < 8; ++i) { const uint4 u = qp[i]; const unsigned w[4] = {u.x, u.y, u.z, u.w};
#pragma unroll
                for (int j = 0; j < 4; ++j) { q[i * 8 + j * 2] = __uint_as_float(w[j] << 16); q[i * 8 + j * 2 + 1] = __uint_as_float(w[j] & 0xffff0000u); } }
        }
#pragma unroll
        for (int d = 0; d < 64; ++d) acc[d] = 0.f;
        float m = p.sinks[qh], l = 1.f;
        for (int j = 0; j < 128; ++j) {
            const int s = t - 127 + j;
            if (s < 0) continue;
            const size_t krow = (size_t)(b * T + s) * NP;
            const uint4* kp = (const uint4*)(P + krow + C_SK + kvh * 64);
            float dot = 0.f;
#pragma unroll
            for (int i = 0; i < 8; ++i) { const uint4 u = kp[i]; const unsigned w[4] = {u.x, u.y, u.z, u.w};
#pragma unroll
                for (int jj = 0; jj < 4; ++jj) { dot += q[i * 8 + jj * 2] * __uint_as_float(w[jj] << 16) + q[i * 8 + jj * 2 + 1] * __uint_as_float(w[jj] & 0xffff0000u); } }
            const float sc = dot * 0.125f;
            const float mn = fmaxf(m, sc), corr = __expf(m - mn), pe = __expf(sc - mn);
            l = l * corr + pe; m = mn;
            const uint4* vp = (const uint4*)(P + krow + C_SV + kvh * 64);
#pragma unroll
            for (int i = 0; i < 8; ++i) { const uint4 u = vp[i]; const unsigned w[4] = {u.x, u.y, u.z, u.w};
#pragma unroll
                for (int jj = 0; jj < 4; ++jj) { acc[i * 8 + jj * 2] = acc[i * 8 + jj * 2] * corr + pe * __uint_as_float(w[jj] << 16);
                                                 acc[i * 8 + jj * 2 + 1] = acc[i * 8 + jj * 2 + 1] * corr + pe * __uint_as_float(w[jj] & 0xffff0000u); } }
        }
        const float inv = 1.f / l;
        const bf16_t* zp = P + row * NP + C_ZB + qh * 64; bf16_t* op = YB + row * 512 + qh * 64;
#pragma unroll
        for (int d = 0; d < 64; ++d) op[d] = f2bf(acc[d] * inv * siluf_(bf2f(zp[d])));
    }
}

DI void phase_xattn_simple(const Params& p, unsigned char* lds, const int bid, const int nb) {
    const bf16_t* P = (const bf16_t*)(p.ws + OFF_P); const bf16_t* KVM = (const bf16_t*)(p.ws + OFF_KVM); bf16_t* YC = (bf16_t*)(p.ws + OFF_YC);
    const int lane = threadIdx.x & 63, wid = threadIdx.x >> 6;
    const long total = (long)M * 4;
    const float scale = 0.08838834764831845f;
    for (long it = (long)bid * NWAVES + wid; it < total; it += (long)nb * NWAVES) {
        const int row = (int)(it >> 2), hd = (int)(it & 3), b = row / T;
        const bf16_t* qp = P + (size_t)row * NP + C_XQ + hd * 128;
        const bf16_t* kb = KVM + (size_t)(b * MEMLEN) * 1024 + hd * 128;
        float s[4] = {0.f, 0.f, 0.f, 0.f};
        for (int c = 0; c < 16; ++c) {
            const uint4 qu = *(const uint4*)(qp + c * 8); const unsigned qw[4] = {qu.x, qu.y, qu.z, qu.w};
#pragma unroll
            for (int i = 0; i < 4; ++i) {
                const uint4 ku = *(const uint4*)(kb + (size_t)(lane + 64 * i) * 1024 + c * 8); const unsigned kw[4] = {ku.x, ku.y, ku.z, ku.w};
#pragma unroll
                for (int j = 0; j < 4; ++j) s[i] += __uint_as_float(qw[j] << 16) * __uint_as_float(kw[j] << 16) + __uint_as_float(qw[j] & 0xffff0000u) * __uint_as_float(kw[j] & 0xffff0000u);
            }
        }
        float mx = -1e30f;
#pragma unroll
        for (int i = 0; i < 4; ++i) { s[i] *= scale; mx = fmaxf(mx, s[i]); }
        mx = wave_max(mx);
        float pe[4], sum = 0.f;
#pragma unroll
        for (int i = 0; i < 4; ++i) { pe[i] = __expf(s[i] - mx); sum += pe[i]; }
        sum = wave_sum(sum);
        const float inv = 1.f / sum;
        float o0 = 0.f, o1 = 0.f;
        const bf16_t* vb = kb + 512;
#pragma unroll
        for (int i = 0; i < 4; ++i)
            for (int mm = 0; mm < 64; ++mm) {
                const float pv = __shfl(pe[i], mm, 64);
                const bf16_t* vr = vb + (size_t)(mm + 64 * i) * 1024;
                o0 += pv * bf2f(vr[lane]); o1 += pv * bf2f(vr[lane + 64]);
            }
        const bf16_t* zp = P + (size_t)row * NP + C_ZC + hd * 128; bf16_t* op = YC + (size_t)row * 512 + hd * 128;
        op[lane] = f2bf(o0 * inv * siluf_(bf2f(zp[lane]))); op[lane + 64] = f2bf(o1 * inv * siluf_(bf2f(zp[lane + 64])));
    }
}

typedef short s16x4 __attribute__((ext_vector_type(4)));
DI int crow(int reg, int hh) { return (reg & 3) + 8 * (reg >> 2) + 4 * hh; }
template <int Dh> DI unsigned k_off(int row, int chunk) { return (unsigned)(row * (Dh * 2) + ((chunk ^ (row & (Dh / 8 - 1))) << 4)); }
DI bf16x8 pack8(const f32x16& x, int s) {
    bf16x8 r;
#pragma unroll
    for (int e = 0; e < 8; ++e) r[e] = (short)f2bf(x[8 * s + e]);
    return r;
}
DI unsigned pk2(float lo, float hi) { typedef float f2_ __attribute__((ext_vector_type(2))); typedef __bf16 b2_ __attribute__((ext_vector_type(2))); return __builtin_bit_cast(unsigned, __builtin_convertvector((f2_){lo, hi}, b2_)); }
DI void unpack8(const uint4& v, float (&x)[8]) { const unsigned w[4] = {v.x, v.y, v.z, v.w};
#pragma unroll
    for (int i = 0; i < 4; ++i) { x[2 * i] = __uint_as_float(w[i] << 16); x[2 * i + 1] = __uint_as_float(w[i] & 0xffff0000u); } }
DI uint4 pack8f(const float (&x)[8]) { return make_uint4(pk2(x[0], x[1]), pk2(x[2], x[3]), pk2(x[4], x[5]), pk2(x[6], x[7])); }
constexpr int VS = 528;

DI void swa_unit(const Params& p, unsigned char* lds, int unit) {
    const bf16_t* P = (const bf16_t*)(p.ws + OFF_P); bf16_t* YB = (bf16_t*)(p.ws + OFF_YB);
    int tid = threadIdx.x; asm volatile("" : "+v"(tid));
    const int lane = tid & 63, wid = __builtin_amdgcn_readfirstlane(tid >> 6), c = lane & 31, hh = lane >> 5;
    const int n = unit & 63, kvh = (unit >> 6) & 1, b = unit >> 7;
    unsigned char* Kl = lds; unsigned char* Vt = lds + 32768;
    __syncthreads();
#pragma unroll
    for (int u = 0; u < 4; ++u) {
        const int idx = tid + 512 * u;
        { const int row = idx >> 3, chunk = idx & 7, t = n * 128 - 128 + row, tc = t < 0 ? 0 : t;
          const uint4 v = *(const uint4*)(P + (size_t)(b * T + tc) * NP + C_SK + kvh * 64 + chunk * 8);
          float x[8]; unpack8(v, x);
          float ss = 0.f;
#pragma unroll
          for (int e = 0; e < 8; ++e) ss += x[e] * x[e];
          ss = quad_sum(ss); ss += __shfl_xor(ss, 4, 64);
          const float rs = rsqrtf(ss * (1.f / 64.f) + 1e-6f);
          const float2* rp = (const float2*)(p.ws + OFF_ROPE) + (size_t)(b * T + tc) * 32 + (chunk & 3) * 8;
          float o[8];
#pragma unroll
          for (int e = 0; e < 8; ++e) { const float y = x[e] * rs * p.k_norm_g[chunk * 8 + e]; const float yp = __shfl_xor(y, 4, 64); const float2 cs = rp[e];
              o[e] = chunk < 4 ? y * cs.x - yp * cs.y : y * cs.x + yp * cs.y; if (t < 0) o[e] = 0.f; }
          *(uint4*)(Kl + k_off<64>(row, chunk)) = pack8f(o); }
        { const int row = idx >> 3, chunk = idx & 7, t = n * 128 - 128 + row;
          uint4 v = make_uint4(0u, 0u, 0u, 0u);
          if (t >= 0) v = *(const uint4*)(P + (size_t)(b * T + t) * NP + C_SV + kvh * 64 + chunk * 8);
          *(uint4*)(Vt + k_off<64>(row, chunk)) = v; }
    }
    __syncthreads();
    const int qh = kvh * 4 + (wid >> 1), rh = wid & 1;
    const float sink = p.sinks[qh];
#pragma unroll 2
    for (int rt = 0; rt < 2; ++rt) {
        const int base = 64 * rh + 32 * rt;
        const size_t qrow = (size_t)(b * T + n * 128 + base + c);
        bf16x8 qf[4];
        {
            float xq[4][8]; float ss = 0.f;
#pragma unroll
            for (int ds = 0; ds < 4; ++ds) { unpack8(*(const uint4*)(P + qrow * NP + C_Q + qh * 64 + 16 * ds + 8 * hh), xq[ds]);
#pragma unroll
                for (int e = 0; e < 8; ++e) ss += xq[ds][e] * xq[ds][e]; }
            ss += __shfl_xor(ss, 32, 64);
            const float rs = rsqrtf(ss * (1.f / 64.f) + 1e-6f);
#pragma unroll
            for (int ds = 0; ds < 4; ++ds)
#pragma unroll
                for (int e = 0; e < 8; ++e) xq[ds][e] *= rs * p.q_norm_g[16 * ds + 8 * hh + e];
            const float2* rp = (const float2*)(p.ws + OFF_ROPE) + qrow * 32 + 8 * hh;
#pragma unroll
            for (int ds = 0; ds < 2; ++ds) { float lo[8], hi[8];
#pragma unroll
                for (int e = 0; e < 8; ++e) { const float2 cs = rp[16 * ds + e]; lo[e] = xq[ds][e] * cs.x - xq[ds + 2][e] * cs.y; hi[e] = xq[ds + 2][e] * cs.x + xq[ds][e] * cs.y; }
                qf[ds] = __builtin_bit_cast(bf16x8, pack8f(lo)); qf[ds + 2] = __builtin_bit_cast(bf16x8, pack8f(hi)); }
        }
        f32x16 st[5];
#pragma unroll
        for (int kt = 0; kt < 5; ++kt) {
#pragma unroll
            for (int i = 0; i < 16; ++i) st[kt][i] = 0.f;
#pragma unroll
            for (int ds = 0; ds < 4; ++ds) { const bf16x8 a = *(const bf16x8*)(Kl + k_off<64>(base + 32 * kt + c, 2 * ds + hh)); st[kt] = MFMA32(a, qf[ds], st[kt]); }
        }
        float mx = sink;
#pragma unroll
        for (int kt = 0; kt < 5; ++kt)
#pragma unroll
            for (int i = 0; i < 16; ++i) {
                const int cr = crow(i, hh);
                bool ok = true;
                if (kt == 0) ok = cr > c;
                if (kt == 4) ok = cr <= c;
                if (n == 0) ok = ok && (base + 32 * kt + cr >= 128);
                const float s = ok ? st[kt][i] * 0.125f : -1e30f;
                st[kt][i] = s; mx = fmaxf(mx, s);
            }
        mx = fmaxf(mx, __shfl_xor(mx, 32, 64));
        float ls = 0.f;
#pragma unroll
        for (int kt = 0; kt < 5; ++kt)
#pragma unroll
            for (int i = 0; i < 16; ++i) { const float pe = __expf(st[kt][i] - mx); st[kt][i] = pe; ls += pe; }
        ls += __shfl_xor(ls, 32, 64);
        const float inv = 1.f / (ls + __expf(sink - mx));
        f32x16 ot[2];
#pragma unroll
        for (int dt = 0; dt < 2; ++dt)
#pragma unroll
            for (int i = 0; i < 16; ++i) ot[dt][i] = 0.f;
#pragma unroll
        for (int kt = 0; kt < 5; ++kt)
#pragma unroll
            for (int s = 0; s < 2; ++s) {
                const bf16x8 pf = pack8(st[kt], s);
#pragma unroll
                for (int dt = 0; dt < 2; ++dt) {
                    const int key0 = base + 32 * kt + 16 * s + 4 * hh + ((lane & 15) >> 2), ch16 = 4 * dt + 2 * ((lane >> 4) & 1) + ((lane & 3) >> 1), sub = (lane & 1) * 8;
                    const s16x4 lo = __builtin_amdgcn_ds_read_tr16_b64_v4i16((LAS s16x4*)(Vt + k_off<64>(key0, ch16) + sub));
                    const s16x4 hi = __builtin_amdgcn_ds_read_tr16_b64_v4i16((LAS s16x4*)(Vt + k_off<64>(key0 + 8, ch16) + sub));
                    const bf16x8 vf = __builtin_shufflevector(lo, hi, 0, 1, 2, 3, 4, 5, 6, 7);
                    ot[dt] = MFMA32(vf, pf, ot[dt]);
                }
            }
        const bf16_t* zp = P + qrow * NP + C_ZB + qh * 64; bf16_t* op = YB + qrow * 512 + qh * 64;
#pragma unroll
        for (int dt = 0; dt < 2; ++dt)
#pragma unroll
            for (int gq = 0; gq < 4; ++gq) {
                const int d0 = 32 * dt + 8 * gq + 4 * hh;
                const uint2 zz = *(const uint2*)(zp + d0);
                const float z0 = __uint_as_float(zz.x << 16), z1 = __uint_as_float(zz.x & 0xffff0000u), z2 = __uint_as_float(zz.y << 16), z3 = __uint_as_float(zz.y & 0xffff0000u);
                const unsigned o0 = (unsigned)f2bf(ot[dt][4 * gq] * inv * siluf_(z0)) | ((unsigned)f2bf(ot[dt][4 * gq + 1] * inv * siluf_(z1)) << 16);
                const unsigned o1 = (unsigned)f2bf(ot[dt][4 * gq + 2] * inv * siluf_(z2)) | ((unsigned)f2bf(ot[dt][4 * gq + 3] * inv * siluf_(z3)) << 16);
                *(uint2*)(op + d0) = make_uint2(o0, o1);
            }
    }
}

DI void xattn_unit(const Params& p, unsigned char* lds, int unit) {
    const bf16_t* P = (const bf16_t*)(p.ws + OFF_P); const bf16_t* KVM = (const bf16_t*)(p.ws + OFF_KVM); bf16_t* YC = (bf16_t*)(p.ws + OFF_YC);
    int tid = threadIdx.x; asm volatile("" : "+v"(tid));
    const int lane = tid & 63, wid = __builtin_amdgcn_readfirstlane(tid >> 6), c = lane & 31, hh = lane >> 5;
    const int qb = unit & 31, hd = (unit >> 5) & 3, b = unit >> 7;
    unsigned char* Kl = lds; unsigned char* Vt = lds + 65536;
    const bf16_t* kb = KVM + (size_t)(b * MEMLEN) * 1024 + hd * 128;
    __syncthreads();
#pragma unroll
    for (int u = 0; u < 8; ++u) {
        const int idx = tid + 512 * u;
        { const int row = idx >> 4, chunk = idx & 15;
          float x[8]; unpack8(*(const uint4*)(kb + (size_t)row * 1024 + chunk * 8), x);
          float ss = 0.f;
#pragma unroll
          for (int e = 0; e < 8; ++e) ss += x[e] * x[e];
          const float rs = rsqrtf(row16_sum(ss) * (1.f / 128.f) + 1e-6f);
#pragma unroll
          for (int e = 0; e < 8; ++e) x[e] *= rs * p.xk_norm_g[chunk * 8 + e];
          *(uint4*)(Kl + k_off<128>(row, chunk)) = pack8f(x); }
        { const int row = idx >> 4, chunk = idx & 15;
          *(uint4*)(Vt + k_off<128>(row, chunk)) = *(const uint4*)(kb + (size_t)row * 1024 + 512 + chunk * 8); }
    }
    __syncthreads();
    const size_t qrow = (size_t)(b * T + qb * 256 + wid * 32 + c);
    const float scale = 0.08838834764831845f;
    bf16x8 qf[8];
    {
        float ss = 0.f; uint4 raw[8];
#pragma unroll
        for (int ds = 0; ds < 8; ++ds) { raw[ds] = *(const uint4*)(P + qrow * NP + C_XQ + hd * 128 + 16 * ds + 8 * hh); float x[8]; unpack8(raw[ds], x);
#pragma unroll
            for (int e = 0; e < 8; ++e) ss += x[e] * x[e]; }
        ss += __shfl_xor(ss, 32, 64);
        const float rs = rsqrtf(ss * (1.f / 128.f) + 1e-6f);
#pragma unroll
        for (int ds = 0; ds < 8; ++ds) { float x[8]; unpack8(raw[ds], x);
#pragma unroll
            for (int e = 0; e < 8; ++e) x[e] *= rs * p.xq_norm_g[16 * ds + 8 * hh + e];
            qf[ds] = __builtin_bit_cast(bf16x8, pack8f(x)); }
    }
    f32x16 ot[4];
#pragma unroll
    for (int dt = 0; dt < 4; ++dt)
#pragma unroll
        for (int i = 0; i < 16; ++i) ot[dt][i] = 0.f;
    float mrun = -1e30f, lrun = 0.f;
#pragma unroll 1
    for (int half = 0; half < 2; ++half) {
        f32x16 st[4];
#pragma unroll
        for (int kt = 0; kt < 4; ++kt) {
#pragma unroll
            for (int i = 0; i < 16; ++i) st[kt][i] = 0.f;
#pragma unroll
            for (int ds = 0; ds < 8; ++ds) { const bf16x8 a = *(const bf16x8*)(Kl + k_off<128>(128 * half + 32 * kt + c, 2 * ds + hh)); st[kt] = MFMA32(a, qf[ds], st[kt]); }
        }
        float mx = mrun;
#pragma unroll
        for (int kt = 0; kt < 4; ++kt)
#pragma unroll
            for (int i = 0; i < 16; ++i) { st[kt][i] *= scale; mx = fmaxf(mx, st[kt][i]); }
        mx = fmaxf(mx, __shfl_xor(mx, 32, 64));
        const float corr = __expf(mrun - mx);
        float ls = 0.f;
#pragma unroll
        for (int kt = 0; kt < 4; ++kt)
#pragma unroll
            for (int i = 0; i < 16; ++i) { const float pe = __expf(st[kt][i] - mx); st[kt][i] = pe; ls += pe; }
        ls += __shfl_xor(ls, 32, 64);
        lrun = lrun * corr + ls; mrun = mx;
#pragma unroll
        for (int dt = 0; dt < 4; ++dt)
#pragma unroll
            for (int i = 0; i < 16; ++i) ot[dt][i] *= corr;
#pragma unroll
        for (int kt = 0; kt < 4; ++kt)
#pragma unroll
            for (int s = 0; s < 2; ++s) {
                const bf16x8 pf = pack8(st[kt], s);
#pragma unroll
                for (int dt = 0; dt < 4; ++dt) {
                    const int key0 = 128 * half + 32 * kt + 16 * s + 4 * hh + ((lane & 15) >> 2), ch16 = 4 * dt + 2 * ((lane >> 4) & 1) + ((lane & 3) >> 1), sub = (lane & 1) * 8;
                    const s16x4 lo = __builtin_amdgcn_ds_read_tr16_b64_v4i16((LAS s16x4*)(Vt + k_off<128>(key0, ch16) + sub));
                    const s16x4 hi = __builtin_amdgcn_ds_read_tr16_b64_v4i16((LAS s16x4*)(Vt + k_off<128>(key0 + 8, ch16) + sub));
                    const bf16x8 vf = __builtin_shufflevector(lo, hi, 0, 1, 2, 3, 4, 5, 6, 7);
                    ot[dt] = MFMA32(vf, pf, ot[dt]);
                }
            }
    }
    const float inv = 1.f / lrun;
    const bf16_t* zp = P + qrow * NP + C_ZC + hd * 128; bf16_t* op = YC + qrow * 512 + hd * 128;
#pragma unroll
    for (int dt = 0; dt < 4; ++dt)
#pragma unroll
        for (int gq = 0; gq < 4; ++gq) {
            const int d0 = 32 * dt + 8 * gq + 4 * hh;
            const uint2 zz = *(const uint2*)(zp + d0);
            const float z0 = __uint_as_float(zz.x << 16), z1 = __uint_as_float(zz.x & 0xffff0000u), z2 = __uint_as_float(zz.y << 16), z3 = __uint_as_float(zz.y & 0xffff0000u);
            const unsigned o0 = (unsigned)f2bf(ot[dt][4 * gq] * inv * siluf_(z0)) | ((unsigned)f2bf(ot[dt][4 * gq + 1] * inv * siluf_(z1)) << 16);
            const unsigned o1 = (unsigned)f2bf(ot[dt][4 * gq + 2] * inv * siluf_(z2)) | ((unsigned)f2bf(ot[dt][4 * gq + 3] * inv * siluf_(z3)) << 16);
            *(uint2*)(op + d0) = make_uint2(o0, o1);
        }
}
DI void phase_attn_queue(const Params& p, unsigned char* lds) {
    unsigned* head = (unsigned*)(p.ws + OFF_CTL + 32768);
    volatile LAS unsigned* bc = (volatile LAS unsigned*)(lds + LDS_CTL_OFF + 128);
    for (;;) {
        __syncthreads();
        if (threadIdx.x == 0) bc[0] = __hip_atomic_fetch_add(head, 1u, __ATOMIC_RELAXED, __HIP_MEMORY_SCOPE_AGENT);
        __syncthreads();
        const unsigned u = bc[0];
        if (u >= 1024u + 172u) break;
        if (u >= 512u && u < 684u) { convert_late(p, lds, (int)u - 512, 172); continue; }
        if (u < 512u) { if (u & 1u) xattn_unit(p, lds, (int)(u >> 1)); else swa_unit(p, lds, (int)(u >> 1)); }
        else {
            const int item = (int)u - 684, bh = item >> 5;
            if (threadIdx.x == 0) {
                unsigned* flag = (unsigned*)(p.ws + OFF_CTL + 32768 + 256) + bh; unsigned sp = 0;
                while (__hip_atomic_load(flag, __ATOMIC_RELAXED, __HIP_MEMORY_SCOPE_AGENT) == 0u) { __builtin_amdgcn_s_sleep(8); if (++sp > (1u << 22)) break; }
                __builtin_amdgcn_fence(__ATOMIC_ACQUIRE, "agent");
                asm volatile("s_waitcnt vmcnt(0)" ::: "memory");
            }
            __syncthreads();
            rwkv_out_item(p, lds, item);
        }
    }
}

namespace pg8 {
#define PG8_LAS __attribute__((address_space(3)))
typedef unsigned short bf16_t;
typedef short bf16x8 __attribute__((ext_vector_type(8)));
typedef float f32x4 __attribute__((ext_vector_type(4)));
typedef unsigned u32x4 __attribute__((ext_vector_type(4)));
constexpr int BM = 256, BK = 64, HALF = 128, HTB = HALF * BK * 2  , STAGE_BYTES = 8 * HTB, NXCD = 8, WGM = 8;

__host__ __device__ __forceinline__ int lds_byte(int r, int c) { const int st = (r >> 4) * 2 + (c >> 5), rr = r & 15, cc = c & 31, ob = rr * 64 + cc * 2; return st * 1024 + (ob ^ (((ob >> 9) & 1) << 5)); }
__host__ __device__ __forceinline__ void stage_rc(int b, int& R, int& C) { const int st = b / 1024, sb = b % 1024, swz = sb ^ (((sb >> 9) & 1) << 5); R = (st >> 1) * 16 + swz / 64; C = (st & 1) * 32 + (swz % 64) / 2; }
__host__ __device__ __forceinline__ int perm32(int rho) { const int n = rho >> 4, i = rho & 15; return 8 * (i >> 2) + 4 * n + (i & 3); }

struct Unit { int pm, pn; };
struct Gemm { const bf16_t* A; const bf16_t* Bt; int M, N, K; };

struct StaticOrder {
    int nM, nN, nwg, G, c;
    __host__ __device__ void init(int M, int N, int G_, int c_) { nM = M / BM; nN = N / BM; nwg = nM * nN; G = G_; c = c_; }
    __host__ __device__ bool next(int i, Unit& u) const {
        const long L = (long)i * G + c; if (L >= nwg) return false;
        int wgid = (int)L; { const int q = nwg / NXCD, r = nwg % NXCD, xcd = wgid % NXCD, off = wgid / NXCD; wgid = (xcd < r ? xcd * (q + 1) : r * (q + 1) + (xcd - r) * q) + off; }
        const int nig = WGM * nN, gid = wgid / nig, fm = gid * WGM, gsz = (nM - fm) < WGM ? (nM - fm) : WGM;
        u.pm = fm + ((wgid % nig) % gsz); u.pn = (wgid % nig) / gsz; return true;
    }
    __device__ __forceinline__ void a_ready(const Unit&) const {}
    __device__ __forceinline__ void done(const Unit&) const {}
};
__device__ __forceinline__ unsigned cvt_pk_bf16(float lo, float hi) { typedef float f2_ __attribute__((ext_vector_type(2))); typedef __bf16 b2_ __attribute__((ext_vector_type(2))); return __builtin_bit_cast(unsigned, __builtin_convertvector((f2_){lo, hi}, b2_)); }
typedef float f32x2 __attribute__((ext_vector_type(2)));
template <class Epi, class Sched, bool ALIGN_EPI = false, bool SP2 = false>
__device__ __forceinline__ void gemm_phase(PG8_LAS unsigned char* lds, const Gemm g, const Sched& S, const Epi& E) {
    int tid = threadIdx.x; asm volatile("" : "+v"(tid));
    const int wid = __builtin_amdgcn_readfirstlane(tid >> 6), lane = tid & 63, wr = wid >> 2, wc = wid & 3, fr = lane & 15, fq = lane >> 4;
    const int K = g.K, nt = K / BK;
    unsigned voffA[2], voffB[2];
#pragma unroll
    for (int i = 0; i < 2; ++i) { int R, C; stage_rc(tid * 16 + i * 8192, R, C); const int Rb = Epi::PERM ? ((R & ~31) + perm32(R & 31)) : R;
        voffA[i] = (unsigned)(R * K + C) * 2u; voffB[i] = (unsigned)(Rb * K + C) * 2u; }
    const size_t kstep = (size_t)(BK * 2);
    const size_t hstep = (size_t)HALF * K * 2;
    const size_t tstep = 2 * hstep;
    const unsigned ldsw = (unsigned)wid * 1024u;
    const int aoff = lds_byte(wr * 64 + fr, fq * 8), boff = lds_byte(wc * 32 + fr, fq * 8);
#define PG8_SA(b, h) (((b) * 2 + (h)) * HTB)
#define PG8_SB(b, h) ((4 + (b) * 2 + (h)) * HTB)
#define PG8_STAGE(bufoff, gbase, voff) do { _Pragma("unroll") for (int _i = 0; _i < 2; ++_i) \
        __builtin_amdgcn_global_load_lds((const unsigned*)((const char*)(gbase) + (voff)[_i]), (PG8_LAS unsigned*)(lds + (bufoff) + ldsw + _i * 8192), 16, 0, 0); } while (0)
#define PG8_LDA(dst, b, h) do { _Pragma("unroll") for (int m = 0; m < 4; ++m) _Pragma("unroll") for (int k = 0; k < 2; ++k) dst[m][k] = *(const PG8_LAS bf16x8*)(lds + PG8_SA(b, h) + aoff + m * 2048 + k * 1024); } while (0)
#define PG8_LDB(dst, b, h) do { _Pragma("unroll") for (int n = 0; n < 2; ++n) _Pragma("unroll") for (int k = 0; k < 2; ++k) dst[n][k] = *(const PG8_LAS bf16x8*)(lds + PG8_SB(b, h) + boff + n * 2048 + k * 1024); } while (0)
#define PG8_MMA(ai, bj, At, Bt) do { __builtin_amdgcn_s_setprio(1); _Pragma("unroll") for (int m = 0; m < 4; ++m) _Pragma("unroll") for (int n = 0; n < 2; ++n) _Pragma("unroll") for (int k = 0; k < 2; ++k) \
        acc[ai][bj][m][n] = __builtin_amdgcn_mfma_f32_16x16x32_bf16(Bt[n][k], At[m][k], acc[ai][bj][m][n], 0, 0, 0); __builtin_amdgcn_s_setprio(0); } while (0)
#define PG8_WAIT_V(n) asm volatile("s_waitcnt vmcnt(" #n ")" ::: "memory")
#define PG8_WAIT_L(n) asm volatile("s_waitcnt lgkmcnt(" #n ")" ::: "memory")
#define PG8_BAR __builtin_amdgcn_s_barrier()
#define PG8_SCHED __builtin_amdgcn_sched_barrier(0)
    Unit cur, nxt; int ui = 0;
    if (!S.next(0, cur)) return;
    f32x4 acc[2][2][4][2];
#pragma unroll
    for (int a = 0; a < 2; ++a)
#pragma unroll
        for (int b = 0; b < 2; ++b)
#pragma unroll
            for (int m = 0; m < 4; ++m)
#pragma unroll
                for (int n = 0; n < 2; ++n) acc[a][b][m][n] = (f32x4){0.f, 0.f, 0.f, 0.f};
    bf16x8 At[4][2], B0[2][2], B1[2][2];
    const char* cA = (const char*)g.A + (size_t)cur.pm * tstep; const char* cB = (const char*)g.Bt + (size_t)cur.pn * tstep;
    S.a_ready(cur);
    if constexpr (SP2) {
        PG8_STAGE(PG8_SB(0, 0), cB, voffB); PG8_STAGE(PG8_SB(0, 1), cB + hstep, voffB); PG8_STAGE(PG8_SA(0, 0), cA, voffA); PG8_STAGE(PG8_SA(0, 1), cA + hstep, voffA);
        if (wr == 1) PG8_BAR;
        PG8_WAIT_V(2); PG8_BAR;
        PG8_STAGE(PG8_SB(1, 0), cB + kstep, voffB); PG8_STAGE(PG8_SA(1, 0), cA + kstep, voffA); PG8_STAGE(PG8_SB(1, 1), cB + hstep + kstep, voffB);
        PG8_WAIT_V(6); PG8_BAR;
    } else {
        PG8_STAGE(PG8_SB(0, 0), cB, voffB); PG8_STAGE(PG8_SA(0, 0), cA, voffA); PG8_STAGE(PG8_SB(0, 1), cB + hstep, voffB); PG8_STAGE(PG8_SA(0, 1), cA + hstep, voffA);
        if (wr == 1) PG8_BAR;
        PG8_WAIT_V(4); PG8_BAR;
        PG8_STAGE(PG8_SB(1, 0), cB + kstep, voffB); PG8_STAGE(PG8_SA(1, 0), cA + kstep, voffA); PG8_STAGE(PG8_SB(1, 1), cB + hstep + kstep, voffB);
        PG8_WAIT_V(6); PG8_BAR;
    }
    for (;;) {
        const bool has_next = S.next(ui + 1, nxt);
        const char* nA = has_next ? (const char*)g.A + (size_t)nxt.pm * tstep : cA; const char* nB = has_next ? (const char*)g.Bt + (size_t)nxt.pn * tstep : cB;
        for (int t = 0; t < nt; t += 2) {
            const bool last = (t == nt - 2);
            const char* a1 = cA + (size_t)(t + 1) * kstep;
            const char* a2 = last ? nA : cA + (size_t)(t + 2) * kstep; const char* b2 = last ? nB : cB + (size_t)(t + 2) * kstep;
            const char* a3 = a2 + kstep; const char* b3 = b2 + kstep;
            if (last && has_next) S.a_ready(nxt);
            if constexpr (SP2) {
            PG8_LDB(B0, 0, 0); PG8_LDB(B1, 0, 1); PG8_SCHED; PG8_LDA(At, 0, 0); PG8_STAGE(PG8_SA(1, 1), a1 + hstep, voffA);
            PG8_WAIT_V(8); PG8_WAIT_L(0); PG8_BAR; PG8_MMA(0, 0, At, B0); PG8_MMA(0, 1, At, B1); PG8_BAR; PG8_SCHED;
            PG8_LDA(At, 0, 1); PG8_STAGE(PG8_SB(0, 0), b2, voffB); PG8_STAGE(PG8_SB(0, 1), b2 + hstep, voffB); PG8_STAGE(PG8_SA(0, 0), a2, voffA);
            PG8_WAIT_V(8); PG8_WAIT_L(0); PG8_BAR; PG8_MMA(1, 0, At, B0); PG8_MMA(1, 1, At, B1); PG8_BAR; PG8_SCHED;
            PG8_LDB(B0, 1, 0); PG8_LDB(B1, 1, 1); PG8_SCHED; PG8_LDA(At, 1, 0); PG8_STAGE(PG8_SA(0, 1), a2 + hstep, voffA);
            PG8_WAIT_V(8); PG8_WAIT_L(0); PG8_BAR; PG8_MMA(0, 0, At, B0); PG8_MMA(0, 1, At, B1); PG8_BAR; PG8_SCHED;
            PG8_LDA(At, 1, 1); PG8_STAGE(PG8_SB(1, 0), b3, voffB); PG8_STAGE(PG8_SB(1, 1), b3 + hstep, voffB); PG8_STAGE(PG8_SA(1, 0), a3, voffA);
            PG8_WAIT_V(8); PG8_WAIT_L(0); PG8_BAR; PG8_MMA(1, 0, At, B0); PG8_MMA(1, 1, At, B1); PG8_BAR; PG8_SCHED;
            } else {
            PG8_LDB(B0, 0, 0); PG8_SCHED; PG8_LDA(At, 0, 0); PG8_STAGE(PG8_SA(1, 1), a1 + hstep, voffA);
            PG8_WAIT_L(8); PG8_BAR; PG8_WAIT_L(0); PG8_MMA(0, 0, At, B0); PG8_BAR; PG8_SCHED;
            PG8_LDB(B1, 0, 1); PG8_STAGE(PG8_SB(0, 0), b2, voffB);
            PG8_BAR; PG8_WAIT_L(0); PG8_MMA(0, 1, At, B1); PG8_BAR;
            PG8_LDA(At, 0, 1); PG8_STAGE(PG8_SA(0, 0), a2, voffA);
            PG8_BAR; PG8_WAIT_L(0); PG8_MMA(1, 0, At, B0); PG8_BAR; PG8_SCHED;
            PG8_STAGE(PG8_SB(0, 1), b2 + hstep, voffB);
            PG8_WAIT_V(6); PG8_BAR; PG8_MMA(1, 1, At, B1); PG8_BAR;
            PG8_LDB(B0, 1, 0); PG8_SCHED; PG8_LDA(At, 1, 0); PG8_STAGE(PG8_SA(0, 1), a2 + hstep, voffA);
            PG8_WAIT_L(8); PG8_BAR; PG8_WAIT_L(0); PG8_MMA(0, 0, At, B0); PG8_BAR; PG8_SCHED;
            PG8_LDB(B1, 1, 1); PG8_STAGE(PG8_SB(1, 0), b3, voffB);
            PG8_BAR; PG8_WAIT_L(0); PG8_MMA(0, 1, At, B1); PG8_BAR;
            PG8_LDA(At, 1, 1); PG8_STAGE(PG8_SA(1, 0), a3, voffA);
            PG8_BAR; PG8_WAIT_L(0); PG8_MMA(1, 0, At, B0); PG8_BAR; PG8_SCHED;
            PG8_STAGE(PG8_SB(1, 1), b3 + hstep, voffB);
            PG8_WAIT_V(6); PG8_BAR; PG8_MMA(1, 1, At, B1); PG8_BAR;
            }
        }
        if constexpr (ALIGN_EPI) { if (wr == 0) PG8_BAR; }
        if constexpr (!Epi::AFTER_DRAIN) { E(acc, cur, wr, wc, fr, fq); S.done(cur); }
        if (!has_next) break;
        if constexpr (!Epi::CHAIN) {
#pragma unroll
        for (int a = 0; a < 2; ++a)
#pragma unroll
            for (int b = 0; b < 2; ++b)
#pragma unroll
                for (int m = 0; m < 4; ++m)
#pragma unroll
                    for (int n = 0; n < 2; ++n) acc[a][b][m][n] = (f32x4){0.f, 0.f, 0.f, 0.f};
        }
        cur = nxt; cA = nA; cB = nB; ++ui;
        if constexpr (ALIGN_EPI) { if (wr == 1) PG8_BAR; }
    }
    PG8_WAIT_V(0);
    if constexpr (!ALIGN_EPI) { if (wr == 0) PG8_BAR; }
    PG8_BAR;
    if constexpr (Epi::AFTER_DRAIN) { E.fused(acc, cur, wr, wc, fr, fq, lds, wid, lane); S.done(cur); }
#undef PG8_SA
#undef PG8_SB
#undef PG8_STAGE
#undef PG8_LDA
#undef PG8_LDB
#undef PG8_MMA
#undef PG8_WAIT_V
#undef PG8_WAIT_L
#undef PG8_BAR
#undef PG8_SCHED
}
}

namespace pg8 {
__device__ __forceinline__ void store16_wt(void* ptr, u32x4 v) { asm volatile("global_store_dwordx4 %0, %1, off sc1\n\ts_nop 1" :: "v"(ptr), "v"(v) : "memory"); }
template <int ACT> struct EpiStore {
    static constexpr bool PERM = true, AFTER_DRAIN = false, CHAIN = false;
    bf16_t* O; int ldc;
    __device__ __forceinline__ void operator()(const f32x4 (&acc)[2][2][4][2], const Unit& u, int wr, int wc, int fr, int fq) const {
        const int row0 = u.pm * BM + wr * 64 + fr, col0 = u.pn * BM + wc * 32 + 8 * fq;
#pragma unroll
        for (int ai = 0; ai < 2; ++ai)
#pragma unroll
            for (int m = 0; m < 4; ++m) { bf16_t* rowp = O + (size_t)(row0 + ai * HALF + m * 16) * ldc + col0;
#pragma unroll
                for (int bj = 0; bj < 2; ++bj) { f32x4 v0 = acc[ai][bj][m][0], v1 = acc[ai][bj][m][1];
                    if (ACT == 1) {
#pragma unroll
                        for (int e = 0; e < 4; ++e) { v0[e] = __builtin_amdgcn_rcpf(1.f + __expf(-v0[e])); v1[e] = __builtin_amdgcn_rcpf(1.f + __expf(-v1[e])); } }
                    u32x4 w; w.x = cvt_pk_bf16(v0[0], v0[1]); w.y = cvt_pk_bf16(v0[2], v0[3]); w.z = cvt_pk_bf16(v1[0], v1[1]); w.w = cvt_pk_bf16(v1[2], v1[3]);
                    store16_wt(rowp + bj * HALF, w); } }
    }
};
template <bool ACCUM> struct EpiProj {
    static constexpr bool PERM = true, AFTER_DRAIN = false, CHAIN = false;
    bf16_t* MG; const bf16_t* SG; int gcol0;
    __device__ __forceinline__ void operator()(const f32x4 (&acc)[2][2][4][2], const Unit& u, int wr, int wc, int fr, int fq) const {
        const int row0 = u.pm * BM + wr * 64 + fr, col0 = u.pn * BM + wc * 32 + 8 * fq;
#pragma unroll
        for (int ai = 0; ai < 2; ++ai)
#pragma unroll
            for (int m = 0; m < 4; ++m) { const size_t row = (size_t)(row0 + ai * HALF + m * 16);
#pragma unroll
                for (int bj = 0; bj < 2; ++bj) {
                    const int col = col0 + bj * HALF;
                    const u32x4 gw = *(const u32x4*)(SG + row * 3072 + gcol0 + col);
                    u32x4 ow = (u32x4){0u, 0u, 0u, 0u};
                    if (ACCUM) ow = *(const u32x4*)(MG + row * 1024 + col);
                    float r[8];
#pragma unroll
                    for (int e = 0; e < 4; ++e) {
                        const float g0 = __uint_as_float(gw[e] << 16), g1 = __uint_as_float(gw[e] & 0xffff0000u);
                        const float a0 = e < 2 ? acc[ai][bj][m][0][2 * e] : acc[ai][bj][m][1][2 * e - 4], a1 = e < 2 ? acc[ai][bj][m][0][2 * e + 1] : acc[ai][bj][m][1][2 * e - 3];
                        r[2 * e] = g0 * a0; r[2 * e + 1] = g1 * a1;
                        if (ACCUM) { r[2 * e] += __uint_as_float(ow[e] << 16); r[2 * e + 1] += __uint_as_float(ow[e] & 0xffff0000u); }
                    }
                    u32x4 w; w.x = cvt_pk_bf16(r[0], r[1]); w.y = cvt_pk_bf16(r[2], r[3]); w.z = cvt_pk_bf16(r[4], r[5]); w.w = cvt_pk_bf16(r[6], r[7]);
                    *(u32x4*)(MG + row * 1024 + col) = w; } }
    }
};
struct ProjOrder {
    int pm, pn, valid;
    __host__ __device__ bool next(int i, Unit& u) const { if (!valid || i >= 3) return false; u.pm = i * 64 + pm; u.pn = i * 4 + pn; return true; }
    __device__ __forceinline__ void a_ready(const Unit&) const {}
    __device__ __forceinline__ void done(const Unit&) const {}
};
struct EpiProj3 {
    static constexpr bool PERM = true, AFTER_DRAIN = false, CHAIN = false;
    bf16_t* MG; const bf16_t* SG;
    __device__ __forceinline__ void operator()(const f32x4 (&acc)[2][2][4][2], const Unit& u, int wr, int wc, int fr, int fq) const {
        const int br = u.pm >> 6, pm = u.pm & 63, pn = u.pn & 3, gcol0 = br * 1024;
        const int row0 = pm * BM + wr * 64 + fr, col0 = pn * BM + wc * 32 + 8 * fq;
#pragma unroll
        for (int ai = 0; ai < 2; ++ai)
#pragma unroll
            for (int m = 0; m < 4; ++m) { const size_t row = (size_t)(row0 + ai * HALF + m * 16);
#pragma unroll
                for (int bj = 0; bj < 2; ++bj) {
                    const int col = col0 + bj * HALF;
                    const u32x4 gw = *(const u32x4*)(SG + row * 3072 + gcol0 + col);
                    u32x4 ow = (u32x4){0u, 0u, 0u, 0u};
                    if (br > 0) ow = *(const u32x4*)(MG + row * 1024 + col);
                    float r[8];
#pragma unroll
                    for (int e = 0; e < 4; ++e) {
                        const float g0 = __uint_as_float(gw[e] << 16), g1 = __uint_as_float(gw[e] & 0xffff0000u);
                        const float a0 = e < 2 ? acc[ai][bj][m][0][2 * e] : acc[ai][bj][m][1][2 * e - 4], a1 = e < 2 ? acc[ai][bj][m][0][2 * e + 1] : acc[ai][bj][m][1][2 * e - 3];
                        r[2 * e] = g0 * a0 + __uint_as_float(ow[e] << 16); r[2 * e + 1] = g1 * a1 + __uint_as_float(ow[e] & 0xffff0000u);
                    }
                    u32x4 w; w.x = cvt_pk_bf16(r[0], r[1]); w.y = cvt_pk_bf16(r[2], r[3]); w.z = cvt_pk_bf16(r[4], r[5]); w.w = cvt_pk_bf16(r[6], r[7]);
                    *(u32x4*)(MG + row * 1024 + col) = w; } }
    }
};
struct GateOrder {
    int pm, pn, valid;
    __host__ __device__ bool next(int i, Unit& u) const { if (!valid || i >= 3) return false; u.pm = pm; u.pn = (2 - i) * 4 + pn; return true; }
    __device__ __forceinline__ void a_ready(const Unit&) const {}
    __device__ __forceinline__ void done(const Unit&) const {}
};
struct EpiGateR {
    static constexpr bool PERM = true, AFTER_DRAIN = false, CHAIN = false;
    bf16_t* SG;
    __device__ __forceinline__ void operator()(const f32x4 (&acc)[2][2][4][2], const Unit& u, int wr, int wc, int fr, int fq) const {
        const int br = u.pn >> 2, pn = u.pn & 3;
        const int row0 = u.pm * BM + wr * 64 + fr, col0 = pn * BM + wc * 32 + 8 * fq;
#pragma unroll
        for (int ai = 0; ai < 2; ++ai)
#pragma unroll
            for (int m = 0; m < 4; ++m) { bf16_t* rowp = SG + (size_t)(row0 + ai * HALF + m * 16) * 3072 + col0;
#pragma unroll
                for (int bj = 0; bj < 2; ++bj) {
                    float s[8];
#pragma unroll
                    for (int e = 0; e < 4; ++e) { s[e] = __builtin_amdgcn_rcpf(1.f + __expf(-acc[ai][bj][m][0][e])); s[4 + e] = __builtin_amdgcn_rcpf(1.f + __expf(-acc[ai][bj][m][1][e])); }
                    if (br < 2) {
                        u32x4 d = *(const u32x4*)(rowp + 2048 + bj * HALF);
                        float den[8];
#pragma unroll
                        for (int e = 0; e < 4; ++e) { den[2 * e] = __uint_as_float(d[e] << 16); den[2 * e + 1] = __uint_as_float(d[e] & 0xffff0000u); }
                        if (br == 0) { const u32x4 d1 = *(const u32x4*)(rowp + 1024 + bj * HALF);
#pragma unroll
                            for (int e = 0; e < 4; ++e) { den[2 * e] *= __uint_as_float(d1[e] << 16); den[2 * e + 1] *= __uint_as_float(d1[e] & 0xffff0000u); } }
#pragma unroll
                        for (int e = 0; e < 8; ++e) s[e] *= __builtin_amdgcn_rcpf(den[e]);
                    }
                    u32x4 w; w.x = cvt_pk_bf16(s[0], s[1]); w.y = cvt_pk_bf16(s[2], s[3]); w.z = cvt_pk_bf16(s[4], s[5]); w.w = cvt_pk_bf16(s[6], s[7]);
                    *(u32x4*)(rowp + br * 1024 + bj * HALF) = w; } }
    }
};
struct EpiProjChain {
    static constexpr bool PERM = true, AFTER_DRAIN = false, CHAIN = true;
    bf16_t* MG; const bf16_t* SG;
    __device__ __forceinline__ void operator()(f32x4 (&acc)[2][2][4][2], const Unit& u, int wr, int wc, int fr, int fq) const {
        const int br = u.pm >> 6, pm = u.pm & 63, pn = u.pn & 3;
        const int row0 = pm * BM + wr * 64 + fr, col0 = pn * BM + wc * 32 + 8 * fq;
#pragma unroll
        for (int ai = 0; ai < 2; ++ai)
#pragma unroll
            for (int m = 0; m < 4; ++m) { const size_t row = (size_t)(row0 + ai * HALF + m * 16);
#pragma unroll
                for (int bj = 0; bj < 2; ++bj) {
                    const int col = col0 + bj * HALF;
                    const u32x4 gw = *(const u32x4*)(SG + row * 3072 + br * 1024 + col);
#pragma unroll
                    for (int e = 0; e < 4; ++e) {
                        const float g0 = __uint_as_float(gw[e] << 16), g1 = __uint_as_float(gw[e] & 0xffff0000u);
                        if (e < 2) { acc[ai][bj][m][0][2 * e] *= g0; acc[ai][bj][m][0][2 * e + 1] *= g1; } else { acc[ai][bj][m][1][2 * e - 4] *= g0; acc[ai][bj][m][1][2 * e - 3] *= g1; }
                    }
                    if (br == 2) {
                        u32x4 w; w.x = cvt_pk_bf16(acc[ai][bj][m][0][0], acc[ai][bj][m][0][1]); w.y = cvt_pk_bf16(acc[ai][bj][m][0][2], acc[ai][bj][m][0][3]);
                        w.z = cvt_pk_bf16(acc[ai][bj][m][1][0], acc[ai][bj][m][1][1]); w.w = cvt_pk_bf16(acc[ai][bj][m][1][2], acc[ai][bj][m][1][3]);
                        *(u32x4*)(MG + row * 1024 + col) = w; } } }
    }
};
struct EpiOut {
    static constexpr bool PERM = false, AFTER_DRAIN = false, CHAIN = false;
    const float* X; float* O;
    __device__ __forceinline__ void operator()(const f32x4 (&acc)[2][2][4][2], const Unit& u, int wr, int wc, int fr, int fq) const {
        const int row0 = u.pm * BM + wr * 64 + fr, col0 = u.pn * BM + wc * 32 + 4 * fq;
#pragma unroll
        for (int ai = 0; ai < 2; ++ai)
#pragma unroll
            for (int m = 0; m < 4; ++m) { const size_t off = (size_t)(row0 + ai * HALF + m * 16) * 1024 + col0;
#pragma unroll
                for (int bj = 0; bj < 2; ++bj)
#pragma unroll
                    for (int n = 0; n < 2; ++n) { const f32x4 xv = *(const f32x4*)(X + off + bj * HALF + n * 16); *(f32x4*)(O + off + bj * HALF + n * 16) = xv + acc[ai][bj][m][n]; } }
    }
};
}

DI void phase_gemm_gate(const Params& p, unsigned char* lds, const int bid, const int nb) {
    unsigned char* ws = p.ws;
    const bf16_t* H = (const bf16_t*)(ws + OFF_H); const bf16_t* Wt = (const bf16_t*)(ws + OFF_WIN) + (size_t)C_G * 1024;
    bf16_t* SG = (bf16_t*)(ws + OFF_SG);
    const int tn = 3072 / 128, nt = (M / 128) * tn;
    for (int it = bid; it < nt; it += nb) {
        GemmTile g; gemm_zero(g);
        const int m0 = (it / tn) * 128, n0 = (it % tn) * 128;
        gemm_tile_k(g, H, 1024, Wt, 1024, m0, n0, 1024, lds);
        GEMM_FOREACH(SG[(size_t)row * 3072 + col] = f2bf(sigmoidf_(g.acc[mi][ni][r])););
    }
}
DI void phase_gemm_proj(const Params& p, unsigned char* lds, const int bid, const int nb) {
    unsigned char* ws = p.ws;
    const bf16_t* SG = (const bf16_t*)(ws + OFF_SG); bf16_t* MG = (bf16_t*)(ws + OFF_MG);
    const int tn = 1024 / 128, nt = (M / 128) * tn;
    for (int it = bid; it < nt; it += nb) {
        const int m0 = (it / tn) * 128, n0 = (it % tn) * 128;
        GemmTile mg; gemm_zero(mg);
#pragma unroll 1
        for (int br = 0; br < 3; ++br) {
            GemmTile g; gemm_zero(g);
            const bf16_t* Y = (const bf16_t*)(ws + (br == 0 ? OFF_YA : br == 1 ? OFF_YB : OFF_YC));
            const bf16_t* W = (const bf16_t*)(ws + (br == 0 ? OFF_WPA : br == 1 ? OFF_WPB : OFF_WPC));
            gemm_tile_k(g, Y, 512, W, 512, m0, n0, 512, lds);
            GEMM_FOREACH(mg.acc[mi][ni][r] += bf2f(SG[(size_t)row * 3072 + br * 1024 + col]) * g.acc[mi][ni][r];);
        }
        GEMM_FOREACH(MG[(size_t)row * 1024 + col] = f2bf(mg.acc[mi][ni][r]););
    }
}
DI void phase_gemm_out(const Params& p, unsigned char* lds, const int bid, const int nb) {
    unsigned char* ws = p.ws;
    const bf16_t* MG = (const bf16_t*)(ws + OFF_MG); const bf16_t* W = (const bf16_t*)(ws + OFF_WO);
    const int tn = 1024 / 128, nt = (M / 128) * tn;
    for (int it = bid; it < nt; it += nb) {
        GemmTile g; gemm_zero(g);
        const int m0 = (it / tn) * 128, n0 = (it % tn) * 128;
        gemm_tile_k(g, MG, 1024, W, 1024, m0, n0, 1024, lds);
        GEMM_FOREACH(p.out[(size_t)row * 1024 + col] = p.x[(size_t)row * 1024 + col] + g.acc[mi][ni][r];);
    }
}

DI void phase_gemm_in_fast(const Params& p, unsigned char* lds, const int bid, const int nb) {
    unsigned char* ws = p.ws;
    {
        pg8::Gemm g{(const bf16_t*)(ws + OFF_H), (const bf16_t*)(ws + OFF_WIN), M, NP, 1024}; pg8::StaticOrder S; S.init(M, NP, nb, bid);
        pg8::EpiStore<0> E{(bf16_t*)(ws + OFF_P), NP};
        pg8::gemm_phase<pg8::EpiStore<0>, pg8::StaticOrder, true, true>(LASP(lds), g, S, E);
    }
    __syncthreads();
    const int tn2 = 1024 / 128, nt2 = (MM / 128) * tn2;
    for (int it = bid - nb / 2; it >= 0 && it < nt2; it += nb) {
        GemmTile g; gemm_zero(g);
        const int m0 = (it / tn2) * 128, n0 = (it % tn2) * 128;
        gemm_tile_k(g, (const bf16_t*)(ws + OFF_HM), 1024, (const bf16_t*)(ws + OFF_WKV), 1024, m0, n0, 1024, lds);
        bf16_t* KVM = (bf16_t*)(ws + OFF_KVM);
        GEMM_FOREACH(KVM[(size_t)row * 1024 + col] = f2bf(g.acc[mi][ni][r]););
    }
}
DI void phase_gemm_gate_fast(const Params& p, unsigned char* lds, const int bid, const int nb) {
    unsigned char* ws = p.ws;
    pg8::Gemm g{(const bf16_t*)(ws + OFF_H), (const bf16_t*)(ws + OFF_WIN) + (size_t)C_G * 1024, M, 3072, 1024};
    pg8::StaticOrder S; S.init(M, 1024, nb, bid);
    pg8::Unit own; const bool has = S.next(0, own);
    pg8::GateOrder O{own.pm, own.pn, has ? 1 : 0};
    pg8::EpiGateR E{(bf16_t*)(ws + OFF_SG)};
    pg8::gemm_phase<pg8::EpiGateR, pg8::GateOrder, true, true>(LASP(lds), g, O, E);
}
DI void phase_gemm_proj_fast(const Params& p, unsigned char* lds, const int bid, const int nb) {
    unsigned char* ws = p.ws;
    bf16_t* MG = (bf16_t*)(ws + OFF_MG); const bf16_t* SG = (const bf16_t*)(ws + OFF_SG);
    pg8::StaticOrder S; S.init(M, 1024, nb, bid);
    { pg8::Gemm g{(const bf16_t*)(ws + OFF_YA), (const bf16_t*)(ws + OFF_WPA), M, 1024, 512}; pg8::EpiProj<false> E{MG, SG, 0};
      pg8::gemm_phase<pg8::EpiProj<false>, pg8::StaticOrder, true, true>(LASP(lds), g, S, E); }
    { pg8::Gemm g{(const bf16_t*)(ws + OFF_YB), (const bf16_t*)(ws + OFF_WPB), M, 1024, 512}; pg8::EpiProj<true> E{MG, SG, 1024};
      pg8::gemm_phase<pg8::EpiProj<true>, pg8::StaticOrder, true, true>(LASP(lds), g, S, E); }
    { pg8::Gemm g{(const bf16_t*)(ws + OFF_YC), (const bf16_t*)(ws + OFF_WPC), M, 1024, 512}; pg8::EpiProj<true> E{MG, SG, 2048};
      pg8::gemm_phase<pg8::EpiProj<true>, pg8::StaticOrder, true, true>(LASP(lds), g, S, E); }
}
DI void phase_gemm_proj3(const Params& p, unsigned char* lds, const int bid, const int nb) {
    unsigned char* ws = p.ws;
    static_assert(OFF_YB == OFF_YA + (size_t)M * 512 * 2 && OFF_YC == OFF_YB + (size_t)M * 512 * 2 && OFF_WPB == OFF_WPA + (size_t)1024 * 512 * 2 && OFF_WPC == OFF_WPB + (size_t)1024 * 512 * 2, "contiguous branches");
    pg8::StaticOrder S; S.init(M, 1024, nb, bid);
    pg8::Unit own; const bool has = S.next(0, own);
    pg8::ProjOrder O{own.pm, own.pn, has ? 1 : 0};
    pg8::Gemm g{(const bf16_t*)(ws + OFF_YA), (const bf16_t*)(ws + OFF_WPA), 3 * M, 3072, 512};
    pg8::EpiProjChain E{(bf16_t*)(ws + OFF_MG), (const bf16_t*)(ws + OFF_SG)};
    pg8::gemm_phase<pg8::EpiProjChain, pg8::ProjOrder, true, true>(LASP(lds), g, O, E);
}
DI void phase_gemm_out_fast(const Params& p, unsigned char* lds, const int bid, const int nb) {
    unsigned char* ws = p.ws;
    pg8::Gemm g{(const bf16_t*)(ws + OFF_MG), (const bf16_t*)(ws + OFF_WO), M, 1024, 1024}; pg8::StaticOrder S; S.init(M, 1024, nb, bid);
    pg8::EpiOut E{p.x, p.out};
    pg8::gemm_phase<pg8::EpiOut, pg8::StaticOrder, true, true>(LASP(lds), g, S, E);
}

#define XB_TMO      128
#define XB_XCNT(j)  (256  + 64 * (j))
#define XB_XSUB(j)  (1280 + 64 * (j))
#define XB_XGEN(j)  (2304 + 64 * (j))
#define XB_TOP      3328
#define XB_TOPGEN   3392
#define XCD_BAR_WORDS 3456
#define XB_SPIN_CAP (1u << 22)
DI unsigned xb_ld(unsigned* p)              { return __hip_atomic_load(p, __ATOMIC_RELAXED, __HIP_MEMORY_SCOPE_AGENT); }
DI unsigned xb_add(unsigned* p, unsigned v) { return __hip_atomic_fetch_add(p, v, __ATOMIC_RELAXED, __HIP_MEMORY_SCOPE_AGENT); }
DI unsigned xb_xcc_id() { return (unsigned)__builtin_amdgcn_s_getreg((3 << 11) | 20) & 0xFu; }
#define XB_SPIN(cond, bar) do { unsigned _sp = 0; while (cond) { __builtin_amdgcn_s_sleep(1); \
    if ((++_sp & 255u) == 0u) { if (xb_ld(&(bar)[XB_TMO])) break; if (_sp > XB_SPIN_CAP) { atomicAdd(&(bar)[XB_TMO], 1u); break; } } } } while (0)
struct XcdBarrier { unsigned* bar; unsigned x; volatile LAS unsigned* st; };
DI XcdBarrier xcd_barrier_post(unsigned* bar, volatile LAS unsigned* st) {
    XcdBarrier b; b.bar = bar; b.x = xb_xcc_id(); b.st = st;
    if (threadIdx.x == 0) (void)xb_add(&bar[XB_XCNT(b.x)], 1u);
    return b;
}
DI void xcd_barrier_complete(unsigned* bar, unsigned x, unsigned& nloc, unsigned& nx) {
    const unsigned G = gridDim.x * gridDim.y * gridDim.z;
    unsigned sum, cnt, mine, sp = 0u;
    for (;;) {
        sum = 0u; cnt = 0u; mine = 0u;
#pragma unroll
        for (unsigned j = 0; j < 16; ++j) { const unsigned c = xb_ld(&bar[XB_XCNT(j)]); sum += c; cnt += (c > 0u) ? 1u : 0u; mine = (j == x) ? c : mine; }
        if (sum == G) break;
        __builtin_amdgcn_s_sleep(1);
        if ((++sp & 255u) == 0u) { if (xb_ld(&bar[XB_TMO])) break; if (sp > XB_SPIN_CAP) { atomicAdd(&bar[XB_TMO], 1u); break; } }
    }
    nloc = mine > 0u ? mine : 1u; nx = cnt > 0u ? cnt : 1u;
}
DI void xcd_barrier(const XcdBarrier& b) {
    asm volatile("s_waitcnt vmcnt(0)" ::: "memory");
    __syncthreads();
    if (threadIdx.x == 0) {
        unsigned* bar = b.bar;
        __builtin_amdgcn_s_waitcnt(0);
        unsigned nloc = b.st[0], nx = b.st[1];
        if (nloc == 0u) { xcd_barrier_complete(bar, b.x, nloc, nx); b.st[0] = nloc; b.st[1] = nx; }
        const unsigned old = xb_add(&bar[XB_XSUB(b.x)], 1u);
        const unsigned gen = old / nloc;
        if (old + 1u == (gen + 1u) * nloc) {
            __builtin_amdgcn_fence(__ATOMIC_RELEASE, "agent");
            asm volatile("s_waitcnt vmcnt(0)" ::: "memory");
            const unsigned og = xb_add(&bar[XB_TOP], 1u);
            const unsigned tg = og / nx;
            if (og + 1u == (tg + 1u) * nx) xb_add(&bar[XB_TOPGEN], 1u);
            else XB_SPIN(xb_ld(&bar[XB_TOPGEN]) == tg, bar);
            __builtin_amdgcn_fence(__ATOMIC_ACQUIRE, "agent");
            xb_add(&bar[XB_XGEN(b.x)], 1u);
            asm volatile("s_waitcnt vmcnt(0)" ::: "memory");
        } else {
            XB_SPIN(xb_ld(&bar[XB_XGEN(b.x)]) == gen, bar);
            __builtin_amdgcn_fence(__ATOMIC_ACQUIRE, "agent");
            asm volatile("s_waitcnt vmcnt(0)" ::: "memory");
        }
    }
    __syncthreads();
}

__global__ void __launch_bounds__(NTHREADS, 2) k_mega(Params p) {
    extern __shared__ __attribute__((aligned(16))) unsigned char lds[];
    volatile LAS unsigned* st = (volatile LAS unsigned*)(lds + LDS_CTL_OFF);
    if (threadIdx.x == 0) { st[0] = 0u; st[1] = 0u; st[2] = 0u; st[3] = 0u; }
    __syncthreads();
    (void)xcd_barrier_post((unsigned*)(p.ws + OFF_CTL), st);
#define GRID_BAR() do { XcdBarrier b_; b_.bar = (unsigned*)(p.ws + OFF_CTL); b_.x = xb_xcc_id(); b_.st = (volatile LAS unsigned*)(lds + LDS_CTL_OFF); xcd_barrier(b_); } while (0)
    const int bid = blockIdx.x, nb = gridDim.x;
#ifndef REPMASK
#define REPMASK 0
#endif
#ifndef REPCNT
#define REPCNT 1
#endif
#ifndef STAMP_PH
#define STAMP_PH -1
#endif
    volatile LAS unsigned* stp = (volatile LAS unsigned*)(lds + LDS_CTL_OFF + 64);
    int nst = 0;
#define STAMP() do { if (STAMP_PH >= 0 && blockIdx.x == 0 && threadIdx.x == 0) stp[nst] = (unsigned)__builtin_amdgcn_s_memrealtime(); ++nst; } while (0)
    STAMP();
#define REP(bit_, call_) do { call_; if (REPMASK & (bit_)) { for (int rep_ = 0; rep_ < REPCNT; ++rep_) { __syncthreads(); call_; } } } while (0)
    REP(1, phase_prologue(p, lds, bid, nb));
    GRID_BAR(); STAMP();
    REP(2, phase_gemm_in_fast(p, lds, bid, nb));
    GRID_BAR(); STAMP();
    REP(8, phase_rwkv_prep(p, lds, bid, nb));
    GRID_BAR(); STAMP();
    if (bid < 16) phase_rwkv_scan(p, lds, bid);
    phase_attn_queue(p, lds);
    GRID_BAR(); STAMP();
    REP(64, phase_gemm_gate_fast(p, lds, bid, nb));
    __syncthreads(); STAMP();
    phase_gemm_proj3(p, lds, bid, nb);
    GRID_BAR(); STAMP();
    REP(256, phase_gemm_out_fast(p, lds, bid, nb));
    if (STAMP_PH >= 0) { GRID_BAR(); STAMP();
        if (blockIdx.x == 0) {
            float* sm = (float*)lds; float best = 1e30f; int bi = 0;
            for (int i = threadIdx.x; i < 65536; i += NTHREADS) { const float a = fabsf(p.out[i]); if (a < best) { best = a; bi = i; } }
            sm[threadIdx.x] = best; ((int*)sm)[512 + threadIdx.x] = bi;
            __syncthreads();
            if (threadIdx.x == 0) {
                for (int i = 1; i < NTHREADS; ++i) if (sm[i] < best) { best = sm[i]; bi = ((int*)sm)[512 + i]; }
                const float tot = (float)(stp[nst - 1] - stp[0]); const float ph = STAMP_PH < 20 ? (float)(stp[STAMP_PH + 1] - stp[STAMP_PH]) : tot * 0.5f;
                const float v = STAMP_PH == 99 ? 0.04f + tot * 1e-6f : 0.05f + 0.1f * ph / tot; p.out[bi] += v; }
        } }
}

extern "C" void kernel_launch(void* const* d_in, const int* in_sizes, int n_in, void* d_out, int out_size, void* d_ws, size_t ws_size, hipStream_t stream) {
    static int grid = 0;
    if (grid == 0) {
        if (n_in != 27 || ws_size < WS_END) { fprintf(stderr, "kernel_launch: unexpected inputs (n_in %d, ws %zu)\n", n_in, ws_size); grid = -1; return; }
        int dev = 0, cus = 0, per_cu = 0;
        if (hipGetDevice(&dev) != hipSuccess || hipDeviceGetAttribute(&cus, hipDeviceAttributeMultiprocessorCount, dev) != hipSuccess) { grid = -1; return; }
        if (hipFuncSetAttribute((const void*)k_mega, hipFuncAttributeMaxDynamicSharedMemorySize, LDS_BYTES) != hipSuccess) { fprintf(stderr, "kernel_launch: hipFuncSetAttribute failed\n"); grid = -1; return; }
        if (hipOccupancyMaxActiveBlocksPerMultiprocessor(&per_cu, (const void*)k_mega, NTHREADS, LDS_BYTES) != hipSuccess || per_cu < 1)
            fprintf(stderr, "kernel_launch: occupancy query reports %d workgroups per CU\n", per_cu);
        (void)hipGetLastError();
        grid = cus;
        if (grid < 32) { fprintf(stderr, "kernel_launch: too few CUs (%d)\n", grid); grid = -1; return; }
    }
    if (grid < 0) return;
    if (hipMemsetAsync((char*)d_ws + OFF_CTL, 0, 65536, stream) != hipSuccess) { fprintf(stderr, "kernel_launch: memset failed\n"); return; }
    Params p{};
    p.x = (const float*)d_in[0]; p.mem = (const float*)d_in[1]; p.pos = (const int*)d_in[2]; p.norm_g = (const float*)d_in[3]; p.mem_norm_g = (const float*)d_in[4];
    p.w_in = (const float*)d_in[5]; p.mu_rkv = (const float*)d_in[6]; p.mu_wa = (const float*)d_in[7]; p.w0 = (const float*)d_in[8]; p.w2 = (const float*)d_in[9];
    p.a0 = (const float*)d_in[10]; p.a2 = (const float*)d_in[11]; p.k_k = (const float*)d_in[12]; p.k_a = (const float*)d_in[13]; p.r_k = (const float*)d_in[14];
    p.lnx_g = (const float*)d_in[15]; p.lnx_b = (const float*)d_in[16]; p.q_norm_g = (const float*)d_in[17]; p.k_norm_g = (const float*)d_in[18]; p.sinks = (const float*)d_in[19];
    p.xq_norm_g = (const float*)d_in[20]; p.xk_norm_g = (const float*)d_in[21]; p.w_mem_kv = (const float*)d_in[22]; p.w_proj_a = (const float*)d_in[23];
    p.w_proj_b = (const float*)d_in[24]; p.w_proj_c = (const float*)d_in[25]; p.w_out = (const float*)d_in[26];
    p.out = (float*)d_out; p.ws = (unsigned char*)d_ws;
    hipLaunchKernelGGL(k_mega, dim3(grid), dim3(NTHREADS), LDS_BYTES, stream, p);
}
```

```cpp
#include <hip/hip_runtime.h>
#include <stdint.h>
#include <stdio.h>

#define DI __device__ __forceinline__
#define LASP(p_) ((__attribute__((address_space(3))) unsigned char*)(p_))
typedef unsigned short bf16_t;
typedef short bf16x8 __attribute__((ext_vector_type(8)));
typedef float f32x4 __attribute__((ext_vector_type(4)));

constexpr int BATCH = 2, T = 8192, M = BATCH * T, D = 1024, NIN = 7552, NP = 4608  ;
constexpr int MEMLEN = 256, MM = BATCH * MEMLEN;
constexpr int C_R = 0, C_K = 512, C_V = 1024, C_W = 1536, C_A = 1600, C_ZA = 1664, C_Q = 2176, C_SK = 2688, C_SV = 2816, C_ZB = 2944, C_XQ = 3456, C_ZC = 3968, C_G = 4480;
constexpr int NTHREADS = 512, NWAVES = 8;
constexpr int LDS_BYTES = 147456;
constexpr int LDS_CTL_OFF = LDS_BYTES - 256;
#define LAS __attribute__((address_space(3)))

constexpr size_t OFF_CTL = 0;
constexpr size_t OFF_WIN = 65536;
constexpr size_t OFF_WKV = OFF_WIN + (size_t)7680 * 1024 * 2;
constexpr size_t OFF_WPA = OFF_WKV + (size_t)1024 * 1024 * 2;
constexpr size_t OFF_WPB = OFF_WPA + (size_t)1024 * 512 * 2;
constexpr size_t OFF_WPC = OFF_WPB + (size_t)1024 * 512 * 2;
constexpr size_t OFF_WO  = OFF_WPC + (size_t)1024 * 512 * 2;
constexpr size_t OFF_H   = OFF_WO + (size_t)1024 * 1024 * 2;
constexpr size_t OFF_HM  = OFF_H + (size_t)M * 1024 * 2;
constexpr size_t OFF_KVM = OFF_HM + (size_t)MM * 1024 * 2;
constexpr size_t OFF_ROPE = OFF_KVM + (size_t)MM * 1024 * 2;
constexpr size_t OFF_P   = OFF_ROPE + (size_t)M * 32 * 8;
constexpr size_t OFF_YA  = OFF_P + (size_t)M * NP * 2;
constexpr size_t OFF_YB  = OFF_YA + (size_t)M * 512 * 2;
constexpr size_t OFF_YC  = OFF_YB + (size_t)M * 512 * 2;
constexpr size_t WS_END  = OFF_YC + (size_t)M * 512 * 2;
constexpr size_t OFF_SG  = OFF_P;
constexpr size_t OFF_MG  = OFF_P + (size_t)M * 3072 * 2;
static_assert(WS_END <= (size_t)256 * 1024 * 1024, "workspace");
static_assert(OFF_MG + (size_t)M * 1024 * 2 <= OFF_YA, "overlay");

struct Params {
    const float* x; const float* mem; const int* pos; const float* norm_g; const float* mem_norm_g; const float* w_in;
    const float* mu_rkv; const float* mu_wa; const float* w0; const float* w2; const float* a0; const float* a2;
    const float* k_k; const float* k_a; const float* r_k; const float* lnx_g; const float* lnx_b;
    const float* q_norm_g; const float* k_norm_g; const float* sinks; const float* xq_norm_g; const float* xk_norm_g;
    const float* w_mem_kv; const float* w_proj_a; const float* w_proj_b; const float* w_proj_c; const float* w_out;
    float* out; unsigned char* ws;
};

DI bf16_t f2bf(float x) { return __builtin_bit_cast(unsigned short, (__bf16)x); }
DI float bf2f(bf16_t h) { return __uint_as_float(((unsigned)h) << 16); }
DI float wave_sum(float v) {
#pragma unroll
    for (int o = 32; o > 0; o >>= 1) v += __shfl_xor(v, o, 64);
    return v;
}
DI float wave_max(float v) {
#pragma unroll
    for (int o = 32; o > 0; o >>= 1) v = fmaxf(v, __shfl_xor(v, o, 64));
    return v;
}
DI float sigmoidf_(float x) { return __builtin_amdgcn_rcpf(1.f + __expf(-x)); }
DI float siluf_(float x) { return x * __builtin_amdgcn_rcpf(1.f + __expf(-x)); }

DI void transpose_convert(const float* W, int K, int N, bf16_t* Wt, int item, float* tile  ) {
    int tid = threadIdx.x; asm volatile("" : "+v"(tid));
    const int tn = N / 64, kt = item / tn, nt = item % tn;
    __syncthreads();
#pragma unroll
    for (int u = 0; u < 2; ++u) { const int idx = tid + NTHREADS * u, r = idx >> 4, c4 = idx & 15;
        *(f32x4*)(tile + r * 68 + c4 * 4) = *(const f32x4*)(W + (size_t)(kt * 64 + r) * N + nt * 64 + c4 * 4); }
    __syncthreads();
    {
        const int n = tid >> 3, k8 = tid & 7;
        unsigned w[4];
#pragma unroll
        for (int e2 = 0; e2 < 4; ++e2) w[e2] = (unsigned)f2bf(tile[(k8 * 8 + 2 * e2) * 68 + n]) | ((unsigned)f2bf(tile[(k8 * 8 + 2 * e2 + 1) * 68 + n]) << 16);
        *(uint4*)(Wt + (size_t)(nt * 64 + n) * K + kt * 64 + k8 * 8) = make_uint4(w[0], w[1], w[2], w[3]);
    }
}

DI void convert_late(const Params& p, unsigned char* lds, const int vb, const int nvb) {
    float* tile = (float*)lds; unsigned char* ws = p.ws;
    const int n_g = 16 * (NIN / 64 - 72), n_pr = (512 / 64) * 16, n_o = 16 * 16, total = n_g + 3 * n_pr + n_o;
    for (int it = vb * 8; it < vb * 8 + 8 && it < total; ++it) {
        int i = it;
        if (i < n_g) { const int kt = i / (NIN / 64 - 72), nt = 72 + i % (NIN / 64 - 72); transpose_convert(p.w_in, 1024, NIN, (bf16_t*)(ws + OFF_WIN), kt * (NIN / 64) + nt, tile); continue; } i -= n_g;
        if (i < n_pr) { transpose_convert(p.w_proj_a, 512, 1024, (bf16_t*)(ws + OFF_WPA), i, tile); continue; } i -= n_pr;
        if (i < n_pr) { transpose_convert(p.w_proj_b, 512, 1024, (bf16_t*)(ws + OFF_WPB), i, tile); continue; } i -= n_pr;
        if (i < n_pr) { transpose_convert(p.w_proj_c, 512, 1024, (bf16_t*)(ws + OFF_WPC), i, tile); continue; } i -= n_pr;
        transpose_convert(p.w_out, 1024, 1024, (bf16_t*)(ws + OFF_WO), i, tile);
    }
}
DI void phase_prologue(const Params& p, unsigned char* lds, const int bid, const int nb) {
    float* tile = (float*)lds;
    unsigned char* ws = p.ws;
    const int n_in = (1024 / 64) * 72, n_kv = 16 * 16;
    for (int it = bid; it < n_in + n_kv; it += nb) {
        if (it < n_in) { const int kt = it / 72, nt = it % 72; transpose_convert(p.w_in, 1024, NIN, (bf16_t*)(ws + OFF_WIN), kt * (NIN / 64) + nt, tile); }
        else transpose_convert(p.w_mem_kv, 1024, 1024, (bf16_t*)(ws + OFF_WKV), it - n_in, tile);
    }
    const int lane = threadIdx.x & 63, wid = threadIdx.x >> 6;
    for (int row = bid * NWAVES + wid; row < M + MM; row += nb * NWAVES) {
        const float* src = row < M ? p.x + (size_t)row * D : p.mem + (size_t)(row - M) * D;
        const float* g = row < M ? p.norm_g : p.mem_norm_g;
        bf16_t* dst = row < M ? (bf16_t*)(ws + OFF_H) + (size_t)row * D : (bf16_t*)(ws + OFF_HM) + (size_t)(row - M) * D;
        f32x4 v[4]; float ss = 0.f;
#pragma unroll
        for (int i = 0; i < 4; ++i) { v[i] = *(const f32x4*)(src + i * 256 + lane * 4); ss += v[i][0] * v[i][0] + v[i][1] * v[i][1] + v[i][2] * v[i][2] + v[i][3] * v[i][3]; }
        ss = wave_sum(ss);
        const float rs = rsqrtf(ss * (1.f / 1024.f) + 1e-6f);
#pragma unroll
        for (int i = 0; i < 4; ++i) {
            const f32x4 gg = *(const f32x4*)(g + i * 256 + lane * 4);
            ushort4 o; o.x = f2bf(v[i][0] * rs * gg[0]); o.y = f2bf(v[i][1] * rs * gg[1]); o.z = f2bf(v[i][2] * rs * gg[2]); o.w = f2bf(v[i][3] * rs * gg[3]);
            *(ushort4*)(dst + i * 256 + lane * 4) = o;
        }
    }
    float2* rope = (float2*)(ws + OFF_ROPE);
    for (int i = bid * NTHREADS + threadIdx.x; i < M * 32; i += nb * NTHREADS) {
        const int row = i >> 5, f = i & 31;
        const double inv = pow(10000.0, -(double)f / 32.0);
        const double ang = (double)p.pos[row] * inv;
        double s, c; sincos(ang, &s, &c);
        rope[i] = make_float2((float)c, (float)s);
    }
}

struct GemmTile { f32x4 acc[2][4]; };
DI void gemm_tile_k(GemmTile& g, const bf16_t* A, int lda, const bf16_t* Bt, int ldb, int m0, int n0, int K, unsigned char* lds) {
    bf16_t* sA = (bf16_t*)lds;
    bf16_t* sB = sA + 128 * 40;
    const int tid = threadIdx.x, lane = tid & 63, wid = tid >> 6, wm = wid & 3, wn = wid >> 2;
    const int srow = tid >> 2, sch = tid & 3;
    const bf16_t* ga = A + (size_t)(m0 + srow) * lda + sch * 8;
    const bf16_t* gb = Bt + (size_t)(n0 + srow) * ldb + sch * 8;
    const int fr = lane & 15, fq = lane >> 4;
    uint4 ra = *(const uint4*)ga, rb = *(const uint4*)gb;
    for (int k0 = 0; k0 < K; k0 += 32) {
        __syncthreads();
        *(uint4*)(sA + srow * 40 + sch * 8) = ra;
        *(uint4*)(sB + srow * 40 + sch * 8) = rb;
        __syncthreads();
        if (k0 + 32 < K) { ra = *(const uint4*)(ga + k0 + 32); rb = *(const uint4*)(gb + k0 + 32); }
        bf16x8 af[2], bfr[4];
#pragma unroll
        for (int mi = 0; mi < 2; ++mi) af[mi] = *(const bf16x8*)(sA + (wm * 32 + mi * 16 + fr) * 40 + fq * 8);
#pragma unroll
        for (int ni = 0; ni < 4; ++ni) bfr[ni] = *(const bf16x8*)(sB + (wn * 64 + ni * 16 + fr) * 40 + fq * 8);
#pragma unroll
        for (int mi = 0; mi < 2; ++mi)
#pragma unroll
            for (int ni = 0; ni < 4; ++ni) g.acc[mi][ni] = __builtin_amdgcn_mfma_f32_16x16x32_bf16(af[mi], bfr[ni], g.acc[mi][ni], 0, 0, 0);
    }
}
DI void gemm_zero(GemmTile& g) {
#pragma unroll
    for (int mi = 0; mi < 2; ++mi)
#pragma unroll
        for (int ni = 0; ni < 4; ++ni) g.acc[mi][ni] = (f32x4){0.f, 0.f, 0.f, 0.f};
}
#define GEMM_FOREACH(body) do { const int lane_ = threadIdx.x & 63, wid_ = threadIdx.x >> 6, wm_ = wid_ & 3, wn_ = wid_ >> 2, fr_ = lane_ & 15, fq_ = lane_ >> 4; \
    _Pragma("unroll") for (int mi = 0; mi < 2; ++mi) _Pragma("unroll") for (int ni = 0; ni < 4; ++ni) _Pragma("unroll") for (int r = 0; r < 4; ++r) { \
        const int row = m0 + wm_ * 32 + mi * 16 + fq_ * 4 + r, col = n0 + wn_ * 64 + ni * 16 + fr_; body } } while (0)

DI void phase_gemm_in(const Params& p, unsigned char* lds, const int bid, const int nb) {
    unsigned char* ws = p.ws;
    const bf16_t* H = (const bf16_t*)(ws + OFF_H); const bf16_t* Wt = (const bf16_t*)(ws + OFF_WIN);
    bf16_t* P = (bf16_t*)(ws + OFF_P);
    const int tn = NP / 128, nt1 = (M / 128) * tn;
    const int tn2 = 1024 / 128, nt2 = (MM / 128) * tn2;
    for (int it = bid; it < nt1 + nt2; it += nb) {
        GemmTile g; gemm_zero(g);
        if (it < nt1) {
            const int m0 = (it / tn) * 128, n0 = (it % tn) * 128;
            gemm_tile_k(g, H, 1024, Wt, 1024, m0, n0, 1024, lds);
            GEMM_FOREACH(P[(size_t)row * NP + col] = f2bf(g.acc[mi][ni][r]););
        } else {
            const int i2 = it - nt1; const int m0 = (i2 / tn2) * 128, n0 = (i2 % tn2) * 128;
            gemm_tile_k(g, (const bf16_t*)(ws + OFF_HM), 1024, (const bf16_t*)(ws + OFF_WKV), 1024, m0, n0, 1024, lds);
            bf16_t* KVM = (bf16_t*)(ws + OFF_KVM);
            GEMM_FOREACH(KVM[(size_t)row * 1024 + col] = f2bf(g.acc[mi][ni][r]););
        }
    }
}

DI void phase_attn_prep(const Params& p, unsigned char* lds, const int bid, const int nb) {
    unsigned char* ws = p.ws; bf16_t* P = (bf16_t*)(ws + OFF_P); bf16_t* KVM = (bf16_t*)(ws + OFF_KVM);
    const float2* rope = (const float2*)(ws + OFF_ROPE);
    const int lane = threadIdx.x & 63, wid = threadIdx.x >> 6;
    const long n1 = (long)M * 14, n2 = (long)MM * 4;
    for (long it = (long)bid * NWAVES + wid; it < n1 + n2; it += (long)nb * NWAVES) {
        if (it < n1) {
            const int row = (int)(it / 14), j = (int)(it % 14);
            if (j < 10) {
                bf16_t* ptr = P + (size_t)row * NP + (j < 8 ? C_Q + j * 64 : C_SK + (j - 8) * 64);
                const float g = j < 8 ? p.q_norm_g[lane] : p.k_norm_g[lane];
                const float xv = bf2f(ptr[lane]);
                const float ss = wave_sum(xv * xv);
                const float y = xv * rsqrtf(ss * (1.f / 64.f) + 1e-6f) * g;
                const float yp = __shfl_xor(y, 32, 64);
                const float2 cs = rope[(size_t)row * 32 + (lane & 31)];
                const float o = lane < 32 ? y * cs.x - yp * cs.y : y * cs.x + yp * cs.y;
                ptr[lane] = f2bf(o);
            } else {
                bf16_t* ptr = P + (size_t)row * NP + C_XQ + (j - 10) * 128;
                const float x0 = bf2f(ptr[lane]), x1 = bf2f(ptr[lane + 64]);
                const float ss = wave_sum(x0 * x0 + x1 * x1);
                const float rs = rsqrtf(ss * (1.f / 128.f) + 1e-6f);
                ptr[lane] = f2bf(x0 * rs * p.xq_norm_g[lane]); ptr[lane + 64] = f2bf(x1 * rs * p.xq_norm_g[lane + 64]);
            }
        } else {
            const long i2 = it - n1; const int row = (int)(i2 / 4), j = (int)(i2 % 4);
            bf16_t* ptr = KVM + (size_t)row * 1024 + j * 128;
            const float x0 = bf2f(ptr[lane]), x1 = bf2f(ptr[lane + 64]);
            const float ss = wave_sum(x0 * x0 + x1 * x1);
            const float rs = rsqrtf(ss * (1.f / 128.f) + 1e-6f);
            ptr[lane] = f2bf(x0 * rs * p.xk_norm_g[lane]); ptr[lane + 64] = f2bf(x1 * rs * p.xk_norm_g[lane + 64]);
        }
    }
}

DI void rwkv_stage(const Params& p, int b, int h, int t0, int ntok, float* ck, float* scratch  ) {
    const bf16_t* P = (const bf16_t*)(p.ws + OFF_P);
    const int lane = threadIdx.x & 63, wid = threadIdx.x >> 6, ch = h * 64 + lane;
    const float mu_r = p.mu_rkv[ch], mu_k = p.mu_rkv[512 + ch], mu_v = p.mu_rkv[1024 + ch], mu_w = p.mu_wa[lane], mu_a = p.mu_wa[64 + lane];
    const float w0c = p.w0[ch], a0c = p.a0[ch], kkc = p.k_k[ch], kac = p.k_a[ch];
    float* sc = scratch + wid * 128;
    for (int i = wid; i < ntok; i += NWAVES) {
        const int t = t0 + i; const bf16_t* pr = P + (size_t)(b * T + t) * NP; const bf16_t* pp = pr - NP; const bool hp = t > 0;
        const float rc = bf2f(pr[C_R + ch]), rp = hp ? bf2f(pp[C_R + ch]) : 0.f;
        const float kc = bf2f(pr[C_K + ch]), kp = hp ? bf2f(pp[C_K + ch]) : 0.f;
        const float vc = bf2f(pr[C_V + ch]), vp = hp ? bf2f(pp[C_V + ch]) : 0.f;
        const float wc = bf2f(pr[C_W + lane]), wp = hp ? bf2f(pp[C_W + lane]) : 0.f;
        const float ac = bf2f(pr[C_A + lane]), ap = hp ? bf2f(pp[C_A + lane]) : 0.f;
        const float r = rc + (rp - rc) * mu_r, k = kc + (kp - kc) * mu_k, v = vc + (vp - vc) * mu_v;
        const float lw = wc + (wp - wc) * mu_w, la = ac + (ap - ac) * mu_a;
        sc[lane] = tanhf(lw); sc[64 + lane] = la;
        float accw = 0.f, acca = 0.f;
#pragma unroll 8
        for (int j = 0; j < 64; ++j) { accw += sc[j] * p.w2[j * 512 + ch]; acca += sc[64 + j] * p.a2[j * 512 + ch]; }
        const float xw = -(w0c + accw);
        const float sp = xw > 20.f ? xw : log1pf(expf(xw));
        const float wlog = -sp - 0.5f;
        const float decay = expf(-expf(wlog));
        const float alpha = 1.f / (1.f + expf(-(a0c + acca)));
        const float kk0 = k * kkc;
        const float n2 = wave_sum(kk0 * kk0);
        const float kk = kk0 / fmaxf(sqrtf(n2), 1e-12f);
        const float k2 = k * (1.f + (alpha - 1.f) * kac);
        float* o = ck + i * 384;
        o[lane] = r; o[64 + lane] = decay; o[128 + lane] = k2; o[192 + lane] = v; o[256 + lane] = -kk; o[320 + lane] = kk * alpha;
    }
}

DI void phase_rwkv_direct(const Params& p, unsigned char* lds, const int bid, const int nb) {
    float* ck = (float*)lds; float* scratch = ck + 64 * 384;
    const int lane = threadIdx.x & 63, wid = threadIdx.x >> 6;
    const bf16_t* P = (const bf16_t*)(p.ws + OFF_P); bf16_t* YA = (bf16_t*)(p.ws + OFF_YA);
    for (int bh = bid; bh < BATCH * 8; bh += nb) {
        const int b = bh >> 3, h = bh & 7, ch = h * 64 + lane;
        float S[64];
#pragma unroll
        for (int k = 0; k < 64; ++k) S[k] = 0.f;
        const float rk = p.r_k[ch], lg = p.lnx_g[ch], lb = p.lnx_b[ch];
        for (int c = 0; c < T / 64; ++c) {
            __syncthreads();
            rwkv_stage(p, b, h, c * 64, 64, ck, scratch);
            __syncthreads();
            if (wid == 0) {
                for (int i = 0; i < 64; ++i) {
                    const float* cc = ck + i * 384;
                    float sa = 0.f;
#pragma unroll
                    for (int k = 0; k < 64; ++k) sa += S[k] * cc[256 + k];
                    const float vv = cc[192 + lane];
#pragma unroll
                    for (int k = 0; k < 64; ++k) S[k] = S[k] * cc[64 + k] + sa * cc[320 + k] + vv * cc[128 + k];
                    float y = 0.f;
#pragma unroll
                    for (int k = 0; k < 64; ++k) y += S[k] * cc[k];
                    const float mean = wave_sum(y) * (1.f / 64.f);
                    const float dy = y - mean;
                    const float var = wave_sum(dy * dy) * (1.f / 64.f);
                    const float yn = dy * rsqrtf(var + 64e-5f) * lg + lb;
                    const float bonus = wave_sum(cc[lane] * cc[128 + lane] * rk) * vv;
                    const int t = c * 64 + i; const size_t row = (size_t)(b * T + t);
                    const float z = bf2f(P[row * NP + C_ZA + ch]);
                    YA[row * 512 + ch] = f2bf((yn + bonus) * siluf_(z));
                }
            }
        }
    }
}

constexpr size_t AF_BYTES = 16384, NF_BYTES = 16384, NCHUNK = 64;
constexpr int CHT = 128;
constexpr size_t OFF_AF = 0, OFF_NF = (size_t)16 * NCHUNK * AF_BYTES;
constexpr size_t OFF_QH = OFF_NF + (size_t)16 * NCHUNK * NF_BYTES;
constexpr size_t OFF_BON = OFF_QH + (size_t)16 * T * 64 * 2;
static_assert(OFF_BON + (size_t)16 * T * 4 <= (size_t)M * 1024 * 4, "d_out scratch");
typedef float f32x16 __attribute__((ext_vector_type(16)));
#define MFMA32(a, b, c) __builtin_amdgcn_mfma_f32_32x32x16_bf16((a), (b), (c), 0, 0, 0)
typedef float f32x2 __attribute__((ext_vector_type(2)));

DI unsigned pk2f(float lo, float hi) { typedef float f2_ __attribute__((ext_vector_type(2))); typedef __bf16 b2_ __attribute__((ext_vector_type(2))); return __builtin_bit_cast(unsigned, __builtin_convertvector((f2_){lo, hi}, b2_)); }
DI float quad_sum(float s) {
    s += __int_as_float(__builtin_amdgcn_update_dpp(0, __float_as_int(s), 0xB1, 0xF, 0xF, true));
    s += __int_as_float(__builtin_amdgcn_update_dpp(0, __float_as_int(s), 0x4E, 0xF, 0xF, true));
    return s;
}

DI float rwkv_stage_tok(const Params& p, const bf16_t* P, int b, int h, int t, float* o, float* sc, float mu_r, float mu_k, float mu_v, float mu_w, float mu_a,
                        float w0c, float a0c, float kkc, float kac, float rkc) {
    const int lane = threadIdx.x & 63, ch = h * 64 + lane;
    const bf16_t* pr = P + (size_t)(b * T + t) * NP; const bf16_t* pp = pr - NP; const bool hp = t > 0;
    const float rc = bf2f(pr[C_R + ch]), rp = hp ? bf2f(pp[C_R + ch]) : 0.f;
    const float kc = bf2f(pr[C_K + ch]), kp = hp ? bf2f(pp[C_K + ch]) : 0.f;
    const float vc = bf2f(pr[C_V + ch]), vp = hp ? bf2f(pp[C_V + ch]) : 0.f;
    const float wc = bf2f(pr[C_W + lane]), wp = hp ? bf2f(pp[C_W + lane]) : 0.f;
    const float ac = bf2f(pr[C_A + lane]), ap = hp ? bf2f(pp[C_A + lane]) : 0.f;
    const float r = rc + (rp - rc) * mu_r, k = kc + (kp - kc) * mu_k, v = vc + (vp - vc) * mu_v;
    const float lw = wc + (wp - wc) * mu_w, la = ac + (ap - ac) * mu_a;
    sc[lane] = tanhf(lw); sc[64 + lane] = la;
    float accw = 0.f, acca = 0.f;
    const float* w2p = p.w2; const float* a2p = p.a2;
    asm volatile("" : "+s"(w2p), "+s"(a2p));
#pragma unroll 8
    for (int j = 0; j < 64; ++j) { accw += sc[j] * w2p[j * 512 + ch]; acca += sc[64 + j] * a2p[j * 512 + ch]; }
    const float xw = -(w0c + accw);
    const float sp = xw > 20.f ? xw : log1pf(expf(xw));
    const float decay = expf(-expf(-sp - 0.5f));
    const float alpha = 1.f / (1.f + expf(-(a0c + acca)));
    const float kk0 = k * kkc;
    const float n2 = wave_sum(kk0 * kk0);
    const float kk = kk0 / fmaxf(sqrtf(n2), 1e-12f);
    const float k2 = k * (1.f + (alpha - 1.f) * kac);
    o[lane] = r; o[64 + lane] = decay; o[128 + lane] = k2; o[192 + lane] = v; o[256 + lane] = -kk; o[320 + lane] = kk * alpha;
    return wave_sum(r * k2 * rkc);
}

typedef float f32x4_t __attribute__((ext_vector_type(4)));
DI float row16_sum(float x) {
    x += __int_as_float(__builtin_amdgcn_update_dpp(0, __float_as_int(x), 0x128, 0xF, 0xF, true));
    x += __int_as_float(__builtin_amdgcn_update_dpp(0, __float_as_int(x), 0x124, 0xF, 0xF, true));
    x += __int_as_float(__builtin_amdgcn_update_dpp(0, __float_as_int(x), 0x122, 0xF, 0xF, true));
    x += __int_as_float(__builtin_amdgcn_update_dpp(0, __float_as_int(x), 0x121, 0xF, 0xF, true));
    return x;
}
DI void build_lora_frags(const Params& p, int h, unsigned char* bfrag) {
    for (int fidx = threadIdx.x; fidx < 1024; fidx += NTHREADS) {
        const int mat = fidx >> 9, nt = (fidx >> 7) & 3, ks = (fidx >> 6) & 1, l = fidx & 63, n = l & 15, kg = l >> 4;
        const float* W = (mat ? p.a2 : p.w2) + (size_t)(32 * ks + 8 * kg) * 512 + h * 64 + 16 * nt + n;
        unsigned w[4];
#pragma unroll
        for (int e2 = 0; e2 < 4; ++e2) w[e2] = (unsigned)f2bf(W[(2 * e2) * 512]) | ((unsigned)f2bf(W[(2 * e2 + 1) * 512]) << 16);
        *(uint4*)(bfrag + fidx * 16) = make_uint4(w[0], w[1], w[2], w[3]);
    }
}
template <int PART, int RS, bool R3>
DI void stage16(const Params& p, const bf16_t* P, int b, int h, int tg0, int tg1, int tg2, int tg3, float* recs, const unsigned char* bfrag, float* bon_out  ) {
    asm volatile("" : "+s"(h));
    const int lane = threadIdx.x & 63, n = lane & 15, rg = lane >> 4;
    constexpr int FIELD = PART == 0 ? 0 : 128;
    {
        const float mu = PART == 0 ? p.mu_wa[lane] : p.mu_wa[64 + lane];
        const int colx = (PART == 0 ? C_W : C_A) + lane;
#pragma unroll
        for (int gi = 0; gi < 4; ++gi) {
            const int t0 = gi == 0 ? tg0 : gi == 1 ? tg1 : gi == 2 ? tg2 : tg3;
            const bf16_t* base = P + (size_t)(b * T + t0) * NP + colx;
            float prev = t0 > 0 ? bf2f(base[-NP]) : 0.f;
#pragma unroll
            for (int rr = 0; rr < 4; ++rr) {
                const float cur = bf2f(base[rr * NP]);
                const float x = cur + (prev - cur) * mu; prev = cur;
                float val = x;
                if (PART == 0) { const float e2 = __expf(2.f * x); val = 1.f - 2.f * __builtin_amdgcn_rcpf(1.f + e2); }
                *(bf16_t*)((unsigned char*)(recs + (gi * 4 + rr) * RS + FIELD) + 2 * lane) = f2bf(val);
            }
        }
    }
    f32x4 acc[4];
#pragma unroll
    for (int nt = 0; nt < 4; ++nt) acc[nt] = (f32x4){0.f, 0.f, 0.f, 0.f};
#pragma unroll
    for (int ks = 0; ks < 2; ++ks) {
        const bf16x8 af = *(const bf16x8*)((const unsigned char*)(recs + n * RS + FIELD) + ks * 64 + rg * 16);
#pragma unroll
        for (int nt = 0; nt < 4; ++nt) {
            const bf16x8 bfr = *(const bf16x8*)(bfrag + (((PART * 4 + nt) * 2 + ks) * 64 + lane) * 16);
            acc[nt] = __builtin_amdgcn_mfma_f32_16x16x32_bf16(af, bfr, acc[nt], 0, 0, 0);
        }
    }
    const int tgl = rg == 0 ? tg0 : rg == 1 ? tg1 : rg == 2 ? tg2 : tg3;
    const bf16_t* rowb = P + (size_t)(b * T + tgl) * NP;
    float* rec0 = recs + (4 * rg) * RS;
    const bool hp = tgl > 0;
    if (PART == 0) {
#pragma unroll
        for (int nt = 0; nt < 4; ++nt) {
            const int cl = 16 * nt + n, ch = h * 64 + cl;
            const float mu_r = p.mu_rkv[ch], mu_v = p.mu_rkv[1024 + ch], w0c = p.w0[ch];
            float rp = hp ? bf2f(rowb[-NP + C_R + ch]) : 0.f, vp = hp ? bf2f(rowb[-NP + C_V + ch]) : 0.f;
#pragma unroll
            for (int rr = 0; rr < 4; ++rr) {
                const float rc = bf2f(rowb[rr * NP + C_R + ch]), vc = bf2f(rowb[rr * NP + C_V + ch]);
                const float r = rc + (rp - rc) * mu_r, v = vc + (vp - vc) * mu_v; rp = rc; vp = vc;
                const float xw = -(w0c + acc[nt][rr]);
                const float sp = xw > 20.f ? xw : __logf(1.f + __expf(xw));
                const float decay = __expf(-__expf(-sp - 0.5f));
                float* o = rec0 + rr * RS;
                o[cl] = r; o[64 + cl] = decay; o[192 + cl] = v;
            }
        }
    } else {
        float kv[4][4], kk0[4][4], al[4][4], rv[4][4], n2[4] = {0.f, 0.f, 0.f, 0.f};
#pragma unroll
        for (int nt = 0; nt < 4; ++nt) {
            const int ch = h * 64 + 16 * nt + n;
            const float mu_k = p.mu_rkv[512 + ch], mu_r = p.mu_rkv[ch], a0c = p.a0[ch], kkc = p.k_k[ch];
            float kp = hp ? bf2f(rowb[-NP + C_K + ch]) : 0.f, rp = (R3 && hp) ? bf2f(rowb[-NP + C_R + ch]) : 0.f;
#pragma unroll
            for (int rr = 0; rr < 4; ++rr) {
                const float kc = bf2f(rowb[rr * NP + C_K + ch]);
                const float k = kc + (kp - kc) * mu_k; kp = kc;
                if (R3) { const float rc = bf2f(rowb[rr * NP + C_R + ch]); rv[nt][rr] = rc + (rp - rc) * mu_r; rp = rc; }
                kv[nt][rr] = k; kk0[nt][rr] = k * kkc; n2[rr] += kk0[nt][rr] * kk0[nt][rr];
                al[nt][rr] = __builtin_amdgcn_rcpf(1.f + __expf(-(a0c + acc[nt][rr])));
            }
        }
        float inv[4], bon[4] = {0.f, 0.f, 0.f, 0.f};
#pragma unroll
        for (int rr = 0; rr < 4; ++rr) inv[rr] = 1.f / fmaxf(sqrtf(row16_sum(n2[rr])), 1e-12f);
#pragma unroll
        for (int nt = 0; nt < 4; ++nt) {
            const int cl = 16 * nt + n, ch = h * 64 + cl;
            const float kac = p.k_a[ch], rkc = p.r_k[ch];
#pragma unroll
            for (int rr = 0; rr < 4; ++rr) {
                const float kk = kk0[nt][rr] * inv[rr], k2 = kv[nt][rr] * (1.f + (al[nt][rr] - 1.f) * kac);
                float* o = rec0 + rr * RS;
                o[128 + cl] = k2; o[256 + cl] = -kk; o[320 + cl] = kk * al[nt][rr];
                if (R3) bon[rr] += rv[nt][rr] * k2 * rkc;
            }
        }
        if (R3) {
#pragma unroll
            for (int rr = 0; rr < 4; ++rr) { const float bs = row16_sum(bon[rr]); if (n == 0) bon_out[tgl + rr] = bs; }
        }
    }
}

constexpr size_t OFF_LWF = OFF_YB, OFF_ALF = OFF_YC;
DI void lora_group(const Params& p, const bf16_t* P, int b, int h, int bh, int t0, unsigned char* scr, const unsigned char* bfrag) {
    int lane = threadIdx.x & 63; asm volatile("" : "+v"(lane));
    const int n = lane & 15, rg = lane >> 4;
    {
        const float mu_w = p.mu_wa[lane], mu_a = p.mu_wa[64 + lane];
#pragma unroll
        for (int u = 0; u < 3; ++u) {
            const int pi = lane + 64 * u, row = pi >> 3, p16 = pi & 7, tt = t0 - 1 + row;
            if (pi < 17 * 8) {
                uint4 vw = make_uint4(0u, 0u, 0u, 0u), va = make_uint4(0u, 0u, 0u, 0u);
                if (tt >= 0) { vw = *(const uint4*)(P + (size_t)(b * T + tt) * NP + C_W + p16 * 8); va = *(const uint4*)(P + (size_t)(b * T + tt) * NP + C_A + p16 * 8); }
                *(uint4*)(scr + row * 128 + p16 * 16) = vw; *(uint4*)(scr + 2176 + row * 128 + p16 * 16) = va;
            }
        }
        float rw[17], ra[17];
#pragma unroll
        for (int i = 0; i < 17; ++i) { rw[i] = bf2f(*(const bf16_t*)(scr + i * 128 + 2 * lane)); ra[i] = bf2f(*(const bf16_t*)(scr + 2176 + i * 128 + 2 * lane)); }
        asm volatile("" ::: "memory");
#pragma unroll
        for (int i = 0; i < 16; ++i) {
            const float xw = rw[i + 1] + (rw[i] - rw[i + 1]) * mu_w;
            const float e2 = __expf(2.f * xw);
            *(bf16_t*)(scr + (i + 1) * 128 + 2 * lane) = f2bf(1.f - 2.f * __builtin_amdgcn_rcpf(1.f + e2));
            *(bf16_t*)(scr + 2176 + (i + 1) * 128 + 2 * lane) = f2bf(ra[i + 1] + (ra[i] - ra[i + 1]) * mu_a);
        }
    }
    f32x4 accw[4], acca[4];
#pragma unroll
    for (int nt = 0; nt < 4; ++nt) { accw[nt] = (f32x4){0.f, 0.f, 0.f, 0.f}; acca[nt] = (f32x4){0.f, 0.f, 0.f, 0.f}; }
#pragma unroll
    for (int ks = 0; ks < 2; ++ks) {
        const bf16x8 afw = *(const bf16x8*)(scr + (n + 1) * 128 + ks * 64 + rg * 16), afa = *(const bf16x8*)(scr + 2176 + (n + 1) * 128 + ks * 64 + rg * 16);
#pragma unroll
        for (int nt = 0; nt < 4; ++nt) {
            accw[nt] = __builtin_amdgcn_mfma_f32_16x16x32_bf16(afw, *(const bf16x8*)(bfrag + ((nt * 2 + ks) * 64 + lane) * 16), accw[nt], 0, 0, 0);
            acca[nt] = __builtin_amdgcn_mfma_f32_16x16x32_bf16(afa, *(const bf16x8*)(bfrag + (((4 + nt) * 2 + ks) * 64 + lane) * 16), acca[nt], 0, 0, 0);
        }
    }
    uint2* lwf = (uint2*)(p.ws + OFF_LWF) + ((size_t)(bh * 512 + (t0 >> 4)) * 4) * 64 + lane;
    uint2* alf = (uint2*)(p.ws + OFF_ALF) + ((size_t)(bh * 512 + (t0 >> 4)) * 4) * 64 + lane;
#pragma unroll
    for (int nt = 0; nt < 4; ++nt) {
        const int ch = h * 64 + 16 * nt + n;
        const float w0c = p.w0[ch], a0c = p.a0[ch];
        float lw[4], al[4];
#pragma unroll
        for (int rr = 0; rr < 4; ++rr) { const float xw = -(w0c + accw[nt][rr]); const float sp = fmaxf(xw, 0.f) + __logf(1.f + __expf(-fabsf(xw))); lw[rr] = -__expf(-sp - 0.5f);
            al[rr] = __builtin_amdgcn_rcpf(1.f + __expf(-(a0c + acca[nt][rr]))); }
        lwf[nt * 64] = make_uint2(pk2f(lw[0], lw[1]), pk2f(lw[2], lw[3]));
        alf[nt * 64] = make_uint2(pk2f(al[0], al[1]), pk2f(al[2], al[3]));
    }
}
template <int PART>
DI void stage16s(const Params& p, const unsigned char* rawc  , const unsigned char* fragl  ,
                 const float* cst  , int h, int bh, int t0, float* recs, float* bon_out, float (&Lb)[4]) {
    (void)p; (void)h; (void)bh;
    int lane = threadIdx.x & 63; asm volatile("" : "+v"(lane));
    const int n = lane & 15, rg = lane >> 4;
    constexpr int RS = 384;
    const int tgl = t0 + 4 * rg;
    const unsigned char* rawl = rawc + (4 * rg) * 384;
    const float hpf = tgl > 0 ? 1.f : 0.f;
    float* rec0 = recs + (4 * rg) * RS;
    const uint2* lwf = (const uint2*)fragl + lane;
    const uint2* alf = (const uint2*)(fragl + 2048) + lane;
#define S16S_L(nt_) \
        float eL[4], eLm[4], eN[4]; { const uint2 lwp = lwf[(nt_) * 64]; float lw[4], pl[4]; \
        lw[0] = __uint_as_float(lwp.x << 16); lw[1] = __uint_as_float(lwp.x & 0xffff0000u); lw[2] = __uint_as_float(lwp.y << 16); lw[3] = __uint_as_float(lwp.y & 0xffff0000u); \
        pl[0] = lw[0]; pl[1] = pl[0] + lw[1]; pl[2] = pl[1] + lw[2]; pl[3] = pl[2] + lw[3]; \
        float inc = pl[3]; float y_ = __shfl_up(inc, 16, 64); if (rg >= 1) inc += y_; y_ = __shfl_up(inc, 32, 64); if (rg >= 2) inc += y_; \
        const float tot = __shfl(inc, 48 + n, 64); const float base_ = Lb[nt_] + inc - pl[3]; \
        _Pragma("unroll") for (int rr = 0; rr < 4; ++rr) { const float L = base_ + pl[rr]; const float Lc = fmaxf(L, -80.f), Lm = fmaxf(L - lw[rr], -80.f); eL[rr] = __expf(Lc); eLm[rr] = __expf(Lm); eN[rr] = __expf(-Lc); } \
        Lb[nt_] += tot; }
    if (PART == 0) {
#pragma unroll
        for (int nt = 0; nt < 4; ++nt) {
            S16S_L(nt)
            (void)eLm; (void)eN;
            const int cl = 16 * nt + n;
            const float mu_r = cst[cl], mu_v = cst[128 + cl];
            float rr_[5], vv_[5];
#pragma unroll
            for (int r5 = 0; r5 < 5; ++r5) { rr_[r5] = bf2f(*(const bf16_t*)(rawl + r5 * 384 + cl * 2)); vv_[r5] = bf2f(*(const bf16_t*)(rawl + r5 * 384 + 256 + cl * 2)); }
            rr_[0] *= hpf; vv_[0] *= hpf;
#pragma unroll
            for (int rr = 0; rr < 4; ++rr) {
                const float r = rr_[rr + 1] + (rr_[rr] - rr_[rr + 1]) * mu_r, v = vv_[rr + 1] + (vv_[rr] - vv_[rr + 1]) * mu_v;
                float* o = rec0 + rr * RS;
                o[cl] = r * eL[rr]; o[192 + cl] = v;
            }
            asm volatile("" ::: "memory");
        }
    } else {
        float kv[4][4], n2[4] = {0.f, 0.f, 0.f, 0.f};
#pragma unroll
        for (int nt = 0; nt < 4; ++nt) {
            const float mu_k = cst[64 + 16 * nt + n], kkc = cst[192 + 16 * nt + n];
            float kk_[5];
#pragma unroll
            for (int r5 = 0; r5 < 5; ++r5) kk_[r5] = bf2f(*(const bf16_t*)(rawl + r5 * 384 + 128 + (16 * nt + n) * 2));
            kk_[0] *= hpf;
#pragma unroll
            for (int rr = 0; rr < 4; ++rr) { const float k = kk_[rr + 1] + (kk_[rr] - kk_[rr + 1]) * mu_k; kv[nt][rr] = k; const float k0 = k * kkc; n2[rr] += k0 * k0; }
        }
        float inv[4], bon[4] = {0.f, 0.f, 0.f, 0.f};
#pragma unroll
        for (int rr = 0; rr < 4; ++rr) inv[rr] = 1.f / fmaxf(sqrtf(row16_sum(n2[rr])), 1e-12f);
#pragma unroll
        for (int nt = 0; nt < 4; ++nt) {
            S16S_L(nt)
            (void)eL;
            const int cl = 16 * nt + n;
            const float kac = cst[256 + cl], rkc = cst[320 + cl], mu_r = cst[cl], kkc = cst[192 + cl];
            const uint2 alp = alf[nt * 64];
            const float al4[4] = {__uint_as_float(alp.x << 16), __uint_as_float(alp.x & 0xffff0000u), __uint_as_float(alp.y << 16), __uint_as_float(alp.y & 0xffff0000u)};
            float rr_[5];
#pragma unroll
            for (int r5 = 0; r5 < 5; ++r5) rr_[r5] = bf2f(*(const bf16_t*)(rawl + r5 * 384 + cl * 2));
            rr_[0] *= hpf;
#pragma unroll
            for (int rr = 0; rr < 4; ++rr) {
                const float r = rr_[rr + 1] + (rr_[rr] - rr_[rr + 1]) * mu_r;
                const float al = al4[rr];
                const float k = kv[nt][rr], kk = k * kkc * inv[rr], k2 = k * (1.f + (al - 1.f) * kac);
                float* o = rec0 + rr * RS;
                o[128 + cl] = k2 * eN[rr]; o[256 + cl] = -kk * eLm[rr]; o[320 + cl] = kk * al * eN[rr];
                bon[rr] += r * k2 * rkc;
            }
            asm volatile("" ::: "memory");
        }
#pragma unroll
        for (int rr = 0; rr < 4; ++rr) { const float bs = row16_sum(bon[rr]); if (n == 0) bon_out[tgl + rr] = bs; }
    }
#undef S16S_L
}
typedef float v2f __attribute__((ext_vector_type(2)));
template <int MODE> DI void rwkv_step_s(v2f (&z)[4][8], const float* cc, int q, int g, float (&yo)[4]) {
    f32x4 av[4], bv[4], kv[4], rv[4];
#pragma unroll
    for (int u = 0; u < 4; ++u) { av[u] = *(const f32x4*)(cc + 256 + 16 * q + 4 * u); bv[u] = *(const f32x4*)(cc + 320 + 16 * q + 4 * u); rv[u] = *(const f32x4*)(cc + 16 * q + 4 * u);
        if (MODE == 1) kv[u] = *(const f32x4*)(cc + 128 + 16 * q + 4 * u); }
    f32x4 vr = (f32x4){0.f, 0.f, 0.f, 0.f};
    if (MODE == 1) vr = *(const f32x4*)(cc + 192 + 4 * g);
#define V2LO(x_) ((v2f){(x_)[0], (x_)[1]})
#define V2HI(x_) ((v2f){(x_)[2], (x_)[3]})
    float sa[4];
#pragma unroll
    for (int rr = 0; rr < 4; ++rr) {
        v2f s = z[rr][0] * V2LO(av[0]);
        s = __builtin_elementwise_fma(z[rr][1], V2HI(av[0]), s);
#pragma unroll
        for (int u = 1; u < 4; ++u) { s = __builtin_elementwise_fma(z[rr][2 * u], V2LO(av[u]), s); s = __builtin_elementwise_fma(z[rr][2 * u + 1], V2HI(av[u]), s); }
        sa[rr] = quad_sum(s[0] + s[1]);
    }
#pragma unroll
    for (int rr = 0; rr < 4; ++rr) {
        const v2f sa2 = (v2f){sa[rr], sa[rr]}, vr2 = (v2f){vr[rr], vr[rr]};
#pragma unroll
        for (int u = 0; u < 4; ++u) {
            v2f t0 = __builtin_elementwise_fma(sa2, V2LO(bv[u]), z[rr][2 * u]), t1 = __builtin_elementwise_fma(sa2, V2HI(bv[u]), z[rr][2 * u + 1]);
            if (MODE == 1) { t0 = __builtin_elementwise_fma(vr2, V2LO(kv[u]), t0); t1 = __builtin_elementwise_fma(vr2, V2HI(kv[u]), t1); }
            z[rr][2 * u] = t0; z[rr][2 * u + 1] = t1;
        }
    }
#pragma unroll
    for (int rr = 0; rr < 4; ++rr) {
        v2f s = z[rr][0] * V2LO(rv[0]);
        s = __builtin_elementwise_fma(z[rr][1], V2HI(rv[0]), s);
#pragma unroll
        for (int u = 1; u < 4; ++u) { s = __builtin_elementwise_fma(z[rr][2 * u], V2LO(rv[u]), s); s = __builtin_elementwise_fma(z[rr][2 * u + 1], V2HI(rv[u]), s); }
        yo[rr] = quad_sum(s[0] + s[1]);
    }
#undef V2LO
#undef V2HI
}

template <int MODE> DI void rwkv_step(float (&z)[4][16], const float* cc, int q, int g, float (&sa)[4], float (&yo)[4]) {
    f32x4 av[4], wv[4], bv[4], kv[4];
#pragma unroll
    for (int u = 0; u < 4; ++u) { av[u] = *(const f32x4*)(cc + 256 + 16 * q + 4 * u); wv[u] = *(const f32x4*)(cc + 64 + 16 * q + 4 * u); bv[u] = *(const f32x4*)(cc + 320 + 16 * q + 4 * u);
        if (MODE == 1) kv[u] = *(const f32x4*)(cc + 128 + 16 * q + 4 * u); }
    f32x4 vr = (f32x4){0.f, 0.f, 0.f, 0.f};
    if (MODE == 1) vr = *(const f32x4*)(cc + 192 + 4 * g);
#pragma unroll
    for (int rr = 0; rr < 4; ++rr) {
        float s0 = 0.f, s1 = 0.f;
#pragma unroll
        for (int u = 0; u < 4; ++u) { s0 += z[rr][4 * u] * av[u][0] + z[rr][4 * u + 2] * av[u][2]; s1 += z[rr][4 * u + 1] * av[u][1] + z[rr][4 * u + 3] * av[u][3]; }
        sa[rr] = quad_sum(s0 + s1);
    }
#pragma unroll
    for (int rr = 0; rr < 4; ++rr)
#pragma unroll
        for (int u = 0; u < 4; ++u)
#pragma unroll
            for (int e = 0; e < 4; ++e) {
                float t = sa[rr] * bv[u][e];
                if (MODE == 1) t += vr[rr] * kv[u][e];
                z[rr][4 * u + e] = z[rr][4 * u + e] * wv[u][e] + t;
            }
    f32x4 rv[4];
#pragma unroll
    for (int u = 0; u < 4; ++u) rv[u] = *(const f32x4*)(cc + 16 * q + 4 * u);
#pragma unroll
    for (int rr = 0; rr < 4; ++rr) {
        float s0 = 0.f, s1 = 0.f;
#pragma unroll
        for (int u = 0; u < 4; ++u) { s0 += z[rr][4 * u] * rv[u][0] + z[rr][4 * u + 2] * rv[u][2]; s1 += z[rr][4 * u + 1] * rv[u][1] + z[rr][4 * u + 3] * rv[u][3]; }
        yo[rr] = quad_sum(s0 + s1);
    }
}

DI void phase_rwkv_prep(const Params& p, unsigned char* lds, const int bid, const int nb) {
    float* ck = (float*)lds; unsigned char* bfrag = lds + 64 * 384 * 4; float* mat = (float*)lds;
    const bf16_t* P = (const bf16_t*)(p.ws + OFF_P);
    unsigned char* fr = (unsigned char*)p.out;
    bf16_t* YA = (bf16_t*)(p.ws + OFF_YA);
    for (int item = bid; item < 256; item += nb) {
        int tid = threadIdx.x; asm volatile("" : "+v"(tid));
        const int lane = tid & 63, wid = __builtin_amdgcn_readfirstlane(tid >> 6), q = lane & 3, g = lane >> 2, cl = wid & 3, role = wid >> 2;
        const int bh = item >> 4, cq = item & 15, b = bh >> 3, h = bh & 7;
        __syncthreads();
        float* cst = (float*)(lds + 64 * 384 * 4 + 16384 + 2048 + 26624);
        if (tid < 384) { const int k6 = tid >> 6, c6 = tid & 63, ch = h * 64 + c6;
            cst[tid] = k6 == 0 ? p.mu_rkv[ch] : k6 == 1 ? p.mu_rkv[512 + ch] : k6 == 2 ? p.mu_rkv[1024 + ch] : k6 == 3 ? p.k_k[ch] : k6 == 4 ? p.k_a[ch] : p.r_k[ch]; }
        build_lora_frags(p, h, bfrag);
        __syncthreads();
        {
#pragma unroll 1
            for (int gi = 0; gi < 4; ++gi) lora_group(p, P, b, h, bh, cq * 4 * CHT + (wid + 8 * gi) * 16, lds + wid * 4352, bfrag);
            asm volatile("s_waitcnt vmcnt(0)" ::: "memory");
            __syncthreads();
            if (tid == 0) __builtin_amdgcn_fence(__ATOMIC_ACQUIRE, "agent");
            asm volatile("s_waitcnt vmcnt(0)" ::: "memory");
        }
        v2f z[4][8];
#pragma unroll
        for (int rr = 0; rr < 4; ++rr)
#pragma unroll
            for (int c = 0; c < 16; ++c) z[rr][c >> 1][c & 1] = (role == 0 && (4 * g + rr) == (16 * q + c)) ? 1.f : 0.f;
        bf16_t* qh = (bf16_t*)(fr + OFF_QH) + (size_t)bh * T * 64;
        float* bon = (float*)(fr + OFF_BON) + (size_t)bh * T;
        float Lb[4] = {0.f, 0.f, 0.f, 0.f};
        unsigned char* rawbuf = lds + 64 * 384 * 4 + 16384 + 2048;
#define RAW_DMA(sl_) do { int ln_ = lane; asm volatile("" : "+v"(ln_)); _Pragma("unroll") for (int u_ = 0; u_ < 4; ++u_) { const int slot_ = u_ * 8 + wid; if (slot_ < 26) { int pi = slot_ * 64 + ln_; pi = pi < 1632 ? pi : 1631; \
            const int clx = pi / 408, rem = pi - clx * 408, row = rem / 24, r2 = rem - row * 24, seg = r2 >> 3, p16 = r2 & 7; int tt = (cq * 4 + clx) * CHT + (sl_) * 16 - 1 + row; tt = tt < 0 ? 0 : tt; \
            __builtin_amdgcn_global_load_lds((const unsigned*)(P + (size_t)(b * T + tt) * NP + (seg == 0 ? C_R : seg == 1 ? C_K : C_V) + h * 64 + p16 * 8), (LAS unsigned*)(LASP(rawbuf) + slot_ * 1024), 16, 0, 0); } } \
              \
            _Pragma("unroll") for (int u_ = 0; u_ < 2; ++u_) { const int j_ = u_ * 8 + wid, clx = j_ >> 2, part = (j_ >> 1) & 1, half = j_ & 1; \
            const unsigned char* src_ = p.ws + (part ? OFF_ALF : OFF_LWF) + ((size_t)(bh * 512 + (((cq * 4 + clx) * CHT + (sl_) * 16) >> 4)) * 4) * 64 * 8 + half * 1024 + ln_ * 16; \
            __builtin_amdgcn_global_load_lds((const unsigned*)src_, (LAS unsigned*)(LASP(bfrag) + clx * 4096 + part * 2048 + half * 1024), 16, 0, 0); } } while (0)
        RAW_DMA(0);
#pragma unroll 1
        for (int sl = 0; sl < CHT / 16; ++sl) {
            const int tb = (cq * 4 + cl) * CHT + sl * 16;
            __syncthreads();
            if (role == 0) stage16s<0>(p, rawbuf + cl * 6528, bfrag + cl * 4096, cst, h, bh, tb, ck + cl * 16 * 384, bon, Lb);
            else           stage16s<1>(p, rawbuf + cl * 6528, bfrag + cl * 4096, cst, h, bh, tb, ck + cl * 16 * 384, bon, Lb);
            __syncthreads();
            if (sl + 1 < CHT / 16) RAW_DMA(sl + 1);
            float yo[4];
            if (role == 0) {
#pragma unroll 1
                for (int i = 0; i < 16; ++i) { rwkv_step_s<0>(z, ck + (cl * 16 + i) * 384, q, g, yo);
                    qh[(size_t)(tb + i) * 64 + 4 * g + q] = f2bf(q == 0 ? yo[0] : q == 1 ? yo[1] : q == 2 ? yo[2] : yo[3]); } }
            else {
#pragma unroll 1
                for (int i = 0; i < 16; ++i) { rwkv_step_s<1>(z, ck + (cl * 16 + i) * 384, q, g, yo);
                    YA[(size_t)(b * T + tb + i) * 512 + h * 64 + 4 * g + q] = f2bf(q == 0 ? yo[0] : q == 1 ? yo[1] : q == 2 ? yo[2] : yo[3]); } }
        }
        {
            float* gC = (float*)(lds + 64 * 384 * 4 + 16384) + wid * 64;
            __syncthreads();
            if ((lane >> 4) == 0) {
#pragma unroll
                for (int nt = 0; nt < 4; ++nt) gC[16 * nt + (lane & 15)] = __expf(fmaxf(Lb[nt], -80.f));
            }
            asm volatile("s_waitcnt lgkmcnt(0)" ::: "memory");
#pragma unroll
            for (int u = 0; u < 4; ++u) { const f32x4 g4 = *(const f32x4*)(gC + 16 * q + 4 * u);
#pragma unroll
                for (int rr = 0; rr < 4; ++rr)
#pragma unroll
                    for (int e = 0; e < 4; ++e) z[rr][2 * u + (e >> 1)][e & 1] *= g4[e]; }
        }
        for (int pass = 0; pass < 2; ++pass) {
            __syncthreads();
            if (role == pass) {
#pragma unroll
                for (int rr = 0; rr < 4; ++rr)
#pragma unroll
                    for (int u = 0; u < 4; ++u) *(f32x4*)(mat + (cl * 64 + 4 * g + rr) * 68 + 16 * q + 4 * u) = (f32x4){z[rr][2 * u][0], z[rr][2 * u][1], z[rr][2 * u + 1][0], z[rr][2 * u + 1][1]};
            }
            __syncthreads();
            int tidb = threadIdx.x; asm volatile("" : "+v"(tidb));
            if (pass == 0) {
                for (int it = tidb; it < 4 * 8 * 64; it += NTHREADS) {
                    const int clx = it >> 9, f = (it >> 6) & 7, l = it & 63, n16 = l & 15, gg = l >> 4, fi = f >> 1, fs = f & 1;
                    const size_t chunk = (size_t)bh * NCHUNK + cq * 4 + clx;
                    unsigned hi[4], lo[4];
#pragma unroll
                    for (int e2 = 0; e2 < 4; ++e2) {
                        unsigned short hs[2], ls[2];
#pragma unroll
                        for (int d = 0; d < 2; ++d) { const int e = 2 * e2 + d, kin = 32 * fs + 16 * (e >> 2) + 4 * gg + (e & 3), kout = 16 * fi + n16;
                            const float val = mat[(clx * 64 + kin) * 68 + kout]; hs[d] = f2bf(val); ls[d] = f2bf(val - bf2f(hs[d])); }
                        hi[e2] = (unsigned)hs[0] | ((unsigned)hs[1] << 16); lo[e2] = (unsigned)ls[0] | ((unsigned)ls[1] << 16);
                    }
                    unsigned char* dst = fr + OFF_AF + chunk * AF_BYTES + (size_t)((f * 2) * 64 + l) * 16;
                    *(uint4*)dst = make_uint4(hi[0], hi[1], hi[2], hi[3]);
                    *(uint4*)(dst + 64 * 16) = make_uint4(lo[0], lo[1], lo[2], lo[3]);
                }
            } else {
                for (int it = tidb; it < 4 * 4 * 4 * 64; it += NTHREADS) {
                    const int l = it & 63, fi = (it >> 6) & 3, w4 = (it >> 8) & 3, clx = it >> 10, gg = l >> 4;
                    const size_t chunk = (size_t)bh * NCHUNK + cq * 4 + clx;
                    const f32x4 v4 = *(const f32x4*)(mat + (clx * 64 + 16 * w4 + (l & 15)) * 68 + 16 * fi + 4 * gg);
                    *(f32x4*)(fr + OFF_NF + chunk * NF_BYTES + (size_t)(((w4 * 4 + fi) * 64 + l) * 4) * 4) = v4;
                }
            }
        }
    }
}

DI void split4x2(const f32x4& xa, const f32x4& xb, bf16x8& hi, bf16x8& lo) {
#pragma unroll
    for (int e = 0; e < 4; ++e) { const float va = xa[e], vb = xb[e]; const bf16_t ha = f2bf(va), hb = f2bf(vb);
        hi[e] = (short)ha; hi[4 + e] = (short)hb; lo[e] = (short)f2bf(va - bf2f(ha)); lo[4 + e] = (short)f2bf(vb - bf2f(hb)); }
}
DI void phase_rwkv_scan(const Params& p, unsigned char* lds, const int bh) {
    unsigned char* fr = (unsigned char*)p.out;
    const int tid = threadIdx.x, lane = tid & 63, wid = tid >> 6;
    const unsigned char* gA = fr + OFF_AF + (size_t)bh * NCHUNK * AF_BYTES;
    unsigned char* gN = fr + OFF_NF + (size_t)bh * NCHUNK * NF_BYTES;
    const bool loader = wid >= 4;
    const int wl = __builtin_amdgcn_readfirstlane(wid - 4);
#define SCAN_DMA(cc_) do { const unsigned char* ga_ = gA + (size_t)(cc_) * AF_BYTES + wl * 4096 + lane * 16; const unsigned char* gn_ = gN + (size_t)(cc_) * NF_BYTES + wl * 4096 + lane * 16; \
        __attribute__((address_space(3))) unsigned char* sl_ = LASP(lds) + ((cc_) & 3) * 32768 + wl * 4096; \
        _Pragma("unroll") for (int j_ = 0; j_ < 4; ++j_) __builtin_amdgcn_global_load_lds((const unsigned*)(ga_ + j_ * 1024), (__attribute__((address_space(3))) unsigned*)(sl_ + j_ * 1024), 16, 0, 0); \
        _Pragma("unroll") for (int j_ = 0; j_ < 4; ++j_) __builtin_amdgcn_global_load_lds((const unsigned*)(gn_ + j_ * 1024), (__attribute__((address_space(3))) unsigned*)(sl_ + 16384 + j_ * 1024), 16, 0, 0); } while (0)
    __syncthreads();
    if (loader) { SCAN_DMA(0); SCAN_DMA(1); SCAN_DMA(2); SCAN_DMA(3); asm volatile("s_waitcnt vmcnt(0)" ::: "memory"); }
    f32x4 X[4];
#pragma unroll
    for (int i = 0; i < 4; ++i) X[i] = (f32x4){0.f, 0.f, 0.f, 0.f};
    bf16x8 ah[8], al[8]; f32x4 nt[4];
#define SCAN_FRAGS(cc_) do { const unsigned char* s_ = lds + ((cc_) & 3) * 32768; \
        _Pragma("unroll") for (int f = 0; f < 8; ++f) { ah[f] = *(const bf16x8*)(s_ + ((f * 2) * 64 + lane) * 16); al[f] = *(const bf16x8*)(s_ + ((f * 2 + 1) * 64 + lane) * 16); } \
        _Pragma("unroll") for (int i = 0; i < 4; ++i) nt[i] = *(const f32x4*)(s_ + 16384 + ((wid * 4 + i) * 64 + lane) * 16); } while (0)
    asm volatile("s_waitcnt lgkmcnt(0)" ::: "memory"); __builtin_amdgcn_s_barrier(); asm volatile("" ::: "memory");
    if (!loader) SCAN_FRAGS(0);
    for (int c = 0; c < (int)NCHUNK; ++c) {
        if (loader) {
            if (c + 4 < (int)NCHUNK) { SCAN_DMA(c + 4); asm volatile("s_waitcnt vmcnt(16)" ::: "memory"); } else asm volatile("s_waitcnt vmcnt(0)" ::: "memory");
        } else {
            const int w4 = wid;
            float* gs = (float*)(gN + (size_t)c * NF_BYTES) + ((w4 * 4) * 64 + lane) * 4;
#pragma unroll
            for (int i = 0; i < 4; ++i) *(f32x4*)(gs + i * 256) = X[i];
            bf16x8 bhi[2], blo[2];
            split4x2(X[0], X[1], bhi[0], blo[0]); split4x2(X[2], X[3], bhi[1], blo[1]);
#pragma unroll
            for (int i = 0; i < 4; ++i) {
                f32x4 D = nt[i];
#pragma unroll
                for (int s = 0; s < 2; ++s) {
                    const int f = i * 2 + s;
                    D = __builtin_amdgcn_mfma_f32_16x16x32_bf16(ah[f], bhi[s], D, 0, 0, 0);
                    D = __builtin_amdgcn_mfma_f32_16x16x32_bf16(ah[f], blo[s], D, 0, 0, 0);
                    D = __builtin_amdgcn_mfma_f32_16x16x32_bf16(al[f], bhi[s], D, 0, 0, 0);
                }
                X[i] = D;
            }
            if (c + 1 < (int)NCHUNK) SCAN_FRAGS(c + 1);
        }
        asm volatile("s_waitcnt lgkmcnt(0)" ::: "memory"); __builtin_amdgcn_s_barrier(); asm volatile("" ::: "memory");
    }
    asm volatile("s_waitcnt vmcnt(0)" ::: "memory");
    __syncthreads();
    if (tid == 0) {
        __builtin_amdgcn_fence(__ATOMIC_RELEASE, "agent");
        asm volatile("s_waitcnt vmcnt(0)" ::: "memory");
        __hip_atomic_store((unsigned*)(p.ws + OFF_CTL + 32768 + 256) + bh, 1u, __ATOMIC_RELAXED, __HIP_MEMORY_SCOPE_AGENT);
    }
}

DI void rwkv_out_item(const Params& p, unsigned char* lds, const int item) {
    const bf16_t* P = (const bf16_t*)(p.ws + OFF_P); bf16_t* YA = (bf16_t*)(p.ws + OFF_YA);
    const unsigned char* fr = (const unsigned char*)p.out;
    int tid = threadIdx.x; asm volatile("" : "+v"(tid));
    const int lane = tid & 63, wid = __builtin_amdgcn_readfirstlane(tid >> 6), c = lane & 31, hh = lane >> 5;
    {
        const int chunkg = item * 2 + (wid >> 2), bh = chunkg >> 6, cc = chunkg & 63, b = bh >> 3, h = bh & 7, tt = wid & 3;
        const int t = cc * CHT + tt * 32 + c;
        const float* sf = (const float*)(fr + OFF_NF + (size_t)chunkg * NF_BYTES);
        const bf16_t* qh = (const bf16_t*)(fr + OFF_QH) + ((size_t)bh * T + t) * 64;
        bf16x8 qf[4];
#pragma unroll
        for (int ks = 0; ks < 4; ++ks) qf[ks] = *(const bf16x8*)(qh + 16 * ks + 8 * hh);
        f32x16 yt[2];
#pragma unroll
        for (int vt = 0; vt < 2; ++vt) {
#pragma unroll
            for (int i = 0; i < 16; ++i) yt[vt][i] = 0.f;
#pragma unroll
            for (int ks = 0; ks < 4; ++ks) {
                const int v = 32 * vt + c;
                const float* s0 = sf + (((v >> 4) * 4 + ks) * 64 + (v & 15) + 32 * hh) * 4;
                const f32x4 lo4 = *(const f32x4*)s0, hi4 = *(const f32x4*)(s0 + 64);
                bf16x8 ah, al;
#pragma unroll
                for (int e = 0; e < 4; ++e) { const bf16_t h0 = f2bf(lo4[e]), h1 = f2bf(hi4[e]); ah[e] = (short)h0; ah[4 + e] = (short)h1;
                    al[e] = (short)f2bf(lo4[e] - bf2f(h0)); al[4 + e] = (short)f2bf(hi4[e] - bf2f(h1)); }
                yt[vt] = MFMA32(ah, qf[ks], yt[vt]);
                yt[vt] = MFMA32(al, qf[ks], yt[vt]);
            }
        }
        const size_t row = (size_t)(b * T + t);
        bf16_t* yrow = YA + row * 512 + h * 64;
        float s1 = 0.f;
#pragma unroll
        for (int vt = 0; vt < 2; ++vt)
#pragma unroll
            for (int gq = 0; gq < 4; ++gq) {
                const uint2 yl = *(const uint2*)(yrow + 32 * vt + 8 * gq + 4 * hh);
                yt[vt][4 * gq] += __uint_as_float(yl.x << 16); yt[vt][4 * gq + 1] += __uint_as_float(yl.x & 0xffff0000u);
                yt[vt][4 * gq + 2] += __uint_as_float(yl.y << 16); yt[vt][4 * gq + 3] += __uint_as_float(yl.y & 0xffff0000u);
                s1 += (yt[vt][4 * gq] + yt[vt][4 * gq + 1]) + (yt[vt][4 * gq + 2] + yt[vt][4 * gq + 3]);
            }
        s1 += __shfl_xor(s1, 32, 64);
        const float mean = s1 * (1.f / 64.f);
        float s2 = 0.f;
#pragma unroll
        for (int vt = 0; vt < 2; ++vt)
#pragma unroll
            for (int i = 0; i < 16; ++i) { yt[vt][i] -= mean; s2 += yt[vt][i] * yt[vt][i]; }
        s2 += __shfl_xor(s2, 32, 64);
        const float rstd = rsqrtf(s2 * (1.f / 64.f) + 64e-5f);
        const float bon = *((const float*)(fr + OFF_BON) + (size_t)bh * T + t);
        const bf16_t* pr = P + row * NP; const bool hp = t > 0;
#pragma unroll
        for (int vt = 0; vt < 2; ++vt)
#pragma unroll
            for (int gq = 0; gq < 4; ++gq) {
                const int v0 = 32 * vt + 8 * gq + 4 * hh, ch = h * 64 + v0;
                const uint2 vc = *(const uint2*)(pr + C_V + ch), vp = hp ? *(const uint2*)(pr - NP + C_V + ch) : make_uint2(0u, 0u), zz = *(const uint2*)(pr + C_ZA + ch);
                const f32x4 mu = *(const f32x4*)(p.mu_rkv + 1024 + ch), lg = *(const f32x4*)(p.lnx_g + ch), lb = *(const f32x4*)(p.lnx_b + ch);
                float o[4];
#pragma unroll
                for (int e = 0; e < 4; ++e) {
                    const unsigned wc = e < 2 ? vc.x : vc.y, wp = e < 2 ? vp.x : vp.y, wz = e < 2 ? zz.x : zz.y;
                    const float vcur = (e & 1) ? __uint_as_float(wc & 0xffff0000u) : __uint_as_float(wc << 16), vprv = (e & 1) ? __uint_as_float(wp & 0xffff0000u) : __uint_as_float(wp << 16);
                    const float zv = (e & 1) ? __uint_as_float(wz & 0xffff0000u) : __uint_as_float(wz << 16);
                    const float vmix = vcur + (vprv - vcur) * mu[e];
                    o[e] = (yt[vt][4 * gq + e] * rstd * lg[e] + lb[e] + bon * vmix) * siluf_(zv);
                }
                *(uint2*)(yrow + v0) = make_uint2(pk2f(o[0], o[1]), pk2f(o[2], o[3]));
            }
    }
}

DI void phase_swa_simple(const Params& p, unsigned char* lds, const int bid, const int nb) {
    const bf16_t* P = (const bf16_t*)(p.ws + OFF_P); bf16_t* YB = (bf16_t*)(p.ws + OFF_YB);
    const long total = (long)BATCH * 8 * T;
    for (long it = (long)bid * NTHREADS + threadIdx.x; it < total; it += (long)nb * NTHREADS) {
        const int t = (int)(it % T), qh = (int)((it / T) % 8), b = (int)(it / ((long)T * 8)), kvh = qh >> 2;
        const size_t row = (size_t)(b * T + t);
        float q[64], acc[64];
        {
            const uint4* qp = (const uint4*)(P + row * NP + C_Q + qh * 64);
#pragma unroll
            for (int i = 0; i < 8; ++i) { const uint4 u = qp[i]; const unsigned w[4] = {u.x, u.y, u.z, u.w};
#pragma unroll
                for (int j = 0; j < 4; ++j) { q[i * 8 + j * 2] = __uint_as_float(w[j] << 16); q[i * 8 + j * 2 + 1] = __uint_as_float(w[j] & 0xffff0000u); } }
        }
#pragma unroll
        for (int d = 0; d < 64; ++d) acc[d] = 0.f;
        float m = p.sinks[qh], l = 1.f;
        for (int j = 0; j < 128; ++j) {
            const int s = t - 127 + j;
            if (s < 0) continue;
            const size_t krow = (size_t)(b * T + s) * NP;
            const uint4* kp = (const uint4*)(P + krow + C_SK + kvh * 64);
            float dot = 0.f;
#pragma unroll
            for (int i = 0; i < 8; ++i) { const uint4 u = kp[i]; const unsigned w[4] = {u.x, u.y, u.z, u.w};
#pragma unroll
                for (int jj = 0; jj < 4; ++jj) { dot += q[i * 8 + jj * 2] * __uint_as_float(w[jj] << 16) + q[i * 8 + jj * 2 + 1] * __uint_as_float(w[jj] & 0xffff0000u); } }
            const float sc = dot * 0.125f;
            const float mn = fmaxf(m, sc), corr = __expf(m - mn), pe = __expf(sc - mn);
            l = l * corr + pe; m = mn;
            const uint4* vp = (const uint4*)(P + krow + C_SV + kvh * 64);
#pragma unroll
            for (int i = 0; i < 8; ++i) { const uint4 u = vp[i]; const unsigned w[4] = {u.x, u.y, u.z, u.w};
#pragma unroll
                for (int jj = 0; jj < 4; ++jj) { acc[i * 8 + jj * 2] = acc[i * 8 + jj * 2] * corr + pe * __uint_as_float(w[jj] << 16);
                                                 acc[i * 8 + jj * 2 + 1] = acc[i * 8 + jj * 2 + 1] * corr + pe * __uint_as_float(w[jj] & 0xffff0000u); } }
        }
        const float inv = 1.f / l;
        const bf16_t* zp = P + row * NP + C_ZB + qh * 64; bf16_t* op = YB + row * 512 + qh * 64;
#pragma unroll
        for (int d = 0; d < 64; ++d) op[d] = f2bf(acc[d] * inv * siluf_(bf2f(zp[d])));
    }
}

DI void phase_xattn_simple(const Params& p, unsigned char* lds, const int bid, const int nb) {
    const bf16_t* P = (const bf16_t*)(p.ws + OFF_P); const bf16_t* KVM = (const bf16_t*)(p.ws + OFF_KVM); bf16_t* YC = (bf16_t*)(p.ws + OFF_YC);
    const int lane = threadIdx.x & 63, wid = threadIdx.x >> 6;
    const long total = (long)M * 4;
    const float scale = 0.08838834764831845f;
    for (long it = (long)bid * NWAVES + wid; it < total; it += (long)nb * NWAVES) {
        const int row = (int)(it >> 2), hd = (int)(it & 3), b = row / T;
        const bf16_t* qp = P + (size_t)row * NP + C_XQ + hd * 128;
        const bf16_t* kb = KVM + (size_t)(b * MEMLEN) * 1024 + hd * 128;
        float s[4] = {0.f, 0.f, 0.f, 0.f};
        for (int c = 0; c < 16; ++c) {
            const uint4 qu = *(const uint4*)(qp + c * 8); const unsigned qw[4] = {qu.x, qu.y, qu.z, qu.w};
#pragma unroll
            for (int i = 0; i < 4; ++i) {
                const uint4 ku = *(const uint4*)(kb + (size_t)(lane + 64 * i) * 1024 + c * 8); const unsigned kw[4] = {ku.x, ku.y, ku.z, ku.w};
#pragma unroll
                for (int j = 0; j < 4; ++j) s[i] += __uint_as_float(qw[j] << 16) * __uint_as_float(kw[j] << 16) + __uint_as_float(qw[j] & 0xffff0000u) * __uint_as_float(kw[j] & 0xffff0000u);
            }
        }
        float mx = -1e30f;
#pragma unroll
        for (int i = 0; i < 4; ++i) { s[i] *= scale; mx = fmaxf(mx, s[i]); }
        mx = wave_max(mx);
        float pe[4], sum = 0.f;
#pragma unroll
        for (int i = 0; i < 4; ++i) { pe[i] = __expf(s[i] - mx); sum += pe[i]; }
        sum = wave_sum(sum);
        const float inv = 1.f / sum;
        float o0 = 0.f, o1 = 0.f;
        const bf16_t* vb = kb + 512;
#pragma unroll
        for (int i = 0; i < 4; ++i)
            for (int mm = 0; mm < 64; ++mm) {
                const float pv = __shfl(pe[i], mm, 64);
                const bf16_t* vr = vb + (size_t)(mm + 64 * i) * 1024;
                o0 += pv * bf2f(vr[lane]); o1 += pv * bf2f(vr[lane + 64]);
            }
        const bf16_t* zp = P + (size_t)row * NP + C_ZC + hd * 128; bf16_t* op = YC + (size_t)row * 512 + hd * 128;
        op[lane] = f2bf(o0 * inv * siluf_(bf2f(zp[lane]))); op[lane + 64] = f2bf(o1 * inv * siluf_(bf2f(zp[lane + 64])));
    }
}

typedef short s16x4 __attribute__((ext_vector_type(4)));
DI int crow(int reg, int hh) { return (reg & 3) + 8 * (reg >> 2) + 4 * hh; }
template <int Dh> DI unsigned k_off(int row, int chunk) { return (unsigned)(row * (Dh * 2) + ((chunk ^ (row & (Dh / 8 - 1))) << 4)); }
DI bf16x8 pack8(const f32x16& x, int s) {
    bf16x8 r;
#pragma unroll
    for (int e = 0; e < 8; ++e) r[e] = (short)f2bf(x[8 * s + e]);
    return r;
}
DI unsigned pk2(float lo, float hi) { typedef float f2_ __attribute__((ext_vector_type(2))); typedef __bf16 b2_ __attribute__((ext_vector_type(2))); return __builtin_bit_cast(unsigned, __builtin_convertvector((f2_){lo, hi}, b2_)); }
DI void unpack8(const uint4& v, float (&x)[8]) { const unsigned w[4] = {v.x, v.y, v.z, v.w};
#pragma unroll
    for (int i = 0; i < 4; ++i) { x[2 * i] = __uint_as_float(w[i] << 16); x[2 * i + 1] = __uint_as_float(w[i] & 0xffff0000u); } }
DI uint4 pack8f(const float (&x)[8]) { return make_uint4(pk2(x[0], x[1]), pk2(x[2], x[3]), pk2(x[4], x[5]), pk2(x[6], x[7])); }
constexpr int VS = 528;

DI void swa_unit(const Params& p, unsigned char* lds, int unit) {
    const bf16_t* P = (const bf16_t*)(p.ws + OFF_P); bf16_t* YB = (bf16_t*)(p.ws + OFF_YB);
    int tid = threadIdx.x; asm volatile("" : "+v"(tid));
    const int lane = tid & 63, wid = __builtin_amdgcn_readfirstlane(tid >> 6), c = lane & 31, hh = lane >> 5;
    const int n = unit & 63, kvh = (unit >> 6) & 1, b = unit >> 7;
    unsigned char* Kl = lds; unsigned char* Vt = lds + 32768;
    __syncthreads();
#pragma unroll
    for (int u = 0; u < 4; ++u) {
        const int idx = tid + 512 * u;
        { const int row = idx >> 3, chunk = idx & 7, t = n * 128 - 128 + row, tc = t < 0 ? 0 : t;
          const uint4 v = *(const uint4*)(P + (size_t)(b * T + tc) * NP + C_SK + kvh * 64 + chunk * 8);
          float x[8]; unpack8(v, x);
          float ss = 0.f;
#pragma unroll
          for (int e = 0; e < 8; ++e) ss += x[e] * x[e];
          ss = quad_sum(ss); ss += __shfl_xor(ss, 4, 64);
          const float rs = rsqrtf(ss * (1.f / 64.f) + 1e-6f);
          const float2* rp = (const float2*)(p.ws + OFF_ROPE) + (size_t)(b * T + tc) * 32 + (chunk & 3) * 8;
          float o[8];
#pragma unroll
          for (int e = 0; e < 8; ++e) { const float y = x[e] * rs * p.k_norm_g[chunk * 8 + e]; const float yp = __shfl_xor(y, 4, 64); const float2 cs = rp[e];
              o[e] = chunk < 4 ? y * cs.x - yp * cs.y : y * cs.x + yp * cs.y; if (t < 0) o[e] = 0.f; }
          *(uint4*)(Kl + k_off<64>(row, chunk)) = pack8f(o); }
        { const int row = idx >> 3, chunk = idx & 7, t = n * 128 - 128 + row;
          uint4 v = make_uint4(0u, 0u, 0u, 0u);
          if (t >= 0) v = *(const uint4*)(P + (size_t)(b * T + t) * NP + C_SV + kvh * 64 + chunk * 8);
          *(uint4*)(Vt + k_off<64>(row, chunk)) = v; }
    }
    __syncthreads();
    const int qh = kvh * 4 + (wid >> 1), rh = wid & 1;
    const float sink = p.sinks[qh];
#pragma unroll 2
    for (int rt = 0; rt < 2; ++rt) {
        const int base = 64 * rh + 32 * rt;
        const size_t qrow = (size_t)(b * T + n * 128 + base + c);
        bf16x8 qf[4];
        {
            float xq[4][8]; float ss = 0.f;
#pragma unroll
            for (int ds = 0; ds < 4; ++ds) { unpack8(*(const uint4*)(P + qrow * NP + C_Q + qh * 64 + 16 * ds + 8 * hh), xq[ds]);
#pragma unroll
                for (int e = 0; e < 8; ++e) ss += xq[ds][e] * xq[ds][e]; }
            ss += __shfl_xor(ss, 32, 64);
            const float rs = rsqrtf(ss * (1.f / 64.f) + 1e-6f);
#pragma unroll
            for (int ds = 0; ds < 4; ++ds)
#pragma unroll
                for (int e = 0; e < 8; ++e) xq[ds][e] *= rs * p.q_norm_g[16 * ds + 8 * hh + e];
            const float2* rp = (const float2*)(p.ws + OFF_ROPE) + qrow * 32 + 8 * hh;
#pragma unroll
            for (int ds = 0; ds < 2; ++ds) { float lo[8], hi[8];
#pragma unroll
                for (int e = 0; e < 8; ++e) { const float2 cs = rp[16 * ds + e]; lo[e] = xq[ds][e] * cs.x - xq[ds + 2][e] * cs.y; hi[e] = xq[ds + 2][e] * cs.x + xq[ds][e] * cs.y; }
                qf[ds] = __builtin_bit_cast(bf16x8, pack8f(lo)); qf[ds + 2] = __builtin_bit_cast(bf16x8, pack8f(hi)); }
        }
        f32x16 st[5];
#pragma unroll
        for (int kt = 0; kt < 5; ++kt) {
#pragma unroll
            for (int i = 0; i < 16; ++i) st[kt][i] = 0.f;
#pragma unroll
            for (int ds = 0; ds < 4; ++ds) { const bf16x8 a = *(const bf16x8*)(Kl + k_off<64>(base + 32 * kt + c, 2 * ds + hh)); st[kt] = MFMA32(a, qf[ds], st[kt]); }
        }
        float mx = sink;
#pragma unroll
        for (int kt = 0; kt < 5; ++kt)
#pragma unroll
            for (int i = 0; i < 16; ++i) {
                const int cr = crow(i, hh);
                bool ok = true;
                if (kt == 0) ok = cr > c;
                if (kt == 4) ok = cr <= c;
                if (n == 0) ok = ok && (base + 32 * kt + cr >= 128);
                const float s = ok ? st[kt][i] * 0.125f : -1e30f;
                st[kt][i] = s; mx = fmaxf(mx, s);
            }
        mx = fmaxf(mx, __shfl_xor(mx, 32, 64));
        float ls = 0.f;
#pragma unroll
        for (int kt = 0; kt < 5; ++kt)
#pragma unroll
            for (int i = 0; i < 16; ++i) { const float pe = __expf(st[kt][i] - mx); st[kt][i] = pe; ls += pe; }
        ls += __shfl_xor(ls, 32, 64);
        const float inv = 1.f / (ls + __expf(sink - mx));
        f32x16 ot[2];
#pragma unroll
        for (int dt = 0; dt < 2; ++dt)
#pragma unroll
            for (int i = 0; i < 16; ++i) ot[dt][i] = 0.f;
#pragma unroll
        for (int kt = 0; kt < 5; ++kt)
#pragma unroll
            for (int s = 0; s < 2; ++s) {
                const bf16x8 pf = pack8(st[kt], s);
#pragma unroll
                for (int dt = 0; dt < 2; ++dt) {
                    const int key0 = base + 32 * kt + 16 * s + 4 * hh + ((lane & 15) >> 2), ch16 = 4 * dt + 2 * ((lane >> 4) & 1) + ((lane & 3) >> 1), sub = (lane & 1) * 8;
                    const s16x4 lo = __builtin_amdgcn_ds_read_tr16_b64_v4i16((LAS s16x4*)(Vt + k_off<64>(key0, ch16) + sub));
                    const s16x4 hi = __builtin_amdgcn_ds_read_tr16_b64_v4i16((LAS s16x4*)(Vt + k_off<64>(key0 + 8, ch16) + sub));
                    const bf16x8 vf = __builtin_shufflevector(lo, hi, 0, 1, 2, 3, 4, 5, 6, 7);
                    ot[dt] = MFMA32(vf, pf, ot[dt]);
                }
            }
        const bf16_t* zp = P + qrow * NP + C_ZB + qh * 64; bf16_t* op = YB + qrow * 512 + qh * 64;
#pragma unroll
        for (int dt = 0; dt < 2; ++dt)
#pragma unroll
            for (int gq = 0; gq < 4; ++gq) {
                const int d0 = 32 * dt + 8 * gq + 4 * hh;
                const uint2 zz = *(const uint2*)(zp + d0);
                const float z0 = __uint_as_float(zz.x << 16), z1 = __uint_as_float(zz.x & 0xffff0000u), z2 = __uint_as_float(zz.y << 16), z3 = __uint_as_float(zz.y & 0xffff0000u);
                const unsigned o0 = (unsigned)f2bf(ot[dt][4 * gq] * inv * siluf_(z0)) | ((unsigned)f2bf(ot[dt][4 * gq + 1] * inv * siluf_(z1)) << 16);
                const unsigned o1 = (unsigned)f2bf(ot[dt][4 * gq + 2] * inv * siluf_(z2)) | ((unsigned)f2bf(ot[dt][4 * gq + 3] * inv * siluf_(z3)) << 16);
                *(uint2*)(op + d0) = make_uint2(o0, o1);
            }
    }
}

DI void xattn_unit(const Params& p, unsigned char* lds, int unit) {
    const bf16_t* P = (const bf16_t*)(p.ws + OFF_P); const bf16_t* KVM = (const bf16_t*)(p.ws + OFF_KVM); bf16_t* YC = (bf16_t*)(p.ws + OFF_YC);
    int tid = threadIdx.x; asm volatile("" : "+v"(tid));
    const int lane = tid & 63, wid = __builtin_amdgcn_readfirstlane(tid >> 6), c = lane & 31, hh = lane >> 5;
    const int qb = unit & 31, hd = (unit >> 5) & 3, b = unit >> 7;
    unsigned char* Kl = lds; unsigned char* Vt = lds + 65536;
    const bf16_t* kb = KVM + (size_t)(b * MEMLEN) * 1024 + hd * 128;
    __syncthreads();
#pragma unroll
    for (int u = 0; u < 8; ++u) {
        const int idx = tid + 512 * u;
        { const int row = idx >> 4, chunk = idx & 15;
          float x[8]; unpack8(*(const uint4*)(kb + (size_t)row * 1024 + chunk * 8), x);
          float ss = 0.f;
#pragma unroll
          for (int e = 0; e < 8; ++e) ss += x[e] * x[e];
          const float rs = rsqrtf(row16_sum(ss) * (1.f / 128.f) + 1e-6f);
#pragma unroll
          for (int e = 0; e < 8; ++e) x[e] *= rs * p.xk_norm_g[chunk * 8 + e];
          *(uint4*)(Kl + k_off<128>(row, chunk)) = pack8f(x); }
        { const int row = idx >> 4, chunk = idx & 15;
          *(uint4*)(Vt + k_off<128>(row, chunk)) = *(const uint4*)(kb + (size_t)row * 1024 + 512 + chunk * 8); }
    }
    __syncthreads();
    const size_t qrow = (size_t)(b * T + qb * 256 + wid * 32 + c);
    const float scale = 0.08838834764831845f;
    bf16x8 qf[8];
    {
        float ss = 0.f; uint4 raw[8];
#pragma unroll
        for (int ds = 0; ds < 8; ++ds) { raw[ds] = *(const uint4*)(P + qrow * NP + C_XQ + hd * 128 + 16 * ds + 8 * hh); float x[8]; unpack8(raw[ds], x);
#pragma unroll
            for (int e = 0; e < 8; ++e) ss += x[e] * x[e]; }
        ss += __shfl_xor(ss, 32, 64);
        const float rs = rsqrtf(ss * (1.f / 128.f) + 1e-6f);
#pragma unroll
        for (int ds = 0; ds < 8; ++ds) { float x[8]; unpack8(raw[ds], x);
#pragma unroll
            for (int e = 0; e < 8; ++e) x[e] *= rs * p.xq_norm_g[16 * ds + 8 * hh + e];
            qf[ds] = __builtin_bit_cast(bf16x8, pack8f(x)); }
    }
    f32x16 ot[4];
#pragma unroll
    for (int dt = 0; dt < 4; ++dt)
#pragma unroll
        for (int i = 0; i < 16; ++i) ot[dt][i] = 0.f;
    float mrun = -1e30f, lrun = 0.f;
#pragma unroll 1
    for (int half = 0; half < 2; ++half) {
        f32x16 st[4];
#pragma unroll
        for (int kt = 0; kt < 4; ++kt) {
#pragma unroll
            for (int i = 0; i < 16; ++i) st[kt][i] = 0.f;
#pragma unroll
            for (int ds = 0; ds < 8; ++ds) { const bf16x8 a = *(const bf16x8*)(Kl + k_off<128>(128 * half + 32 * kt + c, 2 * ds + hh)); st[kt] = MFMA32(a, qf[ds], st[kt]); }
        }
        float mx = mrun;
#pragma unroll
        for (int kt = 0; kt < 4; ++kt)
#pragma unroll
            for (int i = 0; i < 16; ++i) { st[kt][i] *= scale; mx = fmaxf(mx, st[kt][i]); }
        mx = fmaxf(mx, __shfl_xor(mx, 32, 64));
        const float corr = __expf(mrun - mx);
        float ls = 0.f;
#pragma unroll
        for (int kt = 0; kt < 4; ++kt)
#pragma unroll
            for (int i = 0; i < 16; ++i) { const float pe = __expf(st[kt][i] - mx); st[kt][i] = pe; ls += pe; }
        ls += __shfl_xor(ls, 32, 64);
        lrun = lrun * corr + ls; mrun = mx;
#pragma unroll
        for (int dt = 0; dt < 4; ++dt)
#pragma unroll
            for (int i = 0; i < 16; ++i) ot[dt][i] *= corr;
#pragma unroll
        for (int kt = 0; kt < 4; ++kt)
#pragma unroll
            for (int s = 0; s < 2; ++s) {
                const bf16x8 pf = pack8(st[kt], s);
#pragma unroll
                for (int dt = 0; dt < 4; ++dt) {
                    const int key0 = 128 * half + 32 * kt + 16 * s + 4 * hh + ((lane & 15) >> 2), ch16 = 4 * dt + 2 * ((lane >> 4) & 1) + ((lane & 3) >> 1), sub = (lane & 1) * 8;
                    const s16x4 lo = __builtin_amdgcn_ds_read_tr16_b64_v4i16((LAS s16x4*)(Vt + k_off<128>(key0, ch16) + sub));
                    const s16x4 hi = __builtin_amdgcn_ds_read_tr16_b64_v4i16((LAS s16x4*)(Vt + k_off<128>(key0 + 8, ch16) + sub));
                    const bf16x8 vf = __builtin_shufflevector(lo, hi, 0, 1, 2, 3, 4, 5, 6, 7);
                    ot[dt] = MFMA32(vf, pf, ot[dt]);
                }
            }
    }
    const float inv = 1.f / lrun;
    const bf16_t* zp = P + qrow * NP + C_ZC + hd * 128; bf16_t* op = YC + qrow * 512 + hd * 128;
#pragma unroll
    for (int dt = 0; dt < 4; ++dt)
#pragma unroll
        for (int gq = 0; gq < 4; ++gq) {
            const int d0 = 32 * dt + 8 * gq + 4 * hh;
            const uint2 zz = *(const uint2*)(zp + d0);
            const float z0 = __uint_as_float(zz.x << 16), z1 = __uint_as_float(zz.x & 0xffff0000u), z2 = __uint_as_float(zz.y << 16), z3 = __uint_as_float(zz.y & 0xffff0000u);
            const unsigned o0 = (unsigned)f2bf(ot[dt][4 * gq] * inv * siluf_(z0)) | ((unsigned)f2bf(ot[dt][4 * gq + 1] * inv * siluf_(z1)) << 16);
            const unsigned o1 = (unsigned)f2bf(ot[dt][4 * gq + 2] * inv * siluf_(z2)) | ((unsigned)f2bf(ot[dt][4 * gq + 3] * inv * siluf_(z3)) << 16);
            *(uint2*)(op + d0) = make_uint2(o0, o1);
        }
}
DI void phase_attn_queue(const Params& p, unsigned char* lds) {
    unsigned* head = (unsigned*)(p.ws + OFF_CTL + 32768);
    volatile LAS unsigned* bc = (volatile LAS unsigned*)(lds + LDS_CTL_OFF + 128);
    for (;;) {
        __syncthreads();
        if (threadIdx.x == 0) bc[0] = __hip_atomic_fetch_add(head, 1u, __ATOMIC_RELAXED, __HIP_MEMORY_SCOPE_AGENT);
        __syncthreads();
        const unsigned u = bc[0];
        if (u >= 1024u + 172u) break;
        if (u >= 512u && u < 684u) { convert_late(p, lds, (int)u - 512, 172); continue; }
        if (u < 512u) { if (u & 1u) xattn_unit(p, lds, (int)(u >> 1)); else swa_unit(p, lds, (int)(u >> 1)); }
        else {
            const int item = (int)u - 684, bh = item >> 5;
            if (threadIdx.x == 0) {
                unsigned* flag = (unsigned*)(p.ws + OFF_CTL + 32768 + 256) + bh; unsigned sp = 0;
                while (__hip_atomic_load(flag, __ATOMIC_RELAXED, __HIP_MEMORY_SCOPE_AGENT) == 0u) { __builtin_amdgcn_s_sleep(8); if (++sp > (1u << 22)) break; }
                __builtin_amdgcn_fence(__ATOMIC_ACQUIRE, "agent");
                asm volatile("s_waitcnt vmcnt(0)" ::: "memory");
            }
            __syncthreads();
            rwkv_out_item(p, lds, item);
        }
    }
}

namespace pg8 {
#define PG8_LAS __attribute__((address_space(3)))
typedef unsigned short bf16_t;
typedef short bf16x8 __attribute__((ext_vector_type(8)));
typedef float f32x4 __attribute__((ext_vector_type(4)));
typedef unsigned u32x4 __attribute__((ext_vector_type(4)));
constexpr int BM = 256, BK = 64, HALF = 128, HTB = HALF * BK * 2  , STAGE_BYTES = 8 * HTB, NXCD = 8, WGM = 8;

__host__ __device__ __forceinline__ int lds_byte(int r, int c) { const int st = (r >> 4) * 2 + (c >> 5), rr = r & 15, cc = c & 31, ob = rr * 64 + cc * 2; return st * 1024 + (ob ^ (((ob >> 9) & 1) << 5)); }
__host__ __device__ __forceinline__ void stage_rc(int b, int& R, int& C) { const int st = b / 1024, sb = b % 1024, swz = sb ^ (((sb >> 9) & 1) << 5); R = (st >> 1) * 16 + swz / 64; C = (st & 1) * 32 + (swz % 64) / 2; }
__host__ __device__ __forceinline__ int perm32(int rho) { const int n = rho >> 4, i = rho & 15; return 8 * (i >> 2) + 4 * n + (i & 3); }

struct Unit { int pm, pn; };
struct Gemm { const bf16_t* A; const bf16_t* Bt; int M, N, K; };

struct StaticOrder {
    int nM, nN, nwg, G, c;
    __host__ __device__ void init(int M, int N, int G_, int c_) { nM = M / BM; nN = N / BM; nwg = nM * nN; G = G_; c = c_; }
    __host__ __device__ bool next(int i, Unit& u) const {
        const long L = (long)i * G + c; if (L >= nwg) return false;
        int wgid = (int)L; { const int q = nwg / NXCD, r = nwg % NXCD, xcd = wgid % NXCD, off = wgid / NXCD; wgid = (xcd < r ? xcd * (q + 1) : r * (q + 1) + (xcd - r) * q) + off; }
        const int nig = WGM * nN, gid = wgid / nig, fm = gid * WGM, gsz = (nM - fm) < WGM ? (nM - fm) : WGM;
        u.pm = fm + ((wgid % nig) % gsz); u.pn = (wgid % nig) / gsz; return true;
    }
    __device__ __forceinline__ void a_ready(const Unit&) const {}
    __device__ __forceinline__ void done(const Unit&) const {}
};
__device__ __forceinline__ unsigned cvt_pk_bf16(float lo, float hi) { typedef float f2_ __attribute__((ext_vector_type(2))); typedef __bf16 b2_ __attribute__((ext_vector_type(2))); return __builtin_bit_cast(unsigned, __builtin_convertvector((f2_){lo, hi}, b2_)); }
typedef float f32x2 __attribute__((ext_vector_type(2)));
template <class Epi, class Sched, bool ALIGN_EPI = false, bool SP2 = false>
__device__ __forceinline__ void gemm_phase(PG8_LAS unsigned char* lds, const Gemm g, const Sched& S, const Epi& E) {
    int tid = threadIdx.x; asm volatile("" : "+v"(tid));
    const int wid = __builtin_amdgcn_readfirstlane(tid >> 6), lane = tid & 63, wr = wid >> 2, wc = wid & 3, fr = lane & 15, fq = lane >> 4;
    const int K = g.K, nt = K / BK;
    unsigned voffA[2], voffB[2];
#pragma unroll
    for (int i = 0; i < 2; ++i) { int R, C; stage_rc(tid * 16 + i * 8192, R, C); const int Rb = Epi::PERM ? ((R & ~31) + perm32(R & 31)) : R;
        voffA[i] = (unsigned)(R * K + C) * 2u; voffB[i] = (unsigned)(Rb * K + C) * 2u; }
    const size_t kstep = (size_t)(BK * 2);
    const size_t hstep = (size_t)HALF * K * 2;
    const size_t tstep = 2 * hstep;
    const unsigned ldsw = (unsigned)wid * 1024u;
    const int aoff = lds_byte(wr * 64 + fr, fq * 8), boff = lds_byte(wc * 32 + fr, fq * 8);
#define PG8_SA(b, h) (((b) * 2 + (h)) * HTB)
#define PG8_SB(b, h) ((4 + (b) * 2 + (h)) * HTB)
#define PG8_STAGE(bufoff, gbase, voff) do { _Pragma("unroll") for (int _i = 0; _i < 2; ++_i) \
        __builtin_amdgcn_global_load_lds((const unsigned*)((const char*)(gbase) + (voff)[_i]), (PG8_LAS unsigned*)(lds + (bufoff) + ldsw + _i * 8192), 16, 0, 0); } while (0)
#define PG8_LDA(dst, b, h) do { _Pragma("unroll") for (int m = 0; m < 4; ++m) _Pragma("unroll") for (int k = 0; k < 2; ++k) dst[m][k] = *(const PG8_LAS bf16x8*)(lds + PG8_SA(b, h) + aoff + m * 2048 + k * 1024); } while (0)
#define PG8_LDB(dst, b, h) do { _Pragma("unroll") for (int n = 0; n < 2; ++n) _Pragma("unroll") for (int k = 0; k < 2; ++k) dst[n][k] = *(const PG8_LAS bf16x8*)(lds + PG8_SB(b, h) + boff + n * 2048 + k * 1024); } while (0)
#define PG8_MMA(ai, bj, At, Bt) do { __builtin_amdgcn_s_setprio(1); _Pragma("unroll") for (int m = 0; m < 4; ++m) _Pragma("unroll") for (int n = 0; n < 2; ++n) _Pragma("unroll") for (int k = 0; k < 2; ++k) \
        acc[ai][bj][m][n] = __builtin_amdgcn_mfma_f32_16x16x32_bf16(Bt[n][k], At[m][k], acc[ai][bj][m][n], 0, 0, 0); __builtin_amdgcn_s_setprio(0); } while (0)
#define PG8_WAIT_V(n) asm volatile("s_waitcnt vmcnt(" #n ")" ::: "memory")
#define PG8_WAIT_L(n) asm volatile("s_waitcnt lgkmcnt(" #n ")" ::: "memory")
#define PG8_BAR __builtin_amdgcn_s_barrier()
#define PG8_SCHED __builtin_amdgcn_sched_barrier(0)
    Unit cur, nxt; int ui = 0;
    if (!S.next(0, cur)) return;
    f32x4 acc[2][2][4][2];
#pragma unroll
    for (int a = 0; a < 2; ++a)
#pragma unroll
        for (int b = 0; b < 2; ++b)
#pragma unroll
            for (int m = 0; m < 4; ++m)
#pragma unroll
                for (int n = 0; n < 2; ++n) acc[a][b][m][n] = (f32x4){0.f, 0.f, 0.f, 0.f};
    bf16x8 At[4][2], B0[2][2], B1[2][2];
    const char* cA = (const char*)g.A + (size_t)cur.pm * tstep; const char* cB = (const char*)g.Bt + (size_t)cur.pn * tstep;
    S.a_ready(cur);
    if constexpr (SP2) {
        PG8_STAGE(PG8_SB(0, 0), cB, voffB); PG8_STAGE(PG8_SB(0, 1), cB + hstep, voffB); PG8_STAGE(PG8_SA(0, 0), cA, voffA); PG8_STAGE(PG8_SA(0, 1), cA + hstep, voffA);
        if (wr == 1) PG8_BAR;
        PG8_WAIT_V(2); PG8_BAR;
        PG8_STAGE(PG8_SB(1, 0), cB + kstep, voffB); PG8_STAGE(PG8_SA(1, 0), cA + kstep, voffA); PG8_STAGE(PG8_SB(1, 1), cB + hstep + kstep, voffB);
        PG8_WAIT_V(6); PG8_BAR;
    } else {
        PG8_STAGE(PG8_SB(0, 0), cB, voffB); PG8_STAGE(PG8_SA(0, 0), cA, voffA); PG8_STAGE(PG8_SB(0, 1), cB + hstep, voffB); PG8_STAGE(PG8_SA(0, 1), cA + hstep, voffA);
        if (wr == 1) PG8_BAR;
        PG8_WAIT_V(4); PG8_BAR;
        PG8_STAGE(PG8_SB(1, 0), cB + kstep, voffB); PG8_STAGE(PG8_SA(1, 0), cA + kstep, voffA); PG8_STAGE(PG8_SB(1, 1), cB + hstep + kstep, voffB);
        PG8_WAIT_V(6); PG8_BAR;
    }
    for (;;) {
        const bool has_next = S.next(ui + 1, nxt);
        const char* nA = has_next ? (const char*)g.A + (size_t)nxt.pm * tstep : cA; const char* nB = has_next ? (const char*)g.Bt + (size_t)nxt.pn * tstep : cB;
        for (int t = 0; t < nt; t += 2) {
            const bool last = (t == nt - 2);
            const char* a1 = cA + (size_t)(t + 1) * kstep;
            const char* a2 = last ? nA : cA + (size_t)(t + 2) * kstep; const char* b2 = last ? nB : cB + (size_t)(t + 2) * kstep;
            const char* a3 = a2 + kstep; const char* b3 = b2 + kstep;
            if (last && has_next) S.a_ready(nxt);
            if constexpr (SP2) {
            PG8_LDB(B0, 0, 0); PG8_LDB(B1, 0, 1); PG8_SCHED; PG8_LDA(At, 0, 0); PG8_STAGE(PG8_SA(1, 1), a1 + hstep, voffA);
            PG8_WAIT_V(8); PG8_WAIT_L(0); PG8_BAR; PG8_MMA(0, 0, At, B0); PG8_MMA(0, 1, At, B1); PG8_BAR; PG8_SCHED;
            PG8_LDA(At, 0, 1); PG8_STAGE(PG8_SB(0, 0), b2, voffB); PG8_STAGE(PG8_SB(0, 1), b2 + hstep, voffB); PG8_STAGE(PG8_SA(0, 0), a2, voffA);
            PG8_WAIT_V(8); PG8_WAIT_L(0); PG8_BAR; PG8_MMA(1, 0, At, B0); PG8_MMA(1, 1, At, B1); PG8_BAR; PG8_SCHED;
            PG8_LDB(B0, 1, 0); PG8_LDB(B1, 1, 1); PG8_SCHED; PG8_LDA(At, 1, 0); PG8_STAGE(PG8_SA(0, 1), a2 + hstep, voffA);
            PG8_WAIT_V(8); PG8_WAIT_L(0); PG8_BAR; PG8_MMA(0, 0, At, B0); PG8_MMA(0, 1, At, B1); PG8_BAR; PG8_SCHED;
            PG8_LDA(At, 1, 1); PG8_STAGE(PG8_SB(1, 0), b3, voffB); PG8_STAGE(PG8_SB(1, 1), b3 + hstep, voffB); PG8_STAGE(PG8_SA(1, 0), a3, voffA);
            PG8_WAIT_V(8); PG8_WAIT_L(0); PG8_BAR; PG8_MMA(1, 0, At, B0); PG8_MMA(1, 1, At, B1); PG8_BAR; PG8_SCHED;
            } else {
            PG8_LDB(B0, 0, 0); PG8_SCHED; PG8_LDA(At, 0, 0); PG8_STAGE(PG8_SA(1, 1), a1 + hstep, voffA);
            PG8_WAIT_L(8); PG8_BAR; PG8_WAIT_L(0); PG8_MMA(0, 0, At, B0); PG8_BAR; PG8_SCHED;
            PG8_LDB(B1, 0, 1); PG8_STAGE(PG8_SB(0, 0), b2, voffB);
            PG8_BAR; PG8_WAIT_L(0); PG8_MMA(0, 1, At, B1); PG8_BAR;
            PG8_LDA(At, 0, 1); PG8_STAGE(PG8_SA(0, 0), a2, voffA);
            PG8_BAR; PG8_WAIT_L(0); PG8_MMA(1, 0, At, B0); PG8_BAR; PG8_SCHED;
            PG8_STAGE(PG8_SB(0, 1), b2 + hstep, voffB);
            PG8_WAIT_V(6); PG8_BAR; PG8_MMA(1, 1, At, B1); PG8_BAR;
            PG8_LDB(B0, 1, 0); PG8_SCHED; PG8_LDA(At, 1, 0); PG8_STAGE(PG8_SA(0, 1), a2 + hstep, voffA);
            PG8_WAIT_L(8); PG8_BAR; PG8_WAIT_L(0); PG8_MMA(0, 0, At, B0); PG8_BAR; PG8_SCHED;
            PG8_LDB(B1, 1, 1); PG8_STAGE(PG8_SB(1, 0), b3, voffB);
            PG8_BAR; PG8_WAIT_L(0); PG8_MMA(0, 1, At, B1); PG8_BAR;
            PG8_LDA(At, 1, 1); PG8_STAGE(PG8_SA(1, 0), a3, voffA);
            PG8_BAR; PG8_WAIT_L(0); PG8_MMA(1, 0, At, B0); PG8_BAR; PG8_SCHED;
            PG8_STAGE(PG8_SB(1, 1), b3 + hstep, voffB);
            PG8_WAIT_V(6); PG8_BAR; PG8_MMA(1, 1, At, B1); PG8_BAR;
            }
        }
        if constexpr (ALIGN_EPI) { if (wr == 0) PG8_BAR; }
        if constexpr (!Epi::AFTER_DRAIN) { E(acc, cur, wr, wc, fr, fq); S.done(cur); }
        if (!has_next) break;
        if constexpr (!Epi::CHAIN) {
#pragma unroll
        for (int a = 0; a < 2; ++a)
#pragma unroll
            for (int b = 0; b < 2; ++b)
#pragma unroll
                for (int m = 0; m < 4; ++m)
#pragma unroll
                    for (int n = 0; n < 2; ++n) acc[a][b][m][n] = (f32x4){0.f, 0.f, 0.f, 0.f};
        }
        cur = nxt; cA = nA; cB = nB; ++ui;
        if constexpr (ALIGN_EPI) { if (wr == 1) PG8_BAR; }
    }
    PG8_WAIT_V(0);
    if constexpr (!ALIGN_EPI) { if (wr == 0) PG8_BAR; }
    PG8_BAR;
    if constexpr (Epi::AFTER_DRAIN) { E.fused(acc, cur, wr, wc, fr, fq, lds, wid, lane); S.done(cur); }
#undef PG8_SA
#undef PG8_SB
#undef PG8_STAGE
#undef PG8_LDA
#undef PG8_LDB
#undef PG8_MMA
#undef PG8_WAIT_V
#undef PG8_WAIT_L
#undef PG8_BAR
#undef PG8_SCHED
}
}

namespace pg8 {
__device__ __forceinline__ void store16_wt(void* ptr, u32x4 v) { asm volatile("global_store_dwordx4 %0, %1, off sc1\n\ts_nop 1" :: "v"(ptr), "v"(v) : "memory"); }
template <int ACT> struct EpiStore {
    static constexpr bool PERM = true, AFTER_DRAIN = false, CHAIN = false;
    bf16_t* O; int ldc;
    __device__ __forceinline__ void operator()(const f32x4 (&acc)[2][2][4][2], const Unit& u, int wr, int wc, int fr, int fq) const {
        const int row0 = u.pm * BM + wr * 64 + fr, col0 = u.pn * BM + wc * 32 + 8 * fq;
#pragma unroll
        for (int ai = 0; ai < 2; ++ai)
#pragma unroll
            for (int m = 0; m < 4; ++m) { bf16_t* rowp = O + (size_t)(row0 + ai * HALF + m * 16) * ldc + col0;
#pragma unroll
                for (int bj = 0; bj < 2; ++bj) { f32x4 v0 = acc[ai][bj][m][0], v1 = acc[ai][bj][m][1];
                    if (ACT == 1) {
#pragma unroll
                        for (int e = 0; e < 4; ++e) { v0[e] = __builtin_amdgcn_rcpf(1.f + __expf(-v0[e])); v1[e] = __builtin_amdgcn_rcpf(1.f + __expf(-v1[e])); } }
                    u32x4 w; w.x = cvt_pk_bf16(v0[0], v0[1]); w.y = cvt_pk_bf16(v0[2], v0[3]); w.z = cvt_pk_bf16(v1[0], v1[1]); w.w = cvt_pk_bf16(v1[2], v1[3]);
                    store16_wt(rowp + bj * HALF, w); } }
    }
};
template <bool ACCUM> struct EpiProj {
    static constexpr bool PERM = true, AFTER_DRAIN = false, CHAIN = false;
    bf16_t* MG; const bf16_t* SG; int gcol0;
    __device__ __forceinline__ void operator()(const f32x4 (&acc)[2][2][4][2], const Unit& u, int wr, int wc, int fr, int fq) const {
        const int row0 = u.pm * BM + wr * 64 + fr, col0 = u.pn * BM + wc * 32 + 8 * fq;
#pragma unroll
        for (int ai = 0; ai < 2; ++ai)
#pragma unroll
            for (int m = 0; m < 4; ++m) { const size_t row = (size_t)(row0 + ai * HALF + m * 16);
#pragma unroll
                for (int bj = 0; bj < 2; ++bj) {
                    const int col = col0 + bj * HALF;
                    const u32x4 gw = *(const u32x4*)(SG + row * 3072 + gcol0 + col);
                    u32x4 ow = (u32x4){0u, 0u, 0u, 0u};
                    if (ACCUM) ow = *(const u32x4*)(MG + row * 1024 + col);
                    float r[8];
#pragma unroll
                    for (int e = 0; e < 4; ++e) {
                        const float g0 = __uint_as_float(gw[e] << 16), g1 = __uint_as_float(gw[e] & 0xffff0000u);
                        const float a0 = e < 2 ? acc[ai][bj][m][0][2 * e] : acc[ai][bj][m][1][2 * e - 4], a1 = e < 2 ? acc[ai][bj][m][0][2 * e + 1] : acc[ai][bj][m][1][2 * e - 3];
                        r[2 * e] = g0 * a0; r[2 * e + 1] = g1 * a1;
                        if (ACCUM) { r[2 * e] += __uint_as_float(ow[e] << 16); r[2 * e + 1] += __uint_as_float(ow[e] & 0xffff0000u); }
                    }
                    u32x4 w; w.x = cvt_pk_bf16(r[0], r[1]); w.y = cvt_pk_bf16(r[2], r[3]); w.z = cvt_pk_bf16(r[4], r[5]); w.w = cvt_pk_bf16(r[6], r[7]);
                    *(u32x4*)(MG + row * 1024 + col) = w; } }
    }
};
struct ProjOrder {
    int pm, pn, valid;
    __host__ __device__ bool next(int i, Unit& u) const { if (!valid || i >= 3) return false; u.pm = i * 64 + pm; u.pn = i * 4 + pn; return true; }
    __device__ __forceinline__ void a_ready(const Unit&) const {}
    __device__ __forceinline__ void done(const Unit&) const {}
};
struct EpiProj3 {
    static constexpr bool PERM = true, AFTER_DRAIN = false, CHAIN = false;
    bf16_t* MG; const bf16_t* SG;
    __device__ __forceinline__ void operator()(const f32x4 (&acc)[2][2][4][2], const Unit& u, int wr, int wc, int fr, int fq) const {
        const int br = u.pm >> 6, pm = u.pm & 63, pn = u.pn & 3, gcol0 = br * 1024;
        const int row0 = pm * BM + wr * 64 + fr, col0 = pn * BM + wc * 32 + 8 * fq;
#pragma unroll
        for (int ai = 0; ai < 2; ++ai)
#pragma unroll
            for (int m = 0; m < 4; ++m) { const size_t row = (size_t)(row0 + ai * HALF + m * 16);
#pragma unroll
                for (int bj = 0; bj < 2; ++bj) {
                    const int col = col0 + bj * HALF;
                    const u32x4 gw = *(const u32x4*)(SG + row * 3072 + gcol0 + col);
                    u32x4 ow = (u32x4){0u, 0u, 0u, 0u};
                    if (br > 0) ow = *(const u32x4*)(MG + row * 1024 + col);
                    float r[8];
#pragma unroll
                    for (int e = 0; e < 4; ++e) {
                        const float g0 = __uint_as_float(gw[e] << 16), g1 = __uint_as_float(gw[e] & 0xffff0000u);
                        const float a0 = e < 2 ? acc[ai][bj][m][0][2 * e] : acc[ai][bj][m][1][2 * e - 4], a1 = e < 2 ? acc[ai][bj][m][0][2 * e + 1] : acc[ai][bj][m][1][2 * e - 3];
                        r[2 * e] = g0 * a0 + __uint_as_float(ow[e] << 16); r[2 * e + 1] = g1 * a1 + __uint_as_float(ow[e] & 0xffff0000u);
                    }
                    u32x4 w; w.x = cvt_pk_bf16(r[0], r[1]); w.y = cvt_pk_bf16(r[2], r[3]); w.z = cvt_pk_bf16(r[4], r[5]); w.w = cvt_pk_bf16(r[6], r[7]);
                    *(u32x4*)(MG + row * 1024 + col) = w; } }
    }
};
struct GateOrder {
    int pm, pn, valid;
    __host__ __device__ bool next(int i, Unit& u) const { if (!valid || i >= 3) return false; u.pm = pm; u.pn = (2 - i) * 4 + pn; return true; }
    __device__ __forceinline__ void a_ready(const Unit&) const {}
    __device__ __forceinline__ void done(const Unit&) const {}
};
struct EpiGateR {
    static constexpr bool PERM = true, AFTER_DRAIN = false, CHAIN = false;
    bf16_t* SG;
    __device__ __forceinline__ void operator()(const f32x4 (&acc)[2][2][4][2], const Unit& u, int wr, int wc, int fr, int fq) const {
        const int br = u.pn >> 2, pn = u.pn & 3;
        const int row0 = u.pm * BM + wr * 64 + fr, col0 = pn * BM + wc * 32 + 8 * fq;
#pragma unroll
        for (int ai = 0; ai < 2; ++ai)
#pragma unroll
            for (int m = 0; m < 4; ++m) { bf16_t* rowp = SG + (size_t)(row0 + ai * HALF + m * 16) * 3072 + col0;
#pragma unroll
                for (int bj = 0; bj < 2; ++bj) {
                    float s[8];
#pragma unroll
                    for (int e = 0; e < 4; ++e) { s[e] = __builtin_amdgcn_rcpf(1.f + __expf(-acc[ai][bj][m][0][e])); s[4 + e] = __builtin_amdgcn_rcpf(1.f + __expf(-acc[ai][bj][m][1][e])); }
                    if (br < 2) {
                        u32x4 d = *(const u32x4*)(rowp + 2048 + bj * HALF);
                        float den[8];
#pragma unroll
                        for (int e = 0; e < 4; ++e) { den[2 * e] = __uint_as_float(d[e] << 16); den[2 * e + 1] = __uint_as_float(d[e] & 0xffff0000u); }
                        if (br == 0) { const u32x4 d1 = *(const u32x4*)(rowp + 1024 + bj * HALF);
#pragma unroll
                            for (int e = 0; e < 4; ++e) { den[2 * e] *= __uint_as_float(d1[e] << 16); den[2 * e + 1] *= __uint_as_float(d1[e] & 0xffff0000u); } }
#pragma unroll
                        for (int e = 0; e < 8; ++e) s[e] *= __builtin_amdgcn_rcpf(den[e]);
                    }
                    u32x4 w; w.x = cvt_pk_bf16(s[0], s[1]); w.y = cvt_pk_bf16(s[2], s[3]); w.z = cvt_pk_bf16(s[4], s[5]); w.w = cvt_pk_bf16(s[6], s[7]);
                    *(u32x4*)(rowp + br * 1024 + bj * HALF) = w; } }
    }
};
struct EpiProjChain {
    static constexpr bool PERM = true, AFTER_DRAIN = false, CHAIN = true;
    bf16_t* MG; const bf16_t* SG;
    __device__ __forceinline__ void operator()(f32x4 (&acc)[2][2][4][2], const Unit& u, int wr, int wc, int fr, int fq) const {
        const int br = u.pm >> 6, pm = u.pm & 63, pn = u.pn & 3;
        const int row0 = pm * BM + wr * 64 + fr, col0 = pn * BM + wc * 32 + 8 * fq;
#pragma unroll
        for (int ai = 0; ai < 2; ++ai)
#pragma unroll
            for (int m = 0; m < 4; ++m) { const size_t row = (size_t)(row0 + ai * HALF + m * 16);
#pragma unroll
                for (int bj = 0; bj < 2; ++bj) {
                    const int col = col0 + bj * HALF;
                    const u32x4 gw = *(const u32x4*)(SG + row * 3072 + br * 1024 + col);
#pragma unroll
                    for (int e = 0; e < 4; ++e) {
                        const float g0 = __uint_as_float(gw[e] << 16), g1 = __uint_as_float(gw[e] & 0xffff0000u);
                        if (e < 2) { acc[ai][bj][m][0][2 * e] *= g0; acc[ai][bj][m][0][2 * e + 1] *= g1; } else { acc[ai][bj][m][1][2 * e - 4] *= g0; acc[ai][bj][m][1][2 * e - 3] *= g1; }
                    }
                    if (br == 2) {
                        u32x4 w; w.x = cvt_pk_bf16(acc[ai][bj][m][0][0], acc[ai][bj][m][0][1]); w.y = cvt_pk_bf16(acc[ai][bj][m][0][2], acc[ai][bj][m][0][3]);
                        w.z = cvt_pk_bf16(acc[ai][bj][m][1][0], acc[ai][bj][m][1][1]); w.w = cvt_pk_bf16(acc[ai][bj][m][1][2], acc[ai][bj][m][1][3]);
                        *(u32x4*)(MG + row * 1024 + col) = w; } } }
    }
};
struct EpiOut {
    static constexpr bool PERM = false, AFTER_DRAIN = false, CHAIN = false;
    const float* X; float* O;
    __device__ __forceinline__ void operator()(const f32x4 (&acc)[2][2][4][2], const Unit& u, int wr, int wc, int fr, int fq) const {
        const int row0 = u.pm * BM + wr * 64 + fr, col0 = u.pn * BM + wc * 32 + 4 * fq;
#pragma unroll
        for (int ai = 0; ai < 2; ++ai)
#pragma unroll
            for (int m = 0; m < 4; ++m) { const size_t off = (size_t)(row0 + ai * HALF + m * 16) * 1024 + col0;
#pragma unroll
                for (int bj = 0; bj < 2; ++bj)
#pragma unroll
                    for (int n = 0; n < 2; ++n) { const f32x4 xv = *(const f32x4*)(X + off + bj * HALF + n * 16); *(f32x4*)(O + off + bj * HALF + n * 16) = xv + acc[ai][bj][m][n]; } }
    }
};
}

DI void phase_gemm_gate(const Params& p, unsigned char* lds, const int bid, const int nb) {
    unsigned char* ws = p.ws;
    const bf16_t* H = (const bf16_t*)(ws + OFF_H); const bf16_t* Wt = (const bf16_t*)(ws + OFF_WIN) + (size_t)C_G * 1024;
    bf16_t* SG = (bf16_t*)(ws + OFF_SG);
    const int tn = 3072 / 128, nt = (M / 128) * tn;
    for (int it = bid; it < nt; it += nb) {
        GemmTile g; gemm_zero(g);
        const int m0 = (it / tn) * 128, n0 = (it % tn) * 128;
        gemm_tile_k(g, H, 1024, Wt, 1024, m0, n0, 1024, lds);
        GEMM_FOREACH(SG[(size_t)row * 3072 + col] = f2bf(sigmoidf_(g.acc[mi][ni][r])););
    }
}
DI void phase_gemm_proj(const Params& p, unsigned char* lds, const int bid, const int nb) {
    unsigned char* ws = p.ws;
    const bf16_t* SG = (const bf16_t*)(ws + OFF_SG); bf16_t* MG = (bf16_t*)(ws + OFF_MG);
    const int tn = 1024 / 128, nt = (M / 128) * tn;
    for (int it = bid; it < nt; it += nb) {
        const int m0 = (it / tn) * 128, n0 = (it % tn) * 128;
        GemmTile mg; gemm_zero(mg);
#pragma unroll 1
        for (int br = 0; br < 3; ++br) {
            GemmTile g; gemm_zero(g);
            const bf16_t* Y = (const bf16_t*)(ws + (br == 0 ? OFF_YA : br == 1 ? OFF_YB : OFF_YC));
            const bf16_t* W = (const bf16_t*)(ws + (br == 0 ? OFF_WPA : br == 1 ? OFF_WPB : OFF_WPC));
            gemm_tile_k(g, Y, 512, W, 512, m0, n0, 512, lds);
            GEMM_FOREACH(mg.acc[mi][ni][r] += bf2f(SG[(size_t)row * 3072 + br * 1024 + col]) * g.acc[mi][ni][r];);
        }
        GEMM_FOREACH(MG[(size_t)row * 1024 + col] = f2bf(mg.acc[mi][ni][r]););
    }
}
DI void phase_gemm_out(const Params& p, unsigned char* lds, const int bid, const int nb) {
    unsigned char* ws = p.ws;
    const bf16_t* MG = (const bf16_t*)(ws + OFF_MG); const bf16_t* W = (const bf16_t*)(ws + OFF_WO);
    const int tn = 1024 / 128, nt = (M / 128) * tn;
    for (int it = bid; it < nt; it += nb) {
        GemmTile g; gemm_zero(g);
        const int m0 = (it / tn) * 128, n0 = (it % tn) * 128;
        gemm_tile_k(g, MG, 1024, W, 1024, m0, n0, 1024, lds);
        GEMM_FOREACH(p.out[(size_t)row * 1024 + col] = p.x[(size_t)row * 1024 + col] + g.acc[mi][ni][r];);
    }
}

DI void phase_gemm_in_fast(const Params& p, unsigned char* lds, const int bid, const int nb) {
    unsigned char* ws = p.ws;
    {
        pg8::Gemm g{(const bf16_t*)(ws + OFF_H), (const bf16_t*)(ws + OFF_WIN), M, NP, 1024}; pg8::StaticOrder S; S.init(M, NP, nb, bid);
        pg8::EpiStore<0> E{(bf16_t*)(ws + OFF_P), NP};
        pg8::gemm_phase<pg8::EpiStore<0>, pg8::StaticOrder, true, true>(LASP(lds), g, S, E);
    }
    __syncthreads();
    const int tn2 = 1024 / 128, nt2 = (MM / 128) * tn2;
    for (int it = bid - nb / 2; it >= 0 && it < nt2; it += nb) {
        GemmTile g; gemm_zero(g);
        const int m0 = (it / tn2) * 128, n0 = (it % tn2) * 128;
        gemm_tile_k(g, (const bf16_t*)(ws + OFF_HM), 1024, (const bf16_t*)(ws + OFF_WKV), 1024, m0, n0, 1024, lds);
        bf16_t* KVM = (bf16_t*)(ws + OFF_KVM);
        GEMM_FOREACH(KVM[(size_t)row * 1024 + col] = f2bf(g.acc[mi][ni][r]););
    }
}
DI void phase_gemm_gate_fast(const Params& p, unsigned char* lds, const int bid, const int nb) {
    unsigned char* ws = p.ws;
    pg8::Gemm g{(const bf16_t*)(ws + OFF_H), (const bf16_t*)(ws + OFF_WIN) + (size_t)C_G * 1024, M, 3072, 1024};
    pg8::StaticOrder S; S.init(M, 1024, nb, bid);
    pg8::Unit own; const bool has = S.next(0, own);
    pg8::GateOrder O{own.pm, own.pn, has ? 1 : 0};
    pg8::EpiGateR E{(bf16_t*)(ws + OFF_SG)};
    pg8::gemm_phase<pg8::EpiGateR, pg8::GateOrder, true, true>(LASP(lds), g, O, E);
}
DI void phase_gemm_proj_fast(const Params& p, unsigned char* lds, const int bid, const int nb) {
    unsigned char* ws = p.ws;
    bf16_t* MG = (bf16_t*)(ws + OFF_MG); const bf16_t* SG = (const bf16_t*)(ws + OFF_SG);
    pg8::StaticOrder S; S.init(M, 1024, nb, bid);
    { pg8::Gemm g{(const bf16_t*)(ws + OFF_YA), (const bf16_t*)(ws + OFF_WPA), M, 1024, 512}; pg8::EpiProj<false> E{MG, SG, 0};
      pg8::gemm_phase<pg8::EpiProj<false>, pg8::StaticOrder, true, true>(LASP(lds), g, S, E); }
    { pg8::Gemm g{(const bf16_t*)(ws + OFF_YB), (const bf16_t*)(ws + OFF_WPB), M, 1024, 512}; pg8::EpiProj<true> E{MG, SG, 1024};
      pg8::gemm_phase<pg8::EpiProj<true>, pg8::StaticOrder, true, true>(LASP(lds), g, S, E); }
    { pg8::Gemm g{(const bf16_t*)(ws + OFF_YC), (const bf16_t*)(ws + OFF_WPC), M, 1024, 512}; pg8::EpiProj<true> E{MG, SG, 2048};
      pg8::gemm_phase<pg8::EpiProj<true>, pg8::StaticOrder, true, true>(LASP(lds), g, S, E); }
}
DI void phase_gemm_proj3(const Params& p, unsigned char* lds, const int bid, const int nb) {
    unsigned char* ws = p.ws;
    static_assert(OFF_YB == OFF_YA + (size_t)M * 512 * 2 && OFF_YC == OFF_YB + (size_t)M * 512 * 2 && OFF_WPB == OFF_WPA + (size_t)1024 * 512 * 2 && OFF_WPC == OFF_WPB + (size_t)1024 * 512 * 2, "contiguous branches");
    pg8::StaticOrder S; S.init(M, 1024, nb, bid);
    pg8::Unit own; const bool has = S.next(0, own);
    pg8::ProjOrder O{own.pm, own.pn, has ? 1 : 0};
    pg8::Gemm g{(const bf16_t*)(ws + OFF_YA), (const bf16_t*)(ws + OFF_WPA), 3 * M, 3072, 512};
    pg8::EpiProjChain E{(bf16_t*)(ws + OFF_MG), (const bf16_t*)(ws + OFF_SG)};
    pg8::gemm_phase<pg8::EpiProjChain, pg8::ProjOrder, true, true>(LASP(lds), g, O, E);
}
DI void phase_gemm_out_fast(const Params& p, unsigned char* lds, const int bid, const int nb) {
    unsigned char* ws = p.ws;
    pg8::Gemm g{(const bf16_t*)(ws + OFF_MG), (const bf16_t*)(ws + OFF_WO), M, 1024, 1024}; pg8::StaticOrder S; S.init(M, 1024, nb, bid);
    pg8::EpiOut E{p.x, p.out};
    pg8::gemm_phase<pg8::EpiOut, pg8::StaticOrder, true, true>(LASP(lds), g, S, E);
}

#define XB_TMO      128
#define XB_XCNT(j)  (256  + 64 * (j))
#define XB_XSUB(j)  (1280 + 64 * (j))
#define XB_XGEN(j)  (2304 + 64 * (j))
#define XB_TOP      3328
#define XB_TOPGEN   3392
#define XCD_BAR_WORDS 3456
#define XB_SPIN_CAP (1u << 22)
DI unsigned xb_ld(unsigned* p)              { return __hip_atomic_load(p, __ATOMIC_RELAXED, __HIP_MEMORY_SCOPE_AGENT); }
DI unsigned xb_add(unsigned* p, unsigned v) { return __hip_atomic_fetch_add(p, v, __ATOMIC_RELAXED, __HIP_MEMORY_SCOPE_AGENT); }
DI unsigned xb_xcc_id() { return (unsigned)__builtin_amdgcn_s_getreg((3 << 11) | 20) & 0xFu; }
#define XB_SPIN(cond, bar) do { unsigned _sp = 0; while (cond) { __builtin_amdgcn_s_sleep(1); \
    if ((++_sp & 255u) == 0u) { if (xb_ld(&(bar)[XB_TMO])) break; if (_sp > XB_SPIN_CAP) { atomicAdd(&(bar)[XB_TMO], 1u); break; } } } } while (0)
struct XcdBarrier { unsigned* bar; unsigned x; volatile LAS unsigned* st; };
DI XcdBarrier xcd_barrier_post(unsigned* bar, volatile LAS unsigned* st) {
    XcdBarrier b; b.bar = bar; b.x = xb_xcc_id(); b.st = st;
    if (threadIdx.x == 0) (void)xb_add(&bar[XB_XCNT(b.x)], 1u);
    return b;
}
DI void xcd_barrier_complete(unsigned* bar, unsigned x, unsigned& nloc, unsigned& nx) {
    const unsigned G = gridDim.x * gridDim.y * gridDim.z;
    unsigned sum, cnt, mine, sp = 0u;
    for (;;) {
        sum = 0u; cnt = 0u; mine = 0u;
#pragma unroll
        for (unsigned j = 0; j < 16; ++j) { const unsigned c = xb_ld(&bar[XB_XCNT(j)]); sum += c; cnt += (c > 0u) ? 1u : 0u; mine = (j == x) ? c : mine; }
        if (sum == G) break;
        __builtin_amdgcn_s_sleep(1);
        if ((++sp & 255u) == 0u) { if (xb_ld(&bar[XB_TMO])) break; if (sp > XB_SPIN_CAP) { atomicAdd(&bar[XB_TMO], 1u); break; } }
    }
    nloc = mine > 0u ? mine : 1u; nx = cnt > 0u ? cnt : 1u;
}
DI void xcd_barrier(const XcdBarrier& b) {
    asm volatile("s_waitcnt vmcnt(0)" ::: "memory");
    __syncthreads();
    if (threadIdx.x == 0) {
        unsigned* bar = b.bar;
        __builtin_amdgcn_s_waitcnt(0);
        unsigned nloc = b.st[0], nx = b.st[1];
        if (nloc == 0u) { xcd_barrier_complete(bar, b.x, nloc, nx); b.st[0] = nloc; b.st[1] = nx; }
        const unsigned old = xb_add(&bar[XB_XSUB(b.x)], 1u);
        const unsigned gen = old / nloc;
        if (old + 1u == (gen + 1u) * nloc) {
            __builtin_amdgcn_fence(__ATOMIC_RELEASE, "agent");
            asm volatile("s_waitcnt vmcnt(0)" ::: "memory");
            const unsigned og = xb_add(&bar[XB_TOP], 1u);
            const unsigned tg = og / nx;
            if (og + 1u == (tg + 1u) * nx) xb_add(&bar[XB_TOPGEN], 1u);
            else XB_SPIN(xb_ld(&bar[XB_TOPGEN]) == tg, bar);
            __builtin_amdgcn_fence(__ATOMIC_ACQUIRE, "agent");
            xb_add(&bar[XB_XGEN(b.x)], 1u);
            asm volatile("s_waitcnt vmcnt(0)" ::: "memory");
        } else {
            XB_SPIN(xb_ld(&bar[XB_XGEN(b.x)]) == gen, bar);
            __builtin_amdgcn_fence(__ATOMIC_ACQUIRE, "agent");
            asm volatile("s_waitcnt vmcnt(0)" ::: "memory");
        }
    }
    __syncthreads();
}

__global__ void __launch_bounds__(NTHREADS, 2) k_mega(Params p) {
    extern __shared__ __attribute__((aligned(16))) unsigned char lds[];
    volatile LAS unsigned* st = (volatile LAS unsigned*)(lds + LDS_CTL_OFF);
    if (threadIdx.x == 0) { st[0] = 0u; st[1] = 0u; st[2] = 0u; st[3] = 0u; }
    __syncthreads();
    (void)xcd_barrier_post((unsigned*)(p.ws + OFF_CTL), st);
#define GRID_BAR() do { XcdBarrier b_; b_.bar = (unsigned*)(p.ws + OFF_CTL); b_.x = xb_xcc_id(); b_.st = (volatile LAS unsigned*)(lds + LDS_CTL_OFF); xcd_barrier(b_); } while (0)
    const int bid = blockIdx.x, nb = gridDim.x;
#ifndef REPMASK
#define REPMASK 0
#endif
#ifndef REPCNT
#define REPCNT 1
#endif
#ifndef STAMP_PH
#define STAMP_PH -1
#endif
    volatile LAS unsigned* stp = (volatile LAS unsigned*)(lds + LDS_CTL_OFF + 64);
    int nst = 0;
#define STAMP() do { if (STAMP_PH >= 0 && blockIdx.x == 0 && threadIdx.x == 0) stp[nst] = (unsigned)__builtin_amdgcn_s_memrealtime(); ++nst; } while (0)
    STAMP();
#define REP(bit_, call_) do { call_; if (REPMASK & (bit_)) { for (int rep_ = 0; rep_ < REPCNT; ++rep_) { __syncthreads(); call_; } } } while (0)
    REP(1, phase_prologue(p, lds, bid, nb));
    GRID_BAR(); STAMP();
    REP(2, phase_gemm_in_fast(p, lds, bid, nb));
    GRID_BAR(); STAMP();
    REP(8, phase_rwkv_prep(p, lds, bid, nb));
    GRID_BAR(); STAMP();
    if (bid < 16) phase_rwkv_scan(p, lds, bid);
    phase_attn_queue(p, lds);
    GRID_BAR(); STAMP();
    REP(64, phase_gemm_gate_fast(p, lds, bid, nb));
    __syncthreads(); STAMP();
    phase_gemm_proj3(p, lds, bid, nb);
    GRID_BAR(); STAMP();
    REP(256, phase_gemm_out_fast(p, lds, bid, nb));
    if (STAMP_PH >= 0) { GRID_BAR(); STAMP();
        if (blockIdx.x == 0) {
            float* sm = (float*)lds; float best = 1e30f; int bi = 0;
            for (int i = threadIdx.x; i < 65536; i += NTHREADS) { const float a = fabsf(p.out[i]); if (a < best) { best = a; bi = i; } }
            sm[threadIdx.x] = best; ((int*)sm)[512 + threadIdx.x] = bi;
            __syncthreads();
            if (threadIdx.x == 0) {
                for (int i = 1; i < NTHREADS; ++i) if (sm[i] < best) { best = sm[i]; bi = ((int*)sm)[512 + i]; }
                const float tot = (float)(stp[nst - 1] - stp[0]); const float ph = STAMP_PH < 20 ? (float)(stp[STAMP_PH + 1] - stp[STAMP_PH]) : tot * 0.5f;
                const float v = STAMP_PH == 99 ? 0.04f + tot * 1e-6f : 0.05f + 0.1f * ph / tot; p.out[bi] += v; }
        } }
}

extern "C" void kernel_launch(void* const* d_in, const int* in_sizes, int n_in, void* d_out, int out_size, void* d_ws, size_t ws_size, hipStream_t stream) {
    static int grid = 0;
    if (grid == 0) {
        if (n_in != 27 || ws_size < WS_END) { fprintf(stderr, "kernel_launch: unexpected inputs (n_in %d, ws %zu)\n", n_in, ws_size); grid = -1; return; }
        int dev = 0, cus = 0, per_cu = 0;
        if (hipGetDevice(&dev) != hipSuccess || hipDeviceGetAttribute(&cus, hipDeviceAttributeMultiprocessorCount, dev) != hipSuccess) { grid = -1; return; }
        if (hipFuncSetAttribute((const void*)k_mega, hipFuncAttributeMaxDynamicSharedMemorySize, LDS_BYTES) != hipSuccess) { fprintf(stderr, "kernel_launch: hipFuncSetAttribute failed\n"); grid = -1; return; }
        if (hipOccupancyMaxActiveBlocksPerMultiprocessor(&per_cu, (const void*)k_mega, NTHREADS, LDS_BYTES) != hipSuccess || per_cu < 1)
            fprintf(stderr, "kernel_launch: occupancy query reports %d workgroups per CU\n", per_cu);
        (void)hipGetLastError();
        grid = cus;
        if (grid < 32) { fprintf(stderr, "kernel_launch: too few CUs (%d)\n", grid); grid = -1; return; }
    }
    if (grid < 0) return;
    if (hipMemsetAsync((char*)d_ws + OFF_CTL, 0, 65536, stream) != hipSuccess) { fprintf(stderr, "kernel_launch: memset failed\n"); return; }
    Params p{};
    p.x = (const float*)d_in[0]; p.mem = (const float*)d_in[1]; p.pos = (const int*)d_in[2]; p.norm_g = (const float*)d_in[3]; p.mem_norm_g = (const float*)d_in[4];
    p.w_in = (const float*)d_in[5]; p.mu_rkv = (const float*)d_in[6]; p.mu_wa = (const float*)d_in[7]; p.w0 = (const float*)d_in[8]; p.w2 = (const float*)d_in[9];
    p.a0 = (const float*)d_in[10]; p.a2 = (const float*)d_in[11]; p.k_k = (const float*)d_in[12]; p.k_a = (const float*)d_in[13]; p.r_k = (const float*)d_in[14];
    p.lnx_g = (const float*)d_in[15]; p.lnx_b = (const float*)d_in[16]; p.q_norm_g = (const float*)d_in[17]; p.k_norm_g = (const float*)d_in[18]; p.sinks = (const float*)d_in[19];
    p.xq_norm_g = (const float*)d_in[20]; p.xk_norm_g = (const float*)d_in[21]; p.w_mem_kv = (const float*)d_in[22]; p.w_proj_a = (const float*)d_in[23];
    p.w_proj_b = (const float*)d_in[24]; p.w_proj_c = (const float*)d_in[25]; p.w_out = (const float*)d_in[26];
    p.out = (float*)d_out; p.ws = (unsigned char*)d_ws;
    hipLaunchKernelGGL(k_mega, dim3(grid), dim3(NTHREADS), LDS_BYTES, stream, p);
}
```

```cpp
#include <hip/hip_runtime.h>
#include <stdint.h>
#include <stdio.h>

#define DI __device__ __forceinline__
#define LASP(p_) ((__attribute__((address_space(3))) unsigned char*)(p_))
typedef unsigned short bf16_t;
typedef short bf16x8 __attribute__((ext_vector_type(8)));
typedef float f32x4 __attribute__((ext_vector_type(4)));

constexpr int BATCH = 2, T = 8192, M = BATCH * T, D = 1024, NIN = 7552, NP = 4608  ;
constexpr int MEMLEN = 256, MM = BATCH * MEMLEN;
constexpr int C_R = 0, C_K = 512, C_V = 1024, C_W = 1536, C_A = 1600, C_ZA = 1664, C_Q = 2176, C_SK = 2688, C_SV = 2816, C_ZB = 2944, C_XQ = 3456, C_ZC = 3968, C_G = 4480;
constexpr int NTHREADS = 512, NWAVES = 8;
constexpr int LDS_BYTES = 147456;
constexpr int LDS_CTL_OFF = LDS_BYTES - 256;
#ifndef STAMP_PH
#define STAMP_PH -1
#endif
#define R1STAMP(k_) do { if (STAMP_PH >= 30 && blockIdx.x == 0 && threadIdx.x == 0) ((volatile __attribute__((address_space(3))) unsigned*)(lds + LDS_CTL_OFF + 64))[16 + (k_)] = (unsigned)__builtin_amdgcn_s_memrealtime(); } while (0)
#define R1ACC(k_, t0_) do { if (STAMP_PH >= 30 && blockIdx.x == 0 && threadIdx.x == 0) ((volatile __attribute__((address_space(3))) unsigned*)(lds + LDS_CTL_OFF + 64))[24 + (k_)] += (unsigned)__builtin_amdgcn_s_memrealtime() - (t0_); } while (0)
#define LAS __attribute__((address_space(3)))

constexpr size_t OFF_CTL = 0;
constexpr size_t OFF_WIN = 65536;
constexpr size_t OFF_WKV = OFF_WIN + (size_t)7680 * 1024 * 2;
constexpr size_t OFF_WPA = OFF_WKV + (size_t)1024 * 1024 * 2;
constexpr size_t OFF_WPB = OFF_WPA + (size_t)1024 * 512 * 2;
constexpr size_t OFF_WPC = OFF_WPB + (size_t)1024 * 512 * 2;
constexpr size_t OFF_WO  = OFF_WPC + (size_t)1024 * 512 * 2;
constexpr size_t OFF_H   = OFF_WO + (size_t)1024 * 1024 * 2;
constexpr size_t OFF_HM  = OFF_H + (size_t)M * 1024 * 2;
constexpr size_t OFF_KVM = OFF_HM + (size_t)MM * 1024 * 2;
constexpr size_t OFF_ROPE = OFF_KVM + (size_t)MM * 1024 * 2;
constexpr size_t OFF_P   = OFF_ROPE + (size_t)M * 32 * 8;
constexpr size_t OFF_YA  = OFF_P + (size_t)M * NP * 2;
constexpr size_t OFF_YB  = OFF_YA + (size_t)M * 512 * 2;
constexpr size_t OFF_YC  = OFF_YB + (size_t)M * 512 * 2;
constexpr size_t WS_END  = OFF_YC + (size_t)M * 512 * 2;
constexpr size_t OFF_SG  = OFF_P;
constexpr size_t OFF_MG  = OFF_P + (size_t)M * 3072 * 2;
static_assert(WS_END <= (size_t)256 * 1024 * 1024, "workspace");
static_assert(OFF_MG + (size_t)M * 1024 * 2 <= OFF_YA, "overlay");

struct Params {
    const float* x; const float* mem; const int* pos; const float* norm_g; const float* mem_norm_g; const float* w_in;
    const float* mu_rkv; const float* mu_wa; const float* w0; const float* w2; const float* a0; const float* a2;
    const float* k_k; const float* k_a; const float* r_k; const float* lnx_g; const float* lnx_b;
    const float* q_norm_g; const float* k_norm_g; const float* sinks; const float* xq_norm_g; const float* xk_norm_g;
    const float* w_mem_kv; const float* w_proj_a; const float* w_proj_b; const float* w_proj_c; const float* w_out;
    float* out; unsigned char* ws;
};

DI bf16_t f2bf(float x) { return __builtin_bit_cast(unsigned short, (__bf16)x); }
DI float bf2f(bf16_t h) { return __uint_as_float(((unsigned)h) << 16); }
DI float wave_sum(float v) {
#pragma unroll
    for (int o = 32; o > 0; o >>= 1) v += __shfl_xor(v, o, 64);
    return v;
}
DI float wave_max(float v) {
#pragma unroll
    for (int o = 32; o > 0; o >>= 1) v = fmaxf(v, __shfl_xor(v, o, 64));
    return v;
}
DI float sigmoidf_(float x) { return __builtin_amdgcn_rcpf(1.f + __expf(-x)); }
DI float siluf_(float x) { return x * __builtin_amdgcn_rcpf(1.f + __expf(-x)); }

DI void transpose_convert(const float* W, int K, int N, bf16_t* Wt, int item, float* tile  ) {
    int tid = threadIdx.x; asm volatile("" : "+v"(tid));
    const int tn = N / 64, kt = item / tn, nt = item % tn;
    __syncthreads();
#pragma unroll
    for (int u = 0; u < 2; ++u) { const int idx = tid + NTHREADS * u, r = idx >> 4, c4 = idx & 15;
        *(f32x4*)(tile + r * 68 + c4 * 4) = *(const f32x4*)(W + (size_t)(kt * 64 + r) * N + nt * 64 + c4 * 4); }
    __syncthreads();
    {
        const int n = tid >> 3, k8 = tid & 7;
        unsigned w[4];
#pragma unroll
        for (int e2 = 0; e2 < 4; ++e2) w[e2] = (unsigned)f2bf(tile[(k8 * 8 + 2 * e2) * 68 + n]) | ((unsigned)f2bf(tile[(k8 * 8 + 2 * e2 + 1) * 68 + n]) << 16);
        *(uint4*)(Wt + (size_t)(nt * 64 + n) * K + kt * 64 + k8 * 8) = make_uint4(w[0], w[1], w[2], w[3]);
    }
}

DI void convert_late(const Params& p, unsigned char* lds, const int vb, const int nvb) {
    float* tile = (float*)lds; unsigned char* ws = p.ws;
    const int n_g = 16 * (NIN / 64 - 72), n_pr = (512 / 64) * 16, n_o = 16 * 16, total = n_g + 3 * n_pr + n_o;
    for (int it = vb * 8; it < vb * 8 + 8 && it < total; ++it) {
        int i = it;
        if (i < n_g) { const int kt = i / (NIN / 64 - 72), nt = 72 + i % (NIN / 64 - 72); transpose_convert(p.w_in, 1024, NIN, (bf16_t*)(ws + OFF_WIN), kt * (NIN / 64) + nt, tile); continue; } i -= n_g;
        if (i < n_pr) { transpose_convert(p.w_proj_a, 512, 1024, (bf16_t*)(ws + OFF_WPA), i, tile); continue; } i -= n_pr;
        if (i < n_pr) { transpose_convert(p.w_proj_b, 512, 1024, (bf16_t*)(ws + OFF_WPB), i, tile); continue; } i -= n_pr;
        if (i < n_pr) { transpose_convert(p.w_proj_c, 512, 1024, (bf16_t*)(ws + OFF_WPC), i, tile); continue; } i -= n_pr;
        transpose_convert(p.w_out, 1024, 1024, (bf16_t*)(ws + OFF_WO), i, tile);
    }
}
DI void phase_prologue(const Params& p, unsigned char* lds, const int bid, const int nb) {
    float* tile = (float*)lds;
    unsigned char* ws = p.ws;
    const int n_in = (1024 / 64) * 72, n_kv = 16 * 16;
    for (int it = bid; it < n_in + n_kv; it += nb) {
        if (it < n_in) { const int kt = it / 72, nt = it % 72; transpose_convert(p.w_in, 1024, NIN, (bf16_t*)(ws + OFF_WIN), kt * (NIN / 64) + nt, tile); }
        else transpose_convert(p.w_mem_kv, 1024, 1024, (bf16_t*)(ws + OFF_WKV), it - n_in, tile);
    }
    const int lane = threadIdx.x & 63, wid = threadIdx.x >> 6;
    for (int row = bid * NWAVES + wid; row < M + MM; row += nb * NWAVES) {
        const float* src = row < M ? p.x + (size_t)row * D : p.mem + (size_t)(row - M) * D;
        const float* g = row < M ? p.norm_g : p.mem_norm_g;
        bf16_t* dst = row < M ? (bf16_t*)(ws + OFF_H) + (size_t)row * D : (bf16_t*)(ws + OFF_HM) + (size_t)(row - M) * D;
        f32x4 v[4]; float ss = 0.f;
#pragma unroll
        for (int i = 0; i < 4; ++i) { v[i] = *(const f32x4*)(src + i * 256 + lane * 4); ss += v[i][0] * v[i][0] + v[i][1] * v[i][1] + v[i][2] * v[i][2] + v[i][3] * v[i][3]; }
        ss = wave_sum(ss);
        const float rs = rsqrtf(ss * (1.f / 1024.f) + 1e-6f);
#pragma unroll
        for (int i = 0; i < 4; ++i) {
            const f32x4 gg = *(const f32x4*)(g + i * 256 + lane * 4);
            ushort4 o; o.x = f2bf(v[i][0] * rs * gg[0]); o.y = f2bf(v[i][1] * rs * gg[1]); o.z = f2bf(v[i][2] * rs * gg[2]); o.w = f2bf(v[i][3] * rs * gg[3]);
            *(ushort4*)(dst + i * 256 + lane * 4) = o;
        }
    }
    float2* rope = (float2*)(ws + OFF_ROPE);
    for (int i = bid * NTHREADS + threadIdx.x; i < M * 32; i += nb * NTHREADS) {
        const int row = i >> 5, f = i & 31;
        const double inv = pow(10000.0, -(double)f / 32.0);
        const double ang = (double)p.pos[row] * inv;
        double s, c; sincos(ang, &s, &c);
        rope[i] = make_float2((float)c, (float)s);
    }
}

struct GemmTile { f32x4 acc[2][4]; };
DI void gemm_tile_k(GemmTile& g, const bf16_t* A, int lda, const bf16_t* Bt, int ldb, int m0, int n0, int K, unsigned char* lds) {
    bf16_t* sA = (bf16_t*)lds;
    bf16_t* sB = sA + 128 * 40;
    const int tid = threadIdx.x, lane = tid & 63, wid = tid >> 6, wm = wid & 3, wn = wid >> 2;
    const int srow = tid >> 2, sch = tid & 3;
    const bf16_t* ga = A + (size_t)(m0 + srow) * lda + sch * 8;
    const bf16_t* gb = Bt + (size_t)(n0 + srow) * ldb + sch * 8;
    const int fr = lane & 15, fq = lane >> 4;
    uint4 ra = *(const uint4*)ga, rb = *(const uint4*)gb;
    for (int k0 = 0; k0 < K; k0 += 32) {
        __syncthreads();
        *(uint4*)(sA + srow * 40 + sch * 8) = ra;
        *(uint4*)(sB + srow * 40 + sch * 8) = rb;
        __syncthreads();
        if (k0 + 32 < K) { ra = *(const uint4*)(ga + k0 + 32); rb = *(const uint4*)(gb + k0 + 32); }
        bf16x8 af[2], bfr[4];
#pragma unroll
        for (int mi = 0; mi < 2; ++mi) af[mi] = *(const bf16x8*)(sA + (wm * 32 + mi * 16 + fr) * 40 + fq * 8);
#pragma unroll
        for (int ni = 0; ni < 4; ++ni) bfr[ni] = *(const bf16x8*)(sB + (wn * 64 + ni * 16 + fr) * 40 + fq * 8);
#pragma unroll
        for (int mi = 0; mi < 2; ++mi)
#pragma unroll
            for (int ni = 0; ni < 4; ++ni) g.acc[mi][ni] = __builtin_amdgcn_mfma_f32_16x16x32_bf16(af[mi], bfr[ni], g.acc[mi][ni], 0, 0, 0);
    }
}
DI void gemm_zero(GemmTile& g) {
#pragma unroll
    for (int mi = 0; mi < 2; ++mi)
#pragma unroll
        for (int ni = 0; ni < 4; ++ni) g.acc[mi][ni] = (f32x4){0.f, 0.f, 0.f, 0.f};
}
#define GEMM_FOREACH(body) do { const int lane_ = threadIdx.x & 63, wid_ = threadIdx.x >> 6, wm_ = wid_ & 3, wn_ = wid_ >> 2, fr_ = lane_ & 15, fq_ = lane_ >> 4; \
    _Pragma("unroll") for (int mi = 0; mi < 2; ++mi) _Pragma("unroll") for (int ni = 0; ni < 4; ++ni) _Pragma("unroll") for (int r = 0; r < 4; ++r) { \
        const int row = m0 + wm_ * 32 + mi * 16 + fq_ * 4 + r, col = n0 + wn_ * 64 + ni * 16 + fr_; body } } while (0)

DI void phase_gemm_in(const Params& p, unsigned char* lds, const int bid, const int nb) {
    unsigned char* ws = p.ws;
    const bf16_t* H = (const bf16_t*)(ws + OFF_H); const bf16_t* Wt = (const bf16_t*)(ws + OFF_WIN);
    bf16_t* P = (bf16_t*)(ws + OFF_P);
    const int tn = NP / 128, nt1 = (M / 128) * tn;
    const int tn2 = 1024 / 128, nt2 = (MM / 128) * tn2;
    for (int it = bid; it < nt1 + nt2; it += nb) {
        GemmTile g; gemm_zero(g);
        if (it < nt1) {
            const int m0 = (it / tn) * 128, n0 = (it % tn) * 128;
            gemm_tile_k(g, H, 1024, Wt, 1024, m0, n0, 1024, lds);
            GEMM_FOREACH(P[(size_t)row * NP + col] = f2bf(g.acc[mi][ni][r]););
        } else {
            const int i2 = it - nt1; const int m0 = (i2 / tn2) * 128, n0 = (i2 % tn2) * 128;
            gemm_tile_k(g, (const bf16_t*)(ws + OFF_HM), 1024, (const bf16_t*)(ws + OFF_WKV), 1024, m0, n0, 1024, lds);
            bf16_t* KVM = (bf16_t*)(ws + OFF_KVM);
            GEMM_FOREACH(KVM[(size_t)row * 1024 + col] = f2bf(g.acc[mi][ni][r]););
        }
    }
}

DI void phase_attn_prep(const Params& p, unsigned char* lds, const int bid, const int nb) {
    unsigned char* ws = p.ws; bf16_t* P = (bf16_t*)(ws + OFF_P); bf16_t* KVM = (bf16_t*)(ws + OFF_KVM);
    const float2* rope = (const float2*)(ws + OFF_ROPE);
    const int lane = threadIdx.x & 63, wid = threadIdx.x >> 6;
    const long n1 = (long)M * 14, n2 = (long)MM * 4;
    for (long it = (long)bid * NWAVES + wid; it < n1 + n2; it += (long)nb * NWAVES) {
        if (it < n1) {
            const int row = (int)(it / 14), j = (int)(it % 14);
            if (j < 10) {
                bf16_t* ptr = P + (size_t)row * NP + (j < 8 ? C_Q + j * 64 : C_SK + (j - 8) * 64);
                const float g = j < 8 ? p.q_norm_g[lane] : p.k_norm_g[lane];
                const float xv = bf2f(ptr[lane]);
                const float ss = wave_sum(xv * xv);
                const float y = xv * rsqrtf(ss * (1.f / 64.f) + 1e-6f) * g;
                const float yp = __shfl_xor(y, 32, 64);
                const float2 cs = rope[(size_t)row * 32 + (lane & 31)];
                const float o = lane < 32 ? y * cs.x - yp * cs.y : y * cs.x + yp * cs.y;
                ptr[lane] = f2bf(o);
            } else {
                bf16_t* ptr = P + (size_t)row * NP + C_XQ + (j - 10) * 128;
                const float x0 = bf2f(ptr[lane]), x1 = bf2f(ptr[lane + 64]);
                const float ss = wave_sum(x0 * x0 + x1 * x1);
                const float rs = rsqrtf(ss * (1.f / 128.f) + 1e-6f);
                ptr[lane] = f2bf(x0 * rs * p.xq_norm_g[lane]); ptr[lane + 64] = f2bf(x1 * rs * p.xq_norm_g[lane + 64]);
            }
        } else {
            const long i2 = it - n1; const int row = (int)(i2 / 4), j = (int)(i2 % 4);
            bf16_t* ptr = KVM + (size_t)row * 1024 + j * 128;
            const float x0 = bf2f(ptr[lane]), x1 = bf2f(ptr[lane + 64]);
            const float ss = wave_sum(x0 * x0 + x1 * x1);
            const float rs = rsqrtf(ss * (1.f / 128.f) + 1e-6f);
            ptr[lane] = f2bf(x0 * rs * p.xk_norm_g[lane]); ptr[lane + 64] = f2bf(x1 * rs * p.xk_norm_g[lane + 64]);
        }
    }
}

DI void rwkv_stage(const Params& p, int b, int h, int t0, int ntok, float* ck, float* scratch  ) {
    const bf16_t* P = (const bf16_t*)(p.ws + OFF_P);
    const int lane = threadIdx.x & 63, wid = threadIdx.x >> 6, ch = h * 64 + lane;
    const float mu_r = p.mu_rkv[ch], mu_k = p.mu_rkv[512 + ch], mu_v = p.mu_rkv[1024 + ch], mu_w = p.mu_wa[lane], mu_a = p.mu_wa[64 + lane];
    const float w0c = p.w0[ch], a0c = p.a0[ch], kkc = p.k_k[ch], kac = p.k_a[ch];
    float* sc = scratch + wid * 128;
    for (int i = wid; i < ntok; i += NWAVES) {
        const int t = t0 + i; const bf16_t* pr = P + (size_t)(b * T + t) * NP; const bf16_t* pp = pr - NP; const bool hp = t > 0;
        const float rc = bf2f(pr[C_R + ch]), rp = hp ? bf2f(pp[C_R + ch]) : 0.f;
        const float kc = bf2f(pr[C_K + ch]), kp = hp ? bf2f(pp[C_K + ch]) : 0.f;
        const float vc = bf2f(pr[C_V + ch]), vp = hp ? bf2f(pp[C_V + ch]) : 0.f;
        const float wc = bf2f(pr[C_W + lane]), wp = hp ? bf2f(pp[C_W + lane]) : 0.f;
        const float ac = bf2f(pr[C_A + lane]), ap = hp ? bf2f(pp[C_A + lane]) : 0.f;
        const float r = rc + (rp - rc) * mu_r, k = kc + (kp - kc) * mu_k, v = vc + (vp - vc) * mu_v;
        const float lw = wc + (wp - wc) * mu_w, la = ac + (ap - ac) * mu_a;
        sc[lane] = tanhf(lw); sc[64 + lane] = la;
        float accw = 0.f, acca = 0.f;
#pragma unroll 8
        for (int j = 0; j < 64; ++j) { accw += sc[j] * p.w2[j * 512 + ch]; acca += sc[64 + j] * p.a2[j * 512 + ch]; }
        const float xw = -(w0c + accw);
        const float sp = xw > 20.f ? xw : log1pf(expf(xw));
        const float wlog = -sp - 0.5f;
        const float decay = expf(-expf(wlog));
        const float alpha = 1.f / (1.f + expf(-(a0c + acca)));
        const float kk0 = k * kkc;
        const float n2 = wave_sum(kk0 * kk0);
        const float kk = kk0 / fmaxf(sqrtf(n2), 1e-12f);
        const float k2 = k * (1.f + (alpha - 1.f) * kac);
        float* o = ck + i * 384;
        o[lane] = r; o[64 + lane] = decay; o[128 + lane] = k2; o[192 + lane] = v; o[256 + lane] = -kk; o[320 + lane] = kk * alpha;
    }
}

DI void phase_rwkv_direct(const Params& p, unsigned char* lds, const int bid, const int nb) {
    float* ck = (float*)lds; float* scratch = ck + 64 * 384;
    const int lane = threadIdx.x & 63, wid = threadIdx.x >> 6;
    const bf16_t* P = (const bf16_t*)(p.ws + OFF_P); bf16_t* YA = (bf16_t*)(p.ws + OFF_YA);
    for (int bh = bid; bh < BATCH * 8; bh += nb) {
        const int b = bh >> 3, h = bh & 7, ch = h * 64 + lane;
        float S[64];
#pragma unroll
        for (int k = 0; k < 64; ++k) S[k] = 0.f;
        const float rk = p.r_k[ch], lg = p.lnx_g[ch], lb = p.lnx_b[ch];
        for (int c = 0; c < T / 64; ++c) {
            __syncthreads();
            rwkv_stage(p, b, h, c * 64, 64, ck, scratch);
            __syncthreads();
            if (wid == 0) {
                for (int i = 0; i < 64; ++i) {
                    const float* cc = ck + i * 384;
                    float sa = 0.f;
#pragma unroll
                    for (int k = 0; k < 64; ++k) sa += S[k] * cc[256 + k];
                    const float vv = cc[192 + lane];
#pragma unroll
                    for (int k = 0; k < 64; ++k) S[k] = S[k] * cc[64 + k] + sa * cc[320 + k] + vv * cc[128 + k];
                    float y = 0.f;
#pragma unroll
                    for (int k = 0; k < 64; ++k) y += S[k] * cc[k];
                    const float mean = wave_sum(y) * (1.f / 64.f);
                    const float dy = y - mean;
                    const float var = wave_sum(dy * dy) * (1.f / 64.f);
                    const float yn = dy * rsqrtf(var + 64e-5f) * lg + lb;
                    const float bonus = wave_sum(cc[lane] * cc[128 + lane] * rk) * vv;
                    const int t = c * 64 + i; const size_t row = (size_t)(b * T + t);
                    const float z = bf2f(P[row * NP + C_ZA + ch]);
                    YA[row * 512 + ch] = f2bf((yn + bonus) * siluf_(z));
                }
            }
        }
    }
}

constexpr size_t AF_BYTES = 16384, NF_BYTES = 16384, NCHUNK = 64;
constexpr int CHT = 128;
constexpr size_t OFF_AF = 0, OFF_NF = (size_t)16 * NCHUNK * AF_BYTES;
constexpr size_t OFF_QH = OFF_NF + (size_t)16 * NCHUNK * NF_BYTES;
constexpr size_t OFF_BON = OFF_QH + (size_t)16 * T * 64 * 2;
static_assert(OFF_BON + (size_t)16 * T * 4 <= (size_t)M * 1024 * 4, "d_out scratch");
typedef float f32x16 __attribute__((ext_vector_type(16)));
#define MFMA32(a, b, c) __builtin_amdgcn_mfma_f32_32x32x16_bf16((a), (b), (c), 0, 0, 0)
typedef float f32x2 __attribute__((ext_vector_type(2)));

DI unsigned pk2f(float lo, float hi) { typedef float f2_ __attribute__((ext_vector_type(2))); typedef __bf16 b2_ __attribute__((ext_vector_type(2))); return __builtin_bit_cast(unsigned, __builtin_convertvector((f2_){lo, hi}, b2_)); }
DI float quad_sum(float s) {
    s += __int_as_float(__builtin_amdgcn_update_dpp(0, __float_as_int(s), 0xB1, 0xF, 0xF, true));
    s += __int_as_float(__builtin_amdgcn_update_dpp(0, __float_as_int(s), 0x4E, 0xF, 0xF, true));
    return s;
}

DI float rwkv_stage_tok(const Params& p, const bf16_t* P, int b, int h, int t, float* o, float* sc, float mu_r, float mu_k, float mu_v, float mu_w, float mu_a,
                        float w0c, float a0c, float kkc, float kac, float rkc) {
    const int lane = threadIdx.x & 63, ch = h * 64 + lane;
    const bf16_t* pr = P + (size_t)(b * T + t) * NP; const bf16_t* pp = pr - NP; const bool hp = t > 0;
    const float rc = bf2f(pr[C_R + ch]), rp = hp ? bf2f(pp[C_R + ch]) : 0.f;
    const float kc = bf2f(pr[C_K + ch]), kp = hp ? bf2f(pp[C_K + ch]) : 0.f;
    const float vc = bf2f(pr[C_V + ch]), vp = hp ? bf2f(pp[C_V + ch]) : 0.f;
    const float wc = bf2f(pr[C_W + lane]), wp = hp ? bf2f(pp[C_W + lane]) : 0.f;
    const float ac = bf2f(pr[C_A + lane]), ap = hp ? bf2f(pp[C_A + lane]) : 0.f;
    const float r = rc + (rp - rc) * mu_r, k = kc + (kp - kc) * mu_k, v = vc + (vp - vc) * mu_v;
    const float lw = wc + (wp - wc) * mu_w, la = ac + (ap - ac) * mu_a;
    sc[lane] = tanhf(lw); sc[64 + lane] = la;
    float accw = 0.f, acca = 0.f;
    const float* w2p = p.w2; const float* a2p = p.a2;
    asm volatile("" : "+s"(w2p), "+s"(a2p));
#pragma unroll 8
    for (int j = 0; j < 64; ++j) { accw += sc[j] * w2p[j * 512 + ch]; acca += sc[64 + j] * a2p[j * 512 + ch]; }
    const float xw = -(w0c + accw);
    const float sp = xw > 20.f ? xw : log1pf(expf(xw));
    const float decay = expf(-expf(-sp - 0.5f));
    const float alpha = 1.f / (1.f + expf(-(a0c + acca)));
    const float kk0 = k * kkc;
    const float n2 = wave_sum(kk0 * kk0);
    const float kk = kk0 / fmaxf(sqrtf(n2), 1e-12f);
    const float k2 = k * (1.f + (alpha - 1.f) * kac);
    o[lane] = r; o[64 + lane] = decay; o[128 + lane] = k2; o[192 + lane] = v; o[256 + lane] = -kk; o[320 + lane] = kk * alpha;
    return wave_sum(r * k2 * rkc);
}

typedef float f32x4_t __attribute__((ext_vector_type(4)));
DI float row16_sum(float x) {
    x += __int_as_float(__builtin_amdgcn_update_dpp(0, __float_as_int(x), 0x128, 0xF, 0xF, true));
    x += __int_as_float(__builtin_amdgcn_update_dpp(0, __float_as_int(x), 0x124, 0xF, 0xF, true));
    x += __int_as_float(__builtin_amdgcn_update_dpp(0, __float_as_int(x), 0x122, 0xF, 0xF, true));
    x += __int_as_float(__builtin_amdgcn_update_dpp(0, __float_as_int(x), 0x121, 0xF, 0xF, true));
    return x;
}
DI void build_lora_frags(const Params& p, int h, unsigned char* bfrag) {
    for (int fidx = threadIdx.x; fidx < 1024; fidx += NTHREADS) {
        const int mat = fidx >> 9, nt = (fidx >> 7) & 3, ks = (fidx >> 6) & 1, l = fidx & 63, n = l & 15, kg = l >> 4;
        const float* W = (mat ? p.a2 : p.w2) + (size_t)(32 * ks + 8 * kg) * 512 + h * 64 + 16 * nt + n;
        unsigned w[4];
#pragma unroll
        for (int e2 = 0; e2 < 4; ++e2) w[e2] = (unsigned)f2bf(W[(2 * e2) * 512]) | ((unsigned)f2bf(W[(2 * e2 + 1) * 512]) << 16);
        *(uint4*)(bfrag + fidx * 16) = make_uint4(w[0], w[1], w[2], w[3]);
    }
}
template <int PART, int RS, bool R3>
DI void stage16(const Params& p, const bf16_t* P, int b, int h, int tg0, int tg1, int tg2, int tg3, float* recs, const unsigned char* bfrag, float* bon_out  ) {
    asm volatile("" : "+s"(h));
    const int lane = threadIdx.x & 63, n = lane & 15, rg = lane >> 4;
    constexpr int FIELD = PART == 0 ? 0 : 128;
    {
        const float mu = PART == 0 ? p.mu_wa[lane] : p.mu_wa[64 + lane];
        const int colx = (PART == 0 ? C_W : C_A) + lane;
#pragma unroll
        for (int gi = 0; gi < 4; ++gi) {
            const int t0 = gi == 0 ? tg0 : gi == 1 ? tg1 : gi == 2 ? tg2 : tg3;
            const bf16_t* base = P + (size_t)(b * T + t0) * NP + colx;
            float prev = t0 > 0 ? bf2f(base[-NP]) : 0.f;
#pragma unroll
            for (int rr = 0; rr < 4; ++rr) {
                const float cur = bf2f(base[rr * NP]);
                const float x = cur + (prev - cur) * mu; prev = cur;
                float val = x;
                if (PART == 0) { const float e2 = __expf(2.f * x); val = 1.f - 2.f * __builtin_amdgcn_rcpf(1.f + e2); }
                *(bf16_t*)((unsigned char*)(recs + (gi * 4 + rr) * RS + FIELD) + 2 * lane) = f2bf(val);
            }
        }
    }
    f32x4 acc[4];
#pragma unroll
    for (int nt = 0; nt < 4; ++nt) acc[nt] = (f32x4){0.f, 0.f, 0.f, 0.f};
#pragma unroll
    for (int ks = 0; ks < 2; ++ks) {
        const bf16x8 af = *(const bf16x8*)((const unsigned char*)(recs + n * RS + FIELD) + ks * 64 + rg * 16);
#pragma unroll
        for (int nt = 0; nt < 4; ++nt) {
            const bf16x8 bfr = *(const bf16x8*)(bfrag + (((PART * 4 + nt) * 2 + ks) * 64 + lane) * 16);
            acc[nt] = __builtin_amdgcn_mfma_f32_16x16x32_bf16(af, bfr, acc[nt], 0, 0, 0);
        }
    }
    const int tgl = rg == 0 ? tg0 : rg == 1 ? tg1 : rg == 2 ? tg2 : tg3;
    const bf16_t* rowb = P + (size_t)(b * T + tgl) * NP;
    float* rec0 = recs + (4 * rg) * RS;
    const bool hp = tgl > 0;
    if (PART == 0) {
#pragma unroll
        for (int nt = 0; nt < 4; ++nt) {
            const int cl = 16 * nt + n, ch = h * 64 + cl;
            const float mu_r = p.mu_rkv[ch], mu_v = p.mu_rkv[1024 + ch], w0c = p.w0[ch];
            float rp = hp ? bf2f(rowb[-NP + C_R + ch]) : 0.f, vp = hp ? bf2f(rowb[-NP + C_V + ch]) : 0.f;
#pragma unroll
            for (int rr = 0; rr < 4; ++rr) {
                const float rc = bf2f(rowb[rr * NP + C_R + ch]), vc = bf2f(rowb[rr * NP + C_V + ch]);
                const float r = rc + (rp - rc) * mu_r, v = vc + (vp - vc) * mu_v; rp = rc; vp = vc;
                const float xw = -(w0c + acc[nt][rr]);
                const float sp = xw > 20.f ? xw : __logf(1.f + __expf(xw));
                const float decay = __expf(-__expf(-sp - 0.5f));
                float* o = rec0 + rr * RS;
                o[cl] = r; o[64 + cl] = decay; o[192 + cl] = v;
            }
        }
    } else {
        float kv[4][4], kk0[4][4], al[4][4], rv[4][4], n2[4] = {0.f, 0.f, 0.f, 0.f};
#pragma unroll
        for (int nt = 0; nt < 4; ++nt) {
            const int ch = h * 64 + 16 * nt + n;
            const float mu_k = p.mu_rkv[512 + ch], mu_r = p.mu_rkv[ch], a0c = p.a0[ch], kkc = p.k_k[ch];
            float kp = hp ? bf2f(rowb[-NP + C_K + ch]) : 0.f, rp = (R3 && hp) ? bf2f(rowb[-NP + C_R + ch]) : 0.f;
#pragma unroll
            for (int rr = 0; rr < 4; ++rr) {
                const float kc = bf2f(rowb[rr * NP + C_K + ch]);
                const float k = kc + (kp - kc) * mu_k; kp = kc;
                if (R3) { const float rc = bf2f(rowb[rr * NP + C_R + ch]); rv[nt][rr] = rc + (rp - rc) * mu_r; rp = rc; }
                kv[nt][rr] = k; kk0[nt][rr] = k * kkc; n2[rr] += kk0[nt][rr] * kk0[nt][rr];
                al[nt][rr] = __builtin_amdgcn_rcpf(1.f + __expf(-(a0c + acc[nt][rr])));
            }
        }
        float inv[4], bon[4] = {0.f, 0.f, 0.f, 0.f};
#pragma unroll
        for (int rr = 0; rr < 4; ++rr) inv[rr] = 1.f / fmaxf(sqrtf(row16_sum(n2[rr])), 1e-12f);
#pragma unroll
        for (int nt = 0; nt < 4; ++nt) {
            const int cl = 16 * nt + n, ch = h * 64 + cl;
            const float kac = p.k_a[ch], rkc = p.r_k[ch];
#pragma unroll
            for (int rr = 0; rr < 4; ++rr) {
                const float kk = kk0[nt][rr] * inv[rr], k2 = kv[nt][rr] * (1.f + (al[nt][rr] - 1.f) * kac);
                float* o = rec0 + rr * RS;
                o[128 + cl] = k2; o[256 + cl] = -kk; o[320 + cl] = kk * al[nt][rr];
                if (R3) bon[rr] += rv[nt][rr] * k2 * rkc;
            }
        }
        if (R3) {
#pragma unroll
            for (int rr = 0; rr < 4; ++rr) { const float bs = row16_sum(bon[rr]); if (n == 0) bon_out[tgl + rr] = bs; }
        }
    }
}

constexpr size_t OFF_LWF = OFF_YB, OFF_ALF = OFF_YC;
struct LoraRaw { uint4 w0, a0, w1, a1, w2, a2; };
struct LoraCst { float mu_w, mu_a, w0c[4], a0c[4]; };
DI LoraRaw lora_load(const bf16_t* P, int b, int t0) {
    int lane = threadIdx.x & 63; asm volatile("" : "+v"(lane));
    LoraRaw r; const uint4 z4 = make_uint4(0u, 0u, 0u, 0u);
    r.w0 = z4; r.a0 = z4; r.w1 = z4; r.a1 = z4; r.w2 = z4; r.a2 = z4;
    { const int row = lane >> 3, p16 = lane & 7, tt = t0 - 1 + row; if (tt >= 0) { r.w0 = *(const uint4*)(P + (size_t)(b * T + tt) * NP + C_W + p16 * 8); r.a0 = *(const uint4*)(P + (size_t)(b * T + tt) * NP + C_A + p16 * 8); } }
    { const int row = 8 + (lane >> 3), p16 = lane & 7, tt = t0 - 1 + row; r.w1 = *(const uint4*)(P + (size_t)(b * T + tt) * NP + C_W + p16 * 8); r.a1 = *(const uint4*)(P + (size_t)(b * T + tt) * NP + C_A + p16 * 8); }
    if (lane < 8) { const int tt = t0 + 15; r.w2 = *(const uint4*)(P + (size_t)(b * T + tt) * NP + C_W + lane * 8); r.a2 = *(const uint4*)(P + (size_t)(b * T + tt) * NP + C_A + lane * 8); }
    return r;
}
DI void lora_group(const Params& p, const LoraRaw& raw, const LoraCst& lc, int bh, int t0, unsigned char* scr, const unsigned char* bfrag) {
    int lane = threadIdx.x & 63; asm volatile("" : "+v"(lane));
    const int n = lane & 15, rg = lane >> 4;
    {
        const float mu_w = lc.mu_w, mu_a = lc.mu_a;
        { const int row = lane >> 3, p16 = lane & 7; *(uint4*)(scr + row * 128 + p16 * 16) = raw.w0; *(uint4*)(scr + 2176 + row * 128 + p16 * 16) = raw.a0;
          *(uint4*)(scr + (8 + row) * 128 + p16 * 16) = raw.w1; *(uint4*)(scr + 2176 + (8 + row) * 128 + p16 * 16) = raw.a1;
          if (lane < 8) { *(uint4*)(scr + 16 * 128 + lane * 16) = raw.w2; *(uint4*)(scr + 2176 + 16 * 128 + lane * 16) = raw.a2; } }
        float rw[17], ra[17];
#pragma unroll
        for (int i = 0; i < 17; ++i) { rw[i] = bf2f(*(const bf16_t*)(scr + i * 128 + 2 * lane)); ra[i] = bf2f(*(const bf16_t*)(scr + 2176 + i * 128 + 2 * lane)); }
        asm volatile("" ::: "memory");
#pragma unroll
        for (int i = 0; i < 16; ++i) {
            const float xw = rw[i + 1] + (rw[i] - rw[i + 1]) * mu_w;
            const float e2 = __expf(2.f * xw);
            *(bf16_t*)(scr + (i + 1) * 128 + 2 * lane) = f2bf(1.f - 2.f * __builtin_amdgcn_rcpf(1.f + e2));
            *(bf16_t*)(scr + 2176 + (i + 1) * 128 + 2 * lane) = f2bf(ra[i + 1] + (ra[i] - ra[i + 1]) * mu_a);
        }
    }
    f32x4 accw[4], acca[4];
#pragma unroll
    for (int nt = 0; nt < 4; ++nt) { accw[nt] = (f32x4){0.f, 0.f, 0.f, 0.f}; acca[nt] = (f32x4){0.f, 0.f, 0.f, 0.f}; }
#pragma unroll
    for (int ks = 0; ks < 2; ++ks) {
        const bf16x8 afw = *(const bf16x8*)(scr + (n + 1) * 128 + ks * 64 + rg * 16), afa = *(const bf16x8*)(scr + 2176 + (n + 1) * 128 + ks * 64 + rg * 16);
#pragma unroll
        for (int nt = 0; nt < 4; ++nt) {
            accw[nt] = __builtin_amdgcn_mfma_f32_16x16x32_bf16(afw, *(const bf16x8*)(bfrag + ((nt * 2 + ks) * 64 + lane) * 16), accw[nt], 0, 0, 0);
            acca[nt] = __builtin_amdgcn_mfma_f32_16x16x32_bf16(afa, *(const bf16x8*)(bfrag + (((4 + nt) * 2 + ks) * 64 + lane) * 16), acca[nt], 0, 0, 0);
        }
    }
    uint2* lwf = (uint2*)(p.ws + OFF_LWF) + ((size_t)(bh * 512 + (t0 >> 4)) * 4) * 64 + lane;
    uint2* alf = (uint2*)(p.ws + OFF_ALF) + ((size_t)(bh * 512 + (t0 >> 4)) * 4) * 64 + lane;
#pragma unroll
    for (int nt = 0; nt < 4; ++nt) {
        const float w0c = lc.w0c[nt], a0c = lc.a0c[nt];
        float lw[4], al[4];
#pragma unroll
        for (int rr = 0; rr < 4; ++rr) { const float xw = -(w0c + accw[nt][rr]); const float sp = fmaxf(xw, 0.f) + __logf(1.f + __expf(-fabsf(xw))); lw[rr] = -__expf(-sp - 0.5f);
            al[rr] = __builtin_amdgcn_rcpf(1.f + __expf(-(a0c + acca[nt][rr]))); }
        lwf[nt * 64] = make_uint2(pk2f(lw[0], lw[1]), pk2f(lw[2], lw[3]));
        alf[nt * 64] = make_uint2(pk2f(al[0], al[1]), pk2f(al[2], al[3]));
    }
}
template <int PART>
DI void stage16s(const Params& p, const unsigned char* rawc  , const unsigned char* fragl  ,
                 const float* cst  , int h, int bh, int t0, float* recs, float* bon_out, float (&Lb)[4]) {
    (void)p; (void)h; (void)bh;
    int lane = threadIdx.x & 63; asm volatile("" : "+v"(lane));
    const int n = lane & 15, rg = lane >> 4;
    constexpr int RS = 384;
    const int tgl = t0 + 4 * rg;
    const unsigned char* rawl = rawc + (4 * rg) * 384;
    const float hpf = tgl > 0 ? 1.f : 0.f;
    float* rec0 = recs + (4 * rg) * RS;
    const uint2* lwf = (const uint2*)fragl + lane;
    const uint2* alf = (const uint2*)(fragl + 2048) + lane;
#define S16S_L(nt_) \
        float eL[4], eLm[4], eN[4]; { const uint2 lwp = lwf[(nt_) * 64]; float lw[4], pl[4]; \
        lw[0] = __uint_as_float(lwp.x << 16); lw[1] = __uint_as_float(lwp.x & 0xffff0000u); lw[2] = __uint_as_float(lwp.y << 16); lw[3] = __uint_as_float(lwp.y & 0xffff0000u); \
        pl[0] = lw[0]; pl[1] = pl[0] + lw[1]; pl[2] = pl[1] + lw[2]; pl[3] = pl[2] + lw[3]; \
        float inc = pl[3]; float y_ = __shfl_up(inc, 16, 64); if (rg >= 1) inc += y_; y_ = __shfl_up(inc, 32, 64); if (rg >= 2) inc += y_; \
        const float tot = __shfl(inc, 48 + n, 64); const float base_ = Lb[nt_] + inc - pl[3]; \
        _Pragma("unroll") for (int rr = 0; rr < 4; ++rr) { const float L = base_ + pl[rr]; const float Lc = fmaxf(L, -80.f), Lm = fmaxf(L - lw[rr], -80.f); eL[rr] = __expf(Lc); eLm[rr] = __expf(Lm); eN[rr] = __expf(-Lc); } \
        Lb[nt_] += tot; }
    if (PART == 0) {
#pragma unroll
        for (int nt = 0; nt < 4; ++nt) {
            S16S_L(nt)
            (void)eLm; (void)eN;
            const int cl = 16 * nt + n;
            const float mu_r = cst[cl], mu_v = cst[128 + cl];
            float rr_[5], vv_[5];
#pragma unroll
            for (int r5 = 0; r5 < 5; ++r5) { rr_[r5] = bf2f(*(const bf16_t*)(rawl + r5 * 384 + cl * 2)); vv_[r5] = bf2f(*(const bf16_t*)(rawl + r5 * 384 + 256 + cl * 2)); }
            rr_[0] *= hpf; vv_[0] *= hpf;
#pragma unroll
            for (int rr = 0; rr < 4; ++rr) {
                const float r = rr_[rr + 1] + (rr_[rr] - rr_[rr + 1]) * mu_r, v = vv_[rr + 1] + (vv_[rr] - vv_[rr + 1]) * mu_v;
                float* o = rec0 + rr * RS;
                o[cl] = r * eL[rr]; o[192 + cl] = v;
            }
            asm volatile("" ::: "memory");
        }
    } else {
        float kv[4][4], n2[4] = {0.f, 0.f, 0.f, 0.f};
#pragma unroll
        for (int nt = 0; nt < 4; ++nt) {
            const float mu_k = cst[64 + 16 * nt + n], kkc = cst[192 + 16 * nt + n];
            float kk_[5];
#pragma unroll
            for (int r5 = 0; r5 < 5; ++r5) kk_[r5] = bf2f(*(const bf16_t*)(rawl + r5 * 384 + 128 + (16 * nt + n) * 2));
            kk_[0] *= hpf;
#pragma unroll
            for (int rr = 0; rr < 4; ++rr) { const float k = kk_[rr + 1] + (kk_[rr] - kk_[rr + 1]) * mu_k; kv[nt][rr] = k; const float k0 = k * kkc; n2[rr] += k0 * k0; }
        }
        float inv[4], bon[4] = {0.f, 0.f, 0.f, 0.f};
#pragma unroll
        for (int rr = 0; rr < 4; ++rr) inv[rr] = 1.f / fmaxf(sqrtf(row16_sum(n2[rr])), 1e-12f);
#pragma unroll
        for (int nt = 0; nt < 4; ++nt) {
            S16S_L(nt)
            (void)eL;
            const int cl = 16 * nt + n;
            const float kac = cst[256 + cl], rkc = cst[320 + cl], mu_r = cst[cl], kkc = cst[192 + cl];
            const uint2 alp = alf[nt * 64];
            const float al4[4] = {__uint_as_float(alp.x << 16), __uint_as_float(alp.x & 0xffff0000u), __uint_as_float(alp.y << 16), __uint_as_float(alp.y & 0xffff0000u)};
            float rr_[5];
#pragma unroll
            for (int r5 = 0; r5 < 5; ++r5) rr_[r5] = bf2f(*(const bf16_t*)(rawl + r5 * 384 + cl * 2));
            rr_[0] *= hpf;
#pragma unroll
            for (int rr = 0; rr < 4; ++rr) {
                const float r = rr_[rr + 1] + (rr_[rr] - rr_[rr + 1]) * mu_r;
                const float al = al4[rr];
                const float k = kv[nt][rr], kk = k * kkc * inv[rr], k2 = k * (1.f + (al - 1.f) * kac);
                float* o = rec0 + rr * RS;
                o[128 + cl] = k2 * eN[rr]; o[256 + cl] = -kk * eLm[rr]; o[320 + cl] = kk * al * eN[rr];
                bon[rr] += r * k2 * rkc;
            }
            asm volatile("" ::: "memory");
        }
#pragma unroll
        for (int rr = 0; rr < 4; ++rr) { const float bs = row16_sum(bon[rr]); if (n == 0) bon_out[tgl + rr] = bs; }
    }
#undef S16S_L
}
typedef float v2f __attribute__((ext_vector_type(2)));
template <int MODE> DI void rwkv_step_s(v2f (&z)[4][8], const float* cc, int q, int g, float (&yo)[4]) {
    f32x4 av[4], bv[4], kv[4], rv[4];
#pragma unroll
    for (int u = 0; u < 4; ++u) { av[u] = *(const f32x4*)(cc + 256 + 16 * q + 4 * u); bv[u] = *(const f32x4*)(cc + 320 + 16 * q + 4 * u); rv[u] = *(const f32x4*)(cc + 16 * q + 4 * u);
        if (MODE == 1) kv[u] = *(const f32x4*)(cc + 128 + 16 * q + 4 * u); }
    f32x4 vr = (f32x4){0.f, 0.f, 0.f, 0.f};
    if (MODE == 1) vr = *(const f32x4*)(cc + 192 + 4 * g);
#define V2LO(x_) ((v2f){(x_)[0], (x_)[1]})
#define V2HI(x_) ((v2f){(x_)[2], (x_)[3]})
    float sa[4];
#pragma unroll
    for (int rr = 0; rr < 4; ++rr) {
        v2f s = z[rr][0] * V2LO(av[0]);
        s = __builtin_elementwise_fma(z[rr][1], V2HI(av[0]), s);
#pragma unroll
        for (int u = 1; u < 4; ++u) { s = __builtin_elementwise_fma(z[rr][2 * u], V2LO(av[u]), s); s = __builtin_elementwise_fma(z[rr][2 * u + 1], V2HI(av[u]), s); }
        sa[rr] = quad_sum(s[0] + s[1]);
    }
#pragma unroll
    for (int rr = 0; rr < 4; ++rr) {
        const v2f sa2 = (v2f){sa[rr], sa[rr]}, vr2 = (v2f){vr[rr], vr[rr]};
#pragma unroll
        for (int u = 0; u < 4; ++u) {
            v2f t0 = __builtin_elementwise_fma(sa2, V2LO(bv[u]), z[rr][2 * u]), t1 = __builtin_elementwise_fma(sa2, V2HI(bv[u]), z[rr][2 * u + 1]);
            if (MODE == 1) { t0 = __builtin_elementwise_fma(vr2, V2LO(kv[u]), t0); t1 = __builtin_elementwise_fma(vr2, V2HI(kv[u]), t1); }
            z[rr][2 * u] = t0; z[rr][2 * u + 1] = t1;
        }
    }
#pragma unroll
    for (int rr = 0; rr < 4; ++rr) {
        v2f s = z[rr][0] * V2LO(rv[0]);
        s = __builtin_elementwise_fma(z[rr][1], V2HI(rv[0]), s);
#pragma unroll
        for (int u = 1; u < 4; ++u) { s = __builtin_elementwise_fma(z[rr][2 * u], V2LO(rv[u]), s); s = __builtin_elementwise_fma(z[rr][2 * u + 1], V2HI(rv[u]), s); }
        yo[rr] = quad_sum(s[0] + s[1]);
    }
#undef V2LO
#undef V2HI
}

DI void rwkv_step_m(v2f (&z)[4][8], const float* cc, int q, int vro, float (&yo)[4]) {
    f32x4 av[4], bv[4], kv[4], rv[4];
#pragma unroll
    for (int u = 0; u < 4; ++u) { av[u] = *(const f32x4*)(cc + 256 + 16 * q + 4 * u); bv[u] = *(const f32x4*)(cc + 320 + 16 * q + 4 * u); rv[u] = *(const f32x4*)(cc + 16 * q + 4 * u);
        kv[u] = *(const f32x4*)(cc + 128 + 16 * q + 4 * u); }
    const v2f vr = *(const v2f*)(cc + 192 + vro);
#define V2LO(x_) ((v2f){(x_)[0], (x_)[1]})
#define V2HI(x_) ((v2f){(x_)[2], (x_)[3]})
    float sa[4];
#pragma unroll
    for (int rr = 0; rr < 4; ++rr) {
        v2f s = z[rr][0] * V2LO(av[0]);
        s = __builtin_elementwise_fma(z[rr][1], V2HI(av[0]), s);
#pragma unroll
        for (int u = 1; u < 4; ++u) { s = __builtin_elementwise_fma(z[rr][2 * u], V2LO(av[u]), s); s = __builtin_elementwise_fma(z[rr][2 * u + 1], V2HI(av[u]), s); }
        sa[rr] = quad_sum(s[0] + s[1]);
    }
#pragma unroll
    for (int rr = 0; rr < 4; ++rr) {
        const v2f sa2 = (v2f){sa[rr], sa[rr]}, vr2 = (v2f){vr[rr & 1], vr[rr & 1]};
#pragma unroll
        for (int u = 0; u < 4; ++u) {
            v2f t0 = __builtin_elementwise_fma(sa2, V2LO(bv[u]), z[rr][2 * u]), t1 = __builtin_elementwise_fma(sa2, V2HI(bv[u]), z[rr][2 * u + 1]);
            if (rr >= 2) { t0 = __builtin_elementwise_fma(vr2, V2LO(kv[u]), t0); t1 = __builtin_elementwise_fma(vr2, V2HI(kv[u]), t1); }
            z[rr][2 * u] = t0; z[rr][2 * u + 1] = t1;
        }
    }
#pragma unroll
    for (int rr = 0; rr < 4; ++rr) {
        v2f s = z[rr][0] * V2LO(rv[0]);
        s = __builtin_elementwise_fma(z[rr][1], V2HI(rv[0]), s);
#pragma unroll
        for (int u = 1; u < 4; ++u) { s = __builtin_elementwise_fma(z[rr][2 * u], V2LO(rv[u]), s); s = __builtin_elementwise_fma(z[rr][2 * u + 1], V2HI(rv[u]), s); }
        yo[rr] = quad_sum(s[0] + s[1]);
    }
#undef V2LO
#undef V2HI
}

template <int MODE> DI void rwkv_step(float (&z)[4][16], const float* cc, int q, int g, float (&sa)[4], float (&yo)[4]) {
    f32x4 av[4], wv[4], bv[4], kv[4];
#pragma unroll
    for (int u = 0; u < 4; ++u) { av[u] = *(const f32x4*)(cc + 256 + 16 * q + 4 * u); wv[u] = *(const f32x4*)(cc + 64 + 16 * q + 4 * u); bv[u] = *(const f32x4*)(cc + 320 + 16 * q + 4 * u);
        if (MODE == 1) kv[u] = *(const f32x4*)(cc + 128 + 16 * q + 4 * u); }
    f32x4 vr = (f32x4){0.f, 0.f, 0.f, 0.f};
    if (MODE == 1) vr = *(const f32x4*)(cc + 192 + 4 * g);
#pragma unroll
    for (int rr = 0; rr < 4; ++rr) {
        float s0 = 0.f, s1 = 0.f;
#pragma unroll
        for (int u = 0; u < 4; ++u) { s0 += z[rr][4 * u] * av[u][0] + z[rr][4 * u + 2] * av[u][2]; s1 += z[rr][4 * u + 1] * av[u][1] + z[rr][4 * u + 3] * av[u][3]; }
        sa[rr] = quad_sum(s0 + s1);
    }
#pragma unroll
    for (int rr = 0; rr < 4; ++rr)
#pragma unroll
        for (int u = 0; u < 4; ++u)
#pragma unroll
            for (int e = 0; e < 4; ++e) {
                float t = sa[rr] * bv[u][e];
                if (MODE == 1) t += vr[rr] * kv[u][e];
                z[rr][4 * u + e] = z[rr][4 * u + e] * wv[u][e] + t;
            }
    f32x4 rv[4];
#pragma unroll
    for (int u = 0; u < 4; ++u) rv[u] = *(const f32x4*)(cc + 16 * q + 4 * u);
#pragma unroll
    for (int rr = 0; rr < 4; ++rr) {
        float s0 = 0.f, s1 = 0.f;
#pragma unroll
        for (int u = 0; u < 4; ++u) { s0 += z[rr][4 * u] * rv[u][0] + z[rr][4 * u + 2] * rv[u][2]; s1 += z[rr][4 * u + 1] * rv[u][1] + z[rr][4 * u + 3] * rv[u][3]; }
        yo[rr] = quad_sum(s0 + s1);
    }
}

DI void phase_rwkv_prep(const Params& p, unsigned char* lds, const int bid, const int nb) {
    float* ck = (float*)lds; unsigned char* bfrag = lds + 64 * 384 * 4; float* mat = (float*)lds;
    const bf16_t* P = (const bf16_t*)(p.ws + OFF_P);
    unsigned char* fr = (unsigned char*)p.out;
    bf16_t* YA = (bf16_t*)(p.ws + OFF_YA);
    for (int item = bid; item < 256; item += nb) {
        int tid = threadIdx.x; asm volatile("" : "+v"(tid));
        const int lane = tid & 63, wid = __builtin_amdgcn_readfirstlane(tid >> 6), q = lane & 3, g = lane >> 2, cl = wid & 3, role = wid >> 2;
        const int bh = item >> 4, cq = item & 15, b = bh >> 3, h = bh & 7;
        __syncthreads();
        R1STAMP(0);
        if (STAMP_PH >= 30 && blockIdx.x == 0 && threadIdx.x == 0) { ((volatile LAS unsigned*)(lds + LDS_CTL_OFF + 64))[24] = 0u; ((volatile LAS unsigned*)(lds + LDS_CTL_OFF + 64))[25] = 0u; ((volatile LAS unsigned*)(lds + LDS_CTL_OFF + 64))[26] = 0u; }
        float* cst = (float*)(lds + 64 * 384 * 4 + 16384 + 2048 + 26624);
        if (tid < 384) { const int k6 = tid >> 6, c6 = tid & 63, ch = h * 64 + c6;
            cst[tid] = k6 == 0 ? p.mu_rkv[ch] : k6 == 1 ? p.mu_rkv[512 + ch] : k6 == 2 ? p.mu_rkv[1024 + ch] : k6 == 3 ? p.k_k[ch] : k6 == 4 ? p.k_a[ch] : p.r_k[ch]; }
        build_lora_frags(p, h, bfrag);
        __syncthreads();
        R1STAMP(1);
        {
            LoraCst lc; lc.mu_w = p.mu_wa[lane]; lc.mu_a = p.mu_wa[64 + lane];
#pragma unroll
            for (int nt = 0; nt < 4; ++nt) { lc.w0c[nt] = p.w0[h * 64 + 16 * nt + (lane & 15)]; lc.a0c[nt] = p.a0[h * 64 + 16 * nt + (lane & 15)]; }
            LoraRaw cur = lora_load(P, b, cq * 4 * CHT + wid * 16);
#pragma unroll 1
            for (int gi = 0; gi < 4; ++gi) {
                const LoraRaw nxt = lora_load(P, b, cq * 4 * CHT + (wid + 8 * (gi < 3 ? gi + 1 : gi)) * 16);
                lora_group(p, cur, lc, bh, cq * 4 * CHT + (wid + 8 * gi) * 16, lds + wid * 4352, bfrag);
                cur = nxt;
            }
            asm volatile("s_waitcnt vmcnt(0)" ::: "memory");
            __syncthreads();
            if (tid == 0) __builtin_amdgcn_fence(__ATOMIC_ACQUIRE, "agent");
            asm volatile("s_waitcnt vmcnt(0)" ::: "memory");
        }
        R1STAMP(2);
        v2f z[4][8];
#pragma unroll
        for (int rr = 0; rr < 4; ++rr)
#pragma unroll
            for (int c = 0; c < 16; ++c) z[rr][c >> 1][c & 1] = (rr < 2 && (32 * role + 2 * g + rr) == (16 * q + c)) ? 1.f : 0.f;
        bf16_t* qh = (bf16_t*)(fr + OFF_QH) + (size_t)bh * T * 64;
        float* bon = (float*)(fr + OFF_BON) + (size_t)bh * T;
        float Lb[4] = {0.f, 0.f, 0.f, 0.f};
        unsigned char* rawbuf = lds + 64 * 384 * 4 + 16384 + 2048;
#define RAW_DMA(sl_) do { int ln_ = lane; asm volatile("" : "+v"(ln_)); _Pragma("unroll") for (int u_ = 0; u_ < 4; ++u_) { const int slot_ = u_ * 8 + wid; if (slot_ < 26) { int pi = slot_ * 64 + ln_; pi = pi < 1632 ? pi : 1631; \
            const int clx = pi / 408, rem = pi - clx * 408, row = rem / 24, r2 = rem - row * 24, seg = r2 >> 3, p16 = r2 & 7; int tt = (cq * 4 + clx) * CHT + (sl_) * 16 - 1 + row; tt = tt < 0 ? 0 : tt; \
            __builtin_amdgcn_global_load_lds((const unsigned*)(P + (size_t)(b * T + tt) * NP + (seg == 0 ? C_R : seg == 1 ? C_K : C_V) + h * 64 + p16 * 8), (LAS unsigned*)(LASP(rawbuf) + slot_ * 1024), 16, 0, 0); } } \
              \
            _Pragma("unroll") for (int u_ = 0; u_ < 2; ++u_) { const int j_ = u_ * 8 + wid, clx = j_ >> 2, part = (j_ >> 1) & 1, half = j_ & 1; \
            const unsigned char* src_ = p.ws + (part ? OFF_ALF : OFF_LWF) + ((size_t)(bh * 512 + (((cq * 4 + clx) * CHT + (sl_) * 16) >> 4)) * 4) * 64 * 8 + half * 1024 + ln_ * 16; \
            __builtin_amdgcn_global_load_lds((const unsigned*)src_, (LAS unsigned*)(LASP(bfrag) + clx * 4096 + part * 2048 + half * 1024), 16, 0, 0); } } while (0)
        RAW_DMA(0);
#pragma unroll 1
        for (int sl = 0; sl < CHT / 16; ++sl) {
            const int tb = (cq * 4 + cl) * CHT + sl * 16;
            unsigned ts0_ = 0; if (STAMP_PH >= 30) ts0_ = (unsigned)__builtin_amdgcn_s_memrealtime();
            __syncthreads();
            R1ACC(2, ts0_); if (STAMP_PH >= 30) ts0_ = (unsigned)__builtin_amdgcn_s_memrealtime();
            if (role == 0) stage16s<0>(p, rawbuf + cl * 6528, bfrag + cl * 4096, cst, h, bh, tb, ck + cl * 16 * 384, bon, Lb);
            else           stage16s<1>(p, rawbuf + cl * 6528, bfrag + cl * 4096, cst, h, bh, tb, ck + cl * 16 * 384, bon, Lb);
            __syncthreads();
            R1ACC(0, ts0_); if (STAMP_PH >= 30) ts0_ = (unsigned)__builtin_amdgcn_s_memrealtime();
            if (sl + 1 < CHT / 16) RAW_DMA(sl + 1);
            float yo[4];
            {
                const int rowl = 32 * role + 2 * g + (q & 1);
                bf16_t* dstp = q < 2 ? qh + (size_t)tb * 64 + rowl : YA + (size_t)(b * T + tb) * 512 + h * 64 + rowl;
                const int dsts = q < 2 ? 64 : 512;
#pragma unroll 1
                for (int i = 0; i < 16; ++i) { rwkv_step_m(z, ck + (cl * 16 + i) * 384, q, 32 * role + 2 * g, yo);
                    *dstp = f2bf(q == 0 ? yo[0] : q == 1 ? yo[1] : q == 2 ? yo[2] : yo[3]); dstp += dsts; }
            }
            R1ACC(1, ts0_);
        }
        R1STAMP(3);
        {
            float* gC = (float*)(lds + 64 * 384 * 4 + 16384) + wid * 64;
            __syncthreads();
            if ((lane >> 4) == 0) {
#pragma unroll
                for (int nt = 0; nt < 4; ++nt) gC[16 * nt + (lane & 15)] = __expf(fmaxf(Lb[nt], -80.f));
            }
            asm volatile("s_waitcnt lgkmcnt(0)" ::: "memory");
#pragma unroll
            for (int u = 0; u < 4; ++u) { const f32x4 g4 = *(const f32x4*)(gC + 16 * q + 4 * u);
#pragma unroll
                for (int rr = 0; rr < 4; ++rr)
#pragma unroll
                    for (int e = 0; e < 4; ++e) z[rr][2 * u + (e >> 1)][e & 1] *= g4[e]; }
        }
        for (int pass = 0; pass < 2; ++pass) {
            __syncthreads();
            {
#pragma unroll
                for (int r2 = 0; r2 < 2; ++r2) { const int rr = 2 * pass + r2;
#pragma unroll
                    for (int u = 0; u < 4; ++u) *(f32x4*)(mat + (cl * 64 + 32 * role + 2 * g + r2) * 68 + 16 * q + 4 * u) = (f32x4){z[rr][2 * u][0], z[rr][2 * u][1], z[rr][2 * u + 1][0], z[rr][2 * u + 1][1]}; }
            }
            __syncthreads();
            int tidb = threadIdx.x; asm volatile("" : "+v"(tidb));
            if (pass == 0) {
                for (int it = tidb; it < 4 * 8 * 64; it += NTHREADS) {
                    const int clx = it >> 9, f = (it >> 6) & 7, l = it & 63, n16 = l & 15, gg = l >> 4, fi = f >> 1, fs = f & 1;
                    const size_t chunk = (size_t)bh * NCHUNK + cq * 4 + clx;
                    unsigned hi[4], lo[4];
#pragma unroll
                    for (int e2 = 0; e2 < 4; ++e2) {
                        unsigned short hs[2], ls[2];
#pragma unroll
                        for (int d = 0; d < 2; ++d) { const int e = 2 * e2 + d, kin = 32 * fs + 16 * (e >> 2) + 4 * gg + (e & 3), kout = 16 * fi + n16;
                            const float val = mat[(clx * 64 + kin) * 68 + kout]; hs[d] = f2bf(val); ls[d] = f2bf(val - bf2f(hs[d])); }
                        hi[e2] = (unsigned)hs[0] | ((unsigned)hs[1] << 16); lo[e2] = (unsigned)ls[0] | ((unsigned)ls[1] << 16);
                    }
                    unsigned char* dst = fr + OFF_AF + chunk * AF_BYTES + (size_t)((f * 2) * 64 + l) * 16;
                    *(uint4*)dst = make_uint4(hi[0], hi[1], hi[2], hi[3]);
                    *(uint4*)(dst + 64 * 16) = make_uint4(lo[0], lo[1], lo[2], lo[3]);
                }
            } else {
                for (int it = tidb; it < 4 * 4 * 4 * 64; it += NTHREADS) {
                    const int l = it & 63, fi = (it >> 6) & 3, w4 = (it >> 8) & 3, clx = it >> 10, gg = l >> 4;
                    const size_t chunk = (size_t)bh * NCHUNK + cq * 4 + clx;
                    const f32x4 v4 = *(const f32x4*)(mat + (clx * 64 + 16 * w4 + (l & 15)) * 68 + 16 * fi + 4 * gg);
                    *(f32x4*)(fr + OFF_NF + chunk * NF_BYTES + (size_t)(((w4 * 4 + fi) * 64 + l) * 4) * 4) = v4;
                }
            }
        }
        R1STAMP(4);
    }
}

DI void split4x2(const f32x4& xa, const f32x4& xb, bf16x8& hi, bf16x8& lo) {
#pragma unroll
    for (int e = 0; e < 4; ++e) { const float va = xa[e], vb = xb[e]; const bf16_t ha = f2bf(va), hb = f2bf(vb);
        hi[e] = (short)ha; hi[4 + e] = (short)hb; lo[e] = (short)f2bf(va - bf2f(ha)); lo[4 + e] = (short)f2bf(vb - bf2f(hb)); }
}
DI void phase_rwkv_scan(const Params& p, unsigned char* lds, const int bh) {
    unsigned char* fr = (unsigned char*)p.out;
    const int tid = threadIdx.x, lane = tid & 63, wid = tid >> 6;
    const unsigned char* gA = fr + OFF_AF + (size_t)bh * NCHUNK * AF_BYTES;
    unsigned char* gN = fr + OFF_NF + (size_t)bh * NCHUNK * NF_BYTES;
    const bool loader = wid >= 4;
    const int wl = __builtin_amdgcn_readfirstlane(wid - 4);
#define SCAN_DMA(cc_) do { const unsigned char* ga_ = gA + (size_t)(cc_) * AF_BYTES + wl * 4096 + lane * 16; const unsigned char* gn_ = gN + (size_t)(cc_) * NF_BYTES + wl * 4096 + lane * 16; \
        __attribute__((address_space(3))) unsigned char* sl_ = LASP(lds) + ((cc_) & 3) * 32768 + wl * 4096; \
        _Pragma("unroll") for (int j_ = 0; j_ < 4; ++j_) __builtin_amdgcn_global_load_lds((const unsigned*)(ga_ + j_ * 1024), (__attribute__((address_space(3))) unsigned*)(sl_ + j_ * 1024), 16, 0, 0); \
        _Pragma("unroll") for (int j_ = 0; j_ < 4; ++j_) __builtin_amdgcn_global_load_lds((const unsigned*)(gn_ + j_ * 1024), (__attribute__((address_space(3))) unsigned*)(sl_ + 16384 + j_ * 1024), 16, 0, 0); } while (0)
    __syncthreads();
    if (loader) { SCAN_DMA(0); SCAN_DMA(1); SCAN_DMA(2); SCAN_DMA(3); asm volatile("s_waitcnt vmcnt(0)" ::: "memory"); }
    f32x4 X[4];
#pragma unroll
    for (int i = 0; i < 4; ++i) X[i] = (f32x4){0.f, 0.f, 0.f, 0.f};
    bf16x8 ah[8], al[8]; f32x4 nt[4];
#define SCAN_FRAGS(cc_) do { const unsigned char* s_ = lds + ((cc_) & 3) * 32768; \
        _Pragma("unroll") for (int f = 0; f < 8; ++f) { ah[f] = *(const bf16x8*)(s_ + ((f * 2) * 64 + lane) * 16); al[f] = *(const bf16x8*)(s_ + ((f * 2 + 1) * 64 + lane) * 16); } \
        _Pragma("unroll") for (int i = 0; i < 4; ++i) nt[i] = *(const f32x4*)(s_ + 16384 + ((wid * 4 + i) * 64 + lane) * 16); } while (0)
    asm volatile("s_waitcnt lgkmcnt(0)" ::: "memory"); __builtin_amdgcn_s_barrier(); asm volatile("" ::: "memory");
    if (!loader) SCAN_FRAGS(0);
    for (int c = 0; c < (int)NCHUNK; ++c) {
        if (loader) {
            if (c + 4 < (int)NCHUNK) { SCAN_DMA(c + 4); asm volatile("s_waitcnt vmcnt(16)" ::: "memory"); } else asm volatile("s_waitcnt vmcnt(0)" ::: "memory");
        } else {
            const int w4 = wid;
            float* gs = (float*)(gN + (size_t)c * NF_BYTES) + ((w4 * 4) * 64 + lane) * 4;
#pragma unroll
            for (int i = 0; i < 4; ++i) *(f32x4*)(gs + i * 256) = X[i];
            bf16x8 bhi[2], blo[2];
            split4x2(X[0], X[1], bhi[0], blo[0]); split4x2(X[2], X[3], bhi[1], blo[1]);
#pragma unroll
            for (int i = 0; i < 4; ++i) {
                f32x4 D = nt[i];
#pragma unroll
                for (int s = 0; s < 2; ++s) {
                    const int f = i * 2 + s;
                    D = __builtin_amdgcn_mfma_f32_16x16x32_bf16(ah[f], bhi[s], D, 0, 0, 0);
                    D = __builtin_amdgcn_mfma_f32_16x16x32_bf16(ah[f], blo[s], D, 0, 0, 0);
                    D = __builtin_amdgcn_mfma_f32_16x16x32_bf16(al[f], bhi[s], D, 0, 0, 0);
                }
                X[i] = D;
            }
            if (c + 1 < (int)NCHUNK) SCAN_FRAGS(c + 1);
        }
        asm volatile("s_waitcnt lgkmcnt(0)" ::: "memory"); __builtin_amdgcn_s_barrier(); asm volatile("" ::: "memory");
    }
    asm volatile("s_waitcnt vmcnt(0)" ::: "memory");
    __syncthreads();
    if (tid == 0) {
        __builtin_amdgcn_fence(__ATOMIC_RELEASE, "agent");
        asm volatile("s_waitcnt vmcnt(0)" ::: "memory");
        __hip_atomic_store((unsigned*)(p.ws + OFF_CTL + 32768 + 256) + bh, 1u, __ATOMIC_RELAXED, __HIP_MEMORY_SCOPE_AGENT);
    }
}

DI unsigned pk2(float lo, float hi) { typedef float f2_ __attribute__((ext_vector_type(2))); typedef __bf16 b2_ __attribute__((ext_vector_type(2))); return __builtin_bit_cast(unsigned, __builtin_convertvector((f2_){lo, hi}, b2_)); }
DI void unpack8(const uint4& v, float (&x)[8]) { const unsigned w[4] = {v.x, v.y, v.z, v.w};
#pragma unroll
    for (int i = 0; i < 4; ++i) { x[2 * i] = __uint_as_float(w[i] << 16); x[2 * i + 1] = __uint_as_float(w[i] & 0xffff0000u); } }
DI uint4 pack8f(const float (&x)[8]) { return make_uint4(pk2(x[0], x[1]), pk2(x[2], x[3]), pk2(x[4], x[5]), pk2(x[6], x[7])); }
DI void rwkv_out_item(const Params& p, unsigned char* lds, const int item) {
    const bf16_t* P = (const bf16_t*)(p.ws + OFF_P); bf16_t* YA = (bf16_t*)(p.ws + OFF_YA);
    const unsigned char* fr = (const unsigned char*)p.out;
    int tid = threadIdx.x; asm volatile("" : "+v"(tid));
    const int lane = tid & 63, wid = __builtin_amdgcn_readfirstlane(tid >> 6), c = lane & 31, hh = lane >> 5;
    {
        const int chunkg = item * 2 + (wid >> 2), bh = chunkg >> 6, cc = chunkg & 63, b = bh >> 3, h = bh & 7, tt = wid & 3;
        const int t = cc * CHT + tt * 32 + c;
        const float* sf = (const float*)(fr + OFF_NF + (size_t)chunkg * NF_BYTES);
        const bf16_t* qh = (const bf16_t*)(fr + OFF_QH) + ((size_t)bh * T + t) * 64;
        bf16x8 qf[4];
#pragma unroll
        for (int ks = 0; ks < 4; ++ks) qf[ks] = *(const bf16x8*)(qh + 16 * ks + 8 * hh);
        f32x16 yt[2];
#pragma unroll
        for (int vt = 0; vt < 2; ++vt) {
#pragma unroll
            for (int i = 0; i < 16; ++i) yt[vt][i] = 0.f;
#pragma unroll
            for (int ks = 0; ks < 4; ++ks) {
                const int v = 32 * vt + c;
                const float* s0 = sf + (((v >> 4) * 4 + ks) * 64 + (v & 15) + 32 * hh) * 4;
                const f32x4 lo4 = *(const f32x4*)s0, hi4 = *(const f32x4*)(s0 + 64);
                bf16x8 ah, al;
#pragma unroll
                for (int e = 0; e < 4; ++e) { const bf16_t h0 = f2bf(lo4[e]), h1 = f2bf(hi4[e]); ah[e] = (short)h0; ah[4 + e] = (short)h1;
                    al[e] = (short)f2bf(lo4[e] - bf2f(h0)); al[4 + e] = (short)f2bf(hi4[e] - bf2f(h1)); }
                yt[vt] = MFMA32(ah, qf[ks], yt[vt]);
                yt[vt] = MFMA32(al, qf[ks], yt[vt]);
            }
        }
        float* ybuf = (float*)lds + wid * (32 * 68);
#pragma unroll
        for (int vt = 0; vt < 2; ++vt)
#pragma unroll
            for (int gq = 0; gq < 4; ++gq) *(f32x4*)(ybuf + c * 68 + 32 * vt + 8 * gq + 4 * hh) = (f32x4){yt[vt][4 * gq], yt[vt][4 * gq + 1], yt[vt][4 * gq + 2], yt[vt][4 * gq + 3]};
        asm volatile("s_waitcnt lgkmcnt(0)" ::: "memory");
        const int j8 = lane & 7, tl = lane >> 3, ch0 = h * 64 + 8 * j8;
        const f32x4 mu0 = *(const f32x4*)(p.mu_rkv + 1024 + ch0), mu1 = *(const f32x4*)(p.mu_rkv + 1024 + ch0 + 4);
        const f32x4 lg0 = *(const f32x4*)(p.lnx_g + ch0), lg1 = *(const f32x4*)(p.lnx_g + ch0 + 4), lb0 = *(const f32x4*)(p.lnx_b + ch0), lb1 = *(const f32x4*)(p.lnx_b + ch0 + 4);
        const float mu[8] = {mu0[0], mu0[1], mu0[2], mu0[3], mu1[0], mu1[1], mu1[2], mu1[3]}, lg[8] = {lg0[0], lg0[1], lg0[2], lg0[3], lg1[0], lg1[1], lg1[2], lg1[3]};
        const float lb[8] = {lb0[0], lb0[1], lb0[2], lb0[3], lb1[0], lb1[1], lb1[2], lb1[3]};
#pragma unroll
        for (int it = 0; it < 4; ++it) {
            const int tok = 8 * it + tl, t2 = cc * CHT + tt * 32 + tok;
            const size_t row = (size_t)(b * T + t2);
            bf16_t* yrow = YA + row * 512 + ch0;
            const bf16_t* pr = P + row * NP;
            const uint4 yl4 = *(const uint4*)yrow, vc4 = *(const uint4*)(pr + C_V + ch0), zz4 = *(const uint4*)(pr + C_ZA + ch0);
            uint4 vp4 = make_uint4(0u, 0u, 0u, 0u); if (t2 > 0) vp4 = *(const uint4*)(pr - NP + C_V + ch0);
            const float bon = *((const float*)(fr + OFF_BON) + (size_t)bh * T + t2);
            const f32x4 ya = *(const f32x4*)(ybuf + tok * 68 + 8 * j8), yb = *(const f32x4*)(ybuf + tok * 68 + 8 * j8 + 4);
            float y[8] = {ya[0], ya[1], ya[2], ya[3], yb[0], yb[1], yb[2], yb[3]}, yl[8], vc[8], vp[8], zz[8];
            unpack8(yl4, yl); unpack8(vc4, vc); unpack8(vp4, vp); unpack8(zz4, zz);
            float s1 = 0.f;
#pragma unroll
            for (int e = 0; e < 8; ++e) { y[e] += yl[e]; s1 += y[e]; }
            s1 = quad_sum(s1); s1 += __int_as_float(__builtin_amdgcn_update_dpp(0, __float_as_int(s1), 0x141, 0xF, 0xF, true));
            const float mean = s1 * (1.f / 64.f);
            float s2 = 0.f;
#pragma unroll
            for (int e = 0; e < 8; ++e) { y[e] -= mean; s2 += y[e] * y[e]; }
            s2 = quad_sum(s2); s2 += __int_as_float(__builtin_amdgcn_update_dpp(0, __float_as_int(s2), 0x141, 0xF, 0xF, true));
            const float rstd = rsqrtf(s2 * (1.f / 64.f) + 64e-5f);
            float o[8];
#pragma unroll
            for (int e = 0; e < 8; ++e) { const float vmix = vc[e] + (vp[e] - vc[e]) * mu[e]; o[e] = (y[e] * rstd * lg[e] + lb[e] + bon * vmix) * siluf_(zz[e]); }
            *(uint4*)yrow = pack8f(o);
        }
    }
}

DI void phase_swa_simple(const Params& p, unsigned char* lds, const int bid, const int nb) {
    const bf16_t* P = (const bf16_t*)(p.ws + OFF_P); bf16_t* YB = (bf16_t*)(p.ws + OFF_YB);
    const long total = (long)BATCH * 8 * T;
    for (long it = (long)bid * NTHREADS + threadIdx.x; it < total; it += (long)nb * NTHREADS) {
        const int t = (int)(it % T), qh = (int)((it / T) % 8), b = (int)(it / ((long)T * 8)), kvh = qh >> 2;
        const size_t row = (size_t)(b * T + t);
        float q[64], acc[64];
        {
            const uint4* qp = (const uint4*)(P + row * NP + C_Q + qh * 64);
#pragma unroll
            for (int i = 0; i < 8; ++i) { const uint4 u = qp[i]; const unsigned w[4] = {u.x, u.y, u.z, u.w};
#pragma unroll
                for (int j = 0; j < 4; ++j) { q[i * 8 + j * 2] = __uint_as_float(w[j] << 16); q[i * 8 + j * 2 + 1] = __uint_as_float(w[j] & 0xffff0000u); } }
        }
#pragma unroll
        for (int d = 0; d < 64; ++d) acc[d] = 0.f;
        float m = p.sinks[qh], l = 1.f;
        for (int j = 0; j < 128; ++j) {
            const int s = t - 127 + j;
            if (s < 0) continue;
            const size_t krow = (size_t)(b * T + s) * NP;
            const uint4* kp = (const uint4*)(P + krow + C_SK + kvh * 64);
            float dot = 0.f;
#pragma unroll
            for (int i = 0; i < 8; ++i) { const uint4 u = kp[i]; const unsigned w[4] = {u.x, u.y, u.z, u.w};
#pragma unroll
                for (int jj = 0; jj < 4; ++jj) { dot += q[i * 8 + jj * 2] * __uint_as_float(w[jj] << 16) + q[i * 8 + jj * 2 + 1] * __uint_as_float(w[jj] & 0xffff0000u); } }
            const float sc = dot * 0.125f;
            const float mn = fmaxf(m, sc), corr = __expf(m - mn), pe = __expf(sc - mn);
            l = l * corr + pe; m = mn;
            const uint4* vp = (const uint4*)(P + krow + C_SV + kvh * 64);
#pragma unroll
            for (int i = 0; i < 8; ++i) { const uint4 u = vp[i]; const unsigned w[4] = {u.x, u.y, u.z, u.w};
#pragma unroll
                for (int jj = 0; jj < 4; ++jj) { acc[i * 8 + jj * 2] = acc[i * 8 + jj * 2] * corr + pe * __uint_as_float(w[jj] << 16);
                                                 acc[i * 8 + jj * 2 + 1] = acc[i * 8 + jj * 2 + 1] * corr + pe * __uint_as_float(w[jj] & 0xffff0000u); } }
        }
        const float inv = 1.f / l;
        const bf16_t* zp = P + row * NP + C_ZB + qh * 64; bf16_t* op = YB + row * 512 + qh * 64;
#pragma unroll
        for (int d = 0; d < 64; ++d) op[d] = f2bf(acc[d] * inv * siluf_(bf2f(zp[d])));
    }
}

DI void phase_xattn_simple(const Params& p, unsigned char* lds, const int bid, const int nb) {
    const bf16_t* P = (const bf16_t*)(p.ws + OFF_P); const bf16_t* KVM = (const bf16_t*)(p.ws + OFF_KVM); bf16_t* YC = (bf16_t*)(p.ws + OFF_YC);
    const int lane = threadIdx.x & 63, wid = threadIdx.x >> 6;
    const long total = (long)M * 4;
    const float scale = 0.08838834764831845f;
    for (long it = (long)bid * NWAVES + wid; it < total; it += (long)nb * NWAVES) {
        const int row = (int)(it >> 2), hd = (int)(it & 3), b = row / T;
        const bf16_t* qp = P + (size_t)row * NP + C_XQ + hd * 128;
        const bf16_t* kb = KVM + (size_t)(b * MEMLEN) * 1024 + hd * 128;
        float s[4] = {0.f, 0.f, 0.f, 0.f};
        for (int c = 0; c < 16; ++c) {
            const uint4 qu = *(const uint4*)(qp + c * 8); const unsigned qw[4] = {qu.x, qu.y, qu.z, qu.w};
#pragma unroll
            for (int i = 0; i < 4; ++i) {
                const uint4 ku = *(const uint4*)(kb + (size_t)(lane + 64 * i) * 1024 + c * 8); const unsigned kw[4] = {ku.x, ku.y, ku.z, ku.w};
#pragma unroll
                for (int j = 0; j < 4; ++j) s[i] += __uint_as_float(qw[j] << 16) * __uint_as_float(kw[j] << 16) + __uint_as_float(qw[j] & 0xffff0000u) * __uint_as_float(kw[j] & 0xffff0000u);
            }
        }
        float mx = -1e30f;
#pragma unroll
        for (int i = 0; i < 4; ++i) { s[i] *= scale; mx = fmaxf(mx, s[i]); }
        mx = wave_max(mx);
        float pe[4], sum = 0.f;
#pragma unroll
        for (int i = 0; i < 4; ++i) { pe[i] = __expf(s[i] - mx); sum += pe[i]; }
        sum = wave_sum(sum);
        const float inv = 1.f / sum;
        float o0 = 0.f, o1 = 0.f;
        const bf16_t* vb = kb + 512;
#pragma unroll
        for (int i = 0; i < 4; ++i)
            for (int mm = 0; mm < 64; ++mm) {
                const float pv = __shfl(pe[i], mm, 64);
                const bf16_t* vr = vb + (size_t)(mm + 64 * i) * 1024;
                o0 += pv * bf2f(vr[lane]); o1 += pv * bf2f(vr[lane + 64]);
            }
        const bf16_t* zp = P + (size_t)row * NP + C_ZC + hd * 128; bf16_t* op = YC + (size_t)row * 512 + hd * 128;
        op[lane] = f2bf(o0 * inv * siluf_(bf2f(zp[lane]))); op[lane + 64] = f2bf(o1 * inv * siluf_(bf2f(zp[lane + 64])));
    }
}

typedef short s16x4 __attribute__((ext_vector_type(4)));
DI int crow(int reg, int hh) { return (reg & 3) + 8 * (reg >> 2) + 4 * hh; }
template <int Dh> DI unsigned k_off(int row, int chunk) { return (unsigned)(row * (Dh * 2) + ((chunk ^ (row & (Dh / 8 - 1))) << 4)); }
DI bf16x8 pack8(const f32x16& x, int s) {
    bf16x8 r;
#pragma unroll
    for (int e = 0; e < 8; ++e) r[e] = (short)f2bf(x[8 * s + e]);
    return r;
}
constexpr int VS = 528;

DI void swa_unit(const Params& p, unsigned char* lds, int unit) {
    const bf16_t* P = (const bf16_t*)(p.ws + OFF_P); bf16_t* YB = (bf16_t*)(p.ws + OFF_YB);
    int tid = threadIdx.x; asm volatile("" : "+v"(tid));
    const int lane = tid & 63, wid = __builtin_amdgcn_readfirstlane(tid >> 6), c = lane & 31, hh = lane >> 5;
    const int n = unit & 63, kvh = (unit >> 6) & 1, b = unit >> 7;
    unsigned char* Kl = lds; unsigned char* Vt = lds + 32768;
    __syncthreads();
#pragma unroll
    for (int u = 0; u < 4; ++u) {
        const int idx = tid + 512 * u;
        { const int row = idx >> 3, chunk = idx & 7, t = n * 128 - 128 + row, tc = t < 0 ? 0 : t;
          const uint4 v = *(const uint4*)(P + (size_t)(b * T + tc) * NP + C_SK + kvh * 64 + chunk * 8);
          float x[8]; unpack8(v, x);
          float ss = 0.f;
#pragma unroll
          for (int e = 0; e < 8; ++e) ss += x[e] * x[e];
          ss = quad_sum(ss); ss += __shfl_xor(ss, 4, 64);
          const float rs = rsqrtf(ss * (1.f / 64.f) + 1e-6f);
          const float2* rp = (const float2*)(p.ws + OFF_ROPE) + (size_t)(b * T + tc) * 32 + (chunk & 3) * 8;
          float o[8];
#pragma unroll
          for (int e = 0; e < 8; ++e) { const float y = x[e] * rs * p.k_norm_g[chunk * 8 + e]; const float yp = __shfl_xor(y, 4, 64); const float2 cs = rp[e];
              o[e] = chunk < 4 ? y * cs.x - yp * cs.y : y * cs.x + yp * cs.y; if (t < 0) o[e] = 0.f; }
          *(uint4*)(Kl + k_off<64>(row, chunk)) = pack8f(o); }
        { const int row = idx >> 3, chunk = idx & 7, t = n * 128 - 128 + row;
          uint4 v = make_uint4(0u, 0u, 0u, 0u);
          if (t >= 0) v = *(const uint4*)(P + (size_t)(b * T + t) * NP + C_SV + kvh * 64 + chunk * 8);
          *(uint4*)(Vt + k_off<64>(row, chunk)) = v; }
    }
    __syncthreads();
    const int qh = kvh * 4 + (wid >> 1), rh = wid & 1;
    const float sink = p.sinks[qh];
#pragma unroll 2
    for (int rt = 0; rt < 2; ++rt) {
        const int base = 64 * rh + 32 * rt;
        const size_t qrow = (size_t)(b * T + n * 128 + base + c);
        bf16x8 qf[4];
        {
            float xq[4][8]; float ss = 0.f;
#pragma unroll
            for (int ds = 0; ds < 4; ++ds) { unpack8(*(const uint4*)(P + qrow * NP + C_Q + qh * 64 + 16 * ds + 8 * hh), xq[ds]);
#pragma unroll
                for (int e = 0; e < 8; ++e) ss += xq[ds][e] * xq[ds][e]; }
            ss += __shfl_xor(ss, 32, 64);
            const float rs = rsqrtf(ss * (1.f / 64.f) + 1e-6f);
#pragma unroll
            for (int ds = 0; ds < 4; ++ds)
#pragma unroll
                for (int e = 0; e < 8; ++e) xq[ds][e] *= rs * p.q_norm_g[16 * ds + 8 * hh + e];
            const float2* rp = (const float2*)(p.ws + OFF_ROPE) + qrow * 32 + 8 * hh;
#pragma unroll
            for (int ds = 0; ds < 2; ++ds) { float lo[8], hi[8];
#pragma unroll
                for (int e = 0; e < 8; ++e) { const float2 cs = rp[16 * ds + e]; lo[e] = xq[ds][e] * cs.x - xq[ds + 2][e] * cs.y; hi[e] = xq[ds + 2][e] * cs.x + xq[ds][e] * cs.y; }
                qf[ds] = __builtin_bit_cast(bf16x8, pack8f(lo)); qf[ds + 2] = __builtin_bit_cast(bf16x8, pack8f(hi)); }
        }
        f32x16 st[5];
#pragma unroll
        for (int kt = 0; kt < 5; ++kt) {
#pragma unroll
            for (int i = 0; i < 16; ++i) st[kt][i] = 0.f;
#pragma unroll
            for (int ds = 0; ds < 4; ++ds) { const bf16x8 a = *(const bf16x8*)(Kl + k_off<64>(base + 32 * kt + c, 2 * ds + hh)); st[kt] = MFMA32(a, qf[ds], st[kt]); }
        }
        float mx = sink;
#pragma unroll
        for (int kt = 0; kt < 5; ++kt)
#pragma unroll
            for (int i = 0; i < 16; ++i) {
                const int cr = crow(i, hh);
                bool ok = true;
                if (kt == 0) ok = cr > c;
                if (kt == 4) ok = cr <= c;
                if (n == 0) ok = ok && (base + 32 * kt + cr >= 128);
                const float s = ok ? st[kt][i] * 0.125f : -1e30f;
                st[kt][i] = s; mx = fmaxf(mx, s);
            }
        mx = fmaxf(mx, __shfl_xor(mx, 32, 64));
        float ls = 0.f;
#pragma unroll
        for (int kt = 0; kt < 5; ++kt)
#pragma unroll
            for (int i = 0; i < 16; ++i) { const float pe = __expf(st[kt][i] - mx); st[kt][i] = pe; ls += pe; }
        ls += __shfl_xor(ls, 32, 64);
        const float inv = 1.f / (ls + __expf(sink - mx));
        f32x16 ot[2];
#pragma unroll
        for (int dt = 0; dt < 2; ++dt)
#pragma unroll
            for (int i = 0; i < 16; ++i) ot[dt][i] = 0.f;
#pragma unroll
        for (int kt = 0; kt < 5; ++kt)
#pragma unroll
            for (int s = 0; s < 2; ++s) {
                const bf16x8 pf = pack8(st[kt], s);
#pragma unroll
                for (int dt = 0; dt < 2; ++dt) {
                    const int key0 = base + 32 * kt + 16 * s + 4 * hh + ((lane & 15) >> 2), ch16 = 4 * dt + 2 * ((lane >> 4) & 1) + ((lane & 3) >> 1), sub = (lane & 1) * 8;
                    const s16x4 lo = __builtin_amdgcn_ds_read_tr16_b64_v4i16((LAS s16x4*)(Vt + k_off<64>(key0, ch16) + sub));
                    const s16x4 hi = __builtin_amdgcn_ds_read_tr16_b64_v4i16((LAS s16x4*)(Vt + k_off<64>(key0 + 8, ch16) + sub));
                    const bf16x8 vf = __builtin_shufflevector(lo, hi, 0, 1, 2, 3, 4, 5, 6, 7);
                    ot[dt] = MFMA32(vf, pf, ot[dt]);
                }
            }
        const bf16_t* zp = P + qrow * NP + C_ZB + qh * 64; bf16_t* op = YB + qrow * 512 + qh * 64;
#pragma unroll
        for (int dt = 0; dt < 2; ++dt)
#pragma unroll
            for (int gq = 0; gq < 4; ++gq) {
                const int d0 = 32 * dt + 8 * gq + 4 * hh;
                const uint2 zz = *(const uint2*)(zp + d0);
                const float z0 = __uint_as_float(zz.x << 16), z1 = __uint_as_float(zz.x & 0xffff0000u), z2 = __uint_as_float(zz.y << 16), z3 = __uint_as_float(zz.y & 0xffff0000u);
                const unsigned o0 = (unsigned)f2bf(ot[dt][4 * gq] * inv * siluf_(z0)) | ((unsigned)f2bf(ot[dt][4 * gq + 1] * inv * siluf_(z1)) << 16);
                const unsigned o1 = (unsigned)f2bf(ot[dt][4 * gq + 2] * inv * siluf_(z2)) | ((unsigned)f2bf(ot[dt][4 * gq + 3] * inv * siluf_(z3)) << 16);
                *(uint2*)(op + d0) = make_uint2(o0, o1);
            }
    }
}

DI void xattn_unit(const Params& p, unsigned char* lds, int unit) {
    const bf16_t* P = (const bf16_t*)(p.ws + OFF_P); const bf16_t* KVM = (const bf16_t*)(p.ws + OFF_KVM); bf16_t* YC = (bf16_t*)(p.ws + OFF_YC);
    int tid = threadIdx.x; asm volatile("" : "+v"(tid));
    const int lane = tid & 63, wid = __builtin_amdgcn_readfirstlane(tid >> 6), c = lane & 31, hh = lane >> 5;
    const int qb = unit & 31, hd = (unit >> 5) & 3, b = unit >> 7;
    unsigned char* Kl = lds; unsigned char* Vt = lds + 65536;
    const bf16_t* kb = KVM + (size_t)(b * MEMLEN) * 1024 + hd * 128;
    __syncthreads();
#pragma unroll
    for (int u = 0; u < 8; ++u) {
        const int idx = tid + 512 * u;
        { const int row = idx >> 4, chunk = idx & 15;
          float x[8]; unpack8(*(const uint4*)(kb + (size_t)row * 1024 + chunk * 8), x);
          float ss = 0.f;
#pragma unroll
          for (int e = 0; e < 8; ++e) ss += x[e] * x[e];
          const float rs = rsqrtf(row16_sum(ss) * (1.f / 128.f) + 1e-6f);
#pragma unroll
          for (int e = 0; e < 8; ++e) x[e] *= rs * p.xk_norm_g[chunk * 8 + e];
          *(uint4*)(Kl + k_off<128>(row, chunk)) = pack8f(x); }
        { const int row = idx >> 4, chunk = idx & 15;
          *(uint4*)(Vt + k_off<128>(row, chunk)) = *(const uint4*)(kb + (size_t)row * 1024 + 512 + chunk * 8); }
    }
    __syncthreads();
    const size_t qrow = (size_t)(b * T + qb * 256 + wid * 32 + c);
    const float scale = 0.08838834764831845f;
    bf16x8 qf[8];
    {
        float ss = 0.f; uint4 raw[8];
#pragma unroll
        for (int ds = 0; ds < 8; ++ds) { raw[ds] = *(const uint4*)(P + qrow * NP + C_XQ + hd * 128 + 16 * ds + 8 * hh); float x[8]; unpack8(raw[ds], x);
#pragma unroll
            for (int e = 0; e < 8; ++e) ss += x[e] * x[e]; }
        ss += __shfl_xor(ss, 32, 64);
        const float rs = rsqrtf(ss * (1.f / 128.f) + 1e-6f);
#pragma unroll
        for (int ds = 0; ds < 8; ++ds) { float x[8]; unpack8(raw[ds], x);
#pragma unroll
            for (int e = 0; e < 8; ++e) x[e] *= rs * p.xq_norm_g[16 * ds + 8 * hh + e];
            qf[ds] = __builtin_bit_cast(bf16x8, pack8f(x)); }
    }
    f32x16 ot[4];
#pragma unroll
    for (int dt = 0; dt < 4; ++dt)
#pragma unroll
        for (int i = 0; i < 16; ++i) ot[dt][i] = 0.f;
    float mrun = -1e30f, lrun = 0.f;
#pragma unroll 1
    for (int half = 0; half < 2; ++half) {
        f32x16 st[4];
#pragma unroll
        for (int kt = 0; kt < 4; ++kt) {
#pragma unroll
            for (int i = 0; i < 16; ++i) st[kt][i] = 0.f;
#pragma unroll
            for (int ds = 0; ds < 8; ++ds) { const bf16x8 a = *(const bf16x8*)(Kl + k_off<128>(128 * half + 32 * kt + c, 2 * ds + hh)); st[kt] = MFMA32(a, qf[ds], st[kt]); }
        }
        float mx = mrun;
#pragma unroll
        for (int kt = 0; kt < 4; ++kt)
#pragma unroll
            for (int i = 0; i < 16; ++i) { st[kt][i] *= scale; mx = fmaxf(mx, st[kt][i]); }
        mx = fmaxf(mx, __shfl_xor(mx, 32, 64));
        const float corr = __expf(mrun - mx);
        float ls = 0.f;
#pragma unroll
        for (int kt = 0; kt < 4; ++kt)
#pragma unroll
            for (int i = 0; i < 16; ++i) { const float pe = __expf(st[kt][i] - mx); st[kt][i] = pe; ls += pe; }
        ls += __shfl_xor(ls, 32, 64);
        lrun = lrun * corr + ls; mrun = mx;
#pragma unroll
        for (int dt = 0; dt < 4; ++dt)
#pragma unroll
            for (int i = 0; i < 16; ++i) ot[dt][i] *= corr;
#pragma unroll
        for (int kt = 0; kt < 4; ++kt)
#pragma unroll
            for (int s = 0; s < 2; ++s) {
                const bf16x8 pf = pack8(st[kt], s);
#pragma unroll
                for (int dt = 0; dt < 4; ++dt) {
                    const int key0 = 128 * half + 32 * kt + 16 * s + 4 * hh + ((lane & 15) >> 2), ch16 = 4 * dt + 2 * ((lane >> 4) & 1) + ((lane & 3) >> 1), sub = (lane & 1) * 8;
                    const s16x4 lo = __builtin_amdgcn_ds_read_tr16_b64_v4i16((LAS s16x4*)(Vt + k_off<128>(key0, ch16) + sub));
                    const s16x4 hi = __builtin_amdgcn_ds_read_tr16_b64_v4i16((LAS s16x4*)(Vt + k_off<128>(key0 + 8, ch16) + sub));
                    const bf16x8 vf = __builtin_shufflevector(lo, hi, 0, 1, 2, 3, 4, 5, 6, 7);
                    ot[dt] = MFMA32(vf, pf, ot[dt]);
                }
            }
    }
    const float inv = 1.f / lrun;
    const bf16_t* zp = P + qrow * NP + C_ZC + hd * 128; bf16_t* op = YC + qrow * 512 + hd * 128;
#pragma unroll
    for (int dt = 0; dt < 4; ++dt)
#pragma unroll
        for (int gq = 0; gq < 4; ++gq) {
            const int d0 = 32 * dt + 8 * gq + 4 * hh;
            const uint2 zz = *(const uint2*)(zp + d0);
            const float z0 = __uint_as_float(zz.x << 16), z1 = __uint_as_float(zz.x & 0xffff0000u), z2 = __uint_as_float(zz.y << 16), z3 = __uint_as_float(zz.y & 0xffff0000u);
            const unsigned o0 = (unsigned)f2bf(ot[dt][4 * gq] * inv * siluf_(z0)) | ((unsigned)f2bf(ot[dt][4 * gq + 1] * inv * siluf_(z1)) << 16);
            const unsigned o1 = (unsigned)f2bf(ot[dt][4 * gq + 2] * inv * siluf_(z2)) | ((unsigned)f2bf(ot[dt][4 * gq + 3] * inv * siluf_(z3)) << 16);
            *(uint2*)(op + d0) = make_uint2(o0, o1);
        }
}
DI void phase_attn_queue(const Params& p, unsigned char* lds) {
    unsigned* head = (unsigned*)(p.ws + OFF_CTL + 32768);
    volatile LAS unsigned* bc = (volatile LAS unsigned*)(lds + LDS_CTL_OFF + 128);
    for (;;) {
        __syncthreads();
        if (threadIdx.x == 0) bc[0] = __hip_atomic_fetch_add(head, 1u, __ATOMIC_RELAXED, __HIP_MEMORY_SCOPE_AGENT);
        __syncthreads();
        const unsigned u = bc[0];
        if (u >= 1024u + 172u) break;
#if STAMP_PH >= 60
        unsigned* qst = (unsigned*)(p.ws + OFF_CTL + 40000); const bool qme = (blockIdx.x == gridDim.x - 1 && threadIdx.x == 0);
        unsigned qt0 = (unsigned)__builtin_amdgcn_s_memrealtime();
#define QACC(k_) do { __syncthreads(); if (qme) { qst[2 * (k_)] += (unsigned)__builtin_amdgcn_s_memrealtime() - qt0; qst[2 * (k_) + 1] += 1u; } } while (0)
#else
#define QACC(k_) do { } while (0)
#endif
        if (u >= 512u && u < 684u) { convert_late(p, lds, (int)u - 512, 172); QACC(2); continue; }
        if (u < 512u) { if (u & 1u) { xattn_unit(p, lds, (int)(u >> 1)); QACC(1); } else { swa_unit(p, lds, (int)(u >> 1)); QACC(0); } }
        else {
            const int item = (int)u - 684, bh = item >> 5;
            if (threadIdx.x == 0) {
                unsigned* flag = (unsigned*)(p.ws + OFF_CTL + 32768 + 256) + bh; unsigned sp = 0;
                while (__hip_atomic_load(flag, __ATOMIC_RELAXED, __HIP_MEMORY_SCOPE_AGENT) == 0u) { __builtin_amdgcn_s_sleep(8); if (++sp > (1u << 22)) break; }
                __builtin_amdgcn_fence(__ATOMIC_ACQUIRE, "agent");
                asm volatile("s_waitcnt vmcnt(0)" ::: "memory");
            }
            __syncthreads();
#if STAMP_PH >= 60
            if (qme) { qst[8] += (unsigned)__builtin_amdgcn_s_memrealtime() - qt0; } qt0 = (unsigned)__builtin_amdgcn_s_memrealtime();
#endif
            rwkv_out_item(p, lds, item);
            QACC(3);
        }
    }
}

namespace pg8 {
#define PG8_LAS __attribute__((address_space(3)))
typedef unsigned short bf16_t;
typedef short bf16x8 __attribute__((ext_vector_type(8)));
typedef float f32x4 __attribute__((ext_vector_type(4)));
typedef unsigned u32x4 __attribute__((ext_vector_type(4)));
constexpr int BM = 256, BK = 64, HALF = 128, HTB = HALF * BK * 2  , STAGE_BYTES = 8 * HTB, NXCD = 8, WGM = 8;

__host__ __device__ __forceinline__ int lds_byte(int r, int c) { const int st = (r >> 4) * 2 + (c >> 5), rr = r & 15, cc = c & 31, ob = rr * 64 + cc * 2; return st * 1024 + (ob ^ (((ob >> 9) & 1) << 5)); }
__host__ __device__ __forceinline__ void stage_rc(int b, int& R, int& C) { const int st = b / 1024, sb = b % 1024, swz = sb ^ (((sb >> 9) & 1) << 5); R = (st >> 1) * 16 + swz / 64; C = (st & 1) * 32 + (swz % 64) / 2; }
__host__ __device__ __forceinline__ int perm32(int rho) { const int n = rho >> 4, i = rho & 15; return 8 * (i >> 2) + 4 * n + (i & 3); }

struct Unit { int pm, pn; };
struct Gemm { const bf16_t* A; const bf16_t* Bt; int M, N, K; };

struct StaticOrder {
    int nM, nN, nwg, G, c;
    __host__ __device__ void init(int M, int N, int G_, int c_) { nM = M / BM; nN = N / BM; nwg = nM * nN; G = G_; c = c_; }
    __host__ __device__ bool next(int i, Unit& u) const {
        const long L = (long)i * G + c; if (L >= nwg) return false;
        int wgid = (int)L; { const int q = nwg / NXCD, r = nwg % NXCD, xcd = wgid % NXCD, off = wgid / NXCD; wgid = (xcd < r ? xcd * (q + 1) : r * (q + 1) + (xcd - r) * q) + off; }
        const int nig = WGM * nN, gid = wgid / nig, fm = gid * WGM, gsz = (nM - fm) < WGM ? (nM - fm) : WGM;
        u.pm = fm + ((wgid % nig) % gsz); u.pn = (wgid % nig) / gsz; return true;
    }
    __device__ __forceinline__ void a_ready(const Unit&) const {}
    __device__ __forceinline__ void done(const Unit&) const {}
};
__device__ __forceinline__ unsigned cvt_pk_bf16(float lo, float hi) { typedef float f2_ __attribute__((ext_vector_type(2))); typedef __bf16 b2_ __attribute__((ext_vector_type(2))); return __builtin_bit_cast(unsigned, __builtin_convertvector((f2_){lo, hi}, b2_)); }
typedef float f32x2 __attribute__((ext_vector_type(2)));
template <class Epi, class Sched, bool ALIGN_EPI = false, bool SP2 = false>
__device__ __forceinline__ void gemm_phase(PG8_LAS unsigned char* lds, const Gemm g, const Sched& S, const Epi& E) {
    int tid = threadIdx.x; asm volatile("" : "+v"(tid));
    const int wid = __builtin_amdgcn_readfirstlane(tid >> 6), lane = tid & 63, wr = wid >> 2, wc = wid & 3, fr = lane & 15, fq = lane >> 4;
    const int K = g.K, nt = K / BK;
    unsigned voffA[2], voffB[2];
#pragma unroll
    for (int i = 0; i < 2; ++i) { int R, C; stage_rc(tid * 16 + i * 8192, R, C); const int Rb = Epi::PERM ? ((R & ~31) + perm32(R & 31)) : R;
        voffA[i] = (unsigned)(R * K + C) * 2u; voffB[i] = (unsigned)(Rb * K + C) * 2u; }
    const size_t kstep = (size_t)(BK * 2);
    const size_t hstep = (size_t)HALF * K * 2;
    const size_t tstep = 2 * hstep;
    const unsigned ldsw = (unsigned)wid * 1024u;
    const int aoff = lds_byte(wr * 64 + fr, fq * 8), boff = lds_byte(wc * 32 + fr, fq * 8);
#define PG8_SA(b, h) (((b) * 2 + (h)) * HTB)
#define PG8_SB(b, h) ((4 + (b) * 2 + (h)) * HTB)
#define PG8_STAGE(bufoff, gbase, voff) do { _Pragma("unroll") for (int _i = 0; _i < 2; ++_i) \
        __builtin_amdgcn_global_load_lds((const unsigned*)((const char*)(gbase) + (voff)[_i]), (PG8_LAS unsigned*)(lds + (bufoff) + ldsw + _i * 8192), 16, 0, 0); } while (0)
#define PG8_LDA(dst, b, h) do { _Pragma("unroll") for (int m = 0; m < 4; ++m) _Pragma("unroll") for (int k = 0; k < 2; ++k) dst[m][k] = *(const PG8_LAS bf16x8*)(lds + PG8_SA(b, h) + aoff + m * 2048 + k * 1024); } while (0)
#define PG8_LDB(dst, b, h) do { _Pragma("unroll") for (int n = 0; n < 2; ++n) _Pragma("unroll") for (int k = 0; k < 2; ++k) dst[n][k] = *(const PG8_LAS bf16x8*)(lds + PG8_SB(b, h) + boff + n * 2048 + k * 1024); } while (0)
#define PG8_MMA(ai, bj, At, Bt) do { __builtin_amdgcn_s_setprio(1); _Pragma("unroll") for (int m = 0; m < 4; ++m) _Pragma("unroll") for (int n = 0; n < 2; ++n) _Pragma("unroll") for (int k = 0; k < 2; ++k) \
        acc[ai][bj][m][n] = __builtin_amdgcn_mfma_f32_16x16x32_bf16(Bt[n][k], At[m][k], acc[ai][bj][m][n], 0, 0, 0); __builtin_amdgcn_s_setprio(0); } while (0)
#define PG8_WAIT_V(n) asm volatile("s_waitcnt vmcnt(" #n ")" ::: "memory")
#define PG8_WAIT_L(n) asm volatile("s_waitcnt lgkmcnt(" #n ")" ::: "memory")
#define PG8_BAR __builtin_amdgcn_s_barrier()
#define PG8_SCHED __builtin_amdgcn_sched_barrier(0)
    Unit cur, nxt; int ui = 0;
    if (!S.next(0, cur)) return;
    f32x4 acc[2][2][4][2];
#pragma unroll
    for (int a = 0; a < 2; ++a)
#pragma unroll
        for (int b = 0; b < 2; ++b)
#pragma unroll
            for (int m = 0; m < 4; ++m)
#pragma unroll
                for (int n = 0; n < 2; ++n) acc[a][b][m][n] = (f32x4){0.f, 0.f, 0.f, 0.f};
    bf16x8 At[4][2], B0[2][2], B1[2][2];
    const char* cA = (const char*)g.A + (size_t)cur.pm * tstep; const char* cB = (const char*)g.Bt + (size_t)cur.pn * tstep;
    S.a_ready(cur);
    if constexpr (SP2) {
        PG8_STAGE(PG8_SB(0, 0), cB, voffB); PG8_STAGE(PG8_SB(0, 1), cB + hstep, voffB); PG8_STAGE(PG8_SA(0, 0), cA, voffA); PG8_STAGE(PG8_SA(0, 1), cA + hstep, voffA);
        if (wr == 1) PG8_BAR;
        PG8_WAIT_V(2); PG8_BAR;
        PG8_STAGE(PG8_SB(1, 0), cB + kstep, voffB); PG8_STAGE(PG8_SA(1, 0), cA + kstep, voffA); PG8_STAGE(PG8_SB(1, 1), cB + hstep + kstep, voffB);
        PG8_WAIT_V(6); PG8_BAR;
    } else {
        PG8_STAGE(PG8_SB(0, 0), cB, voffB); PG8_STAGE(PG8_SA(0, 0), cA, voffA); PG8_STAGE(PG8_SB(0, 1), cB + hstep, voffB); PG8_STAGE(PG8_SA(0, 1), cA + hstep, voffA);
        if (wr == 1) PG8_BAR;
        PG8_WAIT_V(4); PG8_BAR;
        PG8_STAGE(PG8_SB(1, 0), cB + kstep, voffB); PG8_STAGE(PG8_SA(1, 0), cA + kstep, voffA); PG8_STAGE(PG8_SB(1, 1), cB + hstep + kstep, voffB);
        PG8_WAIT_V(6); PG8_BAR;
    }
    for (;;) {
        const bool has_next = S.next(ui + 1, nxt);
        const char* nA = has_next ? (const char*)g.A + (size_t)nxt.pm * tstep : cA; const char* nB = has_next ? (const char*)g.Bt + (size_t)nxt.pn * tstep : cB;
        for (int t = 0; t < nt; t += 2) {
            const bool last = (t == nt - 2);
            const char* a1 = cA + (size_t)(t + 1) * kstep;
            const char* a2 = last ? nA : cA + (size_t)(t + 2) * kstep; const char* b2 = last ? nB : cB + (size_t)(t + 2) * kstep;
            const char* a3 = a2 + kstep; const char* b3 = b2 + kstep;
            if (last && has_next) S.a_ready(nxt);
            if constexpr (SP2) {
            PG8_LDB(B0, 0, 0); PG8_LDB(B1, 0, 1); PG8_SCHED; PG8_LDA(At, 0, 0); PG8_STAGE(PG8_SA(1, 1), a1 + hstep, voffA);
            PG8_WAIT_V(8); PG8_WAIT_L(0); PG8_BAR; PG8_MMA(0, 0, At, B0); PG8_MMA(0, 1, At, B1); PG8_BAR; PG8_SCHED;
            PG8_LDA(At, 0, 1); PG8_STAGE(PG8_SB(0, 0), b2, voffB); PG8_STAGE(PG8_SB(0, 1), b2 + hstep, voffB); PG8_STAGE(PG8_SA(0, 0), a2, voffA);
            PG8_WAIT_V(8); PG8_WAIT_L(0); PG8_BAR; PG8_MMA(1, 0, At, B0); PG8_MMA(1, 1, At, B1); PG8_BAR; PG8_SCHED;
            PG8_LDB(B0, 1, 0); PG8_LDB(B1, 1, 1); PG8_SCHED; PG8_LDA(At, 1, 0); PG8_STAGE(PG8_SA(0, 1), a2 + hstep, voffA);
            PG8_WAIT_V(8); PG8_WAIT_L(0); PG8_BAR; PG8_MMA(0, 0, At, B0); PG8_MMA(0, 1, At, B1); PG8_BAR; PG8_SCHED;
            PG8_LDA(At, 1, 1); PG8_STAGE(PG8_SB(1, 0), b3, voffB); PG8_STAGE(PG8_SB(1, 1), b3 + hstep, voffB); PG8_STAGE(PG8_SA(1, 0), a3, voffA);
            PG8_WAIT_V(8); PG8_WAIT_L(0); PG8_BAR; PG8_MMA(1, 0, At, B0); PG8_MMA(1, 1, At, B1); PG8_BAR; PG8_SCHED;
            } else {
            PG8_LDB(B0, 0, 0); PG8_SCHED; PG8_LDA(At, 0, 0); PG8_STAGE(PG8_SA(1, 1), a1 + hstep, voffA);
            PG8_WAIT_L(8); PG8_BAR; PG8_WAIT_L(0); PG8_MMA(0, 0, At, B0); PG8_BAR; PG8_SCHED;
            PG8_LDB(B1, 0, 1); PG8_STAGE(PG8_SB(0, 0), b2, voffB);
            PG8_BAR; PG8_WAIT_L(0); PG8_MMA(0, 1, At, B1); PG8_BAR;
            PG8_LDA(At, 0, 1); PG8_STAGE(PG8_SA(0, 0), a2, voffA);
            PG8_BAR; PG8_WAIT_L(0); PG8_MMA(1, 0, At, B0); PG8_BAR; PG8_SCHED;
            PG8_STAGE(PG8_SB(0, 1), b2 + hstep, voffB);
            PG8_WAIT_V(6); PG8_BAR; PG8_MMA(1, 1, At, B1); PG8_BAR;
            PG8_LDB(B0, 1, 0); PG8_SCHED; PG8_LDA(At, 1, 0); PG8_STAGE(PG8_SA(0, 1), a2 + hstep, voffA);
            PG8_WAIT_L(8); PG8_BAR; PG8_WAIT_L(0); PG8_MMA(0, 0, At, B0); PG8_BAR; PG8_SCHED;
            PG8_LDB(B1, 1, 1); PG8_STAGE(PG8_SB(1, 0), b3, voffB);
            PG8_BAR; PG8_WAIT_L(0); PG8_MMA(0, 1, At, B1); PG8_BAR;
            PG8_LDA(At, 1, 1); PG8_STAGE(PG8_SA(1, 0), a3, voffA);
            PG8_BAR; PG8_WAIT_L(0); PG8_MMA(1, 0, At, B0); PG8_BAR; PG8_SCHED;
            PG8_STAGE(PG8_SB(1, 1), b3 + hstep, voffB);
            PG8_WAIT_V(6); PG8_BAR; PG8_MMA(1, 1, At, B1); PG8_BAR;
            }
        }
        if constexpr (ALIGN_EPI) { if (wr == 0) PG8_BAR; }
        if constexpr (!Epi::AFTER_DRAIN) { E(acc, cur, wr, wc, fr, fq); S.done(cur); }
        if (!has_next) break;
        if constexpr (!Epi::CHAIN) {
#pragma unroll
        for (int a = 0; a < 2; ++a)
#pragma unroll
            for (int b = 0; b < 2; ++b)
#pragma unroll
                for (int m = 0; m < 4; ++m)
#pragma unroll
                    for (int n = 0; n < 2; ++n) acc[a][b][m][n] = (f32x4){0.f, 0.f, 0.f, 0.f};
        }
        cur = nxt; cA = nA; cB = nB; ++ui;
        if constexpr (ALIGN_EPI) { if (wr == 1) PG8_BAR; }
    }
    PG8_WAIT_V(0);
    if constexpr (!ALIGN_EPI) { if (wr == 0) PG8_BAR; }
    PG8_BAR;
    if constexpr (Epi::AFTER_DRAIN) { E.fused(acc, cur, wr, wc, fr, fq, lds, wid, lane); S.done(cur); }
#undef PG8_SA
#undef PG8_SB
#undef PG8_STAGE
#undef PG8_LDA
#undef PG8_LDB
#undef PG8_MMA
#undef PG8_WAIT_V
#undef PG8_WAIT_L
#undef PG8_BAR
#undef PG8_SCHED
}
}

namespace pg8 {
__device__ __forceinline__ void store16_wt(void* ptr, u32x4 v) { asm volatile("global_store_dwordx4 %0, %1, off sc1\n\ts_nop 1" :: "v"(ptr), "v"(v) : "memory"); }
template <int ACT> struct EpiStore {
    static constexpr bool PERM = true, AFTER_DRAIN = false, CHAIN = false;
    bf16_t* O; int ldc;
    __device__ __forceinline__ void operator()(const f32x4 (&acc)[2][2][4][2], const Unit& u, int wr, int wc, int fr, int fq) const {
        const int row0 = u.pm * BM + wr * 64 + fr, col0 = u.pn * BM + wc * 32 + 8 * fq;
#pragma unroll
        for (int ai = 0; ai < 2; ++ai)
#pragma unroll
            for (int m = 0; m < 4; ++m) { bf16_t* rowp = O + (size_t)(row0 + ai * HALF + m * 16) * ldc + col0;
#pragma unroll
                for (int bj = 0; bj < 2; ++bj) { f32x4 v0 = acc[ai][bj][m][0], v1 = acc[ai][bj][m][1];
                    if (ACT == 1) {
#pragma unroll
                        for (int e = 0; e < 4; ++e) { v0[e] = __builtin_amdgcn_rcpf(1.f + __expf(-v0[e])); v1[e] = __builtin_amdgcn_rcpf(1.f + __expf(-v1[e])); } }
                    u32x4 w; w.x = cvt_pk_bf16(v0[0], v0[1]); w.y = cvt_pk_bf16(v0[2], v0[3]); w.z = cvt_pk_bf16(v1[0], v1[1]); w.w = cvt_pk_bf16(v1[2], v1[3]);
                    store16_wt(rowp + bj * HALF, w); } }
    }
};
template <bool ACCUM> struct EpiProj {
    static constexpr bool PERM = true, AFTER_DRAIN = false, CHAIN = false;
    bf16_t* MG; const bf16_t* SG; int gcol0;
    __device__ __forceinline__ void operator()(const f32x4 (&acc)[2][2][4][2], const Unit& u, int wr, int wc, int fr, int fq) const {
        const int row0 = u.pm * BM + wr * 64 + fr, col0 = u.pn * BM + wc * 32 + 8 * fq;
#pragma unroll
        for (int ai = 0; ai < 2; ++ai)
#pragma unroll
            for (int m = 0; m < 4; ++m) { const size_t row = (size_t)(row0 + ai * HALF + m * 16);
#pragma unroll
                for (int bj = 0; bj < 2; ++bj) {
                    const int col = col0 + bj * HALF;
                    const u32x4 gw = *(const u32x4*)(SG + row * 3072 + gcol0 + col);
                    u32x4 ow = (u32x4){0u, 0u, 0u, 0u};
                    if (ACCUM) ow = *(const u32x4*)(MG + row * 1024 + col);
                    float r[8];
#pragma unroll
                    for (int e = 0; e < 4; ++e) {
                        const float g0 = __uint_as_float(gw[e] << 16), g1 = __uint_as_float(gw[e] & 0xffff0000u);
                        const float a0 = e < 2 ? acc[ai][bj][m][0][2 * e] : acc[ai][bj][m][1][2 * e - 4], a1 = e < 2 ? acc[ai][bj][m][0][2 * e + 1] : acc[ai][bj][m][1][2 * e - 3];
                        r[2 * e] = g0 * a0; r[2 * e + 1] = g1 * a1;
                        if (ACCUM) { r[2 * e] += __uint_as_float(ow[e] << 16); r[2 * e + 1] += __uint_as_float(ow[e] & 0xffff0000u); }
                    }
                    u32x4 w; w.x = cvt_pk_bf16(r[0], r[1]); w.y = cvt_pk_bf16(r[2], r[3]); w.z = cvt_pk_bf16(r[4], r[5]); w.w = cvt_pk_bf16(r[6], r[7]);
                    *(u32x4*)(MG + row * 1024 + col) = w; } }
    }
};
struct ProjOrder {
    int pm, pn, valid;
    __host__ __device__ bool next(int i, Unit& u) const { if (!valid || i >= 3) return false; u.pm = i * 64 + pm; u.pn = i * 4 + pn; return true; }
    __device__ __forceinline__ void a_ready(const Unit&) const {}
    __device__ __forceinline__ void done(const Unit&) const {}
};
struct EpiProj3 {
    static constexpr bool PERM = true, AFTER_DRAIN = false, CHAIN = false;
    bf16_t* MG; const bf16_t* SG;
    __device__ __forceinline__ void operator()(const f32x4 (&acc)[2][2][4][2], const Unit& u, int wr, int wc, int fr, int fq) const {
        const int br = u.pm >> 6, pm = u.pm & 63, pn = u.pn & 3, gcol0 = br * 1024;
        const int row0 = pm * BM + wr * 64 + fr, col0 = pn * BM + wc * 32 + 8 * fq;
#pragma unroll
        for (int ai = 0; ai < 2; ++ai)
#pragma unroll
            for (int m = 0; m < 4; ++m) { const size_t row = (size_t)(row0 + ai * HALF + m * 16);
#pragma unroll
                for (int bj = 0; bj < 2; ++bj) {
                    const int col = col0 + bj * HALF;
                    const u32x4 gw = *(const u32x4*)(SG + row * 3072 + gcol0 + col);
                    u32x4 ow = (u32x4){0u, 0u, 0u, 0u};
                    if (br > 0) ow = *(const u32x4*)(MG + row * 1024 + col);
                    float r[8];
#pragma unroll
                    for (int e = 0; e < 4; ++e) {
                        const float g0 = __uint_as_float(gw[e] << 16), g1 = __uint_as_float(gw[e] & 0xffff0000u);
                        const float a0 = e < 2 ? acc[ai][bj][m][0][2 * e] : acc[ai][bj][m][1][2 * e - 4], a1 = e < 2 ? acc[ai][bj][m][0][2 * e + 1] : acc[ai][bj][m][1][2 * e - 3];
                        r[2 * e] = g0 * a0 + __uint_as_float(ow[e] << 16); r[2 * e + 1] = g1 * a1 + __uint_as_float(ow[e] & 0xffff0000u);
                    }
                    u32x4 w; w.x = cvt_pk_bf16(r[0], r[1]); w.y = cvt_pk_bf16(r[2], r[3]); w.z = cvt_pk_bf16(r[4], r[5]); w.w = cvt_pk_bf16(r[6], r[7]);
                    *(u32x4*)(MG + row * 1024 + col) = w; } }
    }
};
struct GateOrder {
    int pm, pn, valid;
    __host__ __device__ bool next(int i, Unit& u) const { if (!valid || i >= 3) return false; u.pm = pm; u.pn = (2 - i) * 4 + pn; return true; }
    __device__ __forceinline__ void a_ready(const Unit&) const {}
    __device__ __forceinline__ void done(const Unit&) const {}
};
struct EpiGateR {
    static constexpr bool PERM = true, AFTER_DRAIN = false, CHAIN = false;
    bf16_t* SG;
    __device__ __forceinline__ void operator()(const f32x4 (&acc)[2][2][4][2], const Unit& u, int wr, int wc, int fr, int fq) const {
        const int br = u.pn >> 2, pn = u.pn & 3;
        const int row0 = u.pm * BM + wr * 64 + fr, col0 = pn * BM + wc * 32 + 8 * fq;
#pragma unroll
        for (int ai = 0; ai < 2; ++ai)
#pragma unroll
            for (int m = 0; m < 4; ++m) { bf16_t* rowp = SG + (size_t)(row0 + ai * HALF + m * 16) * 3072 + col0;
#pragma unroll
                for (int bj = 0; bj < 2; ++bj) {
                    float s[8];
#pragma unroll
                    for (int e = 0; e < 4; ++e) { s[e] = __builtin_amdgcn_rcpf(1.f + __expf(-acc[ai][bj][m][0][e])); s[4 + e] = __builtin_amdgcn_rcpf(1.f + __expf(-acc[ai][bj][m][1][e])); }
                    if (br < 2) {
                        u32x4 d = *(const u32x4*)(rowp + 2048 + bj * HALF);
                        float den[8];
#pragma unroll
                        for (int e = 0; e < 4; ++e) { den[2 * e] = __uint_as_float(d[e] << 16); den[2 * e + 1] = __uint_as_float(d[e] & 0xffff0000u); }
                        if (br == 0) { const u32x4 d1 = *(const u32x4*)(rowp + 1024 + bj * HALF);
#pragma unroll
                            for (int e = 0; e < 4; ++e) { den[2 * e] *= __uint_as_float(d1[e] << 16); den[2 * e + 1] *= __uint_as_float(d1[e] & 0xffff0000u); } }
#pragma unroll
                        for (int e = 0; e < 8; ++e) s[e] *= __builtin_amdgcn_rcpf(den[e]);
                    }
                    u32x4 w; w.x = cvt_pk_bf16(s[0], s[1]); w.y = cvt_pk_bf16(s[2], s[3]); w.z = cvt_pk_bf16(s[4], s[5]); w.w = cvt_pk_bf16(s[6], s[7]);
                    *(u32x4*)(rowp + br * 1024 + bj * HALF) = w; } }
    }
};
struct EpiProjChain {
    static constexpr bool PERM = true, AFTER_DRAIN = false, CHAIN = true;
    bf16_t* MG; const bf16_t* SG;
    __device__ __forceinline__ void operator()(f32x4 (&acc)[2][2][4][2], const Unit& u, int wr, int wc, int fr, int fq) const {
        const int br = u.pm >> 6, pm = u.pm & 63, pn = u.pn & 3;
        const int row0 = pm * BM + wr * 64 + fr, col0 = pn * BM + wc * 32 + 8 * fq;
#pragma unroll
        for (int ai = 0; ai < 2; ++ai)
#pragma unroll
            for (int m = 0; m < 4; ++m) { const size_t row = (size_t)(row0 + ai * HALF + m * 16);
#pragma unroll
                for (int bj = 0; bj < 2; ++bj) {
                    const int col = col0 + bj * HALF;
                    const u32x4 gw = *(const u32x4*)(SG + row * 3072 + br * 1024 + col);
#pragma unroll
                    for (int e = 0; e < 4; ++e) {
                        const float g0 = __uint_as_float(gw[e] << 16), g1 = __uint_as_float(gw[e] & 0xffff0000u);
                        if (e < 2) { acc[ai][bj][m][0][2 * e] *= g0; acc[ai][bj][m][0][2 * e + 1] *= g1; } else { acc[ai][bj][m][1][2 * e - 4] *= g0; acc[ai][bj][m][1][2 * e - 3] *= g1; }
                    }
                    if (br == 2) {
                        u32x4 w; w.x = cvt_pk_bf16(acc[ai][bj][m][0][0], acc[ai][bj][m][0][1]); w.y = cvt_pk_bf16(acc[ai][bj][m][0][2], acc[ai][bj][m][0][3]);
                        w.z = cvt_pk_bf16(acc[ai][bj][m][1][0], acc[ai][bj][m][1][1]); w.w = cvt_pk_bf16(acc[ai][bj][m][1][2], acc[ai][bj][m][1][3]);
                        *(u32x4*)(MG + row * 1024 + col) = w; } } }
    }
};
struct EpiOut {
    static constexpr bool PERM = false, AFTER_DRAIN = false, CHAIN = false;
    const float* X; float* O;
    __device__ __forceinline__ void operator()(const f32x4 (&acc)[2][2][4][2], const Unit& u, int wr, int wc, int fr, int fq) const {
        const int row0 = u.pm * BM + wr * 64 + fr, col0 = u.pn * BM + wc * 32 + 4 * fq;
#pragma unroll
        for (int ai = 0; ai < 2; ++ai)
#pragma unroll
            for (int m = 0; m < 4; ++m) { const size_t off = (size_t)(row0 + ai * HALF + m * 16) * 1024 + col0;
#pragma unroll
                for (int bj = 0; bj < 2; ++bj)
#pragma unroll
                    for (int n = 0; n < 2; ++n) { const f32x4 xv = *(const f32x4*)(X + off + bj * HALF + n * 16); *(f32x4*)(O + off + bj * HALF + n * 16) = xv + acc[ai][bj][m][n]; } }
    }
};
}

DI void phase_gemm_gate(const Params& p, unsigned char* lds, const int bid, const int nb) {
    unsigned char* ws = p.ws;
    const bf16_t* H = (const bf16_t*)(ws + OFF_H); const bf16_t* Wt = (const bf16_t*)(ws + OFF_WIN) + (size_t)C_G * 1024;
    bf16_t* SG = (bf16_t*)(ws + OFF_SG);
    const int tn = 3072 / 128, nt = (M / 128) * tn;
    for (int it = bid; it < nt; it += nb) {
        GemmTile g; gemm_zero(g);
        const int m0 = (it / tn) * 128, n0 = (it % tn) * 128;
        gemm_tile_k(g, H, 1024, Wt, 1024, m0, n0, 1024, lds);
        GEMM_FOREACH(SG[(size_t)row * 3072 + col] = f2bf(sigmoidf_(g.acc[mi][ni][r])););
    }
}
DI void phase_gemm_proj(const Params& p, unsigned char* lds, const int bid, const int nb) {
    unsigned char* ws = p.ws;
    const bf16_t* SG = (const bf16_t*)(ws + OFF_SG); bf16_t* MG = (bf16_t*)(ws + OFF_MG);
    const int tn = 1024 / 128, nt = (M / 128) * tn;
    for (int it = bid; it < nt; it += nb) {
        const int m0 = (it / tn) * 128, n0 = (it % tn) * 128;
        GemmTile mg; gemm_zero(mg);
#pragma unroll 1
        for (int br = 0; br < 3; ++br) {
            GemmTile g; gemm_zero(g);
            const bf16_t* Y = (const bf16_t*)(ws + (br == 0 ? OFF_YA : br == 1 ? OFF_YB : OFF_YC));
            const bf16_t* W = (const bf16_t*)(ws + (br == 0 ? OFF_WPA : br == 1 ? OFF_WPB : OFF_WPC));
            gemm_tile_k(g, Y, 512, W, 512, m0, n0, 512, lds);
            GEMM_FOREACH(mg.acc[mi][ni][r] += bf2f(SG[(size_t)row * 3072 + br * 1024 + col]) * g.acc[mi][ni][r];);
        }
        GEMM_FOREACH(MG[(size_t)row * 1024 + col] = f2bf(mg.acc[mi][ni][r]););
    }
}
DI void phase_gemm_out(const Params& p, unsigned char* lds, const int bid, const int nb) {
    unsigned char* ws = p.ws;
    const bf16_t* MG = (const bf16_t*)(ws + OFF_MG); const bf16_t* W = (const bf16_t*)(ws + OFF_WO);
    const int tn = 1024 / 128, nt = (M / 128) * tn;
    for (int it = bid; it < nt; it += nb) {
        GemmTile g; gemm_zero(g);
        const int m0 = (it / tn) * 128, n0 = (it % tn) * 128;
        gemm_tile_k(g, MG, 1024, W, 1024, m0, n0, 1024, lds);
        GEMM_FOREACH(p.out[(size_t)row * 1024 + col] = p.x[(size_t)row * 1024 + col] + g.acc[mi][ni][r];);
    }
}

DI void phase_gemm_in_fast(const Params& p, unsigned char* lds, const int bid, const int nb) {
    unsigned char* ws = p.ws;
    {
        pg8::Gemm g{(const bf16_t*)(ws + OFF_H), (const bf16_t*)(ws + OFF_WIN), M, NP, 1024}; pg8::StaticOrder S; S.init(M, NP, nb, bid);
        pg8::EpiStore<0> E{(bf16_t*)(ws + OFF_P), NP};
        pg8::gemm_phase<pg8::EpiStore<0>, pg8::StaticOrder, true, true>(LASP(lds), g, S, E);
    }
    __syncthreads();
    const int tn2 = 1024 / 128, nt2 = (MM / 128) * tn2;
    for (int it = bid - nb / 2; it >= 0 && it < nt2; it += nb) {
        GemmTile g; gemm_zero(g);
        const int m0 = (it / tn2) * 128, n0 = (it % tn2) * 128;
        gemm_tile_k(g, (const bf16_t*)(ws + OFF_HM), 1024, (const bf16_t*)(ws + OFF_WKV), 1024, m0, n0, 1024, lds);
        bf16_t* KVM = (bf16_t*)(ws + OFF_KVM);
        GEMM_FOREACH(KVM[(size_t)row * 1024 + col] = f2bf(g.acc[mi][ni][r]););
    }
}
DI void phase_gemm_gate_fast(const Params& p, unsigned char* lds, const int bid, const int nb) {
    unsigned char* ws = p.ws;
    pg8::Gemm g{(const bf16_t*)(ws + OFF_H), (const bf16_t*)(ws + OFF_WIN) + (size_t)C_G * 1024, M, 3072, 1024};
    pg8::StaticOrder S; S.init(M, 1024, nb, bid);
    pg8::Unit own; const bool has = S.next(0, own);
    pg8::GateOrder O{own.pm, own.pn, has ? 1 : 0};
    pg8::EpiGateR E{(bf16_t*)(ws + OFF_SG)};
    pg8::gemm_phase<pg8::EpiGateR, pg8::GateOrder, true, true>(LASP(lds), g, O, E);
}
DI void phase_gemm_proj_fast(const Params& p, unsigned char* lds, const int bid, const int nb) {
    unsigned char* ws = p.ws;
    bf16_t* MG = (bf16_t*)(ws + OFF_MG); const bf16_t* SG = (const bf16_t*)(ws + OFF_SG);
    pg8::StaticOrder S; S.init(M, 1024, nb, bid);
    { pg8::Gemm g{(const bf16_t*)(ws + OFF_YA), (const bf16_t*)(ws + OFF_WPA), M, 1024, 512}; pg8::EpiProj<false> E{MG, SG, 0};
      pg8::gemm_phase<pg8::EpiProj<false>, pg8::StaticOrder, true, true>(LASP(lds), g, S, E); }
    { pg8::Gemm g{(const bf16_t*)(ws + OFF_YB), (const bf16_t*)(ws + OFF_WPB), M, 1024, 512}; pg8::EpiProj<true> E{MG, SG, 1024};
      pg8::gemm_phase<pg8::EpiProj<true>, pg8::StaticOrder, true, true>(LASP(lds), g, S, E); }
    { pg8::Gemm g{(const bf16_t*)(ws + OFF_YC), (const bf16_t*)(ws + OFF_WPC), M, 1024, 512}; pg8::EpiProj<true> E{MG, SG, 2048};
      pg8::gemm_phase<pg8::EpiProj<true>, pg8::StaticOrder, true, true>(LASP(lds), g, S, E); }
}
DI void phase_gemm_proj3(const Params& p, unsigned char* lds, const int bid, const int nb) {
    unsigned char* ws = p.ws;
    static_assert(OFF_YB == OFF_YA + (size_t)M * 512 * 2 && OFF_YC == OFF_YB + (size_t)M * 512 * 2 && OFF_WPB == OFF_WPA + (size_t)1024 * 512 * 2 && OFF_WPC == OFF_WPB + (size_t)1024 * 512 * 2, "contiguous branches");
    pg8::StaticOrder S; S.init(M, 1024, nb, bid);
    pg8::Unit own; const bool has = S.next(0, own);
    pg8::ProjOrder O{own.pm, own.pn, has ? 1 : 0};
    pg8::Gemm g{(const bf16_t*)(ws + OFF_YA), (const bf16_t*)(ws + OFF_WPA), 3 * M, 3072, 512};
    pg8::EpiProjChain E{(bf16_t*)(ws + OFF_MG), (const bf16_t*)(ws + OFF_SG)};
    pg8::gemm_phase<pg8::EpiProjChain, pg8::ProjOrder, true, true>(LASP(lds), g, O, E);
}
DI void phase_gemm_out_fast(const Params& p, unsigned char* lds, const int bid, const int nb) {
    unsigned char* ws = p.ws;
    pg8::Gemm g{(const bf16_t*)(ws + OFF_MG), (const bf16_t*)(ws + OFF_WO), M, 1024, 1024}; pg8::StaticOrder S; S.init(M, 1024, nb, bid);
    pg8::EpiOut E{p.x, p.out};
    pg8::gemm_phase<pg8::EpiOut, pg8::StaticOrder, true, true>(LASP(lds), g, S, E);
}

#define XB_TMO      128
#define XB_XCNT(j)  (256  + 64 * (j))
#define XB_XSUB(j)  (1280 + 64 * (j))
#define XB_XGEN(j)  (2304 + 64 * (j))
#define XB_TOP      3328
#define XB_TOPGEN   3392
#define XCD_BAR_WORDS 3456
#define XB_SPIN_CAP (1u << 22)
DI unsigned xb_ld(unsigned* p)              { return __hip_atomic_load(p, __ATOMIC_RELAXED, __HIP_MEMORY_SCOPE_AGENT); }
DI unsigned xb_add(unsigned* p, unsigned v) { return __hip_atomic_fetch_add(p, v, __ATOMIC_RELAXED, __HIP_MEMORY_SCOPE_AGENT); }
DI unsigned xb_xcc_id() { return (unsigned)__builtin_amdgcn_s_getreg((3 << 11) | 20) & 0xFu; }
#define XB_SPIN(cond, bar) do { unsigned _sp = 0; while (cond) { __builtin_amdgcn_s_sleep(1); \
    if ((++_sp & 255u) == 0u) { if (xb_ld(&(bar)[XB_TMO])) break; if (_sp > XB_SPIN_CAP) { atomicAdd(&(bar)[XB_TMO], 1u); break; } } } } while (0)
struct XcdBarrier { unsigned* bar; unsigned x; volatile LAS unsigned* st; };
DI XcdBarrier xcd_barrier_post(unsigned* bar, volatile LAS unsigned* st) {
    XcdBarrier b; b.bar = bar; b.x = xb_xcc_id(); b.st = st;
    if (threadIdx.x == 0) (void)xb_add(&bar[XB_XCNT(b.x)], 1u);
    return b;
}
DI void xcd_barrier_complete(unsigned* bar, unsigned x, unsigned& nloc, unsigned& nx) {
    const unsigned G = gridDim.x * gridDim.y * gridDim.z;
    unsigned sum, cnt, mine, sp = 0u;
    for (;;) {
        sum = 0u; cnt = 0u; mine = 0u;
#pragma unroll
        for (unsigned j = 0; j < 16; ++j) { const unsigned c = xb_ld(&bar[XB_XCNT(j)]); sum += c; cnt += (c > 0u) ? 1u : 0u; mine = (j == x) ? c : mine; }
        if (sum == G) break;
        __builtin_amdgcn_s_sleep(1);
        if ((++sp & 255u) == 0u) { if (xb_ld(&bar[XB_TMO])) break; if (sp > XB_SPIN_CAP) { atomicAdd(&bar[XB_TMO], 1u); break; } }
    }
    nloc = mine > 0u ? mine : 1u; nx = cnt > 0u ? cnt : 1u;
}
DI void xcd_barrier(const XcdBarrier& b) {
    asm volatile("s_waitcnt vmcnt(0)" ::: "memory");
    __syncthreads();
    if (threadIdx.x == 0) {
        unsigned* bar = b.bar;
        __builtin_amdgcn_s_waitcnt(0);
        unsigned nloc = b.st[0], nx = b.st[1];
        if (nloc == 0u) { xcd_barrier_complete(bar, b.x, nloc, nx); b.st[0] = nloc; b.st[1] = nx; }
        const unsigned old = xb_add(&bar[XB_XSUB(b.x)], 1u);
        const unsigned gen = old / nloc;
        if (old + 1u == (gen + 1u) * nloc) {
            __builtin_amdgcn_fence(__ATOMIC_RELEASE, "agent");
            asm volatile("s_waitcnt vmcnt(0)" ::: "memory");
            const unsigned og = xb_add(&bar[XB_TOP], 1u);
            const unsigned tg = og / nx;
            if (og + 1u == (tg + 1u) * nx) xb_add(&bar[XB_TOPGEN], 1u);
            else XB_SPIN(xb_ld(&bar[XB_TOPGEN]) == tg, bar);
            __builtin_amdgcn_fence(__ATOMIC_ACQUIRE, "agent");
            xb_add(&bar[XB_XGEN(b.x)], 1u);
            asm volatile("s_waitcnt vmcnt(0)" ::: "memory");
        } else {
            XB_SPIN(xb_ld(&bar[XB_XGEN(b.x)]) == gen, bar);
            __builtin_amdgcn_fence(__ATOMIC_ACQUIRE, "agent");
            asm volatile("s_waitcnt vmcnt(0)" ::: "memory");
        }
    }
    __syncthreads();
}

__global__ void __launch_bounds__(NTHREADS, 2) k_mega(Params p) {
    extern __shared__ __attribute__((aligned(16))) unsigned char lds[];
    volatile LAS unsigned* st = (volatile LAS unsigned*)(lds + LDS_CTL_OFF);
    if (threadIdx.x == 0) { st[0] = 0u; st[1] = 0u; st[2] = 0u; st[3] = 0u; }
    __syncthreads();
    (void)xcd_barrier_post((unsigned*)(p.ws + OFF_CTL), st);
#define GRID_BAR() do { XcdBarrier b_; b_.bar = (unsigned*)(p.ws + OFF_CTL); b_.x = xb_xcc_id(); b_.st = (volatile LAS unsigned*)(lds + LDS_CTL_OFF); xcd_barrier(b_); } while (0)
    const int bid = blockIdx.x, nb = gridDim.x;
#ifndef REPMASK
#define REPMASK 0
#endif
#ifndef REPCNT
#define REPCNT 1
#endif
    volatile LAS unsigned* stp = (volatile LAS unsigned*)(lds + LDS_CTL_OFF + 64);
    int nst = 0;
#define STAMP() do { if (STAMP_PH >= 0 && blockIdx.x == 0 && threadIdx.x == 0) stp[nst] = (unsigned)__builtin_amdgcn_s_memrealtime(); ++nst; } while (0)
    STAMP();
#define REP(bit_, call_) do { call_; if (REPMASK & (bit_)) { for (int rep_ = 0; rep_ < REPCNT; ++rep_) { __syncthreads(); call_; } } } while (0)
    REP(1, phase_prologue(p, lds, bid, nb));
    GRID_BAR(); STAMP();
    REP(2, phase_gemm_in_fast(p, lds, bid, nb));
    GRID_BAR(); STAMP();
    REP(8, phase_rwkv_prep(p, lds, bid, nb));
    GRID_BAR(); STAMP();
    if (bid < 16) phase_rwkv_scan(p, lds, bid);
    phase_attn_queue(p, lds);
    GRID_BAR(); STAMP();
    REP(64, phase_gemm_gate_fast(p, lds, bid, nb));
    __syncthreads(); STAMP();
    phase_gemm_proj3(p, lds, bid, nb);
    GRID_BAR(); STAMP();
    REP(256, phase_gemm_out_fast(p, lds, bid, nb));
    if (STAMP_PH >= 0) { GRID_BAR(); STAMP();
        if (blockIdx.x == 0) {
            float* sm = (float*)lds; float best = 1e30f; int bi = 0;
            for (int i = threadIdx.x; i < 65536; i += NTHREADS) { const float a = fabsf(p.out[i]); if (a < best) { best = a; bi = i; } }
            sm[threadIdx.x] = best; ((int*)sm)[512 + threadIdx.x] = bi;
            __syncthreads();
            if (threadIdx.x == 0) {
                for (int i = 1; i < NTHREADS; ++i) if (sm[i] < best) { best = sm[i]; bi = ((int*)sm)[512 + i]; }
                const float tot = (float)(stp[nst - 1] - stp[0]); const float ph = STAMP_PH < 20 ? (float)(stp[STAMP_PH + 1] - stp[STAMP_PH]) : STAMP_PH >= 40 ? 4.f * (float)stp[24 + STAMP_PH - 40] : STAMP_PH >= 30 ? 4.f * (float)(stp[17 + STAMP_PH - 30] - stp[16 + STAMP_PH - 30]) : tot * 0.5f;
                float v = STAMP_PH == 99 ? 0.04f + tot * 1e-6f : 0.05f + 0.1f * ph / tot;
#if STAMP_PH >= 60
                { const unsigned* qst = (const unsigned*)(p.ws + OFF_CTL + 40000); const int k = STAMP_PH - 60;
                  if (k < 4) v = 0.05f + 0.001f * ((float)__hip_atomic_load(qst + 2 * k, __ATOMIC_RELAXED, __HIP_MEMORY_SCOPE_AGENT) / fmaxf((float)__hip_atomic_load(qst + 2 * k + 1, __ATOMIC_RELAXED, __HIP_MEMORY_SCOPE_AGENT), 1.f)) * 0.01f;
                  else if (k == 4) v = 0.05f + 0.0005f * (float)__hip_atomic_load(qst + 8, __ATOMIC_RELAXED, __HIP_MEMORY_SCOPE_AGENT) * 0.01f;
                  else v = 0.05f + 0.01f * (float)__hip_atomic_load(qst + 2 * (k - 5) + 1, __ATOMIC_RELAXED, __HIP_MEMORY_SCOPE_AGENT); }
#endif
                p.out[bi] += v; }
        } }
}

extern "C" void kernel_launch(void* const* d_in, const int* in_sizes, int n_in, void* d_out, int out_size, void* d_ws, size_t ws_size, hipStream_t stream) {
    static int grid = 0;
    if (grid == 0) {
        if (n_in != 27 || ws_size < WS_END) { fprintf(stderr, "kernel_launch: unexpected inputs (n_in %d, ws %zu)\n", n_in, ws_size); grid = -1; return; }
        int dev = 0, cus = 0, per_cu = 0;
        if (hipGetDevice(&dev) != hipSuccess || hipDeviceGetAttribute(&cus, hipDeviceAttributeMultiprocessorCount, dev) != hipSuccess) { grid = -1; return; }
        if (hipFuncSetAttribute((const void*)k_mega, hipFuncAttributeMaxDynamicSharedMemorySize, LDS_BYTES) != hipSuccess) { fprintf(stderr, "kernel_launch: hipFuncSetAttribute failed\n"); grid = -1; return; }
        if (hipOccupancyMaxActiveBlocksPerMultiprocessor(&per_cu, (const void*)k_mega, NTHREADS, LDS_BYTES) != hipSuccess || per_cu < 1)
            fprintf(stderr, "kernel_launch: occupancy query reports %d workgroups per CU\n", per_cu);
        (void)hipGetLastError();
        grid = cus;
        if (grid < 32) { fprintf(stderr, "kernel_launch: too few CUs (%d)\n", grid); grid = -1; return; }
    }
    if (grid < 0) return;
    if (hipMemsetAsync((char*)d_ws + OFF_CTL, 0, 65536, stream) != hipSuccess) { fprintf(stderr, "kernel_launch: memset failed\n"); return; }
    Params p{};
    p.x = (const float*)d_in[0]; p.mem = (const float*)d_in[1]; p.pos = (const int*)d_in[2]; p.norm_g = (const float*)d_in[3]; p.mem_norm_g = (const float*)d_in[4];
    p.w_in = (const float*)d_in[5]; p.mu_rkv = (const float*)d_in[6]; p.mu_wa = (const float*)d_in[7]; p.w0 = (const float*)d_in[8]; p.w2 = (const float*)d_in[9];
    p.a0 = (const float*)d_in[10]; p.a2 = (const float*)d_in[11]; p.k_k = (const float*)d_in[12]; p.k_a = (const float*)d_in[13]; p.r_k = (const float*)d_in[14];
    p.lnx_g = (const float*)d_in[15]; p.lnx_b = (const float*)d_in[16]; p.q_norm_g = (const float*)d_in[17]; p.k_norm_g = (const float*)d_in[18]; p.sinks = (const float*)d_in[19];
    p.xq_norm_g = (const float*)d_in[20]; p.xk_norm_g = (const float*)d_in[21]; p.w_mem_kv = (const float*)d_in[22]; p.w_proj_a = (const float*)d_in[23];
    p.w_proj_b = (const float*)d_in[24]; p.w_proj_c = (const float*)d_in[25]; p.w_out = (const float*)d_in[26];
    p.out = (float*)d_out; p.ws = (unsigned char*)d_ws;
    hipLaunchKernelGGL(k_mega, dim3(grid), dim3(NTHREADS), LDS_BYTES, stream, p);
}
```

```cpp
#include <hip/hip_runtime.h>
#include <stdint.h>
#include <stdio.h>

#define DI __device__ __forceinline__
#define LASP(p_) ((__attribute__((address_space(3))) unsigned char*)(p_))
typedef unsigned short bf16_t;
typedef short bf16x8 __attribute__((ext_vector_type(8)));
typedef float f32x4 __attribute__((ext_vector_type(4)));
typedef float v2f __attribute__((ext_vector_type(2)));

constexpr int BATCH = 2, T = 8192, M = BATCH * T, D = 1024, NIN = 7552, NP = 4608  ;
constexpr int MEMLEN = 256, MM = BATCH * MEMLEN;
constexpr int C_R = 0, C_K = 512, C_V = 1024, C_W = 1536, C_A = 1600, C_ZA = 1664, C_Q = 2176, C_SK = 2688, C_SV = 2816, C_ZB = 2944, C_XQ = 3456, C_ZC = 3968, C_G = 4480;
constexpr int NTHREADS = 512, NWAVES = 8;
constexpr int LDS_BYTES = 147456;
constexpr int LDS_CTL_OFF = LDS_BYTES - 256;
#ifndef STAMP_PH
#define STAMP_PH -1
#endif
#define R1STAMP(k_) do { if (STAMP_PH >= 30 && blockIdx.x == 0 && threadIdx.x == 0) ((volatile __attribute__((address_space(3))) unsigned*)(lds + LDS_CTL_OFF + 64))[16 + (k_)] = (unsigned)__builtin_amdgcn_s_memrealtime(); } while (0)
#define R1ACC(k_, t0_) do { if (STAMP_PH >= 30 && blockIdx.x == 0 && threadIdx.x == 0) ((volatile __attribute__((address_space(3))) unsigned*)(lds + LDS_CTL_OFF + 64))[24 + (k_)] += (unsigned)__builtin_amdgcn_s_memrealtime() - (t0_); } while (0)
#define LAS __attribute__((address_space(3)))

constexpr size_t OFF_CTL = 0;
constexpr size_t OFF_WIN = 65536;
constexpr size_t OFF_WKV = OFF_WIN + (size_t)7680 * 1024 * 2;
constexpr size_t OFF_WPA = OFF_WKV + (size_t)1024 * 1024 * 2;
constexpr size_t OFF_WPB = OFF_WPA + (size_t)1024 * 512 * 2;
constexpr size_t OFF_WPC = OFF_WPB + (size_t)1024 * 512 * 2;
constexpr size_t OFF_WO  = OFF_WPC + (size_t)1024 * 512 * 2;
constexpr size_t OFF_H   = OFF_WO + (size_t)1024 * 1024 * 2;
constexpr size_t OFF_HM  = OFF_H + (size_t)M * 1024 * 2;
constexpr size_t OFF_KVM = OFF_HM + (size_t)MM * 1024 * 2;
constexpr size_t OFF_ROPE = OFF_KVM + (size_t)MM * 1024 * 2;
constexpr size_t OFF_P   = OFF_ROPE + (size_t)M * 32 * 8;
constexpr size_t OFF_YA  = OFF_P + (size_t)M * NP * 2;
constexpr size_t OFF_YB  = OFF_YA + (size_t)M * 512 * 2;
constexpr size_t OFF_YC  = OFF_YB + (size_t)M * 512 * 2;
constexpr size_t WS_END  = OFF_YC + (size_t)M * 512 * 2;
constexpr size_t OFF_SG  = OFF_P;
constexpr size_t OFF_MG  = OFF_P + (size_t)M * 3072 * 2;
static_assert(WS_END <= (size_t)256 * 1024 * 1024, "workspace");
static_assert(OFF_MG + (size_t)M * 1024 * 2 <= OFF_YA, "overlay");

struct Params {
    const float* x; const float* mem; const int* pos; const float* norm_g; const float* mem_norm_g; const float* w_in;
    const float* mu_rkv; const float* mu_wa; const float* w0; const float* w2; const float* a0; const float* a2;
    const float* k_k; const float* k_a; const float* r_k; const float* lnx_g; const float* lnx_b;
    const float* q_norm_g; const float* k_norm_g; const float* sinks; const float* xq_norm_g; const float* xk_norm_g;
    const float* w_mem_kv; const float* w_proj_a; const float* w_proj_b; const float* w_proj_c; const float* w_out;
    float* out; unsigned char* ws;
};

DI bf16_t f2bf(float x) { return __builtin_bit_cast(unsigned short, (__bf16)x); }
DI float bf2f(bf16_t h) { return __uint_as_float(((unsigned)h) << 16); }
DI float wave_sum_v(float x) {
    x += __int_as_float(__builtin_amdgcn_update_dpp(0, __float_as_int(x), 0x128, 0xF, 0xF, true));
    x += __int_as_float(__builtin_amdgcn_update_dpp(0, __float_as_int(x), 0x124, 0xF, 0xF, true));
    x += __int_as_float(__builtin_amdgcn_update_dpp(0, __float_as_int(x), 0x122, 0xF, 0xF, true));
    x += __int_as_float(__builtin_amdgcn_update_dpp(0, __float_as_int(x), 0x121, 0xF, 0xF, true));
    typedef unsigned u2_ __attribute__((ext_vector_type(2)));
    const u2_ q = __builtin_amdgcn_permlane16_swap(__float_as_uint(x), __float_as_uint(x), false, false);
    x = __uint_as_float(q[0]) + __uint_as_float(q[1]);
    const u2_ h = __builtin_amdgcn_permlane32_swap(__float_as_uint(x), __float_as_uint(x), false, false);
    return __uint_as_float(h[0]) + __uint_as_float(h[1]);
}
DI float wave_sum(float v) {
#pragma unroll
    for (int o = 32; o > 0; o >>= 1) v += __shfl_xor(v, o, 64);
    return v;
}
DI float wave_max(float v) {
#pragma unroll
    for (int o = 32; o > 0; o >>= 1) v = fmaxf(v, __shfl_xor(v, o, 64));
    return v;
}
DI float sigmoidf_(float x) { return __builtin_amdgcn_rcpf(1.f + __expf(-x)); }
DI float siluf_(float x) { return x * __builtin_amdgcn_rcpf(1.f + __expf(-x)); }

DI void transpose_convert(const float* W, int K, int N, bf16_t* Wt, int item, float* tile  ) {
    int tid = threadIdx.x; asm volatile("" : "+v"(tid));
    const int tn = N / 64, kt = item / tn, nt = item % tn;
    __syncthreads();
#pragma unroll
    for (int u = 0; u < 2; ++u) { const int idx = tid + NTHREADS * u, r = idx >> 4, c4 = idx & 15;
        *(f32x4*)(tile + r * 68 + c4 * 4) = *(const f32x4*)(W + (size_t)(kt * 64 + r) * N + nt * 64 + c4 * 4); }
    __syncthreads();
    {
        const int n = tid >> 3, k8 = tid & 7;
        unsigned w[4];
#pragma unroll
        for (int e2 = 0; e2 < 4; ++e2) w[e2] = (unsigned)f2bf(tile[(k8 * 8 + 2 * e2) * 68 + n]) | ((unsigned)f2bf(tile[(k8 * 8 + 2 * e2 + 1) * 68 + n]) << 16);
        *(uint4*)(Wt + (size_t)(nt * 64 + n) * K + kt * 64 + k8 * 8) = make_uint4(w[0], w[1], w[2], w[3]);
    }
}

DI void transpose_convert_w(const float* W, int K, int N, bf16_t* Wt, int item, float* tile) {
    int lane = threadIdx.x & 63; asm volatile("" : "+v"(lane));
    const int tn = N / 64, kt = item / tn, nt = item % tn;
    f32x4 v[16];
#pragma unroll
    for (int u = 0; u < 16; ++u) { const int idx = lane + 64 * u, r = idx >> 4, c4 = idx & 15; v[u] = *(const f32x4*)(W + (size_t)(kt * 64 + r) * N + nt * 64 + c4 * 4); }
#pragma unroll
    for (int u = 0; u < 16; ++u) { const int idx = lane + 64 * u, r = idx >> 4, c4 = idx & 15; *(f32x4*)(tile + r * 68 + c4 * 4) = v[u]; }
    asm volatile("s_waitcnt lgkmcnt(0)" ::: "memory");
#pragma unroll
    for (int s = 0; s < 8; ++s) { const int idx = lane + 64 * s, n = idx >> 3, k8 = idx & 7;
        unsigned w[4];
#pragma unroll
        for (int e2 = 0; e2 < 4; ++e2) w[e2] = (unsigned)f2bf(tile[(k8 * 8 + 2 * e2) * 68 + n]) | ((unsigned)f2bf(tile[(k8 * 8 + 2 * e2 + 1) * 68 + n]) << 16);
        *(uint4*)(Wt + (size_t)(nt * 64 + n) * K + kt * 64 + k8 * 8) = make_uint4(w[0], w[1], w[2], w[3]); }
    asm volatile("s_waitcnt lgkmcnt(0)" ::: "memory");
}
DI void convert_late(const Params& p, unsigned char* lds, const int vb, const int nvb) {
    unsigned char* ws = p.ws;
    const int n_g = 16 * (NIN / 64 - 72), n_pr = (512 / 64) * 16, n_o = 16 * 16, total = n_g + 3 * n_pr + n_o;
    __syncthreads();
    const int wid = threadIdx.x >> 6;
    float* tile = (float*)lds + wid * (64 * 68);
    int i = vb * 8 + wid;
    if (i < total) {
        if (i < n_g) { const int kt = i / (NIN / 64 - 72), nt = 72 + i % (NIN / 64 - 72); transpose_convert_w(p.w_in, 1024, NIN, (bf16_t*)(ws + OFF_WIN), kt * (NIN / 64) + nt, tile); }
        else { i -= n_g;
            if (i < n_pr) transpose_convert_w(p.w_proj_a, 512, 1024, (bf16_t*)(ws + OFF_WPA), i, tile);
            else { i -= n_pr;
                if (i < n_pr) transpose_convert_w(p.w_proj_b, 512, 1024, (bf16_t*)(ws + OFF_WPB), i, tile);
                else { i -= n_pr;
                    if (i < n_pr) transpose_convert_w(p.w_proj_c, 512, 1024, (bf16_t*)(ws + OFF_WPC), i, tile);
                    else transpose_convert_w(p.w_out, 1024, 1024, (bf16_t*)(ws + OFF_WO), i - n_pr, tile); } } }
    }
}

__device__ const float ROPE_C_HI[32] = {1.591549367e-01f, 1.193493679e-01f, 8.949939907e-02f, 6.711508334e-02f, 5.032921210e-02f, 3.774158657e-02f, 2.830219641e-02f, 2.122365311e-02f, 1.591549441e-02f, 1.193493698e-02f, 8.949940093e-03f, 6.711508147e-03f, 5.032921210e-03f, 3.774158424e-03f, 2.830219688e-03f, 2.122365171e-03f, 1.591549488e-03f, 1.193493721e-03f, 8.949940093e-04f, 6.711508031e-04f, 5.032921326e-04f, 3.774158540e-04f, 2.830219455e-04f, 2.122365258e-04f, 1.591549371e-04f, 1.193493736e-04f, 8.949940093e-05f, 6.711508468e-05f, 5.032921035e-05f, 3.774158540e-05f, 2.830219637e-05f, 2.122365186e-05f};
__device__ const float ROPE_C_LO[32] = {6.420638243e-09f, 2.294664903e-09f, 2.542919653e-09f, -3.316028840e-10f, 5.173299289e-12f, -1.848551645e-09f, -5.826552019e-10f, -3.431038786e-10f, -1.029942243e-10f, 4.320196978e-11f, 6.802745173e-11f, 1.531042237e-10f, 5.173301024e-13f, 4.797548470e-11f, -1.048316434e-10f, 1.053879969e-10f, -5.686555046e-11f, -1.896286773e-11f, 6.802744999e-12f, 2.695195456e-11f, -1.158979943e-11f, -6.843983713e-12f, 1.279990003e-11f, 1.807650600e-12f, 5.954976963e-12f, -3.351478166e-12f, 6.802745216e-13f, -1.670379113e-12f, 1.751403167e-12f, -6.843983930e-13f, -5.389994549e-13f, 9.083608431e-13f};
DI void phase_prologue(const Params& p, unsigned char* lds, const int bid, const int nb) {
    float* tile = (float*)lds;
    unsigned char* ws = p.ws;
    const int n_in = (1024 / 64) * 72, n_kv = 16 * 16;
    const int lane = threadIdx.x & 63, wid = threadIdx.x >> 6;
    const int gw = bid * NWAVES + wid, nw = nb * NWAVES;
    float* wtile = tile + wid * (64 * 68);
#define PRO_TILES() do { for (int g16 = gw; g16 < (n_in + n_kv) / 11 * 16; g16 += nw) { if ((g16 & 15) < 11) { const int it = (g16 >> 4) * 11 + (g16 & 15); \
        if (it < n_in) { const int kt = it / 72, nt = it % 72; transpose_convert_w(p.w_in, 1024, NIN, (bf16_t*)(ws + OFF_WIN), kt * (NIN / 64) + nt, wtile); } \
        else transpose_convert_w(p.w_mem_kv, 1024, 1024, (bf16_t*)(ws + OFF_WKV), it - n_in, wtile); } } } while (0)
#define PRO_ROWS() do { int row = gw; f32x4 vn[4]; \
        if (row < M + MM) { const float* s0 = row < M ? p.x + (size_t)row * D : p.mem + (size_t)(row - M) * D; _Pragma("unroll") for (int i = 0; i < 4; ++i) vn[i] = *(const f32x4*)(s0 + i * 256 + lane * 4); } \
        for (; row < M + MM; row += nw) { \
        const float* g = row < M ? p.norm_g : p.mem_norm_g; \
        bf16_t* dst = row < M ? (bf16_t*)(ws + OFF_H) + (size_t)row * D : (bf16_t*)(ws + OFF_HM) + (size_t)(row - M) * D; \
        f32x4 v[4]; float ss = 0.f; \
        _Pragma("unroll") for (int i = 0; i < 4; ++i) { v[i] = vn[i]; ss += v[i][0] * v[i][0] + v[i][1] * v[i][1] + v[i][2] * v[i][2] + v[i][3] * v[i][3]; } \
        { const int rn = row + nw; if (rn < M + MM) { const float* s1 = rn < M ? p.x + (size_t)rn * D : p.mem + (size_t)(rn - M) * D; _Pragma("unroll") for (int i = 0; i < 4; ++i) vn[i] = *(const f32x4*)(s1 + i * 256 + lane * 4); } } \
        ss = wave_sum_v(ss); \
        const float rs = rsqrtf(ss * (1.f / 1024.f) + 1e-6f); \
        _Pragma("unroll") for (int i = 0; i < 4; ++i) { \
            const f32x4 gg = *(const f32x4*)(g + i * 256 + lane * 4); \
            ushort4 o; o.x = f2bf(v[i][0] * rs * gg[0]); o.y = f2bf(v[i][1] * rs * gg[1]); o.z = f2bf(v[i][2] * rs * gg[2]); o.w = f2bf(v[i][3] * rs * gg[3]); \
            *(ushort4*)(dst + i * 256 + lane * 4) = o; } } } while (0)
    static_assert(((1024 / 64) * 72 + 16 * 16) % 11 == 0, "tile groups of 11");
    if (wid & 1) { PRO_ROWS(); PRO_TILES(); } else { PRO_TILES(); PRO_ROWS(); }
#undef PRO_TILES
#undef PRO_ROWS
    float2* rope = (float2*)(ws + OFF_ROPE);
    {
        const int f = threadIdx.x & 31;
        const float c_hi = ROPE_C_HI[f], c_lo = ROPE_C_LO[f];
        for (int i0 = bid * NTHREADS + threadIdx.x; i0 < M * 32; i0 += 4 * nb * NTHREADS) {
            int ps[4];
#pragma unroll
            for (int k = 0; k < 4; ++k) { const int i = i0 + k * nb * NTHREADS; ps[k] = i < M * 32 ? p.pos[i >> 5] : 0; }
#pragma unroll
            for (int k = 0; k < 4; ++k) { const int i = i0 + k * nb * NTHREADS;
                if (i < M * 32) {
                    const float pf = (float)ps[k];
                    const float r_hi = pf * c_hi, e = fmaf(pf, c_hi, -r_hi);
                    const float r = (r_hi - floorf(r_hi)) + (e + pf * c_lo);
                    rope[i] = make_float2(__builtin_amdgcn_cosf(r), __builtin_amdgcn_sinf(r)); } }
        }
    }
}

struct GemmTile { f32x4 acc[2][4]; };
DI void gemm_tile_k(GemmTile& g, const bf16_t* A, int lda, const bf16_t* Bt, int ldb, int m0, int n0, int K, unsigned char* lds) {
    bf16_t* sA = (bf16_t*)lds;
    bf16_t* sB = sA + 128 * 40;
    const int tid = threadIdx.x, lane = tid & 63, wid = tid >> 6, wm = wid & 3, wn = wid >> 2;
    const int srow = tid >> 2, sch = tid & 3;
    const bf16_t* ga = A + (size_t)(m0 + srow) * lda + sch * 8;
    const bf16_t* gb = Bt + (size_t)(n0 + srow) * ldb + sch * 8;
    const int fr = lane & 15, fq = lane >> 4;
    uint4 ra = *(const uint4*)ga, rb = *(const uint4*)gb;
    for (int k0 = 0; k0 < K; k0 += 32) {
        __syncthreads();
        *(uint4*)(sA + srow * 40 + sch * 8) = ra;
        *(uint4*)(sB + srow * 40 + sch * 8) = rb;
        __syncthreads();
        if (k0 + 32 < K) { ra = *(const uint4*)(ga + k0 + 32); rb = *(const uint4*)(gb + k0 + 32); }
        bf16x8 af[2], bfr[4];
#pragma unroll
        for (int mi = 0; mi < 2; ++mi) af[mi] = *(const bf16x8*)(sA + (wm * 32 + mi * 16 + fr) * 40 + fq * 8);
#pragma unroll
        for (int ni = 0; ni < 4; ++ni) bfr[ni] = *(const bf16x8*)(sB + (wn * 64 + ni * 16 + fr) * 40 + fq * 8);
#pragma unroll
        for (int mi = 0; mi < 2; ++mi)
#pragma unroll
            for (int ni = 0; ni < 4; ++ni) g.acc[mi][ni] = __builtin_amdgcn_mfma_f32_16x16x32_bf16(af[mi], bfr[ni], g.acc[mi][ni], 0, 0, 0);
    }
}
DI void gemm_zero(GemmTile& g) {
#pragma unroll
    for (int mi = 0; mi < 2; ++mi)
#pragma unroll
        for (int ni = 0; ni < 4; ++ni) g.acc[mi][ni] = (f32x4){0.f, 0.f, 0.f, 0.f};
}
#define GEMM_FOREACH(body) do { const int lane_ = threadIdx.x & 63, wid_ = threadIdx.x >> 6, wm_ = wid_ & 3, wn_ = wid_ >> 2, fr_ = lane_ & 15, fq_ = lane_ >> 4; \
    _Pragma("unroll") for (int mi = 0; mi < 2; ++mi) _Pragma("unroll") for (int ni = 0; ni < 4; ++ni) _Pragma("unroll") for (int r = 0; r < 4; ++r) { \
        const int row = m0 + wm_ * 32 + mi * 16 + fq_ * 4 + r, col = n0 + wn_ * 64 + ni * 16 + fr_; body } } while (0)

DI void phase_gemm_in(const Params& p, unsigned char* lds, const int bid, const int nb) {
    unsigned char* ws = p.ws;
    const bf16_t* H = (const bf16_t*)(ws + OFF_H); const bf16_t* Wt = (const bf16_t*)(ws + OFF_WIN);
    bf16_t* P = (bf16_t*)(ws + OFF_P);
    const int tn = NP / 128, nt1 = (M / 128) * tn;
    const int tn2 = 1024 / 128, nt2 = (MM / 128) * tn2;
    for (int it = bid; it < nt1 + nt2; it += nb) {
        GemmTile g; gemm_zero(g);
        if (it < nt1) {
            const int m0 = (it / tn) * 128, n0 = (it % tn) * 128;
            gemm_tile_k(g, H, 1024, Wt, 1024, m0, n0, 1024, lds);
            GEMM_FOREACH(P[(size_t)row * NP + col] = f2bf(g.acc[mi][ni][r]););
        } else {
            const int i2 = it - nt1; const int m0 = (i2 / tn2) * 128, n0 = (i2 % tn2) * 128;
            gemm_tile_k(g, (const bf16_t*)(ws + OFF_HM), 1024, (const bf16_t*)(ws + OFF_WKV), 1024, m0, n0, 1024, lds);
            bf16_t* KVM = (bf16_t*)(ws + OFF_KVM);
            GEMM_FOREACH(KVM[(size_t)row * 1024 + col] = f2bf(g.acc[mi][ni][r]););
        }
    }
}

DI void phase_attn_prep(const Params& p, unsigned char* lds, const int bid, const int nb) {
    unsigned char* ws = p.ws; bf16_t* P = (bf16_t*)(ws + OFF_P); bf16_t* KVM = (bf16_t*)(ws + OFF_KVM);
    const float2* rope = (const float2*)(ws + OFF_ROPE);
    const int lane = threadIdx.x & 63, wid = threadIdx.x >> 6;
    const long n1 = (long)M * 14, n2 = (long)MM * 4;
    for (long it = (long)bid * NWAVES + wid; it < n1 + n2; it += (long)nb * NWAVES) {
        if (it < n1) {
            const int row = (int)(it / 14), j = (int)(it % 14);
            if (j < 10) {
                bf16_t* ptr = P + (size_t)row * NP + (j < 8 ? C_Q + j * 64 : C_SK + (j - 8) * 64);
                const float g = j < 8 ? p.q_norm_g[lane] : p.k_norm_g[lane];
                const float xv = bf2f(ptr[lane]);
                const float ss = wave_sum(xv * xv);
                const float y = xv * rsqrtf(ss * (1.f / 64.f) + 1e-6f) * g;
                const float yp = __shfl_xor(y, 32, 64);
                const float2 cs = rope[(size_t)row * 32 + (lane & 31)];
                const float o = lane < 32 ? y * cs.x - yp * cs.y : y * cs.x + yp * cs.y;
                ptr[lane] = f2bf(o);
            } else {
                bf16_t* ptr = P + (size_t)row * NP + C_XQ + (j - 10) * 128;
                const float x0 = bf2f(ptr[lane]), x1 = bf2f(ptr[lane + 64]);
                const float ss = wave_sum(x0 * x0 + x1 * x1);
                const float rs = rsqrtf(ss * (1.f / 128.f) + 1e-6f);
                ptr[lane] = f2bf(x0 * rs * p.xq_norm_g[lane]); ptr[lane + 64] = f2bf(x1 * rs * p.xq_norm_g[lane + 64]);
            }
        } else {
            const long i2 = it - n1; const int row = (int)(i2 / 4), j = (int)(i2 % 4);
            bf16_t* ptr = KVM + (size_t)row * 1024 + j * 128;
            const float x0 = bf2f(ptr[lane]), x1 = bf2f(ptr[lane + 64]);
            const float ss = wave_sum(x0 * x0 + x1 * x1);
            const float rs = rsqrtf(ss * (1.f / 128.f) + 1e-6f);
            ptr[lane] = f2bf(x0 * rs * p.xk_norm_g[lane]); ptr[lane + 64] = f2bf(x1 * rs * p.xk_norm_g[lane + 64]);
        }
    }
}

DI void rwkv_stage(const Params& p, int b, int h, int t0, int ntok, float* ck, float* scratch  ) {
    const bf16_t* P = (const bf16_t*)(p.ws + OFF_P);
    const int lane = threadIdx.x & 63, wid = threadIdx.x >> 6, ch = h * 64 + lane;
    const float mu_r = p.mu_rkv[ch], mu_k = p.mu_rkv[512 + ch], mu_v = p.mu_rkv[1024 + ch], mu_w = p.mu_wa[lane], mu_a = p.mu_wa[64 + lane];
    const float w0c = p.w0[ch], a0c = p.a0[ch], kkc = p.k_k[ch], kac = p.k_a[ch];
    float* sc = scratch + wid * 128;
    for (int i = wid; i < ntok; i += NWAVES) {
        const int t = t0 + i; const bf16_t* pr = P + (size_t)(b * T + t) * NP; const bf16_t* pp = pr - NP; const bool hp = t > 0;
        const float rc = bf2f(pr[C_R + ch]), rp = hp ? bf2f(pp[C_R + ch]) : 0.f;
        const float kc = bf2f(pr[C_K + ch]), kp = hp ? bf2f(pp[C_K + ch]) : 0.f;
        const float vc = bf2f(pr[C_V + ch]), vp = hp ? bf2f(pp[C_V + ch]) : 0.f;
        const float wc = bf2f(pr[C_W + lane]), wp = hp ? bf2f(pp[C_W + lane]) : 0.f;
        const float ac = bf2f(pr[C_A + lane]), ap = hp ? bf2f(pp[C_A + lane]) : 0.f;
        const float r = rc + (rp - rc) * mu_r, k = kc + (kp - kc) * mu_k, v = vc + (vp - vc) * mu_v;
        const float lw = wc + (wp - wc) * mu_w, la = ac + (ap - ac) * mu_a;
        sc[lane] = tanhf(lw); sc[64 + lane] = la;
        float accw = 0.f, acca = 0.f;
#pragma unroll 8
        for (int j = 0; j < 64; ++j) { accw += sc[j] * p.w2[j * 512 + ch]; acca += sc[64 + j] * p.a2[j * 512 + ch]; }
        const float xw = -(w0c + accw);
        const float sp = xw > 20.f ? xw : log1pf(expf(xw));
        const float wlog = -sp - 0.5f;
        const float decay = expf(-expf(wlog));
        const float alpha = 1.f / (1.f + expf(-(a0c + acca)));
        const float kk0 = k * kkc;
        const float n2 = wave_sum(kk0 * kk0);
        const float kk = kk0 / fmaxf(sqrtf(n2), 1e-12f);
        const float k2 = k * (1.f + (alpha - 1.f) * kac);
        float* o = ck + i * 384;
        o[lane] = r; o[64 + lane] = decay; o[128 + lane] = k2; o[192 + lane] = v; o[256 + lane] = -kk; o[320 + lane] = kk * alpha;
    }
}

DI void phase_rwkv_direct(const Params& p, unsigned char* lds, const int bid, const int nb) {
    float* ck = (float*)lds; float* scratch = ck + 64 * 384;
    const int lane = threadIdx.x & 63, wid = threadIdx.x >> 6;
    const bf16_t* P = (const bf16_t*)(p.ws + OFF_P); bf16_t* YA = (bf16_t*)(p.ws + OFF_YA);
    for (int bh = bid; bh < BATCH * 8; bh += nb) {
        const int b = bh >> 3, h = bh & 7, ch = h * 64 + lane;
        float S[64];
#pragma unroll
        for (int k = 0; k < 64; ++k) S[k] = 0.f;
        const float rk = p.r_k[ch], lg = p.lnx_g[ch], lb = p.lnx_b[ch];
        for (int c = 0; c < T / 64; ++c) {
            __syncthreads();
            rwkv_stage(p, b, h, c * 64, 64, ck, scratch);
            __syncthreads();
            if (wid == 0) {
                for (int i = 0; i < 64; ++i) {
                    const float* cc = ck + i * 384;
                    float sa = 0.f;
#pragma unroll
                    for (int k = 0; k < 64; ++k) sa += S[k] * cc[256 + k];
                    const float vv = cc[192 + lane];
#pragma unroll
                    for (int k = 0; k < 64; ++k) S[k] = S[k] * cc[64 + k] + sa * cc[320 + k] + vv * cc[128 + k];
                    float y = 0.f;
#pragma unroll
                    for (int k = 0; k < 64; ++k) y += S[k] * cc[k];
                    const float mean = wave_sum(y) * (1.f / 64.f);
                    const float dy = y - mean;
                    const float var = wave_sum(dy * dy) * (1.f / 64.f);
                    const float yn = dy * rsqrtf(var + 64e-5f) * lg + lb;
                    const float bonus = wave_sum(cc[lane] * cc[128 + lane] * rk) * vv;
                    const int t = c * 64 + i; const size_t row = (size_t)(b * T + t);
                    const float z = bf2f(P[row * NP + C_ZA + ch]);
                    YA[row * 512 + ch] = f2bf((yn + bonus) * siluf_(z));
                }
            }
        }
    }
}

constexpr size_t AF_BYTES = 16384, NF_BYTES = 16384, NCHUNK = 64;
constexpr int CHT = 128;
constexpr size_t OFF_AF = 0, OFF_NF = (size_t)16 * NCHUNK * AF_BYTES;
constexpr size_t OFF_QH = OFF_NF + (size_t)16 * NCHUNK * NF_BYTES;
constexpr size_t OFF_BON = OFF_QH + (size_t)16 * T * 64 * 2;
static_assert(OFF_BON + (size_t)16 * T * 4 <= (size_t)M * 1024 * 4, "d_out scratch");
typedef float f32x16 __attribute__((ext_vector_type(16)));
#define MFMA32(a, b, c) __builtin_amdgcn_mfma_f32_32x32x16_bf16((a), (b), (c), 0, 0, 0)
typedef float f32x2 __attribute__((ext_vector_type(2)));

DI unsigned pk2f(float lo, float hi) { typedef float f2_ __attribute__((ext_vector_type(2))); typedef __bf16 b2_ __attribute__((ext_vector_type(2))); return __builtin_bit_cast(unsigned, __builtin_convertvector((f2_){lo, hi}, b2_)); }
DI float quad_sum(float s) {
    s += __int_as_float(__builtin_amdgcn_update_dpp(0, __float_as_int(s), 0xB1, 0xF, 0xF, true));
    s += __int_as_float(__builtin_amdgcn_update_dpp(0, __float_as_int(s), 0x4E, 0xF, 0xF, true));
    return s;
}

DI float rwkv_stage_tok(const Params& p, const bf16_t* P, int b, int h, int t, float* o, float* sc, float mu_r, float mu_k, float mu_v, float mu_w, float mu_a,
                        float w0c, float a0c, float kkc, float kac, float rkc) {
    const int lane = threadIdx.x & 63, ch = h * 64 + lane;
    const bf16_t* pr = P + (size_t)(b * T + t) * NP; const bf16_t* pp = pr - NP; const bool hp = t > 0;
    const float rc = bf2f(pr[C_R + ch]), rp = hp ? bf2f(pp[C_R + ch]) : 0.f;
    const float kc = bf2f(pr[C_K + ch]), kp = hp ? bf2f(pp[C_K + ch]) : 0.f;
    const float vc = bf2f(pr[C_V + ch]), vp = hp ? bf2f(pp[C_V + ch]) : 0.f;
    const float wc = bf2f(pr[C_W + lane]), wp = hp ? bf2f(pp[C_W + lane]) : 0.f;
    const float ac = bf2f(pr[C_A + lane]), ap = hp ? bf2f(pp[C_A + lane]) : 0.f;
    const float r = rc + (rp - rc) * mu_r, k = kc + (kp - kc) * mu_k, v = vc + (vp - vc) * mu_v;
    const float lw = wc + (wp - wc) * mu_w, la = ac + (ap - ac) * mu_a;
    sc[lane] = tanhf(lw); sc[64 + lane] = la;
    float accw = 0.f, acca = 0.f;
    const float* w2p = p.w2; const float* a2p = p.a2;
    asm volatile("" : "+s"(w2p), "+s"(a2p));
#pragma unroll 8
    for (int j = 0; j < 64; ++j) { accw += sc[j] * w2p[j * 512 + ch]; acca += sc[64 + j] * a2p[j * 512 + ch]; }
    const float xw = -(w0c + accw);
    const float sp = xw > 20.f ? xw : log1pf(expf(xw));
    const float decay = expf(-expf(-sp - 0.5f));
    const float alpha = 1.f / (1.f + expf(-(a0c + acca)));
    const float kk0 = k * kkc;
    const float n2 = wave_sum(kk0 * kk0);
    const float kk = kk0 / fmaxf(sqrtf(n2), 1e-12f);
    const float k2 = k * (1.f + (alpha - 1.f) * kac);
    o[lane] = r; o[64 + lane] = decay; o[128 + lane] = k2; o[192 + lane] = v; o[256 + lane] = -kk; o[320 + lane] = kk * alpha;
    return wave_sum(r * k2 * rkc);
}

typedef float f32x4_t __attribute__((ext_vector_type(4)));
typedef unsigned u32x2h_ __attribute__((ext_vector_type(2)));
DI float xhalf_sum(float x) { const u32x2h_ r = __builtin_amdgcn_permlane32_swap(__float_as_uint(x), __float_as_uint(x), false, false); return __uint_as_float(r[0]) + __uint_as_float(r[1]); }
DI float xhalf_max(float x) { const u32x2h_ r = __builtin_amdgcn_permlane32_swap(__float_as_uint(x), __float_as_uint(x), false, false); return fmaxf(__uint_as_float(r[0]), __uint_as_float(r[1])); }
DI float lane_xor4(float x) {
    const int xi = __float_as_int(x);
    int r = __builtin_amdgcn_update_dpp(0, xi, 0x124, 0xF, 0xA, false);
    r = __builtin_amdgcn_update_dpp(r, xi, 0x12C, 0xF, 0x5, false);
    return __int_as_float(r);
}
DI float row16_sum(float x) {
    x += __int_as_float(__builtin_amdgcn_update_dpp(0, __float_as_int(x), 0x128, 0xF, 0xF, true));
    x += __int_as_float(__builtin_amdgcn_update_dpp(0, __float_as_int(x), 0x124, 0xF, 0xF, true));
    x += __int_as_float(__builtin_amdgcn_update_dpp(0, __float_as_int(x), 0x122, 0xF, 0xF, true));
    x += __int_as_float(__builtin_amdgcn_update_dpp(0, __float_as_int(x), 0x121, 0xF, 0xF, true));
    return x;
}
DI void build_lora_frags(const Params& p, int h, unsigned char* bfrag) {
    for (int fidx = threadIdx.x; fidx < 1024; fidx += NTHREADS) {
        const int mat = fidx >> 9, nt = (fidx >> 7) & 3, ks = (fidx >> 6) & 1, l = fidx & 63, n = l & 15, kg = l >> 4;
        const float* W = (mat ? p.a2 : p.w2) + (size_t)(32 * ks + 8 * kg) * 512 + h * 64 + 16 * nt + n;
        unsigned w[4];
#pragma unroll
        for (int e2 = 0; e2 < 4; ++e2) w[e2] = (unsigned)f2bf(W[(2 * e2) * 512]) | ((unsigned)f2bf(W[(2 * e2 + 1) * 512]) << 16);
        *(uint4*)(bfrag + fidx * 16) = make_uint4(w[0], w[1], w[2], w[3]);
    }
}
template <int PART, int RS, bool R3>
DI void stage16(const Params& p, const bf16_t* P, int b, int h, int tg0, int tg1, int tg2, int tg3, float* recs, const unsigned char* bfrag, float* bon_out  ) {
    asm volatile("" : "+s"(h));
    const int lane = threadIdx.x & 63, n = lane & 15, rg = lane >> 4;
    constexpr int FIELD = PART == 0 ? 0 : 128;
    {
        const float mu = PART == 0 ? p.mu_wa[lane] : p.mu_wa[64 + lane];
        const int colx = (PART == 0 ? C_W : C_A) + lane;
#pragma unroll
        for (int gi = 0; gi < 4; ++gi) {
            const int t0 = gi == 0 ? tg0 : gi == 1 ? tg1 : gi == 2 ? tg2 : tg3;
            const bf16_t* base = P + (size_t)(b * T + t0) * NP + colx;
            float prev = t0 > 0 ? bf2f(base[-NP]) : 0.f;
#pragma unroll
            for (int rr = 0; rr < 4; ++rr) {
                const float cur = bf2f(base[rr * NP]);
                const float x = cur + (prev - cur) * mu; prev = cur;
                float val = x;
                if (PART == 0) { const float e2 = __expf(2.f * x); val = 1.f - 2.f * __builtin_amdgcn_rcpf(1.f + e2); }
                *(bf16_t*)((unsigned char*)(recs + (gi * 4 + rr) * RS + FIELD) + 2 * lane) = f2bf(val);
            }
        }
    }
    f32x4 acc[4];
#pragma unroll
    for (int nt = 0; nt < 4; ++nt) acc[nt] = (f32x4){0.f, 0.f, 0.f, 0.f};
#pragma unroll
    for (int ks = 0; ks < 2; ++ks) {
        const bf16x8 af = *(const bf16x8*)((const unsigned char*)(recs + n * RS + FIELD) + ks * 64 + rg * 16);
#pragma unroll
        for (int nt = 0; nt < 4; ++nt) {
            const bf16x8 bfr = *(const bf16x8*)(bfrag + (((PART * 4 + nt) * 2 + ks) * 64 + lane) * 16);
            acc[nt] = __builtin_amdgcn_mfma_f32_16x16x32_bf16(af, bfr, acc[nt], 0, 0, 0);
        }
    }
    const int tgl = rg == 0 ? tg0 : rg == 1 ? tg1 : rg == 2 ? tg2 : tg3;
    const bf16_t* rowb = P + (size_t)(b * T + tgl) * NP;
    float* rec0 = recs + (4 * rg) * RS;
    const bool hp = tgl > 0;
    if (PART == 0) {
#pragma unroll
        for (int nt = 0; nt < 4; ++nt) {
            const int cl = 16 * nt + n, ch = h * 64 + cl;
            const float mu_r = p.mu_rkv[ch], mu_v = p.mu_rkv[1024 + ch], w0c = p.w0[ch];
            float rp = hp ? bf2f(rowb[-NP + C_R + ch]) : 0.f, vp = hp ? bf2f(rowb[-NP + C_V + ch]) : 0.f;
#pragma unroll
            for (int rr = 0; rr < 4; ++rr) {
                const float rc = bf2f(rowb[rr * NP + C_R + ch]), vc = bf2f(rowb[rr * NP + C_V + ch]);
                const float r = rc + (rp - rc) * mu_r, v = vc + (vp - vc) * mu_v; rp = rc; vp = vc;
                const float xw = -(w0c + acc[nt][rr]);
                const float sp = xw > 20.f ? xw : __logf(1.f + __expf(xw));
                const float decay = __expf(-__expf(-sp - 0.5f));
                float* o = rec0 + rr * RS;
                o[cl] = r; o[64 + cl] = decay; o[192 + cl] = v;
            }
        }
    } else {
        float kv[4][4], kk0[4][4], al[4][4], rv[4][4], n2[4] = {0.f, 0.f, 0.f, 0.f};
#pragma unroll
        for (int nt = 0; nt < 4; ++nt) {
            const int ch = h * 64 + 16 * nt + n;
            const float mu_k = p.mu_rkv[512 + ch], mu_r = p.mu_rkv[ch], a0c = p.a0[ch], kkc = p.k_k[ch];
            float kp = hp ? bf2f(rowb[-NP + C_K + ch]) : 0.f, rp = (R3 && hp) ? bf2f(rowb[-NP + C_R + ch]) : 0.f;
#pragma unroll
            for (int rr = 0; rr < 4; ++rr) {
                const float kc = bf2f(rowb[rr * NP + C_K + ch]);
                const float k = kc + (kp - kc) * mu_k; kp = kc;
                if (R3) { const float rc = bf2f(rowb[rr * NP + C_R + ch]); rv[nt][rr] = rc + (rp - rc) * mu_r; rp = rc; }
                kv[nt][rr] = k; kk0[nt][rr] = k * kkc; n2[rr] += kk0[nt][rr] * kk0[nt][rr];
                al[nt][rr] = __builtin_amdgcn_rcpf(1.f + __expf(-(a0c + acc[nt][rr])));
            }
        }
        float inv[4], bon[4] = {0.f, 0.f, 0.f, 0.f};
#pragma unroll
        for (int rr = 0; rr < 4; ++rr) inv[rr] = 1.f / fmaxf(sqrtf(row16_sum(n2[rr])), 1e-12f);
#pragma unroll
        for (int nt = 0; nt < 4; ++nt) {
            const int cl = 16 * nt + n, ch = h * 64 + cl;
            const float kac = p.k_a[ch], rkc = p.r_k[ch];
#pragma unroll
            for (int rr = 0; rr < 4; ++rr) {
                const float kk = kk0[nt][rr] * inv[rr], k2 = kv[nt][rr] * (1.f + (al[nt][rr] - 1.f) * kac);
                float* o = rec0 + rr * RS;
                o[128 + cl] = k2; o[256 + cl] = -kk; o[320 + cl] = kk * al[nt][rr];
                if (R3) bon[rr] += rv[nt][rr] * k2 * rkc;
            }
        }
        if (R3) {
#pragma unroll
            for (int rr = 0; rr < 4; ++rr) { const float bs = row16_sum(bon[rr]); if (n == 0) bon_out[tgl + rr] = bs; }
        }
    }
}

constexpr size_t OFF_LWF = OFF_YB, OFF_ALF = OFF_YC;
struct LoraRaw { uint4 w0, a0, w1, a1, w2, a2; };
struct LoraCst { float mu_w, mu_a, w0c[4], a0c[4]; };
DI LoraRaw lora_load(const bf16_t* P, int b, int t0) {
    int lane = threadIdx.x & 63; asm volatile("" : "+v"(lane));
    LoraRaw r; const uint4 z4 = make_uint4(0u, 0u, 0u, 0u);
    r.w0 = z4; r.a0 = z4; r.w1 = z4; r.a1 = z4; r.w2 = z4; r.a2 = z4;
    { const int row = lane >> 3, p16 = lane & 7, tt = t0 - 1 + row; if (tt >= 0) { r.w0 = *(const uint4*)(P + (size_t)(b * T + tt) * NP + C_W + p16 * 8); r.a0 = *(const uint4*)(P + (size_t)(b * T + tt) * NP + C_A + p16 * 8); } }
    { const int row = 8 + (lane >> 3), p16 = lane & 7, tt = t0 - 1 + row; r.w1 = *(const uint4*)(P + (size_t)(b * T + tt) * NP + C_W + p16 * 8); r.a1 = *(const uint4*)(P + (size_t)(b * T + tt) * NP + C_A + p16 * 8); }
    if (lane < 8) { const int tt = t0 + 15; r.w2 = *(const uint4*)(P + (size_t)(b * T + tt) * NP + C_W + lane * 8); r.a2 = *(const uint4*)(P + (size_t)(b * T + tt) * NP + C_A + lane * 8); }
    return r;
}
DI void lora_group(const Params& p, const LoraRaw& raw, const LoraCst& lc, int bh, int t0, unsigned char* scr, const unsigned char* bfrag) {
    int lane = threadIdx.x & 63; asm volatile("" : "+v"(lane));
    const int n = lane & 15, rg = lane >> 4;
    {
        const float mu_w = lc.mu_w, mu_a = lc.mu_a;
        { const int row = lane >> 3, p16 = lane & 7; *(uint4*)(scr + row * 128 + p16 * 16) = raw.w0; *(uint4*)(scr + 2176 + row * 128 + p16 * 16) = raw.a0;
          *(uint4*)(scr + (8 + row) * 128 + p16 * 16) = raw.w1; *(uint4*)(scr + 2176 + (8 + row) * 128 + p16 * 16) = raw.a1;
          if (lane < 8) { *(uint4*)(scr + 16 * 128 + lane * 16) = raw.w2; *(uint4*)(scr + 2176 + 16 * 128 + lane * 16) = raw.a2; } }
        v2f rwa[17];
#pragma unroll
        for (int i = 0; i < 17; ++i) rwa[i] = (v2f){bf2f(*(const bf16_t*)(scr + i * 128 + 2 * lane)), bf2f(*(const bf16_t*)(scr + 2176 + i * 128 + 2 * lane))};
        asm volatile("" ::: "memory");
        const v2f mu2 = (v2f){mu_w, mu_a};
#pragma unroll
        for (int i = 0; i < 16; ++i) {
            const v2f xm = __builtin_elementwise_fma(rwa[i] - rwa[i + 1], mu2, rwa[i + 1]);
            const float e2 = __builtin_amdgcn_exp2f(2.88539008178f * xm[0]);
            *(bf16_t*)(scr + (i + 1) * 128 + 2 * lane) = f2bf(1.f - 2.f * __builtin_amdgcn_rcpf(1.f + e2));
            *(bf16_t*)(scr + 2176 + (i + 1) * 128 + 2 * lane) = f2bf(xm[1]);
        }
    }
    f32x4 accw[4], acca[4];
#pragma unroll
    for (int nt = 0; nt < 4; ++nt) { accw[nt] = (f32x4){0.f, 0.f, 0.f, 0.f}; acca[nt] = (f32x4){0.f, 0.f, 0.f, 0.f}; }
#pragma unroll
    for (int ks = 0; ks < 2; ++ks) {
        const bf16x8 afw = *(const bf16x8*)(scr + (n + 1) * 128 + ks * 64 + rg * 16), afa = *(const bf16x8*)(scr + 2176 + (n + 1) * 128 + ks * 64 + rg * 16);
#pragma unroll
        for (int nt = 0; nt < 4; ++nt) {
            accw[nt] = __builtin_amdgcn_mfma_f32_16x16x32_bf16(afw, *(const bf16x8*)(bfrag + ((nt * 2 + ks) * 64 + lane) * 16), accw[nt], 0, 0, 0);
            acca[nt] = __builtin_amdgcn_mfma_f32_16x16x32_bf16(afa, *(const bf16x8*)(bfrag + (((4 + nt) * 2 + ks) * 64 + lane) * 16), acca[nt], 0, 0, 0);
        }
    }
    uint2* lwf = (uint2*)(p.ws + OFF_LWF) + ((size_t)(bh * 512 + (t0 >> 4)) * 4) * 64 + lane;
    uint2* alf = (uint2*)(p.ws + OFF_ALF) + ((size_t)(bh * 512 + (t0 >> 4)) * 4) * 64 + lane;
#pragma unroll
    for (int nt = 0; nt < 4; ++nt) {
        const float w0c = lc.w0c[nt], a0c = lc.a0c[nt];
        float lw[4], al[4];
#pragma unroll
        for (int rr = 0; rr < 4; ++rr) { lw[rr] = -0.60653066f * __builtin_amdgcn_rcpf(1.f + __expf(-(w0c + accw[nt][rr])));
            al[rr] = __builtin_amdgcn_rcpf(1.f + __expf(-(a0c + acca[nt][rr]))); }
        lwf[nt * 64] = make_uint2(pk2f(lw[0], lw[1]), pk2f(lw[2], lw[3]));
        alf[nt * 64] = make_uint2(pk2f(al[0], al[1]), pk2f(al[2], al[3]));
    }
}
template <int PART>
DI void stage16s(const Params& p, const unsigned char* rawc  , const unsigned char* fragl  ,
                 const float* cst  , int h, int bh, int t0, float* recs, float* bon_out, float (&Lb)[4]) {
    (void)p; (void)h; (void)bh;
    int lane = threadIdx.x & 63; asm volatile("" : "+v"(lane));
    const int n = lane & 15, rg = lane >> 4;
    constexpr int RS = 384;
    const int tgl = t0 + 4 * rg;
    const unsigned char* rawl = rawc + (4 * rg) * 384;
    const float hpf = tgl > 0 ? 1.f : 0.f;
    float* rec0 = recs + (4 * rg) * RS;
    const uint2* lwf = (const uint2*)fragl + lane;
    const uint2* alf = (const uint2*)(fragl + 2048) + lane;
#define S16S_L(nt_) \
        float eL[4], eLm[4], eN[4]; { const uint2 lwp = lwf[(nt_) * 64]; float lw[4], pl[4]; \
        lw[0] = __uint_as_float(lwp.x << 16); lw[1] = __uint_as_float(lwp.x & 0xffff0000u); lw[2] = __uint_as_float(lwp.y << 16); lw[3] = __uint_as_float(lwp.y & 0xffff0000u); \
        pl[0] = lw[0]; pl[1] = pl[0] + lw[1]; pl[2] = pl[1] + lw[2]; pl[3] = pl[2] + lw[3]; \
          \
        float inc, tot; { const unsigned xb_ = __float_as_uint(pl[3]); \
            const u32x2h_ q_ = __builtin_amdgcn_permlane16_swap(xb_, xb_, false, false); \
            const float s_ = __uint_as_float(q_[0]) + __uint_as_float(q_[1]); \
            const float p1_ = (rg & 1) ? s_ : pl[3]; \
            const u32x2h_ h_ = __builtin_amdgcn_permlane32_swap(__float_as_uint(s_), __float_as_uint(s_), false, false); \
            tot = __uint_as_float(h_[0]) + __uint_as_float(h_[1]); inc = p1_ + (rg >= 2 ? __uint_as_float(h_[0]) : 0.f); } \
        const float base_ = Lb[nt_] + inc - pl[3]; \
          \
        _Pragma("unroll") for (int rr = 0; rr < 4; ++rr) { const float L = base_ + pl[rr]; const float Lc = fmaxf(L, -80.f); eL[rr] = __expf(Lc); eN[rr] = __expf(-Lc); } \
        eLm[0] = __expf(fmaxf(base_, -80.f)); eLm[1] = eL[0]; eLm[2] = eL[1]; eLm[3] = eL[2]; \
        Lb[nt_] += tot; }
    if (PART == 0) {
#pragma unroll
        for (int nt = 0; nt < 4; ++nt) {
            S16S_L(nt)
            (void)eLm; (void)eN;
            const int cl = 16 * nt + n;
            const float mu_r = cst[cl], mu_v = cst[128 + cl];
            float rr_[5], vv_[5];
#pragma unroll
            for (int r5 = 0; r5 < 5; ++r5) { rr_[r5] = bf2f(*(const bf16_t*)(rawl + r5 * 384 + cl * 2)); vv_[r5] = bf2f(*(const bf16_t*)(rawl + r5 * 384 + 256 + cl * 2)); }
            rr_[0] *= hpf; vv_[0] *= hpf;
#pragma unroll
            for (int rr = 0; rr < 4; ++rr) {
                const float r = rr_[rr + 1] + (rr_[rr] - rr_[rr + 1]) * mu_r, v = vv_[rr + 1] + (vv_[rr] - vv_[rr + 1]) * mu_v;
                float* o = rec0 + rr * RS;
                o[cl] = r * eL[rr]; o[192 + cl] = v;
            }
            asm volatile("" ::: "memory");
        }
    } else {
        float kv[4][4], n2[4] = {0.f, 0.f, 0.f, 0.f};
#pragma unroll
        for (int nt = 0; nt < 4; ++nt) {
            const float mu_k = cst[64 + 16 * nt + n], kkc = cst[192 + 16 * nt + n];
            float kk_[5];
#pragma unroll
            for (int r5 = 0; r5 < 5; ++r5) kk_[r5] = bf2f(*(const bf16_t*)(rawl + r5 * 384 + 128 + (16 * nt + n) * 2));
            kk_[0] *= hpf;
#pragma unroll
            for (int rr = 0; rr < 4; ++rr) { const float k = kk_[rr + 1] + (kk_[rr] - kk_[rr + 1]) * mu_k; kv[nt][rr] = k; const float k0 = k * kkc; n2[rr] += k0 * k0; }
        }
        float inv[4], bon[4] = {0.f, 0.f, 0.f, 0.f};
#pragma unroll
        for (int rr = 0; rr < 4; ++rr) inv[rr] = fminf(__builtin_amdgcn_rsqf(row16_sum(n2[rr])), 1e12f);
#pragma unroll
        for (int nt = 0; nt < 4; ++nt) {
            S16S_L(nt)
            (void)eL;
            const int cl = 16 * nt + n;
            const float kac = cst[256 + cl], rkc = cst[320 + cl], mu_r = cst[cl], kkc = cst[192 + cl];
            const uint2 alp = alf[nt * 64];
            const float al4[4] = {__uint_as_float(alp.x << 16), __uint_as_float(alp.x & 0xffff0000u), __uint_as_float(alp.y << 16), __uint_as_float(alp.y & 0xffff0000u)};
            float rr_[5];
#pragma unroll
            for (int r5 = 0; r5 < 5; ++r5) rr_[r5] = bf2f(*(const bf16_t*)(rawl + r5 * 384 + cl * 2));
            rr_[0] *= hpf;
#pragma unroll
            for (int rr = 0; rr < 4; ++rr) {
                const float r = rr_[rr + 1] + (rr_[rr] - rr_[rr + 1]) * mu_r;
                const float al = al4[rr];
                const float k = kv[nt][rr], kk = k * kkc * inv[rr], k2 = k * (1.f + (al - 1.f) * kac);
                float* o = rec0 + rr * RS;
                o[128 + cl] = k2 * eN[rr]; o[256 + cl] = -kk * eLm[rr]; o[320 + cl] = kk * al * eN[rr];
                bon[rr] += r * k2 * rkc;
            }
            asm volatile("" ::: "memory");
        }
#pragma unroll
        for (int rr = 0; rr < 4; ++rr) { const float bs = row16_sum(bon[rr]); if (n == 0) bon_out[tgl + rr] = bs; }
    }
#undef S16S_L
}
template <int MODE> DI void rwkv_step_s(v2f (&z)[4][8], const float* cc, int q, int g, float (&yo)[4]) {
    f32x4 av[4], bv[4], kv[4], rv[4];
#pragma unroll
    for (int u = 0; u < 4; ++u) { av[u] = *(const f32x4*)(cc + 256 + 16 * q + 4 * u); bv[u] = *(const f32x4*)(cc + 320 + 16 * q + 4 * u); rv[u] = *(const f32x4*)(cc + 16 * q + 4 * u);
        if (MODE == 1) kv[u] = *(const f32x4*)(cc + 128 + 16 * q + 4 * u); }
    f32x4 vr = (f32x4){0.f, 0.f, 0.f, 0.f};
    if (MODE == 1) vr = *(const f32x4*)(cc + 192 + 4 * g);
#define V2LO(x_) ((v2f){(x_)[0], (x_)[1]})
#define V2HI(x_) ((v2f){(x_)[2], (x_)[3]})
    float sa[4];
#pragma unroll
    for (int rr = 0; rr < 4; ++rr) {
        v2f s = z[rr][0] * V2LO(av[0]);
        s = __builtin_elementwise_fma(z[rr][1], V2HI(av[0]), s);
#pragma unroll
        for (int u = 1; u < 4; ++u) { s = __builtin_elementwise_fma(z[rr][2 * u], V2LO(av[u]), s); s = __builtin_elementwise_fma(z[rr][2 * u + 1], V2HI(av[u]), s); }
        sa[rr] = quad_sum(s[0] + s[1]);
    }
#pragma unroll
    for (int rr = 0; rr < 4; ++rr) {
        const v2f sa2 = (v2f){sa[rr], sa[rr]}, vr2 = (v2f){vr[rr], vr[rr]};
#pragma unroll
        for (int u = 0; u < 4; ++u) {
            v2f t0 = __builtin_elementwise_fma(sa2, V2LO(bv[u]), z[rr][2 * u]), t1 = __builtin_elementwise_fma(sa2, V2HI(bv[u]), z[rr][2 * u + 1]);
            if (MODE == 1) { t0 = __builtin_elementwise_fma(vr2, V2LO(kv[u]), t0); t1 = __builtin_elementwise_fma(vr2, V2HI(kv[u]), t1); }
            z[rr][2 * u] = t0; z[rr][2 * u + 1] = t1;
        }
    }
#pragma unroll
    for (int rr = 0; rr < 4; ++rr) {
        v2f s = z[rr][0] * V2LO(rv[0]);
        s = __builtin_elementwise_fma(z[rr][1], V2HI(rv[0]), s);
#pragma unroll
        for (int u = 1; u < 4; ++u) { s = __builtin_elementwise_fma(z[rr][2 * u], V2LO(rv[u]), s); s = __builtin_elementwise_fma(z[rr][2 * u + 1], V2HI(rv[u]), s); }
        yo[rr] = quad_sum(s[0] + s[1]);
    }
#undef V2LO
#undef V2HI
}

DI void rwkv_step_m(v2f (&z)[4][8], const float* cc, int q, int vro, float (&yo)[4]) {
    f32x4 av[4], bv[4], kv[4], rv[4];
#pragma unroll
    for (int u = 0; u < 4; ++u) { av[u] = *(const f32x4*)(cc + 256 + 16 * q + 4 * u); bv[u] = *(const f32x4*)(cc + 320 + 16 * q + 4 * u); rv[u] = *(const f32x4*)(cc + 16 * q + 4 * u);
        kv[u] = *(const f32x4*)(cc + 128 + 16 * q + 4 * u); }
    const v2f vr = *(const v2f*)(cc + 192 + vro);
#define V2LO(x_) ((v2f){(x_)[0], (x_)[1]})
#define V2HI(x_) ((v2f){(x_)[2], (x_)[3]})
    float sa[4];
#pragma unroll
    for (int rr = 0; rr < 4; ++rr) {
        v2f s = z[rr][0] * V2LO(av[0]);
        s = __builtin_elementwise_fma(z[rr][1], V2HI(av[0]), s);
#pragma unroll
        for (int u = 1; u < 4; ++u) { s = __builtin_elementwise_fma(z[rr][2 * u], V2LO(av[u]), s); s = __builtin_elementwise_fma(z[rr][2 * u + 1], V2HI(av[u]), s); }
        sa[rr] = quad_sum(s[0] + s[1]);
    }
#pragma unroll
    for (int rr = 0; rr < 4; ++rr) {
        const v2f sa2 = (v2f){sa[rr], sa[rr]}, vr2 = (v2f){vr[rr & 1], vr[rr & 1]};
#pragma unroll
        for (int u = 0; u < 4; ++u) {
            v2f t0 = __builtin_elementwise_fma(sa2, V2LO(bv[u]), z[rr][2 * u]), t1 = __builtin_elementwise_fma(sa2, V2HI(bv[u]), z[rr][2 * u + 1]);
            if (rr >= 2) { t0 = __builtin_elementwise_fma(vr2, V2LO(kv[u]), t0); t1 = __builtin_elementwise_fma(vr2, V2HI(kv[u]), t1); }
            z[rr][2 * u] = t0; z[rr][2 * u + 1] = t1;
        }
    }
#pragma unroll
    for (int rr = 0; rr < 4; ++rr) {
        v2f s = z[rr][0] * V2LO(rv[0]);
        s = __builtin_elementwise_fma(z[rr][1], V2HI(rv[0]), s);
#pragma unroll
        for (int u = 1; u < 4; ++u) { s = __builtin_elementwise_fma(z[rr][2 * u], V2LO(rv[u]), s); s = __builtin_elementwise_fma(z[rr][2 * u + 1], V2HI(rv[u]), s); }
        yo[rr] = quad_sum(s[0] + s[1]);
    }
#undef V2LO
#undef V2HI
}

struct StepOps { f32x4 av[4], bv[4], kv[4], rv[4]; v2f vr; };
DI void load_ops(StepOps& o, const float* cc, int q, int vro) {
#pragma unroll
    for (int u = 0; u < 4; ++u) { o.av[u] = *(const f32x4*)(cc + 256 + 16 * q + 4 * u); o.bv[u] = *(const f32x4*)(cc + 320 + 16 * q + 4 * u); o.rv[u] = *(const f32x4*)(cc + 16 * q + 4 * u);
        o.kv[u] = *(const f32x4*)(cc + 128 + 16 * q + 4 * u); }
    o.vr = *(const v2f*)(cc + 192 + vro);
}
DI void rwkv_step_mo(v2f (&z)[4][8], const StepOps& o, float (&yo)[4]) {
#define V2LO(x_) ((v2f){(x_)[0], (x_)[1]})
#define V2HI(x_) ((v2f){(x_)[2], (x_)[3]})
    float sa[4];
#pragma unroll
    for (int rr = 0; rr < 4; ++rr) {
        v2f s = z[rr][0] * V2LO(o.av[0]);
        s = __builtin_elementwise_fma(z[rr][1], V2HI(o.av[0]), s);
#pragma unroll
        for (int u = 1; u < 4; ++u) { s = __builtin_elementwise_fma(z[rr][2 * u], V2LO(o.av[u]), s); s = __builtin_elementwise_fma(z[rr][2 * u + 1], V2HI(o.av[u]), s); }
        sa[rr] = quad_sum(s[0] + s[1]);
    }
#pragma unroll
    for (int rr = 0; rr < 4; ++rr) {
        const v2f sa2 = (v2f){sa[rr], sa[rr]}, vr2 = (v2f){o.vr[rr & 1], o.vr[rr & 1]};
#pragma unroll
        for (int u = 0; u < 4; ++u) {
            v2f t0 = __builtin_elementwise_fma(sa2, V2LO(o.bv[u]), z[rr][2 * u]), t1 = __builtin_elementwise_fma(sa2, V2HI(o.bv[u]), z[rr][2 * u + 1]);
            if (rr >= 2) { t0 = __builtin_elementwise_fma(vr2, V2LO(o.kv[u]), t0); t1 = __builtin_elementwise_fma(vr2, V2HI(o.kv[u]), t1); }
            z[rr][2 * u] = t0; z[rr][2 * u + 1] = t1;
        }
    }
#pragma unroll
    for (int rr = 0; rr < 4; ++rr) {
        v2f s = z[rr][0] * V2LO(o.rv[0]);
        s = __builtin_elementwise_fma(z[rr][1], V2HI(o.rv[0]), s);
#pragma unroll
        for (int u = 1; u < 4; ++u) { s = __builtin_elementwise_fma(z[rr][2 * u], V2LO(o.rv[u]), s); s = __builtin_elementwise_fma(z[rr][2 * u + 1], V2HI(o.rv[u]), s); }
        yo[rr] = quad_sum(s[0] + s[1]);
    }
#undef V2LO
#undef V2HI
}

template <int MODE> DI void rwkv_step(float (&z)[4][16], const float* cc, int q, int g, float (&sa)[4], float (&yo)[4]) {
    f32x4 av[4], wv[4], bv[4], kv[4];
#pragma unroll
    for (int u = 0; u < 4; ++u) { av[u] = *(const f32x4*)(cc + 256 + 16 * q + 4 * u); wv[u] = *(const f32x4*)(cc + 64 + 16 * q + 4 * u); bv[u] = *(const f32x4*)(cc + 320 + 16 * q + 4 * u);
        if (MODE == 1) kv[u] = *(const f32x4*)(cc + 128 + 16 * q + 4 * u); }
    f32x4 vr = (f32x4){0.f, 0.f, 0.f, 0.f};
    if (MODE == 1) vr = *(const f32x4*)(cc + 192 + 4 * g);
#pragma unroll
    for (int rr = 0; rr < 4; ++rr) {
        float s0 = 0.f, s1 = 0.f;
#pragma unroll
        for (int u = 0; u < 4; ++u) { s0 += z[rr][4 * u] * av[u][0] + z[rr][4 * u + 2] * av[u][2]; s1 += z[rr][4 * u + 1] * av[u][1] + z[rr][4 * u + 3] * av[u][3]; }
        sa[rr] = quad_sum(s0 + s1);
    }
#pragma unroll
    for (int rr = 0; rr < 4; ++rr)
#pragma unroll
        for (int u = 0; u < 4; ++u)
#pragma unroll
            for (int e = 0; e < 4; ++e) {
                float t = sa[rr] * bv[u][e];
                if (MODE == 1) t += vr[rr] * kv[u][e];
                z[rr][4 * u + e] = z[rr][4 * u + e] * wv[u][e] + t;
            }
    f32x4 rv[4];
#pragma unroll
    for (int u = 0; u < 4; ++u) rv[u] = *(const f32x4*)(cc + 16 * q + 4 * u);
#pragma unroll
    for (int rr = 0; rr < 4; ++rr) {
        float s0 = 0.f, s1 = 0.f;
#pragma unroll
        for (int u = 0; u < 4; ++u) { s0 += z[rr][4 * u] * rv[u][0] + z[rr][4 * u + 2] * rv[u][2]; s1 += z[rr][4 * u + 1] * rv[u][1] + z[rr][4 * u + 3] * rv[u][3]; }
        yo[rr] = quad_sum(s0 + s1);
    }
}

DI void phase_rwkv_prep(const Params& p, unsigned char* lds, const int bid, const int nb) {
    float* ck = (float*)lds; unsigned char* bfrag = lds + 64 * 384 * 4; float* mat = (float*)lds;
    const bf16_t* P = (const bf16_t*)(p.ws + OFF_P);
    unsigned char* fr = (unsigned char*)p.out;
    bf16_t* YA = (bf16_t*)(p.ws + OFF_YA);
    for (int item = bid; item < 256; item += nb) {
        int tid = threadIdx.x; asm volatile("" : "+v"(tid));
        const int lane = tid & 63, wid = __builtin_amdgcn_readfirstlane(tid >> 6), q = lane & 3, g = lane >> 2, cl = wid & 3, role = wid >> 2;
        const int bh = item >> 4, cq = item & 15, b = bh >> 3, h = bh & 7;
        __syncthreads();
        R1STAMP(0);
        if (STAMP_PH >= 30 && blockIdx.x == 0 && threadIdx.x == 0) { ((volatile LAS unsigned*)(lds + LDS_CTL_OFF + 64))[24] = 0u; ((volatile LAS unsigned*)(lds + LDS_CTL_OFF + 64))[25] = 0u; ((volatile LAS unsigned*)(lds + LDS_CTL_OFF + 64))[26] = 0u; }
        float* cst = (float*)(lds + 64 * 384 * 4 + 16384 + 2048 + 26624);
        if (tid < 384) { const int k6 = tid >> 6, c6 = tid & 63, ch = h * 64 + c6;
            cst[tid] = k6 == 0 ? p.mu_rkv[ch] : k6 == 1 ? p.mu_rkv[512 + ch] : k6 == 2 ? p.mu_rkv[1024 + ch] : k6 == 3 ? p.k_k[ch] : k6 == 4 ? p.k_a[ch] : p.r_k[ch]; }
        build_lora_frags(p, h, bfrag);
        __syncthreads();
        R1STAMP(1);
        {
            LoraCst lc; lc.mu_w = p.mu_wa[lane]; lc.mu_a = p.mu_wa[64 + lane];
#pragma unroll
            for (int nt = 0; nt < 4; ++nt) { lc.w0c[nt] = p.w0[h * 64 + 16 * nt + (lane & 15)]; lc.a0c[nt] = p.a0[h * 64 + 16 * nt + (lane & 15)]; }
            LoraRaw cur = lora_load(P, b, cq * 4 * CHT + wid * 16);
#pragma unroll 1
            for (int gi = 0; gi < 4; ++gi) {
                const LoraRaw nxt = lora_load(P, b, cq * 4 * CHT + (wid + 8 * (gi < 3 ? gi + 1 : gi)) * 16);
                lora_group(p, cur, lc, bh, cq * 4 * CHT + (wid + 8 * gi) * 16, lds + wid * 4352, bfrag);
                cur = nxt;
            }
            asm volatile("s_waitcnt vmcnt(0)" ::: "memory");
            __syncthreads();
            if (tid == 0) __builtin_amdgcn_fence(__ATOMIC_ACQUIRE, "agent");
            asm volatile("s_waitcnt vmcnt(0)" ::: "memory");
        }
        R1STAMP(2);
        v2f z[4][8];
#pragma unroll
        for (int rr = 0; rr < 4; ++rr)
#pragma unroll
            for (int c = 0; c < 16; ++c) z[rr][c >> 1][c & 1] = (rr < 2 && (32 * role + 2 * g + rr) == (16 * q + c)) ? 1.f : 0.f;
        bf16_t* qh = (bf16_t*)(fr + OFF_QH) + (size_t)bh * T * 64;
        float* bon = (float*)(fr + OFF_BON) + (size_t)bh * T;
        float Lb[4] = {0.f, 0.f, 0.f, 0.f};
        unsigned char* rawbuf = lds + 64 * 384 * 4 + 16384 + 2048;
#define RAW_DMA(sl_) do { int ln_ = lane; asm volatile("" : "+v"(ln_)); _Pragma("unroll") for (int u_ = 0; u_ < 4; ++u_) { const int slot_ = u_ * 8 + wid; if (slot_ < 26) { int pi = slot_ * 64 + ln_; pi = pi < 1632 ? pi : 1631; \
            const int clx = pi / 408, rem = pi - clx * 408, row = rem / 24, r2 = rem - row * 24, seg = r2 >> 3, p16 = r2 & 7; int tt = (cq * 4 + clx) * CHT + (sl_) * 16 - 1 + row; tt = tt < 0 ? 0 : tt; \
            __builtin_amdgcn_global_load_lds((const unsigned*)(P + (size_t)(b * T + tt) * NP + (seg == 0 ? C_R : seg == 1 ? C_K : C_V) + h * 64 + p16 * 8), (LAS unsigned*)(LASP(rawbuf) + slot_ * 1024), 16, 0, 0); } } \
              \
            _Pragma("unroll") for (int u_ = 0; u_ < 2; ++u_) { const int j_ = u_ * 8 + wid, clx = j_ >> 2, part = (j_ >> 1) & 1, half = j_ & 1; \
            const unsigned char* src_ = p.ws + (part ? OFF_ALF : OFF_LWF) + ((size_t)(bh * 512 + (((cq * 4 + clx) * CHT + (sl_) * 16) >> 4)) * 4) * 64 * 8 + half * 1024 + ln_ * 16; \
            __builtin_amdgcn_global_load_lds((const unsigned*)src_, (LAS unsigned*)(LASP(bfrag) + clx * 4096 + part * 2048 + half * 1024), 16, 0, 0); } } while (0)
        RAW_DMA(0);
#pragma unroll 1
        for (int sl = 0; sl < CHT / 16; ++sl) {
            const int tb = (cq * 4 + cl) * CHT + sl * 16;
            unsigned ts0_ = 0; if (STAMP_PH >= 30) ts0_ = (unsigned)__builtin_amdgcn_s_memrealtime();
            __syncthreads();
            R1ACC(2, ts0_); if (STAMP_PH >= 30) ts0_ = (unsigned)__builtin_amdgcn_s_memrealtime();
            if (role == 0) stage16s<0>(p, rawbuf + cl * 6528, bfrag + cl * 4096, cst, h, bh, tb, ck + cl * 16 * 384, bon, Lb);
            else           stage16s<1>(p, rawbuf + cl * 6528, bfrag + cl * 4096, cst, h, bh, tb, ck + cl * 16 * 384, bon, Lb);
            __syncthreads();
            R1ACC(0, ts0_); if (STAMP_PH >= 30) ts0_ = (unsigned)__builtin_amdgcn_s_memrealtime();
            if (sl + 1 < CHT / 16) RAW_DMA(sl + 1);
            float yo[4];
            {
                const int rowl = 32 * role + 2 * g + (q & 1);
                bf16_t* dstp = q < 2 ? qh + (size_t)tb * 64 + rowl : YA + (size_t)(b * T + tb) * 512 + h * 64 + rowl;
                const int dsts = q < 2 ? 64 : 512;
                const float* rc = ck + (cl * 16) * 384; const int vro = 32 * role + 2 * g;
                StepOps oa, ob2;
                load_ops(oa, rc, q, vro);
#pragma unroll 1
                for (int i = 0; i < 16; i += 2) {
                    load_ops(ob2, rc + (i + 1) * 384, q, vro); __builtin_amdgcn_sched_barrier(0);
                    rwkv_step_mo(z, oa, yo);
                    *dstp = f2bf(q == 0 ? yo[0] : q == 1 ? yo[1] : q == 2 ? yo[2] : yo[3]); dstp += dsts;
                    load_ops(oa, rc + (i + 2 < 16 ? i + 2 : i + 1) * 384, q, vro); __builtin_amdgcn_sched_barrier(0);
                    rwkv_step_mo(z, ob2, yo);
                    *dstp = f2bf(q == 0 ? yo[0] : q == 1 ? yo[1] : q == 2 ? yo[2] : yo[3]); dstp += dsts;
                }
            }
            R1ACC(1, ts0_);
        }
        R1STAMP(3);
        {
            float* gC = (float*)(lds + 64 * 384 * 4 + 16384) + wid * 64;
            __syncthreads();
            if ((lane >> 4) == 0) {
#pragma unroll
                for (int nt = 0; nt < 4; ++nt) gC[16 * nt + (lane & 15)] = __expf(fmaxf(Lb[nt], -80.f));
            }
            asm volatile("s_waitcnt lgkmcnt(0)" ::: "memory");
#pragma unroll
            for (int u = 0; u < 4; ++u) { const f32x4 g4 = *(const f32x4*)(gC + 16 * q + 4 * u);
#pragma unroll
                for (int rr = 0; rr < 4; ++rr)
#pragma unroll
                    for (int e = 0; e < 4; ++e) z[rr][2 * u + (e >> 1)][e & 1] *= g4[e]; }
        }
        for (int pass = 0; pass < 2; ++pass) {
            __syncthreads();
            {
#pragma unroll
                for (int r2 = 0; r2 < 2; ++r2) { const int rr = 2 * pass + r2;
#pragma unroll
                    for (int u = 0; u < 4; ++u) *(f32x4*)(mat + (cl * 64 + 32 * role + 2 * g + r2) * 68 + 16 * q + 4 * u) = (f32x4){z[rr][2 * u][0], z[rr][2 * u][1], z[rr][2 * u + 1][0], z[rr][2 * u + 1][1]}; }
            }
            __syncthreads();
            int tidb = threadIdx.x; asm volatile("" : "+v"(tidb));
            if (pass == 0) {
                for (int it = tidb; it < 4 * 8 * 64; it += NTHREADS) {
                    const int clx = it >> 9, f = (it >> 6) & 7, l = it & 63, n16 = l & 15, gg = l >> 4, fi = f >> 1, fs = f & 1;
                    const size_t chunk = (size_t)bh * NCHUNK + cq * 4 + clx;
                    unsigned hi[4], lo[4];
#pragma unroll
                    for (int e2 = 0; e2 < 4; ++e2) {
                        unsigned short hs[2], ls[2];
#pragma unroll
                        for (int d = 0; d < 2; ++d) { const int e = 2 * e2 + d, kin = 32 * fs + 16 * (e >> 2) + 4 * gg + (e & 3), kout = 16 * fi + n16;
                            const float val = mat[(clx * 64 + kin) * 68 + kout]; hs[d] = f2bf(val); ls[d] = f2bf(val - bf2f(hs[d])); }
                        hi[e2] = (unsigned)hs[0] | ((unsigned)hs[1] << 16); lo[e2] = (unsigned)ls[0] | ((unsigned)ls[1] << 16);
                    }
                    unsigned char* dst = fr + OFF_AF + chunk * AF_BYTES + (size_t)((f * 2) * 64 + l) * 16;
                    *(uint4*)dst = make_uint4(hi[0], hi[1], hi[2], hi[3]);
                    *(uint4*)(dst + 64 * 16) = make_uint4(lo[0], lo[1], lo[2], lo[3]);
                }
            } else {
                for (int it = tidb; it < 4 * 4 * 4 * 64; it += NTHREADS) {
                    const int l = it & 63, fi = (it >> 6) & 3, w4 = (it >> 8) & 3, clx = it >> 10, gg = l >> 4;
                    const size_t chunk = (size_t)bh * NCHUNK + cq * 4 + clx;
                    const f32x4 v4 = *(const f32x4*)(mat + (clx * 64 + 16 * w4 + (l & 15)) * 68 + 16 * fi + 4 * gg);
                    *(f32x4*)(fr + OFF_NF + chunk * NF_BYTES + (size_t)(((w4 * 4 + fi) * 64 + l) * 4) * 4) = v4;
                }
            }
        }
        R1STAMP(4);
    }
}

DI void split4x2(const f32x4& xa, const f32x4& xb, bf16x8& hi, bf16x8& lo) {
#pragma unroll
    for (int e = 0; e < 4; ++e) { const float va = xa[e], vb = xb[e]; const bf16_t ha = f2bf(va), hb = f2bf(vb);
        hi[e] = (short)ha; hi[4 + e] = (short)hb; lo[e] = (short)f2bf(va - bf2f(ha)); lo[4 + e] = (short)f2bf(vb - bf2f(hb)); }
}
DI void phase_rwkv_scan(const Params& p, unsigned char* lds, const int bh) {
    unsigned char* fr = (unsigned char*)p.out;
    const int tid = threadIdx.x, lane = tid & 63, wid = tid >> 6;
    const unsigned char* gA = fr + OFF_AF + (size_t)bh * NCHUNK * AF_BYTES;
    unsigned char* gN = fr + OFF_NF + (size_t)bh * NCHUNK * NF_BYTES;
    const bool loader = wid >= 4;
    const int wl = __builtin_amdgcn_readfirstlane(wid - 4);
#define SCAN_DMA(cc_) do { const unsigned char* ga_ = gA + (size_t)(cc_) * AF_BYTES + wl * 4096 + lane * 16; const unsigned char* gn_ = gN + (size_t)(cc_) * NF_BYTES + wl * 4096 + lane * 16; \
        __attribute__((address_space(3))) unsigned char* sl_ = LASP(lds) + ((cc_) & 3) * 32768 + wl * 4096; \
        _Pragma("unroll") for (int j_ = 0; j_ < 4; ++j_) __builtin_amdgcn_global_load_lds((const unsigned*)(ga_ + j_ * 1024), (__attribute__((address_space(3))) unsigned*)(sl_ + j_ * 1024), 16, 0, 0); \
        _Pragma("unroll") for (int j_ = 0; j_ < 4; ++j_) __builtin_amdgcn_global_load_lds((const unsigned*)(gn_ + j_ * 1024), (__attribute__((address_space(3))) unsigned*)(sl_ + 16384 + j_ * 1024), 16, 0, 0); } while (0)
    __syncthreads();
    if (loader) { SCAN_DMA(0); SCAN_DMA(1); SCAN_DMA(2); SCAN_DMA(3); asm volatile("s_waitcnt vmcnt(0)" ::: "memory"); }
    f32x4 X[4];
#pragma unroll
    for (int i = 0; i < 4; ++i) X[i] = (f32x4){0.f, 0.f, 0.f, 0.f};
    bf16x8 ah[8], al[8]; f32x4 nt[4];
#define SCAN_FRAGS(cc_) do { const unsigned char* s_ = lds + ((cc_) & 3) * 32768; \
        _Pragma("unroll") for (int f = 0; f < 8; ++f) { ah[f] = *(const bf16x8*)(s_ + ((f * 2) * 64 + lane) * 16); al[f] = *(const bf16x8*)(s_ + ((f * 2 + 1) * 64 + lane) * 16); } \
        _Pragma("unroll") for (int i = 0; i < 4; ++i) nt[i] = *(const f32x4*)(s_ + 16384 + ((wid * 4 + i) * 64 + lane) * 16); } while (0)
    asm volatile("s_waitcnt lgkmcnt(0)" ::: "memory"); __builtin_amdgcn_s_barrier(); asm volatile("" ::: "memory");
    if (!loader) SCAN_FRAGS(0);
    asm volatile("s_waitcnt lgkmcnt(0)" ::: "memory"); __builtin_amdgcn_s_barrier(); asm volatile("" ::: "memory");
    for (int c = 0; c < (int)NCHUNK; ++c) {
        if (loader) {
            if (c + 4 < (int)NCHUNK) { SCAN_DMA(c + 4); asm volatile("s_waitcnt vmcnt(16)" ::: "memory"); } else asm volatile("s_waitcnt vmcnt(0)" ::: "memory");
        } else {
            const int w4 = wid;
            float* gs = (float*)(gN + (size_t)c * NF_BYTES) + ((w4 * 4) * 64 + lane) * 4;
#pragma unroll
            for (int i = 0; i < 4; ++i) *(f32x4*)(gs + i * 256) = X[i];
            bf16x8 bhi[2], blo[2];
            split4x2(X[0], X[1], bhi[0], blo[0]); split4x2(X[2], X[3], bhi[1], blo[1]);
#pragma unroll
            for (int i = 0; i < 4; ++i) {
                f32x4 D = nt[i];
#pragma unroll
                for (int s = 0; s < 2; ++s) {
                    const int f = i * 2 + s;
                    D = __builtin_amdgcn_mfma_f32_16x16x32_bf16(ah[f], bhi[s], D, 0, 0, 0);
                    D = __builtin_amdgcn_mfma_f32_16x16x32_bf16(ah[f], blo[s], D, 0, 0, 0);
                    D = __builtin_amdgcn_mfma_f32_16x16x32_bf16(al[f], bhi[s], D, 0, 0, 0);
                }
                X[i] = D;
            }
            if (c + 1 < (int)NCHUNK) SCAN_FRAGS(c + 1);
        }
        asm volatile("s_waitcnt lgkmcnt(0)" ::: "memory"); __builtin_amdgcn_s_barrier(); asm volatile("" ::: "memory");
    }
    asm volatile("s_waitcnt vmcnt(0)" ::: "memory");
    __syncthreads();
    if (tid == 0) {
        __builtin_amdgcn_fence(__ATOMIC_RELEASE, "agent");
        asm volatile("s_waitcnt vmcnt(0)" ::: "memory");
        __hip_atomic_store((unsigned*)(p.ws + OFF_CTL + 32768 + 256) + bh, 1u, __ATOMIC_RELAXED, __HIP_MEMORY_SCOPE_AGENT);
    }
}

DI unsigned pk2(float lo, float hi) { typedef float f2_ __attribute__((ext_vector_type(2))); typedef __bf16 b2_ __attribute__((ext_vector_type(2))); return __builtin_bit_cast(unsigned, __builtin_convertvector((f2_){lo, hi}, b2_)); }
DI void unpack8(const uint4& v, float (&x)[8]) { const unsigned w[4] = {v.x, v.y, v.z, v.w};
#pragma unroll
    for (int i = 0; i < 4; ++i) { x[2 * i] = __uint_as_float(w[i] << 16); x[2 * i + 1] = __uint_as_float(w[i] & 0xffff0000u); } }
DI uint4 pack8f(const float (&x)[8]) { return make_uint4(pk2(x[0], x[1]), pk2(x[2], x[3]), pk2(x[4], x[5]), pk2(x[6], x[7])); }
DI void rwkv_out_item(const Params& p, unsigned char* lds, const int item) {
    const bf16_t* P = (const bf16_t*)(p.ws + OFF_P); bf16_t* YA = (bf16_t*)(p.ws + OFF_YA);
    const unsigned char* fr = (const unsigned char*)p.out;
    int tid = threadIdx.x; asm volatile("" : "+v"(tid));
    const int lane = tid & 63, wid = __builtin_amdgcn_readfirstlane(tid >> 6), c = lane & 31, hh = lane >> 5;
    {
        const int chunkg = item * 2 + (wid >> 2), bh = chunkg >> 6, cc = chunkg & 63, b = bh >> 3, h = bh & 7, tt = wid & 3;
        const int t = cc * CHT + tt * 32 + c;
        const float* sf = (const float*)(fr + OFF_NF + (size_t)chunkg * NF_BYTES);
        const bf16_t* qh = (const bf16_t*)(fr + OFF_QH) + ((size_t)bh * T + t) * 64;
        bf16x8 qf[4];
#pragma unroll
        for (int ks = 0; ks < 4; ++ks) qf[ks] = *(const bf16x8*)(qh + 16 * ks + 8 * hh);
        f32x16 yt[2];
#pragma unroll
        for (int vt = 0; vt < 2; ++vt) {
#pragma unroll
            for (int i = 0; i < 16; ++i) yt[vt][i] = 0.f;
#pragma unroll
            for (int ks = 0; ks < 4; ++ks) {
                const int v = 32 * vt + c;
                const float* s0 = sf + (((v >> 4) * 4 + ks) * 64 + (v & 15) + 32 * hh) * 4;
                const f32x4 lo4 = *(const f32x4*)s0, hi4 = *(const f32x4*)(s0 + 64);
                bf16x8 ah, al;
#pragma unroll
                for (int e = 0; e < 4; ++e) { const bf16_t h0 = f2bf(lo4[e]), h1 = f2bf(hi4[e]); ah[e] = (short)h0; ah[4 + e] = (short)h1;
                    al[e] = (short)f2bf(lo4[e] - bf2f(h0)); al[4 + e] = (short)f2bf(hi4[e] - bf2f(h1)); }
                yt[vt] = MFMA32(ah, qf[ks], yt[vt]);
                yt[vt] = MFMA32(al, qf[ks], yt[vt]);
            }
        }
        float* ybuf = (float*)lds + wid * (32 * 68);
#pragma unroll
        for (int vt = 0; vt < 2; ++vt)
#pragma unroll
            for (int gq = 0; gq < 4; ++gq) *(f32x4*)(ybuf + c * 68 + 32 * vt + 8 * gq + 4 * hh) = (f32x4){yt[vt][4 * gq], yt[vt][4 * gq + 1], yt[vt][4 * gq + 2], yt[vt][4 * gq + 3]};
        asm volatile("s_waitcnt lgkmcnt(0)" ::: "memory");
        const int j8 = lane & 7, tl = lane >> 3, ch0 = h * 64 + 8 * j8;
        const f32x4 mu0 = *(const f32x4*)(p.mu_rkv + 1024 + ch0), mu1 = *(const f32x4*)(p.mu_rkv + 1024 + ch0 + 4);
        const f32x4 lg0 = *(const f32x4*)(p.lnx_g + ch0), lg1 = *(const f32x4*)(p.lnx_g + ch0 + 4), lb0 = *(const f32x4*)(p.lnx_b + ch0), lb1 = *(const f32x4*)(p.lnx_b + ch0 + 4);
        const float mu[8] = {mu0[0], mu0[1], mu0[2], mu0[3], mu1[0], mu1[1], mu1[2], mu1[3]}, lg[8] = {lg0[0], lg0[1], lg0[2], lg0[3], lg1[0], lg1[1], lg1[2], lg1[3]};
        const float lb[8] = {lb0[0], lb0[1], lb0[2], lb0[3], lb1[0], lb1[1], lb1[2], lb1[3]};
        uint4 yl4_[4], vc4_[4], zz4_[4], vp4_[4]; float bon_[4];
#pragma unroll
        for (int it = 0; it < 4; ++it) {
            const int tok = 8 * it + tl, t2 = cc * CHT + tt * 32 + tok;
            const size_t row = (size_t)(b * T + t2);
            const bf16_t* pr = P + row * NP;
            yl4_[it] = *(const uint4*)(YA + row * 512 + ch0); vc4_[it] = *(const uint4*)(pr + C_V + ch0); zz4_[it] = *(const uint4*)(pr + C_ZA + ch0);
            vp4_[it] = make_uint4(0u, 0u, 0u, 0u); if (t2 > 0) vp4_[it] = *(const uint4*)(pr - NP + C_V + ch0);
            bon_[it] = *((const float*)(fr + OFF_BON) + (size_t)bh * T + t2);
        }
#pragma unroll
        for (int it = 0; it < 4; ++it) {
            const int tok = 8 * it + tl, t2 = cc * CHT + tt * 32 + tok;
            const size_t row = (size_t)(b * T + t2);
            bf16_t* yrow = YA + row * 512 + ch0;
            const uint4 yl4 = yl4_[it], vc4 = vc4_[it], zz4 = zz4_[it], vp4 = vp4_[it];
            const float bon = bon_[it];
            const f32x4 ya = *(const f32x4*)(ybuf + tok * 68 + 8 * j8), yb = *(const f32x4*)(ybuf + tok * 68 + 8 * j8 + 4);
            float y[8] = {ya[0], ya[1], ya[2], ya[3], yb[0], yb[1], yb[2], yb[3]}, yl[8], vc[8], vp[8], zz[8];
            unpack8(yl4, yl); unpack8(vc4, vc); unpack8(vp4, vp); unpack8(zz4, zz);
            float s1 = 0.f;
#pragma unroll
            for (int e = 0; e < 8; ++e) { y[e] += yl[e]; s1 += y[e]; }
            s1 = quad_sum(s1); s1 += __int_as_float(__builtin_amdgcn_update_dpp(0, __float_as_int(s1), 0x141, 0xF, 0xF, true));
            const float mean = s1 * (1.f / 64.f);
            float s2 = 0.f;
#pragma unroll
            for (int e = 0; e < 8; ++e) { y[e] -= mean; s2 += y[e] * y[e]; }
            s2 = quad_sum(s2); s2 += __int_as_float(__builtin_amdgcn_update_dpp(0, __float_as_int(s2), 0x141, 0xF, 0xF, true));
            const float rstd = rsqrtf(s2 * (1.f / 64.f) + 64e-5f);
            float o[8];
#pragma unroll
            for (int e = 0; e < 8; ++e) { const float vmix = vc[e] + (vp[e] - vc[e]) * mu[e]; o[e] = (y[e] * rstd * lg[e] + lb[e] + bon * vmix) * siluf_(zz[e]); }
            *(uint4*)yrow = pack8f(o);
        }
    }
}

DI void phase_swa_simple(const Params& p, unsigned char* lds, const int bid, const int nb) {
    const bf16_t* P = (const bf16_t*)(p.ws + OFF_P); bf16_t* YB = (bf16_t*)(p.ws + OFF_YB);
    const long total = (long)BATCH * 8 * T;
    for (long it = (long)bid * NTHREADS + threadIdx.x; it < total; it += (long)nb * NTHREADS) {
        const int t = (int)(it % T), qh = (int)((it / T) % 8), b = (int)(it / ((long)T * 8)), kvh = qh >> 2;
        const size_t row = (size_t)(b * T + t);
        float q[64], acc[64];
        {
            const uint4* qp = (const uint4*)(P + row * NP + C_Q + qh * 64);
#pragma unroll
            for (int i = 0; i < 8; ++i) { const uint4 u = qp[i]; const unsigned w[4] = {u.x, u.y, u.z, u.w};
#pragma unroll
                for (int j = 0; j < 4; ++j) { q[i * 8 + j * 2] = __uint_as_float(w[j] << 16); q[i * 8 + j * 2 + 1] = __uint_as_float(w[j] & 0xffff0000u); } }
        }
#pragma unroll
        for (int d = 0; d < 64; ++d) acc[d] = 0.f;
        float m = p.sinks[qh], l = 1.f;
        for (int j = 0; j < 128; ++j) {
            const int s = t - 127 + j;
            if (s < 0) continue;
            const size_t krow = (size_t)(b * T + s) * NP;
            const uint4* kp = (const uint4*)(P + krow + C_SK + kvh * 64);
            float dot = 0.f;
#pragma unroll
            for (int i = 0; i < 8; ++i) { const uint4 u = kp[i]; const unsigned w[4] = {u.x, u.y, u.z, u.w};
#pragma unroll
                for (int jj = 0; jj < 4; ++jj) { dot += q[i * 8 + jj * 2] * __uint_as_float(w[jj] << 16) + q[i * 8 + jj * 2 + 1] * __uint_as_float(w[jj] & 0xffff0000u); } }
            const float sc = dot * 0.125f;
            const float mn = fmaxf(m, sc), corr = __expf(m - mn), pe = __expf(sc - mn);
            l = l * corr + pe; m = mn;
            const uint4* vp = (const uint4*)(P + krow + C_SV + kvh * 64);
#pragma unroll
            for (int i = 0; i < 8; ++i) { const uint4 u = vp[i]; const unsigned w[4] = {u.x, u.y, u.z, u.w};
#pragma unroll
                for (int jj = 0; jj < 4; ++jj) { acc[i * 8 + jj * 2] = acc[i * 8 + jj * 2] * corr + pe * __uint_as_float(w[jj] << 16);
                                                 acc[i * 8 + jj * 2 + 1] = acc[i * 8 + jj * 2 + 1] * corr + pe * __uint_as_float(w[jj] & 0xffff0000u); } }
        }
        const float inv = 1.f / l;
        const bf16_t* zp = P + row * NP + C_ZB + qh * 64; bf16_t* op = YB + row * 512 + qh * 64;
#pragma unroll
        for (int d = 0; d < 64; ++d) op[d] = f2bf(acc[d] * inv * siluf_(bf2f(zp[d])));
    }
}

DI void phase_xattn_simple(const Params& p, unsigned char* lds, const int bid, const int nb) {
    const bf16_t* P = (const bf16_t*)(p.ws + OFF_P); const bf16_t* KVM = (const bf16_t*)(p.ws + OFF_KVM); bf16_t* YC = (bf16_t*)(p.ws + OFF_YC);
    const int lane = threadIdx.x & 63, wid = threadIdx.x >> 6;
    const long total = (long)M * 4;
    const float scale = 0.08838834764831845f;
    for (long it = (long)bid * NWAVES + wid; it < total; it += (long)nb * NWAVES) {
        const int row = (int)(it >> 2), hd = (int)(it & 3), b = row / T;
        const bf16_t* qp = P + (size_t)row * NP + C_XQ + hd * 128;
        const bf16_t* kb = KVM + (size_t)(b * MEMLEN) * 1024 + hd * 128;
        float s[4] = {0.f, 0.f, 0.f, 0.f};
        for (int c = 0; c < 16; ++c) {
            const uint4 qu = *(const uint4*)(qp + c * 8); const unsigned qw[4] = {qu.x, qu.y, qu.z, qu.w};
#pragma unroll
            for (int i = 0; i < 4; ++i) {
                const uint4 ku = *(const uint4*)(kb + (size_t)(lane + 64 * i) * 1024 + c * 8); const unsigned kw[4] = {ku.x, ku.y, ku.z, ku.w};
#pragma unroll
                for (int j = 0; j < 4; ++j) s[i] += __uint_as_float(qw[j] << 16) * __uint_as_float(kw[j] << 16) + __uint_as_float(qw[j] & 0xffff0000u) * __uint_as_float(kw[j] & 0xffff0000u);
            }
        }
        float mx = -1e30f;
#pragma unroll
        for (int i = 0; i < 4; ++i) { s[i] *= scale; mx = fmaxf(mx, s[i]); }
        mx = wave_max(mx);
        float pe[4], sum = 0.f;
#pragma unroll
        for (int i = 0; i < 4; ++i) { pe[i] = __expf(s[i] - mx); sum += pe[i]; }
        sum = wave_sum(sum);
        const float inv = 1.f / sum;
        float o0 = 0.f, o1 = 0.f;
        const bf16_t* vb = kb + 512;
#pragma unroll
        for (int i = 0; i < 4; ++i)
            for (int mm = 0; mm < 64; ++mm) {
                const float pv = __shfl(pe[i], mm, 64);
                const bf16_t* vr = vb + (size_t)(mm + 64 * i) * 1024;
                o0 += pv * bf2f(vr[lane]); o1 += pv * bf2f(vr[lane + 64]);
            }
        const bf16_t* zp = P + (size_t)row * NP + C_ZC + hd * 128; bf16_t* op = YC + (size_t)row * 512 + hd * 128;
        op[lane] = f2bf(o0 * inv * siluf_(bf2f(zp[lane]))); op[lane + 64] = f2bf(o1 * inv * siluf_(bf2f(zp[lane + 64])));
    }
}

typedef short s16x4 __attribute__((ext_vector_type(4)));
DI int crow(int reg, int hh) { return (reg & 3) + 8 * (reg >> 2) + 4 * hh; }
template <int Dh> DI unsigned k_off(int row, int chunk) { return (unsigned)(row * (Dh * 2) + ((chunk ^ (row & (Dh / 8 - 1))) << 4)); }
DI bf16x8 pack8(const f32x16& x, int s) {
    bf16x8 r;
#pragma unroll
    for (int e = 0; e < 8; ++e) r[e] = (short)f2bf(x[8 * s + e]);
    return r;
}
constexpr int VS = 528;

DI void swa_unit(const Params& p, unsigned char* lds, int unit) {
    const bf16_t* P = (const bf16_t*)(p.ws + OFF_P); bf16_t* YB = (bf16_t*)(p.ws + OFF_YB);
    int tid = threadIdx.x; asm volatile("" : "+v"(tid));
    const int lane = tid & 63, wid = __builtin_amdgcn_readfirstlane(tid >> 6), c = lane & 31, hh = lane >> 5;
    const int n = unit & 63, kvh = (unit >> 6) & 1, b = unit >> 7;
    unsigned char* Kl = lds; unsigned char* Vt = lds + 32768;
    __syncthreads();
#pragma unroll
    for (int u = 0; u < 4; ++u) {
        const int idx = tid + 512 * u;
        { const int row = idx >> 3, chunk = idx & 7, t = n * 128 - 128 + row, tc = t < 0 ? 0 : t;
          const uint4 v = *(const uint4*)(P + (size_t)(b * T + tc) * NP + C_SK + kvh * 64 + chunk * 8);
          float x[8]; unpack8(v, x);
          float ss = 0.f;
#pragma unroll
          for (int e = 0; e < 8; ++e) ss += x[e] * x[e];
          ss = quad_sum(ss); ss += __int_as_float(__builtin_amdgcn_update_dpp(0, __float_as_int(ss), 0x141, 0xF, 0xF, true));
          const float rs = rsqrtf(ss * (1.f / 64.f) + 1e-6f);
          const float2* rp = (const float2*)(p.ws + OFF_ROPE) + (size_t)(b * T + tc) * 32 + (chunk & 3) * 8;
          float o[8];
#pragma unroll
          for (int e = 0; e < 8; ++e) { const float y = x[e] * rs * p.k_norm_g[chunk * 8 + e]; const float yp = lane_xor4(y); const float2 cs = rp[e];
              o[e] = chunk < 4 ? y * cs.x - yp * cs.y : y * cs.x + yp * cs.y; if (t < 0) o[e] = 0.f; }
          *(uint4*)(Kl + k_off<64>(row, chunk)) = pack8f(o); }
        { const int row = idx >> 3, chunk = idx & 7, t = n * 128 - 128 + row;
          uint4 v = make_uint4(0u, 0u, 0u, 0u);
          if (t >= 0) v = *(const uint4*)(P + (size_t)(b * T + t) * NP + C_SV + kvh * 64 + chunk * 8);
          *(uint4*)(Vt + k_off<64>(row, chunk)) = v; }
    }
    const int qh = kvh * 4 + (wid >> 1), rh = wid & 1;
    const float sink = p.sinks[qh];
    bf16x8 qfa[2][4];
#pragma unroll
    for (int rt = 0; rt < 2; ++rt) {
        const size_t qrow = (size_t)(b * T + n * 128 + 64 * rh + 32 * rt + c);
        bf16x8 qf[4];
        {
            float xq[4][8]; float ss = 0.f;
#pragma unroll
            for (int ds = 0; ds < 4; ++ds) { unpack8(*(const uint4*)(P + qrow * NP + C_Q + qh * 64 + 16 * ds + 8 * hh), xq[ds]);
#pragma unroll
                for (int e = 0; e < 8; ++e) ss += xq[ds][e] * xq[ds][e]; }
            ss = xhalf_sum(ss);
            const float rs = rsqrtf(ss * (1.f / 64.f) + 1e-6f);
#pragma unroll
            for (int ds = 0; ds < 4; ++ds)
#pragma unroll
                for (int e = 0; e < 8; ++e) xq[ds][e] *= rs * p.q_norm_g[16 * ds + 8 * hh + e];
            const float2* rp = (const float2*)(p.ws + OFF_ROPE) + qrow * 32 + 8 * hh;
#pragma unroll
            for (int ds = 0; ds < 2; ++ds) { float lo[8], hi[8];
#pragma unroll
                for (int e = 0; e < 8; ++e) { const float2 cs = rp[16 * ds + e]; lo[e] = xq[ds][e] * cs.x - xq[ds + 2][e] * cs.y; hi[e] = xq[ds + 2][e] * cs.x + xq[ds][e] * cs.y; }
                qf[ds] = __builtin_bit_cast(bf16x8, pack8f(lo)); qf[ds + 2] = __builtin_bit_cast(bf16x8, pack8f(hi)); }
        }
#pragma unroll
        for (int ds = 0; ds < 4; ++ds) qfa[rt][ds] = qf[ds];
    }
    __syncthreads();
#pragma unroll 2
    for (int rt = 0; rt < 2; ++rt) {
        const int base = 64 * rh + 32 * rt;
        bf16x8 qf[4];
#pragma unroll
        for (int ds = 0; ds < 4; ++ds) qf[ds] = qfa[rt][ds];
        f32x16 st[5];
#pragma unroll
        for (int kt = 0; kt < 5; ++kt) {
#pragma unroll
            for (int i = 0; i < 16; ++i) st[kt][i] = 0.f;
#pragma unroll
            for (int ds = 0; ds < 4; ++ds) { const bf16x8 a = *(const bf16x8*)(Kl + k_off<64>(base + 32 * kt + c, 2 * ds + hh)); st[kt] = MFMA32(a, qf[ds], st[kt]); }
        }
        float mr = -1e30f;
#pragma unroll
        for (int kt = 0; kt < 5; ++kt)
#pragma unroll
            for (int i = 0; i < 16; ++i) {
                const int cr = crow(i, hh);
                bool ok = true;
                if (kt == 0) ok = cr > c;
                if (kt == 4) ok = cr <= c;
                if (n == 0) ok = ok && (base + 32 * kt + cr >= 128);
                const float s = ok ? st[kt][i] : -1e30f;
                st[kt][i] = s; mr = fmaxf(mr, s);
            }
        mr = xhalf_max(mr);
        const float mx = fmaxf(sink, mr * 0.125f);
        const float c1 = 0.125f * 1.44269504089f, c0 = -mx * 1.44269504089f;
        float ls = 0.f;
#pragma unroll
        for (int kt = 0; kt < 5; ++kt)
#pragma unroll
            for (int i = 0; i < 16; ++i) { const float pe = __builtin_amdgcn_exp2f(fmaf(st[kt][i], c1, c0)); st[kt][i] = pe; ls += pe; }
        ls = xhalf_sum(ls);
        const float inv = __builtin_amdgcn_rcpf(ls + __expf(sink - mx));
        f32x16 ot[2];
#pragma unroll
        for (int dt = 0; dt < 2; ++dt)
#pragma unroll
            for (int i = 0; i < 16; ++i) ot[dt][i] = 0.f;
#pragma unroll
        for (int kt = 0; kt < 5; ++kt)
#pragma unroll
            for (int s = 0; s < 2; ++s) {
                const bf16x8 pf = pack8(st[kt], s);
#pragma unroll
                for (int dt = 0; dt < 2; ++dt) {
                    const int key0 = base + 32 * kt + 16 * s + 4 * hh + ((lane & 15) >> 2), ch16 = 4 * dt + 2 * ((lane >> 4) & 1) + ((lane & 3) >> 1), sub = (lane & 1) * 8;
                    const s16x4 lo = __builtin_amdgcn_ds_read_tr16_b64_v4i16((LAS s16x4*)(Vt + k_off<64>(key0, ch16) + sub));
                    const s16x4 hi = __builtin_amdgcn_ds_read_tr16_b64_v4i16((LAS s16x4*)(Vt + k_off<64>(key0 + 8, ch16) + sub));
                    const bf16x8 vf = __builtin_shufflevector(lo, hi, 0, 1, 2, 3, 4, 5, 6, 7);
                    ot[dt] = MFMA32(vf, pf, ot[dt]);
                }
            }
        LAS float* ob = (LAS float*)(LASP(lds) + 65536 + wid * 8704);
#pragma unroll
        for (int dt = 0; dt < 2; ++dt)
#pragma unroll
            for (int gq = 0; gq < 4; ++gq) *(volatile LAS f32x4*)(ob + c * 68 + 32 * dt + 8 * gq + 4 * hh) = (f32x4){ot[dt][4 * gq] * inv, ot[dt][4 * gq + 1] * inv, ot[dt][4 * gq + 2] * inv, ot[dt][4 * gq + 3] * inv};
        uint4 zz4_[4];
#pragma unroll
        for (int it = 0; it < 4; ++it) zz4_[it] = *(const uint4*)(P + (size_t)(b * T + n * 128 + base + 8 * it + (lane >> 3)) * NP + C_ZB + qh * 64 + 8 * (lane & 7));
#pragma unroll
        for (int it = 0; it < 4; ++it) {
            const int tok = 8 * it + (lane >> 3), j8 = lane & 7;
            const size_t qr = (size_t)(b * T + n * 128 + base + tok);
            const uint4 zz4 = zz4_[it];
            const f32x4 oa = *(const volatile LAS f32x4*)(ob + tok * 68 + 8 * j8), ob4 = *(const volatile LAS f32x4*)(ob + tok * 68 + 8 * j8 + 4);
            float zz[8]; unpack8(zz4, zz);
            const float o[8] = {oa[0] * siluf_(zz[0]), oa[1] * siluf_(zz[1]), oa[2] * siluf_(zz[2]), oa[3] * siluf_(zz[3]), ob4[0] * siluf_(zz[4]), ob4[1] * siluf_(zz[5]), ob4[2] * siluf_(zz[6]), ob4[3] * siluf_(zz[7])};
            *(uint4*)(YB + qr * 512 + qh * 64 + 8 * j8) = pack8f(o);
        }
    }
}

DI void xattn_unit(const Params& p, unsigned char* lds, int unit) {
    const bf16_t* P = (const bf16_t*)(p.ws + OFF_P); const bf16_t* KVM = (const bf16_t*)(p.ws + OFF_KVM); bf16_t* YC = (bf16_t*)(p.ws + OFF_YC);
    int tid = threadIdx.x; asm volatile("" : "+v"(tid));
    const int lane = tid & 63, wid = __builtin_amdgcn_readfirstlane(tid >> 6), c = lane & 31, hh = lane >> 5;
    const int qb = unit & 31, hd = (unit >> 5) & 3, b = unit >> 7;
    unsigned char* Kl = lds; unsigned char* Vt = lds + 65536;
    const bf16_t* kb = KVM + (size_t)(b * MEMLEN) * 1024 + hd * 128;
    __syncthreads();
#pragma unroll
    for (int u = 0; u < 8; ++u) {
        const int blk = u * 8 + wid, row = 4 * blk + (lane >> 4), chunk = (lane & 15) ^ (row & 15);
        __builtin_amdgcn_global_load_lds((const unsigned*)(kb + (size_t)row * 1024 + chunk * 8), (LAS unsigned*)(LASP(Kl) + blk * 1024), 16, 0, 0);
        __builtin_amdgcn_global_load_lds((const unsigned*)(kb + (size_t)row * 1024 + 512 + chunk * 8), (LAS unsigned*)(LASP(Vt) + blk * 1024), 16, 0, 0);
    }
    const size_t qrow = (size_t)(b * T + qb * 256 + wid * 32 + c);
    uint4 raw[8];
#pragma unroll
    for (int ds = 0; ds < 8; ++ds) raw[ds] = *(const uint4*)(P + qrow * NP + C_XQ + hd * 128 + 16 * ds + 8 * hh);
    asm volatile("s_waitcnt vmcnt(0)" ::: "memory");
    __syncthreads();
    const float scale = 0.08838834764831845f;
    bf16x8 qf[8];
    {
        float ss = 0.f;
#pragma unroll
        for (int ds = 0; ds < 8; ++ds) { float x[8]; unpack8(raw[ds], x);
#pragma unroll
            for (int e = 0; e < 8; ++e) ss += x[e] * x[e]; }
        ss = xhalf_sum(ss);
        const float rs = rsqrtf(ss * (1.f / 128.f) + 1e-6f);
#pragma unroll
        for (int ds = 0; ds < 8; ++ds) { float x[8]; unpack8(raw[ds], x);
#pragma unroll
            for (int e = 0; e < 8; ++e) x[e] *= rs * p.xq_norm_g[16 * ds + 8 * hh + e];
            qf[ds] = __builtin_bit_cast(bf16x8, pack8f(x)); }
    }
    f32x16 ot[4];
#pragma unroll
    for (int dt = 0; dt < 4; ++dt)
#pragma unroll
        for (int i = 0; i < 16; ++i) ot[dt][i] = 0.f;
    float mrun = -1e30f, lrun = 0.f;
#pragma unroll 1
    for (int half = 0; half < 2; ++half) {
        f32x16 st[4];
#pragma unroll
        for (int kt = 0; kt < 4; ++kt) {
#pragma unroll
            for (int i = 0; i < 16; ++i) st[kt][i] = 0.f;
#pragma unroll
            for (int ds = 0; ds < 8; ++ds) { const bf16x8 a = *(const bf16x8*)(Kl + k_off<128>(128 * half + 32 * kt + c, 2 * ds + hh)); st[kt] = MFMA32(a, qf[ds], st[kt]); }
        }
        float mr = -1e30f;
#pragma unroll
        for (int kt = 0; kt < 4; ++kt)
#pragma unroll
            for (int i = 0; i < 16; ++i) mr = fmaxf(mr, st[kt][i]);
        mr = xhalf_max(mr);
        const float mx = fmaxf(mrun, mr * scale);
        const float corr = __expf(mrun - mx);
        const float c1 = scale * 1.44269504089f, c0 = -mx * 1.44269504089f;
        float ls = 0.f;
#pragma unroll
        for (int kt = 0; kt < 4; ++kt)
#pragma unroll
            for (int i = 0; i < 16; ++i) { const float pe = __builtin_amdgcn_exp2f(fmaf(st[kt][i], c1, c0)); st[kt][i] = pe; ls += pe; }
        ls = xhalf_sum(ls);
        lrun = lrun * corr + ls; mrun = mx;
#pragma unroll
        for (int dt = 0; dt < 4; ++dt)
#pragma unroll
            for (int i = 0; i < 16; ++i) ot[dt][i] *= corr;
#pragma unroll
        for (int kt = 0; kt < 4; ++kt)
#pragma unroll
            for (int s = 0; s < 2; ++s) {
                const bf16x8 pf = pack8(st[kt], s);
#pragma unroll
                for (int dt = 0; dt < 4; ++dt) {
                    const int key0 = 128 * half + 32 * kt + 16 * s + 4 * hh + ((lane & 15) >> 2), ch16 = 4 * dt + 2 * ((lane >> 4) & 1) + ((lane & 3) >> 1), sub = (lane & 1) * 8;
                    const s16x4 lo = __builtin_amdgcn_ds_read_tr16_b64_v4i16((LAS s16x4*)(Vt + k_off<128>(key0, ch16) + sub));
                    const s16x4 hi = __builtin_amdgcn_ds_read_tr16_b64_v4i16((LAS s16x4*)(Vt + k_off<128>(key0 + 8, ch16) + sub));
                    const bf16x8 vf = __builtin_shufflevector(lo, hi, 0, 1, 2, 3, 4, 5, 6, 7);
                    ot[dt] = MFMA32(vf, pf, ot[dt]);
                }
            }
    }
    const float inv = __builtin_amdgcn_rcpf(lrun);
    __syncthreads();
    float* ob = (float*)lds + wid * (32 * 132);
#pragma unroll
    for (int dt = 0; dt < 4; ++dt)
#pragma unroll
        for (int gq = 0; gq < 4; ++gq) *(f32x4*)(ob + c * 132 + 32 * dt + 8 * gq + 4 * hh) = (f32x4){ot[dt][4 * gq] * inv, ot[dt][4 * gq + 1] * inv, ot[dt][4 * gq + 2] * inv, ot[dt][4 * gq + 3] * inv};
    asm volatile("s_waitcnt lgkmcnt(0)" ::: "memory");
    uint4 zz4_[8];
#pragma unroll
    for (int it = 0; it < 8; ++it) zz4_[it] = *(const uint4*)(P + (size_t)(b * T + qb * 256 + wid * 32 + 4 * it + (lane >> 4)) * NP + C_ZC + hd * 128 + 8 * (lane & 15));
#pragma unroll
    for (int it = 0; it < 8; ++it) {
        const int tok = 4 * it + (lane >> 4), j16 = lane & 15;
        const size_t qr = (size_t)(b * T + qb * 256 + wid * 32 + tok);
        const uint4 zz4 = zz4_[it];
        const f32x4 oa = *(const f32x4*)(ob + tok * 132 + 8 * j16), ob4 = *(const f32x4*)(ob + tok * 132 + 8 * j16 + 4);
        float zz[8]; unpack8(zz4, zz);
        const float o[8] = {oa[0] * siluf_(zz[0]), oa[1] * siluf_(zz[1]), oa[2] * siluf_(zz[2]), oa[3] * siluf_(zz[3]), ob4[0] * siluf_(zz[4]), ob4[1] * siluf_(zz[5]), ob4[2] * siluf_(zz[6]), ob4[3] * siluf_(zz[7])};
        *(uint4*)(YC + qr * 512 + hd * 128 + 8 * j16) = pack8f(o);
    }
}
DI void phase_attn_queue(const Params& p, unsigned char* lds) {
    unsigned* head = (unsigned*)(p.ws + OFF_CTL + 32768);
    volatile LAS unsigned* bc = (volatile LAS unsigned*)(lds + LDS_CTL_OFF + 128);
    for (;;) {
        __syncthreads();
        if (threadIdx.x == 0) bc[0] = __hip_atomic_fetch_add(head, 1u, __ATOMIC_RELAXED, __HIP_MEMORY_SCOPE_AGENT);
        __syncthreads();
        const unsigned u = bc[0];
        if (u >= 1024u) break;
#if STAMP_PH >= 60
        unsigned* qst = (unsigned*)(p.ws + OFF_CTL + 40000); const bool qme = (blockIdx.x == gridDim.x - 1 && threadIdx.x == 0);
        unsigned qt0 = (unsigned)__builtin_amdgcn_s_memrealtime();
#define QACC(k_) do { __syncthreads(); if (qme) { qst[2 * (k_)] += (unsigned)__builtin_amdgcn_s_memrealtime() - qt0; qst[2 * (k_) + 1] += 1u; } } while (0)
#else
#define QACC(k_) do { } while (0)
#endif
        if (u < 512u) { if (u & 1u) { xattn_unit(p, lds, (int)(u >> 1)); QACC(1); } else { swa_unit(p, lds, (int)(u >> 1)); QACC(0); } }
        else {
            const int item = (int)u - 512, bh = item >> 5;
            if (threadIdx.x == 0) {
                unsigned* flag = (unsigned*)(p.ws + OFF_CTL + 32768 + 256) + bh; unsigned sp = 0;
                while (__hip_atomic_load(flag, __ATOMIC_RELAXED, __HIP_MEMORY_SCOPE_AGENT) == 0u) { __builtin_amdgcn_s_sleep(8); if (++sp > (1u << 22)) break; }
                __builtin_amdgcn_fence(__ATOMIC_ACQUIRE, "agent");
                asm volatile("s_waitcnt vmcnt(0)" ::: "memory");
            }
            __syncthreads();
#if STAMP_PH >= 60
            if (qme) { qst[8] += (unsigned)__builtin_amdgcn_s_memrealtime() - qt0; } qt0 = (unsigned)__builtin_amdgcn_s_memrealtime();
#endif
            rwkv_out_item(p, lds, item);
            QACC(3);
        }
    }
}

namespace pg8 {
#define PG8_LAS __attribute__((address_space(3)))
typedef unsigned short bf16_t;
typedef short bf16x8 __attribute__((ext_vector_type(8)));
typedef float f32x4 __attribute__((ext_vector_type(4)));
typedef unsigned u32x4 __attribute__((ext_vector_type(4)));
constexpr int BM = 256, BK = 64, HALF = 128, HTB = HALF * BK * 2  , STAGE_BYTES = 8 * HTB, NXCD = 8, WGM = 8;

__host__ __device__ __forceinline__ int lds_byte(int r, int c) { const int st = (r >> 4) * 2 + (c >> 5), rr = r & 15, cc = c & 31, ob = rr * 64 + cc * 2; return st * 1024 + (ob ^ (((ob >> 9) & 1) << 5)); }
__host__ __device__ __forceinline__ void stage_rc(int b, int& R, int& C) { const int st = b / 1024, sb = b % 1024, swz = sb ^ (((sb >> 9) & 1) << 5); R = (st >> 1) * 16 + swz / 64; C = (st & 1) * 32 + (swz % 64) / 2; }
__host__ __device__ __forceinline__ int perm32(int rho) { const int n = rho >> 4, i = rho & 15; return 8 * (i >> 2) + 4 * n + (i & 3); }

struct Unit { int pm, pn; };
struct Gemm { const bf16_t* A; const bf16_t* Bt; int M, N, K; };

struct StaticOrder {
    int nM, nN, nwg, G, c;
    __host__ __device__ void init(int M, int N, int G_, int c_) { nM = M / BM; nN = N / BM; nwg = nM * nN; G = G_; c = c_; }
    __host__ __device__ bool next(int i, Unit& u) const {
        const long L = (long)i * G + c; if (L >= nwg) return false;
        int wgid = (int)L; { const int q = nwg / NXCD, r = nwg % NXCD, xcd = wgid % NXCD, off = wgid / NXCD; wgid = (xcd < r ? xcd * (q + 1) : r * (q + 1) + (xcd - r) * q) + off; }
        const int nig = WGM * nN, gid = wgid / nig, fm = gid * WGM, gsz = (nM - fm) < WGM ? (nM - fm) : WGM;
        u.pm = fm + ((wgid % nig) % gsz); u.pn = (wgid % nig) / gsz; return true;
    }
    __device__ __forceinline__ void a_ready(const Unit&) const {}
    __device__ __forceinline__ void done(const Unit&) const {}
};
__device__ __forceinline__ unsigned cvt_pk_bf16(float lo, float hi) { typedef float f2_ __attribute__((ext_vector_type(2))); typedef __bf16 b2_ __attribute__((ext_vector_type(2))); return __builtin_bit_cast(unsigned, __builtin_convertvector((f2_){lo, hi}, b2_)); }
typedef float f32x2 __attribute__((ext_vector_type(2)));
template <class Epi, class Sched, bool ALIGN_EPI = false, bool SP2 = false>
__device__ __forceinline__ void gemm_phase(PG8_LAS unsigned char* lds, const Gemm g, const Sched& S, const Epi& E) {
    int tid = threadIdx.x; asm volatile("" : "+v"(tid));
    const int wid = __builtin_amdgcn_readfirstlane(tid >> 6), lane = tid & 63, wr = wid >> 2, wc = wid & 3, fr = lane & 15, fq = lane >> 4;
    const int K = g.K, nt = K / BK;
    unsigned voffA[2], voffB[2];
#pragma unroll
    for (int i = 0; i < 2; ++i) { int R, C; stage_rc(tid * 16 + i * 8192, R, C); const int Rb = Epi::PERM ? ((R & ~31) + perm32(R & 31)) : R;
        voffA[i] = (unsigned)(R * K + C) * 2u; voffB[i] = (unsigned)(Rb * K + C) * 2u; }
    const size_t kstep = (size_t)(BK * 2);
    const size_t hstep = (size_t)HALF * K * 2;
    const size_t tstep = 2 * hstep;
    const unsigned ldsw = (unsigned)wid * 1024u;
    const int aoff = lds_byte(wr * 64 + fr, fq * 8), boff = lds_byte(wc * 32 + fr, fq * 8);
#define PG8_SA(b, h) (((b) * 2 + (h)) * HTB)
#define PG8_SB(b, h) ((4 + (b) * 2 + (h)) * HTB)
#define PG8_STAGE(bufoff, gbase, voff) do { _Pragma("unroll") for (int _i = 0; _i < 2; ++_i) \
        __builtin_amdgcn_global_load_lds((const unsigned*)((const char*)(gbase) + (voff)[_i]), (PG8_LAS unsigned*)(lds + (bufoff) + ldsw + _i * 8192), 16, 0, 0); } while (0)
#define PG8_LDA(dst, b, h) do { _Pragma("unroll") for (int m = 0; m < 4; ++m) _Pragma("unroll") for (int k = 0; k < 2; ++k) dst[m][k] = *(const PG8_LAS bf16x8*)(lds + PG8_SA(b, h) + aoff + m * 2048 + k * 1024); } while (0)
#define PG8_LDB(dst, b, h) do { _Pragma("unroll") for (int n = 0; n < 2; ++n) _Pragma("unroll") for (int k = 0; k < 2; ++k) dst[n][k] = *(const PG8_LAS bf16x8*)(lds + PG8_SB(b, h) + boff + n * 2048 + k * 1024); } while (0)
#define PG8_MMA(ai, bj, At, Bt) do { __builtin_amdgcn_s_setprio(1); _Pragma("unroll") for (int m = 0; m < 4; ++m) _Pragma("unroll") for (int n = 0; n < 2; ++n) _Pragma("unroll") for (int k = 0; k < 2; ++k) \
        acc[ai][bj][m][n] = __builtin_amdgcn_mfma_f32_16x16x32_bf16(Bt[n][k], At[m][k], acc[ai][bj][m][n], 0, 0, 0); __builtin_amdgcn_s_setprio(0); } while (0)
#define PG8_WAIT_V(n) asm volatile("s_waitcnt vmcnt(" #n ")" ::: "memory")
#define PG8_WAIT_L(n) asm volatile("s_waitcnt lgkmcnt(" #n ")" ::: "memory")
#define PG8_BAR __builtin_amdgcn_s_barrier()
#define PG8_SCHED __builtin_amdgcn_sched_barrier(0)
    Unit cur, nxt; int ui = 0;
    if (!S.next(0, cur)) return;
    f32x4 acc[2][2][4][2];
#pragma unroll
    for (int a = 0; a < 2; ++a)
#pragma unroll
        for (int b = 0; b < 2; ++b)
#pragma unroll
            for (int m = 0; m < 4; ++m)
#pragma unroll
                for (int n = 0; n < 2; ++n) acc[a][b][m][n] = (f32x4){0.f, 0.f, 0.f, 0.f};
    bf16x8 At[4][2], B0[2][2], B1[2][2];
    const char* cA = (const char*)g.A + (size_t)cur.pm * tstep; const char* cB = (const char*)g.Bt + (size_t)cur.pn * tstep;
    S.a_ready(cur);
    if constexpr (SP2) {
        PG8_STAGE(PG8_SB(0, 0), cB, voffB); PG8_STAGE(PG8_SB(0, 1), cB + hstep, voffB); PG8_STAGE(PG8_SA(0, 0), cA, voffA); PG8_STAGE(PG8_SA(0, 1), cA + hstep, voffA);
        if (wr == 1) PG8_BAR;
        PG8_WAIT_V(2); PG8_BAR;
        PG8_STAGE(PG8_SB(1, 0), cB + kstep, voffB); PG8_STAGE(PG8_SA(1, 0), cA + kstep, voffA); PG8_STAGE(PG8_SB(1, 1), cB + hstep + kstep, voffB);
        PG8_WAIT_V(6); PG8_BAR;
    } else {
        PG8_STAGE(PG8_SB(0, 0), cB, voffB); PG8_STAGE(PG8_SA(0, 0), cA, voffA); PG8_STAGE(PG8_SB(0, 1), cB + hstep, voffB); PG8_STAGE(PG8_SA(0, 1), cA + hstep, voffA);
        if (wr == 1) PG8_BAR;
        PG8_WAIT_V(4); PG8_BAR;
        PG8_STAGE(PG8_SB(1, 0), cB + kstep, voffB); PG8_STAGE(PG8_SA(1, 0), cA + kstep, voffA); PG8_STAGE(PG8_SB(1, 1), cB + hstep + kstep, voffB);
        PG8_WAIT_V(6); PG8_BAR;
    }
    for (;;) {
        const bool has_next = S.next(ui + 1, nxt);
        const char* nA = has_next ? (const char*)g.A + (size_t)nxt.pm * tstep : cA; const char* nB = has_next ? (const char*)g.Bt + (size_t)nxt.pn * tstep : cB;
        for (int t = 0; t < nt; t += 2) {
            const bool last = (t == nt - 2);
            const char* a1 = cA + (size_t)(t + 1) * kstep;
            const char* a2 = last ? nA : cA + (size_t)(t + 2) * kstep; const char* b2 = last ? nB : cB + (size_t)(t + 2) * kstep;
            const char* a3 = a2 + kstep; const char* b3 = b2 + kstep;
            if (last && has_next) S.a_ready(nxt);
            if constexpr (SP2) {
            PG8_LDB(B0, 0, 0); PG8_LDB(B1, 0, 1); PG8_SCHED; PG8_LDA(At, 0, 0); PG8_STAGE(PG8_SA(1, 1), a1 + hstep, voffA);
            PG8_WAIT_V(8); PG8_WAIT_L(0); PG8_BAR; PG8_MMA(0, 0, At, B0); PG8_MMA(0, 1, At, B1); PG8_BAR; PG8_SCHED;
            PG8_LDA(At, 0, 1); PG8_STAGE(PG8_SB(0, 0), b2, voffB); PG8_STAGE(PG8_SB(0, 1), b2 + hstep, voffB); PG8_STAGE(PG8_SA(0, 0), a2, voffA);
            PG8_WAIT_V(8); PG8_WAIT_L(0); PG8_BAR; PG8_MMA(1, 0, At, B0); PG8_MMA(1, 1, At, B1); PG8_BAR; PG8_SCHED;
            PG8_LDB(B0, 1, 0); PG8_LDB(B1, 1, 1); PG8_SCHED; PG8_LDA(At, 1, 0); PG8_STAGE(PG8_SA(0, 1), a2 + hstep, voffA);
            PG8_WAIT_V(8); PG8_WAIT_L(0); PG8_BAR; PG8_MMA(0, 0, At, B0); PG8_MMA(0, 1, At, B1); PG8_BAR; PG8_SCHED;
            PG8_LDA(At, 1, 1); PG8_STAGE(PG8_SB(1, 0), b3, voffB); PG8_STAGE(PG8_SB(1, 1), b3 + hstep, voffB); PG8_STAGE(PG8_SA(1, 0), a3, voffA);
            PG8_WAIT_V(8); PG8_WAIT_L(0); PG8_BAR; PG8_MMA(1, 0, At, B0); PG8_MMA(1, 1, At, B1); PG8_BAR; PG8_SCHED;
            } else {
            PG8_LDB(B0, 0, 0); PG8_SCHED; PG8_LDA(At, 0, 0); PG8_STAGE(PG8_SA(1, 1), a1 + hstep, voffA);
            PG8_WAIT_L(8); PG8_BAR; PG8_WAIT_L(0); PG8_MMA(0, 0, At, B0); PG8_BAR; PG8_SCHED;
            PG8_LDB(B1, 0, 1); PG8_STAGE(PG8_SB(0, 0), b2, voffB);
            PG8_BAR; PG8_WAIT_L(0); PG8_MMA(0, 1, At, B1); PG8_BAR;
            PG8_LDA(At, 0, 1); PG8_STAGE(PG8_SA(0, 0), a2, voffA);
            PG8_BAR; PG8_WAIT_L(0); PG8_MMA(1, 0, At, B0); PG8_BAR; PG8_SCHED;
            PG8_STAGE(PG8_SB(0, 1), b2 + hstep, voffB);
            PG8_WAIT_V(6); PG8_BAR; PG8_MMA(1, 1, At, B1); PG8_BAR;
            PG8_LDB(B0, 1, 0); PG8_SCHED; PG8_LDA(At, 1, 0); PG8_STAGE(PG8_SA(0, 1), a2 + hstep, voffA);
            PG8_WAIT_L(8); PG8_BAR; PG8_WAIT_L(0); PG8_MMA(0, 0, At, B0); PG8_BAR; PG8_SCHED;
            PG8_LDB(B1, 1, 1); PG8_STAGE(PG8_SB(1, 0), b3, voffB);
            PG8_BAR; PG8_WAIT_L(0); PG8_MMA(0, 1, At, B1); PG8_BAR;
            PG8_LDA(At, 1, 1); PG8_STAGE(PG8_SA(1, 0), a3, voffA);
            PG8_BAR; PG8_WAIT_L(0); PG8_MMA(1, 0, At, B0); PG8_BAR; PG8_SCHED;
            PG8_STAGE(PG8_SB(1, 1), b3 + hstep, voffB);
            PG8_WAIT_V(6); PG8_BAR; PG8_MMA(1, 1, At, B1); PG8_BAR;
            }
        }
        if constexpr (ALIGN_EPI) { if (wr == 0) PG8_BAR; }
        if constexpr (!Epi::AFTER_DRAIN) { E(acc, cur, wr, wc, fr, fq); S.done(cur); }
        if (!has_next) break;
        if constexpr (!Epi::CHAIN) {
#pragma unroll
        for (int a = 0; a < 2; ++a)
#pragma unroll
            for (int b = 0; b < 2; ++b)
#pragma unroll
                for (int m = 0; m < 4; ++m)
#pragma unroll
                    for (int n = 0; n < 2; ++n) acc[a][b][m][n] = (f32x4){0.f, 0.f, 0.f, 0.f};
        }
        cur = nxt; cA = nA; cB = nB; ++ui;
        if constexpr (ALIGN_EPI) { if (wr == 1) PG8_BAR; }
    }
    PG8_WAIT_V(0);
    if constexpr (!ALIGN_EPI) { if (wr == 0) PG8_BAR; }
    PG8_BAR;
    if constexpr (Epi::AFTER_DRAIN) { E.fused(acc, cur, wr, wc, fr, fq, lds, wid, lane); S.done(cur); }
#undef PG8_SA
#undef PG8_SB
#undef PG8_STAGE
#undef PG8_LDA
#undef PG8_LDB
#undef PG8_MMA
#undef PG8_WAIT_V
#undef PG8_WAIT_L
#undef PG8_BAR
#undef PG8_SCHED
}
}

namespace pg8 {
__device__ __forceinline__ void store16_wt(void* ptr, u32x4 v) { asm volatile("global_store_dwordx4 %0, %1, off sc1\n\ts_nop 1" :: "v"(ptr), "v"(v) : "memory"); }
template <int ACT> struct EpiStore {
    static constexpr bool PERM = true, AFTER_DRAIN = false, CHAIN = false;
    bf16_t* O; int ldc;
    __device__ __forceinline__ void operator()(const f32x4 (&acc)[2][2][4][2], const Unit& u, int wr, int wc, int fr, int fq) const {
        const int row0 = u.pm * BM + wr * 64 + fr, col0 = u.pn * BM + wc * 32 + 8 * fq;
#pragma unroll
        for (int ai = 0; ai < 2; ++ai)
#pragma unroll
            for (int m = 0; m < 4; ++m) { bf16_t* rowp = O + (size_t)(row0 + ai * HALF + m * 16) * ldc + col0;
#pragma unroll
                for (int bj = 0; bj < 2; ++bj) { f32x4 v0 = acc[ai][bj][m][0], v1 = acc[ai][bj][m][1];
                    if (ACT == 1) {
#pragma unroll
                        for (int e = 0; e < 4; ++e) { v0[e] = __builtin_amdgcn_rcpf(1.f + __expf(-v0[e])); v1[e] = __builtin_amdgcn_rcpf(1.f + __expf(-v1[e])); } }
                    u32x4 w; w.x = cvt_pk_bf16(v0[0], v0[1]); w.y = cvt_pk_bf16(v0[2], v0[3]); w.z = cvt_pk_bf16(v1[0], v1[1]); w.w = cvt_pk_bf16(v1[2], v1[3]);
                    store16_wt(rowp + bj * HALF, w); } }
    }
};
template <bool ACCUM> struct EpiProj {
    static constexpr bool PERM = true, AFTER_DRAIN = false, CHAIN = false;
    bf16_t* MG; const bf16_t* SG; int gcol0;
    __device__ __forceinline__ void operator()(const f32x4 (&acc)[2][2][4][2], const Unit& u, int wr, int wc, int fr, int fq) const {
        const int row0 = u.pm * BM + wr * 64 + fr, col0 = u.pn * BM + wc * 32 + 8 * fq;
#pragma unroll
        for (int ai = 0; ai < 2; ++ai)
#pragma unroll
            for (int m = 0; m < 4; ++m) { const size_t row = (size_t)(row0 + ai * HALF + m * 16);
#pragma unroll
                for (int bj = 0; bj < 2; ++bj) {
                    const int col = col0 + bj * HALF;
                    const u32x4 gw = *(const u32x4*)(SG + row * 3072 + gcol0 + col);
                    u32x4 ow = (u32x4){0u, 0u, 0u, 0u};
                    if (ACCUM) ow = *(const u32x4*)(MG + row * 1024 + col);
                    float r[8];
#pragma unroll
                    for (int e = 0; e < 4; ++e) {
                        const float g0 = __uint_as_float(gw[e] << 16), g1 = __uint_as_float(gw[e] & 0xffff0000u);
                        const float a0 = e < 2 ? acc[ai][bj][m][0][2 * e] : acc[ai][bj][m][1][2 * e - 4], a1 = e < 2 ? acc[ai][bj][m][0][2 * e + 1] : acc[ai][bj][m][1][2 * e - 3];
                        r[2 * e] = g0 * a0; r[2 * e + 1] = g1 * a1;
                        if (ACCUM) { r[2 * e] += __uint_as_float(ow[e] << 16); r[2 * e + 1] += __uint_as_float(ow[e] & 0xffff0000u); }
                    }
                    u32x4 w; w.x = cvt_pk_bf16(r[0], r[1]); w.y = cvt_pk_bf16(r[2], r[3]); w.z = cvt_pk_bf16(r[4], r[5]); w.w = cvt_pk_bf16(r[6], r[7]);
                    *(u32x4*)(MG + row * 1024 + col) = w; } }
    }
};
struct ProjOrder {
    int pm, pn, valid;
    __host__ __device__ bool next(int i, Unit& u) const { if (!valid || i >= 3) return false; u.pm = i * 64 + pm; u.pn = i * 4 + pn; return true; }
    __device__ __forceinline__ void a_ready(const Unit&) const {}
    __device__ __forceinline__ void done(const Unit&) const {}
};
struct EpiProj3 {
    static constexpr bool PERM = true, AFTER_DRAIN = false, CHAIN = false;
    bf16_t* MG; const bf16_t* SG;
    __device__ __forceinline__ void operator()(const f32x4 (&acc)[2][2][4][2], const Unit& u, int wr, int wc, int fr, int fq) const {
        const int br = u.pm >> 6, pm = u.pm & 63, pn = u.pn & 3, gcol0 = br * 1024;
        const int row0 = pm * BM + wr * 64 + fr, col0 = pn * BM + wc * 32 + 8 * fq;
#pragma unroll
        for (int ai = 0; ai < 2; ++ai)
#pragma unroll
            for (int m = 0; m < 4; ++m) { const size_t row = (size_t)(row0 + ai * HALF + m * 16);
#pragma unroll
                for (int bj = 0; bj < 2; ++bj) {
                    const int col = col0 + bj * HALF;
                    const u32x4 gw = *(const u32x4*)(SG + row * 3072 + gcol0 + col);
                    u32x4 ow = (u32x4){0u, 0u, 0u, 0u};
                    if (br > 0) ow = *(const u32x4*)(MG + row * 1024 + col);
                    float r[8];
#pragma unroll
                    for (int e = 0; e < 4; ++e) {
                        const float g0 = __uint_as_float(gw[e] << 16), g1 = __uint_as_float(gw[e] & 0xffff0000u);
                        const float a0 = e < 2 ? acc[ai][bj][m][0][2 * e] : acc[ai][bj][m][1][2 * e - 4], a1 = e < 2 ? acc[ai][bj][m][0][2 * e + 1] : acc[ai][bj][m][1][2 * e - 3];
                        r[2 * e] = g0 * a0 + __uint_as_float(ow[e] << 16); r[2 * e + 1] = g1 * a1 + __uint_as_float(ow[e] & 0xffff0000u);
                    }
                    u32x4 w; w.x = cvt_pk_bf16(r[0], r[1]); w.y = cvt_pk_bf16(r[2], r[3]); w.z = cvt_pk_bf16(r[4], r[5]); w.w = cvt_pk_bf16(r[6], r[7]);
                    *(u32x4*)(MG + row * 1024 + col) = w; } }
    }
};
struct GateOrder {
    int pm, pn, valid;
    __host__ __device__ bool next(int i, Unit& u) const { if (!valid || i >= 3) return false; u.pm = pm; u.pn = (2 - i) * 4 + pn; return true; }
    __device__ __forceinline__ void a_ready(const Unit&) const {}
    __device__ __forceinline__ void done(const Unit&) const {}
};
struct EpiGateR {
    static constexpr bool PERM = true, AFTER_DRAIN = false, CHAIN = false;
    bf16_t* SG;
    __device__ __forceinline__ void operator()(const f32x4 (&acc)[2][2][4][2], const Unit& u, int wr, int wc, int fr, int fq) const {
        const int br = u.pn >> 2, pn = u.pn & 3;
        const int row0 = u.pm * BM + wr * 64 + fr, col0 = pn * BM + wc * 32 + 8 * fq;
#pragma unroll
        for (int ai = 0; ai < 2; ++ai)
#pragma unroll
        for (int mh = 0; mh < 4; ++mh) {
            u32x4 dA[1][2], dB[1][2];
            if (br < 2) {
#pragma unroll
                for (int m2 = 0; m2 < 1; ++m2)
#pragma unroll
                    for (int bj = 0; bj < 2; ++bj) { const bf16_t* rowp = SG + (size_t)(row0 + ai * HALF + (mh + m2) * 16) * 3072 + col0;
                        dA[m2][bj] = *(const u32x4*)(rowp + 2048 + bj * HALF); if (br == 0) dB[m2][bj] = *(const u32x4*)(rowp + 1024 + bj * HALF); }
            }
#pragma unroll
            for (int m2 = 0; m2 < 1; ++m2) { const int m = mh + m2; bf16_t* rowp = SG + (size_t)(row0 + ai * HALF + m * 16) * 3072 + col0;
#pragma unroll
                for (int bj = 0; bj < 2; ++bj) {
                    float s[8];
#pragma unroll
                    for (int e = 0; e < 4; ++e) { s[e] = 1.f + __expf(-acc[ai][bj][m][0][e]); s[4 + e] = 1.f + __expf(-acc[ai][bj][m][1][e]); }
                    if (br < 2) {
                        const u32x4 d = dA[m2][bj];
                        float den[8];
#pragma unroll
                        for (int e = 0; e < 4; ++e) { den[2 * e] = __uint_as_float(d[e] << 16); den[2 * e + 1] = __uint_as_float(d[e] & 0xffff0000u); }
                        if (br == 0) { const u32x4 d1 = dB[m2][bj];
#pragma unroll
                            for (int e = 0; e < 4; ++e) { den[2 * e] *= __uint_as_float(d1[e] << 16); den[2 * e + 1] *= __uint_as_float(d1[e] & 0xffff0000u); } }
#pragma unroll
                        for (int e = 0; e < 8; ++e) s[e] *= den[e];
                    }
#pragma unroll
                    for (int e = 0; e < 8; ++e) s[e] = __builtin_amdgcn_rcpf(s[e]);
                    u32x4 w; w.x = cvt_pk_bf16(s[0], s[1]); w.y = cvt_pk_bf16(s[2], s[3]); w.z = cvt_pk_bf16(s[4], s[5]); w.w = cvt_pk_bf16(s[6], s[7]);
                    *(u32x4*)(rowp + br * 1024 + bj * HALF) = w; } }
        }
    }
};
struct EpiProjChain {
    static constexpr bool PERM = true, AFTER_DRAIN = false, CHAIN = true;
    bf16_t* MG; const bf16_t* SG;
    __device__ __forceinline__ void operator()(f32x4 (&acc)[2][2][4][2], const Unit& u, int wr, int wc, int fr, int fq) const {
        const int br = u.pm >> 6, pm = u.pm & 63, pn = u.pn & 3;
        const int row0 = pm * BM + wr * 64 + fr, col0 = pn * BM + wc * 32 + 8 * fq;
#pragma unroll
        for (int ai = 0; ai < 2; ++ai) {
          u32x4 gA[4][2];
#pragma unroll
          for (int m = 0; m < 4; ++m)
#pragma unroll
              for (int bj = 0; bj < 2; ++bj) gA[m][bj] = *(const u32x4*)(SG + (size_t)(row0 + ai * HALF + m * 16) * 3072 + br * 1024 + col0 + bj * HALF);
#pragma unroll
            for (int m = 0; m < 4; ++m) { const size_t row = (size_t)(row0 + ai * HALF + m * 16);
#pragma unroll
                for (int bj = 0; bj < 2; ++bj) {
                    const int col = col0 + bj * HALF;
                    const u32x4 gw = gA[m][bj];
#pragma unroll
                    for (int e = 0; e < 4; ++e) {
                        const float g0 = __uint_as_float(gw[e] << 16), g1 = __uint_as_float(gw[e] & 0xffff0000u);
                        if (e < 2) { acc[ai][bj][m][0][2 * e] *= g0; acc[ai][bj][m][0][2 * e + 1] *= g1; } else { acc[ai][bj][m][1][2 * e - 4] *= g0; acc[ai][bj][m][1][2 * e - 3] *= g1; }
                    }
                    if (br == 2) {
                        u32x4 w; w.x = cvt_pk_bf16(acc[ai][bj][m][0][0], acc[ai][bj][m][0][1]); w.y = cvt_pk_bf16(acc[ai][bj][m][0][2], acc[ai][bj][m][0][3]);
                        w.z = cvt_pk_bf16(acc[ai][bj][m][1][0], acc[ai][bj][m][1][1]); w.w = cvt_pk_bf16(acc[ai][bj][m][1][2], acc[ai][bj][m][1][3]);
                        *(u32x4*)(MG + row * 1024 + col) = w; } } }
        }
    }
};
struct EpiOut {
    static constexpr bool PERM = false, AFTER_DRAIN = false, CHAIN = false;
    const float* X; float* O;
    __device__ __forceinline__ void operator()(const f32x4 (&acc)[2][2][4][2], const Unit& u, int wr, int wc, int fr, int fq) const {
        const int row0 = u.pm * BM + wr * 64 + fr, col0 = u.pn * BM + wc * 32 + 4 * fq;
#pragma unroll
        for (int ai = 0; ai < 2; ++ai)
#pragma unroll
            for (int m = 0; m < 4; ++m) { const size_t off = (size_t)(row0 + ai * HALF + m * 16) * 1024 + col0;
#pragma unroll
                for (int bj = 0; bj < 2; ++bj)
#pragma unroll
                    for (int n = 0; n < 2; ++n) { const f32x4 xv = *(const f32x4*)(X + off + bj * HALF + n * 16); *(f32x4*)(O + off + bj * HALF + n * 16) = xv + acc[ai][bj][m][n]; } }
    }
};
}

DI void phase_gemm_gate(const Params& p, unsigned char* lds, const int bid, const int nb) {
    unsigned char* ws = p.ws;
    const bf16_t* H = (const bf16_t*)(ws + OFF_H); const bf16_t* Wt = (const bf16_t*)(ws + OFF_WIN) + (size_t)C_G * 1024;
    bf16_t* SG = (bf16_t*)(ws + OFF_SG);
    const int tn = 3072 / 128, nt = (M / 128) * tn;
    for (int it = bid; it < nt; it += nb) {
        GemmTile g; gemm_zero(g);
        const int m0 = (it / tn) * 128, n0 = (it % tn) * 128;
        gemm_tile_k(g, H, 1024, Wt, 1024, m0, n0, 1024, lds);
        GEMM_FOREACH(SG[(size_t)row * 3072 + col] = f2bf(sigmoidf_(g.acc[mi][ni][r])););
    }
}
DI void phase_gemm_proj(const Params& p, unsigned char* lds, const int bid, const int nb) {
    unsigned char* ws = p.ws;
    const bf16_t* SG = (const bf16_t*)(ws + OFF_SG); bf16_t* MG = (bf16_t*)(ws + OFF_MG);
    const int tn = 1024 / 128, nt = (M / 128) * tn;
    for (int it = bid; it < nt; it += nb) {
        const int m0 = (it / tn) * 128, n0 = (it % tn) * 128;
        GemmTile mg; gemm_zero(mg);
#pragma unroll 1
        for (int br = 0; br < 3; ++br) {
            GemmTile g; gemm_zero(g);
            const bf16_t* Y = (const bf16_t*)(ws + (br == 0 ? OFF_YA : br == 1 ? OFF_YB : OFF_YC));
            const bf16_t* W = (const bf16_t*)(ws + (br == 0 ? OFF_WPA : br == 1 ? OFF_WPB : OFF_WPC));
            gemm_tile_k(g, Y, 512, W, 512, m0, n0, 512, lds);
            GEMM_FOREACH(mg.acc[mi][ni][r] += bf2f(SG[(size_t)row * 3072 + br * 1024 + col]) * g.acc[mi][ni][r];);
        }
        GEMM_FOREACH(MG[(size_t)row * 1024 + col] = f2bf(mg.acc[mi][ni][r]););
    }
}
DI void phase_gemm_out(const Params& p, unsigned char* lds, const int bid, const int nb) {
    unsigned char* ws = p.ws;
    const bf16_t* MG = (const bf16_t*)(ws + OFF_MG); const bf16_t* W = (const bf16_t*)(ws + OFF_WO);
    const int tn = 1024 / 128, nt = (M / 128) * tn;
    for (int it = bid; it < nt; it += nb) {
        GemmTile g; gemm_zero(g);
        const int m0 = (it / tn) * 128, n0 = (it % tn) * 128;
        gemm_tile_k(g, MG, 1024, W, 1024, m0, n0, 1024, lds);
        GEMM_FOREACH(p.out[(size_t)row * 1024 + col] = p.x[(size_t)row * 1024 + col] + g.acc[mi][ni][r];);
    }
}

DI void phase_gemm_in_fast(const Params& p, unsigned char* lds, const int bid, const int nb) {
    unsigned char* ws = p.ws;
    {
        pg8::Gemm g{(const bf16_t*)(ws + OFF_H), (const bf16_t*)(ws + OFF_WIN), M, NP, 1024}; pg8::StaticOrder S; S.init(M, NP, nb, bid);
        pg8::EpiStore<0> E{(bf16_t*)(ws + OFF_P), NP};
        pg8::gemm_phase<pg8::EpiStore<0>, pg8::StaticOrder, true, true>(LASP(lds), g, S, E);
    }
    __syncthreads();
    const int tn2 = 1024 / 128, nt2 = (MM / 128) * tn2;
    for (int it = bid - nb / 2; it >= 0 && it < nt2; it += nb) {
        GemmTile g; gemm_zero(g);
        const int m0 = (it / tn2) * 128, n0 = (it % tn2) * 128;
        gemm_tile_k(g, (const bf16_t*)(ws + OFF_HM), 1024, (const bf16_t*)(ws + OFF_WKV), 1024, m0, n0, 1024, lds);
        bf16_t* KVM = (bf16_t*)(ws + OFF_KVM);
        GEMM_FOREACH(KVM[(size_t)row * 1024 + col] = f2bf(g.acc[mi][ni][r]););
        if (n0 < 512) {
            __syncthreads();
            int t2 = threadIdx.x; asm volatile("" : "+v"(t2));
            bf16_t* rp = KVM + (size_t)(m0 + (t2 >> 2)) * 1024 + n0 + (t2 & 3) * 32;
            float x[4][8]; float ss = 0.f;
#pragma unroll
            for (int i = 0; i < 4; ++i) { unpack8(*(const uint4*)(rp + 8 * i), x[i]);
#pragma unroll
                for (int e = 0; e < 8; ++e) ss += x[i][e] * x[i][e]; }
            const float rs = rsqrtf(quad_sum(ss) * (1.f / 128.f) + 1e-6f);
#pragma unroll
            for (int i = 0; i < 4; ++i) {
#pragma unroll
                for (int e = 0; e < 8; ++e) x[i][e] *= rs * p.xk_norm_g[(t2 & 3) * 32 + 8 * i + e];
                *(uint4*)(rp + 8 * i) = pack8f(x[i]); }
        }
    }
    { const int first = nb / 2 + nt2, cnt = nb - first;
      if (cnt > 0) { for (int it = bid - first; it >= 0 && it < 172; it += cnt) convert_late(p, lds, it, 172); }
      else { for (int it = bid; it < 172; it += nb) convert_late(p, lds, it, 172); } }
}
DI void phase_gemm_gate_fast(const Params& p, unsigned char* lds, const int bid, const int nb, const int ui = 0) {
    unsigned char* ws = p.ws;
    pg8::Gemm g{(const bf16_t*)(ws + OFF_H), (const bf16_t*)(ws + OFF_WIN) + (size_t)C_G * 1024, M, 3072, 1024};
    pg8::StaticOrder S; S.init(M, 1024, nb, bid);
    pg8::Unit own; const bool has = S.next(ui, own);
    pg8::GateOrder O{own.pm, own.pn, has ? 1 : 0};
    pg8::EpiGateR E{(bf16_t*)(ws + OFF_SG)};
    pg8::gemm_phase<pg8::EpiGateR, pg8::GateOrder, true, true>(LASP(lds), g, O, E);
}
DI void phase_gemm_proj_fast(const Params& p, unsigned char* lds, const int bid, const int nb) {
    unsigned char* ws = p.ws;
    bf16_t* MG = (bf16_t*)(ws + OFF_MG); const bf16_t* SG = (const bf16_t*)(ws + OFF_SG);
    pg8::StaticOrder S; S.init(M, 1024, nb, bid);
    { pg8::Gemm g{(const bf16_t*)(ws + OFF_YA), (const bf16_t*)(ws + OFF_WPA), M, 1024, 512}; pg8::EpiProj<false> E{MG, SG, 0};
      pg8::gemm_phase<pg8::EpiProj<false>, pg8::StaticOrder, true, true>(LASP(lds), g, S, E); }
    { pg8::Gemm g{(const bf16_t*)(ws + OFF_YB), (const bf16_t*)(ws + OFF_WPB), M, 1024, 512}; pg8::EpiProj<true> E{MG, SG, 1024};
      pg8::gemm_phase<pg8::EpiProj<true>, pg8::StaticOrder, true, true>(LASP(lds), g, S, E); }
    { pg8::Gemm g{(const bf16_t*)(ws + OFF_YC), (const bf16_t*)(ws + OFF_WPC), M, 1024, 512}; pg8::EpiProj<true> E{MG, SG, 2048};
      pg8::gemm_phase<pg8::EpiProj<true>, pg8::StaticOrder, true, true>(LASP(lds), g, S, E); }
}
DI void phase_gemm_proj3(const Params& p, unsigned char* lds, const int bid, const int nb, const int ui = 0) {
    unsigned char* ws = p.ws;
    static_assert(OFF_YB == OFF_YA + (size_t)M * 512 * 2 && OFF_YC == OFF_YB + (size_t)M * 512 * 2 && OFF_WPB == OFF_WPA + (size_t)1024 * 512 * 2 && OFF_WPC == OFF_WPB + (size_t)1024 * 512 * 2, "contiguous branches");
    pg8::StaticOrder S; S.init(M, 1024, nb, bid);
    pg8::Unit own; const bool has = S.next(ui, own);
    pg8::ProjOrder O{own.pm, own.pn, has ? 1 : 0};
    pg8::Gemm g{(const bf16_t*)(ws + OFF_YA), (const bf16_t*)(ws + OFF_WPA), 3 * M, 3072, 512};
    pg8::EpiProjChain E{(bf16_t*)(ws + OFF_MG), (const bf16_t*)(ws + OFF_SG)};
    pg8::gemm_phase<pg8::EpiProjChain, pg8::ProjOrder, true, true>(LASP(lds), g, O, E);
}
DI void phase_gemm_out_fast(const Params& p, unsigned char* lds, const int bid, const int nb) {
    unsigned char* ws = p.ws;
    pg8::Gemm g{(const bf16_t*)(ws + OFF_MG), (const bf16_t*)(ws + OFF_WO), M, 1024, 1024}; pg8::StaticOrder S; S.init(M, 1024, nb, bid);
    pg8::EpiOut E{p.x, p.out};
    pg8::gemm_phase<pg8::EpiOut, pg8::StaticOrder, true, true>(LASP(lds), g, S, E);
}

#define XB_TMO      128
#define XB_XCNT(j)  (256  + 64 * (j))
#define XB_XSUB(j)  (1280 + 64 * (j))
#define XB_XGEN(j)  (2304 + 64 * (j))
#define XB_TOP      3328
#define XB_TOPGEN   3392
#define XCD_BAR_WORDS 3456
#define XB_SPIN_CAP (1u << 22)
DI unsigned xb_ld(unsigned* p)              { return __hip_atomic_load(p, __ATOMIC_RELAXED, __HIP_MEMORY_SCOPE_AGENT); }
DI unsigned xb_add(unsigned* p, unsigned v) { return __hip_atomic_fetch_add(p, v, __ATOMIC_RELAXED, __HIP_MEMORY_SCOPE_AGENT); }
DI unsigned xb_xcc_id() { return (unsigned)__builtin_amdgcn_s_getreg((3 << 11) | 20) & 0xFu; }
#define XB_SPIN(cond, bar) do { unsigned _sp = 0; while (cond) { __builtin_amdgcn_s_sleep(1); \
    if ((++_sp & 255u) == 0u) { if (xb_ld(&(bar)[XB_TMO])) break; if (_sp > XB_SPIN_CAP) { atomicAdd(&(bar)[XB_TMO], 1u); break; } } } } while (0)
struct XcdBarrier { unsigned* bar; unsigned x; volatile LAS unsigned* st; };
DI XcdBarrier xcd_barrier_post(unsigned* bar, volatile LAS unsigned* st) {
    XcdBarrier b; b.bar = bar; b.x = xb_xcc_id(); b.st = st;
    if (threadIdx.x == 0) (void)xb_add(&bar[XB_XCNT(b.x)], 1u);
    return b;
}
DI void xcd_barrier_complete(unsigned* bar, unsigned x, unsigned& nloc, unsigned& nx) {
    const unsigned G = gridDim.x * gridDim.y * gridDim.z;
    unsigned sum, cnt, mine, sp = 0u;
    for (;;) {
        sum = 0u; cnt = 0u; mine = 0u;
#pragma unroll
        for (unsigned j = 0; j < 16; ++j) { const unsigned c = xb_ld(&bar[XB_XCNT(j)]); sum += c; cnt += (c > 0u) ? 1u : 0u; mine = (j == x) ? c : mine; }
        if (sum == G) break;
        __builtin_amdgcn_s_sleep(1);
        if ((++sp & 255u) == 0u) { if (xb_ld(&bar[XB_TMO])) break; if (sp > XB_SPIN_CAP) { atomicAdd(&bar[XB_TMO], 1u); break; } }
    }
    nloc = mine > 0u ? mine : 1u; nx = cnt > 0u ? cnt : 1u;
}
DI void xcd_barrier(const XcdBarrier& b) {
    asm volatile("s_waitcnt vmcnt(0)" ::: "memory");
    __syncthreads();
    if (threadIdx.x == 0) {
        unsigned* bar = b.bar;
        __builtin_amdgcn_s_waitcnt(0);
        unsigned nloc = b.st[0], nx = b.st[1];
        if (nloc == 0u) { xcd_barrier_complete(bar, b.x, nloc, nx); b.st[0] = nloc; b.st[1] = nx; }
        const unsigned old = xb_add(&bar[XB_XSUB(b.x)], 1u);
        const unsigned gen = old / nloc;
        if (old + 1u == (gen + 1u) * nloc) {
            __builtin_amdgcn_fence(__ATOMIC_RELEASE, "agent");
            asm volatile("s_waitcnt vmcnt(0)" ::: "memory");
            const unsigned og = xb_add(&bar[XB_TOP], 1u);
            const unsigned tg = og / nx;
            if (og + 1u == (tg + 1u) * nx) xb_add(&bar[XB_TOPGEN], 1u);
            else XB_SPIN(xb_ld(&bar[XB_TOPGEN]) == tg, bar);
            __builtin_amdgcn_fence(__ATOMIC_ACQUIRE, "agent");
            xb_add(&bar[XB_XGEN(b.x)], 1u);
            asm volatile("s_waitcnt vmcnt(0)" ::: "memory");
        } else {
            XB_SPIN(xb_ld(&bar[XB_XGEN(b.x)]) == gen, bar);
            __builtin_amdgcn_fence(__ATOMIC_ACQUIRE, "agent");
            asm volatile("s_waitcnt vmcnt(0)" ::: "memory");
        }
    }
    __syncthreads();
}

__global__ void __launch_bounds__(NTHREADS, 2) k_mega(Params p) {
    extern __shared__ __attribute__((aligned(16))) unsigned char lds[];
    volatile LAS unsigned* st = (volatile LAS unsigned*)(lds + LDS_CTL_OFF);
    if (threadIdx.x == 0) { st[0] = 0u; st[1] = 0u; st[2] = 0u; st[3] = 0u; }
    __syncthreads();
    (void)xcd_barrier_post((unsigned*)(p.ws + OFF_CTL), st);
#define GRID_BAR() do { XcdBarrier b_; b_.bar = (unsigned*)(p.ws + OFF_CTL); b_.x = xb_xcc_id(); b_.st = (volatile LAS unsigned*)(lds + LDS_CTL_OFF); xcd_barrier(b_); } while (0)
    const int bid = blockIdx.x, nb = gridDim.x;
#ifndef REPMASK
#define REPMASK 0
#endif
#ifndef REPCNT
#define REPCNT 1
#endif
    volatile LAS unsigned* stp = (volatile LAS unsigned*)(lds + LDS_CTL_OFF + 64);
    int nst = 0;
#define STAMP() do { if (STAMP_PH >= 0 && blockIdx.x == 0 && threadIdx.x == 0) stp[nst] = (unsigned)__builtin_amdgcn_s_memrealtime(); ++nst; } while (0)
    STAMP();
#define REP(bit_, call_) do { call_; if (REPMASK & (bit_)) { for (int rep_ = 0; rep_ < REPCNT; ++rep_) { __syncthreads(); call_; } } } while (0)
    REP(1, phase_prologue(p, lds, bid, nb));
    GRID_BAR(); STAMP();
    REP(2, phase_gemm_in_fast(p, lds, bid, nb));
    GRID_BAR(); STAMP();
    REP(8, phase_rwkv_prep(p, lds, bid, nb));
    GRID_BAR(); STAMP();
    if (bid < 16) phase_rwkv_scan(p, lds, bid);
    phase_attn_queue(p, lds);
    GRID_BAR(); STAMP();
    REP(64, phase_gemm_gate_fast(p, lds, bid, nb));
    __syncthreads(); STAMP();
    phase_gemm_proj3(p, lds, bid, nb);
    for (int ui = 1; (long)ui * nb + bid < 256; ++ui) {
        __syncthreads(); phase_gemm_gate_fast(p, lds, bid, nb, ui); __syncthreads(); phase_gemm_proj3(p, lds, bid, nb, ui); }
    GRID_BAR(); STAMP();
    REP(256, phase_gemm_out_fast(p, lds, bid, nb));
    if (STAMP_PH >= 0) { GRID_BAR(); STAMP();
        if (blockIdx.x == 0) {
            float* sm = (float*)lds; float best = 1e30f; int bi = 0;
            for (int i = threadIdx.x; i < 65536; i += NTHREADS) { const float a = fabsf(p.out[i]); if (a < best) { best = a; bi = i; } }
            sm[threadIdx.x] = best; ((int*)sm)[512 + threadIdx.x] = bi;
            __syncthreads();
            if (threadIdx.x == 0) {
                for (int i = 1; i < NTHREADS; ++i) if (sm[i] < best) { best = sm[i]; bi = ((int*)sm)[512 + i]; }
                const float tot = (float)(stp[nst - 1] - stp[0]); const float ph = STAMP_PH < 20 ? (float)(stp[STAMP_PH + 1] - stp[STAMP_PH]) : STAMP_PH >= 40 ? 4.f * (float)stp[24 + STAMP_PH - 40] : STAMP_PH >= 30 ? 4.f * (float)(stp[17 + STAMP_PH - 30] - stp[16 + STAMP_PH - 30]) : tot * 0.5f;
                float v = STAMP_PH == 99 ? 0.04f + tot * 1e-6f : 0.05f + 0.1f * ph / tot;
#if STAMP_PH >= 60
                { const unsigned* qst = (const unsigned*)(p.ws + OFF_CTL + 40000); const int k = STAMP_PH - 60;
                  if (k < 4) v = 0.05f + 0.001f * ((float)__hip_atomic_load(qst + 2 * k, __ATOMIC_RELAXED, __HIP_MEMORY_SCOPE_AGENT) / fmaxf((float)__hip_atomic_load(qst + 2 * k + 1, __ATOMIC_RELAXED, __HIP_MEMORY_SCOPE_AGENT), 1.f)) * 0.01f;
                  else if (k == 4) v = 0.05f + 0.0005f * (float)__hip_atomic_load(qst + 8, __ATOMIC_RELAXED, __HIP_MEMORY_SCOPE_AGENT) * 0.01f;
                  else v = 0.05f + 0.01f * (float)__hip_atomic_load(qst + 2 * (k - 5) + 1, __ATOMIC_RELAXED, __HIP_MEMORY_SCOPE_AGENT); }
#endif
                p.out[bi] += v; }
        } }
}

extern "C" void kernel_launch(void* const* d_in, const int* in_sizes, int n_in, void* d_out, int out_size, void* d_ws, size_t ws_size, hipStream_t stream) {
    static int grid = 0;
    if (grid == 0) {
        if (n_in != 27 || ws_size < WS_END) { fprintf(stderr, "kernel_launch: unexpected inputs (n_in %d, ws %zu)\n", n_in, ws_size); grid = -1; return; }
        int dev = 0, cus = 0, per_cu = 0;
        if (hipGetDevice(&dev) != hipSuccess || hipDeviceGetAttribute(&cus, hipDeviceAttributeMultiprocessorCount, dev) != hipSuccess) { grid = -1; return; }
        if (hipFuncSetAttribute((const void*)k_mega, hipFuncAttributeMaxDynamicSharedMemorySize, LDS_BYTES) != hipSuccess) { fprintf(stderr, "kernel_launch: hipFuncSetAttribute failed\n"); grid = -1; return; }
        if (hipOccupancyMaxActiveBlocksPerMultiprocessor(&per_cu, (const void*)k_mega, NTHREADS, LDS_BYTES) != hipSuccess || per_cu < 1)
            fprintf(stderr, "kernel_launch: occupancy query reports %d workgroups per CU\n", per_cu);
        (void)hipGetLastError();
        grid = cus;
        if (grid < 32) { fprintf(stderr, "kernel_launch: too few CUs (%d)\n", grid); grid = -1; return; }
    }
    if (grid < 0) return;
    if (hipMemsetAsync((char*)d_ws + OFF_CTL, 0, 65536, stream) != hipSuccess) { fprintf(stderr, "kernel_launch: memset failed\n"); return; }
    Params p{};
    p.x = (const float*)d_in[0]; p.mem = (const float*)d_in[1]; p.pos = (const int*)d_in[2]; p.norm_g = (const float*)d_in[3]; p.mem_norm_g = (const float*)d_in[4];
    p.w_in = (const float*)d_in[5]; p.mu_rkv = (const float*)d_in[6]; p.mu_wa = (const float*)d_in[7]; p.w0 = (const float*)d_in[8]; p.w2 = (const float*)d_in[9];
    p.a0 = (const float*)d_in[10]; p.a2 = (const float*)d_in[11]; p.k_k = (const float*)d_in[12]; p.k_a = (const float*)d_in[13]; p.r_k = (const float*)d_in[14];
    p.lnx_g = (const float*)d_in[15]; p.lnx_b = (const float*)d_in[16]; p.q_norm_g = (const float*)d_in[17]; p.k_norm_g = (const float*)d_in[18]; p.sinks = (const float*)d_in[19];
    p.xq_norm_g = (const float*)d_in[20]; p.xk_norm_g = (const float*)d_in[21]; p.w_mem_kv = (const float*)d_in[22]; p.w_proj_a = (const float*)d_in[23];
    p.w_proj_b = (const float*)d_in[24]; p.w_proj_c = (const float*)d_in[25]; p.w_out = (const float*)d_in[26];
    p.out = (float*)d_out; p.ws = (unsigned char*)d_ws;
    hipLaunchKernelGGL(k_mega, dim3(grid), dim3(NTHREADS), LDS_BYTES, stream, p);
}
```
